# Optimizing an MI355X kernel written in HIP

```python
import math
import jax, jax.numpy as jnp
from jax import lax
import numpy as np

D_MODEL = 1024
BATCH = 32
SEQ = 2048
DEPTH = 1

GRID_W = 64
CTX_LEN = 256
MLA_HEADS = 8
QK_NOPE = 64
QK_ROPE = 32
QK_DIM = QK_NOPE + QK_ROPE
V_DIM = 64
Q_LORA = 384
KV_LORA = 256
ROPE_THETA = 10000.0
Q_BLOCK = 128
F_GROUPS = 4
F_GROUP_DIM = 128
D_F = F_GROUPS * F_GROUP_DIM
OFF_Q = 0
OFF_KV = OFF_Q + Q_LORA
OFF_KPE = OFF_KV + KV_LORA
OFF_F = OFF_KPE + QK_ROPE
OFF_GA = OFF_F + D_F
OFF_GB = OFF_GA + D_MODEL
N_IN = OFF_GB + D_MODEL
N_EXPERTS = 16
D_EXPERT = 512
CAPACITY_FACTOR = 2
EPS = 1e-6

kernel_name = "hybrid_mla_fnet_ecmoe_dit_layer"


def _rms(x, g):
    xf = x.astype(jnp.float32)
    y = xf * lax.rsqrt(jnp.mean(xf * xf, axis=-1, keepdims=True) + EPS)
    return (y * g.astype(jnp.float32)).astype(x.dtype)


def _modulate(h, shift, scale):
    return h * (1.0 + scale) + shift


def _axial_tables(pos_row, pos_col, dtype):
    half = QK_ROPE // 2
    n_freq = half // 2
    inv_freq = 1.0 / (ROPE_THETA ** (jnp.arange(n_freq, dtype=jnp.float32) / n_freq))

    def tab(pos):
        ang = pos.astype(jnp.float32)[:, None] * inv_freq[None, :]
        ang = jnp.concatenate([ang, ang], axis=-1)[None, :, None, :]
        return jnp.cos(ang).astype(dtype), jnp.sin(ang).astype(dtype)

    cr, sr = tab(pos_row)
    cc, scol = tab(pos_col)
    return cr, sr, cc, scol


def _rope_axis(x, cos, sin):
    x1, x2 = jnp.split(x, 2, axis=-1)
    return x * cos + jnp.concatenate([-x2, x1], axis=-1) * sin


def _rope_2d(x, tabs):
    cr, sr, cc, scol = tabs
    xr, xc = jnp.split(x, 2, axis=-1)
    return jnp.concatenate([_rope_axis(xr, cr, sr), _rope_axis(xc, cc, scol)], axis=-1)


def _mla_qkv(p, q_a_g, kv_a_g, w_q_up, w_kv_up, q_g, k_g, tabs):
    B, T, _ = p.shape
    cq = _rms(p[..., OFF_Q:OFF_KV], q_a_g)
    ckv = _rms(p[..., OFF_KV:OFF_KPE], kv_a_g)
    k_pe = p[..., OFF_KPE:OFF_F]
    q = (cq @ w_q_up).reshape(B, T, MLA_HEADS, QK_DIM)
    kv = (ckv @ w_kv_up).reshape(B, T, MLA_HEADS, QK_NOPE + V_DIM)
    k_nope, v = kv[..., :QK_NOPE], kv[..., QK_NOPE:]
    k = jnp.concatenate([k_nope, jnp.broadcast_to(k_pe[:, :, None, :], (B, T, MLA_HEADS, QK_ROPE))], axis=-1)
    q = _rms(q, q_g)
    k = _rms(k, k_g)
    if tabs is not None:
        q = jnp.concatenate([q[..., :QK_NOPE], _rope_2d(q[..., QK_NOPE:], tabs)], axis=-1)
        k = jnp.concatenate([k[..., :QK_NOPE], _rope_2d(k[..., QK_NOPE:], tabs)], axis=-1)
    return q, k, v


def _attend_dense(q, k, v):
    s = jnp.einsum('bqhd,bkhd->bhqk', q, k, preferred_element_type=jnp.float32) * (QK_DIM ** -0.5)
    pr = jax.nn.softmax(s, axis=-1).astype(v.dtype)
    return jnp.einsum('bhqk,bkhd->bqhd', pr, v)


def _attend_latent(q, k_lat, v_lat, k_ctx, v_ctx):
    B, T, H, _ = q.shape
    k_all = jnp.concatenate([k_lat, k_ctx], axis=1)
    v_all = jnp.concatenate([v_lat, v_ctx], axis=1)
    nb = T // Q_BLOCK
    qb = jnp.moveaxis(q.reshape(B, nb, Q_BLOCK, H, QK_DIM), 1, 0)
    o = lax.map(lambda qi: _attend_dense(qi, k_all, v_all), qb)
    return jnp.moveaxis(o, 0, 1).reshape(B, T, H * V_DIM)


def _fourier(f):
    B, T, _ = f.shape
    fg = f.reshape(B, T, F_GROUPS, F_GROUP_DIM).astype(jnp.float32)
    y = jnp.fft.fft2(fg, axes=(1, 3), norm="ortho").real
    return y.reshape(B, T, D_F).astype(f.dtype)


def _expert_choice(h, w_r, w_g, w_u, w_d):
    B, T, D = h.shape
    cap = (CAPACITY_FACTOR * T) // N_EXPERTS
    logits = jnp.einsum('btd,de->bte', h, w_r, preferred_element_type=jnp.float32)
    aff = jax.nn.softmax(logits, axis=-1)
    gate, idx = lax.top_k(jnp.swapaxes(aff, 1, 2), cap)
    xe = jax.vmap(lambda hb, ib: hb[ib])(h, idx)
    a = jnp.einsum('becd,edf->becf', xe, w_g)
    u = jnp.einsum('becd,edf->becf', xe, w_u)
    ye = jnp.einsum('becf,efd->becd', jax.nn.silu(a) * u, w_d) * gate[..., None].astype(h.dtype)
    return jax.vmap(lambda yb, ib: jnp.zeros((T, D), yb.dtype).at[ib.reshape(-1)].add(yb.reshape(-1, D)))(ye, idx)


def _merge(p, attn_o, four_o, w_o_attn, w_fourier, w_out):
    ga = jax.nn.sigmoid(p[..., OFF_GA:OFF_GB])
    gb = jax.nn.sigmoid(p[..., OFF_GB:N_IN])
    return (ga * (attn_o @ w_o_attn) + gb * (four_o @ w_fourier)) @ w_out


def setup_inputs(seed: int = 0) -> dict:
    key = jax.random.key(seed)
    ks = jax.random.split(key, 24)
    L, D = DEPTH, D_MODEL

    def nrm(k, shape, fan_in, mult=1.0):
        return jax.random.normal(k, shape, jnp.float32) * (mult * fan_in ** -0.5)

    def gain(k, shape):
        return 1.0 + 0.02 * jax.random.normal(k, shape, jnp.float32)

    return {
        "x": jax.random.normal(ks[0], (BATCH, SEQ, D), jnp.float32),
        "c": jax.random.normal(ks[1], (BATCH, D), jnp.float32),
        "ctx": jax.random.normal(ks[2], (BATCH, CTX_LEN, D), jnp.float32),
        "c_ctx": 0.5 * jax.random.normal(ks[3], (D,), jnp.float32),
        "w_mod": nrm(ks[4], (L, D, 6 * D), D, 0.5),
        "b_mod": 0.02 * jax.random.normal(ks[5], (L, 6 * D), jnp.float32),
        "norm1_g": gain(ks[6], (L, D)),
        "w_in": nrm(ks[7], (L, D, N_IN), D),
        "q_a_norm_g": gain(ks[8], (L, Q_LORA)),
        "kv_a_norm_g": gain(ks[9], (L, KV_LORA)),
        "w_q_up": nrm(ks[10], (L, Q_LORA, MLA_HEADS * QK_DIM), Q_LORA),
        "w_kv_up": nrm(ks[11], (L, KV_LORA, MLA_HEADS * (QK_NOPE + V_DIM)), KV_LORA),
        "q_norm_g": gain(ks[12], (L, QK_DIM)),
        "k_norm_g": gain(ks[13], (L, QK_DIM)),
        "w_o_attn": nrm(ks[14], (L, MLA_HEADS * V_DIM, D), MLA_HEADS * V_DIM),
        "w_fourier": nrm(ks[15], (L, D_F, D), D_F),
        "w_out": nrm(ks[16], (L, D, D), D),
        "norm2_g": gain(ks[17], (L, D)),
        "w_router": nrm(ks[18], (L, D, N_EXPERTS), D),
        "w_e_gate": nrm(ks[19], (L, N_EXPERTS, D, D_EXPERT), D),
        "w_e_up": nrm(ks[20], (L, N_EXPERTS, D, D_EXPERT), D),
        "w_e_down": nrm(ks[21], (L, N_EXPERTS, D_EXPERT, D), D_EXPERT),
    }


def reference(x, c, ctx, c_ctx, w_mod, b_mod, norm1_g, w_in, q_a_norm_g, kv_a_norm_g,
              w_q_up, w_kv_up, q_norm_g, k_norm_g, w_o_attn, w_fourier, w_out, norm2_g,
              w_router, w_e_gate, w_e_up, w_e_down):
    T = x.shape[1]
    rows = T // GRID_W
    pos_row = jnp.repeat(jnp.arange(rows, dtype=jnp.int32), GRID_W)
    pos_col = jnp.tile(jnp.arange(GRID_W, dtype=jnp.int32), rows)
    tabs = _axial_tables(pos_row, pos_col, x.dtype)
    s_lat = jax.nn.silu(c)
    s_ctx = jax.nn.silu(c_ctx)

    for l in range(DEPTH):
        last = l == DEPTH - 1
        mod_l = (s_lat @ w_mod[l] + b_mod[l])[:, None, :]
        mod_c = s_ctx @ w_mod[l] + b_mod[l]
        sh1, sc1, g1, sh2, sc2, g2 = jnp.split(mod_l, 6, axis=-1)
        csh1, csc1, cg1, csh2, csc2, cg2 = jnp.split(mod_c, 6, axis=-1)

        h = _modulate(_rms(x, norm1_g[l]), sh1, sc1)
        hc = _modulate(_rms(ctx, norm1_g[l]), csh1, csc1)
        p = h @ w_in[l]
        pc = hc @ w_in[l]
        mla_w = (q_a_norm_g[l], kv_a_norm_g[l], w_q_up[l], w_kv_up[l], q_norm_g[l], k_norm_g[l])
        q, k, v = _mla_qkv(p, *mla_w, tabs)
        qc, kc, vc = _mla_qkv(pc, *mla_w, None)
        attn_lat = _attend_latent(q, k, v, kc, vc)
        four_lat = _fourier(p[..., OFF_F:OFF_GA])
        x = x + g1 * _merge(p, attn_lat, four_lat, w_o_attn[l], w_fourier[l], w_out[l])

        if not last:
            B = ctx.shape[0]
            attn_ctx = _attend_dense(qc, kc, vc).reshape(B, CTX_LEN, MLA_HEADS * V_DIM)
            four_ctx = _fourier(pc[..., OFF_F:OFF_GA])
            ctx = ctx + cg1 * _merge(pc, attn_ctx, four_ctx, w_o_attn[l], w_fourier[l], w_out[l])

        moe_w = (w_router[l], w_e_gate[l], w_e_up[l], w_e_down[l])
        h2 = _modulate(_rms(x, norm2_g[l]), sh2, sc2)
        x = x + g2 * _expert_choice(h2, *moe_w)
        if not last:
            hc2 = _modulate(_rms(ctx, norm2_g[l]), csh2, csc2)
            ctx = ctx + cg2 * _expert_choice(hc2, *moe_w)
    return x
```

```cpp
#include <hip/hip_runtime.h>
#include <hip/hip_cooperative_groups.h>
#include <cstdio>
#include <cstring>
#include <cstdint>
namespace cg = cooperative_groups;

#define DI __device__ __forceinline__
typedef unsigned short bf16_t;
typedef short bf16x8 __attribute__((ext_vector_type(8)));
typedef float f32x16 __attribute__((ext_vector_type(16)));
#define MFMA(a, b, c) __builtin_amdgcn_mfma_f32_32x32x16_bf16((a), (b), (c), 0, 0, 0)

constexpr int NB = 32, SEQ = 2048, DM = 1024, NT = NB * SEQ, CTXL = 256, NC = NB * CTXL;
constexpr int NH = 8, QKD = 96, VD = 64, QL = 384, KVL = 256, NKEY = SEQ + CTXL;
constexpr int N_IN = 3232, NINP = 3328;
constexpr int NE = 16, DE = 512, CAP = 256;
constexpr float EPS = 1e-6f;
constexpr int LDQKV = 672, LDCKV = 288;
constexpr int SMEM_BYTES = 73728;

struct TJob {
  const float* src; bf16_t* dst; const float* scale;
  int K, ldS, n_off, n_cnt, dst_row0, mode, batch, tiles_n, tile_start, pad0;
  long src_bstride, dst_bstride;
};
constexpr int NJOBS = 11;

struct Params {
  const float *x, *c, *ctx, *c_ctx, *w_mod, *b_mod, *norm1_g, *q_norm_g, *k_norm_g, *norm2_g, *w_router;
  float* out;
  bf16_t *WinT, *WqT, *WkvT, *WoT, *WfT, *WoutT, *WguT, *WdT, *chanT, *posM;
  float *ropeTab, *mod;
  bf16_t *h, *pqkv, *pckv, *pf, *pg, *Q, *K, *Vt, *attn_o, *ABt, *four_o, *m, *h2, *hmid;
  float *aff, *gate;
  int* idx;
  TJob jobs[NJOBS];
  int n_ttiles, pad1;
};

typedef float f32x2v __attribute__((ext_vector_type(2)));
typedef __bf16 bf16x2v __attribute__((ext_vector_type(2)));
DI unsigned pk_bf16(float lo, float hi) { f32x2v v = {lo, hi}; bf16x2v b = __builtin_convertvector(v, bf16x2v); return __builtin_bit_cast(unsigned, b); }
DI float bf_lo(unsigned u) { return __uint_as_float(u << 16); }
DI float bf_hi(unsigned u) { return __uint_as_float(u & 0xffff0000u); }
DI float bf2f(bf16_t b) { return __uint_as_float(((unsigned)b) << 16); }
DI bf16_t f2bf(float f) { return (bf16_t)(pk_bf16(f, 0.f) & 0xffffu); }
DI float sigmoidf_(float x) { return 1.f / (1.f + __expf(-x)); }
DI int crow(int i, int hh) { return (i & 3) + 8 * (i >> 2) + 4 * hh; }
DI float wave_sum(float v) {
#pragma unroll
  for (int o = 32; o >= 1; o >>= 1) v += __shfl_xor(v, o);
  return v;
}
DI f32x16 zero16() { f32x16 z;
#pragma unroll
  for (int i = 0; i < 16; ++i) z[i] = 0.f; return z; }

template <int TM, int TN, int WM, int WN, bool SUMSQ, class AF, class BF>
DI void gemm_core(f32x16 (&acc)[TM][TN], AF arow, BF brow, int K, char* smem, float& sumsq) {
  constexpr int RA = 32 * TM * WM, RB = 32 * TN * WN, NA = RA / 32, NBR = RB / 32;
  constexpr int LDR = 144;
  constexpr int STAGE = (RA + RB) * LDR;
  static_assert(2 * STAGE <= SMEM_BYTES, "smem");
  const int t = threadIdx.x, lane = t & 63, w = t >> 6, r = lane & 31, hh = lane >> 5;
  const int wm = w % WM, wn = w / WM;
  const int c = t & 7, row0 = t >> 3;
  const bf16_t* pa[NA]; const bf16_t* pb[NBR];
#pragma unroll
  for (int i = 0; i < NA; ++i) pa[i] = arow(row0 + 32 * i) + c * 8;
#pragma unroll
  for (int i = 0; i < NBR; ++i) pb[i] = brow(row0 + 32 * i) + c * 8;
  uint4 ra[NA], rb[NBR];
#pragma unroll
  for (int i = 0; i < NA; ++i) ra[i] = *(const uint4*)(pa[i]);
#pragma unroll
  for (int i = 0; i < NBR; ++i) rb[i] = *(const uint4*)(pb[i]);
  {
    char* sa = smem + row0 * LDR + c * 16;
#pragma unroll
    for (int i = 0; i < NA; ++i) *(uint4*)(sa + i * 32 * LDR) = ra[i];
    char* sb = smem + RA * LDR + row0 * LDR + c * 16;
#pragma unroll
    for (int i = 0; i < NBR; ++i) *(uint4*)(sb + i * 32 * LDR) = rb[i];
  }
  __syncthreads();
  const int nk = K >> 6;
  for (int kt = 0; kt < nk; ++kt) {
    const char* cur = smem + (kt & 1) * STAGE;
    const bool more = (kt + 1 < nk);
    if (more) {
#pragma unroll
      for (int i = 0; i < NA; ++i) ra[i] = *(const uint4*)(pa[i] + (kt + 1) * 64);
#pragma unroll
      for (int i = 0; i < NBR; ++i) rb[i] = *(const uint4*)(pb[i] + (kt + 1) * 64);
    }
    const char* As = cur + (wm * TM * 32 + r) * LDR + hh * 16;
    const char* Bs = cur + RA * LDR + (wn * TN * 32 + r) * LDR + hh * 16;
#pragma unroll
    for (int ks = 0; ks < 4; ++ks) {
      bf16x8 a[TM], b[TN];
#pragma unroll
      for (int tm = 0; tm < TM; ++tm) a[tm] = *(const bf16x8*)(As + tm * 32 * LDR + ks * 32);
#pragma unroll
      for (int tn = 0; tn < TN; ++tn) b[tn] = *(const bf16x8*)(Bs + tn * 32 * LDR + ks * 32);
      if (SUMSQ) {
        uint4 u = __builtin_bit_cast(uint4, b[0]);
        float e0 = bf_lo(u.x), e1 = bf_hi(u.x), e2 = bf_lo(u.y), e3 = bf_hi(u.y), e4 = bf_lo(u.z), e5 = bf_hi(u.z), e6 = bf_lo(u.w), e7 = bf_hi(u.w);
        sumsq += e0 * e0 + e1 * e1 + e2 * e2 + e3 * e3 + e4 * e4 + e5 * e5 + e6 * e6 + e7 * e7;
      }
#pragma unroll
      for (int tm = 0; tm < TM; ++tm)
#pragma unroll
        for (int tn = 0; tn < TN; ++tn) acc[tm][tn] = MFMA(a[tm], b[tn], acc[tm][tn]);
    }
    if (more) {
      char* nxt = smem + ((kt + 1) & 1) * STAGE;
      char* sa = nxt + row0 * LDR + c * 16;
#pragma unroll
      for (int i = 0; i < NA; ++i) *(uint4*)(sa + i * 32 * LDR) = ra[i];
      char* sb = nxt + RA * LDR + row0 * LDR + c * 16;
#pragma unroll
      for (int i = 0; i < NBR; ++i) *(uint4*)(sb + i * 32 * LDR) = rb[i];
    }
    __syncthreads();
  }
}

DI void transpose_tile(const TJob& j, int tile, char* smem) {
  const int t = threadIdx.x;
  const int tpb = (j.K >> 6) * j.tiles_n;
  const int bi = tile / tpb, rem = tile % tpb;
  const int kt = rem / j.tiles_n, ntile = rem % j.tiles_n;
  const int k0 = kt * 64, n0 = ntile * 64;
  const float* src = j.src + (size_t)bi * j.src_bstride;
  bf16_t* dst = j.dst + (size_t)bi * j.dst_bstride;
  bf16_t* T = (bf16_t*)smem;
  const int nn = t & 63, kq = t >> 6;
  const bool nvalid = (n0 + nn) < j.n_cnt;
  __syncthreads();
#pragma unroll 4
  for (int i = 0; i < 16; ++i) {
    const int kk = kq + 4 * i;
    float v = 0.f;
    if (nvalid) {
      v = src[(size_t)(k0 + kk) * j.ldS + j.n_off + n0 + nn];
      if (j.scale) v *= j.scale[k0 + kk];
    }
    T[nn * 66 + kk] = f2bf(v);
  }
  __syncthreads();
  const int n = t >> 2, part = t & 3;
  if (n0 + n < j.n_cnt) {
    const unsigned* tp = (const unsigned*)(T + n * 66 + part * 16);
    uint4 o0, o1;
    o0.x = tp[0]; o0.y = tp[1]; o0.z = tp[2]; o0.w = tp[3];
    o1.x = tp[4]; o1.y = tp[5]; o1.z = tp[6]; o1.w = tp[7];
    const int f = n0 + n;
    int drow;
    if (j.mode == 0) drow = j.dst_row0 + f;
    else drow = (f >> 6) * 128 + ((f & 63) >> 5) * 64 + (j.mode == 2 ? 32 : 0) + (f & 31);
    uint4* dp = (uint4*)(dst + (size_t)drow * j.K + k0 + part * 16);
    dp[0] = o0; dp[1] = o1;
  }
}

DI void mod_item(const Params& p, int it, char* smem) {
  const int t = threadIdx.x, cgi = t & 63, kg = t >> 6;
  const int j0 = it * 64;
  float* Ssm = (float*)smem;
  float* red = (float*)(smem + 33 * 128 * 4);
  float acc[33];
#pragma unroll
  for (int r = 0; r < 33; ++r) acc[r] = 0.f;
  for (int kc = 0; kc < 8; ++kc) {
    __syncthreads();
    for (int idx = t; idx < 33 * 128; idx += 256) {
      const int r = idx >> 7, kk = idx & 127;
      float v = (r < 32) ? p.c[r * DM + kc * 128 + kk] : p.c_ctx[kc * 128 + kk];
      Ssm[idx] = v * sigmoidf_(v);
    }
    __syncthreads();
    for (int kk = 0; kk < 32; kk += 4) {
      const int k = kc * 128 + kg * 32 + kk;
      const float w0 = p.w_mod[(size_t)(k + 0) * 6144 + j0 + cgi];
      const float w1 = p.w_mod[(size_t)(k + 1) * 6144 + j0 + cgi];
      const float w2 = p.w_mod[(size_t)(k + 2) * 6144 + j0 + cgi];
      const float w3 = p.w_mod[(size_t)(k + 3) * 6144 + j0 + cgi];
#pragma unroll
      for (int r = 0; r < 33; ++r) {
        const float4 s = *(const float4*)(Ssm + r * 128 + kg * 32 + kk);
        acc[r] += s.x * w0 + s.y * w1 + s.z * w2 + s.w * w3;
      }
    }
  }
  __syncthreads();
#pragma unroll
  for (int r = 0; r < 33; ++r) red[(kg * 33 + r) * 64 + cgi] = acc[r];
  __syncthreads();
  for (int idx = t; idx < 33 * 64; idx += 256) {
    const int r = idx >> 6, cc = idx & 63;
    float s = red[(0 * 33 + r) * 64 + cc] + red[(1 * 33 + r) * 64 + cc] + red[(2 * 33 + r) * 64 + cc] + red[(3 * 33 + r) * 64 + cc];
    p.mod[r * 6144 + j0 + cc] = s + p.b_mod[j0 + cc];
  }
}

DI void phase0(const Params& p, char* smem) {
  const int t = threadIdx.x;
  const int nMod = 96;
  const int nPos = 256;
  const int nMisc = 3;
  const int nT = p.n_ttiles;
  const int total = nMod + nT + nPos + nMisc;
  float* ctab = (float*)(smem + 65536 - 8192 - 1024);
  for (int j = t; j < 2048; j += 256) ctab[j] = cospif((float)j * (1.f / 1024.f));
  __syncthreads();
  for (int it = blockIdx.x; it < total; it += gridDim.x) {
    if (it < nMod) { mod_item(p, it, smem); continue; }
    int u = it - nMod;
    if (u < nT) {
      int jb = 0;
#pragma unroll 1
      for (int q = 1; q < NJOBS; ++q) if (u >= p.jobs[q].tile_start) jb = q;
      transpose_tile(p.jobs[jb], u - p.jobs[jb].tile_start, smem);
      continue;
    }
    u -= nT;
    if (u < nPos) {
      for (int e = t; e < 8 * 512; e += 256) {
        const int k = u * 8 + (e >> 9), c8 = (e & 511) * 8;
        float v[8];
#pragma unroll
        for (int q = 0; q < 8; ++q) {
          const int tt = c8 + q;
          if (tt < 2048) v[q] = ctab[(k * tt) & 2047];
          else v[q] = -ctab[(k * (tt - 2048) - 512) & 2047];
        }
        uint4 o; o.x = pk_bf16(v[0], v[1]); o.y = pk_bf16(v[2], v[3]); o.z = pk_bf16(v[4], v[5]); o.w = pk_bf16(v[6], v[7]);
        *(uint4*)(p.posM + (size_t)k * 4096 + c8) = o;
      }
      continue;
    }
    u -= nPos;
    if (u == 0) {
      for (int e = t; e < 256 * 128; e += 256) {
        const int m2 = e >> 7, cc = e & 127, mm = m2 & 127;
        float v = (m2 < 128) ? ctab[(mm * cc * 16) & 2047] : ctab[(mm * cc * 16 - 512) & 2047];
        p.chanT[e] = f2bf(v);
      }
    } else if (u == 1) {
      for (int e = t; e < 64 * 8; e += 256) {
        const int pos = e >> 3, jf = e & 7;
        const float inv = 1.0f / powf(10000.0f, (float)jf / 8.0f);
        const float ang = (float)pos * inv;
        p.ropeTab[e * 2 + 0] = cosf(ang);
        p.ropeTab[e * 2 + 1] = sinf(ang);
      }
    } else {
      uint4 z; z.x = z.y = z.z = z.w = 0u;
      uint4* dp = (uint4*)(p.WinT + (size_t)N_IN * DM);
      for (int e = t; e < (NINP - N_IN) * DM / 8; e += 256) dp[e] = z;
    }
  }
}

DI void phase1(const Params& p) {
  const int lane = threadIdx.x & 63, w = threadIdx.x >> 6;
  const int gw = blockIdx.x * 4 + w, nw = gridDim.x * 4;
  for (int R = gw; R < NT + NC; R += nw) {
    const float* src; const float* md;
    if (R < NT) { src = p.x + (size_t)R * DM; md = p.mod + (R >> 11) * 6144; }
    else { src = p.ctx + (size_t)(R - NT) * DM; md = p.mod + 32 * 6144; }
    float4 v[4]; float ss = 0.f;
#pragma unroll
    for (int i = 0; i < 4; ++i) { v[i] = *(const float4*)(src + lane * 4 + 256 * i); ss += v[i].x * v[i].x + v[i].y * v[i].y + v[i].z * v[i].z + v[i].w * v[i].w; }
    ss = wave_sum(ss);
    const float rr = rsqrtf(ss * (1.f / DM) + EPS);
#pragma unroll
    for (int i = 0; i < 4; ++i) {
      const int d = lane * 4 + 256 * i;
      const float4 g = *(const float4*)(p.norm1_g + d);
      const float4 sh = *(const float4*)(md + d);
      const float4 sc = *(const float4*)(md + 1024 + d);
      const float o0 = v[i].x * rr * g.x * (1.f + sc.x) + sh.x;
      const float o1 = v[i].y * rr * g.y * (1.f + sc.y) + sh.y;
      const float o2 = v[i].z * rr * g.z * (1.f + sc.z) + sh.z;
      const float o3 = v[i].w * rr * g.w * (1.f + sc.w) + sh.w;
      uint2 o; o.x = pk_bf16(o0, o1); o.y = pk_bf16(o2, o3);
      *(uint2*)(p.h + (size_t)R * DM + d) = o;
    }
  }
}

DI void phase2(const Params& p, char* smem) {
  const int t = threadIdx.x, lane = t & 63, w = t >> 6, r = lane & 31, hh = lane >> 5;
  const int wm = w & 1, wn = w >> 1;
  const int nLat = 512 * 26, nCtx = 64 * 3;
  for (int it = blockIdx.x; it < nLat + nCtx; it += gridDim.x) {
    int tokTile, ft; bool lat = it < nLat;
    if (lat) { tokTile = it / 26; ft = it % 26; }
    else { const int u = it - nLat; tokTile = 512 + u / 3; const int q = u % 3; ft = (q == 2) ? 25 : 3 + q; }
    f32x16 acc[2][2];
#pragma unroll
    for (int a = 0; a < 2; ++a)
#pragma unroll
      for (int b = 0; b < 2; ++b) acc[a][b] = zero16();
    const bf16_t* Ab = p.WinT + (size_t)ft * 128 * DM;
    const bf16_t* Bb = p.h + (size_t)tokTile * 128 * DM;
    float dummy = 0.f;
    gemm_core<2, 2, 2, 2, false>(acc, [&](int row) { return Ab + (size_t)row * DM; }, [&](int row) { return Bb + (size_t)row * DM; }, DM, smem, dummy);
#pragma unroll
    for (int tm = 0; tm < 2; ++tm)
#pragma unroll
      for (int tn = 0; tn < 2; ++tn) {
        const int tok = tokTile * 128 + wn * 64 + tn * 32 + r;
#pragma unroll
        for (int q = 0; q < 4; ++q) {
          const int F0 = ft * 128 + wm * 64 + tm * 32 + 8 * q + 4 * hh;
          float v0 = acc[tm][tn][4 * q + 0], v1 = acc[tm][tn][4 * q + 1], v2 = acc[tm][tn][4 * q + 2], v3 = acc[tm][tn][4 * q + 3];
          bf16_t* dst = nullptr;
          if (lat) {
            if (ft < 5) dst = p.pqkv + (size_t)tok * LDQKV + F0;
            else if (ft < 9) dst = p.pf + (size_t)tok * 512 + (F0 - 640);
            else if (ft < 25) { v0 = sigmoidf_(v0); v1 = sigmoidf_(v1); v2 = sigmoidf_(v2); v3 = sigmoidf_(v3); dst = p.pg + (size_t)tok * 2048 + (F0 - 1152); }
            else if (F0 - 3200 < 32) dst = p.pqkv + (size_t)tok * LDQKV + 640 + (F0 - 3200);
          } else {
            const int ct = tok - NT;
            if (ft < 5) dst = p.pckv + (size_t)ct * LDCKV + (F0 - 384);
            else if (F0 - 3200 < 32) dst = p.pckv + (size_t)ct * LDCKV + 256 + (F0 - 3200);
          }
          if (dst) { uint2 o; o.x = pk_bf16(v0, v1); o.y = pk_bf16(v2, v3); *(uint2*)dst = o; }
        }
      }
  }
}

DI void rope_pair(float& x1, float& x2, const float* tab) { const float c = tab[0], s = tab[1]; const float a = x1 * c - x2 * s, b = x2 * c + x1 * s; x1 = a; x2 = b; }

DI void phase3(const Params& p, char* smem) {
  const int t = threadIdx.x, lane = t & 63, w = t >> 6, r = lane & 31, hh = lane >> 5;
  const int nKV = (512 + 64) * 8, nQ = 512 * 8, nCh = 32 * 4 * 16 * 2;
  for (int it = blockIdx.x; it < nKV + nQ + nCh; it += gridDim.x) {
    if (it < nKV) {
      const int tokTile = it >> 3, hd = it & 7;
      const bool lat = tokTile < 512;
      const bf16_t* Bb; int ldb; const bf16_t* kpeb;
      int b, key0;
      if (lat) { Bb = p.pqkv + (size_t)tokTile * 128 * LDQKV + QL; ldb = LDQKV; kpeb = p.pqkv + (size_t)tokTile * 128 * LDQKV + 640; b = tokTile >> 4; key0 = (tokTile & 15) * 128; }
      else { const int ct = tokTile - 512; Bb = p.pckv + (size_t)ct * 128 * LDCKV; ldb = LDCKV; kpeb = Bb + 256; b = ct >> 1; key0 = SEQ + (ct & 1) * 128; }
      const bf16_t* Ab = p.WkvT + (size_t)hd * 128 * KVL;
      f32x16 acc[4][1];
#pragma unroll
      for (int a = 0; a < 4; ++a) acc[a][0] = zero16();
      float sumsq = 0.f;
      gemm_core<4, 1, 1, 4, true>(acc, [&](int row) { return Ab + (size_t)row * KVL; }, [&](int row) { return Bb + (size_t)row * ldb; }, KVL, smem, sumsq);
      sumsq += __shfl_xor(sumsq, 32);
      const float ra = rsqrtf(sumsq * (1.f / KVL) + EPS);
      const int tl = w * 32 + r;
      const int key = key0 + tl;
      float kp[16];
#pragma unroll
      for (int q = 0; q < 4; ++q) {
        const uint2 u = *(const uint2*)(kpeb + (size_t)tl * ldb + 8 * q + 4 * hh);
        kp[4 * q + 0] = bf_lo(u.x); kp[4 * q + 1] = bf_hi(u.x); kp[4 * q + 2] = bf_lo(u.y); kp[4 * q + 3] = bf_hi(u.y);
      }
      float ss = 0.f;
#pragma unroll
      for (int tm = 0; tm < 4; ++tm)
#pragma unroll
        for (int i = 0; i < 16; ++i) { const float v = acc[tm][0][i] * ra; acc[tm][0][i] = v; if (tm < 2) ss += v * v; }
#pragma unroll
      for (int i = 0; i < 16; ++i) ss += kp[i] * kp[i];
      ss += __shfl_xor(ss, 32);
      const float rk = rsqrtf(ss * (1.f / QKD) + EPS);
#pragma unroll
      for (int i = 0; i < 16; ++i) kp[i] *= rk * p.k_norm_g[64 + crow(i, hh)];
      if (lat) {
        const int pos = key;
        const float* tr = p.ropeTab + ((pos >> 6) * 8 + 4 * hh) * 2;
        const float* tc = p.ropeTab + ((pos & 63) * 8 + 4 * hh) * 2;
#pragma unroll
        for (int i = 0; i < 4; ++i) { rope_pair(kp[i], kp[i + 4], tr + 2 * i); rope_pair(kp[8 + i], kp[12 + i], tc + 2 * i); }
      }
      bf16_t* Kd = p.K + ((size_t)(b * NH + hd) * NKEY + key) * QKD;
#pragma unroll
      for (int tm = 0; tm < 2; ++tm)
#pragma unroll
        for (int q = 0; q < 4; ++q) {
          const int f = tm * 32 + 8 * q + 4 * hh;
          const float4 g = *(const float4*)(p.k_norm_g + f);
          uint2 o; o.x = pk_bf16(acc[tm][0][4 * q] * rk * g.x, acc[tm][0][4 * q + 1] * rk * g.y); o.y = pk_bf16(acc[tm][0][4 * q + 2] * rk * g.z, acc[tm][0][4 * q + 3] * rk * g.w);
          *(uint2*)(Kd + f) = o;
        }
#pragma unroll
      for (int q = 0; q < 4; ++q) {
        uint2 o; o.x = pk_bf16(kp[4 * q], kp[4 * q + 1]); o.y = pk_bf16(kp[4 * q + 2], kp[4 * q + 3]);
        *(uint2*)(Kd + 64 + 8 * q + 4 * hh) = o;
      }
      bf16_t* Vd = p.Vt + (size_t)(b * NH + hd) * VD * NKEY + key;
#pragma unroll
      for (int tm = 2; tm < 4; ++tm)
#pragma unroll
        for (int i = 0; i < 16; ++i) Vd[(size_t)((tm - 2) * 32 + crow(i, hh)) * NKEY] = f2bf(acc[tm][0][i]);
    } else if (it < nKV + nQ) {
      const int u = it - nKV;
      const int tokTile = u >> 3, hd = u & 7;
      const bf16_t* Bb = p.pqkv + (size_t)tokTile * 128 * LDQKV;
      const bf16_t* Ab = p.WqT + (size_t)hd * QKD * QL;
      f32x16 acc[3][1];
#pragma unroll
      for (int a = 0; a < 3; ++a) acc[a][0] = zero16();
      float sumsq = 0.f;
      gemm_core<3, 1, 1, 4, true>(acc, [&](int row) { return Ab + (size_t)row * QL; }, [&](int row) { return Bb + (size_t)row * LDQKV; }, QL, smem, sumsq);
      sumsq += __shfl_xor(sumsq, 32);
      const float ra = rsqrtf(sumsq * (1.f / QL) + EPS);
      const int tl = w * 32 + r;
      const int b = tokTile >> 4, pos = (tokTile & 15) * 128 + tl;
      float ss = 0.f;
#pragma unroll
      for (int tm = 0; tm < 3; ++tm)
#pragma unroll
        for (int i = 0; i < 16; ++i) { const float v = acc[tm][0][i] * ra; acc[tm][0][i] = v; ss += v * v; }
      ss += __shfl_xor(ss, 32);
      const float rh = rsqrtf(ss * (1.f / QKD) + EPS);
#pragma unroll
      for (int tm = 0; tm < 3; ++tm)
#pragma unroll
        for (int q = 0; q < 4; ++q) {
          const float4 g = *(const float4*)(p.q_norm_g + tm * 32 + 8 * q + 4 * hh);
          acc[tm][0][4 * q] *= rh * g.x; acc[tm][0][4 * q + 1] *= rh * g.y; acc[tm][0][4 * q + 2] *= rh * g.z; acc[tm][0][4 * q + 3] *= rh * g.w;
        }
      {
        const float* tr = p.ropeTab + ((pos >> 6) * 8 + 4 * hh) * 2;
        const float* tc = p.ropeTab + ((pos & 63) * 8 + 4 * hh) * 2;
#pragma unroll
        for (int i = 0; i < 4; ++i) {
          float a0 = acc[2][0][i], a1 = acc[2][0][i + 4], c0 = acc[2][0][8 + i], c1 = acc[2][0][12 + i];
          rope_pair(a0, a1, tr + 2 * i); rope_pair(c0, c1, tc + 2 * i);
          acc[2][0][i] = a0; acc[2][0][i + 4] = a1; acc[2][0][8 + i] = c0; acc[2][0][12 + i] = c1;
        }
      }
      const float qs = 0.10206207261596575f * 1.4426950408889634f;
      bf16_t* Qd = p.Q + ((size_t)(b * NH + hd) * SEQ + pos) * QKD;
#pragma unroll
      for (int tm = 0; tm < 3; ++tm)
#pragma unroll
        for (int q = 0; q < 4; ++q) {
          uint2 o; o.x = pk_bf16(acc[tm][0][4 * q] * qs, acc[tm][0][4 * q + 1] * qs); o.y = pk_bf16(acc[tm][0][4 * q + 2] * qs, acc[tm][0][4 * q + 3] * qs);
          *(uint2*)(Qd + tm * 32 + 8 * q + 4 * hh) = o;
        }
    } else {
      const int u = it - nKV - nQ;
      const int ft = u & 1, tt = (u >> 1) & 15, g = (u >> 5) & 3, b = u >> 7;
      const int wm = w & 1, wn = w >> 1;
      const bf16_t* Ab = p.chanT + (size_t)ft * 128 * 128;
      const bf16_t* Bb = p.pf + (size_t)(b * SEQ + tt * 128) * 512 + g * 128;
      f32x16 acc[2][2];
#pragma unroll
      for (int a = 0; a < 2; ++a)
#pragma unroll
        for (int c = 0; c < 2; ++c) acc[a][c] = zero16();
      float dummy = 0.f;
      gemm_core<2, 2, 2, 2, false>(acc, [&](int row) { return Ab + (size_t)row * 128; }, [&](int row) { return Bb + (size_t)row * 512; }, 128, smem, dummy);
#pragma unroll
      for (int tm = 0; tm < 2; ++tm)
#pragma unroll
        for (int tn = 0; tn < 2; ++tn) {
          const int tpos = tt * 128 + wn * 64 + tn * 32 + r;
#pragma unroll
          for (int i = 0; i < 16; ++i) {
            const int mm = wm * 64 + tm * 32 + crow(i, hh);
            p.ABt[((size_t)(b * 512 + g * 128 + mm)) * 4096 + ft * 2048 + tpos] = f2bf(acc[tm][tn][i]);
          }
        }
    }
  }
}

DI void attn_item(const Params& p, int it, char* smem) {
  const int t = threadIdx.x, lane = t & 63, w = t >> 6, r = lane & 31, hh = lane >> 5;
  const int qt = it & 15, bh = it >> 4;
  constexpr int KROW = 208, VROW = 136, KBYTES = 64 * KROW, STAGE = KBYTES + 64 * VROW;
  const bf16_t* Kb = p.K + (size_t)bh * NKEY * QKD;
  const bf16_t* Vb = p.Vt + (size_t)bh * VD * NKEY;
  const int qpos = qt * 128 + w * 32 + r;
  const bf16_t* Qp = p.Q + ((size_t)bh * SEQ + qpos) * QKD + hh * 8;
  bf16x8 qf[6];
#pragma unroll
  for (int c = 0; c < 6; ++c) qf[c] = *(const bf16x8*)(Qp + c * 16);
  f32x16 o[2]; o[0] = zero16(); o[1] = zero16();
  float mrun = -INFINITY, lrun = 0.f;
  const int kid0 = t, kid1 = t + 256, kid2 = t + 512;
  const int kgo0 = (kid0 / 12) * QKD + (kid0 % 12) * 8, kgo1 = (kid1 / 12) * QKD + (kid1 % 12) * 8, kgo2 = (kid2 / 12) * QKD + (kid2 % 12) * 8;
  const int klo0 = (kid0 / 12) * KROW + (kid0 % 12) * 16, klo1 = (kid1 / 12) * KROW + (kid1 % 12) * 16, klo2 = (kid2 / 12) * KROW + (kid2 % 12) * 16;
  const int vid0 = t, vid1 = t + 256;
  const int vgo0 = (vid0 >> 3) * NKEY + (vid0 & 7) * 8, vgo1 = (vid1 >> 3) * NKEY + (vid1 & 7) * 8;
  const int vlo0 = KBYTES + (vid0 >> 3) * VROW + (vid0 & 7) * 16, vlo1 = KBYTES + (vid1 >> 3) * VROW + (vid1 & 7) * 16;
  uint4 rk0, rk1, rk2, rv0, rv1;
  rk0 = *(const uint4*)(Kb + kgo0); rk1 = *(const uint4*)(Kb + kgo1); rk2 = *(const uint4*)(Kb + kgo2);
  rv0 = *(const uint4*)(Vb + vgo0); rv1 = *(const uint4*)(Vb + vgo1);
#define ATT_STORE(base) do { \
    *(uint4*)((base) + klo0) = rk0; *(uint4*)((base) + klo1) = rk1; *(uint4*)((base) + klo2) = rk2; \
    { uint2* d = (uint2*)((base) + vlo0); d[0] = make_uint2(rv0.x, rv0.y); d[1] = make_uint2(rv0.z, rv0.w); } \
    { uint2* d = (uint2*)((base) + vlo1); d[0] = make_uint2(rv1.x, rv1.y); d[1] = make_uint2(rv1.z, rv1.w); } } while (0)
  ATT_STORE(smem);
  __syncthreads();
  constexpr int NKT = NKEY / 64;
  for (int kt = 0; kt < NKT; ++kt) {
    const char* cur = smem + (kt & 1) * STAGE;
    const bool more = kt + 1 < NKT;
    if (more) {
      const bf16_t* kn = Kb + (size_t)(kt + 1) * 64 * QKD; const bf16_t* vn = Vb + (kt + 1) * 64;
      rk0 = *(const uint4*)(kn + kgo0); rk1 = *(const uint4*)(kn + kgo1); rk2 = *(const uint4*)(kn + kgo2);
      rv0 = *(const uint4*)(vn + vgo0); rv1 = *(const uint4*)(vn + vgo1);
    }
    f32x16 s[2];
#pragma unroll
    for (int t2 = 0; t2 < 2; ++t2) {
      s[t2] = zero16();
      const char* kp = cur + (t2 * 32 + r) * KROW + hh * 16;
#pragma unroll
      for (int c = 0; c < 6; ++c) { const bf16x8 kf = *(const bf16x8*)(kp + c * 32); s[t2] = MFMA(kf, qf[c], s[t2]); }
    }
    __builtin_amdgcn_sched_barrier(0);
    float mx = s[0][0];
#pragma unroll
    for (int i = 0; i < 16; ++i) { mx = fmaxf(mx, s[0][i]); mx = fmaxf(mx, s[1][i]); }
    mx = fmaxf(mx, __shfl_xor(mx, 32));
    const float mnew = fmaxf(mrun, mx);
    const float alpha = __builtin_amdgcn_exp2f(mrun - mnew);
    mrun = mnew;
    float ls = 0.f;
#pragma unroll
    for (int t2 = 0; t2 < 2; ++t2)
#pragma unroll
      for (int i = 0; i < 16; ++i) { const float e = __builtin_amdgcn_exp2f(s[t2][i] - mnew); s[t2][i] = e; ls += e; }
    lrun = lrun * alpha + ls;
#pragma unroll
    for (int i = 0; i < 16; ++i) { o[0][i] *= alpha; o[1][i] *= alpha; }
    __builtin_amdgcn_sched_barrier(0);
#pragma unroll
    for (int t2 = 0; t2 < 2; ++t2)
#pragma unroll
      for (int s2 = 0; s2 < 2; ++s2) {
        uint4 pu;
        pu.x = pk_bf16(s[t2][8 * s2 + 0], s[t2][8 * s2 + 1]); pu.y = pk_bf16(s[t2][8 * s2 + 2], s[t2][8 * s2 + 3]);
        pu.z = pk_bf16(s[t2][8 * s2 + 4], s[t2][8 * s2 + 5]); pu.w = pk_bf16(s[t2][8 * s2 + 6], s[t2][8 * s2 + 7]);
        const bf16x8 pb = __builtin_bit_cast(bf16x8, pu);
#pragma unroll
        for (int vt = 0; vt < 2; ++vt) {
          const char* vp = cur + KBYTES + (vt * 32 + r) * VROW + (t2 * 32 + 16 * s2 + 4 * hh) * 2;
          const uint2 lo = *(const uint2*)(vp), hi = *(const uint2*)(vp + 16);
          uint4 vu; vu.x = lo.x; vu.y = lo.y; vu.z = hi.x; vu.w = hi.y;
          o[vt] = MFMA(__builtin_bit_cast(bf16x8, vu), pb, o[vt]);
        }
      }
    if (more) { char* nxt = smem + ((kt + 1) & 1) * STAGE; ATT_STORE(nxt); }
    __syncthreads();
  }
  lrun += __shfl_xor(lrun, 32);
  const float inv = 1.f / lrun;
  const int b = bh >> 3, hd = bh & 7;
  bf16_t* od = p.attn_o + (size_t)(b * SEQ + qpos) * 512 + hd * 64;
#pragma unroll
  for (int vt = 0; vt < 2; ++vt)
#pragma unroll
    for (int q = 0; q < 4; ++q) {
      uint2 ou; ou.x = pk_bf16(o[vt][4 * q] * inv, o[vt][4 * q + 1] * inv); ou.y = pk_bf16(o[vt][4 * q + 2] * inv, o[vt][4 * q + 3] * inv);
      *(uint2*)(od + vt * 32 + 8 * q + 4 * hh) = ou;
    }
}

DI void phase4(const Params& p, char* smem) {
  const int t = threadIdx.x, lane = t & 63, w = t >> 6, r = lane & 31, hh = lane >> 5;
  const int nDft = 32 * 4 * 16, nAtt = 32 * 8 * 16;
  for (int it = blockIdx.x; it < nDft + nAtt; it += gridDim.x) {
    if (it < nDft) {
      const int kt = it & 15, ct = (it >> 4) & 3, b = it >> 6;
      const int wm = w & 1, wn = w >> 1;
      const bf16_t* Ab = p.ABt + (size_t)(b * 512 + ct * 128) * 4096;
      const bf16_t* Bb = p.posM + (size_t)kt * 128 * 4096;
      f32x16 acc[2][2];
#pragma unroll
      for (int a = 0; a < 2; ++a)
#pragma unroll
        for (int c = 0; c < 2; ++c) acc[a][c] = zero16();
      float dummy = 0.f;
      gemm_core<2, 2, 2, 2, false>(acc, [&](int row) { return Ab + (size_t)row * 4096; }, [&](int row) { return Bb + (size_t)row * 4096; }, 4096, smem, dummy);
      const float sc = 1.f / 512.f;
#pragma unroll
      for (int tm = 0; tm < 2; ++tm)
#pragma unroll
        for (int tn = 0; tn < 2; ++tn) {
          const int kpos = kt * 128 + wn * 64 + tn * 32 + r;
          bf16_t* d = p.four_o + (size_t)(b * SEQ + kpos) * 512 + ct * 128 + wm * 64 + tm * 32 + 4 * hh;
#pragma unroll
          for (int q = 0; q < 4; ++q) {
            uint2 ou; ou.x = pk_bf16(acc[tm][tn][4 * q] * sc, acc[tm][tn][4 * q + 1] * sc); ou.y = pk_bf16(acc[tm][tn][4 * q + 2] * sc, acc[tm][tn][4 * q + 3] * sc);
            *(uint2*)(d + 8 * q) = ou;
          }
        }
    } else {
      attn_item(p, it - nDft, smem);
    }
  }
}

DI void phase5(const Params& p, char* smem) {
  const int t = threadIdx.x, lane = t & 63, w = t >> 6, r = lane & 31, hh = lane >> 5;
  const int wm = w & 1, wn = w >> 1;
  for (int it = blockIdx.x; it < 512 * 8; it += gridDim.x) {
    const int tokTile = it >> 3, nt = it & 7;
    f32x16 acc1[2][2], acc2[2][2];
#pragma unroll
    for (int a = 0; a < 2; ++a)
#pragma unroll
      for (int c = 0; c < 2; ++c) { acc1[a][c] = zero16(); acc2[a][c] = zero16(); }
    float dummy = 0.f;
    {
      const bf16_t* Ab = p.WoT + (size_t)nt * 128 * 512; const bf16_t* Bb = p.attn_o + (size_t)tokTile * 128 * 512;
      gemm_core<2, 2, 2, 2, false>(acc1, [&](int row) { return Ab + (size_t)row * 512; }, [&](int row) { return Bb + (size_t)row * 512; }, 512, smem, dummy);
    }
    {
      const bf16_t* Ab = p.WfT + (size_t)nt * 128 * 512; const bf16_t* Bb = p.four_o + (size_t)tokTile * 128 * 512;
      gemm_core<2, 2, 2, 2, false>(acc2, [&](int row) { return Ab + (size_t)row * 512; }, [&](int row) { return Bb + (size_t)row * 512; }, 512, smem, dummy);
    }
#pragma unroll
    for (int tm = 0; tm < 2; ++tm)
#pragma unroll
      for (int tn = 0; tn < 2; ++tn) {
        const int tok = tokTile * 128 + wn * 64 + tn * 32 + r;
#pragma unroll
        for (int q = 0; q < 4; ++q) {
          const int n = nt * 128 + wm * 64 + tm * 32 + 8 * q + 4 * hh;
          const uint2 ga = *(const uint2*)(p.pg + (size_t)tok * 2048 + n);
          const uint2 gb = *(const uint2*)(p.pg + (size_t)tok * 2048 + 1024 + n);
          const float v0 = bf_lo(ga.x) * acc1[tm][tn][4 * q] + bf_lo(gb.x) * acc2[tm][tn][4 * q];
          const float v1 = bf_hi(ga.x) * acc1[tm][tn][4 * q + 1] + bf_hi(gb.x) * acc2[tm][tn][4 * q + 1];
          const float v2 = bf_lo(ga.y) * acc1[tm][tn][4 * q + 2] + bf_lo(gb.y) * acc2[tm][tn][4 * q + 2];
          const float v3 = bf_hi(ga.y) * acc1[tm][tn][4 * q + 3] + bf_hi(gb.y) * acc2[tm][tn][4 * q + 3];
          uint2 ou; ou.x = pk_bf16(v0, v1); ou.y = pk_bf16(v2, v3);
          *(uint2*)(p.m + (size_t)tok * DM + n) = ou;
        }
      }
  }
}

DI void phase6(const Params& p, char* smem) {
  const int t = threadIdx.x, lane = t & 63, w = t >> 6, r = lane & 31, hh = lane >> 5;
  const int wm = w & 1, wn = w >> 1;
  for (int it = blockIdx.x; it < 512 * 8; it += gridDim.x) {
    const int tokTile = it >> 3, nt = it & 7;
    f32x16 acc[2][2];
#pragma unroll
    for (int a = 0; a < 2; ++a)
#pragma unroll
      for (int c = 0; c < 2; ++c) acc[a][c] = zero16();
    float dummy = 0.f;
    const bf16_t* Ab = p.WoutT + (size_t)nt * 128 * DM; const bf16_t* Bb = p.m + (size_t)tokTile * 128 * DM;
    gemm_core<2, 2, 2, 2, false>(acc, [&](int row) { return Ab + (size_t)row * DM; }, [&](int row) { return Bb + (size_t)row * DM; }, DM, smem, dummy);
    const float* g1 = p.mod + (tokTile >> 4) * 6144 + 2048;
#pragma unroll
    for (int tm = 0; tm < 2; ++tm)
#pragma unroll
      for (int tn = 0; tn < 2; ++tn) {
        const int tok = tokTile * 128 + wn * 64 + tn * 32 + r;
#pragma unroll
        for (int q = 0; q < 4; ++q) {
          const int n = nt * 128 + wm * 64 + tm * 32 + 8 * q + 4 * hh;
          const float4 xv = *(const float4*)(p.x + (size_t)tok * DM + n);
          const float4 g = *(const float4*)(g1 + n);
          float4 ov;
          ov.x = xv.x + g.x * acc[tm][tn][4 * q]; ov.y = xv.y + g.y * acc[tm][tn][4 * q + 1];
          ov.z = xv.z + g.z * acc[tm][tn][4 * q + 2]; ov.w = xv.w + g.w * acc[tm][tn][4 * q + 3];
          *(float4*)(p.out + (size_t)tok * DM + n) = ov;
        }
      }
  }
}

DI void phase7(const Params& p, char* smem) {
  const int t = threadIdx.x, lane = t & 63, w = t >> 6;
  float* wr = (float*)smem;
  for (int idx = t; idx < DM * NE; idx += 256) { const int d = idx >> 4, e = idx & 15; wr[e * DM + d] = p.w_router[idx]; }
  __syncthreads();
  const int gw = blockIdx.x * 4 + w, nw = gridDim.x * 4;
  for (int R = gw; R < NT; R += nw) {
    asm volatile("" ::: "memory");
    const float* src = p.out + (size_t)R * DM;
    const int b = R >> 11;
    const float* md = p.mod + b * 6144;
    float4 v[4]; float ss = 0.f;
#pragma unroll
    for (int i = 0; i < 4; ++i) { v[i] = *(const float4*)(src + lane * 4 + 256 * i); ss += v[i].x * v[i].x + v[i].y * v[i].y + v[i].z * v[i].z + v[i].w * v[i].w; }
    ss = wave_sum(ss);
    const float rr = rsqrtf(ss * (1.f / DM) + EPS);
#pragma unroll
    for (int i = 0; i < 4; ++i) {
      const int d = lane * 4 + 256 * i;
      const float4 g = *(const float4*)(p.norm2_g + d);
      const float4 sh = *(const float4*)(md + 3072 + d);
      const float4 sc = *(const float4*)(md + 4096 + d);
      v[i].x = v[i].x * rr * g.x * (1.f + sc.x) + sh.x;
      v[i].y = v[i].y * rr * g.y * (1.f + sc.y) + sh.y;
      v[i].z = v[i].z * rr * g.z * (1.f + sc.z) + sh.z;
      v[i].w = v[i].w * rr * g.w * (1.f + sc.w) + sh.w;
      uint2 o; o.x = pk_bf16(v[i].x, v[i].y); o.y = pk_bf16(v[i].z, v[i].w);
      *(uint2*)(p.h2 + (size_t)R * DM + d) = o;
    }
    float a[16];
#pragma unroll
    for (int e = 0; e < 16; ++e) {
      float s = 0.f;
#pragma unroll
      for (int i = 0; i < 4; ++i) { const float4 wv = *(const float4*)(wr + e * DM + lane * 4 + 256 * i); s += v[i].x * wv.x + v[i].y * wv.y + v[i].z * wv.z + v[i].w * wv.w; }
      a[e] = s;
      if ((e & 3) == 3) __builtin_amdgcn_sched_barrier(0);
    }
    float a8[8], a4[4], a2[2], a1;
    {
      const bool up = lane & 32;
#pragma unroll
      for (int j = 0; j < 8; ++j) { const float send = up ? a[j] : a[j + 8]; const float keep = up ? a[j + 8] : a[j]; a8[j] = keep + __shfl_xor(send, 32); }
    }
    {
      const bool up = lane & 16;
#pragma unroll
      for (int j = 0; j < 4; ++j) { const float send = up ? a8[j] : a8[j + 4]; const float keep = up ? a8[j + 4] : a8[j]; a4[j] = keep + __shfl_xor(send, 16); }
    }
    {
      const bool up = lane & 8;
#pragma unroll
      for (int j = 0; j < 2; ++j) { const float send = up ? a4[j] : a4[j + 2]; const float keep = up ? a4[j + 2] : a4[j]; a2[j] = keep + __shfl_xor(send, 8); }
    }
    {
      const bool up = lane & 4;
      const float send = up ? a2[0] : a2[1]; const float keep = up ? a2[1] : a2[0]; a1 = keep + __shfl_xor(send, 4);
    }
    a1 += __shfl_xor(a1, 2);
    a1 += __shfl_xor(a1, 1);
    float mx = a1;
#pragma unroll
    for (int o = 4; o <= 32; o <<= 1) mx = fmaxf(mx, __shfl_xor(mx, o));
    const float ex = __expf(a1 - mx);
    float sm = ex;
#pragma unroll
    for (int o = 4; o <= 32; o <<= 1) sm += __shfl_xor(sm, o);
    if ((lane & 3) == 0) {
      const int e = (lane >> 2) & 15;
      p.aff[((size_t)(b * NE + e)) * SEQ + (R & 2047)] = ex / sm;
    }
  }
}

DI void phase8(const Params& p) {
  const int lane = threadIdx.x & 63, w = threadIdx.x >> 6;
  const int gw = blockIdx.x * 4 + w, nw = gridDim.x * 4;
  for (int pr = gw; pr < NB * NE; pr += nw) {
    const float* a = p.aff + (size_t)pr * SEQ;
    unsigned u[32];
#pragma unroll
    for (int q = 0; q < 32; ++q) u[q] = __float_as_uint(a[q * 64 + lane]);
    unsigned thr = 0;
    for (int bit = 30; bit >= 0; --bit) {
      const unsigned cand = thr | (1u << bit);
      int cnt = 0;
#pragma unroll
      for (int q = 0; q < 32; ++q) cnt += __popcll(__ballot(u[q] >= cand));
      if (cnt >= CAP) thr = cand;
    }
    int ngt = 0;
#pragma unroll
    for (int q = 0; q < 32; ++q) ngt += __popcll(__ballot(u[q] > thr));
    int cgt = 0, ceq = 0;
    int* io = p.idx + pr * CAP; float* go = p.gate + pr * CAP;
#pragma unroll
    for (int q = 0; q < 32; ++q) {
      const bool gt = u[q] > thr, eq = u[q] == thr;
      const unsigned long long mg = __ballot(gt), me = __ballot(eq);
      const unsigned long long below = (1ull << lane) - 1ull;
      if (gt) { const int s = cgt + __popcll(mg & below); io[s] = q * 64 + lane; go[s] = __uint_as_float(u[q]); }
      if (eq) { const int s = ngt + ceq + __popcll(me & below); if (s < CAP) { io[s] = q * 64 + lane; go[s] = __uint_as_float(u[q]); } }
      cgt += __popcll(mg); ceq += __popcll(me);
    }
  }
}

DI void phase9(const Params& p, char* smem) {
  const int t = threadIdx.x, lane = t & 63, w = t >> 6, r = lane & 31, hh = lane >> 5;
  const int wm = w & 1, wn = w >> 1;
  for (int it = blockIdx.x; it < NB * NE * 2 * 8; it += gridDim.x) {
    const int ft = it & 7, st = (it >> 3) & 1, be = it >> 4;
    const int b = be >> 4, e = be & 15;
    const bf16_t* Ab = p.WguT + ((size_t)e * 1024 + ft * 128) * DM;
    const int* ib = p.idx + be * CAP + st * 128;
    const bf16_t* hb = p.h2 + (size_t)b * SEQ * DM;
    f32x16 acc[2][2];
#pragma unroll
    for (int a = 0; a < 2; ++a)
#pragma unroll
      for (int c = 0; c < 2; ++c) acc[a][c] = zero16();
    float dummy = 0.f;
    gemm_core<2, 2, 2, 2, false>(acc, [&](int row) { return Ab + (size_t)row * DM; }, [&](int row) { return hb + (size_t)ib[row] * DM; }, DM, smem, dummy);
#pragma unroll
    for (int tn = 0; tn < 2; ++tn) {
      const int slot = st * 128 + wn * 64 + tn * 32 + r;
      bf16_t* d = p.hmid + ((size_t)be * CAP + slot) * DE + ft * 64 + wm * 32 + 4 * hh;
#pragma unroll
      for (int q = 0; q < 4; ++q) {
        float v[4];
#pragma unroll
        for (int j = 0; j < 4; ++j) { const float g = acc[0][tn][4 * q + j], uu = acc[1][tn][4 * q + j]; v[j] = g * sigmoidf_(g) * uu; }
        uint2 ou; ou.x = pk_bf16(v[0], v[1]); ou.y = pk_bf16(v[2], v[3]);
        *(uint2*)(d + 8 * q) = ou;
      }
    }
  }
}

DI void phase10(const Params& p, char* smem) {
  const int t = threadIdx.x, lane = t & 63, w = t >> 6, r = lane & 31, hh = lane >> 5;
  const int wm = w & 1, wn = w >> 1;
  for (int it = blockIdx.x; it < NB * NE * 2 * 8; it += gridDim.x) {
    const int nt = it & 7, st = (it >> 3) & 1, be = it >> 4;
    const int b = be >> 4, e = be & 15;
    const bf16_t* Ab = p.hmid + ((size_t)be * CAP + st * 128) * DE;
    const bf16_t* Bb = p.WdT + ((size_t)e * DM + nt * 128) * DE;
    f32x16 acc[2][2];
#pragma unroll
    for (int a = 0; a < 2; ++a)
#pragma unroll
      for (int c = 0; c < 2; ++c) acc[a][c] = zero16();
    float dummy = 0.f;
    gemm_core<2, 2, 2, 2, false>(acc, [&](int row) { return Ab + (size_t)row * DE; }, [&](int row) { return Bb + (size_t)row * DE; }, DE, smem, dummy);
    const float* g2 = p.mod + b * 6144 + 5120;
#pragma unroll
    for (int tn = 0; tn < 2; ++tn) {
      const int n = nt * 128 + wn * 64 + tn * 32 + r;
      const float gn = g2[n];
#pragma unroll
      for (int tm = 0; tm < 2; ++tm)
#pragma unroll
        for (int i = 0; i < 16; ++i) {
          const int slot = st * 128 + wm * 64 + tm * 32 + crow(i, hh);
          const int tok = p.idx[be * CAP + slot];
          const float gt = p.gate[be * CAP + slot];
          unsafeAtomicAdd(p.out + ((size_t)(b * SEQ + tok)) * DM + n, gn * gt * acc[tm][tn][i]);
        }
    }
  }
}

__global__ void __launch_bounds__(256, 2) mega_kernel(Params p) {
  cg::grid_group grid = cg::this_grid();
  __shared__ __attribute__((aligned(16))) char smem[SMEM_BYTES];
  phase0(p, smem);
  grid.sync();
  phase1(p);
  grid.sync();
  phase2(p, smem);
  grid.sync();
  phase3(p, smem);
  grid.sync();
  phase4(p, smem);
  grid.sync();
  phase5(p, smem);
  grid.sync();
  phase6(p, smem);
  grid.sync();
  phase7(p, smem);
  grid.sync();
  phase8(p);
  grid.sync();
  phase9(p, smem);
  grid.sync();
  phase10(p, smem);
}

static inline size_t align_up(size_t v, size_t a) { return (v + a - 1) / a * a; }

extern "C" void kernel_launch(void* const* d_in, const int* in_sizes, int n_in,
                              void* d_out, int out_size, void* d_ws, size_t ws_size,
                              hipStream_t stream) {
  static int grid_blocks = 0;
  if (!grid_blocks) {
    int dev = 0, cus = 0, per_cu = 0;
    (void)hipGetDevice(&dev);
    (void)hipDeviceGetAttribute(&cus, hipDeviceAttributeMultiprocessorCount, dev);
    (void)hipOccupancyMaxActiveBlocksPerMultiprocessor(&per_cu, mega_kernel, 256, 0);
    if (per_cu > 2) per_cu = 2;
    if (per_cu < 1) per_cu = 1;
    grid_blocks = cus * per_cu;
  }
  Params p;
  memset(&p, 0, sizeof(p));
  const float* x = (const float*)d_in[0];
  p.x = x; p.c = (const float*)d_in[1]; p.ctx = (const float*)d_in[2]; p.c_ctx = (const float*)d_in[3];
  p.w_mod = (const float*)d_in[4]; p.b_mod = (const float*)d_in[5]; p.norm1_g = (const float*)d_in[6];
  const float* w_in = (const float*)d_in[7];
  const float* q_a_g = (const float*)d_in[8];
  const float* kv_a_g = (const float*)d_in[9];
  const float* w_q_up = (const float*)d_in[10];
  const float* w_kv_up = (const float*)d_in[11];
  p.q_norm_g = (const float*)d_in[12]; p.k_norm_g = (const float*)d_in[13];
  const float* w_o_attn = (const float*)d_in[14];
  const float* w_fourier = (const float*)d_in[15];
  const float* w_out = (const float*)d_in[16];
  p.norm2_g = (const float*)d_in[17]; p.w_router = (const float*)d_in[18];
  const float* w_e_gate = (const float*)d_in[19];
  const float* w_e_up = (const float*)d_in[20];
  const float* w_e_down = (const float*)d_in[21];
  p.out = (float*)d_out;

  char* base = (char*)d_ws; size_t off = 0;
  auto alloc = [&](size_t bytes) { char* q = base + off; off = align_up(off + bytes, 256); return q; };
  p.WinT = (bf16_t*)alloc((size_t)NINP * DM * 2);
  p.WqT = (bf16_t*)alloc((size_t)768 * QL * 2);
  p.WkvT = (bf16_t*)alloc((size_t)1024 * KVL * 2);
  p.WoT = (bf16_t*)alloc((size_t)DM * 512 * 2);
  p.WfT = (bf16_t*)alloc((size_t)DM * 512 * 2);
  p.WoutT = (bf16_t*)alloc((size_t)DM * DM * 2);
  p.WguT = (bf16_t*)alloc((size_t)NE * 1024 * DM * 2);
  p.WdT = (bf16_t*)alloc((size_t)NE * DM * DE * 2);
  p.chanT = (bf16_t*)alloc((size_t)256 * 128 * 2);
  p.posM = (bf16_t*)alloc((size_t)2048 * 4096 * 2);
  p.ropeTab = (float*)alloc(64 * 8 * 2 * 4);
  p.mod = (float*)alloc(33 * 6144 * 4);
  p.aff = (float*)alloc((size_t)NB * NE * SEQ * 4);
  p.gate = (float*)alloc((size_t)NB * NE * CAP * 4);
  p.idx = (int*)alloc((size_t)NB * NE * CAP * 4);
  p.pckv = (bf16_t*)alloc((size_t)NC * LDCKV * 2);
  char* regA = alloc((size_t)(NT + NC) * DM * 2);
  p.h = (bf16_t*)regA; p.ABt = (bf16_t*)regA; p.h2 = (bf16_t*)regA;
  char* regB1 = alloc((size_t)NT * LDQKV * 2);
  p.pqkv = (bf16_t*)regB1; p.attn_o = (bf16_t*)regB1;
  char* regB2 = alloc((size_t)NT * 512 * 2);
  p.pf = (bf16_t*)regB2; p.four_o = (bf16_t*)regB2;
  p.pg = (bf16_t*)alloc((size_t)NT * 2048 * 2);
  const size_t szQ = (size_t)NB * NH * SEQ * QKD * 2, szK = (size_t)NB * NH * NKEY * QKD * 2, szV = (size_t)NB * NH * VD * NKEY * 2;
  char* regC = alloc(szQ + szK + szV + 1024);
  p.Q = (bf16_t*)regC; p.K = (bf16_t*)(regC + align_up(szQ, 256)); p.Vt = (bf16_t*)(regC + align_up(szQ, 256) + align_up(szK, 256));
  p.m = (bf16_t*)regC; p.hmid = (bf16_t*)(regC + (size_t)NT * DM * 2);
  if (off > ws_size) { fprintf(stderr, "workspace too small: need %zu have %zu\n", off, ws_size); return; }

  int ts = 0;
  auto job = [&](int i, const float* src, bf16_t* dst, const float* scale, int K, int ldS, int n_off, int n_cnt, int dst_row0, int mode, int batch, long sbs, long dbs) {
    TJob& j = p.jobs[i];
    j.src = src; j.dst = dst; j.scale = scale; j.K = K; j.ldS = ldS; j.n_off = n_off; j.n_cnt = n_cnt; j.dst_row0 = dst_row0; j.mode = mode; j.batch = batch;
    j.tiles_n = (n_cnt + 63) / 64; j.tile_start = ts; j.src_bstride = sbs; j.dst_bstride = dbs;
    ts += batch * (K / 64) * j.tiles_n;
  };
  job(0, w_e_gate, p.WguT, nullptr, DM, DE, 0, DE, 0, 1, NE, (long)DM * DE, (long)1024 * DM);
  job(1, w_e_up, p.WguT, nullptr, DM, DE, 0, DE, 0, 2, NE, (long)DM * DE, (long)1024 * DM);
  job(2, w_e_down, p.WdT, nullptr, DE, DM, 0, DM, 0, 0, NE, (long)DE * DM, (long)DM * DE);
  job(3, w_in, p.WinT, nullptr, DM, N_IN, 0, 640, 0, 0, 1, 0, 0);
  job(4, w_in, p.WinT, nullptr, DM, N_IN, 672, 2560, 640, 0, 1, 0, 0);
  job(5, w_in, p.WinT, nullptr, DM, N_IN, 640, 32, 3200, 0, 1, 0, 0);
  job(6, w_q_up, p.WqT, q_a_g, QL, 768, 0, 768, 0, 0, 1, 0, 0);
  job(7, w_kv_up, p.WkvT, kv_a_g, KVL, 1024, 0, 1024, 0, 0, 1, 0, 0);
  job(8, w_o_attn, p.WoT, nullptr, 512, DM, 0, DM, 0, 0, 1, 0, 0);
  job(9, w_fourier, p.WfT, nullptr, 512, DM, 0, DM, 0, 0, 1, 0, 0);
  job(10, w_out, p.WoutT, nullptr, DM, DM, 0, DM, 0, 0, 1, 0, 0);
  p.n_ttiles = ts;

  void* args[] = {&p};
  hipError_t e = hipLaunchCooperativeKernel((void*)mega_kernel, dim3(grid_blocks), dim3(256), args, 0, stream);
  if (e != hipSuccess) fprintf(stderr, "cooperative launch failed: %s (grid %d)\n", hipGetErrorString(e), grid_blocks);
}
```

```cpp
#include <hip/hip_runtime.h>
#include <hip/hip_cooperative_groups.h>
#include <cstdio>
#include <cstring>
#include <cstdint>
namespace cg = cooperative_groups;

#define DI __device__ __forceinline__
typedef unsigned short bf16_t;
typedef short bf16x8 __attribute__((ext_vector_type(8)));
typedef float f32x16 __attribute__((ext_vector_type(16)));
#define MFMA(a, b, c) __builtin_amdgcn_mfma_f32_32x32x16_bf16((a), (b), (c), 0, 0, 0)

constexpr int NB = 32, SEQ = 2048, DM = 1024, NT = NB * SEQ, CTXL = 256, NC = NB * CTXL;
constexpr int NH = 8, QKD = 96, VD = 64, QL = 384, KVL = 256, NKEY = SEQ + CTXL;
constexpr int N_IN = 3232, NINP = 3328;
constexpr int NE = 16, DE = 512, CAP = 256;
constexpr float EPS = 1e-6f;
constexpr int LDQKV = 672, LDCKV = 288;
constexpr int SMEM_BYTES = 73728;

struct TJob {
  const float* src; bf16_t* dst; const float* scale;
  int K, ldS, n_off, n_cnt, dst_row0, mode, batch, tiles_n, tile_start, pad0;
  long src_bstride, dst_bstride;
};
constexpr int NJOBS = 11;

struct Params {
  const float *x, *c, *ctx, *c_ctx, *w_mod, *b_mod, *norm1_g, *q_norm_g, *k_norm_g, *norm2_g, *w_router;
  float* out;
  bf16_t *WinT, *WqT, *WkvT, *WoT, *WfT, *WoutT, *WguT, *WdT, *chanT, *posM;
  float *ropeTab, *mod;
  bf16_t *h, *pqkv, *pckv, *pf, *pg, *Q, *K, *Vt, *attn_o, *ABt, *four_o, *m, *h2, *hmid;
  float *aff, *gate;
  int* idx;
  TJob jobs[NJOBS];
  int n_ttiles, pad1;
};

typedef float f32x2v __attribute__((ext_vector_type(2)));
typedef __bf16 bf16x2v __attribute__((ext_vector_type(2)));
DI unsigned pk_bf16(float lo, float hi) { f32x2v v = {lo, hi}; bf16x2v b = __builtin_convertvector(v, bf16x2v); return __builtin_bit_cast(unsigned, b); }
DI float bf_lo(unsigned u) { return __uint_as_float(u << 16); }
DI float bf_hi(unsigned u) { return __uint_as_float(u & 0xffff0000u); }
DI float bf2f(bf16_t b) { return __uint_as_float(((unsigned)b) << 16); }
DI bf16_t f2bf(float f) { return (bf16_t)(pk_bf16(f, 0.f) & 0xffffu); }
DI float sigmoidf_(float x) { return 1.f / (1.f + __expf(-x)); }
DI int crow(int i, int hh) { return (i & 3) + 8 * (i >> 2) + 4 * hh; }
DI float wave_sum(float v) {
#pragma unroll
  for (int o = 32; o >= 1; o >>= 1) v += __shfl_xor(v, o);
  return v;
}
DI f32x16 zero16() { f32x16 z;
#pragma unroll
  for (int i = 0; i < 16; ++i) z[i] = 0.f; return z; }

template <int TM, int TN, int WM, int WN, bool SUMSQ, class AF, class BF>
DI void gemm_core(f32x16 (&acc)[TM][TN], AF arow, BF brow, int K, char* smem, float& sumsq) {
  constexpr int RA = 32 * TM * WM, RB = 32 * TN * WN, NA = RA / 32, NBR = RB / 32;
  constexpr int LDR = 144;
  constexpr int STAGE = (RA + RB) * LDR;
  static_assert(2 * STAGE <= SMEM_BYTES, "smem");
  const int t = threadIdx.x, lane = t & 63, w = t >> 6, r = lane & 31, hh = lane >> 5;
  const int wm = w % WM, wn = w / WM;
  const int c = t & 7, row0 = t >> 3;
  static_assert(NBR == 4 && (NA == 3 || NA == 4), "loader shape");
  const bf16_t* pa0 = arow(row0) + c * 8; const bf16_t* pa1 = arow(row0 + 32) + c * 8; const bf16_t* pa2 = arow(row0 + 64) + c * 8;
  const bf16_t* pa3 = (NA > 3) ? arow(row0 + 96) + c * 8 : pa2;
  const bf16_t* pb0 = brow(row0) + c * 8; const bf16_t* pb1 = brow(row0 + 32) + c * 8; const bf16_t* pb2 = brow(row0 + 64) + c * 8; const bf16_t* pb3 = brow(row0 + 96) + c * 8;
  uint4 ra0, ra1, ra2, ra3, rb0, rb1, rb2, rb3;
#define G_LOAD(ko) do { ra0 = *(const uint4*)(pa0 + (ko)); ra1 = *(const uint4*)(pa1 + (ko)); ra2 = *(const uint4*)(pa2 + (ko)); if (NA > 3) ra3 = *(const uint4*)(pa3 + (ko)); \
    rb0 = *(const uint4*)(pb0 + (ko)); rb1 = *(const uint4*)(pb1 + (ko)); rb2 = *(const uint4*)(pb2 + (ko)); rb3 = *(const uint4*)(pb3 + (ko)); } while (0)
#define G_STORE(base) do { char* sa_ = (base) + row0 * LDR + c * 16; \
    *(uint4*)(sa_) = ra0; *(uint4*)(sa_ + 32 * LDR) = ra1; *(uint4*)(sa_ + 64 * LDR) = ra2; if (NA > 3) *(uint4*)(sa_ + 96 * LDR) = ra3; \
    char* sb_ = sa_ + RA * LDR; \
    *(uint4*)(sb_) = rb0; *(uint4*)(sb_ + 32 * LDR) = rb1; *(uint4*)(sb_ + 64 * LDR) = rb2; *(uint4*)(sb_ + 96 * LDR) = rb3; } while (0)
  G_LOAD(0);
  __builtin_amdgcn_sched_barrier(0);
  G_STORE(smem);
  __syncthreads();
  const int nk = K >> 6;
  const int aoff = (wm * TM * 32 + r) * LDR + hh * 16, boff = RA * LDR + (wn * TN * 32 + r) * LDR + hh * 16;
  auto compute = [&](const char* cur) {
    const char* As = cur + aoff;
    const char* Bs = cur + boff;
    bf16x8 a0[TM], b0[TN], a1[TM], b1[TN];
#define LOADF(A_, B_, ks) do { _Pragma("unroll") for (int tm = 0; tm < TM; ++tm) A_[tm] = *(const bf16x8*)(As + tm * 32 * LDR + (ks) * 32); \
      _Pragma("unroll") for (int tn = 0; tn < TN; ++tn) B_[tn] = *(const bf16x8*)(Bs + tn * 32 * LDR + (ks) * 32); } while (0)
#define MMF(A_, B_) do { if (SUMSQ) { uint4 u = __builtin_bit_cast(uint4, B_[0]); \
        float e0 = bf_lo(u.x), e1 = bf_hi(u.x), e2 = bf_lo(u.y), e3 = bf_hi(u.y), e4 = bf_lo(u.z), e5 = bf_hi(u.z), e6 = bf_lo(u.w), e7 = bf_hi(u.w); \
        sumsq += e0 * e0 + e1 * e1 + e2 * e2 + e3 * e3 + e4 * e4 + e5 * e5 + e6 * e6 + e7 * e7; } \
      _Pragma("unroll") for (int tm = 0; tm < TM; ++tm) _Pragma("unroll") for (int tn = 0; tn < TN; ++tn) acc[tm][tn] = MFMA(A_[tm], B_[tn], acc[tm][tn]); } while (0)
    LOADF(a0, b0, 0);
    LOADF(a1, b1, 1);
    MMF(a0, b0);
    LOADF(a0, b0, 2);
    MMF(a1, b1);
    LOADF(a1, b1, 3);
    MMF(a0, b0);
    MMF(a1, b1);
    constexpr int NF = TM + TN, NM = TM * TN;
    __builtin_amdgcn_sched_group_barrier(0x100, NF, 0);
    __builtin_amdgcn_sched_group_barrier(0x100, NF, 0);
    __builtin_amdgcn_sched_group_barrier(0x008, NM, 0);
    __builtin_amdgcn_sched_group_barrier(0x100, NF, 0);
    __builtin_amdgcn_sched_group_barrier(0x008, NM, 0);
    __builtin_amdgcn_sched_group_barrier(0x100, NF, 0);
    __builtin_amdgcn_sched_group_barrier(0x008, NM, 0);
    __builtin_amdgcn_sched_group_barrier(0x008, NM, 0);
  };
  for (int kt = 0; kt < nk - 1; ++kt) {
    G_LOAD((kt + 1) * 64);
    __builtin_amdgcn_sched_barrier(0);
    compute(smem + (kt & 1) * STAGE);
    __builtin_amdgcn_sched_barrier(0);
    G_STORE(smem + ((kt + 1) & 1) * STAGE);
    __syncthreads();
  }
  compute(smem + ((nk - 1) & 1) * STAGE);
  __syncthreads();
}

DI void transpose_tile(const TJob& j, int tile, char* smem) {
  const int t = threadIdx.x;
  const int tpb = (j.K >> 6) * j.tiles_n;
  const int bi = tile / tpb, rem = tile % tpb;
  const int kt = rem / j.tiles_n, ntile = rem % j.tiles_n;
  const int k0 = kt * 64, n0 = ntile * 64;
  const float* src = j.src + (size_t)bi * j.src_bstride;
  bf16_t* dst = j.dst + (size_t)bi * j.dst_bstride;
  bf16_t* T = (bf16_t*)smem;
  const int nn = t & 63, kq = t >> 6;
  const bool nvalid = (n0 + nn) < j.n_cnt;
  __syncthreads();
#pragma unroll 4
  for (int i = 0; i < 16; ++i) {
    const int kk = kq + 4 * i;
    float v = 0.f;
    if (nvalid) {
      v = src[(size_t)(k0 + kk) * j.ldS + j.n_off + n0 + nn];
      if (j.scale) v *= j.scale[k0 + kk];
    }
    T[nn * 66 + kk] = f2bf(v);
  }
  __syncthreads();
  const int n = t >> 2, part = t & 3;
  if (n0 + n < j.n_cnt) {
    const unsigned* tp = (const unsigned*)(T + n * 66 + part * 16);
    uint4 o0, o1;
    o0.x = tp[0]; o0.y = tp[1]; o0.z = tp[2]; o0.w = tp[3];
    o1.x = tp[4]; o1.y = tp[5]; o1.z = tp[6]; o1.w = tp[7];
    const int f = n0 + n;
    int drow;
    if (j.mode == 0) drow = j.dst_row0 + f;
    else drow = (f >> 6) * 128 + ((f & 63) >> 5) * 64 + (j.mode == 2 ? 32 : 0) + (f & 31);
    uint4* dp = (uint4*)(dst + (size_t)drow * j.K + k0 + part * 16);
    dp[0] = o0; dp[1] = o1;
  }
}

DI void mod_item(const Params& p, int it, char* smem) {
  const int t = threadIdx.x, cgi = t & 63, kg = t >> 6;
  const int j0 = it * 64;
  float* Ssm = (float*)smem;
  float* red = (float*)(smem + 33 * 128 * 4);
  float acc[33];
#pragma unroll
  for (int r = 0; r < 33; ++r) acc[r] = 0.f;
  for (int kc = 0; kc < 8; ++kc) {
    __syncthreads();
    for (int idx = t; idx < 33 * 128; idx += 256) {
      const int r = idx >> 7, kk = idx & 127;
      float v = (r < 32) ? p.c[r * DM + kc * 128 + kk] : p.c_ctx[kc * 128 + kk];
      Ssm[idx] = v * sigmoidf_(v);
    }
    __syncthreads();
    for (int kk = 0; kk < 32; kk += 4) {
      const int k = kc * 128 + kg * 32 + kk;
      const float w0 = p.w_mod[(size_t)(k + 0) * 6144 + j0 + cgi];
      const float w1 = p.w_mod[(size_t)(k + 1) * 6144 + j0 + cgi];
      const float w2 = p.w_mod[(size_t)(k + 2) * 6144 + j0 + cgi];
      const float w3 = p.w_mod[(size_t)(k + 3) * 6144 + j0 + cgi];
#pragma unroll
      for (int r = 0; r < 33; ++r) {
        const float4 s = *(const float4*)(Ssm + r * 128 + kg * 32 + kk);
        acc[r] += s.x * w0 + s.y * w1 + s.z * w2 + s.w * w3;
      }
    }
  }
  __syncthreads();
#pragma unroll
  for (int r = 0; r < 33; ++r) red[(kg * 33 + r) * 64 + cgi] = acc[r];
  __syncthreads();
  for (int idx = t; idx < 33 * 64; idx += 256) {
    const int r = idx >> 6, cc = idx & 63;
    float s = red[(0 * 33 + r) * 64 + cc] + red[(1 * 33 + r) * 64 + cc] + red[(2 * 33 + r) * 64 + cc] + red[(3 * 33 + r) * 64 + cc];
    p.mod[r * 6144 + j0 + cc] = s + p.b_mod[j0 + cc];
  }
}

DI void phase0(const Params& p, char* smem) {
  const int t = threadIdx.x;
  const int nMod = 96;
  const int nPos = 256;
  const int nMisc = 3;
  const int nT = p.n_ttiles;
  const int total = nMod + nT + nPos + nMisc;
  float* ctab = (float*)(smem + 65536 - 8192 - 1024);
  for (int j = t; j < 2048; j += 256) ctab[j] = cospif((float)j * (1.f / 1024.f));
  __syncthreads();
  for (int it = blockIdx.x; it < total; it += gridDim.x) {
    if (it < nMod) { mod_item(p, it, smem); continue; }
    int u = it - nMod;
    if (u < nT) {
      int jb = 0;
#pragma unroll 1
      for (int q = 1; q < NJOBS; ++q) if (u >= p.jobs[q].tile_start) jb = q;
      transpose_tile(p.jobs[jb], u - p.jobs[jb].tile_start, smem);
      continue;
    }
    u -= nT;
    if (u < nPos) {
      for (int e = t; e < 8 * 512; e += 256) {
        const int k = u * 8 + (e >> 9), c8 = (e & 511) * 8;
        float v[8];
#pragma unroll
        for (int q = 0; q < 8; ++q) {
          const int tt = c8 + q;
          if (tt < 2048) v[q] = ctab[(k * tt) & 2047];
          else v[q] = -ctab[(k * (tt - 2048) - 512) & 2047];
        }
        uint4 o; o.x = pk_bf16(v[0], v[1]); o.y = pk_bf16(v[2], v[3]); o.z = pk_bf16(v[4], v[5]); o.w = pk_bf16(v[6], v[7]);
        *(uint4*)(p.posM + (size_t)k * 4096 + c8) = o;
      }
      continue;
    }
    u -= nPos;
    if (u == 0) {
      for (int e = t; e < 256 * 128; e += 256) {
        const int m2 = e >> 7, cc = e & 127, mm = m2 & 127;
        float v = (m2 < 128) ? ctab[(mm * cc * 16) & 2047] : ctab[(mm * cc * 16 - 512) & 2047];
        p.chanT[e] = f2bf(v);
      }
    } else if (u == 1) {
      for (int e = t; e < 64 * 8; e += 256) {
        const int pos = e >> 3, jf = e & 7;
        const float inv = 1.0f / powf(10000.0f, (float)jf / 8.0f);
        const float ang = (float)pos * inv;
        p.ropeTab[e * 2 + 0] = cosf(ang);
        p.ropeTab[e * 2 + 1] = sinf(ang);
      }
    } else {
      uint4 z; z.x = z.y = z.z = z.w = 0u;
      uint4* dp = (uint4*)(p.WinT + (size_t)N_IN * DM);
      for (int e = t; e < (NINP - N_IN) * DM / 8; e += 256) dp[e] = z;
    }
  }
}

DI void phase1(const Params& p) {
  const int lane = threadIdx.x & 63, w = threadIdx.x >> 6;
  const int gw = blockIdx.x * 4 + w, nw = gridDim.x * 4;
  for (int R = gw; R < NT + NC; R += nw) {
    const float* src; const float* md;
    if (R < NT) { src = p.x + (size_t)R * DM; md = p.mod + (R >> 11) * 6144; }
    else { src = p.ctx + (size_t)(R - NT) * DM; md = p.mod + 32 * 6144; }
    float4 v[4]; float ss = 0.f;
#pragma unroll
    for (int i = 0; i < 4; ++i) { v[i] = *(const float4*)(src + lane * 4 + 256 * i); ss += v[i].x * v[i].x + v[i].y * v[i].y + v[i].z * v[i].z + v[i].w * v[i].w; }
    ss = wave_sum(ss);
    const float rr = rsqrtf(ss * (1.f / DM) + EPS);
#pragma unroll
    for (int i = 0; i < 4; ++i) {
      const int d = lane * 4 + 256 * i;
      const float4 g = *(const float4*)(p.norm1_g + d);
      const float4 sh = *(const float4*)(md + d);
      const float4 sc = *(const float4*)(md + 1024 + d);
      const float o0 = v[i].x * rr * g.x * (1.f + sc.x) + sh.x;
      const float o1 = v[i].y * rr * g.y * (1.f + sc.y) + sh.y;
      const float o2 = v[i].z * rr * g.z * (1.f + sc.z) + sh.z;
      const float o3 = v[i].w * rr * g.w * (1.f + sc.w) + sh.w;
      uint2 o; o.x = pk_bf16(o0, o1); o.y = pk_bf16(o2, o3);
      *(uint2*)(p.h + (size_t)R * DM + d) = o;
    }
  }
}

DI void phase2(const Params& p, char* smem) {
  const int t = threadIdx.x, lane = t & 63, w = t >> 6, r = lane & 31, hh = lane >> 5;
  const int wm = w & 1, wn = w >> 1;
  const int xcd = blockIdx.x & 7, jl = blockIdx.x >> 3, nl = gridDim.x >> 3;
  for (int L = jl; L < 1664 + 24; L += nl) {
    int tokTile, ft; const bool lat = L < 1664;
    if (lat) { const int tg = L / 208, rem = L % 208; ft = rem >> 3; tokTile = xcd * 64 + tg * 8 + (rem & 7); }
    else { const int u = L - 1664; tokTile = 512 + xcd * 8 + u / 3; const int q = u % 3; ft = (q == 2) ? 25 : 3 + q; }
    f32x16 acc[2][2];
#pragma unroll
    for (int a = 0; a < 2; ++a)
#pragma unroll
      for (int b = 0; b < 2; ++b) acc[a][b] = zero16();
    const bf16_t* Ab = p.WinT + (size_t)ft * 128 * DM;
    const bf16_t* Bb = p.h + (size_t)tokTile * 128 * DM;
    float dummy = 0.f;
    gemm_core<2, 2, 2, 2, false>(acc, [&](int row) { return Ab + (size_t)row * DM; }, [&](int row) { return Bb + (size_t)row * DM; }, DM, smem, dummy);
#pragma unroll
    for (int tm = 0; tm < 2; ++tm)
#pragma unroll
      for (int tn = 0; tn < 2; ++tn) {
        const int tok = tokTile * 128 + wn * 64 + tn * 32 + r;
#pragma unroll
        for (int q = 0; q < 4; ++q) {
          const int F0 = ft * 128 + wm * 64 + tm * 32 + 8 * q + 4 * hh;
          float v0 = acc[tm][tn][4 * q + 0], v1 = acc[tm][tn][4 * q + 1], v2 = acc[tm][tn][4 * q + 2], v3 = acc[tm][tn][4 * q + 3];
          bf16_t* dst = nullptr;
          if (lat) {
            if (ft < 5) dst = p.pqkv + (size_t)tok * LDQKV + F0;
            else if (ft < 9) dst = p.pf + (size_t)tok * 512 + (F0 - 640);
            else if (ft < 25) { v0 = sigmoidf_(v0); v1 = sigmoidf_(v1); v2 = sigmoidf_(v2); v3 = sigmoidf_(v3); dst = p.pg + (size_t)tok * 2048 + (F0 - 1152); }
            else if (F0 - 3200 < 32) dst = p.pqkv + (size_t)tok * LDQKV + 640 + (F0 - 3200);
          } else {
            const int ct = tok - NT;
            if (ft < 5) dst = p.pckv + (size_t)ct * LDCKV + (F0 - 384);
            else if (F0 - 3200 < 32) dst = p.pckv + (size_t)ct * LDCKV + 256 + (F0 - 3200);
          }
          if (dst) { uint2 o; o.x = pk_bf16(v0, v1); o.y = pk_bf16(v2, v3); *(uint2*)dst = o; }
        }
      }
  }
}

DI void rope_pair(float& x1, float& x2, const float* tab) { const float c = tab[0], s = tab[1]; const float a = x1 * c - x2 * s, b = x2 * c + x1 * s; x1 = a; x2 = b; }

DI void phase3(const Params& p, char* smem) {
  const int t = threadIdx.x, lane = t & 63, w = t >> 6, r = lane & 31, hh = lane >> 5;
  const int nKV = 576, nQ = 512, nCh = 512;
  const int xcd = blockIdx.x & 7, jl = blockIdx.x >> 3, nl = gridDim.x >> 3;
  for (int it = jl; it < nKV + nQ + nCh; it += nl) {
    if (it < nKV) {
      const int tl_ = it >> 3, hd = it & 7;
      const bool lat = tl_ < 64;
      const int tokTile = lat ? xcd * 64 + tl_ : 512 + xcd * 8 + (tl_ - 64);
      const bf16_t* Bb; int ldb; const bf16_t* kpeb;
      int b, key0;
      if (lat) { Bb = p.pqkv + (size_t)tokTile * 128 * LDQKV + QL; ldb = LDQKV; kpeb = p.pqkv + (size_t)tokTile * 128 * LDQKV + 640; b = tokTile >> 4; key0 = (tokTile & 15) * 128; }
      else { const int ct = tokTile - 512; Bb = p.pckv + (size_t)ct * 128 * LDCKV; ldb = LDCKV; kpeb = Bb + 256; b = ct >> 1; key0 = SEQ + (ct & 1) * 128; }
      const bf16_t* Ab = p.WkvT + (size_t)hd * 128 * KVL;
      f32x16 acc[4][1];
#pragma unroll
      for (int a = 0; a < 4; ++a) acc[a][0] = zero16();
      float sumsq = 0.f;
      gemm_core<4, 1, 1, 4, true>(acc, [&](int row) { return Ab + (size_t)row * KVL; }, [&](int row) { return Bb + (size_t)row * ldb; }, KVL, smem, sumsq);
      sumsq += __shfl_xor(sumsq, 32);
      const float ra = rsqrtf(sumsq * (1.f / KVL) + EPS);
      const int tl = w * 32 + r;
      const int key = key0 + tl;
      float kp[16];
#pragma unroll
      for (int q = 0; q < 4; ++q) {
        const uint2 u = *(const uint2*)(kpeb + (size_t)tl * ldb + 8 * q + 4 * hh);
        kp[4 * q + 0] = bf_lo(u.x); kp[4 * q + 1] = bf_hi(u.x); kp[4 * q + 2] = bf_lo(u.y); kp[4 * q + 3] = bf_hi(u.y);
      }
      float ss = 0.f;
#pragma unroll
      for (int tm = 0; tm < 4; ++tm)
#pragma unroll
        for (int i = 0; i < 16; ++i) { const float v = acc[tm][0][i] * ra; acc[tm][0][i] = v; if (tm < 2) ss += v * v; }
#pragma unroll
      for (int i = 0; i < 16; ++i) ss += kp[i] * kp[i];
      ss += __shfl_xor(ss, 32);
      const float rk = rsqrtf(ss * (1.f / QKD) + EPS);
#pragma unroll
      for (int i = 0; i < 16; ++i) kp[i] *= rk * p.k_norm_g[64 + crow(i, hh)];
      if (lat) {
        const int pos = key;
        const float* tr = p.ropeTab + ((pos >> 6) * 8 + 4 * hh) * 2;
        const float* tc = p.ropeTab + ((pos & 63) * 8 + 4 * hh) * 2;
#pragma unroll
        for (int i = 0; i < 4; ++i) { rope_pair(kp[i], kp[i + 4], tr + 2 * i); rope_pair(kp[8 + i], kp[12 + i], tc + 2 * i); }
      }
      bf16_t* Kd = p.K + ((size_t)(b * NH + hd) * NKEY + key) * QKD;
#pragma unroll
      for (int tm = 0; tm < 2; ++tm)
#pragma unroll
        for (int q = 0; q < 4; ++q) {
          const int f = tm * 32 + 8 * q + 4 * hh;
          const float4 g = *(const float4*)(p.k_norm_g + f);
          uint2 o; o.x = pk_bf16(acc[tm][0][4 * q] * rk * g.x, acc[tm][0][4 * q + 1] * rk * g.y); o.y = pk_bf16(acc[tm][0][4 * q + 2] * rk * g.z, acc[tm][0][4 * q + 3] * rk * g.w);
          *(uint2*)(Kd + f) = o;
        }
#pragma unroll
      for (int q = 0; q < 4; ++q) {
        uint2 o; o.x = pk_bf16(kp[4 * q], kp[4 * q + 1]); o.y = pk_bf16(kp[4 * q + 2], kp[4 * q + 3]);
        *(uint2*)(Kd + 64 + 8 * q + 4 * hh) = o;
      }
      bf16_t* Vd = p.Vt + (size_t)(b * NH + hd) * VD * NKEY + key;
#pragma unroll
      for (int tm = 2; tm < 4; ++tm)
#pragma unroll
        for (int i = 0; i < 16; ++i) Vd[(size_t)((tm - 2) * 32 + crow(i, hh)) * NKEY] = f2bf(acc[tm][0][i]);
    } else if (it < nKV + nQ) {
      const int u = it - nKV;
      const int tokTile = xcd * 64 + (u >> 3), hd = u & 7;
      const bf16_t* Bb = p.pqkv + (size_t)tokTile * 128 * LDQKV;
      const bf16_t* Ab = p.WqT + (size_t)hd * QKD * QL;
      f32x16 acc[3][1];
#pragma unroll
      for (int a = 0; a < 3; ++a) acc[a][0] = zero16();
      float sumsq = 0.f;
      gemm_core<3, 1, 1, 4, true>(acc, [&](int row) { return Ab + (size_t)row * QL; }, [&](int row) { return Bb + (size_t)row * LDQKV; }, QL, smem, sumsq);
      sumsq += __shfl_xor(sumsq, 32);
      const float ra = rsqrtf(sumsq * (1.f / QL) + EPS);
      const int tl = w * 32 + r;
      const int b = tokTile >> 4, pos = (tokTile & 15) * 128 + tl;
      float ss = 0.f;
#pragma unroll
      for (int tm = 0; tm < 3; ++tm)
#pragma unroll
        for (int i = 0; i < 16; ++i) { const float v = acc[tm][0][i] * ra; acc[tm][0][i] = v; ss += v * v; }
      ss += __shfl_xor(ss, 32);
      const float rh = rsqrtf(ss * (1.f / QKD) + EPS);
#pragma unroll
      for (int tm = 0; tm < 3; ++tm)
#pragma unroll
        for (int q = 0; q < 4; ++q) {
          const float4 g = *(const float4*)(p.q_norm_g + tm * 32 + 8 * q + 4 * hh);
          acc[tm][0][4 * q] *= rh * g.x; acc[tm][0][4 * q + 1] *= rh * g.y; acc[tm][0][4 * q + 2] *= rh * g.z; acc[tm][0][4 * q + 3] *= rh * g.w;
        }
      {
        const float* tr = p.ropeTab + ((pos >> 6) * 8 + 4 * hh) * 2;
        const float* tc = p.ropeTab + ((pos & 63) * 8 + 4 * hh) * 2;
#pragma unroll
        for (int i = 0; i < 4; ++i) {
          float a0 = acc[2][0][i], a1 = acc[2][0][i + 4], c0 = acc[2][0][8 + i], c1 = acc[2][0][12 + i];
          rope_pair(a0, a1, tr + 2 * i); rope_pair(c0, c1, tc + 2 * i);
          acc[2][0][i] = a0; acc[2][0][i + 4] = a1; acc[2][0][8 + i] = c0; acc[2][0][12 + i] = c1;
        }
      }
      const float qs = 0.10206207261596575f * 1.4426950408889634f;
      bf16_t* Qd = p.Q + ((size_t)(b * NH + hd) * SEQ + pos) * QKD;
#pragma unroll
      for (int tm = 0; tm < 3; ++tm)
#pragma unroll
        for (int q = 0; q < 4; ++q) {
          uint2 o; o.x = pk_bf16(acc[tm][0][4 * q] * qs, acc[tm][0][4 * q + 1] * qs); o.y = pk_bf16(acc[tm][0][4 * q + 2] * qs, acc[tm][0][4 * q + 3] * qs);
          *(uint2*)(Qd + tm * 32 + 8 * q + 4 * hh) = o;
        }
    } else {
      const int u = it - nKV - nQ;
      const int ft = u & 1, tt = (u >> 1) & 15, g = (u >> 5) & 3, b = xcd * 4 + (u >> 7);
      const int wm = w & 1, wn = w >> 1;
      const bf16_t* Ab = p.chanT + (size_t)ft * 128 * 128;
      const bf16_t* Bb = p.pf + (size_t)(b * SEQ + tt * 128) * 512 + g * 128;
      f32x16 acc[2][2];
#pragma unroll
      for (int a = 0; a < 2; ++a)
#pragma unroll
        for (int c = 0; c < 2; ++c) acc[a][c] = zero16();
      float dummy = 0.f;
      gemm_core<2, 2, 2, 2, false>(acc, [&](int row) { return Ab + (size_t)row * 128; }, [&](int row) { return Bb + (size_t)row * 512; }, 128, smem, dummy);
#pragma unroll
      for (int tm = 0; tm < 2; ++tm)
#pragma unroll
        for (int tn = 0; tn < 2; ++tn) {
          const int tpos = tt * 128 + wn * 64 + tn * 32 + r;
#pragma unroll
          for (int i = 0; i < 16; ++i) {
            const int mm = wm * 64 + tm * 32 + crow(i, hh);
            p.ABt[((size_t)(b * 512 + g * 128 + mm)) * 4096 + ft * 2048 + tpos] = f2bf(acc[tm][tn][i]);
          }
        }
    }
  }
}

DI void attn_item(const Params& p, int it, char* smem) {
  const int t = threadIdx.x, lane = t & 63, w = t >> 6, r = lane & 31, hh = lane >> 5;
  const int qt = it & 15, bh = it >> 4;
  constexpr int KROW = 208, VROW = 136, KBYTES = 64 * KROW, STAGE = KBYTES + 64 * VROW;
  const bf16_t* Kb = p.K + (size_t)bh * NKEY * QKD;
  const bf16_t* Vb = p.Vt + (size_t)bh * VD * NKEY;
  const int qpos = qt * 128 + w * 32 + r;
  const bf16_t* Qp = p.Q + ((size_t)bh * SEQ + qpos) * QKD + hh * 8;
  bf16x8 qf[6];
#pragma unroll
  for (int c = 0; c < 6; ++c) qf[c] = *(const bf16x8*)(Qp + c * 16);
  f32x16 o[2]; o[0] = zero16(); o[1] = zero16();
  float mrun = -INFINITY, lrun = 0.f;
  const int kid0 = t, kid1 = t + 256, kid2 = t + 512;
  const int kgo0 = (kid0 / 12) * QKD + (kid0 % 12) * 8, kgo1 = (kid1 / 12) * QKD + (kid1 % 12) * 8, kgo2 = (kid2 / 12) * QKD + (kid2 % 12) * 8;
  const int klo0 = (kid0 / 12) * KROW + (kid0 % 12) * 16, klo1 = (kid1 / 12) * KROW + (kid1 % 12) * 16, klo2 = (kid2 / 12) * KROW + (kid2 % 12) * 16;
  const int vid0 = t, vid1 = t + 256;
  const int vgo0 = (vid0 >> 3) * NKEY + (vid0 & 7) * 8, vgo1 = (vid1 >> 3) * NKEY + (vid1 & 7) * 8;
  const int vlo0 = KBYTES + (vid0 >> 3) * VROW + (vid0 & 7) * 16, vlo1 = KBYTES + (vid1 >> 3) * VROW + (vid1 & 7) * 16;
  uint4 rk0, rk1, rk2, rv0, rv1;
  rk0 = *(const uint4*)(Kb + kgo0); rk1 = *(const uint4*)(Kb + kgo1); rk2 = *(const uint4*)(Kb + kgo2);
  rv0 = *(const uint4*)(Vb + vgo0); rv1 = *(const uint4*)(Vb + vgo1);
  __builtin_amdgcn_sched_barrier(0);
#define ATT_STORE(base) do { \
    *(uint4*)((base) + klo0) = rk0; *(uint4*)((base) + klo1) = rk1; *(uint4*)((base) + klo2) = rk2; \
    { uint2* d = (uint2*)((base) + vlo0); d[0] = make_uint2(rv0.x, rv0.y); d[1] = make_uint2(rv0.z, rv0.w); } \
    { uint2* d = (uint2*)((base) + vlo1); d[0] = make_uint2(rv1.x, rv1.y); d[1] = make_uint2(rv1.z, rv1.w); } } while (0)
  ATT_STORE(smem);
  __syncthreads();
  constexpr int NKT = NKEY / 64;
  for (int kt = 0; kt < NKT; ++kt) {
    const char* cur = smem + (kt & 1) * STAGE;
    const bool more = kt + 1 < NKT;
    if (more) {
      const bf16_t* kn = Kb + (size_t)(kt + 1) * 64 * QKD; const bf16_t* vn = Vb + (kt + 1) * 64;
      rk0 = *(const uint4*)(kn + kgo0); rk1 = *(const uint4*)(kn + kgo1); rk2 = *(const uint4*)(kn + kgo2);
      rv0 = *(const uint4*)(vn + vgo0); rv1 = *(const uint4*)(vn + vgo1);
    }
    __builtin_amdgcn_sched_barrier(0);
    f32x16 s[2];
#pragma unroll
    for (int t2 = 0; t2 < 2; ++t2) {
      s[t2] = zero16();
      const char* kp = cur + (t2 * 32 + r) * KROW + hh * 16;
#pragma unroll
      for (int c = 0; c < 6; ++c) { const bf16x8 kf = *(const bf16x8*)(kp + c * 32); s[t2] = MFMA(kf, qf[c], s[t2]); }
    }
    __builtin_amdgcn_sched_barrier(0);
    float mx = s[0][0];
#pragma unroll
    for (int i = 0; i < 16; ++i) { mx = fmaxf(mx, s[0][i]); mx = fmaxf(mx, s[1][i]); }
    mx = fmaxf(mx, __shfl_xor(mx, 32));
    const float mnew = fmaxf(mrun, mx);
    const float alpha = __builtin_amdgcn_exp2f(mrun - mnew);
    mrun = mnew;
    float ls = 0.f;
#pragma unroll
    for (int t2 = 0; t2 < 2; ++t2)
#pragma unroll
      for (int i = 0; i < 16; ++i) { const float e = __builtin_amdgcn_exp2f(s[t2][i] - mnew); s[t2][i] = e; ls += e; }
    lrun = lrun * alpha + ls;
#pragma unroll
    for (int i = 0; i < 16; ++i) { o[0][i] *= alpha; o[1][i] *= alpha; }
    __builtin_amdgcn_sched_barrier(0);
#pragma unroll
    for (int t2 = 0; t2 < 2; ++t2)
#pragma unroll
      for (int s2 = 0; s2 < 2; ++s2) {
        uint4 pu;
        pu.x = pk_bf16(s[t2][8 * s2 + 0], s[t2][8 * s2 + 1]); pu.y = pk_bf16(s[t2][8 * s2 + 2], s[t2][8 * s2 + 3]);
        pu.z = pk_bf16(s[t2][8 * s2 + 4], s[t2][8 * s2 + 5]); pu.w = pk_bf16(s[t2][8 * s2 + 6], s[t2][8 * s2 + 7]);
        const bf16x8 pb = __builtin_bit_cast(bf16x8, pu);
#pragma unroll
        for (int vt = 0; vt < 2; ++vt) {
          const char* vp = cur + KBYTES + (vt * 32 + r) * VROW + (t2 * 32 + 16 * s2 + 4 * hh) * 2;
          const uint2 lo = *(const uint2*)(vp), hi = *(const uint2*)(vp + 16);
          uint4 vu; vu.x = lo.x; vu.y = lo.y; vu.z = hi.x; vu.w = hi.y;
          o[vt] = MFMA(__builtin_bit_cast(bf16x8, vu), pb, o[vt]);
        }
      }
    __builtin_amdgcn_sched_barrier(0);
    if (more) { char* nxt = smem + ((kt + 1) & 1) * STAGE; ATT_STORE(nxt); }
    __syncthreads();
  }
  lrun += __shfl_xor(lrun, 32);
  const float inv = 1.f / lrun;
  const int b = bh >> 3, hd = bh & 7;
  bf16_t* od = p.attn_o + (size_t)(b * SEQ + qpos) * 512 + hd * 64;
#pragma unroll
  for (int vt = 0; vt < 2; ++vt)
#pragma unroll
    for (int q = 0; q < 4; ++q) {
      uint2 ou; ou.x = pk_bf16(o[vt][4 * q] * inv, o[vt][4 * q + 1] * inv); ou.y = pk_bf16(o[vt][4 * q + 2] * inv, o[vt][4 * q + 3] * inv);
      *(uint2*)(od + vt * 32 + 8 * q + 4 * hh) = ou;
    }
}

DI void phase4(const Params& p, char* smem) {
  const int t = threadIdx.x, lane = t & 63, w = t >> 6, r = lane & 31, hh = lane >> 5;
  const int nDft = 256, nAtt = 512;
  const int xcd = blockIdx.x & 7, jl = blockIdx.x >> 3, nl = gridDim.x >> 3;
  for (int it = jl; it < nDft + nAtt; it += nl) {
    if (it < nDft) {
      const int kt = it & 15, ct = (it >> 4) & 3, b = xcd * 4 + (it >> 6);
      const int wm = w & 1, wn = w >> 1;
      const bf16_t* Ab = p.ABt + (size_t)(b * 512 + ct * 128) * 4096;
      const bf16_t* Bb = p.posM + (size_t)kt * 128 * 4096;
      f32x16 acc[2][2];
#pragma unroll
      for (int a = 0; a < 2; ++a)
#pragma unroll
        for (int c = 0; c < 2; ++c) acc[a][c] = zero16();
      float dummy = 0.f;
      gemm_core<2, 2, 2, 2, false>(acc, [&](int row) { return Ab + (size_t)row * 4096; }, [&](int row) { return Bb + (size_t)row * 4096; }, 4096, smem, dummy);
      const float sc = 1.f / 512.f;
#pragma unroll
      for (int tm = 0; tm < 2; ++tm)
#pragma unroll
        for (int tn = 0; tn < 2; ++tn) {
          const int kpos = kt * 128 + wn * 64 + tn * 32 + r;
          bf16_t* d = p.four_o + (size_t)(b * SEQ + kpos) * 512 + ct * 128 + wm * 64 + tm * 32 + 4 * hh;
#pragma unroll
          for (int q = 0; q < 4; ++q) {
            uint2 ou; ou.x = pk_bf16(acc[tm][tn][4 * q] * sc, acc[tm][tn][4 * q + 1] * sc); ou.y = pk_bf16(acc[tm][tn][4 * q + 2] * sc, acc[tm][tn][4 * q + 3] * sc);
            *(uint2*)(d + 8 * q) = ou;
          }
        }
    } else {
      attn_item(p, xcd * 512 + (it - nDft), smem);
    }
  }
}

DI void phase5(const Params& p, char* smem) {
  const int t = threadIdx.x, lane = t & 63, w = t >> 6, r = lane & 31, hh = lane >> 5;
  const int wm = w & 1, wn = w >> 1;
  const int xcd = blockIdx.x & 7, jl = blockIdx.x >> 3, nl = gridDim.x >> 3;
  for (int L = jl; L < 512; L += nl) {
    const int tokTile = xcd * 64 + (L >> 6) * 8 + (L & 7), nt = (L >> 3) & 7;
    f32x16 acc1[2][2], acc2[2][2];
#pragma unroll
    for (int a = 0; a < 2; ++a)
#pragma unroll
      for (int c = 0; c < 2; ++c) { acc1[a][c] = zero16(); acc2[a][c] = zero16(); }
    float dummy = 0.f;
    {
      const bf16_t* Ab = p.WoT + (size_t)nt * 128 * 512; const bf16_t* Bb = p.attn_o + (size_t)tokTile * 128 * 512;
      gemm_core<2, 2, 2, 2, false>(acc1, [&](int row) { return Ab + (size_t)row * 512; }, [&](int row) { return Bb + (size_t)row * 512; }, 512, smem, dummy);
    }
    {
      const bf16_t* Ab = p.WfT + (size_t)nt * 128 * 512; const bf16_t* Bb = p.four_o + (size_t)tokTile * 128 * 512;
      gemm_core<2, 2, 2, 2, false>(acc2, [&](int row) { return Ab + (size_t)row * 512; }, [&](int row) { return Bb + (size_t)row * 512; }, 512, smem, dummy);
    }
#pragma unroll
    for (int tm = 0; tm < 2; ++tm)
#pragma unroll
      for (int tn = 0; tn < 2; ++tn) {
        const int tok = tokTile * 128 + wn * 64 + tn * 32 + r;
#pragma unroll
        for (int q = 0; q < 4; ++q) {
          const int n = nt * 128 + wm * 64 + tm * 32 + 8 * q + 4 * hh;
          const uint2 ga = *(const uint2*)(p.pg + (size_t)tok * 2048 + n);
          const uint2 gb = *(const uint2*)(p.pg + (size_t)tok * 2048 + 1024 + n);
          const float v0 = bf_lo(ga.x) * acc1[tm][tn][4 * q] + bf_lo(gb.x) * acc2[tm][tn][4 * q];
          const float v1 = bf_hi(ga.x) * acc1[tm][tn][4 * q + 1] + bf_hi(gb.x) * acc2[tm][tn][4 * q + 1];
          const float v2 = bf_lo(ga.y) * acc1[tm][tn][4 * q + 2] + bf_lo(gb.y) * acc2[tm][tn][4 * q + 2];
          const float v3 = bf_hi(ga.y) * acc1[tm][tn][4 * q + 3] + bf_hi(gb.y) * acc2[tm][tn][4 * q + 3];
          uint2 ou; ou.x = pk_bf16(v0, v1); ou.y = pk_bf16(v2, v3);
          *(uint2*)(p.m + (size_t)tok * DM + n) = ou;
        }
      }
  }
}

DI void phase6(const Params& p, char* smem) {
  const int t = threadIdx.x, lane = t & 63, w = t >> 6, r = lane & 31, hh = lane >> 5;
  const int wm = w & 1, wn = w >> 1;
  const int xcd = blockIdx.x & 7, jl = blockIdx.x >> 3, nl = gridDim.x >> 3;
  for (int L = jl; L < 512; L += nl) {
    const int tokTile = xcd * 64 + (L >> 6) * 8 + (L & 7), nt = (L >> 3) & 7;
    f32x16 acc[2][2];
#pragma unroll
    for (int a = 0; a < 2; ++a)
#pragma unroll
      for (int c = 0; c < 2; ++c) acc[a][c] = zero16();
    float dummy = 0.f;
    const bf16_t* Ab = p.WoutT + (size_t)nt * 128 * DM; const bf16_t* Bb = p.m + (size_t)tokTile * 128 * DM;
    gemm_core<2, 2, 2, 2, false>(acc, [&](int row) { return Ab + (size_t)row * DM; }, [&](int row) { return Bb + (size_t)row * DM; }, DM, smem, dummy);
    const float* g1 = p.mod + (tokTile >> 4) * 6144 + 2048;
#pragma unroll
    for (int tm = 0; tm < 2; ++tm)
#pragma unroll
      for (int tn = 0; tn < 2; ++tn) {
        const int tok = tokTile * 128 + wn * 64 + tn * 32 + r;
#pragma unroll
        for (int q = 0; q < 4; ++q) {
          const int n = nt * 128 + wm * 64 + tm * 32 + 8 * q + 4 * hh;
          const float4 xv = *(const float4*)(p.x + (size_t)tok * DM + n);
          const float4 g = *(const float4*)(g1 + n);
          float4 ov;
          ov.x = xv.x + g.x * acc[tm][tn][4 * q]; ov.y = xv.y + g.y * acc[tm][tn][4 * q + 1];
          ov.z = xv.z + g.z * acc[tm][tn][4 * q + 2]; ov.w = xv.w + g.w * acc[tm][tn][4 * q + 3];
          *(float4*)(p.out + (size_t)tok * DM + n) = ov;
        }
      }
  }
}

DI void phase7(const Params& p, char* smem) {
  const int t = threadIdx.x, lane = t & 63, w = t >> 6;
  float* wr = (float*)smem;
  for (int idx = t; idx < DM * NE; idx += 256) { const int d = idx >> 4, e = idx & 15; wr[e * DM + d] = p.w_router[idx]; }
  __syncthreads();
  const int gw = blockIdx.x * 4 + w, nw = gridDim.x * 4;
  for (int R = gw; R < NT; R += nw) {
    asm volatile("" ::: "memory");
    const float* src = p.out + (size_t)R * DM;
    const int b = R >> 11;
    const float* md = p.mod + b * 6144;
    float4 v[4]; float ss = 0.f;
#pragma unroll
    for (int i = 0; i < 4; ++i) { v[i] = *(const float4*)(src + lane * 4 + 256 * i); ss += v[i].x * v[i].x + v[i].y * v[i].y + v[i].z * v[i].z + v[i].w * v[i].w; }
    ss = wave_sum(ss);
    const float rr = rsqrtf(ss * (1.f / DM) + EPS);
#pragma unroll
    for (int i = 0; i < 4; ++i) {
      const int d = lane * 4 + 256 * i;
      const float4 g = *(const float4*)(p.norm2_g + d);
      const float4 sh = *(const float4*)(md + 3072 + d);
      const float4 sc = *(const float4*)(md + 4096 + d);
      v[i].x = v[i].x * rr * g.x * (1.f + sc.x) + sh.x;
      v[i].y = v[i].y * rr * g.y * (1.f + sc.y) + sh.y;
      v[i].z = v[i].z * rr * g.z * (1.f + sc.z) + sh.z;
      v[i].w = v[i].w * rr * g.w * (1.f + sc.w) + sh.w;
      uint2 o; o.x = pk_bf16(v[i].x, v[i].y); o.y = pk_bf16(v[i].z, v[i].w);
      *(uint2*)(p.h2 + (size_t)R * DM + d) = o;
    }
    float a[16];
#pragma unroll
    for (int e = 0; e < 16; ++e) {
      float s = 0.f;
#pragma unroll
      for (int i = 0; i < 4; ++i) { const float4 wv = *(const float4*)(wr + e * DM + lane * 4 + 256 * i); s += v[i].x * wv.x + v[i].y * wv.y + v[i].z * wv.z + v[i].w * wv.w; }
      a[e] = s;
      if ((e & 3) == 3) __builtin_amdgcn_sched_barrier(0);
    }
    float a8[8], a4[4], a2[2], a1;
    {
      const bool up = lane & 32;
#pragma unroll
      for (int j = 0; j < 8; ++j) { const float send = up ? a[j] : a[j + 8]; const float keep = up ? a[j + 8] : a[j]; a8[j] = keep + __shfl_xor(send, 32); }
    }
    {
      const bool up = lane & 16;
#pragma unroll
      for (int j = 0; j < 4; ++j) { const float send = up ? a8[j] : a8[j + 4]; const float keep = up ? a8[j + 4] : a8[j]; a4[j] = keep + __shfl_xor(send, 16); }
    }
    {
      const bool up = lane & 8;
#pragma unroll
      for (int j = 0; j < 2; ++j) { const float send = up ? a4[j] : a4[j + 2]; const float keep = up ? a4[j + 2] : a4[j]; a2[j] = keep + __shfl_xor(send, 8); }
    }
    {
      const bool up = lane & 4;
      const float send = up ? a2[0] : a2[1]; const float keep = up ? a2[1] : a2[0]; a1 = keep + __shfl_xor(send, 4);
    }
    a1 += __shfl_xor(a1, 2);
    a1 += __shfl_xor(a1, 1);
    float mx = a1;
#pragma unroll
    for (int o = 4; o <= 32; o <<= 1) mx = fmaxf(mx, __shfl_xor(mx, o));
    const float ex = __expf(a1 - mx);
    float sm = ex;
#pragma unroll
    for (int o = 4; o <= 32; o <<= 1) sm += __shfl_xor(sm, o);
    if ((lane & 3) == 0) {
      const int e = (lane >> 2) & 15;
      p.aff[((size_t)(b * NE + e)) * SEQ + (R & 2047)] = ex / sm;
    }
  }
}

DI void phase8(const Params& p) {
  const int lane = threadIdx.x & 63, w = threadIdx.x >> 6;
  const int gw = blockIdx.x * 4 + w, nw = gridDim.x * 4;
  for (int pr = gw; pr < NB * NE; pr += nw) {
    const float* a = p.aff + (size_t)pr * SEQ;
    unsigned u[32];
#pragma unroll
    for (int q = 0; q < 32; ++q) u[q] = __float_as_uint(a[q * 64 + lane]);
    unsigned thr = 0;
    for (int bit = 30; bit >= 0; --bit) {
      const unsigned cand = thr | (1u << bit);
      int cnt = 0;
#pragma unroll
      for (int q = 0; q < 32; ++q) cnt += __popcll(__ballot(u[q] >= cand));
      if (cnt >= CAP) thr = cand;
    }
    int ngt = 0;
#pragma unroll
    for (int q = 0; q < 32; ++q) ngt += __popcll(__ballot(u[q] > thr));
    int cgt = 0, ceq = 0;
    int* io = p.idx + pr * CAP; float* go = p.gate + pr * CAP;
#pragma unroll
    for (int q = 0; q < 32; ++q) {
      const bool gt = u[q] > thr, eq = u[q] == thr;
      const unsigned long long mg = __ballot(gt), me = __ballot(eq);
      const unsigned long long below = (1ull << lane) - 1ull;
      if (gt) { const int s = cgt + __popcll(mg & below); io[s] = q * 64 + lane; go[s] = __uint_as_float(u[q]); }
      if (eq) { const int s = ngt + ceq + __popcll(me & below); if (s < CAP) { io[s] = q * 64 + lane; go[s] = __uint_as_float(u[q]); } }
      cgt += __popcll(mg); ceq += __popcll(me);
    }
  }
}

DI void phase9(const Params& p, char* smem) {
  const int t = threadIdx.x, lane = t & 63, w = t >> 6, r = lane & 31, hh = lane >> 5;
  const int wm = w & 1, wn = w >> 1;
  const int xcd = blockIdx.x & 7, jl = blockIdx.x >> 3, nl = gridDim.x >> 3;
  for (int L = jl; L < 1024; L += nl) {
    const int e = xcd * 2 + (L >> 9), rem = L & 511, ft = (rem >> 3) & 7, st = rem & 1, b = (rem >> 6) * 4 + ((rem & 7) >> 1);
    const int be = b * NE + e;
    const bf16_t* Ab = p.WguT + ((size_t)e * 1024 + ft * 128) * DM;
    const int* ib = p.idx + be * CAP + st * 128;
    const bf16_t* hb = p.h2 + (size_t)b * SEQ * DM;
    f32x16 acc[2][2];
#pragma unroll
    for (int a = 0; a < 2; ++a)
#pragma unroll
      for (int c = 0; c < 2; ++c) acc[a][c] = zero16();
    float dummy = 0.f;
    gemm_core<2, 2, 2, 2, false>(acc, [&](int row) { return Ab + (size_t)row * DM; }, [&](int row) { return hb + (size_t)ib[row] * DM; }, DM, smem, dummy);
#pragma unroll
    for (int tn = 0; tn < 2; ++tn) {
      const int slot = st * 128 + wn * 64 + tn * 32 + r;
      bf16_t* d = p.hmid + ((size_t)be * CAP + slot) * DE + ft * 64 + wm * 32 + 4 * hh;
#pragma unroll
      for (int q = 0; q < 4; ++q) {
        float v[4];
#pragma unroll
        for (int j = 0; j < 4; ++j) { const float g = acc[0][tn][4 * q + j], uu = acc[1][tn][4 * q + j]; v[j] = g * sigmoidf_(g) * uu; }
        uint2 ou; ou.x = pk_bf16(v[0], v[1]); ou.y = pk_bf16(v[2], v[3]);
        *(uint2*)(d + 8 * q) = ou;
      }
    }
  }
}

DI void phase10(const Params& p, char* smem) {
  const int t = threadIdx.x, lane = t & 63, w = t >> 6, r = lane & 31, hh = lane >> 5;
  const int wm = w & 1, wn = w >> 1;
  const int xcd = blockIdx.x & 7, jl = blockIdx.x >> 3, nl = gridDim.x >> 3;
  for (int L = jl; L < 1024; L += nl) {
    const int e = xcd * 2 + (L >> 9), rem = L & 511, nt = (rem >> 3) & 7, st = rem & 1, b = (rem >> 6) * 4 + ((rem & 7) >> 1);
    const int be = b * NE + e;
    const bf16_t* Ab = p.hmid + ((size_t)be * CAP + st * 128) * DE;
    const bf16_t* Bb = p.WdT + ((size_t)e * DM + nt * 128) * DE;
    f32x16 acc[2][2];
#pragma unroll
    for (int a = 0; a < 2; ++a)
#pragma unroll
      for (int c = 0; c < 2; ++c) acc[a][c] = zero16();
    float dummy = 0.f;
    gemm_core<2, 2, 2, 2, false>(acc, [&](int row) { return Ab + (size_t)row * DE; }, [&](int row) { return Bb + (size_t)row * DE; }, DE, smem, dummy);
    const float* g2 = p.mod + b * 6144 + 5120;
#pragma unroll
    for (int tn = 0; tn < 2; ++tn) {
      const int n = nt * 128 + wn * 64 + tn * 32 + r;
      const float gn = g2[n];
#pragma unroll
      for (int tm = 0; tm < 2; ++tm)
#pragma unroll
        for (int i = 0; i < 16; ++i) {
          const int slot = st * 128 + wm * 64 + tm * 32 + crow(i, hh);
          const int tok = p.idx[be * CAP + slot];
          const float gt = p.gate[be * CAP + slot];
          unsafeAtomicAdd(p.out + ((size_t)(b * SEQ + tok)) * DM + n, gn * gt * acc[tm][tn][i]);
        }
    }
  }
}

__global__ void __launch_bounds__(256, 2) mega_kernel(Params p) {
  cg::grid_group grid = cg::this_grid();
  __shared__ __attribute__((aligned(16))) char smem[SMEM_BYTES];
#ifndef REPMASK
#define REPMASK 0
#endif
#define RUNPH(k, call) for (int rep_ = 0; rep_ < (((REPMASK) >> (k)) & 1) + 1; ++rep_) { call; grid.sync(); }
  RUNPH(0, phase0(p, smem))
  RUNPH(1, phase1(p))
  RUNPH(2, phase2(p, smem))
  RUNPH(3, phase3(p, smem))
  RUNPH(4, phase4(p, smem))
  RUNPH(5, phase5(p, smem))
  RUNPH(6, phase6(p, smem))
  RUNPH(7, phase7(p, smem))
  RUNPH(8, phase8(p))
  RUNPH(9, phase9(p, smem))
  phase10(p, smem);
}

static inline size_t align_up(size_t v, size_t a) { return (v + a - 1) / a * a; }

extern "C" void kernel_launch(void* const* d_in, const int* in_sizes, int n_in,
                              void* d_out, int out_size, void* d_ws, size_t ws_size,
                              hipStream_t stream) {
  static int grid_blocks = 0;
  if (!grid_blocks) {
    int dev = 0, cus = 0, per_cu = 0;
    (void)hipGetDevice(&dev);
    (void)hipDeviceGetAttribute(&cus, hipDeviceAttributeMultiprocessorCount, dev);
    (void)hipOccupancyMaxActiveBlocksPerMultiprocessor(&per_cu, mega_kernel, 256, 0);
    if (per_cu > 2) per_cu = 2;
    if (per_cu < 1) per_cu = 1;
    grid_blocks = (cus * per_cu) & ~7;
    if (grid_blocks < 8) grid_blocks = 8;
  }
  Params p;
  memset(&p, 0, sizeof(p));
  const float* x = (const float*)d_in[0];
  p.x = x; p.c = (const float*)d_in[1]; p.ctx = (const float*)d_in[2]; p.c_ctx = (const float*)d_in[3];
  p.w_mod = (const float*)d_in[4]; p.b_mod = (const float*)d_in[5]; p.norm1_g = (const float*)d_in[6];
  const float* w_in = (const float*)d_in[7];
  const float* q_a_g = (const float*)d_in[8];
  const float* kv_a_g = (const float*)d_in[9];
  const float* w_q_up = (const float*)d_in[10];
  const float* w_kv_up = (const float*)d_in[11];
  p.q_norm_g = (const float*)d_in[12]; p.k_norm_g = (const float*)d_in[13];
  const float* w_o_attn = (const float*)d_in[14];
  const float* w_fourier = (const float*)d_in[15];
  const float* w_out = (const float*)d_in[16];
  p.norm2_g = (const float*)d_in[17]; p.w_router = (const float*)d_in[18];
  const float* w_e_gate = (const float*)d_in[19];
  const float* w_e_up = (const float*)d_in[20];
  const float* w_e_down = (const float*)d_in[21];
  p.out = (float*)d_out;

  char* base = (char*)d_ws; size_t off = 0;
  auto alloc = [&](size_t bytes) { char* q = base + off; off = align_up(off + bytes, 256); return q; };
  p.WinT = (bf16_t*)alloc((size_t)NINP * DM * 2);
  p.WqT = (bf16_t*)alloc((size_t)768 * QL * 2);
  p.WkvT = (bf16_t*)alloc((size_t)1024 * KVL * 2);
  p.WoT = (bf16_t*)alloc((size_t)DM * 512 * 2);
  p.WfT = (bf16_t*)alloc((size_t)DM * 512 * 2);
  p.WoutT = (bf16_t*)alloc((size_t)DM * DM * 2);
  p.WguT = (bf16_t*)alloc((size_t)NE * 1024 * DM * 2);
  p.WdT = (bf16_t*)alloc((size_t)NE * DM * DE * 2);
  p.chanT = (bf16_t*)alloc((size_t)256 * 128 * 2);
  p.posM = (bf16_t*)alloc((size_t)2048 * 4096 * 2);
  p.ropeTab = (float*)alloc(64 * 8 * 2 * 4);
  p.mod = (float*)alloc(33 * 6144 * 4);
  p.aff = (float*)alloc((size_t)NB * NE * SEQ * 4);
  p.gate = (float*)alloc((size_t)NB * NE * CAP * 4);
  p.idx = (int*)alloc((size_t)NB * NE * CAP * 4);
  p.pckv = (bf16_t*)alloc((size_t)NC * LDCKV * 2);
  char* regA = alloc((size_t)(NT + NC) * DM * 2);
  p.h = (bf16_t*)regA; p.ABt = (bf16_t*)regA; p.h2 = (bf16_t*)regA;
  char* regB1 = alloc((size_t)NT * LDQKV * 2);
  p.pqkv = (bf16_t*)regB1; p.attn_o = (bf16_t*)regB1;
  char* regB2 = alloc((size_t)NT * 512 * 2);
  p.pf = (bf16_t*)regB2; p.four_o = (bf16_t*)regB2;
  p.pg = (bf16_t*)alloc((size_t)NT * 2048 * 2);
  const size_t szQ = (size_t)NB * NH * SEQ * QKD * 2, szK = (size_t)NB * NH * NKEY * QKD * 2, szV = (size_t)NB * NH * VD * NKEY * 2;
  char* regC = alloc(szQ + szK + szV + 1024);
  p.Q = (bf16_t*)regC; p.K = (bf16_t*)(regC + align_up(szQ, 256)); p.Vt = (bf16_t*)(regC + align_up(szQ, 256) + align_up(szK, 256));
  p.m = (bf16_t*)regC; p.hmid = (bf16_t*)(regC + (size_t)NT * DM * 2);
  if (off > ws_size) { fprintf(stderr, "workspace too small: need %zu have %zu\n", off, ws_size); return; }

  int ts = 0;
  auto job = [&](int i, const float* src, bf16_t* dst, const float* scale, int K, int ldS, int n_off, int n_cnt, int dst_row0, int mode, int batch, long sbs, long dbs) {
    TJob& j = p.jobs[i];
    j.src = src; j.dst = dst; j.scale = scale; j.K = K; j.ldS = ldS; j.n_off = n_off; j.n_cnt = n_cnt; j.dst_row0 = dst_row0; j.mode = mode; j.batch = batch;
    j.tiles_n = (n_cnt + 63) / 64; j.tile_start = ts; j.src_bstride = sbs; j.dst_bstride = dbs;
    ts += batch * (K / 64) * j.tiles_n;
  };
  job(0, w_e_gate, p.WguT, nullptr, DM, DE, 0, DE, 0, 1, NE, (long)DM * DE, (long)1024 * DM);
  job(1, w_e_up, p.WguT, nullptr, DM, DE, 0, DE, 0, 2, NE, (long)DM * DE, (long)1024 * DM);
  job(2, w_e_down, p.WdT, nullptr, DE, DM, 0, DM, 0, 0, NE, (long)DE * DM, (long)DM * DE);
  job(3, w_in, p.WinT, nullptr, DM, N_IN, 0, 640, 0, 0, 1, 0, 0);
  job(4, w_in, p.WinT, nullptr, DM, N_IN, 672, 2560, 640, 0, 1, 0, 0);
  job(5, w_in, p.WinT, nullptr, DM, N_IN, 640, 32, 3200, 0, 1, 0, 0);
  job(6, w_q_up, p.WqT, q_a_g, QL, 768, 0, 768, 0, 0, 1, 0, 0);
  job(7, w_kv_up, p.WkvT, kv_a_g, KVL, 1024, 0, 1024, 0, 0, 1, 0, 0);
  job(8, w_o_attn, p.WoT, nullptr, 512, DM, 0, DM, 0, 0, 1, 0, 0);
  job(9, w_fourier, p.WfT, nullptr, 512, DM, 0, DM, 0, 0, 1, 0, 0);
  job(10, w_out, p.WoutT, nullptr, DM, DM, 0, DM, 0, 0, 1, 0, 0);
  p.n_ttiles = ts;

  void* args[] = {&p};
  hipError_t e = hipLaunchCooperativeKernel((void*)mega_kernel, dim3(grid_blocks), dim3(256), args, 0, stream);
  if (e != hipSuccess) fprintf(stderr, "cooperative launch failed: %s (grid %d)\n", hipGetErrorString(e), grid_blocks);
}
```

```cpp
#include <hip/hip_runtime.h>
#include <hip/hip_cooperative_groups.h>
#include <cstdio>
#include <cstring>
#include <cstdint>
namespace cg = cooperative_groups;

#define DI __device__ __forceinline__
typedef unsigned short bf16_t;
typedef short bf16x8 __attribute__((ext_vector_type(8)));
typedef float f32x16 __attribute__((ext_vector_type(16)));
#define MFMA(a, b, c) __builtin_amdgcn_mfma_f32_32x32x16_bf16((a), (b), (c), 0, 0, 0)

constexpr int NB = 32, SEQ = 2048, DM = 1024, NT = NB * SEQ, CTXL = 256, NC = NB * CTXL;
constexpr int NH = 8, QKD = 96, VD = 64, QL = 384, KVL = 256, NKEY = SEQ + CTXL;
constexpr int N_IN = 3232, NINP = 3328;
constexpr int NE = 16, DE = 512, CAP = 256;
constexpr float EPS = 1e-6f;
constexpr int LDQKV = 672, LDCKV = 288;
constexpr int SMEM_BYTES = 73728;

struct TJob {
  const float* src; bf16_t* dst; const float* scale;
  int K, ldS, n_off, n_cnt, dst_row0, mode, batch, tiles_n, tile_start, pad0;
  long src_bstride, dst_bstride;
};
constexpr int NJOBS = 11;

struct Params {
  const float *x, *c, *ctx, *c_ctx, *w_mod, *b_mod, *norm1_g, *q_norm_g, *k_norm_g, *norm2_g, *w_router;
  float* out;
  bf16_t *WinT, *WqT, *WkvT, *WoT, *WfT, *WoutT, *WguT, *WdT, *chanT, *posM;
  float *ropeTab, *mod;
  bf16_t *h, *pqkv, *pckv, *pf, *pg, *Q, *K, *Vt, *attn_o, *ABt, *four_o, *m, *h2, *hmid;
  float *aff, *gate;
  int* idx;
  int* inv;
  bf16_t* Y;
  TJob jobs[NJOBS];
  int n_ttiles, pad1;
};

typedef float f32x2v __attribute__((ext_vector_type(2)));
typedef __bf16 bf16x2v __attribute__((ext_vector_type(2)));
DI unsigned pk_bf16(float lo, float hi) { f32x2v v = {lo, hi}; bf16x2v b = __builtin_convertvector(v, bf16x2v); return __builtin_bit_cast(unsigned, b); }
DI int tid_() { int t = threadIdx.x; asm volatile("" : "+v"(t)); return t; }
DI float bf_lo(unsigned u) { return __uint_as_float(u << 16); }
DI float bf_hi(unsigned u) { return __uint_as_float(u & 0xffff0000u); }
DI float bf2f(bf16_t b) { return __uint_as_float(((unsigned)b) << 16); }
DI bf16_t f2bf(float f) { return (bf16_t)(pk_bf16(f, 0.f) & 0xffffu); }
DI float sigmoidf_(float x) { return 1.f / (1.f + __expf(-x)); }
DI int crow(int i, int hh) { return (i & 3) + 8 * (i >> 2) + 4 * hh; }
DI float wave_sum(float v) {
#pragma unroll
  for (int o = 32; o >= 1; o >>= 1) v += __shfl_xor(v, o);
  return v;
}
DI f32x16 zero16() { f32x16 z;
#pragma unroll
  for (int i = 0; i < 16; ++i) z[i] = 0.f; return z; }

template <int TM, int TN, int WM, int WN, bool SUMSQ, class AF, class BF>
DI void gemm_core(f32x16 (&acc)[TM][TN], AF arow, BF brow, int K, char* smem, float& sumsq) {
  constexpr int RA = 32 * TM * WM, RB = 32 * TN * WN, NA = RA / 32, NBR = RB / 32;
  constexpr int LDR = 144;
  constexpr int STAGE = (RA + RB) * LDR;
  static_assert(2 * STAGE <= SMEM_BYTES, "smem");
  const int t = tid_(), lane = t & 63, w = t >> 6, r = lane & 31, hh = lane >> 5;
  const int wm = w % WM, wn = w / WM;
  const int c = t & 7, row0 = t >> 3;
  static_assert(NBR == 4 && (NA == 3 || NA == 4), "loader shape");
  const bf16_t* pa0 = arow(row0) + c * 8; const bf16_t* pa1 = arow(row0 + 32) + c * 8; const bf16_t* pa2 = arow(row0 + 64) + c * 8;
  const bf16_t* pa3 = (NA > 3) ? arow(row0 + 96) + c * 8 : pa2;
  const bf16_t* pb0 = brow(row0) + c * 8; const bf16_t* pb1 = brow(row0 + 32) + c * 8; const bf16_t* pb2 = brow(row0 + 64) + c * 8; const bf16_t* pb3 = brow(row0 + 96) + c * 8;
  uint4 ra0, ra1, ra2, ra3, rb0, rb1, rb2, rb3;
#define G_LOAD(ko) do { ra0 = *(const uint4*)(pa0 + (ko)); ra1 = *(const uint4*)(pa1 + (ko)); ra2 = *(const uint4*)(pa2 + (ko)); if (NA > 3) ra3 = *(const uint4*)(pa3 + (ko)); \
    rb0 = *(const uint4*)(pb0 + (ko)); rb1 = *(const uint4*)(pb1 + (ko)); rb2 = *(const uint4*)(pb2 + (ko)); rb3 = *(const uint4*)(pb3 + (ko)); } while (0)
#define G_STORE(base) do { char* sa_ = (base) + row0 * LDR + c * 16; \
    *(uint4*)(sa_) = ra0; *(uint4*)(sa_ + 32 * LDR) = ra1; *(uint4*)(sa_ + 64 * LDR) = ra2; if (NA > 3) *(uint4*)(sa_ + 96 * LDR) = ra3; \
    char* sb_ = sa_ + RA * LDR; \
    *(uint4*)(sb_) = rb0; *(uint4*)(sb_ + 32 * LDR) = rb1; *(uint4*)(sb_ + 64 * LDR) = rb2; *(uint4*)(sb_ + 96 * LDR) = rb3; } while (0)
  G_LOAD(0);
  __builtin_amdgcn_sched_barrier(0);
  G_STORE(smem);
  __syncthreads();
  const int nk = K >> 6;
  const int aoff = (wm * TM * 32 + r) * LDR + hh * 16, boff = RA * LDR + (wn * TN * 32 + r) * LDR + hh * 16;
  auto compute = [&](const char* cur) {
    const char* As = cur + aoff;
    const char* Bs = cur + boff;
    bf16x8 a0[TM], b0[TN], a1[TM], b1[TN];
#define LOADF(A_, B_, ks) do { _Pragma("unroll") for (int tm = 0; tm < TM; ++tm) A_[tm] = *(const bf16x8*)(As + tm * 32 * LDR + (ks) * 32); \
      _Pragma("unroll") for (int tn = 0; tn < TN; ++tn) B_[tn] = *(const bf16x8*)(Bs + tn * 32 * LDR + (ks) * 32); } while (0)
#define MMF(A_, B_) do { if (SUMSQ) { uint4 u = __builtin_bit_cast(uint4, B_[0]); \
        float e0 = bf_lo(u.x), e1 = bf_hi(u.x), e2 = bf_lo(u.y), e3 = bf_hi(u.y), e4 = bf_lo(u.z), e5 = bf_hi(u.z), e6 = bf_lo(u.w), e7 = bf_hi(u.w); \
        sumsq += e0 * e0 + e1 * e1 + e2 * e2 + e3 * e3 + e4 * e4 + e5 * e5 + e6 * e6 + e7 * e7; } \
      _Pragma("unroll") for (int tm = 0; tm < TM; ++tm) _Pragma("unroll") for (int tn = 0; tn < TN; ++tn) acc[tm][tn] = MFMA(A_[tm], B_[tn], acc[tm][tn]); } while (0)
    LOADF(a0, b0, 0);
    LOADF(a1, b1, 1);
    MMF(a0, b0);
    LOADF(a0, b0, 2);
    MMF(a1, b1);
    LOADF(a1, b1, 3);
    MMF(a0, b0);
    MMF(a1, b1);
    constexpr int NF = TM + TN, NM = TM * TN;
    __builtin_amdgcn_sched_group_barrier(0x100, NF, 0);
    __builtin_amdgcn_sched_group_barrier(0x100, NF, 0);
    __builtin_amdgcn_sched_group_barrier(0x008, NM, 0);
    __builtin_amdgcn_sched_group_barrier(0x100, NF, 0);
    __builtin_amdgcn_sched_group_barrier(0x008, NM, 0);
    __builtin_amdgcn_sched_group_barrier(0x100, NF, 0);
    __builtin_amdgcn_sched_group_barrier(0x008, NM, 0);
    __builtin_amdgcn_sched_group_barrier(0x008, NM, 0);
  };
  for (int kt = 0; kt < nk - 1; ++kt) {
    G_LOAD((kt + 1) * 64);
    __builtin_amdgcn_sched_barrier(0);
    compute(smem + (kt & 1) * STAGE);
    __builtin_amdgcn_sched_barrier(0);
    G_STORE(smem + ((kt + 1) & 1) * STAGE);
    __syncthreads();
  }
  compute(smem + ((nk - 1) & 1) * STAGE);
  __syncthreads();
}


constexpr int LDT = 272;
template <class F>
DI void stage_tile(const f32x16 (&acc)[2][2], char* tile, F f) {
  const int t = tid_(), lane = t & 63, w = t >> 6, r = lane & 31, hh = lane >> 5;
  const int wm = w & 1, wn = w >> 1;
#pragma unroll
  for (int tm = 0; tm < 2; ++tm)
#pragma unroll
    for (int tn = 0; tn < 2; ++tn) {
      char* d = tile + (wn * 64 + tn * 32 + r) * LDT + (wm * 64 + tm * 32 + 4 * hh) * 2;
#pragma unroll
      for (int q = 0; q < 4; ++q) {
        uint2 o; o.x = pk_bf16(f(acc[tm][tn][4 * q]), f(acc[tm][tn][4 * q + 1])); o.y = pk_bf16(f(acc[tm][tn][4 * q + 2]), f(acc[tm][tn][4 * q + 3]));
        *(uint2*)(d + 16 * q) = o;
      }
    }
}
template <class RF>
DI void copy_tile(const char* tile, RF dst, int nch) {
  const int t = tid_(), ch = t & 15, r0 = t >> 4;
  if (ch < nch) {
#pragma unroll
    for (int i = 0; i < 8; ++i) {
      const int row = r0 + 16 * i;
      const uint4 v = *(const uint4*)(tile + row * LDT + ch * 16);
      *(uint4*)(dst(row) + ch * 8) = v;
    }
  }
}

DI void transpose_tile(const TJob& j, int tile, char* smem) {
  const int t = tid_();
  const int tpb = (j.K >> 6) * j.tiles_n;
  const int bi = tile / tpb, rem = tile % tpb;
  const int kt = rem / j.tiles_n, ntile = rem % j.tiles_n;
  const int k0 = kt * 64, n0 = ntile * 64;
  const float* src = j.src + (size_t)bi * j.src_bstride;
  bf16_t* dst = j.dst + (size_t)bi * j.dst_bstride;
  bf16_t* T = (bf16_t*)smem;
  const int nn = t & 63, kq = t >> 6;
  const bool nvalid = (n0 + nn) < j.n_cnt;
  __syncthreads();
#pragma unroll 4
  for (int i = 0; i < 16; ++i) {
    const int kk = kq + 4 * i;
    float v = 0.f;
    if (nvalid) {
      v = src[(size_t)(k0 + kk) * j.ldS + j.n_off + n0 + nn];
      if (j.scale) v *= j.scale[k0 + kk];
    }
    T[nn * 66 + kk] = f2bf(v);
  }
  __syncthreads();
  const int n = t >> 2, part = t & 3;
  if (n0 + n < j.n_cnt) {
    const unsigned* tp = (const unsigned*)(T + n * 66 + part * 16);
    uint4 o0, o1;
    o0.x = tp[0]; o0.y = tp[1]; o0.z = tp[2]; o0.w = tp[3];
    o1.x = tp[4]; o1.y = tp[5]; o1.z = tp[6]; o1.w = tp[7];
    const int f = n0 + n;
    int drow;
    if (j.mode == 0) drow = j.dst_row0 + f;
    else drow = (f >> 6) * 128 + ((f & 63) >> 5) * 64 + (j.mode == 2 ? 32 : 0) + (f & 31);
    uint4* dp = (uint4*)(dst + (size_t)drow * j.K + k0 + part * 16);
    dp[0] = o0; dp[1] = o1;
  }
}

DI void mod_item(const Params& p, int it, char* smem) {
  const int t = tid_(), cgi = t & 63, kg = t >> 6;
  const int j0 = it * 64;
  float* Ssm = (float*)smem;
  float* red = (float*)(smem + 33 * 128 * 4);
  float acc[33];
#pragma unroll
  for (int r = 0; r < 33; ++r) acc[r] = 0.f;
  for (int kc = 0; kc < 8; ++kc) {
    __syncthreads();
    for (int idx = t; idx < 33 * 128; idx += 256) {
      const int r = idx >> 7, kk = idx & 127;
      float v = (r < 32) ? p.c[r * DM + kc * 128 + kk] : p.c_ctx[kc * 128 + kk];
      Ssm[idx] = v * sigmoidf_(v);
    }
    __syncthreads();
    for (int kk = 0; kk < 32; kk += 4) {
      const int k = kc * 128 + kg * 32 + kk;
      const float w0 = p.w_mod[(size_t)(k + 0) * 6144 + j0 + cgi];
      const float w1 = p.w_mod[(size_t)(k + 1) * 6144 + j0 + cgi];
      const float w2 = p.w_mod[(size_t)(k + 2) * 6144 + j0 + cgi];
      const float w3 = p.w_mod[(size_t)(k + 3) * 6144 + j0 + cgi];
#pragma unroll
      for (int r = 0; r < 33; ++r) {
        const float4 s = *(const float4*)(Ssm + r * 128 + kg * 32 + kk);
        acc[r] += s.x * w0 + s.y * w1 + s.z * w2 + s.w * w3;
      }
    }
  }
  __syncthreads();
#pragma unroll
  for (int r = 0; r < 33; ++r) red[(kg * 33 + r) * 64 + cgi] = acc[r];
  __syncthreads();
  for (int idx = t; idx < 33 * 64; idx += 256) {
    const int r = idx >> 6, cc = idx & 63;
    float s = red[(0 * 33 + r) * 64 + cc] + red[(1 * 33 + r) * 64 + cc] + red[(2 * 33 + r) * 64 + cc] + red[(3 * 33 + r) * 64 + cc];
    p.mod[r * 6144 + j0 + cc] = s + p.b_mod[j0 + cc];
  }
}

DI void phase0(const Params& p, char* smem) {
  const int t = tid_();
  const int nMod = 96;
  const int nPos = 256;
  const int nMisc = 3;
  const int nT = p.n_ttiles;
  const int total = nMod + nT + nPos + nMisc;
  float* ctab = (float*)(smem + 65536 - 8192 - 1024);
  for (int j = t; j < 2048; j += 256) ctab[j] = cospif((float)j * (1.f / 1024.f));
  __syncthreads();
  for (int it = blockIdx.x; it < total; it += gridDim.x) {
    if (it < nMod) { mod_item(p, it, smem); continue; }
    int u = it - nMod;
    if (u < nT) {
      int jb = 0;
#pragma unroll 1
      for (int q = 1; q < NJOBS; ++q) if (u >= p.jobs[q].tile_start) jb = q;
      transpose_tile(p.jobs[jb], u - p.jobs[jb].tile_start, smem);
      continue;
    }
    u -= nT;
    if (u < nPos) {
      for (int e = t; e < 8 * 512; e += 256) {
        const int k = u * 8 + (e >> 9), c8 = (e & 511) * 8;
        float v[8];
#pragma unroll
        for (int q = 0; q < 8; ++q) {
          const int tt = c8 + q;
          if (tt < 2048) v[q] = ctab[(k * tt) & 2047];
          else v[q] = -ctab[(k * (tt - 2048) - 512) & 2047];
        }
        uint4 o; o.x = pk_bf16(v[0], v[1]); o.y = pk_bf16(v[2], v[3]); o.z = pk_bf16(v[4], v[5]); o.w = pk_bf16(v[6], v[7]);
        *(uint4*)(p.posM + (size_t)k * 4096 + c8) = o;
      }
      continue;
    }
    u -= nPos;
    if (u == 0) {
      for (int e = t; e < 256 * 128; e += 256) {
        const int m2 = e >> 7, cc = e & 127, mm = m2 & 127;
        float v = (m2 < 128) ? ctab[(mm * cc * 16) & 2047] : ctab[(mm * cc * 16 - 512) & 2047];
        p.chanT[e] = f2bf(v);
      }
    } else if (u == 1) {
      for (int e = t; e < 64 * 8; e += 256) {
        const int pos = e >> 3, jf = e & 7;
        const float inv = 1.0f / powf(10000.0f, (float)jf / 8.0f);
        const float ang = (float)pos * inv;
        p.ropeTab[e * 2 + 0] = cosf(ang);
        p.ropeTab[e * 2 + 1] = sinf(ang);
      }
    } else {
      uint4 z; z.x = z.y = z.z = z.w = 0u;
      uint4* dp = (uint4*)(p.WinT + (size_t)N_IN * DM);
      for (int e = t; e < (NINP - N_IN) * DM / 8; e += 256) dp[e] = z;
    }
  }
}

DI void phase1(const Params& p) {
  const int t_ = tid_(); const int lane = t_ & 63, w = t_ >> 6;
  const int gw = blockIdx.x * 4 + w, nw = gridDim.x * 4;
  for (int R = gw; R < NT + NC; R += nw) {
    const float* src; const float* md;
    if (R < NT) { src = p.x + (size_t)R * DM; md = p.mod + (R >> 11) * 6144; }
    else { src = p.ctx + (size_t)(R - NT) * DM; md = p.mod + 32 * 6144; }
    float4 v[4]; float ss = 0.f;
#pragma unroll
    for (int i = 0; i < 4; ++i) { v[i] = *(const float4*)(src + lane * 4 + 256 * i); ss += v[i].x * v[i].x + v[i].y * v[i].y + v[i].z * v[i].z + v[i].w * v[i].w; }
    ss = wave_sum(ss);
    const float rr = rsqrtf(ss * (1.f / DM) + EPS);
#pragma unroll
    for (int i = 0; i < 4; ++i) {
      const int d = lane * 4 + 256 * i;
      const float4 g = *(const float4*)(p.norm1_g + d);
      const float4 sh = *(const float4*)(md + d);
      const float4 sc = *(const float4*)(md + 1024 + d);
      const float o0 = v[i].x * rr * g.x * (1.f + sc.x) + sh.x;
      const float o1 = v[i].y * rr * g.y * (1.f + sc.y) + sh.y;
      const float o2 = v[i].z * rr * g.z * (1.f + sc.z) + sh.z;
      const float o3 = v[i].w * rr * g.w * (1.f + sc.w) + sh.w;
      uint2 o; o.x = pk_bf16(o0, o1); o.y = pk_bf16(o2, o3);
      *(uint2*)(p.h + (size_t)R * DM + d) = o;
    }
  }
}

DI void phase2(const Params& p, char* smem) {
  const int t = tid_(), lane = t & 63, w = t >> 6, r = lane & 31, hh = lane >> 5;
  const int wm = w & 1, wn = w >> 1;
  const int xcd = blockIdx.x & 7, jl = blockIdx.x >> 3, nl = gridDim.x >> 3;
  for (int L = jl; L < 1664 + 24; L += nl) {
    int tokTile, ft; const bool lat = L < 1664;
    if (lat) { const int tg = L / 208, rem = L % 208; ft = rem >> 3; tokTile = xcd * 64 + tg * 8 + (rem & 7); }
    else { const int u = L - 1664; tokTile = 512 + xcd * 8 + u / 3; const int q = u % 3; ft = (q == 2) ? 25 : 3 + q; }
    f32x16 acc[2][2];
#pragma unroll
    for (int a = 0; a < 2; ++a)
#pragma unroll
      for (int b = 0; b < 2; ++b) acc[a][b] = zero16();
    const bf16_t* Ab = p.WinT + (size_t)ft * 128 * DM;
    const bf16_t* Bb = p.h + (size_t)tokTile * 128 * DM;
    float dummy = 0.f;
    gemm_core<2, 2, 2, 2, false>(acc, [&](int row) { return Ab + (size_t)row * DM; }, [&](int row) { return Bb + (size_t)row * DM; }, DM, smem, dummy);
    {
      bf16_t* base; int ld, nch = 16; bool sg = false;
      const int tok0 = tokTile * 128;
      if (lat) {
        if (ft < 5) { base = p.pqkv + (size_t)tok0 * LDQKV + ft * 128; ld = LDQKV; }
        else if (ft < 9) { base = p.pf + (size_t)tok0 * 512 + (ft - 5) * 128; ld = 512; }
        else if (ft < 25) { base = p.pg + (size_t)tok0 * 2048 + (ft - 9) * 128; ld = 2048; sg = true; }
        else { base = p.pqkv + (size_t)tok0 * LDQKV + 640; ld = LDQKV; nch = 4; }
      } else {
        const int ct0 = tok0 - NT;
        if (ft < 5) { base = p.pckv + (size_t)ct0 * LDCKV + (ft - 3) * 128; ld = LDCKV; }
        else { base = p.pckv + (size_t)ct0 * LDCKV + 256; ld = LDCKV; nch = 4; }
      }
      if (sg) stage_tile(acc, smem, [](float v) { return sigmoidf_(v); });
      else stage_tile(acc, smem, [](float v) { return v; });
      __syncthreads();
      copy_tile(smem, [&](int row) { return base + (size_t)row * ld; }, nch);
      __syncthreads();
    }
  }
}

DI void rope_pair(float& x1, float& x2, const float* tab) { const float c = tab[0], s = tab[1]; const float a = x1 * c - x2 * s, b = x2 * c + x1 * s; x1 = a; x2 = b; }

DI void phase3(const Params& p, char* smem) {
  const int t = tid_(), lane = t & 63, w = t >> 6, r = lane & 31, hh = lane >> 5;
  const int nKV = 576, nQ = 512, nCh = 512;
  const int xcd = blockIdx.x & 7, jl = blockIdx.x >> 3, nl = gridDim.x >> 3;
  for (int it = jl; it < nKV + nQ + nCh; it += nl) {
    if (it < nKV) {
      const int tl_ = it >> 3, hd = it & 7;
      const bool lat = tl_ < 64;
      const int tokTile = lat ? xcd * 64 + tl_ : 512 + xcd * 8 + (tl_ - 64);
      const bf16_t* Bb; int ldb; const bf16_t* kpeb;
      int b, key0;
      if (lat) { Bb = p.pqkv + (size_t)tokTile * 128 * LDQKV + QL; ldb = LDQKV; kpeb = p.pqkv + (size_t)tokTile * 128 * LDQKV + 640; b = tokTile >> 4; key0 = (tokTile & 15) * 128; }
      else { const int ct = tokTile - 512; Bb = p.pckv + (size_t)ct * 128 * LDCKV; ldb = LDCKV; kpeb = Bb + 256; b = ct >> 1; key0 = SEQ + (ct & 1) * 128; }
      const bf16_t* Ab = p.WkvT + (size_t)hd * 128 * KVL;
      f32x16 acc[4][1];
#pragma unroll
      for (int a = 0; a < 4; ++a) acc[a][0] = zero16();
      float sumsq = 0.f;
      gemm_core<4, 1, 1, 4, true>(acc, [&](int row) { return Ab + (size_t)row * KVL; }, [&](int row) { return Bb + (size_t)row * ldb; }, KVL, smem, sumsq);
      sumsq += __shfl_xor(sumsq, 32);
      const float ra = rsqrtf(sumsq * (1.f / KVL) + EPS);
      const int tl = w * 32 + r;
      const int key = key0 + tl;
      float kp[16];
#pragma unroll
      for (int q = 0; q < 4; ++q) {
        const uint2 u = *(const uint2*)(kpeb + (size_t)tl * ldb + 8 * q + 4 * hh);
        kp[4 * q + 0] = bf_lo(u.x); kp[4 * q + 1] = bf_hi(u.x); kp[4 * q + 2] = bf_lo(u.y); kp[4 * q + 3] = bf_hi(u.y);
      }
      float ss = 0.f;
#pragma unroll
      for (int tm = 0; tm < 4; ++tm)
#pragma unroll
        for (int i = 0; i < 16; ++i) { const float v = acc[tm][0][i] * ra; acc[tm][0][i] = v; if (tm < 2) ss += v * v; }
#pragma unroll
      for (int i = 0; i < 16; ++i) ss += kp[i] * kp[i];
      ss += __shfl_xor(ss, 32);
      const float rk = rsqrtf(ss * (1.f / QKD) + EPS);
#pragma unroll
      for (int i = 0; i < 16; ++i) kp[i] *= rk * p.k_norm_g[64 + crow(i, hh)];
      if (lat) {
        const int pos = key;
        const float* tr = p.ropeTab + ((pos >> 6) * 8 + 4 * hh) * 2;
        const float* tc = p.ropeTab + ((pos & 63) * 8 + 4 * hh) * 2;
#pragma unroll
        for (int i = 0; i < 4; ++i) { rope_pair(kp[i], kp[i + 4], tr + 2 * i); rope_pair(kp[8 + i], kp[12 + i], tc + 2 * i); }
      }
      bf16_t* Kd = p.K + ((size_t)(b * NH + hd) * NKEY + key) * QKD;
#pragma unroll
      for (int tm = 0; tm < 2; ++tm)
#pragma unroll
        for (int q = 0; q < 4; ++q) {
          const int f = tm * 32 + 8 * q + 4 * hh;
          const float4 g = *(const float4*)(p.k_norm_g + f);
          uint2 o; o.x = pk_bf16(acc[tm][0][4 * q] * rk * g.x, acc[tm][0][4 * q + 1] * rk * g.y); o.y = pk_bf16(acc[tm][0][4 * q + 2] * rk * g.z, acc[tm][0][4 * q + 3] * rk * g.w);
          *(uint2*)(Kd + f) = o;
        }
#pragma unroll
      for (int q = 0; q < 4; ++q) {
        uint2 o; o.x = pk_bf16(kp[4 * q], kp[4 * q + 1]); o.y = pk_bf16(kp[4 * q + 2], kp[4 * q + 3]);
        *(uint2*)(Kd + 64 + 8 * q + 4 * hh) = o;
      }
      bf16_t* Vd = p.Vt + (size_t)(b * NH + hd) * VD * NKEY + key;
#pragma unroll
      for (int tm = 2; tm < 4; ++tm)
#pragma unroll
        for (int i = 0; i < 16; ++i) Vd[(size_t)((tm - 2) * 32 + crow(i, hh)) * NKEY] = f2bf(acc[tm][0][i]);
    } else if (it < nKV + nQ) {
      const int u = it - nKV;
      const int tokTile = xcd * 64 + (u >> 3), hd = u & 7;
      const bf16_t* Bb = p.pqkv + (size_t)tokTile * 128 * LDQKV;
      const bf16_t* Ab = p.WqT + (size_t)hd * QKD * QL;
      f32x16 acc[3][1];
#pragma unroll
      for (int a = 0; a < 3; ++a) acc[a][0] = zero16();
      float sumsq = 0.f;
      gemm_core<3, 1, 1, 4, true>(acc, [&](int row) { return Ab + (size_t)row * QL; }, [&](int row) { return Bb + (size_t)row * LDQKV; }, QL, smem, sumsq);
      sumsq += __shfl_xor(sumsq, 32);
      const float ra = rsqrtf(sumsq * (1.f / QL) + EPS);
      const int tl = w * 32 + r;
      const int b = tokTile >> 4, pos = (tokTile & 15) * 128 + tl;
      float ss = 0.f;
#pragma unroll
      for (int tm = 0; tm < 3; ++tm)
#pragma unroll
        for (int i = 0; i < 16; ++i) { const float v = acc[tm][0][i] * ra; acc[tm][0][i] = v; ss += v * v; }
      ss += __shfl_xor(ss, 32);
      const float rh = rsqrtf(ss * (1.f / QKD) + EPS);
#pragma unroll
      for (int tm = 0; tm < 3; ++tm)
#pragma unroll
        for (int q = 0; q < 4; ++q) {
          const float4 g = *(const float4*)(p.q_norm_g + tm * 32 + 8 * q + 4 * hh);
          acc[tm][0][4 * q] *= rh * g.x; acc[tm][0][4 * q + 1] *= rh * g.y; acc[tm][0][4 * q + 2] *= rh * g.z; acc[tm][0][4 * q + 3] *= rh * g.w;
        }
      {
        const float* tr = p.ropeTab + ((pos >> 6) * 8 + 4 * hh) * 2;
        const float* tc = p.ropeTab + ((pos & 63) * 8 + 4 * hh) * 2;
#pragma unroll
        for (int i = 0; i < 4; ++i) {
          float a0 = acc[2][0][i], a1 = acc[2][0][i + 4], c0 = acc[2][0][8 + i], c1 = acc[2][0][12 + i];
          rope_pair(a0, a1, tr + 2 * i); rope_pair(c0, c1, tc + 2 * i);
          acc[2][0][i] = a0; acc[2][0][i + 4] = a1; acc[2][0][8 + i] = c0; acc[2][0][12 + i] = c1;
        }
      }
      const float qs = 0.10206207261596575f * 1.4426950408889634f;
      bf16_t* Qd = p.Q + ((size_t)(b * NH + hd) * SEQ + pos) * QKD;
#pragma unroll
      for (int tm = 0; tm < 3; ++tm)
#pragma unroll
        for (int q = 0; q < 4; ++q) {
          uint2 o; o.x = pk_bf16(acc[tm][0][4 * q] * qs, acc[tm][0][4 * q + 1] * qs); o.y = pk_bf16(acc[tm][0][4 * q + 2] * qs, acc[tm][0][4 * q + 3] * qs);
          *(uint2*)(Qd + tm * 32 + 8 * q + 4 * hh) = o;
        }
    } else {
      const int u = it - nKV - nQ;
      const int ft = u & 1, tt = (u >> 1) & 15, g = (u >> 5) & 3, b = xcd * 4 + (u >> 7);
      const int wm = w & 1, wn = w >> 1;
      const bf16_t* Ab = p.chanT + (size_t)ft * 128 * 128;
      const bf16_t* Bb = p.pf + (size_t)(b * SEQ + tt * 128) * 512 + g * 128;
      f32x16 acc[2][2];
#pragma unroll
      for (int a = 0; a < 2; ++a)
#pragma unroll
        for (int c = 0; c < 2; ++c) acc[a][c] = zero16();
      float dummy = 0.f;
      gemm_core<2, 2, 2, 2, false>(acc, [&](int row) { return Ab + (size_t)row * 128; }, [&](int row) { return Bb + (size_t)row * 512; }, 128, smem, dummy);
#pragma unroll
      for (int tm = 0; tm < 2; ++tm)
#pragma unroll
        for (int tn = 0; tn < 2; ++tn) {
          const int tpos = tt * 128 + wn * 64 + tn * 32 + r;
#pragma unroll
          for (int i = 0; i < 16; ++i) {
            const int mm = wm * 64 + tm * 32 + crow(i, hh);
            p.ABt[((size_t)(b * 512 + g * 128 + mm)) * 4096 + ft * 2048 + tpos] = f2bf(acc[tm][tn][i]);
          }
        }
    }
  }
}

DI void attn_item(const Params& p, int it, char* smem) {
  const int t = tid_(), lane = t & 63, w = t >> 6, r = lane & 31, hh = lane >> 5;
  const int qt = it & 15, bh = it >> 4;
  constexpr int KROW = 208, VROW = 136, KBYTES = 64 * KROW, STAGE = KBYTES + 64 * VROW;
  const bf16_t* Kb = p.K + (size_t)bh * NKEY * QKD;
  const bf16_t* Vb = p.Vt + (size_t)bh * VD * NKEY;
  const int qpos = qt * 128 + w * 32 + r;
  const bf16_t* Qp = p.Q + ((size_t)bh * SEQ + qpos) * QKD + hh * 8;
  bf16x8 qf[6];
#pragma unroll
  for (int c = 0; c < 6; ++c) qf[c] = *(const bf16x8*)(Qp + c * 16);
  f32x16 o[2]; o[0] = zero16(); o[1] = zero16();
  float mrun = -INFINITY, lrun = 0.f;
  const int kid0 = t, kid1 = t + 256, kid2 = t + 512;
  const int kgo0 = (kid0 / 12) * QKD + (kid0 % 12) * 8, kgo1 = (kid1 / 12) * QKD + (kid1 % 12) * 8, kgo2 = (kid2 / 12) * QKD + (kid2 % 12) * 8;
  const int klo0 = (kid0 / 12) * KROW + (kid0 % 12) * 16, klo1 = (kid1 / 12) * KROW + (kid1 % 12) * 16, klo2 = (kid2 / 12) * KROW + (kid2 % 12) * 16;
  const int vid0 = t, vid1 = t + 256;
  const int vgo0 = (vid0 >> 3) * NKEY + (vid0 & 7) * 8, vgo1 = (vid1 >> 3) * NKEY + (vid1 & 7) * 8;
  const int vlo0 = KBYTES + (vid0 >> 3) * VROW + (vid0 & 7) * 16, vlo1 = KBYTES + (vid1 >> 3) * VROW + (vid1 & 7) * 16;
  uint4 rk0, rk1, rk2, rv0, rv1;
  rk0 = *(const uint4*)(Kb + kgo0); rk1 = *(const uint4*)(Kb + kgo1); rk2 = *(const uint4*)(Kb + kgo2);
  rv0 = *(const uint4*)(Vb + vgo0); rv1 = *(const uint4*)(Vb + vgo1);
  __builtin_amdgcn_sched_barrier(0);
#define ATT_STORE(base) do { \
    *(uint4*)((base) + klo0) = rk0; *(uint4*)((base) + klo1) = rk1; *(uint4*)((base) + klo2) = rk2; \
    { uint2* d = (uint2*)((base) + vlo0); d[0] = make_uint2(rv0.x, rv0.y); d[1] = make_uint2(rv0.z, rv0.w); } \
    { uint2* d = (uint2*)((base) + vlo1); d[0] = make_uint2(rv1.x, rv1.y); d[1] = make_uint2(rv1.z, rv1.w); } } while (0)
  ATT_STORE(smem);
  __syncthreads();
  constexpr int NKT = NKEY / 64;
  for (int kt = 0; kt < NKT; ++kt) {
    const char* cur = smem + (kt & 1) * STAGE;
    const bool more = kt + 1 < NKT;
    if (more) {
      const bf16_t* kn = Kb + (size_t)(kt + 1) * 64 * QKD; const bf16_t* vn = Vb + (kt + 1) * 64;
      rk0 = *(const uint4*)(kn + kgo0); rk1 = *(const uint4*)(kn + kgo1); rk2 = *(const uint4*)(kn + kgo2);
      rv0 = *(const uint4*)(vn + vgo0); rv1 = *(const uint4*)(vn + vgo1);
    }
    __builtin_amdgcn_sched_barrier(0);
    f32x16 s[2];
#pragma unroll
    for (int t2 = 0; t2 < 2; ++t2) {
      s[t2] = zero16();
      const char* kp = cur + (t2 * 32 + r) * KROW + hh * 16;
#pragma unroll
      for (int c = 0; c < 6; ++c) { const bf16x8 kf = *(const bf16x8*)(kp + c * 32); s[t2] = MFMA(kf, qf[c], s[t2]); }
    }
    __builtin_amdgcn_sched_barrier(0);
    float mx = s[0][0];
#pragma unroll
    for (int i = 0; i < 16; ++i) { mx = fmaxf(mx, s[0][i]); mx = fmaxf(mx, s[1][i]); }
    mx = fmaxf(mx, __shfl_xor(mx, 32));
    const float mnew = fmaxf(mrun, mx);
    const float alpha = __builtin_amdgcn_exp2f(mrun - mnew);
    mrun = mnew;
    float ls = 0.f;
#pragma unroll
    for (int t2 = 0; t2 < 2; ++t2)
#pragma unroll
      for (int i = 0; i < 16; ++i) { const float e = __builtin_amdgcn_exp2f(s[t2][i] - mnew); s[t2][i] = e; ls += e; }
    lrun = lrun * alpha + ls;
#pragma unroll
    for (int i = 0; i < 16; ++i) { o[0][i] *= alpha; o[1][i] *= alpha; }
    __builtin_amdgcn_sched_barrier(0);
#pragma unroll
    for (int t2 = 0; t2 < 2; ++t2)
#pragma unroll
      for (int s2 = 0; s2 < 2; ++s2) {
        uint4 pu;
        pu.x = pk_bf16(s[t2][8 * s2 + 0], s[t2][8 * s2 + 1]); pu.y = pk_bf16(s[t2][8 * s2 + 2], s[t2][8 * s2 + 3]);
        pu.z = pk_bf16(s[t2][8 * s2 + 4], s[t2][8 * s2 + 5]); pu.w = pk_bf16(s[t2][8 * s2 + 6], s[t2][8 * s2 + 7]);
        const bf16x8 pb = __builtin_bit_cast(bf16x8, pu);
#pragma unroll
        for (int vt = 0; vt < 2; ++vt) {
          const char* vp = cur + KBYTES + (vt * 32 + r) * VROW + (t2 * 32 + 16 * s2 + 4 * hh) * 2;
          const uint2 lo = *(const uint2*)(vp), hi = *(const uint2*)(vp + 16);
          uint4 vu; vu.x = lo.x; vu.y = lo.y; vu.z = hi.x; vu.w = hi.y;
          o[vt] = MFMA(__builtin_bit_cast(bf16x8, vu), pb, o[vt]);
        }
      }
    __builtin_amdgcn_sched_barrier(0);
    if (more) { char* nxt = smem + ((kt + 1) & 1) * STAGE; ATT_STORE(nxt); }
    __syncthreads();
  }
  lrun += __shfl_xor(lrun, 32);
  const float inv = 1.f / lrun;
  const int b = bh >> 3, hd = bh & 7;
  bf16_t* od = p.attn_o + (size_t)(b * SEQ + qpos) * 512 + hd * 64;
#pragma unroll
  for (int vt = 0; vt < 2; ++vt)
#pragma unroll
    for (int q = 0; q < 4; ++q) {
      uint2 ou; ou.x = pk_bf16(o[vt][4 * q] * inv, o[vt][4 * q + 1] * inv); ou.y = pk_bf16(o[vt][4 * q + 2] * inv, o[vt][4 * q + 3] * inv);
      *(uint2*)(od + vt * 32 + 8 * q + 4 * hh) = ou;
    }
}

DI void phase4(const Params& p, char* smem) {
  const int t = tid_(), lane = t & 63, w = t >> 6, r = lane & 31, hh = lane >> 5;
  const int nDft = 256, nAtt = 512;
  const int xcd = blockIdx.x & 7, jl = blockIdx.x >> 3, nl = gridDim.x >> 3;
  for (int it = jl; it < nDft + nAtt; it += nl) {
    if (it < nDft) {
      const int kt = it & 15, ct = (it >> 4) & 3, b = xcd * 4 + (it >> 6);
      const int wm = w & 1, wn = w >> 1;
      const bf16_t* Ab = p.ABt + (size_t)(b * 512 + ct * 128) * 4096;
      const bf16_t* Bb = p.posM + (size_t)kt * 128 * 4096;
      f32x16 acc[2][2];
#pragma unroll
      for (int a = 0; a < 2; ++a)
#pragma unroll
        for (int c = 0; c < 2; ++c) acc[a][c] = zero16();
      float dummy = 0.f;
      gemm_core<2, 2, 2, 2, false>(acc, [&](int row) { return Ab + (size_t)row * 4096; }, [&](int row) { return Bb + (size_t)row * 4096; }, 4096, smem, dummy);
      const float sc = 1.f / 512.f;
#pragma unroll
      for (int tm = 0; tm < 2; ++tm)
#pragma unroll
        for (int tn = 0; tn < 2; ++tn) {
          const int kpos = kt * 128 + wn * 64 + tn * 32 + r;
          bf16_t* d = p.four_o + (size_t)(b * SEQ + kpos) * 512 + ct * 128 + wm * 64 + tm * 32 + 4 * hh;
#pragma unroll
          for (int q = 0; q < 4; ++q) {
            uint2 ou; ou.x = pk_bf16(acc[tm][tn][4 * q] * sc, acc[tm][tn][4 * q + 1] * sc); ou.y = pk_bf16(acc[tm][tn][4 * q + 2] * sc, acc[tm][tn][4 * q + 3] * sc);
            *(uint2*)(d + 8 * q) = ou;
          }
        }
    } else {
      attn_item(p, xcd * 512 + (it - nDft), smem);
    }
  }
}

DI void phase5(const Params& p, char* smem) {
  const int t = tid_(), lane = t & 63, w = t >> 6, r = lane & 31, hh = lane >> 5;
  const int wm = w & 1, wn = w >> 1;
  const int xcd = blockIdx.x & 7, jl = blockIdx.x >> 3, nl = gridDim.x >> 3;
  for (int L = jl; L < 512; L += nl) {
    const int tokTile = xcd * 64 + (L >> 6) * 8 + (L & 7), nt = (L >> 3) & 7;
    f32x16 acc1[2][2], acc2[2][2];
#pragma unroll
    for (int a = 0; a < 2; ++a)
#pragma unroll
      for (int c = 0; c < 2; ++c) { acc1[a][c] = zero16(); acc2[a][c] = zero16(); }
    float dummy = 0.f;
    {
      const bf16_t* Ab = p.WoT + (size_t)nt * 128 * 512; const bf16_t* Bb = p.attn_o + (size_t)tokTile * 128 * 512;
      gemm_core<2, 2, 2, 2, false>(acc1, [&](int row) { return Ab + (size_t)row * 512; }, [&](int row) { return Bb + (size_t)row * 512; }, 512, smem, dummy);
    }
    {
      const bf16_t* Ab = p.WfT + (size_t)nt * 128 * 512; const bf16_t* Bb = p.four_o + (size_t)tokTile * 128 * 512;
      gemm_core<2, 2, 2, 2, false>(acc2, [&](int row) { return Ab + (size_t)row * 512; }, [&](int row) { return Bb + (size_t)row * 512; }, 512, smem, dummy);
    }
    {
      char* t1 = smem; char* t2 = smem + 128 * LDT;
      stage_tile(acc1, t1, [](float v) { return v; });
      stage_tile(acc2, t2, [](float v) { return v; });
      __syncthreads();
      const int ch = t & 15, r0 = t >> 4;
#pragma unroll
      for (int i = 0; i < 8; ++i) {
        const int row = r0 + 16 * i;
        const size_t tok = (size_t)tokTile * 128 + row;
        const uint4 u1 = *(const uint4*)(t1 + row * LDT + ch * 16), u2 = *(const uint4*)(t2 + row * LDT + ch * 16);
        const uint4 ga = *(const uint4*)(p.pg + tok * 2048 + nt * 128 + ch * 8), gb = *(const uint4*)(p.pg + tok * 2048 + 1024 + nt * 128 + ch * 8);
        uint4 o;
        o.x = pk_bf16(bf_lo(ga.x) * bf_lo(u1.x) + bf_lo(gb.x) * bf_lo(u2.x), bf_hi(ga.x) * bf_hi(u1.x) + bf_hi(gb.x) * bf_hi(u2.x));
        o.y = pk_bf16(bf_lo(ga.y) * bf_lo(u1.y) + bf_lo(gb.y) * bf_lo(u2.y), bf_hi(ga.y) * bf_hi(u1.y) + bf_hi(gb.y) * bf_hi(u2.y));
        o.z = pk_bf16(bf_lo(ga.z) * bf_lo(u1.z) + bf_lo(gb.z) * bf_lo(u2.z), bf_hi(ga.z) * bf_hi(u1.z) + bf_hi(gb.z) * bf_hi(u2.z));
        o.w = pk_bf16(bf_lo(ga.w) * bf_lo(u1.w) + bf_lo(gb.w) * bf_lo(u2.w), bf_hi(ga.w) * bf_hi(u1.w) + bf_hi(gb.w) * bf_hi(u2.w));
        *(uint4*)(p.m + tok * DM + nt * 128 + ch * 8) = o;
      }
      __syncthreads();
    }
  }
}

DI void phase6(const Params& p, char* smem) {
  const int t = tid_(), lane = t & 63, w = t >> 6, r = lane & 31, hh = lane >> 5;
  const int wm = w & 1, wn = w >> 1;
  const int xcd = blockIdx.x & 7, jl = blockIdx.x >> 3, nl = gridDim.x >> 3;
  for (int L = jl; L < 512; L += nl) {
    const int tokTile = xcd * 64 + (L >> 6) * 8 + (L & 7), nt = (L >> 3) & 7;
    f32x16 acc[2][2];
#pragma unroll
    for (int a = 0; a < 2; ++a)
#pragma unroll
      for (int c = 0; c < 2; ++c) acc[a][c] = zero16();
    float dummy = 0.f;
    const bf16_t* Wb = p.WoutT + (size_t)nt * 128 * DM; const bf16_t* Mb = p.m + (size_t)tokTile * 128 * DM;
    gemm_core<2, 2, 2, 2, false>(acc, [&](int row) { return Mb + (size_t)row * DM; }, [&](int row) { return Wb + (size_t)row * DM; }, DM, smem, dummy);
    const float* g1 = p.mod + (tokTile >> 4) * 6144 + 2048;
#pragma unroll
    for (int tn = 0; tn < 2; ++tn) {
      const int n = nt * 128 + wn * 64 + tn * 32 + r;
      const float g = g1[n];
#pragma unroll
      for (int tm = 0; tm < 2; ++tm)
#pragma unroll
        for (int i = 0; i < 16; ++i) {
          const size_t o = ((size_t)tokTile * 128 + wm * 64 + tm * 32 + crow(i, hh)) * DM + n;
          p.out[o] = p.x[o] + g * acc[tm][tn][i];
        }
    }
  }
}

DI void phase7(const Params& p, char* smem) {
  const int t = tid_(), lane = t & 63, w = t >> 6;
  float* wr = (float*)smem;
  for (int idx = t; idx < DM * NE; idx += 256) { const int d = idx >> 4, e = idx & 15; wr[e * DM + d] = p.w_router[idx]; }
  __syncthreads();
  const int gw = blockIdx.x * 4 + w, nw = gridDim.x * 4;
  for (int R = gw; R < NT; R += nw) {
    asm volatile("" ::: "memory");
    const float* src = p.out + (size_t)R * DM;
    const int b = R >> 11;
    const float* md = p.mod + b * 6144;
    float4 v[4]; float ss = 0.f;
#pragma unroll
    for (int i = 0; i < 4; ++i) { v[i] = *(const float4*)(src + lane * 4 + 256 * i); ss += v[i].x * v[i].x + v[i].y * v[i].y + v[i].z * v[i].z + v[i].w * v[i].w; }
    ss = wave_sum(ss);
    const float rr = rsqrtf(ss * (1.f / DM) + EPS);
#pragma unroll
    for (int i = 0; i < 4; ++i) {
      const int d = lane * 4 + 256 * i;
      const float4 g = *(const float4*)(p.norm2_g + d);
      const float4 sh = *(const float4*)(md + 3072 + d);
      const float4 sc = *(const float4*)(md + 4096 + d);
      v[i].x = v[i].x * rr * g.x * (1.f + sc.x) + sh.x;
      v[i].y = v[i].y * rr * g.y * (1.f + sc.y) + sh.y;
      v[i].z = v[i].z * rr * g.z * (1.f + sc.z) + sh.z;
      v[i].w = v[i].w * rr * g.w * (1.f + sc.w) + sh.w;
      uint2 o; o.x = pk_bf16(v[i].x, v[i].y); o.y = pk_bf16(v[i].z, v[i].w);
      *(uint2*)(p.h2 + (size_t)R * DM + d) = o;
    }
    float a[16];
#pragma unroll
    for (int e = 0; e < 16; ++e) {
      float s = 0.f;
#pragma unroll
      for (int i = 0; i < 4; ++i) { const float4 wv = *(const float4*)(wr + e * DM + lane * 4 + 256 * i); s += v[i].x * wv.x + v[i].y * wv.y + v[i].z * wv.z + v[i].w * wv.w; }
      a[e] = s;
      if ((e & 3) == 3) __builtin_amdgcn_sched_barrier(0);
    }
    float a8[8], a4[4], a2[2], a1;
    {
      const bool up = lane & 32;
#pragma unroll
      for (int j = 0; j < 8; ++j) { const float send = up ? a[j] : a[j + 8]; const float keep = up ? a[j + 8] : a[j]; a8[j] = keep + __shfl_xor(send, 32); }
    }
    {
      const bool up = lane & 16;
#pragma unroll
      for (int j = 0; j < 4; ++j) { const float send = up ? a8[j] : a8[j + 4]; const float keep = up ? a8[j + 4] : a8[j]; a4[j] = keep + __shfl_xor(send, 16); }
    }
    {
      const bool up = lane & 8;
#pragma unroll
      for (int j = 0; j < 2; ++j) { const float send = up ? a4[j] : a4[j + 2]; const float keep = up ? a4[j + 2] : a4[j]; a2[j] = keep + __shfl_xor(send, 8); }
    }
    {
      const bool up = lane & 4;
      const float send = up ? a2[0] : a2[1]; const float keep = up ? a2[1] : a2[0]; a1 = keep + __shfl_xor(send, 4);
    }
    a1 += __shfl_xor(a1, 2);
    a1 += __shfl_xor(a1, 1);
    float mx = a1;
#pragma unroll
    for (int o = 4; o <= 32; o <<= 1) mx = fmaxf(mx, __shfl_xor(mx, o));
    const float ex = __expf(a1 - mx);
    float sm = ex;
#pragma unroll
    for (int o = 4; o <= 32; o <<= 1) sm += __shfl_xor(sm, o);
    if ((lane & 3) == 0) {
      const int e = (lane >> 2) & 15;
      p.aff[((size_t)(b * NE + e)) * SEQ + (R & 2047)] = ex / sm;
    }
  }
}

DI void phase8(const Params& p) {
  const int t_ = tid_(); const int lane = t_ & 63, w = t_ >> 6;
  const int gw = blockIdx.x * 4 + w, nw = gridDim.x * 4;
  for (int pr = gw; pr < NB * NE; pr += nw) {
    const float* a = p.aff + (size_t)pr * SEQ;
    unsigned u[32];
#pragma unroll
    for (int q = 0; q < 32; ++q) u[q] = __float_as_uint(a[q * 64 + lane]);
    unsigned thr = 0;
    for (int bit = 30; bit >= 0; --bit) {
      const unsigned cand = thr | (1u << bit);
      int cnt = 0;
#pragma unroll
      for (int q = 0; q < 32; ++q) cnt += __popcll(__ballot(u[q] >= cand));
      if (cnt >= CAP) thr = cand;
    }
    int ngt = 0;
#pragma unroll
    for (int q = 0; q < 32; ++q) ngt += __popcll(__ballot(u[q] > thr));
    int cgt = 0, ceq = 0;
    int* io = p.idx + pr * CAP; float* go = p.gate + pr * CAP;
    int* iv = p.inv + (size_t)pr * SEQ;
#pragma unroll
    for (int q = 0; q < 32; ++q) {
      const bool gt = u[q] > thr, eq = u[q] == thr;
      const unsigned long long mg = __ballot(gt), me = __ballot(eq);
      const unsigned long long below = (1ull << lane) - 1ull;
      int myslot = -1;
      if (gt) { const int s = cgt + __popcll(mg & below); io[s] = q * 64 + lane; go[s] = __uint_as_float(u[q]); myslot = s; }
      if (eq) { const int s = ngt + ceq + __popcll(me & below); if (s < CAP) { io[s] = q * 64 + lane; go[s] = __uint_as_float(u[q]); myslot = s; } }
      iv[q * 64 + lane] = myslot;
      cgt += __popcll(mg); ceq += __popcll(me);
    }
  }
}

DI void phase9(const Params& p, char* smem) {
  const int t = tid_(), lane = t & 63, w = t >> 6, r = lane & 31, hh = lane >> 5;
  const int wm = w & 1, wn = w >> 1;
  const int xcd = blockIdx.x & 7, jl = blockIdx.x >> 3, nl = gridDim.x >> 3;
  for (int L = jl; L < 1024; L += nl) {
    const int e = xcd * 2 + (L >> 9), rem = L & 511, ft = (rem >> 3) & 7, st = rem & 1, b = (rem >> 6) * 4 + ((rem & 7) >> 1);
    const int be = b * NE + e;
    const bf16_t* Ab = p.WguT + ((size_t)e * 1024 + ft * 128) * DM;
    const int* ib = p.idx + be * CAP + st * 128;
    const bf16_t* hb = p.h2 + (size_t)b * SEQ * DM;
    f32x16 acc[2][2];
#pragma unroll
    for (int a = 0; a < 2; ++a)
#pragma unroll
      for (int c = 0; c < 2; ++c) acc[a][c] = zero16();
    float dummy = 0.f;
    gemm_core<2, 2, 2, 2, false>(acc, [&](int row) { return Ab + (size_t)row * DM; }, [&](int row) { return hb + (size_t)ib[row] * DM; }, DM, smem, dummy);
    {
#pragma unroll
      for (int tn = 0; tn < 2; ++tn) {
        char* d = smem + (wn * 64 + tn * 32 + r) * 144 + (wm * 32 + 4 * hh) * 2;
#pragma unroll
        for (int q = 0; q < 4; ++q) {
          float v[4];
#pragma unroll
          for (int j = 0; j < 4; ++j) { const float g = acc[0][tn][4 * q + j], uu = acc[1][tn][4 * q + j]; v[j] = g * sigmoidf_(g) * uu; }
          uint2 ou; ou.x = pk_bf16(v[0], v[1]); ou.y = pk_bf16(v[2], v[3]);
          *(uint2*)(d + 16 * q) = ou;
        }
      }
      __syncthreads();
      const int ch = t & 7, r0 = t >> 3;
#pragma unroll
      for (int i = 0; i < 4; ++i) {
        const int row = r0 + 32 * i;
        const uint4 v = *(const uint4*)(smem + row * 144 + ch * 16);
        *(uint4*)(p.hmid + ((size_t)be * CAP + st * 128 + row) * DE + ft * 64 + ch * 8) = v;
      }
      __syncthreads();
    }
  }
}

DI void phase10(const Params& p, char* smem) {
  const int t = tid_(), lane = t & 63, w = t >> 6, r = lane & 31, hh = lane >> 5;
  const int wm = w & 1, wn = w >> 1;
  const int xcd = blockIdx.x & 7, jl = blockIdx.x >> 3, nl = gridDim.x >> 3;
  for (int L = jl; L < 1024; L += nl) {
    const int e = xcd * 2 + (L >> 9), rem = L & 511, nt = (rem >> 3) & 7, st = rem & 1, b = (rem >> 6) * 4 + ((rem & 7) >> 1);
    const int be = b * NE + e;
    const bf16_t* Hb = p.hmid + ((size_t)be * CAP + st * 128) * DE;
    const bf16_t* Wb = p.WdT + ((size_t)e * DM + nt * 128) * DE;
    f32x16 acc[2][2];
#pragma unroll
    for (int a = 0; a < 2; ++a)
#pragma unroll
      for (int c = 0; c < 2; ++c) acc[a][c] = zero16();
    float dummy = 0.f;
    gemm_core<2, 2, 2, 2, false>(acc, [&](int row) { return Wb + (size_t)row * DE; }, [&](int row) { return Hb + (size_t)row * DE; }, DE, smem, dummy);
    stage_tile(acc, smem, [](float v) { return v; });
    __syncthreads();
    bf16_t* yb = p.Y + ((size_t)be * CAP + st * 128) * DM + nt * 128;
    copy_tile(smem, [&](int row) { return yb + (size_t)row * DM; }, 16);
    __syncthreads();
  }
}

DI void phase11(const Params& p) {
  const int t_ = tid_(); const int lane = t_ & 63, w = t_ >> 6;
  const int gw = blockIdx.x * 4 + w, nw = gridDim.x * 4;
  for (int R = gw; R < NT; R += nw) {
    const int b = R >> 11, tq = R & 2047;
    const int myslot = (lane < NE) ? p.inv[((size_t)(b * NE + lane)) * SEQ + tq] : -1;
    unsigned long long mask = __ballot(myslot >= 0);
    if (mask == 0ull) continue;
    float4 a[4];
#pragma unroll
    for (int i = 0; i < 4; ++i) a[i] = make_float4(0.f, 0.f, 0.f, 0.f);
    while (mask) {
      const int e = __ffsll((long long)mask) - 1; mask &= mask - 1ull;
      const int slot = __shfl(myslot, e);
      const float g = p.gate[(b * NE + e) * CAP + slot];
      const bf16_t* y = p.Y + ((size_t)(b * NE + e) * CAP + slot) * DM + lane * 4;
#pragma unroll
      for (int i = 0; i < 4; ++i) {
        const uint2 u = *(const uint2*)(y + 256 * i);
        a[i].x += g * bf_lo(u.x); a[i].y += g * bf_hi(u.x); a[i].z += g * bf_lo(u.y); a[i].w += g * bf_hi(u.y);
      }
    }
    const float* g2 = p.mod + b * 6144 + 5120;
    float* o = p.out + (size_t)R * DM;
#pragma unroll
    for (int i = 0; i < 4; ++i) {
      const int d = lane * 4 + 256 * i;
      const float4 gv = *(const float4*)(g2 + d);
      float4 xv = *(float4*)(o + d);
      xv.x += gv.x * a[i].x; xv.y += gv.y * a[i].y; xv.z += gv.z * a[i].z; xv.w += gv.w * a[i].w;
      *(float4*)(o + d) = xv;
    }
  }
}

__global__ void __launch_bounds__(256, 2) mega_kernel(Params p) {
  cg::grid_group grid = cg::this_grid();
  __shared__ __attribute__((aligned(16))) char smem[SMEM_BYTES];
#ifndef REPMASK
#define REPMASK 0
#endif
#define RUNPH(k, call) for (int rep_ = 0; rep_ < (((REPMASK) >> (k)) & 1) + 1; ++rep_) { call; grid.sync(); }
  RUNPH(0, phase0(p, smem))
  RUNPH(1, phase1(p))
  RUNPH(2, phase2(p, smem))
  RUNPH(3, phase3(p, smem))
  RUNPH(4, phase4(p, smem))
  RUNPH(5, phase5(p, smem))
  RUNPH(6, phase6(p, smem))
  RUNPH(7, phase7(p, smem))
  RUNPH(8, phase8(p))
  RUNPH(9, phase9(p, smem))
  phase10(p, smem);
  grid.sync();
  phase11(p);
}

static inline size_t align_up(size_t v, size_t a) { return (v + a - 1) / a * a; }

extern "C" void kernel_launch(void* const* d_in, const int* in_sizes, int n_in,
                              void* d_out, int out_size, void* d_ws, size_t ws_size,
                              hipStream_t stream) {
  static int grid_blocks = 0;
  if (!grid_blocks) {
    int dev = 0, cus = 0, per_cu = 0;
    (void)hipGetDevice(&dev);
    (void)hipDeviceGetAttribute(&cus, hipDeviceAttributeMultiprocessorCount, dev);
    (void)hipOccupancyMaxActiveBlocksPerMultiprocessor(&per_cu, mega_kernel, 256, 0);
    if (per_cu > 2) per_cu = 2;
    if (per_cu < 1) per_cu = 1;
    grid_blocks = (cus * per_cu) & ~7;
    if (grid_blocks < 8) grid_blocks = 8;
  }
  Params p;
  memset(&p, 0, sizeof(p));
  const float* x = (const float*)d_in[0];
  p.x = x; p.c = (const float*)d_in[1]; p.ctx = (const float*)d_in[2]; p.c_ctx = (const float*)d_in[3];
  p.w_mod = (const float*)d_in[4]; p.b_mod = (const float*)d_in[5]; p.norm1_g = (const float*)d_in[6];
  const float* w_in = (const float*)d_in[7];
  const float* q_a_g = (const float*)d_in[8];
  const float* kv_a_g = (const float*)d_in[9];
  const float* w_q_up = (const float*)d_in[10];
  const float* w_kv_up = (const float*)d_in[11];
  p.q_norm_g = (const float*)d_in[12]; p.k_norm_g = (const float*)d_in[13];
  const float* w_o_attn = (const float*)d_in[14];
  const float* w_fourier = (const float*)d_in[15];
  const float* w_out = (const float*)d_in[16];
  p.norm2_g = (const float*)d_in[17]; p.w_router = (const float*)d_in[18];
  const float* w_e_gate = (const float*)d_in[19];
  const float* w_e_up = (const float*)d_in[20];
  const float* w_e_down = (const float*)d_in[21];
  p.out = (float*)d_out;

  char* base = (char*)d_ws; size_t off = 0;
  auto alloc = [&](size_t bytes) { char* q = base + off; off = align_up(off + bytes, 256); return q; };
  p.WinT = (bf16_t*)alloc((size_t)NINP * DM * 2);
  p.WqT = (bf16_t*)alloc((size_t)768 * QL * 2);
  p.WkvT = (bf16_t*)alloc((size_t)1024 * KVL * 2);
  p.WoT = (bf16_t*)alloc((size_t)DM * 512 * 2);
  p.WfT = (bf16_t*)alloc((size_t)DM * 512 * 2);
  p.WoutT = (bf16_t*)alloc((size_t)DM * DM * 2);
  p.WguT = (bf16_t*)alloc((size_t)NE * 1024 * DM * 2);
  p.WdT = (bf16_t*)alloc((size_t)NE * DM * DE * 2);
  p.chanT = (bf16_t*)alloc((size_t)256 * 128 * 2);
  p.posM = (bf16_t*)alloc((size_t)2048 * 4096 * 2);
  p.ropeTab = (float*)alloc(64 * 8 * 2 * 4);
  p.mod = (float*)alloc(33 * 6144 * 4);
  p.aff = (float*)alloc((size_t)NB * NE * SEQ * 4);
  p.gate = (float*)alloc((size_t)NB * NE * CAP * 4);
  p.idx = (int*)alloc((size_t)NB * NE * CAP * 4);
  p.inv = (int*)alloc((size_t)NB * NE * SEQ * 4);
  p.pckv = (bf16_t*)alloc((size_t)NC * LDCKV * 2);
  char* regA = alloc((size_t)(NT + NC) * DM * 2);
  p.h = (bf16_t*)regA; p.ABt = (bf16_t*)regA; p.h2 = (bf16_t*)regA;
  char* regB1 = alloc((size_t)NT * LDQKV * 2);
  p.pqkv = (bf16_t*)regB1; p.attn_o = (bf16_t*)regB1;
  char* regB2 = alloc((size_t)NT * 512 * 2);
  p.pf = (bf16_t*)regB2; p.four_o = (bf16_t*)regB2;
  p.pg = (bf16_t*)alloc((size_t)NT * 2048 * 2);
  p.Y = p.pg;
  const size_t szQ = (size_t)NB * NH * SEQ * QKD * 2, szK = (size_t)NB * NH * NKEY * QKD * 2, szV = (size_t)NB * NH * VD * NKEY * 2;
  char* regC = alloc(szQ + szK + szV + 1024);
  p.Q = (bf16_t*)regC; p.K = (bf16_t*)(regC + align_up(szQ, 256)); p.Vt = (bf16_t*)(regC + align_up(szQ, 256) + align_up(szK, 256));
  p.m = (bf16_t*)regC; p.hmid = (bf16_t*)(regC + (size_t)NT * DM * 2);
  if (off > ws_size) { fprintf(stderr, "workspace too small: need %zu have %zu\n", off, ws_size); return; }

  int ts = 0;
  auto job = [&](int i, const float* src, bf16_t* dst, const float* scale, int K, int ldS, int n_off, int n_cnt, int dst_row0, int mode, int batch, long sbs, long dbs) {
    TJob& j = p.jobs[i];
    j.src = src; j.dst = dst; j.scale = scale; j.K = K; j.ldS = ldS; j.n_off = n_off; j.n_cnt = n_cnt; j.dst_row0 = dst_row0; j.mode = mode; j.batch = batch;
    j.tiles_n = (n_cnt + 63) / 64; j.tile_start = ts; j.src_bstride = sbs; j.dst_bstride = dbs;
    ts += batch * (K / 64) * j.tiles_n;
  };
  job(0, w_e_gate, p.WguT, nullptr, DM, DE, 0, DE, 0, 1, NE, (long)DM * DE, (long)1024 * DM);
  job(1, w_e_up, p.WguT, nullptr, DM, DE, 0, DE, 0, 2, NE, (long)DM * DE, (long)1024 * DM);
  job(2, w_e_down, p.WdT, nullptr, DE, DM, 0, DM, 0, 0, NE, (long)DE * DM, (long)DM * DE);
  job(3, w_in, p.WinT, nullptr, DM, N_IN, 0, 640, 0, 0, 1, 0, 0);
  job(4, w_in, p.WinT, nullptr, DM, N_IN, 672, 2560, 640, 0, 1, 0, 0);
  job(5, w_in, p.WinT, nullptr, DM, N_IN, 640, 32, 3200, 0, 1, 0, 0);
  job(6, w_q_up, p.WqT, q_a_g, QL, 768, 0, 768, 0, 0, 1, 0, 0);
  job(7, w_kv_up, p.WkvT, kv_a_g, KVL, 1024, 0, 1024, 0, 0, 1, 0, 0);
  job(8, w_o_attn, p.WoT, nullptr, 512, DM, 0, DM, 0, 0, 1, 0, 0);
  job(9, w_fourier, p.WfT, nullptr, 512, DM, 0, DM, 0, 0, 1, 0, 0);
  job(10, w_out, p.WoutT, nullptr, DM, DM, 0, DM, 0, 0, 1, 0, 0);
  p.n_ttiles = ts;

  void* args[] = {&p};
  hipError_t e = hipLaunchCooperativeKernel((void*)mega_kernel, dim3(grid_blocks), dim3(256), args, 0, stream);
  if (e != hipSuccess) fprintf(stderr, "cooperative launch failed: %s (grid %d)\n", hipGetErrorString(e), grid_blocks);
}
```

```cpp
#include <hip/hip_runtime.h>
#include <hip/hip_cooperative_groups.h>
#include <cstdio>
#include <cstring>
#include <cstdint>
namespace cg = cooperative_groups;

#define DI __device__ __forceinline__
typedef unsigned short bf16_t;
typedef short bf16x8 __attribute__((ext_vector_type(8)));
typedef float f32x16 __attribute__((ext_vector_type(16)));
#define MFMA(a, b, c) __builtin_amdgcn_mfma_f32_32x32x16_bf16((a), (b), (c), 0, 0, 0)

constexpr int NB = 32, SEQ = 2048, DM = 1024, NT = NB * SEQ, CTXL = 256, NC = NB * CTXL;
constexpr int NH = 8, QKD = 96, VD = 64, QL = 384, KVL = 256, NKEY = SEQ + CTXL;
constexpr int N_IN = 3232, NINP = 3328;
constexpr int NE = 16, DE = 512, CAP = 256;
constexpr float EPS = 1e-6f;
constexpr int LDQKV = 672, LDCKV = 288;
constexpr int SMEM_BYTES = 73728;

struct TJob {
  const float* src; bf16_t* dst; const float* scale;
  int K, ldS, n_off, n_cnt, dst_row0, mode, batch, tiles_n, tile_start, pad0;
  long src_bstride, dst_bstride;
};
constexpr int NJOBS = 11;

struct Params {
  const float *x, *c, *ctx, *c_ctx, *w_mod, *b_mod, *norm1_g, *q_norm_g, *k_norm_g, *norm2_g, *w_router;
  float* out;
  bf16_t *WinT, *WqT, *WkvT, *WoT, *WfT, *WoutT, *WguT, *WdT, *chanT, *posM;
  float *ropeTab, *mod;
  bf16_t *h, *pqkv, *pckv, *pf, *pg, *Q, *K, *Vt, *attn_o, *ABt, *four_o, *m, *h2, *hmid;
  float *aff, *gate;
  int* idx;
  int* inv;
  bf16_t* Y;
  TJob jobs[NJOBS];
  int n_ttiles, pad1;
};

typedef float f32x2v __attribute__((ext_vector_type(2)));
typedef __bf16 bf16x2v __attribute__((ext_vector_type(2)));
DI unsigned pk_bf16(float lo, float hi) { f32x2v v = {lo, hi}; bf16x2v b = __builtin_convertvector(v, bf16x2v); return __builtin_bit_cast(unsigned, b); }
DI int tid_() { int t = threadIdx.x; asm volatile("" : "+v"(t)); return t; }
DI float bf_lo(unsigned u) { return __uint_as_float(u << 16); }
DI float bf_hi(unsigned u) { return __uint_as_float(u & 0xffff0000u); }
DI float bf2f(bf16_t b) { return __uint_as_float(((unsigned)b) << 16); }
DI bf16_t f2bf(float f) { return (bf16_t)(pk_bf16(f, 0.f) & 0xffffu); }
DI float sigmoidf_(float x) { return 1.f / (1.f + __expf(-x)); }
DI int crow(int i, int hh) { return (i & 3) + 8 * (i >> 2) + 4 * hh; }
DI float wave_sum(float v) {
#pragma unroll
  for (int o = 32; o >= 1; o >>= 1) v += __shfl_xor(v, o);
  return v;
}
DI f32x16 zero16() { f32x16 z;
#pragma unroll
  for (int i = 0; i < 16; ++i) z[i] = 0.f; return z; }

template <int TM, int TN, int WM, int WN, bool SUMSQ, class AF, class BF>
DI void gemm_core(f32x16 (&acc)[TM][TN], AF arow, BF brow, int K, char* smem, float& sumsq) {
  constexpr int RA = 32 * TM * WM, RB = 32 * TN * WN, NA = RA / 32, NBR = RB / 32;
  constexpr int LDR = 128;
  constexpr int STAGE = (RA + RB) * LDR;
  static_assert(2 * STAGE <= SMEM_BYTES, "smem");
  static_assert(NBR == 4 && (NA == 3 || NA == 4), "loader shape");
  const int t = tid_(), lane = t & 63, w = t >> 6, r = lane & 31, hh = lane >> 5;
  const int wm = w % WM, wn = w / WM;
  const int row0 = t >> 3;
  const int c = (t & 7) ^ ((row0 >> 1) & 7);
  const bf16_t* pa0 = arow(row0) + c * 8; const bf16_t* pa1 = arow(row0 + 32) + c * 8; const bf16_t* pa2 = arow(row0 + 64) + c * 8;
  const bf16_t* pa3 = (NA > 3) ? arow(row0 + 96) + c * 8 : pa2;
  const bf16_t* pb0 = brow(row0) + c * 8; const bf16_t* pb1 = brow(row0 + 32) + c * 8; const bf16_t* pb2 = brow(row0 + 64) + c * 8; const bf16_t* pb3 = brow(row0 + 96) + c * 8;
#define GLDS(gp, lp) __builtin_amdgcn_global_load_lds((const unsigned*)(gp), (__attribute__((address_space(3))) unsigned*)(lp), 16, 0, 0)
#define G_ISSUE(base, ko) do { char* l_ = (base) + t * 16; \
    GLDS(pa0 + (ko), l_); GLDS(pa1 + (ko), l_ + 4096); GLDS(pa2 + (ko), l_ + 8192); if (NA > 3) GLDS(pa3 + (ko), l_ + 12288); \
    char* m_ = l_ + RA * LDR; \
    GLDS(pb0 + (ko), m_); GLDS(pb1 + (ko), m_ + 4096); GLDS(pb2 + (ko), m_ + 8192); GLDS(pb3 + (ko), m_ + 12288); } while (0)
  G_ISSUE(smem, 0);
  __syncthreads();
  const int nk = K >> 6;
  const int sw = (r >> 1) & 7;
  const int aoff = (wm * TM * 32 + r) * LDR, boff = RA * LDR + (wn * TN * 32 + r) * LDR;
  auto compute = [&](const char* cur) {
    const char* As = cur + aoff;
    const char* Bs = cur + boff;
    bf16x8 a0[TM], b0[TN], a1[TM], b1[TN];
#define LOADF(A_, B_, ks) do { const int po_ = (((ks) * 2 + hh) ^ sw) * 16; \
      _Pragma("unroll") for (int tm = 0; tm < TM; ++tm) A_[tm] = *(const bf16x8*)(As + tm * 32 * LDR + po_); \
      _Pragma("unroll") for (int tn = 0; tn < TN; ++tn) B_[tn] = *(const bf16x8*)(Bs + tn * 32 * LDR + po_); } while (0)
#define MMF(A_, B_) do { if (SUMSQ) { uint4 u = __builtin_bit_cast(uint4, B_[0]); \
        float e0 = bf_lo(u.x), e1 = bf_hi(u.x), e2 = bf_lo(u.y), e3 = bf_hi(u.y), e4 = bf_lo(u.z), e5 = bf_hi(u.z), e6 = bf_lo(u.w), e7 = bf_hi(u.w); \
        sumsq += e0 * e0 + e1 * e1 + e2 * e2 + e3 * e3 + e4 * e4 + e5 * e5 + e6 * e6 + e7 * e7; } \
      _Pragma("unroll") for (int tm = 0; tm < TM; ++tm) _Pragma("unroll") for (int tn = 0; tn < TN; ++tn) acc[tm][tn] = MFMA(A_[tm], B_[tn], acc[tm][tn]); } while (0)
    LOADF(a0, b0, 0);
    LOADF(a1, b1, 1);
    MMF(a0, b0);
    LOADF(a0, b0, 2);
    MMF(a1, b1);
    LOADF(a1, b1, 3);
    MMF(a0, b0);
    MMF(a1, b1);
    constexpr int NF = TM + TN, NM = TM * TN;
    __builtin_amdgcn_sched_group_barrier(0x100, NF, 0);
    __builtin_amdgcn_sched_group_barrier(0x100, NF, 0);
    __builtin_amdgcn_sched_group_barrier(0x008, NM, 0);
    __builtin_amdgcn_sched_group_barrier(0x100, NF, 0);
    __builtin_amdgcn_sched_group_barrier(0x008, NM, 0);
    __builtin_amdgcn_sched_group_barrier(0x100, NF, 0);
    __builtin_amdgcn_sched_group_barrier(0x008, NM, 0);
    __builtin_amdgcn_sched_group_barrier(0x008, NM, 0);
  };
  for (int kt = 0; kt < nk - 1; ++kt) {
    G_ISSUE(smem + ((kt + 1) & 1) * STAGE, (kt + 1) * 64);
    __builtin_amdgcn_sched_barrier(0);
    compute(smem + (kt & 1) * STAGE);
    __builtin_amdgcn_sched_barrier(0);
    __syncthreads();
  }
  compute(smem + ((nk - 1) & 1) * STAGE);
  __syncthreads();
}

constexpr int LDT = 272;
template <class F>
DI void stage_tile(const f32x16 (&acc)[2][2], char* tile, F f) {
  const int t = tid_(), lane = t & 63, w = t >> 6, r = lane & 31, hh = lane >> 5;
  const int wm = w & 1, wn = w >> 1;
#pragma unroll
  for (int tm = 0; tm < 2; ++tm)
#pragma unroll
    for (int tn = 0; tn < 2; ++tn) {
      char* d = tile + (wn * 64 + tn * 32 + r) * LDT + (wm * 64 + tm * 32 + 4 * hh) * 2;
#pragma unroll
      for (int q = 0; q < 4; ++q) {
        uint2 o; o.x = pk_bf16(f(acc[tm][tn][4 * q]), f(acc[tm][tn][4 * q + 1])); o.y = pk_bf16(f(acc[tm][tn][4 * q + 2]), f(acc[tm][tn][4 * q + 3]));
        *(uint2*)(d + 16 * q) = o;
      }
    }
}
template <class RF>
DI void copy_tile(const char* tile, RF dst, int nch) {
  const int t = tid_(), ch = t & 15, r0 = t >> 4;
  if (ch < nch) {
#pragma unroll
    for (int i = 0; i < 8; ++i) {
      const int row = r0 + 16 * i;
      const uint4 v = *(const uint4*)(tile + row * LDT + ch * 16);
      *(uint4*)(dst(row) + ch * 8) = v;
    }
  }
}

DI void transpose_tile(const TJob& j, int tile, char* smem) {
  const int t = tid_();
  const int tpb = (j.K >> 6) * j.tiles_n;
  const int bi = tile / tpb, rem = tile % tpb;
  const int kt = rem / j.tiles_n, ntile = rem % j.tiles_n;
  const int k0 = kt * 64, n0 = ntile * 64;
  const float* src = j.src + (size_t)bi * j.src_bstride;
  bf16_t* dst = j.dst + (size_t)bi * j.dst_bstride;
  bf16_t* T = (bf16_t*)smem;
  const int nn = t & 63, kq = t >> 6;
  const bool nvalid = (n0 + nn) < j.n_cnt;
  __syncthreads();
#pragma unroll 4
  for (int i = 0; i < 16; ++i) {
    const int kk = kq + 4 * i;
    float v = 0.f;
    if (nvalid) {
      v = src[(size_t)(k0 + kk) * j.ldS + j.n_off + n0 + nn];
      if (j.scale) v *= j.scale[k0 + kk];
    }
    T[nn * 66 + kk] = f2bf(v);
  }
  __syncthreads();
  const int n = t >> 2, part = t & 3;
  if (n0 + n < j.n_cnt) {
    const unsigned* tp = (const unsigned*)(T + n * 66 + part * 16);
    uint4 o0, o1;
    o0.x = tp[0]; o0.y = tp[1]; o0.z = tp[2]; o0.w = tp[3];
    o1.x = tp[4]; o1.y = tp[5]; o1.z = tp[6]; o1.w = tp[7];
    const int f = n0 + n;
    int drow;
    if (j.mode == 0) drow = j.dst_row0 + f;
    else drow = (f >> 6) * 128 + ((f & 63) >> 5) * 64 + (j.mode == 2 ? 32 : 0) + (f & 31);
    uint4* dp = (uint4*)(dst + (size_t)drow * j.K + k0 + part * 16);
    dp[0] = o0; dp[1] = o1;
  }
}

DI void mod_item(const Params& p, int it, char* smem) {
  const int t = tid_(), cgi = t & 15, kg = t >> 4;
  const int j0 = it * 16;
  float* Ssm = (float*)smem;
  float* red = (float*)(smem + 33 * 128 * 4);
  float acc[33];
#pragma unroll
  for (int r = 0; r < 33; ++r) acc[r] = 0.f;
#pragma unroll 1
  for (int kc = 0; kc < 8; ++kc) {
    __syncthreads();
    for (int idx = t; idx < 33 * 128; idx += 256) {
      const int r = idx >> 7, kk = idx & 127;
      float v = (r < 32) ? p.c[r * DM + kc * 128 + kk] : p.c_ctx[kc * 128 + kk];
      Ssm[idx] = v * sigmoidf_(v);
    }
    __syncthreads();
#pragma unroll 1
    for (int kk = 0; kk < 8; kk += 4) {
      const int k = kc * 128 + kg * 8 + kk;
      const float w0 = p.w_mod[(size_t)(k + 0) * 6144 + j0 + cgi];
      const float w1 = p.w_mod[(size_t)(k + 1) * 6144 + j0 + cgi];
      const float w2 = p.w_mod[(size_t)(k + 2) * 6144 + j0 + cgi];
      const float w3 = p.w_mod[(size_t)(k + 3) * 6144 + j0 + cgi];
#pragma unroll
      for (int r = 0; r < 33; ++r) {
        const float4 s = *(const float4*)(Ssm + r * 128 + kg * 8 + kk);
        acc[r] += s.x * w0 + s.y * w1 + s.z * w2 + s.w * w3;
      }
    }
  }
  __syncthreads();
#pragma unroll
  for (int r = 0; r < 33; ++r) red[(kg * 33 + r) * 16 + cgi] = acc[r];
  __syncthreads();
  for (int idx = t; idx < 33 * 16; idx += 256) {
    const int r = idx >> 4, cc = idx & 15;
    float s = 0.f;
#pragma unroll
    for (int g = 0; g < 16; ++g) s += red[(g * 33 + r) * 16 + cc];
    p.mod[r * 6144 + j0 + cc] = s + p.b_mod[j0 + cc];
  }
}

DI void phase0(const Params& p, char* smem) {
  const int t = tid_();
  const int nMod = 384;
  const int nPos = 288;
  const int nMisc = 3;
  const int nT = p.n_ttiles;
  const int total = nMod + nT + nPos + nMisc;
  float* ctab = (float*)(smem + 65536 - 8192 - 1024);
  for (int j = t; j < 2048; j += 256) ctab[j] = cospif((float)j * (1.f / 1024.f));
  __syncthreads();
  for (int it = blockIdx.x; it < total; it += gridDim.x) {
    if (it < nMod) { mod_item(p, it, smem); continue; }
    int u = it - nMod;
    if (u < nT) {
      int jb = 0;
#pragma unroll 1
      for (int q = 1; q < NJOBS; ++q) if (u >= p.jobs[q].tile_start) jb = q;
      transpose_tile(p.jobs[jb], u - p.jobs[jb].tile_start, smem);
      continue;
    }
    u -= nT;
    if (u < nPos) {
      for (int e = t; e < 8 * 256; e += 256) {
        const int R = u * 8 + (e >> 8), c8 = (e & 255) * 8;
        const int part = R >= 1152 ? 1 : 0, k = R - part * 1152;
        float v[8];
#pragma unroll
        for (int q = 0; q < 8; ++q) {
          const int tt = c8 + q;
          v[q] = (k > 1024) ? 0.f : (part ? ctab[(k * tt - 512) & 2047] : ctab[(k * tt) & 2047]);
        }
        uint4 o; o.x = pk_bf16(v[0], v[1]); o.y = pk_bf16(v[2], v[3]); o.z = pk_bf16(v[4], v[5]); o.w = pk_bf16(v[6], v[7]);
        *(uint4*)(p.posM + (size_t)R * 2048 + c8) = o;
      }
      continue;
    }
    u -= nPos;
    if (u == 0) {
      for (int e = t; e < 256 * 128; e += 256) {
        const int m2 = e >> 7, cc = e & 127, mm = m2 & 127;
        float v = (m2 < 128) ? ctab[(mm * cc * 16) & 2047] : ctab[(mm * cc * 16 - 512) & 2047];
        p.chanT[e] = f2bf(v);
      }
    } else if (u == 1) {
      for (int e = t; e < 64 * 8; e += 256) {
        const int pos = e >> 3, jf = e & 7;
        const float inv = 1.0f / powf(10000.0f, (float)jf / 8.0f);
        const float ang = (float)pos * inv;
        p.ropeTab[e * 2 + 0] = cosf(ang);
        p.ropeTab[e * 2 + 1] = sinf(ang);
      }
    } else {
      uint4 z; z.x = z.y = z.z = z.w = 0u;
      uint4* dp = (uint4*)(p.WinT + (size_t)N_IN * DM);
      for (int e = t; e < (NINP - N_IN) * DM / 8; e += 256) dp[e] = z;
    }
  }
}

DI void phase1(const Params& p) {
  const int t_ = tid_(); const int lane = t_ & 63, w = t_ >> 6;
  const int gw = blockIdx.x * 4 + w, nw = gridDim.x * 4;
  for (int R = gw; R < NT + NC; R += nw) {
    const float* src; const float* md;
    if (R < NT) { src = p.x + (size_t)R * DM; md = p.mod + (R >> 11) * 6144; }
    else { src = p.ctx + (size_t)(R - NT) * DM; md = p.mod + 32 * 6144; }
    float4 v[4]; float ss = 0.f;
#pragma unroll
    for (int i = 0; i < 4; ++i) { v[i] = *(const float4*)(src + lane * 4 + 256 * i); ss += v[i].x * v[i].x + v[i].y * v[i].y + v[i].z * v[i].z + v[i].w * v[i].w; }
    ss = wave_sum(ss);
    const float rr = rsqrtf(ss * (1.f / DM) + EPS);
#pragma unroll
    for (int i = 0; i < 4; ++i) {
      const int d = lane * 4 + 256 * i;
      const float4 g = *(const float4*)(p.norm1_g + d);
      const float4 sh = *(const float4*)(md + d);
      const float4 sc = *(const float4*)(md + 1024 + d);
      const float o0 = v[i].x * rr * g.x * (1.f + sc.x) + sh.x;
      const float o1 = v[i].y * rr * g.y * (1.f + sc.y) + sh.y;
      const float o2 = v[i].z * rr * g.z * (1.f + sc.z) + sh.z;
      const float o3 = v[i].w * rr * g.w * (1.f + sc.w) + sh.w;
      uint2 o; o.x = pk_bf16(o0, o1); o.y = pk_bf16(o2, o3);
      *(uint2*)(p.h + (size_t)R * DM + d) = o;
    }
  }
}

DI void phase2(const Params& p, char* smem) {
  const int t = tid_(), lane = t & 63, w = t >> 6, r = lane & 31, hh = lane >> 5;
  const int wm = w & 1, wn = w >> 1;
  const int xcd = blockIdx.x & 7, jl = blockIdx.x >> 3, nl = gridDim.x >> 3;
  for (int L = jl; L < 1664 + 24; L += nl) {
    int tokTile, ft; const bool lat = L < 1664;
    if (lat) { const int tg = L / 208, rem = L % 208; ft = rem >> 3; tokTile = xcd * 64 + tg * 8 + (rem & 7); }
    else { const int u = L - 1664; tokTile = 512 + xcd * 8 + u / 3; const int q = u % 3; ft = (q == 2) ? 25 : 3 + q; }
    f32x16 acc[2][2];
#pragma unroll
    for (int a = 0; a < 2; ++a)
#pragma unroll
      for (int b = 0; b < 2; ++b) acc[a][b] = zero16();
    const bf16_t* Ab = p.WinT + (size_t)ft * 128 * DM;
    const bf16_t* Bb = p.h + (size_t)tokTile * 128 * DM;
    float dummy = 0.f;
    gemm_core<2, 2, 2, 2, false>(acc, [&](int row) { return Ab + (size_t)row * DM; }, [&](int row) { return Bb + (size_t)row * DM; }, DM, smem, dummy);
    {
      bf16_t* base; int ld, nch = 16; bool sg = false;
      const int tok0 = tokTile * 128;
      if (lat) {
        if (ft < 5) { base = p.pqkv + (size_t)tok0 * LDQKV + ft * 128; ld = LDQKV; }
        else if (ft < 9) { base = p.pf + (size_t)tok0 * 512 + (ft - 5) * 128; ld = 512; }
        else if (ft < 25) { base = p.pg + (size_t)tok0 * 2048 + (ft - 9) * 128; ld = 2048; sg = true; }
        else { base = p.pqkv + (size_t)tok0 * LDQKV + 640; ld = LDQKV; nch = 4; }
      } else {
        const int ct0 = tok0 - NT;
        if (ft < 5) { base = p.pckv + (size_t)ct0 * LDCKV + (ft - 3) * 128; ld = LDCKV; }
        else { base = p.pckv + (size_t)ct0 * LDCKV + 256; ld = LDCKV; nch = 4; }
      }
      if (sg) stage_tile(acc, smem, [](float v) { return sigmoidf_(v); });
      else stage_tile(acc, smem, [](float v) { return v; });
      __syncthreads();
      copy_tile(smem, [&](int row) { return base + (size_t)row * ld; }, nch);
      __syncthreads();
    }
  }
}

DI void rope_pair(float& x1, float& x2, const float* tab) { const float c = tab[0], s = tab[1]; const float a = x1 * c - x2 * s, b = x2 * c + x1 * s; x1 = a; x2 = b; }

DI void phase3(const Params& p, char* smem) {
  const int t = tid_(), lane = t & 63, w = t >> 6, r = lane & 31, hh = lane >> 5;
  const int nKV = 576, nQ = 512, nCh = 512;
  const int xcd = blockIdx.x & 7, jl = blockIdx.x >> 3, nl = gridDim.x >> 3;
  for (int it = jl; it < nKV + nQ + nCh; it += nl) {
    if (it < nKV) {
      const int tl_ = it >> 3, hd = it & 7;
      const bool lat = tl_ < 64;
      const int tokTile = lat ? xcd * 64 + tl_ : 512 + xcd * 8 + (tl_ - 64);
      const bf16_t* Bb; int ldb; const bf16_t* kpeb;
      int b, key0;
      if (lat) { Bb = p.pqkv + (size_t)tokTile * 128 * LDQKV + QL; ldb = LDQKV; kpeb = p.pqkv + (size_t)tokTile * 128 * LDQKV + 640; b = tokTile >> 4; key0 = (tokTile & 15) * 128; }
      else { const int ct = tokTile - 512; Bb = p.pckv + (size_t)ct * 128 * LDCKV; ldb = LDCKV; kpeb = Bb + 256; b = ct >> 1; key0 = SEQ + (ct & 1) * 128; }
      const bf16_t* Ab = p.WkvT + (size_t)hd * 128 * KVL;
      f32x16 acc[4][1];
#pragma unroll
      for (int a = 0; a < 4; ++a) acc[a][0] = zero16();
      float sumsq = 0.f;
      gemm_core<4, 1, 1, 4, true>(acc, [&](int row) { return Ab + (size_t)row * KVL; }, [&](int row) { return Bb + (size_t)row * ldb; }, KVL, smem, sumsq);
      sumsq += __shfl_xor(sumsq, 32);
      const float ra = rsqrtf(sumsq * (1.f / KVL) + EPS);
      const int tl = w * 32 + r;
      const int key = key0 + tl;
      float kp[16];
#pragma unroll
      for (int q = 0; q < 4; ++q) {
        const uint2 u = *(const uint2*)(kpeb + (size_t)tl * ldb + 8 * q + 4 * hh);
        kp[4 * q + 0] = bf_lo(u.x); kp[4 * q + 1] = bf_hi(u.x); kp[4 * q + 2] = bf_lo(u.y); kp[4 * q + 3] = bf_hi(u.y);
      }
      float ss = 0.f;
#pragma unroll
      for (int tm = 0; tm < 4; ++tm)
#pragma unroll
        for (int i = 0; i < 16; ++i) { const float v = acc[tm][0][i] * ra; acc[tm][0][i] = v; if (tm < 2) ss += v * v; }
#pragma unroll
      for (int i = 0; i < 16; ++i) ss += kp[i] * kp[i];
      ss += __shfl_xor(ss, 32);
      const float rk = rsqrtf(ss * (1.f / QKD) + EPS);
#pragma unroll
      for (int i = 0; i < 16; ++i) kp[i] *= rk * p.k_norm_g[64 + crow(i, hh)];
      if (lat) {
        const int pos = key;
        const float* tr = p.ropeTab + ((pos >> 6) * 8 + 4 * hh) * 2;
        const float* tc = p.ropeTab + ((pos & 63) * 8 + 4 * hh) * 2;
#pragma unroll
        for (int i = 0; i < 4; ++i) { rope_pair(kp[i], kp[i + 4], tr + 2 * i); rope_pair(kp[8 + i], kp[12 + i], tc + 2 * i); }
      }
      bf16_t* Kd = p.K + ((size_t)(b * NH + hd) * NKEY + key) * QKD;
#pragma unroll
      for (int tm = 0; tm < 2; ++tm)
#pragma unroll
        for (int q = 0; q < 4; ++q) {
          const int f = tm * 32 + 8 * q + 4 * hh;
          const float4 g = *(const float4*)(p.k_norm_g + f);
          uint2 o; o.x = pk_bf16(acc[tm][0][4 * q] * rk * g.x, acc[tm][0][4 * q + 1] * rk * g.y); o.y = pk_bf16(acc[tm][0][4 * q + 2] * rk * g.z, acc[tm][0][4 * q + 3] * rk * g.w);
          *(uint2*)(Kd + f) = o;
        }
#pragma unroll
      for (int q = 0; q < 4; ++q) {
        uint2 o; o.x = pk_bf16(kp[4 * q], kp[4 * q + 1]); o.y = pk_bf16(kp[4 * q + 2], kp[4 * q + 3]);
        *(uint2*)(Kd + 64 + 8 * q + 4 * hh) = o;
      }
      bf16_t* Vd = p.Vt + (size_t)(b * NH + hd) * VD * NKEY + key;
#pragma unroll
      for (int tm = 2; tm < 4; ++tm)
#pragma unroll
        for (int i = 0; i < 16; ++i) Vd[(size_t)((tm - 2) * 32 + crow(i, hh)) * NKEY] = f2bf(acc[tm][0][i]);
    } else if (it < nKV + nQ) {
      const int u = it - nKV;
      const int tokTile = xcd * 64 + (u >> 3), hd = u & 7;
      const bf16_t* Bb = p.pqkv + (size_t)tokTile * 128 * LDQKV;
      const bf16_t* Ab = p.WqT + (size_t)hd * QKD * QL;
      f32x16 acc[3][1];
#pragma unroll
      for (int a = 0; a < 3; ++a) acc[a][0] = zero16();
      float sumsq = 0.f;
      gemm_core<3, 1, 1, 4, true>(acc, [&](int row) { return Ab + (size_t)row * QL; }, [&](int row) { return Bb + (size_t)row * LDQKV; }, QL, smem, sumsq);
      sumsq += __shfl_xor(sumsq, 32);
      const float ra = rsqrtf(sumsq * (1.f / QL) + EPS);
      const int tl = w * 32 + r;
      const int b = tokTile >> 4, pos = (tokTile & 15) * 128 + tl;
      float ss = 0.f;
#pragma unroll
      for (int tm = 0; tm < 3; ++tm)
#pragma unroll
        for (int i = 0; i < 16; ++i) { const float v = acc[tm][0][i] * ra; acc[tm][0][i] = v; ss += v * v; }
      ss += __shfl_xor(ss, 32);
      const float rh = rsqrtf(ss * (1.f / QKD) + EPS);
#pragma unroll
      for (int tm = 0; tm < 3; ++tm)
#pragma unroll
        for (int q = 0; q < 4; ++q) {
          const float4 g = *(const float4*)(p.q_norm_g + tm * 32 + 8 * q + 4 * hh);
          acc[tm][0][4 * q] *= rh * g.x; acc[tm][0][4 * q + 1] *= rh * g.y; acc[tm][0][4 * q + 2] *= rh * g.z; acc[tm][0][4 * q + 3] *= rh * g.w;
        }
      {
        const float* tr = p.ropeTab + ((pos >> 6) * 8 + 4 * hh) * 2;
        const float* tc = p.ropeTab + ((pos & 63) * 8 + 4 * hh) * 2;
#pragma unroll
        for (int i = 0; i < 4; ++i) {
          float a0 = acc[2][0][i], a1 = acc[2][0][i + 4], c0 = acc[2][0][8 + i], c1 = acc[2][0][12 + i];
          rope_pair(a0, a1, tr + 2 * i); rope_pair(c0, c1, tc + 2 * i);
          acc[2][0][i] = a0; acc[2][0][i + 4] = a1; acc[2][0][8 + i] = c0; acc[2][0][12 + i] = c1;
        }
      }
      const float qs = 0.10206207261596575f * 1.4426950408889634f;
      bf16_t* Qd = p.Q + ((size_t)(b * NH + hd) * SEQ + pos) * QKD;
#pragma unroll
      for (int tm = 0; tm < 3; ++tm)
#pragma unroll
        for (int q = 0; q < 4; ++q) {
          uint2 o; o.x = pk_bf16(acc[tm][0][4 * q] * qs, acc[tm][0][4 * q + 1] * qs); o.y = pk_bf16(acc[tm][0][4 * q + 2] * qs, acc[tm][0][4 * q + 3] * qs);
          *(uint2*)(Qd + tm * 32 + 8 * q + 4 * hh) = o;
        }
    } else {
      const int u = it - nKV - nQ;
      const int ft = u & 1, tt = (u >> 1) & 15, g = (u >> 5) & 3, b = xcd * 4 + (u >> 7);
      const int wm = w & 1, wn = w >> 1;
      const bf16_t* Ab = p.chanT + (size_t)ft * 128 * 128;
      const bf16_t* Bb = p.pf + (size_t)(b * SEQ + tt * 128) * 512 + g * 128;
      f32x16 acc[2][2];
#pragma unroll
      for (int a = 0; a < 2; ++a)
#pragma unroll
        for (int c = 0; c < 2; ++c) acc[a][c] = zero16();
      float dummy = 0.f;
      gemm_core<2, 2, 2, 2, false>(acc, [&](int row) { return Ab + (size_t)row * 128; }, [&](int row) { return Bb + (size_t)row * 512; }, 128, smem, dummy);
#pragma unroll
      for (int tm = 0; tm < 2; ++tm)
#pragma unroll
        for (int tn = 0; tn < 2; ++tn) {
          const int tpos = tt * 128 + wn * 64 + tn * 32 + r;
#pragma unroll
          for (int i = 0; i < 16; ++i) {
            const int mm = wm * 64 + tm * 32 + crow(i, hh);
            p.ABt[((size_t)(b * 512 + g * 128 + mm)) * 4096 + ft * 2048 + tpos] = f2bf(acc[tm][tn][i]);
          }
        }
    }
  }
}

DI void attn_item(const Params& p, int it, char* smem) {
  const int t = tid_(), lane = t & 63, w = t >> 6, r = lane & 31, hh = lane >> 5;
  const int qt = it & 15, bh = it >> 4;
  constexpr int KROW = 208, VROW = 136, KBYTES = 64 * KROW, STAGE = KBYTES + 64 * VROW;
  const bf16_t* Kb = p.K + (size_t)bh * NKEY * QKD;
  const bf16_t* Vb = p.Vt + (size_t)bh * VD * NKEY;
  const int qpos = qt * 128 + w * 32 + r;
  const bf16_t* Qp = p.Q + ((size_t)bh * SEQ + qpos) * QKD + hh * 8;
  bf16x8 qf[6];
#pragma unroll
  for (int c = 0; c < 6; ++c) qf[c] = *(const bf16x8*)(Qp + c * 16);
  f32x16 o[2]; o[0] = zero16(); o[1] = zero16();
  float mrun = -INFINITY, lrun = 0.f;
  const int kid0 = t, kid1 = t + 256, kid2 = t + 512;
  const int kgo0 = (kid0 / 12) * QKD + (kid0 % 12) * 8, kgo1 = (kid1 / 12) * QKD + (kid1 % 12) * 8, kgo2 = (kid2 / 12) * QKD + (kid2 % 12) * 8;
  const int klo0 = (kid0 / 12) * KROW + (kid0 % 12) * 16, klo1 = (kid1 / 12) * KROW + (kid1 % 12) * 16, klo2 = (kid2 / 12) * KROW + (kid2 % 12) * 16;
  const int vid0 = t, vid1 = t + 256;
  const int vgo0 = (vid0 >> 3) * NKEY + (vid0 & 7) * 8, vgo1 = (vid1 >> 3) * NKEY + (vid1 & 7) * 8;
  const int vlo0 = KBYTES + (vid0 >> 3) * VROW + (vid0 & 7) * 16, vlo1 = KBYTES + (vid1 >> 3) * VROW + (vid1 & 7) * 16;
  uint4 rk0, rk1, rk2, rv0, rv1;
  rk0 = *(const uint4*)(Kb + kgo0); rk1 = *(const uint4*)(Kb + kgo1); rk2 = *(const uint4*)(Kb + kgo2);
  rv0 = *(const uint4*)(Vb + vgo0); rv1 = *(const uint4*)(Vb + vgo1);
  __builtin_amdgcn_sched_barrier(0);
#define ATT_STORE(base) do { \
    *(uint4*)((base) + klo0) = rk0; *(uint4*)((base) + klo1) = rk1; *(uint4*)((base) + klo2) = rk2; \
    { uint2* d = (uint2*)((base) + vlo0); d[0] = make_uint2(rv0.x, rv0.y); d[1] = make_uint2(rv0.z, rv0.w); } \
    { uint2* d = (uint2*)((base) + vlo1); d[0] = make_uint2(rv1.x, rv1.y); d[1] = make_uint2(rv1.z, rv1.w); } } while (0)
  ATT_STORE(smem);
  __syncthreads();
  constexpr int NKT = NKEY / 64;
  for (int kt = 0; kt < NKT; ++kt) {
    const char* cur = smem + (kt & 1) * STAGE;
    const bool more = kt + 1 < NKT;
    if (more) {
      const bf16_t* kn = Kb + (size_t)(kt + 1) * 64 * QKD; const bf16_t* vn = Vb + (kt + 1) * 64;
      rk0 = *(const uint4*)(kn + kgo0); rk1 = *(const uint4*)(kn + kgo1); rk2 = *(const uint4*)(kn + kgo2);
      rv0 = *(const uint4*)(vn + vgo0); rv1 = *(const uint4*)(vn + vgo1);
    }
    __builtin_amdgcn_sched_barrier(0);
    f32x16 s[2];
#pragma unroll
    for (int t2 = 0; t2 < 2; ++t2) {
      s[t2] = zero16();
      const char* kp = cur + (t2 * 32 + r) * KROW + hh * 16;
#pragma unroll
      for (int c = 0; c < 6; ++c) { const bf16x8 kf = *(const bf16x8*)(kp + c * 32); s[t2] = MFMA(kf, qf[c], s[t2]); }
    }
    __builtin_amdgcn_sched_barrier(0);
    float mx = s[0][0];
#pragma unroll
    for (int i = 0; i < 16; ++i) { mx = fmaxf(mx, s[0][i]); mx = fmaxf(mx, s[1][i]); }
    mx = fmaxf(mx, __shfl_xor(mx, 32));
    const float mnew = fmaxf(mrun, mx);
    const float alpha = __builtin_amdgcn_exp2f(mrun - mnew);
    mrun = mnew;
    float ls = 0.f;
#pragma unroll
    for (int t2 = 0; t2 < 2; ++t2)
#pragma unroll
      for (int i = 0; i < 16; ++i) { const float e = __builtin_amdgcn_exp2f(s[t2][i] - mnew); s[t2][i] = e; ls += e; }
    lrun = lrun * alpha + ls;
#pragma unroll
    for (int i = 0; i < 16; ++i) { o[0][i] *= alpha; o[1][i] *= alpha; }
    __builtin_amdgcn_sched_barrier(0);
#pragma unroll
    for (int t2 = 0; t2 < 2; ++t2)
#pragma unroll
      for (int s2 = 0; s2 < 2; ++s2) {
        uint4 pu;
        pu.x = pk_bf16(s[t2][8 * s2 + 0], s[t2][8 * s2 + 1]); pu.y = pk_bf16(s[t2][8 * s2 + 2], s[t2][8 * s2 + 3]);
        pu.z = pk_bf16(s[t2][8 * s2 + 4], s[t2][8 * s2 + 5]); pu.w = pk_bf16(s[t2][8 * s2 + 6], s[t2][8 * s2 + 7]);
        const bf16x8 pb = __builtin_bit_cast(bf16x8, pu);
#pragma unroll
        for (int vt = 0; vt < 2; ++vt) {
          const char* vp = cur + KBYTES + (vt * 32 + r) * VROW + (t2 * 32 + 16 * s2 + 4 * hh) * 2;
          const uint2 lo = *(const uint2*)(vp), hi = *(const uint2*)(vp + 16);
          uint4 vu; vu.x = lo.x; vu.y = lo.y; vu.z = hi.x; vu.w = hi.y;
          o[vt] = MFMA(__builtin_bit_cast(bf16x8, vu), pb, o[vt]);
        }
      }
    __builtin_amdgcn_sched_barrier(0);
    if (more) { char* nxt = smem + ((kt + 1) & 1) * STAGE; ATT_STORE(nxt); }
    __syncthreads();
  }
  lrun += __shfl_xor(lrun, 32);
  const float inv = 1.f / lrun;
  const int b = bh >> 3, hd = bh & 7;
  bf16_t* od = p.attn_o + (size_t)(b * SEQ + qpos) * 512 + hd * 64;
#pragma unroll
  for (int vt = 0; vt < 2; ++vt)
#pragma unroll
    for (int q = 0; q < 4; ++q) {
      uint2 ou; ou.x = pk_bf16(o[vt][4 * q] * inv, o[vt][4 * q + 1] * inv); ou.y = pk_bf16(o[vt][4 * q + 2] * inv, o[vt][4 * q + 3] * inv);
      *(uint2*)(od + vt * 32 + 8 * q + 4 * hh) = ou;
    }
}

DI void phase4(const Params& p, char* smem) {
  const int t = tid_(), lane = t & 63, w = t >> 6, r = lane & 31, hh = lane >> 5;
  const int nDft = 144, nAtt = 512;
  const int xcd = blockIdx.x & 7, jl = blockIdx.x >> 3, nl = gridDim.x >> 3;
  for (int it = jl; it < nDft + nAtt; it += nl) {
    if (it < nDft) {
      const int bl = it / 36, rem = it % 36, ct = rem / 9, kt = rem % 9, b = xcd * 4 + bl;
      const int wm = w & 1, wn = w >> 1;
      const bf16_t* Ab = p.ABt + (size_t)(b * 512 + ct * 128) * 4096;
      const bf16_t* Cb = p.posM + (size_t)kt * 128 * 2048;
      const bf16_t* Sb = p.posM + (size_t)(1152 + kt * 128) * 2048;
      f32x16 acc1[2][2], acc2[2][2];
#pragma unroll
      for (int a = 0; a < 2; ++a)
#pragma unroll
        for (int c = 0; c < 2; ++c) { acc1[a][c] = zero16(); acc2[a][c] = zero16(); }
      float dummy = 0.f;
      gemm_core<2, 2, 2, 2, false>(acc1, [&](int row) { return Ab + (size_t)row * 4096; }, [&](int row) { return Cb + (size_t)row * 2048; }, 2048, smem, dummy);
      gemm_core<2, 2, 2, 2, false>(acc2, [&](int row) { return Ab + (size_t)row * 4096 + 2048; }, [&](int row) { return Sb + (size_t)row * 2048; }, 2048, smem, dummy);
      const float sc = 1.f / 512.f;
#pragma unroll
      for (int tm = 0; tm < 2; ++tm)
#pragma unroll
        for (int tn = 0; tn < 2; ++tn) {
          const int kpos = kt * 128 + wn * 64 + tn * 32 + r;
          const int moff = ct * 128 + wm * 64 + tm * 32 + 4 * hh;
          if (kpos <= 1024) {
            bf16_t* d = p.four_o + (size_t)(b * SEQ + kpos) * 512 + moff;
#pragma unroll
            for (int q = 0; q < 4; ++q) {
              uint2 ou; ou.x = pk_bf16((acc1[tm][tn][4 * q] - acc2[tm][tn][4 * q]) * sc, (acc1[tm][tn][4 * q + 1] - acc2[tm][tn][4 * q + 1]) * sc);
              ou.y = pk_bf16((acc1[tm][tn][4 * q + 2] - acc2[tm][tn][4 * q + 2]) * sc, (acc1[tm][tn][4 * q + 3] - acc2[tm][tn][4 * q + 3]) * sc);
              *(uint2*)(d + 8 * q) = ou;
            }
          }
          if (kpos >= 1 && kpos <= 1023) {
            bf16_t* d = p.four_o + (size_t)(b * SEQ + 2048 - kpos) * 512 + moff;
#pragma unroll
            for (int q = 0; q < 4; ++q) {
              uint2 ou; ou.x = pk_bf16((acc1[tm][tn][4 * q] + acc2[tm][tn][4 * q]) * sc, (acc1[tm][tn][4 * q + 1] + acc2[tm][tn][4 * q + 1]) * sc);
              ou.y = pk_bf16((acc1[tm][tn][4 * q + 2] + acc2[tm][tn][4 * q + 2]) * sc, (acc1[tm][tn][4 * q + 3] + acc2[tm][tn][4 * q + 3]) * sc);
              *(uint2*)(d + 8 * q) = ou;
            }
          }
        }
    } else {
      attn_item(p, xcd * 512 + (it - nDft), smem);
    }
  }
}

DI void phase5(const Params& p, char* smem) {
  const int t = tid_(), lane = t & 63, w = t >> 6, r = lane & 31, hh = lane >> 5;
  const int wm = w & 1, wn = w >> 1;
  const int xcd = blockIdx.x & 7, jl = blockIdx.x >> 3, nl = gridDim.x >> 3;
  for (int L = jl; L < 512; L += nl) {
    const int tokTile = xcd * 64 + (L >> 6) * 8 + (L & 7), nt = (L >> 3) & 7;
    f32x16 acc1[2][2], acc2[2][2];
#pragma unroll
    for (int a = 0; a < 2; ++a)
#pragma unroll
      for (int c = 0; c < 2; ++c) { acc1[a][c] = zero16(); acc2[a][c] = zero16(); }
    float dummy = 0.f;
    {
      const bf16_t* Ab = p.WoT + (size_t)nt * 128 * 512; const bf16_t* Bb = p.attn_o + (size_t)tokTile * 128 * 512;
      gemm_core<2, 2, 2, 2, false>(acc1, [&](int row) { return Ab + (size_t)row * 512; }, [&](int row) { return Bb + (size_t)row * 512; }, 512, smem, dummy);
    }
    {
      const bf16_t* Ab = p.WfT + (size_t)nt * 128 * 512; const bf16_t* Bb = p.four_o + (size_t)tokTile * 128 * 512;
      gemm_core<2, 2, 2, 2, false>(acc2, [&](int row) { return Ab + (size_t)row * 512; }, [&](int row) { return Bb + (size_t)row * 512; }, 512, smem, dummy);
    }
    {
      char* t1 = smem; char* t2 = smem + 128 * LDT;
      stage_tile(acc1, t1, [](float v) { return v; });
      stage_tile(acc2, t2, [](float v) { return v; });
      __syncthreads();
      const int ch = t & 15, r0 = t >> 4;
#pragma unroll
      for (int i = 0; i < 8; ++i) {
        const int row = r0 + 16 * i;
        const size_t tok = (size_t)tokTile * 128 + row;
        const uint4 u1 = *(const uint4*)(t1 + row * LDT + ch * 16), u2 = *(const uint4*)(t2 + row * LDT + ch * 16);
        const uint4 ga = *(const uint4*)(p.pg + tok * 2048 + nt * 128 + ch * 8), gb = *(const uint4*)(p.pg + tok * 2048 + 1024 + nt * 128 + ch * 8);
        uint4 o;
        o.x = pk_bf16(bf_lo(ga.x) * bf_lo(u1.x) + bf_lo(gb.x) * bf_lo(u2.x), bf_hi(ga.x) * bf_hi(u1.x) + bf_hi(gb.x) * bf_hi(u2.x));
        o.y = pk_bf16(bf_lo(ga.y) * bf_lo(u1.y) + bf_lo(gb.y) * bf_lo(u2.y), bf_hi(ga.y) * bf_hi(u1.y) + bf_hi(gb.y) * bf_hi(u2.y));
        o.z = pk_bf16(bf_lo(ga.z) * bf_lo(u1.z) + bf_lo(gb.z) * bf_lo(u2.z), bf_hi(ga.z) * bf_hi(u1.z) + bf_hi(gb.z) * bf_hi(u2.z));
        o.w = pk_bf16(bf_lo(ga.w) * bf_lo(u1.w) + bf_lo(gb.w) * bf_lo(u2.w), bf_hi(ga.w) * bf_hi(u1.w) + bf_hi(gb.w) * bf_hi(u2.w));
        *(uint4*)(p.m + tok * DM + nt * 128 + ch * 8) = o;
      }
      __syncthreads();
    }
  }
}

DI void phase6(const Params& p, char* smem) {
  const int t = tid_(), lane = t & 63, w = t >> 6, r = lane & 31, hh = lane >> 5;
  const int wm = w & 1, wn = w >> 1;
  const int xcd = blockIdx.x & 7, jl = blockIdx.x >> 3, nl = gridDim.x >> 3;
  for (int L = jl; L < 512; L += nl) {
    const int tokTile = xcd * 64 + (L >> 6) * 8 + (L & 7), nt = (L >> 3) & 7;
    f32x16 acc[2][2];
#pragma unroll
    for (int a = 0; a < 2; ++a)
#pragma unroll
      for (int c = 0; c < 2; ++c) acc[a][c] = zero16();
    float dummy = 0.f;
    const bf16_t* Wb = p.WoutT + (size_t)nt * 128 * DM; const bf16_t* Mb = p.m + (size_t)tokTile * 128 * DM;
    gemm_core<2, 2, 2, 2, false>(acc, [&](int row) { return Wb + (size_t)row * DM; }, [&](int row) { return Mb + (size_t)row * DM; }, DM, smem, dummy);
#pragma unroll
    for (int tm = 0; tm < 2; ++tm)
#pragma unroll
      for (int tn = 0; tn < 2; ++tn) {
        char* d = smem + (wn * 64 + tn * 32 + r) * 528 + (wm * 64 + tm * 32 + 4 * hh) * 4;
#pragma unroll
        for (int q = 0; q < 4; ++q) *(float4*)(d + 32 * q) = make_float4(acc[tm][tn][4 * q], acc[tm][tn][4 * q + 1], acc[tm][tn][4 * q + 2], acc[tm][tn][4 * q + 3]);
      }
    __syncthreads();
    {
      const int ch = t & 31, r0 = t >> 5;
      const float4 g = *(const float4*)(p.mod + (tokTile >> 4) * 6144 + 2048 + nt * 128 + ch * 4);
#pragma unroll 4
      for (int i = 0; i < 16; ++i) {
        const int row = r0 + 8 * i;
        const float4 a = *(const float4*)(smem + row * 528 + ch * 16);
        const size_t o = ((size_t)tokTile * 128 + row) * DM + nt * 128 + ch * 4;
        const float4 xv = *(const float4*)(p.x + o);
        *(float4*)(p.out + o) = make_float4(xv.x + g.x * a.x, xv.y + g.y * a.y, xv.z + g.z * a.z, xv.w + g.w * a.w);
      }
    }
    __syncthreads();
  }
}

DI void phase7(const Params& p, char* smem) {
  const int t = tid_(), lane = t & 63, w = t >> 6;
  float* wr = (float*)smem;
  for (int idx = t; idx < DM * NE; idx += 256) { const int d = idx >> 4, e = idx & 15; wr[e * DM + d] = p.w_router[idx]; }
  __syncthreads();
  const int gw = blockIdx.x * 4 + w, nw = gridDim.x * 4;
  for (int R = gw; R < NT; R += nw) {
    asm volatile("" ::: "memory");
    const float* src = p.out + (size_t)R * DM;
    const int b = R >> 11;
    const float* md = p.mod + b * 6144;
    float4 v[4]; float ss = 0.f;
#pragma unroll
    for (int i = 0; i < 4; ++i) { v[i] = *(const float4*)(src + lane * 4 + 256 * i); ss += v[i].x * v[i].x + v[i].y * v[i].y + v[i].z * v[i].z + v[i].w * v[i].w; }
    ss = wave_sum(ss);
    const float rr = rsqrtf(ss * (1.f / DM) + EPS);
#pragma unroll
    for (int i = 0; i < 4; ++i) {
      const int d = lane * 4 + 256 * i;
      const float4 g = *(const float4*)(p.norm2_g + d);
      const float4 sh = *(const float4*)(md + 3072 + d);
      const float4 sc = *(const float4*)(md + 4096 + d);
      v[i].x = v[i].x * rr * g.x * (1.f + sc.x) + sh.x;
      v[i].y = v[i].y * rr * g.y * (1.f + sc.y) + sh.y;
      v[i].z = v[i].z * rr * g.z * (1.f + sc.z) + sh.z;
      v[i].w = v[i].w * rr * g.w * (1.f + sc.w) + sh.w;
      uint2 o; o.x = pk_bf16(v[i].x, v[i].y); o.y = pk_bf16(v[i].z, v[i].w);
      *(uint2*)(p.h2 + (size_t)R * DM + d) = o;
    }
    float a[16];
#pragma unroll
    for (int e = 0; e < 16; ++e) {
      float s = 0.f;
#pragma unroll
      for (int i = 0; i < 4; ++i) { const float4 wv = *(const float4*)(wr + e * DM + lane * 4 + 256 * i); s += v[i].x * wv.x + v[i].y * wv.y + v[i].z * wv.z + v[i].w * wv.w; }
      a[e] = s;
      if ((e & 3) == 3) __builtin_amdgcn_sched_barrier(0);
    }
    float a8[8], a4[4], a2[2], a1;
    {
      const bool up = lane & 32;
#pragma unroll
      for (int j = 0; j < 8; ++j) { const float send = up ? a[j] : a[j + 8]; const float keep = up ? a[j + 8] : a[j]; a8[j] = keep + __shfl_xor(send, 32); }
    }
    {
      const bool up = lane & 16;
#pragma unroll
      for (int j = 0; j < 4; ++j) { const float send = up ? a8[j] : a8[j + 4]; const float keep = up ? a8[j + 4] : a8[j]; a4[j] = keep + __shfl_xor(send, 16); }
    }
    {
      const bool up = lane & 8;
#pragma unroll
      for (int j = 0; j < 2; ++j) { const float send = up ? a4[j] : a4[j + 2]; const float keep = up ? a4[j + 2] : a4[j]; a2[j] = keep + __shfl_xor(send, 8); }
    }
    {
      const bool up = lane & 4;
      const float send = up ? a2[0] : a2[1]; const float keep = up ? a2[1] : a2[0]; a1 = keep + __shfl_xor(send, 4);
    }
    a1 += __shfl_xor(a1, 2);
    a1 += __shfl_xor(a1, 1);
    float mx = a1;
#pragma unroll
    for (int o = 4; o <= 32; o <<= 1) mx = fmaxf(mx, __shfl_xor(mx, o));
    const float ex = __expf(a1 - mx);
    float sm = ex;
#pragma unroll
    for (int o = 4; o <= 32; o <<= 1) sm += __shfl_xor(sm, o);
    if ((lane & 3) == 0) {
      const int e = (lane >> 2) & 15;
      p.aff[((size_t)(b * NE + e)) * SEQ + (R & 2047)] = ex / sm;
    }
  }
}

DI void phase8(const Params& p) {
  const int t_ = tid_(); const int lane = t_ & 63, w = t_ >> 6;
  const int gw = blockIdx.x * 4 + w, nw = gridDim.x * 4;
  for (int pr = gw; pr < NB * NE; pr += nw) {
    const float* a = p.aff + (size_t)pr * SEQ;
    unsigned u[32];
#pragma unroll
    for (int q = 0; q < 32; ++q) u[q] = __float_as_uint(a[q * 64 + lane]);
    unsigned thr = 0;
    for (int bit = 30; bit >= 0; --bit) {
      const unsigned cand = thr | (1u << bit);
      int cnt = 0;
#pragma unroll
      for (int q = 0; q < 32; ++q) cnt += __popcll(__ballot(u[q] >= cand));
      if (cnt >= CAP) thr = cand;
    }
    int ngt = 0;
#pragma unroll
    for (int q = 0; q < 32; ++q) ngt += __popcll(__ballot(u[q] > thr));
    int cgt = 0, ceq = 0;
    int* io = p.idx + pr * CAP; float* go = p.gate + pr * CAP;
    int* iv = p.inv + (size_t)pr * SEQ;
#pragma unroll
    for (int q = 0; q < 32; ++q) {
      const bool gt = u[q] > thr, eq = u[q] == thr;
      const unsigned long long mg = __ballot(gt), me = __ballot(eq);
      const unsigned long long below = (1ull << lane) - 1ull;
      int myslot = -1;
      if (gt) { const int s = cgt + __popcll(mg & below); io[s] = q * 64 + lane; go[s] = __uint_as_float(u[q]); myslot = s; }
      if (eq) { const int s = ngt + ceq + __popcll(me & below); if (s < CAP) { io[s] = q * 64 + lane; go[s] = __uint_as_float(u[q]); myslot = s; } }
      iv[q * 64 + lane] = myslot;
      cgt += __popcll(mg); ceq += __popcll(me);
    }
  }
}

DI void phase9(const Params& p, char* smem) {
  const int t = tid_(), lane = t & 63, w = t >> 6, r = lane & 31, hh = lane >> 5;
  const int wm = w & 1, wn = w >> 1;
  const int xcd = blockIdx.x & 7, jl = blockIdx.x >> 3, nl = gridDim.x >> 3;
  for (int L = jl; L < 1024; L += nl) {
    const int e = xcd * 2 + (L >> 9), rem = L & 511, ft = (rem >> 3) & 7, st = rem & 1, b = (rem >> 6) * 4 + ((rem & 7) >> 1);
    const int be = b * NE + e;
    const bf16_t* Ab = p.WguT + ((size_t)e * 1024 + ft * 128) * DM;
    const int* ib = p.idx + be * CAP + st * 128;
    const bf16_t* hb = p.h2 + (size_t)b * SEQ * DM;
    f32x16 acc[2][2];
#pragma unroll
    for (int a = 0; a < 2; ++a)
#pragma unroll
      for (int c = 0; c < 2; ++c) acc[a][c] = zero16();
    float dummy = 0.f;
    gemm_core<2, 2, 2, 2, false>(acc, [&](int row) { return Ab + (size_t)row * DM; }, [&](int row) { return hb + (size_t)ib[row] * DM; }, DM, smem, dummy);
    {
#pragma unroll
      for (int tn = 0; tn < 2; ++tn) {
        char* d = smem + (wn * 64 + tn * 32 + r) * 144 + (wm * 32 + 4 * hh) * 2;
#pragma unroll
        for (int q = 0; q < 4; ++q) {
          float v[4];
#pragma unroll
          for (int j = 0; j < 4; ++j) { const float g = acc[0][tn][4 * q + j], uu = acc[1][tn][4 * q + j]; v[j] = g * sigmoidf_(g) * uu; }
          uint2 ou; ou.x = pk_bf16(v[0], v[1]); ou.y = pk_bf16(v[2], v[3]);
          *(uint2*)(d + 16 * q) = ou;
        }
      }
      __syncthreads();
      const int ch = t & 7, r0 = t >> 3;
#pragma unroll
      for (int i = 0; i < 4; ++i) {
        const int row = r0 + 32 * i;
        const uint4 v = *(const uint4*)(smem + row * 144 + ch * 16);
        *(uint4*)(p.hmid + ((size_t)be * CAP + st * 128 + row) * DE + ft * 64 + ch * 8) = v;
      }
      __syncthreads();
    }
  }
}

DI void phase10(const Params& p, char* smem) {
  const int t = tid_(), lane = t & 63, w = t >> 6, r = lane & 31, hh = lane >> 5;
  const int wm = w & 1, wn = w >> 1;
  const int xcd = blockIdx.x & 7, jl = blockIdx.x >> 3, nl = gridDim.x >> 3;
  for (int L = jl; L < 1024; L += nl) {
    const int e = xcd * 2 + (L >> 9), rem = L & 511, nt = (rem >> 3) & 7, st = rem & 1, b = (rem >> 6) * 4 + ((rem & 7) >> 1);
    const int be = b * NE + e;
    const bf16_t* Hb = p.hmid + ((size_t)be * CAP + st * 128) * DE;
    const bf16_t* Wb = p.WdT + ((size_t)e * DM + nt * 128) * DE;
    f32x16 acc[2][2];
#pragma unroll
    for (int a = 0; a < 2; ++a)
#pragma unroll
      for (int c = 0; c < 2; ++c) acc[a][c] = zero16();
    float dummy = 0.f;
    gemm_core<2, 2, 2, 2, false>(acc, [&](int row) { return Wb + (size_t)row * DE; }, [&](int row) { return Hb + (size_t)row * DE; }, DE, smem, dummy);
    stage_tile(acc, smem, [](float v) { return v; });
    __syncthreads();
    bf16_t* yb = p.Y + ((size_t)be * CAP + st * 128) * DM + nt * 128;
    copy_tile(smem, [&](int row) { return yb + (size_t)row * DM; }, 16);
    __syncthreads();
  }
}

DI void phase11(const Params& p) {
  const int t_ = tid_(); const int lane = t_ & 63, w = t_ >> 6;
  const int gw = blockIdx.x * 4 + w, nw = gridDim.x * 4;
  for (int R = gw; R < NT; R += nw) {
    const int b = R >> 11, tq = R & 2047;
    const int myslot = (lane < NE) ? p.inv[((size_t)(b * NE + lane)) * SEQ + tq] : -1;
    unsigned long long mask = __ballot(myslot >= 0);
    if (mask == 0ull) continue;
    float4 a[4];
#pragma unroll
    for (int i = 0; i < 4; ++i) a[i] = make_float4(0.f, 0.f, 0.f, 0.f);
    while (mask) {
      const int e = __ffsll((long long)mask) - 1; mask &= mask - 1ull;
      const int slot = __shfl(myslot, e);
      const float g = p.gate[(b * NE + e) * CAP + slot];
      const bf16_t* y = p.Y + ((size_t)(b * NE + e) * CAP + slot) * DM + lane * 4;
#pragma unroll
      for (int i = 0; i < 4; ++i) {
        const uint2 u = *(const uint2*)(y + 256 * i);
        a[i].x += g * bf_lo(u.x); a[i].y += g * bf_hi(u.x); a[i].z += g * bf_lo(u.y); a[i].w += g * bf_hi(u.y);
      }
    }
    const float* g2 = p.mod + b * 6144 + 5120;
    float* o = p.out + (size_t)R * DM;
#pragma unroll
    for (int i = 0; i < 4; ++i) {
      const int d = lane * 4 + 256 * i;
      const float4 gv = *(const float4*)(g2 + d);
      float4 xv = *(float4*)(o + d);
      xv.x += gv.x * a[i].x; xv.y += gv.y * a[i].y; xv.z += gv.z * a[i].z; xv.w += gv.w * a[i].w;
      *(float4*)(o + d) = xv;
    }
  }
}

__global__ void __launch_bounds__(256, 2) mega_kernel(Params p) {
  cg::grid_group grid = cg::this_grid();
  __shared__ __attribute__((aligned(16))) char smem[SMEM_BYTES];
#ifndef REPMASK
#define REPMASK 0
#endif
#define RUNPH(k, call) for (int rep_ = 0; rep_ < (((REPMASK) >> (k)) & 1) + 1; ++rep_) { call; grid.sync(); }
  RUNPH(0, phase0(p, smem))
  RUNPH(1, phase1(p))
  RUNPH(2, phase2(p, smem))
  RUNPH(3, phase3(p, smem))
  RUNPH(4, phase4(p, smem))
  RUNPH(5, phase5(p, smem))
  RUNPH(6, phase6(p, smem))
  RUNPH(7, phase7(p, smem))
  RUNPH(8, phase8(p))
  RUNPH(9, phase9(p, smem))
  phase10(p, smem);
  grid.sync();
  phase11(p);
}

static inline size_t align_up(size_t v, size_t a) { return (v + a - 1) / a * a; }

extern "C" void kernel_launch(void* const* d_in, const int* in_sizes, int n_in,
                              void* d_out, int out_size, void* d_ws, size_t ws_size,
                              hipStream_t stream) {
  static int grid_blocks = 0;
  if (!grid_blocks) {
    int dev = 0, cus = 0, per_cu = 0;
    (void)hipGetDevice(&dev);
    (void)hipDeviceGetAttribute(&cus, hipDeviceAttributeMultiprocessorCount, dev);
    (void)hipOccupancyMaxActiveBlocksPerMultiprocessor(&per_cu, mega_kernel, 256, 0);
    if (per_cu > 2) per_cu = 2;
    if (per_cu < 1) per_cu = 1;
    grid_blocks = (cus * per_cu) & ~7;
    if (grid_blocks < 8) grid_blocks = 8;
  }
  Params p;
  memset(&p, 0, sizeof(p));
  const float* x = (const float*)d_in[0];
  p.x = x; p.c = (const float*)d_in[1]; p.ctx = (const float*)d_in[2]; p.c_ctx = (const float*)d_in[3];
  p.w_mod = (const float*)d_in[4]; p.b_mod = (const float*)d_in[5]; p.norm1_g = (const float*)d_in[6];
  const float* w_in = (const float*)d_in[7];
  const float* q_a_g = (const float*)d_in[8];
  const float* kv_a_g = (const float*)d_in[9];
  const float* w_q_up = (const float*)d_in[10];
  const float* w_kv_up = (const float*)d_in[11];
  p.q_norm_g = (const float*)d_in[12]; p.k_norm_g = (const float*)d_in[13];
  const float* w_o_attn = (const float*)d_in[14];
  const float* w_fourier = (const float*)d_in[15];
  const float* w_out = (const float*)d_in[16];
  p.norm2_g = (const float*)d_in[17]; p.w_router = (const float*)d_in[18];
  const float* w_e_gate = (const float*)d_in[19];
  const float* w_e_up = (const float*)d_in[20];
  const float* w_e_down = (const float*)d_in[21];
  p.out = (float*)d_out;

  char* base = (char*)d_ws; size_t off = 0;
  auto alloc = [&](size_t bytes) { char* q = base + off; off = align_up(off + bytes, 256); return q; };
  p.WinT = (bf16_t*)alloc((size_t)NINP * DM * 2);
  p.WqT = (bf16_t*)alloc((size_t)768 * QL * 2);
  p.WkvT = (bf16_t*)alloc((size_t)1024 * KVL * 2);
  p.WoT = (bf16_t*)alloc((size_t)DM * 512 * 2);
  p.WfT = (bf16_t*)alloc((size_t)DM * 512 * 2);
  p.WoutT = (bf16_t*)alloc((size_t)DM * DM * 2);
  p.WguT = (bf16_t*)alloc((size_t)NE * 1024 * DM * 2);
  p.WdT = (bf16_t*)alloc((size_t)NE * DM * DE * 2);
  p.chanT = (bf16_t*)alloc((size_t)256 * 128 * 2);
  p.posM = (bf16_t*)alloc((size_t)2 * 1152 * 2048 * 2);
  p.ropeTab = (float*)alloc(64 * 8 * 2 * 4);
  p.mod = (float*)alloc(33 * 6144 * 4);
  p.aff = (float*)alloc((size_t)NB * NE * SEQ * 4);
  p.gate = (float*)alloc((size_t)NB * NE * CAP * 4);
  p.idx = (int*)alloc((size_t)NB * NE * CAP * 4);
  p.inv = (int*)alloc((size_t)NB * NE * SEQ * 4);
  p.pckv = (bf16_t*)alloc((size_t)NC * LDCKV * 2);
  char* regA = alloc((size_t)(NT + NC) * DM * 2);
  p.h = (bf16_t*)regA; p.ABt = (bf16_t*)regA; p.h2 = (bf16_t*)regA;
  char* regB1 = alloc((size_t)NT * LDQKV * 2);
  p.pqkv = (bf16_t*)regB1; p.attn_o = (bf16_t*)regB1;
  char* regB2 = alloc((size_t)NT * 512 * 2);
  p.pf = (bf16_t*)regB2; p.four_o = (bf16_t*)regB2;
  p.pg = (bf16_t*)alloc((size_t)NT * 2048 * 2);
  p.Y = p.pg;
  const size_t szQ = (size_t)NB * NH * SEQ * QKD * 2, szK = (size_t)NB * NH * NKEY * QKD * 2, szV = (size_t)NB * NH * VD * NKEY * 2;
  char* regC = alloc(szQ + szK + szV + 1024);
  p.Q = (bf16_t*)regC; p.K = (bf16_t*)(regC + align_up(szQ, 256)); p.Vt = (bf16_t*)(regC + align_up(szQ, 256) + align_up(szK, 256));
  p.m = (bf16_t*)regC; p.hmid = (bf16_t*)(regC + (size_t)NT * DM * 2);
  if (off > ws_size) { fprintf(stderr, "workspace too small: need %zu have %zu\n", off, ws_size); return; }

  int ts = 0;
  auto job = [&](int i, const float* src, bf16_t* dst, const float* scale, int K, int ldS, int n_off, int n_cnt, int dst_row0, int mode, int batch, long sbs, long dbs) {
    TJob& j = p.jobs[i];
    j.src = src; j.dst = dst; j.scale = scale; j.K = K; j.ldS = ldS; j.n_off = n_off; j.n_cnt = n_cnt; j.dst_row0 = dst_row0; j.mode = mode; j.batch = batch;
    j.tiles_n = (n_cnt + 63) / 64; j.tile_start = ts; j.src_bstride = sbs; j.dst_bstride = dbs;
    ts += batch * (K / 64) * j.tiles_n;
  };
  job(0, w_e_gate, p.WguT, nullptr, DM, DE, 0, DE, 0, 1, NE, (long)DM * DE, (long)1024 * DM);
  job(1, w_e_up, p.WguT, nullptr, DM, DE, 0, DE, 0, 2, NE, (long)DM * DE, (long)1024 * DM);
  job(2, w_e_down, p.WdT, nullptr, DE, DM, 0, DM, 0, 0, NE, (long)DE * DM, (long)DM * DE);
  job(3, w_in, p.WinT, nullptr, DM, N_IN, 0, 640, 0, 0, 1, 0, 0);
  job(4, w_in, p.WinT, nullptr, DM, N_IN, 672, 2560, 640, 0, 1, 0, 0);
  job(5, w_in, p.WinT, nullptr, DM, N_IN, 640, 32, 3200, 0, 1, 0, 0);
  job(6, w_q_up, p.WqT, q_a_g, QL, 768, 0, 768, 0, 0, 1, 0, 0);
  job(7, w_kv_up, p.WkvT, kv_a_g, KVL, 1024, 0, 1024, 0, 0, 1, 0, 0);
  job(8, w_o_attn, p.WoT, nullptr, 512, DM, 0, DM, 0, 0, 1, 0, 0);
  job(9, w_fourier, p.WfT, nullptr, 512, DM, 0, DM, 0, 0, 1, 0, 0);
  job(10, w_out, p.WoutT, nullptr, DM, DM, 0, DM, 0, 0, 1, 0, 0);
  p.n_ttiles = ts;

  void* args[] = {&p};
  hipError_t e = hipLaunchCooperativeKernel((void*)mega_kernel, dim3(grid_blocks), dim3(256), args, 0, stream);
  if (e != hipSuccess) fprintf(stderr, "cooperative launch failed: %s (grid %d)\n", hipGetErrorString(e), grid_blocks);
}
```

```cpp
#include <hip/hip_runtime.h>
#include <hip/hip_cooperative_groups.h>
#include <cstdio>
#include <cstring>
#include <cstdint>
namespace cg = cooperative_groups;

#define DI __device__ __forceinline__
typedef unsigned short bf16_t;
typedef short bf16x8 __attribute__((ext_vector_type(8)));
typedef float f32x16 __attribute__((ext_vector_type(16)));
#define MFMA(a, b, c) __builtin_amdgcn_mfma_f32_32x32x16_bf16((a), (b), (c), 0, 0, 0)

constexpr int NB = 32, SEQ = 2048, DM = 1024, NT = NB * SEQ, CTXL = 256, NC = NB * CTXL;
constexpr int NH = 8, QKD = 96, VD = 64, QL = 384, KVL = 256, NKEY = SEQ + CTXL;
constexpr int N_IN = 3232, NINP = 3328;
constexpr int NE = 16, DE = 512, CAP = 256;
constexpr float EPS = 1e-6f;
constexpr int LDQKV = 672, LDCKV = 288;
constexpr int SMEM_BYTES = 73728;

struct TJob {
  const float* src; bf16_t* dst; const float* scale;
  int K, ldS, n_off, n_cnt, dst_row0, mode, batch, tiles_n, tile_start, pad0;
  long src_bstride, dst_bstride;
};
constexpr int NJOBS = 11;

struct Params {
  const float *x, *c, *ctx, *c_ctx, *w_mod, *b_mod, *norm1_g, *q_norm_g, *k_norm_g, *norm2_g, *w_router;
  float* out;
  bf16_t *WinT, *WqT, *WkvT, *WoT, *WfT, *WoutT, *WguT, *WdT, *chanT, *posM;
  float *ropeTab, *mod;
  bf16_t *h, *pqkv, *pckv, *pf, *pg, *Q, *K, *Vt, *attn_o, *ABt, *four_o, *m, *h2, *hmid;
  float *aff, *gate;
  int* idx;
  int* inv;
  bf16_t* Y;
  TJob jobs[NJOBS];
  int n_ttiles, pad1;
};

typedef float f32x2v __attribute__((ext_vector_type(2)));
typedef __bf16 bf16x2v __attribute__((ext_vector_type(2)));
DI unsigned pk_bf16(float lo, float hi) { f32x2v v = {lo, hi}; bf16x2v b = __builtin_convertvector(v, bf16x2v); return __builtin_bit_cast(unsigned, b); }
DI int tid_() { int t = threadIdx.x; asm volatile("" : "+v"(t)); return t; }
DI float bf_lo(unsigned u) { return __uint_as_float(u << 16); }
DI float bf_hi(unsigned u) { return __uint_as_float(u & 0xffff0000u); }
DI float bf2f(bf16_t b) { return __uint_as_float(((unsigned)b) << 16); }
DI bf16_t f2bf(float f) { return (bf16_t)(pk_bf16(f, 0.f) & 0xffffu); }
DI float sigmoidf_(float x) { return 1.f / (1.f + __expf(-x)); }
DI int crow(int i, int hh) { return (i & 3) + 8 * (i >> 2) + 4 * hh; }
DI float wave_sum(float v) {
#pragma unroll
  for (int o = 32; o >= 1; o >>= 1) v += __shfl_xor(v, o);
  return v;
}
DI f32x16 zero16() { f32x16 z;
#pragma unroll
  for (int i = 0; i < 16; ++i) z[i] = 0.f; return z; }

DI void wait_vm0() { asm volatile("s_waitcnt vmcnt(0)" ::: "memory"); }
DI void wait_lgkm0() { asm volatile("s_waitcnt lgkmcnt(0)" ::: "memory"); }
DI void bar_() { __builtin_amdgcn_s_barrier(); }
DI void lds_sync() { wait_lgkm0(); bar_(); }
#define GLDS(gp, lp) __builtin_amdgcn_global_load_lds((const unsigned*)(gp), (__attribute__((address_space(3))) unsigned*)(lp), 16, 0, 0)
#define SB_ __builtin_amdgcn_sched_barrier(0)
constexpr int EPI_OFF = 32768;

template <int TM, int TN, int WM, int WN, bool SUMSQ, class AF, class BF, class AFN, class BFN>
DI void gemm_core2(f32x16 (&acc)[TM][TN], AF arow, BF brow, int K, char* smem, float& sumsq, bool pre, bool hasNext, AFN arowN, BFN browN) {
  constexpr int RA = 32 * TM * WM, RB = 32 * TN * WN, NA = RA / 32, NBR = RB / 32;
  constexpr int LDR = 128;
  constexpr int STAGE = 32768;
  static_assert((RA + RB) * LDR <= STAGE, "stage");
  static_assert(NBR == 4 && (NA == 3 || NA == 4), "loader shape");
  const int t = tid_(), lane = t & 63, w = t >> 6, r = lane & 31, hh = lane >> 5;
  const int wm = w % WM, wn = w / WM;
  const int row0 = t >> 3;
  const int c = (t & 7) ^ ((row0 >> 1) & 7);
  const bf16_t* pa0 = arow(row0) + c * 8; const bf16_t* pa1 = arow(row0 + 32) + c * 8; const bf16_t* pa2 = arow(row0 + 64) + c * 8;
  const bf16_t* pa3 = (NA > 3) ? arow(row0 + 96) + c * 8 : pa2;
  const bf16_t* pb0 = brow(row0) + c * 8; const bf16_t* pb1 = brow(row0 + 32) + c * 8; const bf16_t* pb2 = brow(row0 + 64) + c * 8; const bf16_t* pb3 = brow(row0 + 96) + c * 8;
  if (!pre) {
    char* l_ = smem + t * 16; char* m_ = l_ + RA * LDR;
    GLDS(pa0, l_); GLDS(pa1, l_ + 4096); GLDS(pa2, l_ + 8192); if (NA > 3) GLDS(pa3, l_ + 12288);
    GLDS(pb0, m_); GLDS(pb1, m_ + 4096); GLDS(pb2, m_ + 8192); GLDS(pb3, m_ + 12288);
  }
  wait_vm0(); bar_();
  const int nk = K >> 6;
  const int sw = (r >> 1) & 7;
  const int aoff = (wm * TM * 32 + r) * LDR, boff = RA * LDR + (wn * TN * 32 + r) * LDR;
  auto compute = [&](const char* cur, char* nxt, bool issue, const bf16_t* q0, const bf16_t* q1, const bf16_t* q2, const bf16_t* q3,
                     const bf16_t* s0, const bf16_t* s1, const bf16_t* s2, const bf16_t* s3) {
    const char* As = cur + aoff;
    const char* Bs = cur + boff;
    char* l_ = nxt + t * 16; char* m_ = l_ + RA * LDR;
    bf16x8 a0[TM], b0[TN], a1[TM], b1[TN];
#define LOADF(A_, B_, ks) do { const int po_ = (((ks) * 2 + hh) ^ sw) * 16; \
      _Pragma("unroll") for (int tm = 0; tm < TM; ++tm) A_[tm] = *(const bf16x8*)(As + tm * 32 * LDR + po_); \
      _Pragma("unroll") for (int tn = 0; tn < TN; ++tn) B_[tn] = *(const bf16x8*)(Bs + tn * 32 * LDR + po_); } while (0)
#define MMF(A_, B_) do { if (SUMSQ) { uint4 u = __builtin_bit_cast(uint4, B_[0]); \
        float e0 = bf_lo(u.x), e1 = bf_hi(u.x), e2 = bf_lo(u.y), e3 = bf_hi(u.y), e4 = bf_lo(u.z), e5 = bf_hi(u.z), e6 = bf_lo(u.w), e7 = bf_hi(u.w); \
        sumsq += e0 * e0 + e1 * e1 + e2 * e2 + e3 * e3 + e4 * e4 + e5 * e5 + e6 * e6 + e7 * e7; } \
      _Pragma("unroll") for (int tm = 0; tm < TM; ++tm) _Pragma("unroll") for (int tn = 0; tn < TN; ++tn) acc[tm][tn] = MFMA(A_[tm], B_[tn], acc[tm][tn]); } while (0)
    LOADF(a0, b0, 0);
    LOADF(a1, b1, 1);
    SB_;
    if (issue) { GLDS(q0, l_); GLDS(q1, l_ + 4096); }
    SB_;
    __builtin_amdgcn_s_setprio(1);
    MMF(a0, b0);
    LOADF(a0, b0, 2);
    SB_;
    if (issue) { GLDS(q2, l_ + 8192); if (NA > 3) GLDS(q3, l_ + 12288); }
    SB_;
    MMF(a1, b1);
    LOADF(a1, b1, 3);
    SB_;
    if (issue) { GLDS(s0, m_); GLDS(s1, m_ + 4096); }
    SB_;
    MMF(a0, b0);
    SB_;
    if (issue) { GLDS(s2, m_ + 8192); GLDS(s3, m_ + 12288); }
    SB_;
    MMF(a1, b1);
    __builtin_amdgcn_s_setprio(0);
  };
  for (int kt = 0; kt < nk - 1; ++kt) {
    const int ko = (kt + 1) * 64;
    SB_;
    compute(smem + (kt & 1) * STAGE, smem + ((kt + 1) & 1) * STAGE, true, pa0 + ko, pa1 + ko, pa2 + ko, pa3 + ko, pb0 + ko, pb1 + ko, pb2 + ko, pb3 + ko);
    SB_;
    wait_vm0(); bar_();
  }
  {
    const bf16_t *q0 = pa0, *q1 = pa0, *q2 = pa0, *q3 = pa0, *s0 = pa0, *s1 = pa0, *s2 = pa0, *s3 = pa0;
    if (hasNext) {
      q0 = arowN(row0) + c * 8; q1 = arowN(row0 + 32) + c * 8; q2 = arowN(row0 + 64) + c * 8; q3 = (NA > 3) ? arowN(row0 + 96) + c * 8 : q2;
      s0 = browN(row0) + c * 8; s1 = browN(row0 + 32) + c * 8; s2 = browN(row0 + 64) + c * 8; s3 = browN(row0 + 96) + c * 8;
    }
    SB_;
    compute(smem + ((nk - 1) & 1) * STAGE, smem, hasNext, q0, q1, q2, q3, s0, s1, s2, s3);
    SB_;
    lds_sync();
  }
}
template <int TM, int TN, int WM, int WN, bool SUMSQ, class AF, class BF>
DI void gemm_core(f32x16 (&acc)[TM][TN], AF arow, BF brow, int K, char* smem, float& sumsq) {
  gemm_core2<TM, TN, WM, WN, SUMSQ>(acc, arow, brow, K, smem, sumsq, false, false, arow, brow);
}

constexpr int LDT = 272;
template <class F>
DI void stage_tile(const f32x16 (&acc)[2][2], char* tile, F f) {
  const int t = tid_(), lane = t & 63, w = t >> 6, r = lane & 31, hh = lane >> 5;
  const int wm = w & 1, wn = w >> 1;
#pragma unroll
  for (int tm = 0; tm < 2; ++tm)
#pragma unroll
    for (int tn = 0; tn < 2; ++tn) {
      char* d = tile + (wn * 64 + tn * 32 + r) * LDT + (wm * 64 + tm * 32 + 4 * hh) * 2;
#pragma unroll
      for (int q = 0; q < 4; ++q) {
        uint2 o; o.x = pk_bf16(f(acc[tm][tn][4 * q]), f(acc[tm][tn][4 * q + 1])); o.y = pk_bf16(f(acc[tm][tn][4 * q + 2]), f(acc[tm][tn][4 * q + 3]));
        *(uint2*)(d + 16 * q) = o;
      }
    }
}
template <class RF>
DI void copy_tile(const char* tile, RF dst, int nch) {
  const int t = tid_(), ch = t & 15, r0 = t >> 4;
  if (ch < nch) {
#pragma unroll
    for (int i = 0; i < 8; ++i) {
      const int row = r0 + 16 * i;
      const uint4 v = *(const uint4*)(tile + row * LDT + ch * 16);
      *(uint4*)(dst(row) + ch * 8) = v;
    }
  }
}

DI void transpose_tile(const TJob& j, int tile, char* smem) {
  const int t = tid_();
  const int tpb = (j.K >> 6) * j.tiles_n;
  const int bi = tile / tpb, rem = tile % tpb;
  const int kt = rem / j.tiles_n, ntile = rem % j.tiles_n;
  const int k0 = kt * 64, n0 = ntile * 64;
  const float* src = j.src + (size_t)bi * j.src_bstride;
  bf16_t* dst = j.dst + (size_t)bi * j.dst_bstride;
  bf16_t* T = (bf16_t*)smem;
  const int nn = t & 63, kq = t >> 6;
  const bool nvalid = (n0 + nn) < j.n_cnt;
  __syncthreads();
#pragma unroll 4
  for (int i = 0; i < 16; ++i) {
    const int kk = kq + 4 * i;
    float v = 0.f;
    if (nvalid) {
      v = src[(size_t)(k0 + kk) * j.ldS + j.n_off + n0 + nn];
      if (j.scale) v *= j.scale[k0 + kk];
    }
    T[nn * 66 + kk] = f2bf(v);
  }
  __syncthreads();
  const int n = t >> 2, part = t & 3;
  if (n0 + n < j.n_cnt) {
    const unsigned* tp = (const unsigned*)(T + n * 66 + part * 16);
    uint4 o0, o1;
    o0.x = tp[0]; o0.y = tp[1]; o0.z = tp[2]; o0.w = tp[3];
    o1.x = tp[4]; o1.y = tp[5]; o1.z = tp[6]; o1.w = tp[7];
    const int f = n0 + n;
    int drow;
    if (j.mode == 0) drow = j.dst_row0 + f;
    else drow = (f >> 6) * 128 + ((f & 63) >> 5) * 64 + (j.mode == 2 ? 32 : 0) + (f & 31);
    uint4* dp = (uint4*)(dst + (size_t)drow * j.K + k0 + part * 16);
    dp[0] = o0; dp[1] = o1;
  }
}

DI void mod_item(const Params& p, int it, char* smem) {
  const int t = tid_(), cgi = t & 15, kg = t >> 4;
  const int j0 = it * 16;
  float* Ssm = (float*)smem;
  float* red = (float*)(smem + 33 * 128 * 4);
  float acc[33];
#pragma unroll
  for (int r = 0; r < 33; ++r) acc[r] = 0.f;
#pragma unroll 1
  for (int kc = 0; kc < 8; ++kc) {
    __syncthreads();
    for (int idx = t; idx < 33 * 128; idx += 256) {
      const int r = idx >> 7, kk = idx & 127;
      float v = (r < 32) ? p.c[r * DM + kc * 128 + kk] : p.c_ctx[kc * 128 + kk];
      Ssm[idx] = v * sigmoidf_(v);
    }
    __syncthreads();
#pragma unroll 1
    for (int kk = 0; kk < 8; kk += 4) {
      const int k = kc * 128 + kg * 8 + kk;
      const float w0 = p.w_mod[(size_t)(k + 0) * 6144 + j0 + cgi];
      const float w1 = p.w_mod[(size_t)(k + 1) * 6144 + j0 + cgi];
      const float w2 = p.w_mod[(size_t)(k + 2) * 6144 + j0 + cgi];
      const float w3 = p.w_mod[(size_t)(k + 3) * 6144 + j0 + cgi];
#pragma unroll
      for (int r = 0; r < 33; ++r) {
        const float4 s = *(const float4*)(Ssm + r * 128 + kg * 8 + kk);
        acc[r] += s.x * w0 + s.y * w1 + s.z * w2 + s.w * w3;
      }
    }
  }
  __syncthreads();
#pragma unroll
  for (int r = 0; r < 33; ++r) red[(kg * 33 + r) * 16 + cgi] = acc[r];
  __syncthreads();
  for (int idx = t; idx < 33 * 16; idx += 256) {
    const int r = idx >> 4, cc = idx & 15;
    float s = 0.f;
#pragma unroll
    for (int g = 0; g < 16; ++g) s += red[(g * 33 + r) * 16 + cc];
    p.mod[r * 6144 + j0 + cc] = s + p.b_mod[j0 + cc];
  }
}

DI void phase0(const Params& p, char* smem) {
  const int t = tid_();
  const int nMod = 384;
  const int nPos = 288;
  const int nMisc = 3;
  const int nT = p.n_ttiles;
  const int total = nMod + nT + nPos + nMisc;
  float* ctab = (float*)(smem + 65536 - 8192 - 1024);
  for (int j = t; j < 2048; j += 256) ctab[j] = cospif((float)j * (1.f / 1024.f));
  __syncthreads();
  for (int it = blockIdx.x; it < total; it += gridDim.x) {
    if (it < nMod) { mod_item(p, it, smem); continue; }
    int u = it - nMod;
    if (u < nT) {
      int jb = 0;
#pragma unroll 1
      for (int q = 1; q < NJOBS; ++q) if (u >= p.jobs[q].tile_start) jb = q;
      transpose_tile(p.jobs[jb], u - p.jobs[jb].tile_start, smem);
      continue;
    }
    u -= nT;
    if (u < nPos) {
      for (int e = t; e < 8 * 256; e += 256) {
        const int R = u * 8 + (e >> 8), c8 = (e & 255) * 8;
        const int part = R >= 1152 ? 1 : 0, k = R - part * 1152;
        float v[8];
#pragma unroll
        for (int q = 0; q < 8; ++q) {
          const int tt = c8 + q;
          v[q] = (k > 1024) ? 0.f : (part ? ctab[(k * tt - 512) & 2047] : ctab[(k * tt) & 2047]);
        }
        uint4 o; o.x = pk_bf16(v[0], v[1]); o.y = pk_bf16(v[2], v[3]); o.z = pk_bf16(v[4], v[5]); o.w = pk_bf16(v[6], v[7]);
        *(uint4*)(p.posM + (size_t)R * 2048 + c8) = o;
      }
      continue;
    }
    u -= nPos;
    if (u == 0) {
      for (int e = t; e < 256 * 128; e += 256) {
        const int m2 = e >> 7, cc = e & 127, mm = m2 & 127;
        float v = (m2 < 128) ? ctab[(mm * cc * 16) & 2047] : ctab[(mm * cc * 16 - 512) & 2047];
        p.chanT[e] = f2bf(v);
      }
    } else if (u == 1) {
      for (int e = t; e < 64 * 8; e += 256) {
        const int pos = e >> 3, jf = e & 7;
        const float inv = 1.0f / powf(10000.0f, (float)jf / 8.0f);
        const float ang = (float)pos * inv;
        p.ropeTab[e * 2 + 0] = cosf(ang);
        p.ropeTab[e * 2 + 1] = sinf(ang);
      }
    } else {
      uint4 z; z.x = z.y = z.z = z.w = 0u;
      uint4* dp = (uint4*)(p.WinT + (size_t)N_IN * DM);
      for (int e = t; e < (NINP - N_IN) * DM / 8; e += 256) dp[e] = z;
    }
  }
}

DI void phase1(const Params& p) {
  const int t_ = tid_(); const int lane = t_ & 63, w = t_ >> 6;
  const int gw = blockIdx.x * 4 + w, nw = gridDim.x * 4;
  for (int R0 = gw; R0 < NT + NC; R0 += 2 * nw) {
    const int R1 = R0 + nw; const bool has1 = R1 < NT + NC;
    const float* src0 = (R0 < NT) ? p.x + (size_t)R0 * DM : p.ctx + (size_t)(R0 - NT) * DM;
    const float* src1 = has1 ? ((R1 < NT) ? p.x + (size_t)R1 * DM : p.ctx + (size_t)(R1 - NT) * DM) : src0;
    const float* md0 = p.mod + ((R0 < NT) ? (R0 >> 11) : 32) * 6144;
    const float* md1 = p.mod + ((has1 && R1 < NT) ? (R1 >> 11) : 32) * 6144;
    float4 v0[4], v1[4]; float s0 = 0.f, s1 = 0.f;
#pragma unroll
    for (int i = 0; i < 4; ++i) { v0[i] = *(const float4*)(src0 + lane * 4 + 256 * i); v1[i] = *(const float4*)(src1 + lane * 4 + 256 * i); }
#pragma unroll
    for (int i = 0; i < 4; ++i) { s0 += v0[i].x * v0[i].x + v0[i].y * v0[i].y + v0[i].z * v0[i].z + v0[i].w * v0[i].w; s1 += v1[i].x * v1[i].x + v1[i].y * v1[i].y + v1[i].z * v1[i].z + v1[i].w * v1[i].w; }
    s0 = wave_sum(s0); s1 = wave_sum(s1);
    const float r0 = rsqrtf(s0 * (1.f / DM) + EPS), r1 = rsqrtf(s1 * (1.f / DM) + EPS);
#pragma unroll
    for (int i = 0; i < 4; ++i) {
      const int d = lane * 4 + 256 * i;
      const float4 g = *(const float4*)(p.norm1_g + d);
      {
        const float4 sh = *(const float4*)(md0 + d), sc = *(const float4*)(md0 + 1024 + d);
        uint2 o; o.x = pk_bf16(v0[i].x * r0 * g.x * (1.f + sc.x) + sh.x, v0[i].y * r0 * g.y * (1.f + sc.y) + sh.y);
        o.y = pk_bf16(v0[i].z * r0 * g.z * (1.f + sc.z) + sh.z, v0[i].w * r0 * g.w * (1.f + sc.w) + sh.w);
        *(uint2*)(p.h + (size_t)R0 * DM + d) = o;
      }
      if (has1) {
        const float4 sh = *(const float4*)(md1 + d), sc = *(const float4*)(md1 + 1024 + d);
        uint2 o; o.x = pk_bf16(v1[i].x * r1 * g.x * (1.f + sc.x) + sh.x, v1[i].y * r1 * g.y * (1.f + sc.y) + sh.y);
        o.y = pk_bf16(v1[i].z * r1 * g.z * (1.f + sc.z) + sh.z, v1[i].w * r1 * g.w * (1.f + sc.w) + sh.w);
        *(uint2*)(p.h + (size_t)R1 * DM + d) = o;
      }
    }
  }
}

DI void phase2(const Params& p, char* smem) {
  const int xcd = blockIdx.x & 7, jl = blockIdx.x >> 3, nl = gridDim.x >> 3;
  auto decode = [&](int L, int& tokTile, int& ft) {
    if (L < 1664) { const int tg = L / 208, rem = L % 208; ft = rem >> 3; tokTile = xcd * 64 + tg * 8 + (rem & 7); }
    else { const int u = L - 1664; tokTile = 512 + xcd * 8 + u / 3; const int q = u % 3; ft = (q == 2) ? 25 : 3 + q; }
  };
  bool pre = false;
  for (int L = jl; L < 1664 + 24; L += nl) {
    int tokTile, ft, tokTileN = 0, ftN = 0;
    decode(L, tokTile, ft);
    const bool lat = L < 1664;
    const int Ln = L + nl; const bool hasNext = Ln < 1664 + 24;
    if (hasNext) decode(Ln, tokTileN, ftN);
    f32x16 acc[2][2];
#pragma unroll
    for (int a = 0; a < 2; ++a)
#pragma unroll
      for (int b = 0; b < 2; ++b) acc[a][b] = zero16();
    const bf16_t* Ab = p.WinT + (size_t)ft * 128 * DM;
    const bf16_t* Bb = p.h + (size_t)tokTile * 128 * DM;
    const bf16_t* AbN = p.WinT + (size_t)ftN * 128 * DM;
    const bf16_t* BbN = p.h + (size_t)tokTileN * 128 * DM;
    float dummy = 0.f;
    gemm_core2<2, 2, 2, 2, false>(acc, [&](int row) { return Ab + (size_t)row * DM; }, [&](int row) { return Bb + (size_t)row * DM; }, DM, smem, dummy,
                                  pre, hasNext, [&](int row) { return AbN + (size_t)row * DM; }, [&](int row) { return BbN + (size_t)row * DM; });
    pre = hasNext;
    {
      bf16_t* base; int ld, nch = 16; bool sg = false;
      const int tok0 = tokTile * 128;
      if (lat) {
        if (ft < 5) { base = p.pqkv + (size_t)tok0 * LDQKV + ft * 128; ld = LDQKV; }
        else if (ft < 9) { base = p.pf + (size_t)tok0 * 512 + (ft - 5) * 128; ld = 512; }
        else if (ft < 25) { base = p.pg + (size_t)tok0 * 2048 + (ft - 9) * 128; ld = 2048; sg = true; }
        else { base = p.pqkv + (size_t)tok0 * LDQKV + 640; ld = LDQKV; nch = 4; }
      } else {
        const int ct0 = tok0 - NT;
        if (ft < 5) { base = p.pckv + (size_t)ct0 * LDCKV + (ft - 3) * 128; ld = LDCKV; }
        else { base = p.pckv + (size_t)ct0 * LDCKV + 256; ld = LDCKV; nch = 4; }
      }
      char* tile = smem + EPI_OFF;
      if (sg) stage_tile(acc, tile, [](float v) { return sigmoidf_(v); });
      else stage_tile(acc, tile, [](float v) { return v; });
      lds_sync();
      copy_tile(tile, [&](int row) { return base + (size_t)row * ld; }, nch);
    }
  }
}

DI void rope_pair(float& x1, float& x2, const float* tab) { const float c = tab[0], s = tab[1]; const float a = x1 * c - x2 * s, b = x2 * c + x1 * s; x1 = a; x2 = b; }

DI void phase3(const Params& p, char* smem) {
  const int t = tid_(), lane = t & 63, w = t >> 6, r = lane & 31, hh = lane >> 5;
  const int nKV = 576, nQ = 512, nCh = 512;
  const int xcd = blockIdx.x & 7, jl = blockIdx.x >> 3, nl = gridDim.x >> 3;
  for (int it = jl; it < nKV + nQ + nCh; it += nl) {
    if (it < nKV) {
      const int tl_ = it >> 3, hd = it & 7;
      const bool lat = tl_ < 64;
      const int tokTile = lat ? xcd * 64 + tl_ : 512 + xcd * 8 + (tl_ - 64);
      const bf16_t* Bb; int ldb; const bf16_t* kpeb;
      int b, key0;
      if (lat) { Bb = p.pqkv + (size_t)tokTile * 128 * LDQKV + QL; ldb = LDQKV; kpeb = p.pqkv + (size_t)tokTile * 128 * LDQKV + 640; b = tokTile >> 4; key0 = (tokTile & 15) * 128; }
      else { const int ct = tokTile - 512; Bb = p.pckv + (size_t)ct * 128 * LDCKV; ldb = LDCKV; kpeb = Bb + 256; b = ct >> 1; key0 = SEQ + (ct & 1) * 128; }
      const bf16_t* Ab = p.WkvT + (size_t)hd * 128 * KVL;
      f32x16 acc[4][1];
#pragma unroll
      for (int a = 0; a < 4; ++a) acc[a][0] = zero16();
      float sumsq = 0.f;
      gemm_core<4, 1, 1, 4, true>(acc, [&](int row) { return Ab + (size_t)row * KVL; }, [&](int row) { return Bb + (size_t)row * ldb; }, KVL, smem, sumsq);
      sumsq += __shfl_xor(sumsq, 32);
      const float ra = rsqrtf(sumsq * (1.f / KVL) + EPS);
      const int tl = w * 32 + r;
      const int key = key0 + tl;
      float kp[16];
#pragma unroll
      for (int q = 0; q < 4; ++q) {
        const uint2 u = *(const uint2*)(kpeb + (size_t)tl * ldb + 8 * q + 4 * hh);
        kp[4 * q + 0] = bf_lo(u.x); kp[4 * q + 1] = bf_hi(u.x); kp[4 * q + 2] = bf_lo(u.y); kp[4 * q + 3] = bf_hi(u.y);
      }
      float ss = 0.f;
#pragma unroll
      for (int tm = 0; tm < 4; ++tm)
#pragma unroll
        for (int i = 0; i < 16; ++i) { const float v = acc[tm][0][i] * ra; acc[tm][0][i] = v; if (tm < 2) ss += v * v; }
#pragma unroll
      for (int i = 0; i < 16; ++i) ss += kp[i] * kp[i];
      ss += __shfl_xor(ss, 32);
      const float rk = rsqrtf(ss * (1.f / QKD) + EPS);
#pragma unroll
      for (int i = 0; i < 16; ++i) kp[i] *= rk * p.k_norm_g[64 + crow(i, hh)];
      if (lat) {
        const int pos = key;
        const float* tr = p.ropeTab + ((pos >> 6) * 8 + 4 * hh) * 2;
        const float* tc = p.ropeTab + ((pos & 63) * 8 + 4 * hh) * 2;
#pragma unroll
        for (int i = 0; i < 4; ++i) { rope_pair(kp[i], kp[i + 4], tr + 2 * i); rope_pair(kp[8 + i], kp[12 + i], tc + 2 * i); }
      }
      {
        char* kt_ = smem; char* vt_ = smem + 128 * 208;
        char* kd = kt_ + tl * 208;
#pragma unroll
        for (int tm = 0; tm < 2; ++tm)
#pragma unroll
          for (int q = 0; q < 4; ++q) {
            const int f = tm * 32 + 8 * q + 4 * hh;
            const float4 g = *(const float4*)(p.k_norm_g + f);
            uint2 o; o.x = pk_bf16(acc[tm][0][4 * q] * rk * g.x, acc[tm][0][4 * q + 1] * rk * g.y); o.y = pk_bf16(acc[tm][0][4 * q + 2] * rk * g.z, acc[tm][0][4 * q + 3] * rk * g.w);
            *(uint2*)(kd + f * 2) = o;
          }
#pragma unroll
        for (int q = 0; q < 4; ++q) {
          uint2 o; o.x = pk_bf16(kp[4 * q], kp[4 * q + 1]); o.y = pk_bf16(kp[4 * q + 2], kp[4 * q + 3]);
          *(uint2*)(kd + (64 + 8 * q + 4 * hh) * 2) = o;
        }
#pragma unroll
        for (int tm = 2; tm < 4; ++tm)
#pragma unroll
          for (int i = 0; i < 16; ++i) *(bf16_t*)(vt_ + ((tm - 2) * 32 + crow(i, hh)) * 272 + tl * 2) = f2bf(acc[tm][0][i]);
        __syncthreads();
        bf16_t* Kg = p.K + ((size_t)(b * NH + hd) * NKEY + key0) * QKD;
#pragma unroll
        for (int i = 0; i < 6; ++i) {
          const int id = t + 256 * i, row = id / 12, ch = id % 12;
          *(uint4*)(Kg + row * QKD + ch * 8) = *(const uint4*)(kt_ + row * 208 + ch * 16);
        }
        bf16_t* Vg = p.Vt + (size_t)(b * NH + hd) * VD * NKEY + key0;
#pragma unroll
        for (int i = 0; i < 4; ++i) {
          const int row = (t >> 4) + 16 * i, ch = t & 15;
          *(uint4*)(Vg + (size_t)row * NKEY + ch * 8) = *(const uint4*)(vt_ + row * 272 + ch * 16);
        }
        __syncthreads();
      }
    } else if (it < nKV + nQ) {
      const int u = it - nKV;
      const int tokTile = xcd * 64 + (u >> 3), hd = u & 7;
      const bf16_t* Bb = p.pqkv + (size_t)tokTile * 128 * LDQKV;
      const bf16_t* Ab = p.WqT + (size_t)hd * QKD * QL;
      f32x16 acc[3][1];
#pragma unroll
      for (int a = 0; a < 3; ++a) acc[a][0] = zero16();
      float sumsq = 0.f;
      gemm_core<3, 1, 1, 4, true>(acc, [&](int row) { return Ab + (size_t)row * QL; }, [&](int row) { return Bb + (size_t)row * LDQKV; }, QL, smem, sumsq);
      sumsq += __shfl_xor(sumsq, 32);
      const float ra = rsqrtf(sumsq * (1.f / QL) + EPS);
      const int tl = w * 32 + r;
      const int b = tokTile >> 4, pos = (tokTile & 15) * 128 + tl;
      float ss = 0.f;
#pragma unroll
      for (int tm = 0; tm < 3; ++tm)
#pragma unroll
        for (int i = 0; i < 16; ++i) { const float v = acc[tm][0][i] * ra; acc[tm][0][i] = v; ss += v * v; }
      ss += __shfl_xor(ss, 32);
      const float rh = rsqrtf(ss * (1.f / QKD) + EPS);
#pragma unroll
      for (int tm = 0; tm < 3; ++tm)
#pragma unroll
        for (int q = 0; q < 4; ++q) {
          const float4 g = *(const float4*)(p.q_norm_g + tm * 32 + 8 * q + 4 * hh);
          acc[tm][0][4 * q] *= rh * g.x; acc[tm][0][4 * q + 1] *= rh * g.y; acc[tm][0][4 * q + 2] *= rh * g.z; acc[tm][0][4 * q + 3] *= rh * g.w;
        }
      {
        const float* tr = p.ropeTab + ((pos >> 6) * 8 + 4 * hh) * 2;
        const float* tc = p.ropeTab + ((pos & 63) * 8 + 4 * hh) * 2;
#pragma unroll
        for (int i = 0; i < 4; ++i) {
          float a0 = acc[2][0][i], a1 = acc[2][0][i + 4], c0 = acc[2][0][8 + i], c1 = acc[2][0][12 + i];
          rope_pair(a0, a1, tr + 2 * i); rope_pair(c0, c1, tc + 2 * i);
          acc[2][0][i] = a0; acc[2][0][i + 4] = a1; acc[2][0][8 + i] = c0; acc[2][0][12 + i] = c1;
        }
      }
      const float qs = 0.10206207261596575f * 1.4426950408889634f;
      {
        char* qd = smem + tl * 208;
#pragma unroll
        for (int tm = 0; tm < 3; ++tm)
#pragma unroll
          for (int q = 0; q < 4; ++q) {
            uint2 o; o.x = pk_bf16(acc[tm][0][4 * q] * qs, acc[tm][0][4 * q + 1] * qs); o.y = pk_bf16(acc[tm][0][4 * q + 2] * qs, acc[tm][0][4 * q + 3] * qs);
            *(uint2*)(qd + (tm * 32 + 8 * q + 4 * hh) * 2) = o;
          }
        __syncthreads();
        bf16_t* Qg = p.Q + ((size_t)(b * NH + hd) * SEQ + (tokTile & 15) * 128) * QKD;
#pragma unroll
        for (int i = 0; i < 6; ++i) {
          const int id = t + 256 * i, row = id / 12, ch = id % 12;
          *(uint4*)(Qg + row * QKD + ch * 8) = *(const uint4*)(smem + row * 208 + ch * 16);
        }
        __syncthreads();
      }
    } else {
      const int u = it - nKV - nQ;
      const int ft = u & 1, tt = (u >> 1) & 15, g = (u >> 5) & 3, b = xcd * 4 + (u >> 7);
      const int wm = w & 1, wn = w >> 1;
      const bf16_t* Ab = p.chanT + (size_t)ft * 128 * 128;
      const bf16_t* Bb = p.pf + (size_t)(b * SEQ + tt * 128) * 512 + g * 128;
      f32x16 acc[2][2];
#pragma unroll
      for (int a = 0; a < 2; ++a)
#pragma unroll
        for (int c = 0; c < 2; ++c) acc[a][c] = zero16();
      float dummy = 0.f;
      gemm_core<2, 2, 2, 2, false>(acc, [&](int row) { return Bb + (size_t)row * 512; }, [&](int row) { return Ab + (size_t)row * 128; }, 128, smem, dummy);
      stage_tile(acc, smem, [](float v) { return v; });
      __syncthreads();
      bf16_t* dst0 = p.ABt + ((size_t)(b * 512 + g * 128)) * 4096 + ft * 2048 + tt * 128;
      copy_tile(smem, [&](int row) { return dst0 + (size_t)row * 4096; }, 16);
      __syncthreads();
    }
  }
}

DI void attn_item(const Params& p, int it, char* smem) {
  const int t = tid_(), lane = t & 63, w = t >> 6, r = lane & 31, hh = lane >> 5;
  const int qt = it & 15, bh = it >> 4;
  constexpr int KROW = 208, VROW = 136, KBYTES = 64 * KROW, STAGE = KBYTES + 64 * VROW;
  const bf16_t* Kb = p.K + (size_t)bh * NKEY * QKD;
  const bf16_t* Vb = p.Vt + (size_t)bh * VD * NKEY;
  const int qpos = qt * 128 + w * 32 + r;
  const bf16_t* Qp = p.Q + ((size_t)bh * SEQ + qpos) * QKD + hh * 8;
  bf16x8 qf[6];
#pragma unroll
  for (int c = 0; c < 6; ++c) qf[c] = *(const bf16x8*)(Qp + c * 16);
  f32x16 o[2]; o[0] = zero16(); o[1] = zero16();
  float mrun = -INFINITY, lrun = 0.f;
  const int kid0 = t, kid1 = t + 256, kid2 = t + 512;
  const int kgo0 = (kid0 / 12) * QKD + (kid0 % 12) * 8, kgo1 = (kid1 / 12) * QKD + (kid1 % 12) * 8, kgo2 = (kid2 / 12) * QKD + (kid2 % 12) * 8;
  const int klo0 = (kid0 / 12) * KROW + (kid0 % 12) * 16, klo1 = (kid1 / 12) * KROW + (kid1 % 12) * 16, klo2 = (kid2 / 12) * KROW + (kid2 % 12) * 16;
  const int vid0 = t, vid1 = t + 256;
  const int vgo0 = (vid0 >> 3) * NKEY + (vid0 & 7) * 8, vgo1 = (vid1 >> 3) * NKEY + (vid1 & 7) * 8;
  const int vlo0 = KBYTES + (vid0 >> 3) * VROW + (vid0 & 7) * 16, vlo1 = KBYTES + (vid1 >> 3) * VROW + (vid1 & 7) * 16;
  uint4 rk0, rk1, rk2, rv0, rv1;
  rk0 = *(const uint4*)(Kb + kgo0); rk1 = *(const uint4*)(Kb + kgo1); rk2 = *(const uint4*)(Kb + kgo2);
  rv0 = *(const uint4*)(Vb + vgo0); rv1 = *(const uint4*)(Vb + vgo1);
  __builtin_amdgcn_sched_barrier(0);
#define ATT_STORE(base) do { \
    *(uint4*)((base) + klo0) = rk0; *(uint4*)((base) + klo1) = rk1; *(uint4*)((base) + klo2) = rk2; \
    { uint2* d = (uint2*)((base) + vlo0); d[0] = make_uint2(rv0.x, rv0.y); d[1] = make_uint2(rv0.z, rv0.w); } \
    { uint2* d = (uint2*)((base) + vlo1); d[0] = make_uint2(rv1.x, rv1.y); d[1] = make_uint2(rv1.z, rv1.w); } } while (0)
  ATT_STORE(smem);
  __syncthreads();
  constexpr int NKT = NKEY / 64;
  for (int kt = 0; kt < NKT; ++kt) {
    const char* cur = smem + (kt & 1) * STAGE;
    const bool more = kt + 1 < NKT;
    if (more) {
      const bf16_t* kn = Kb + (size_t)(kt + 1) * 64 * QKD; const bf16_t* vn = Vb + (kt + 1) * 64;
      rk0 = *(const uint4*)(kn + kgo0); rk1 = *(const uint4*)(kn + kgo1); rk2 = *(const uint4*)(kn + kgo2);
      rv0 = *(const uint4*)(vn + vgo0); rv1 = *(const uint4*)(vn + vgo1);
    }
    __builtin_amdgcn_sched_barrier(0);
    f32x16 s[2];
#pragma unroll
    for (int t2 = 0; t2 < 2; ++t2) {
      s[t2] = zero16();
      const char* kp = cur + (t2 * 32 + r) * KROW + hh * 16;
#pragma unroll
      for (int c = 0; c < 6; ++c) { const bf16x8 kf = *(const bf16x8*)(kp + c * 32); s[t2] = MFMA(kf, qf[c], s[t2]); }
    }
    __builtin_amdgcn_sched_barrier(0);
    float mx = s[0][0];
#pragma unroll
    for (int i = 0; i < 16; ++i) { mx = fmaxf(mx, s[0][i]); mx = fmaxf(mx, s[1][i]); }
    mx = fmaxf(mx, __shfl_xor(mx, 32));
    const float mnew = fmaxf(mrun, mx);
    const float alpha = __builtin_amdgcn_exp2f(mrun - mnew);
    mrun = mnew;
    float ls = 0.f;
#pragma unroll
    for (int t2 = 0; t2 < 2; ++t2)
#pragma unroll
      for (int i = 0; i < 16; ++i) { const float e = __builtin_amdgcn_exp2f(s[t2][i] - mnew); s[t2][i] = e; ls += e; }
    lrun = lrun * alpha + ls;
#pragma unroll
    for (int i = 0; i < 16; ++i) { o[0][i] *= alpha; o[1][i] *= alpha; }
    __builtin_amdgcn_sched_barrier(0);
#pragma unroll
    for (int t2 = 0; t2 < 2; ++t2)
#pragma unroll
      for (int s2 = 0; s2 < 2; ++s2) {
        uint4 pu;
        pu.x = pk_bf16(s[t2][8 * s2 + 0], s[t2][8 * s2 + 1]); pu.y = pk_bf16(s[t2][8 * s2 + 2], s[t2][8 * s2 + 3]);
        pu.z = pk_bf16(s[t2][8 * s2 + 4], s[t2][8 * s2 + 5]); pu.w = pk_bf16(s[t2][8 * s2 + 6], s[t2][8 * s2 + 7]);
        const bf16x8 pb = __builtin_bit_cast(bf16x8, pu);
#pragma unroll
        for (int vt = 0; vt < 2; ++vt) {
          const char* vp = cur + KBYTES + (vt * 32 + r) * VROW + (t2 * 32 + 16 * s2 + 4 * hh) * 2;
          const uint2 lo = *(const uint2*)(vp), hi = *(const uint2*)(vp + 16);
          uint4 vu; vu.x = lo.x; vu.y = lo.y; vu.z = hi.x; vu.w = hi.y;
          o[vt] = MFMA(__builtin_bit_cast(bf16x8, vu), pb, o[vt]);
        }
      }
    __builtin_amdgcn_sched_barrier(0);
    if (more) { char* nxt = smem + ((kt + 1) & 1) * STAGE; ATT_STORE(nxt); }
    __syncthreads();
  }
  lrun += __shfl_xor(lrun, 32);
  const float inv = 1.f / lrun;
  const int b = bh >> 3, hd = bh & 7;
  bf16_t* od = p.attn_o + (size_t)(b * SEQ + qpos) * 512 + hd * 64;
#pragma unroll
  for (int vt = 0; vt < 2; ++vt)
#pragma unroll
    for (int q = 0; q < 4; ++q) {
      uint2 ou; ou.x = pk_bf16(o[vt][4 * q] * inv, o[vt][4 * q + 1] * inv); ou.y = pk_bf16(o[vt][4 * q + 2] * inv, o[vt][4 * q + 3] * inv);
      *(uint2*)(od + vt * 32 + 8 * q + 4 * hh) = ou;
    }
}

DI void phase4(const Params& p, char* smem) {
  const int t = tid_(), lane = t & 63, w = t >> 6, r = lane & 31, hh = lane >> 5;
  const int nDft = 144, nAtt = 512;
  const int xcd = blockIdx.x & 7, jl = blockIdx.x >> 3, nl = gridDim.x >> 3;
  bool dftPre = false;
  for (int it = jl; it < nDft + nAtt; it += nl) {
    if (it < nDft) {
      const int bl = it / 36, rem = it % 36, ct = rem / 9, kt = rem % 9, b = xcd * 4 + bl;
      const int wm = w & 1, wn = w >> 1;
      const bf16_t* Ab = p.ABt + (size_t)(b * 512 + ct * 128) * 4096;
      const bf16_t* Cb = p.posM + (size_t)kt * 128 * 2048;
      const bf16_t* Sb = p.posM + (size_t)(1152 + kt * 128) * 2048;
      f32x16 acc1[2][2], acc2[2][2];
#pragma unroll
      for (int a = 0; a < 2; ++a)
#pragma unroll
        for (int c = 0; c < 2; ++c) { acc1[a][c] = zero16(); acc2[a][c] = zero16(); }
      float dummy = 0.f;
      const int itn = it + nl; const bool hasNext = itn < nDft;
      const int remn = itn % 36, ctn = remn / 9, ktn = remn % 9, bn = xcd * 4 + itn / 36;
      const bf16_t* AbN = p.ABt + (size_t)(bn * 512 + ctn * 128) * 4096;
      const bf16_t* CbN = p.posM + (size_t)ktn * 128 * 2048;
      gemm_core2<2, 2, 2, 2, false>(acc1, [&](int row) { return Ab + (size_t)row * 4096; }, [&](int row) { return Cb + (size_t)row * 2048; }, 2048, smem, dummy,
                                    dftPre, true, [&](int row) { return Ab + (size_t)row * 4096 + 2048; }, [&](int row) { return Sb + (size_t)row * 2048; });
      gemm_core2<2, 2, 2, 2, false>(acc2, [&](int row) { return Ab + (size_t)row * 4096 + 2048; }, [&](int row) { return Sb + (size_t)row * 2048; }, 2048, smem, dummy,
                                    true, hasNext, [&](int row) { return AbN + (size_t)row * 4096; }, [&](int row) { return CbN + (size_t)row * 2048; });
      dftPre = hasNext;
      const float sc = 1.f / 512.f;
#pragma unroll
      for (int tm = 0; tm < 2; ++tm)
#pragma unroll
        for (int tn = 0; tn < 2; ++tn) {
          const int kpos = kt * 128 + wn * 64 + tn * 32 + r;
          const int moff = ct * 128 + wm * 64 + tm * 32 + 4 * hh;
          if (kpos <= 1024) {
            bf16_t* d = p.four_o + (size_t)(b * SEQ + kpos) * 512 + moff;
#pragma unroll
            for (int q = 0; q < 4; ++q) {
              uint2 ou; ou.x = pk_bf16((acc1[tm][tn][4 * q] - acc2[tm][tn][4 * q]) * sc, (acc1[tm][tn][4 * q + 1] - acc2[tm][tn][4 * q + 1]) * sc);
              ou.y = pk_bf16((acc1[tm][tn][4 * q + 2] - acc2[tm][tn][4 * q + 2]) * sc, (acc1[tm][tn][4 * q + 3] - acc2[tm][tn][4 * q + 3]) * sc);
              *(uint2*)(d + 8 * q) = ou;
            }
          }
          if (kpos >= 1 && kpos <= 1023) {
            bf16_t* d = p.four_o + (size_t)(b * SEQ + 2048 - kpos) * 512 + moff;
#pragma unroll
            for (int q = 0; q < 4; ++q) {
              uint2 ou; ou.x = pk_bf16((acc1[tm][tn][4 * q] + acc2[tm][tn][4 * q]) * sc, (acc1[tm][tn][4 * q + 1] + acc2[tm][tn][4 * q + 1]) * sc);
              ou.y = pk_bf16((acc1[tm][tn][4 * q + 2] + acc2[tm][tn][4 * q + 2]) * sc, (acc1[tm][tn][4 * q + 3] + acc2[tm][tn][4 * q + 3]) * sc);
              *(uint2*)(d + 8 * q) = ou;
            }
          }
        }
    } else {
      attn_item(p, xcd * 512 + (it - nDft), smem);
    }
  }
}

DI void phase5(const Params& p, char* smem) {
  const int t = tid_(), lane = t & 63, w = t >> 6, r = lane & 31, hh = lane >> 5;
  const int wm = w & 1, wn = w >> 1;
  const int xcd = blockIdx.x & 7, jl = blockIdx.x >> 3, nl = gridDim.x >> 3;
  for (int L = jl; L < 512; L += nl) {
    const int tokTile = xcd * 64 + (L >> 6) * 8 + (L & 7), nt = (L >> 3) & 7;
    f32x16 acc1[2][2], acc2[2][2];
#pragma unroll
    for (int a = 0; a < 2; ++a)
#pragma unroll
      for (int c = 0; c < 2; ++c) { acc1[a][c] = zero16(); acc2[a][c] = zero16(); }
    float dummy = 0.f;
    {
      const bf16_t* Ab = p.WoT + (size_t)nt * 128 * 512; const bf16_t* Bb = p.attn_o + (size_t)tokTile * 128 * 512;
      gemm_core<2, 2, 2, 2, false>(acc1, [&](int row) { return Ab + (size_t)row * 512; }, [&](int row) { return Bb + (size_t)row * 512; }, 512, smem, dummy);
    }
    {
      const bf16_t* Ab = p.WfT + (size_t)nt * 128 * 512; const bf16_t* Bb = p.four_o + (size_t)tokTile * 128 * 512;
      gemm_core<2, 2, 2, 2, false>(acc2, [&](int row) { return Ab + (size_t)row * 512; }, [&](int row) { return Bb + (size_t)row * 512; }, 512, smem, dummy);
    }
    {
      char* t1 = smem; char* t2 = smem + 128 * LDT;
      stage_tile(acc1, t1, [](float v) { return v; });
      stage_tile(acc2, t2, [](float v) { return v; });
      __syncthreads();
      const int ch = t & 15, r0 = t >> 4;
#pragma unroll
      for (int i = 0; i < 8; ++i) {
        const int row = r0 + 16 * i;
        const size_t tok = (size_t)tokTile * 128 + row;
        const uint4 u1 = *(const uint4*)(t1 + row * LDT + ch * 16), u2 = *(const uint4*)(t2 + row * LDT + ch * 16);
        const uint4 ga = *(const uint4*)(p.pg + tok * 2048 + nt * 128 + ch * 8), gb = *(const uint4*)(p.pg + tok * 2048 + 1024 + nt * 128 + ch * 8);
        uint4 o;
        o.x = pk_bf16(bf_lo(ga.x) * bf_lo(u1.x) + bf_lo(gb.x) * bf_lo(u2.x), bf_hi(ga.x) * bf_hi(u1.x) + bf_hi(gb.x) * bf_hi(u2.x));
        o.y = pk_bf16(bf_lo(ga.y) * bf_lo(u1.y) + bf_lo(gb.y) * bf_lo(u2.y), bf_hi(ga.y) * bf_hi(u1.y) + bf_hi(gb.y) * bf_hi(u2.y));
        o.z = pk_bf16(bf_lo(ga.z) * bf_lo(u1.z) + bf_lo(gb.z) * bf_lo(u2.z), bf_hi(ga.z) * bf_hi(u1.z) + bf_hi(gb.z) * bf_hi(u2.z));
        o.w = pk_bf16(bf_lo(ga.w) * bf_lo(u1.w) + bf_lo(gb.w) * bf_lo(u2.w), bf_hi(ga.w) * bf_hi(u1.w) + bf_hi(gb.w) * bf_hi(u2.w));
        *(uint4*)(p.m + tok * DM + nt * 128 + ch * 8) = o;
      }
      __syncthreads();
    }
  }
}

DI void phase6(const Params& p, char* smem) {
  const int t = tid_(), lane = t & 63, w = t >> 6, r = lane & 31, hh = lane >> 5;
  const int wm = w & 1, wn = w >> 1;
  const int xcd = blockIdx.x & 7, jl = blockIdx.x >> 3, nl = gridDim.x >> 3;
  for (int L = jl; L < 512; L += nl) {
    const int tokTile = xcd * 64 + (L >> 6) * 8 + (L & 7), nt = (L >> 3) & 7;
    f32x16 acc[2][2];
#pragma unroll
    for (int a = 0; a < 2; ++a)
#pragma unroll
      for (int c = 0; c < 2; ++c) acc[a][c] = zero16();
    float dummy = 0.f;
    const bf16_t* Wb = p.WoutT + (size_t)nt * 128 * DM; const bf16_t* Mb = p.m + (size_t)tokTile * 128 * DM;
    gemm_core<2, 2, 2, 2, false>(acc, [&](int row) { return Wb + (size_t)row * DM; }, [&](int row) { return Mb + (size_t)row * DM; }, DM, smem, dummy);
#pragma unroll
    for (int tm = 0; tm < 2; ++tm)
#pragma unroll
      for (int tn = 0; tn < 2; ++tn) {
        char* d = smem + (wn * 64 + tn * 32 + r) * 528 + (wm * 64 + tm * 32 + 4 * hh) * 4;
#pragma unroll
        for (int q = 0; q < 4; ++q) *(float4*)(d + 32 * q) = make_float4(acc[tm][tn][4 * q], acc[tm][tn][4 * q + 1], acc[tm][tn][4 * q + 2], acc[tm][tn][4 * q + 3]);
      }
    __syncthreads();
    {
      const int ch = t & 31, r0 = t >> 5;
      const float4 g = *(const float4*)(p.mod + (tokTile >> 4) * 6144 + 2048 + nt * 128 + ch * 4);
#pragma unroll 4
      for (int i = 0; i < 16; ++i) {
        const int row = r0 + 8 * i;
        const float4 a = *(const float4*)(smem + row * 528 + ch * 16);
        const size_t o = ((size_t)tokTile * 128 + row) * DM + nt * 128 + ch * 4;
        const float4 xv = *(const float4*)(p.x + o);
        *(float4*)(p.out + o) = make_float4(xv.x + g.x * a.x, xv.y + g.y * a.y, xv.z + g.z * a.z, xv.w + g.w * a.w);
      }
    }
    __syncthreads();
  }
}

DI void phase7(const Params& p, char* smem) {
  const int t = tid_(), lane = t & 63, w = t >> 6;
  float* wr = (float*)smem;
  for (int idx = t; idx < DM * NE; idx += 256) { const int d = idx >> 4, e = idx & 15; wr[e * DM + d] = p.w_router[idx]; }
  __syncthreads();
  const int gw = blockIdx.x * 4 + w, nw = gridDim.x * 4;
  for (int R = gw; R < NT; R += nw) {
    asm volatile("" ::: "memory");
    const float* src = p.out + (size_t)R * DM;
    const int b = R >> 11;
    const float* md = p.mod + b * 6144;
    float4 v[4]; float ss = 0.f;
#pragma unroll
    for (int i = 0; i < 4; ++i) { v[i] = *(const float4*)(src + lane * 4 + 256 * i); ss += v[i].x * v[i].x + v[i].y * v[i].y + v[i].z * v[i].z + v[i].w * v[i].w; }
    ss = wave_sum(ss);
    const float rr = rsqrtf(ss * (1.f / DM) + EPS);
#pragma unroll
    for (int i = 0; i < 4; ++i) {
      const int d = lane * 4 + 256 * i;
      const float4 g = *(const float4*)(p.norm2_g + d);
      const float4 sh = *(const float4*)(md + 3072 + d);
      const float4 sc = *(const float4*)(md + 4096 + d);
      v[i].x = v[i].x * rr * g.x * (1.f + sc.x) + sh.x;
      v[i].y = v[i].y * rr * g.y * (1.f + sc.y) + sh.y;
      v[i].z = v[i].z * rr * g.z * (1.f + sc.z) + sh.z;
      v[i].w = v[i].w * rr * g.w * (1.f + sc.w) + sh.w;
      uint2 o; o.x = pk_bf16(v[i].x, v[i].y); o.y = pk_bf16(v[i].z, v[i].w);
      *(uint2*)(p.h2 + (size_t)R * DM + d) = o;
    }
    float a[16];
#pragma unroll
    for (int e = 0; e < 16; ++e) {
      float s = 0.f;
#pragma unroll
      for (int i = 0; i < 4; ++i) { const float4 wv = *(const float4*)(wr + e * DM + lane * 4 + 256 * i); s += v[i].x * wv.x + v[i].y * wv.y + v[i].z * wv.z + v[i].w * wv.w; }
      a[e] = s;
      if ((e & 3) == 3) __builtin_amdgcn_sched_barrier(0);
    }
    float a8[8], a4[4], a2[2], a1;
    {
      const bool up = lane & 32;
#pragma unroll
      for (int j = 0; j < 8; ++j) { const float send = up ? a[j] : a[j + 8]; const float keep = up ? a[j + 8] : a[j]; a8[j] = keep + __shfl_xor(send, 32); }
    }
    {
      const bool up = lane & 16;
#pragma unroll
      for (int j = 0; j < 4; ++j) { const float send = up ? a8[j] : a8[j + 4]; const float keep = up ? a8[j + 4] : a8[j]; a4[j] = keep + __shfl_xor(send, 16); }
    }
    {
      const bool up = lane & 8;
#pragma unroll
      for (int j = 0; j < 2; ++j) { const float send = up ? a4[j] : a4[j + 2]; const float keep = up ? a4[j + 2] : a4[j]; a2[j] = keep + __shfl_xor(send, 8); }
    }
    {
      const bool up = lane & 4;
      const float send = up ? a2[0] : a2[1]; const float keep = up ? a2[1] : a2[0]; a1 = keep + __shfl_xor(send, 4);
    }
    a1 += __shfl_xor(a1, 2);
    a1 += __shfl_xor(a1, 1);
    float mx = a1;
#pragma unroll
    for (int o = 4; o <= 32; o <<= 1) mx = fmaxf(mx, __shfl_xor(mx, o));
    const float ex = __expf(a1 - mx);
    float sm = ex;
#pragma unroll
    for (int o = 4; o <= 32; o <<= 1) sm += __shfl_xor(sm, o);
    if ((lane & 3) == 0) {
      const int e = (lane >> 2) & 15;
      p.aff[((size_t)(b * NE + e)) * SEQ + (R & 2047)] = ex / sm;
    }
  }
}

DI void phase8(const Params& p) {
  const int t_ = tid_(); const int lane = t_ & 63, w = t_ >> 6;
  const int gw = blockIdx.x * 4 + w, nw = gridDim.x * 4;
  for (int pr = gw; pr < NB * NE; pr += nw) {
    const float* a = p.aff + (size_t)pr * SEQ;
    unsigned u[32];
#pragma unroll
    for (int q = 0; q < 32; ++q) u[q] = __float_as_uint(a[q * 64 + lane]);
    unsigned thr = 0;
    for (int bit = 30; bit >= 0; --bit) {
      const unsigned cand = thr | (1u << bit);
      int cnt = 0;
#pragma unroll
      for (int q = 0; q < 32; ++q) cnt += __popcll(__ballot(u[q] >= cand));
      if (cnt >= CAP) thr = cand;
    }
    int ngt = 0;
#pragma unroll
    for (int q = 0; q < 32; ++q) ngt += __popcll(__ballot(u[q] > thr));
    int cgt = 0, ceq = 0;
    int* io = p.idx + pr * CAP; float* go = p.gate + pr * CAP;
    int* iv = p.inv + (size_t)pr * SEQ;
#pragma unroll
    for (int q = 0; q < 32; ++q) {
      const bool gt = u[q] > thr, eq = u[q] == thr;
      const unsigned long long mg = __ballot(gt), me = __ballot(eq);
      const unsigned long long below = (1ull << lane) - 1ull;
      int myslot = -1;
      if (gt) { const int s = cgt + __popcll(mg & below); io[s] = q * 64 + lane; go[s] = __uint_as_float(u[q]); myslot = s; }
      if (eq) { const int s = ngt + ceq + __popcll(me & below); if (s < CAP) { io[s] = q * 64 + lane; go[s] = __uint_as_float(u[q]); myslot = s; } }
      iv[q * 64 + lane] = myslot;
      cgt += __popcll(mg); ceq += __popcll(me);
    }
  }
}

DI void phase9(const Params& p, char* smem) {
  const int t = tid_(), lane = t & 63, w = t >> 6, r = lane & 31, hh = lane >> 5;
  const int wm = w & 1, wn = w >> 1;
  const int xcd = blockIdx.x & 7, jl = blockIdx.x >> 3, nl = gridDim.x >> 3;
  for (int L = jl; L < 1024; L += nl) {
    const int e = xcd * 2 + (L >> 9), rem = L & 511, ft = (rem >> 3) & 7, st = rem & 1, b = (rem >> 6) * 4 + ((rem & 7) >> 1);
    const int be = b * NE + e;
    const bf16_t* Ab = p.WguT + ((size_t)e * 1024 + ft * 128) * DM;
    const int* ib = p.idx + be * CAP + st * 128;
    const bf16_t* hb = p.h2 + (size_t)b * SEQ * DM;
    f32x16 acc[2][2];
#pragma unroll
    for (int a = 0; a < 2; ++a)
#pragma unroll
      for (int c = 0; c < 2; ++c) acc[a][c] = zero16();
    float dummy = 0.f;
    gemm_core<2, 2, 2, 2, false>(acc, [&](int row) { return Ab + (size_t)row * DM; }, [&](int row) { return hb + (size_t)ib[row] * DM; }, DM, smem, dummy);
    {
#pragma unroll
      for (int tn = 0; tn < 2; ++tn) {
        char* d = smem + (wn * 64 + tn * 32 + r) * 144 + (wm * 32 + 4 * hh) * 2;
#pragma unroll
        for (int q = 0; q < 4; ++q) {
          float v[4];
#pragma unroll
          for (int j = 0; j < 4; ++j) { const float g = acc[0][tn][4 * q + j], uu = acc[1][tn][4 * q + j]; v[j] = g * sigmoidf_(g) * uu; }
          uint2 ou; ou.x = pk_bf16(v[0], v[1]); ou.y = pk_bf16(v[2], v[3]);
          *(uint2*)(d + 16 * q) = ou;
        }
      }
      __syncthreads();
      const int ch = t & 7, r0 = t >> 3;
#pragma unroll
      for (int i = 0; i < 4; ++i) {
        const int row = r0 + 32 * i;
        const uint4 v = *(const uint4*)(smem + row * 144 + ch * 16);
        *(uint4*)(p.hmid + ((size_t)be * CAP + st * 128 + row) * DE + ft * 64 + ch * 8) = v;
      }
      __syncthreads();
    }
  }
}

DI void phase10(const Params& p, char* smem) {
  const int t = tid_(), lane = t & 63, w = t >> 6, r = lane & 31, hh = lane >> 5;
  const int wm = w & 1, wn = w >> 1;
  const int xcd = blockIdx.x & 7, jl = blockIdx.x >> 3, nl = gridDim.x >> 3;
  for (int L = jl; L < 1024; L += nl) {
    const int e = xcd * 2 + (L >> 9), rem = L & 511, nt = (rem >> 3) & 7, st = rem & 1, b = (rem >> 6) * 4 + ((rem & 7) >> 1);
    const int be = b * NE + e;
    const bf16_t* Hb = p.hmid + ((size_t)be * CAP + st * 128) * DE;
    const bf16_t* Wb = p.WdT + ((size_t)e * DM + nt * 128) * DE;
    f32x16 acc[2][2];
#pragma unroll
    for (int a = 0; a < 2; ++a)
#pragma unroll
      for (int c = 0; c < 2; ++c) acc[a][c] = zero16();
    float dummy = 0.f;
    gemm_core<2, 2, 2, 2, false>(acc, [&](int row) { return Wb + (size_t)row * DE; }, [&](int row) { return Hb + (size_t)row * DE; }, DE, smem, dummy);
    stage_tile(acc, smem, [](float v) { return v; });
    __syncthreads();
    bf16_t* yb = p.Y + ((size_t)be * CAP + st * 128) * DM + nt * 128;
    copy_tile(smem, [&](int row) { return yb + (size_t)row * DM; }, 16);
    __syncthreads();
  }
}

DI void phase11(const Params& p) {
  const int t_ = tid_(); const int lane = t_ & 63, w = t_ >> 6;
  const int gw = blockIdx.x * 4 + w, nw = gridDim.x * 4;
  for (int R = gw; R < NT; R += nw) {
    const int b = R >> 11, tq = R & 2047;
    const int myslot = (lane < NE) ? p.inv[((size_t)(b * NE + lane)) * SEQ + tq] : -1;
    unsigned long long mask = __ballot(myslot >= 0);
    if (mask == 0ull) continue;
    float4 a[4];
#pragma unroll
    for (int i = 0; i < 4; ++i) a[i] = make_float4(0.f, 0.f, 0.f, 0.f);
    while (mask) {
      const int e = __ffsll((long long)mask) - 1; mask &= mask - 1ull;
      const int slot = __shfl(myslot, e);
      const float g = p.gate[(b * NE + e) * CAP + slot];
      const bf16_t* y = p.Y + ((size_t)(b * NE + e) * CAP + slot) * DM + lane * 4;
#pragma unroll
      for (int i = 0; i < 4; ++i) {
        const uint2 u = *(const uint2*)(y + 256 * i);
        a[i].x += g * bf_lo(u.x); a[i].y += g * bf_hi(u.x); a[i].z += g * bf_lo(u.y); a[i].w += g * bf_hi(u.y);
      }
    }
    const float* g2 = p.mod + b * 6144 + 5120;
    float* o = p.out + (size_t)R * DM;
#pragma unroll
    for (int i = 0; i < 4; ++i) {
      const int d = lane * 4 + 256 * i;
      const float4 gv = *(const float4*)(g2 + d);
      float4 xv = *(float4*)(o + d);
      xv.x += gv.x * a[i].x; xv.y += gv.y * a[i].y; xv.z += gv.z * a[i].z; xv.w += gv.w * a[i].w;
      *(float4*)(o + d) = xv;
    }
  }
}

__global__ void __launch_bounds__(256, 2) mega_kernel(Params p) {
  cg::grid_group grid = cg::this_grid();
  __shared__ __attribute__((aligned(16))) char smem[SMEM_BYTES];
#ifndef REPMASK
#define REPMASK 0
#endif
#define RUNPH(k, call) for (int rep_ = 0; rep_ < (((REPMASK) >> (k)) & 1) + 1; ++rep_) { call; grid.sync(); }
  RUNPH(0, phase0(p, smem))
  RUNPH(1, phase1(p))
  RUNPH(2, phase2(p, smem))
  RUNPH(3, phase3(p, smem))
  RUNPH(4, phase4(p, smem))
  RUNPH(5, phase5(p, smem))
  RUNPH(6, phase6(p, smem))
  RUNPH(7, phase7(p, smem))
  RUNPH(8, phase8(p))
  RUNPH(9, phase9(p, smem))
  phase10(p, smem);
  grid.sync();
  phase11(p);
}

static inline size_t align_up(size_t v, size_t a) { return (v + a - 1) / a * a; }

extern "C" void kernel_launch(void* const* d_in, const int* in_sizes, int n_in,
                              void* d_out, int out_size, void* d_ws, size_t ws_size,
                              hipStream_t stream) {
  static int grid_blocks = 0;
  if (!grid_blocks) {
    int dev = 0, cus = 0, per_cu = 0;
    (void)hipGetDevice(&dev);
    (void)hipDeviceGetAttribute(&cus, hipDeviceAttributeMultiprocessorCount, dev);
    (void)hipOccupancyMaxActiveBlocksPerMultiprocessor(&per_cu, mega_kernel, 256, 0);
    if (per_cu > 2) per_cu = 2;
    if (per_cu < 1) per_cu = 1;
    grid_blocks = (cus * per_cu) & ~7;
    if (grid_blocks < 8) grid_blocks = 8;
  }
  Params p;
  memset(&p, 0, sizeof(p));
  const float* x = (const float*)d_in[0];
  p.x = x; p.c = (const float*)d_in[1]; p.ctx = (const float*)d_in[2]; p.c_ctx = (const float*)d_in[3];
  p.w_mod = (const float*)d_in[4]; p.b_mod = (const float*)d_in[5]; p.norm1_g = (const float*)d_in[6];
  const float* w_in = (const float*)d_in[7];
  const float* q_a_g = (const float*)d_in[8];
  const float* kv_a_g = (const float*)d_in[9];
  const float* w_q_up = (const float*)d_in[10];
  const float* w_kv_up = (const float*)d_in[11];
  p.q_norm_g = (const float*)d_in[12]; p.k_norm_g = (const float*)d_in[13];
  const float* w_o_attn = (const float*)d_in[14];
  const float* w_fourier = (const float*)d_in[15];
  const float* w_out = (const float*)d_in[16];
  p.norm2_g = (const float*)d_in[17]; p.w_router = (const float*)d_in[18];
  const float* w_e_gate = (const float*)d_in[19];
  const float* w_e_up = (const float*)d_in[20];
  const float* w_e_down = (const float*)d_in[21];
  p.out = (float*)d_out;

  char* base = (char*)d_ws; size_t off = 0;
  auto alloc = [&](size_t bytes) { char* q = base + off; off = align_up(off + bytes, 256); return q; };
  p.WinT = (bf16_t*)alloc((size_t)NINP * DM * 2);
  p.WqT = (bf16_t*)alloc((size_t)768 * QL * 2);
  p.WkvT = (bf16_t*)alloc((size_t)1024 * KVL * 2);
  p.WoT = (bf16_t*)alloc((size_t)DM * 512 * 2);
  p.WfT = (bf16_t*)alloc((size_t)DM * 512 * 2);
  p.WoutT = (bf16_t*)alloc((size_t)DM * DM * 2);
  p.WguT = (bf16_t*)alloc((size_t)NE * 1024 * DM * 2);
  p.WdT = (bf16_t*)alloc((size_t)NE * DM * DE * 2);
  p.chanT = (bf16_t*)alloc((size_t)256 * 128 * 2);
  p.posM = (bf16_t*)alloc((size_t)2 * 1152 * 2048 * 2);
  p.ropeTab = (float*)alloc(64 * 8 * 2 * 4);
  p.mod = (float*)alloc(33 * 6144 * 4);
  p.aff = (float*)alloc((size_t)NB * NE * SEQ * 4);
  p.gate = (float*)alloc((size_t)NB * NE * CAP * 4);
  p.idx = (int*)alloc((size_t)NB * NE * CAP * 4);
  p.inv = (int*)alloc((size_t)NB * NE * SEQ * 4);
  p.pckv = (bf16_t*)alloc((size_t)NC * LDCKV * 2);
  char* regA = alloc((size_t)(NT + NC) * DM * 2);
  p.h = (bf16_t*)regA; p.ABt = (bf16_t*)regA; p.h2 = (bf16_t*)regA;
  char* regB1 = alloc((size_t)NT * LDQKV * 2);
  p.pqkv = (bf16_t*)regB1; p.attn_o = (bf16_t*)regB1;
  char* regB2 = alloc((size_t)NT * 512 * 2);
  p.pf = (bf16_t*)regB2; p.four_o = (bf16_t*)regB2;
  p.pg = (bf16_t*)alloc((size_t)NT * 2048 * 2);
  p.Y = p.pg;
  const size_t szQ = (size_t)NB * NH * SEQ * QKD * 2, szK = (size_t)NB * NH * NKEY * QKD * 2, szV = (size_t)NB * NH * VD * NKEY * 2;
  char* regC = alloc(szQ + szK + szV + 1024);
  p.Q = (bf16_t*)regC; p.K = (bf16_t*)(regC + align_up(szQ, 256)); p.Vt = (bf16_t*)(regC + align_up(szQ, 256) + align_up(szK, 256));
  p.m = (bf16_t*)regC; p.hmid = (bf16_t*)(regC + (size_t)NT * DM * 2);
  if (off > ws_size) { fprintf(stderr, "workspace too small: need %zu have %zu\n", off, ws_size); return; }

  int ts = 0;
  auto job = [&](int i, const float* src, bf16_t* dst, const float* scale, int K, int ldS, int n_off, int n_cnt, int dst_row0, int mode, int batch, long sbs, long dbs) {
    TJob& j = p.jobs[i];
    j.src = src; j.dst = dst; j.scale = scale; j.K = K; j.ldS = ldS; j.n_off = n_off; j.n_cnt = n_cnt; j.dst_row0 = dst_row0; j.mode = mode; j.batch = batch;
    j.tiles_n = (n_cnt + 63) / 64; j.tile_start = ts; j.src_bstride = sbs; j.dst_bstride = dbs;
    ts += batch * (K / 64) * j.tiles_n;
  };
  job(0, w_e_gate, p.WguT, nullptr, DM, DE, 0, DE, 0, 1, NE, (long)DM * DE, (long)1024 * DM);
  job(1, w_e_up, p.WguT, nullptr, DM, DE, 0, DE, 0, 2, NE, (long)DM * DE, (long)1024 * DM);
  job(2, w_e_down, p.WdT, nullptr, DE, DM, 0, DM, 0, 0, NE, (long)DE * DM, (long)DM * DE);
  job(3, w_in, p.WinT, nullptr, DM, N_IN, 0, 640, 0, 0, 1, 0, 0);
  job(4, w_in, p.WinT, nullptr, DM, N_IN, 672, 2560, 640, 0, 1, 0, 0);
  job(5, w_in, p.WinT, nullptr, DM, N_IN, 640, 32, 3200, 0, 1, 0, 0);
  job(6, w_q_up, p.WqT, q_a_g, QL, 768, 0, 768, 0, 0, 1, 0, 0);
  job(7, w_kv_up, p.WkvT, kv_a_g, KVL, 1024, 0, 1024, 0, 0, 1, 0, 0);
  job(8, w_o_attn, p.WoT, nullptr, 512, DM, 0, DM, 0, 0, 1, 0, 0);
  job(9, w_fourier, p.WfT, nullptr, 512, DM, 0, DM, 0, 0, 1, 0, 0);
  job(10, w_out, p.WoutT, nullptr, DM, DM, 0, DM, 0, 0, 1, 0, 0);
  p.n_ttiles = ts;

  void* args[] = {&p};
  hipError_t e = hipLaunchCooperativeKernel((void*)mega_kernel, dim3(grid_blocks), dim3(256), args, 0, stream);
  if (e != hipSuccess) fprintf(stderr, "cooperative launch failed: %s (grid %d)\n", hipGetErrorString(e), grid_blocks);
}
```

```cpp
#include <hip/hip_runtime.h>
#include <hip/hip_cooperative_groups.h>
#include <cstdio>
#include <cstring>
#include <cstdint>
namespace cg = cooperative_groups;

#define DI __device__ __forceinline__
typedef unsigned short bf16_t;
typedef short bf16x8 __attribute__((ext_vector_type(8)));
typedef float f32x16 __attribute__((ext_vector_type(16)));
#define MFMA(a, b, c) __builtin_amdgcn_mfma_f32_32x32x16_bf16((a), (b), (c), 0, 0, 0)

constexpr int NB = 32, SEQ = 2048, DM = 1024, NT = NB * SEQ, CTXL = 256, NC = NB * CTXL;
constexpr int NH = 8, QKD = 96, VD = 64, QL = 384, KVL = 256, NKEY = SEQ + CTXL;
constexpr int N_IN = 3232, NINP = 3328;
constexpr int NE = 16, DE = 512, CAP = 256;
constexpr float EPS = 1e-6f;
constexpr int LDQKV = 672, LDCKV = 288;
constexpr int NTH = 512, NWV = 8;
constexpr int SMEM_BYTES = 147456;

struct TJob {
  const float* src; bf16_t* dst; const float* scale;
  int K, ldS, n_off, n_cnt, dst_row0, mode, batch, tiles_n, tile_start, pad0;
  long src_bstride, dst_bstride;
};
constexpr int NJOBS = 10;

struct Params {
  const float *x, *c, *ctx, *c_ctx, *w_mod, *b_mod, *norm1_g, *q_norm_g, *k_norm_g, *norm2_g, *w_router;
  float* out;
  bf16_t *WinT, *WqT, *WkvT, *WoT, *WfT, *WoutT, *WguT, *WdT, *chanT, *posM;
  float *ropeTab, *mod;
  bf16_t *h, *pqkv, *pckv, *pf, *pg, *Q, *K, *Vt, *attn_o, *ABt, *four_o, *m, *h2, *hmid;
  float *aff, *gate;
  int* idx;
  int* inv;
  bf16_t* Y;
  TJob jobs[NJOBS];
  int n_ttiles, pad1;
};

typedef float f32x2v __attribute__((ext_vector_type(2)));
typedef __bf16 bf16x2v __attribute__((ext_vector_type(2)));
DI unsigned pk_bf16(float lo, float hi) { f32x2v v = {lo, hi}; bf16x2v b = __builtin_convertvector(v, bf16x2v); return __builtin_bit_cast(unsigned, b); }
DI int tid_() { int t = threadIdx.x; asm volatile("" : "+v"(t)); return t; }
DI float bf_lo(unsigned u) { return __uint_as_float(u << 16); }
DI float bf_hi(unsigned u) { return __uint_as_float(u & 0xffff0000u); }
DI bf16_t f2bf(float f) { return (bf16_t)(pk_bf16(f, 0.f) & 0xffffu); }
DI float sigmoidf_(float x) { return 1.f / (1.f + __expf(-x)); }
DI int crow(int i, int hh) { return (i & 3) + 8 * (i >> 2) + 4 * hh; }
DI float wave_sum(float v) {
#pragma unroll
  for (int o = 32; o >= 1; o >>= 1) v += __shfl_xor(v, o);
  return v;
}
DI f32x16 zero16() { f32x16 z;
#pragma unroll
  for (int i = 0; i < 16; ++i) z[i] = 0.f; return z; }
DI void wait_vm0() { asm volatile("s_waitcnt vmcnt(0)" ::: "memory"); }
DI void wait_lgkm0() { asm volatile("s_waitcnt lgkmcnt(0)" ::: "memory"); }
DI void bar_() { __builtin_amdgcn_s_barrier(); }
DI void lds_sync() { wait_lgkm0(); bar_(); }
#define GLDS(gp, lp) __builtin_amdgcn_global_load_lds((const unsigned*)(gp), (__attribute__((address_space(3))) unsigned*)(lp), 16, 0, 0)
#define SB_ __builtin_amdgcn_sched_barrier(0)

template <int TM, int TN, int WM, int WN, bool SUMSQ, class AF, class BF>
DI void gemm8(f32x16 (&acc)[TM][TN], AF arow, BF brow, int K, char* smem, float& sumsq) {
  constexpr int RA = 32 * TM * WM, RB = 32 * TN * WN;
  constexpr int LDR = 128, STAGE = (RA + RB) * LDR;
  static_assert(WM * WN == NWV, "waves");
  static_assert(2 * STAGE <= SMEM_BYTES, "smem");
  static_assert(RA <= 256 && RB <= 256 && RA % 32 == 0 && RB % 32 == 0, "shape");
  const int t = tid_(), lane = t & 63, w = t >> 6, r = lane & 31, hh = lane >> 5;
  const int wm = w % WM, wn = w / WM;
  const int row0 = t >> 3;
  const int c = (t & 7) ^ ((row0 >> 1) & 7);
  const bool a0v = row0 < RA, a1v = row0 + 64 < RA, a2v = row0 + 128 < RA, a3v = row0 + 192 < RA;
  const bool b0v = row0 < RB, b1v = row0 + 64 < RB, b2v = row0 + 128 < RB, b3v = row0 + 192 < RB;
  const bf16_t* pa0 = arow(a0v ? row0 : 0) + c * 8;
  const bf16_t* pa1 = arow(a1v ? row0 + 64 : 0) + c * 8;
  const bf16_t* pa2 = arow(a2v ? row0 + 128 : 0) + c * 8;
  const bf16_t* pa3 = arow(a3v ? row0 + 192 : 0) + c * 8;
  const bf16_t* pb0 = brow(b0v ? row0 : 0) + c * 8;
  const bf16_t* pb1 = brow(b1v ? row0 + 64 : 0) + c * 8;
  const bf16_t* pb2 = brow(b2v ? row0 + 128 : 0) + c * 8;
  const bf16_t* pb3 = brow(b3v ? row0 + 192 : 0) + c * 8;
  {
    char* l_ = smem + t * 16; char* m_ = l_ + RA * LDR;
    if (a0v) GLDS(pa0, l_); if (a1v) GLDS(pa1, l_ + 8192); if (a2v) GLDS(pa2, l_ + 16384); if (a3v) GLDS(pa3, l_ + 24576);
    if (b0v) GLDS(pb0, m_); if (b1v) GLDS(pb1, m_ + 8192); if (b2v) GLDS(pb2, m_ + 16384); if (b3v) GLDS(pb3, m_ + 24576);
  }
  wait_vm0(); bar_();
  const int nk = K >> 6;
  const int sw = (r >> 1) & 7;
  const int aoff = (wm * TM * 32 + r) * LDR, boff = RA * LDR + (wn * TN * 32 + r) * LDR;
  auto compute = [&](const char* cur, char* nxt, int ko, bool issue) {
    const char* As = cur + aoff;
    const char* Bs = cur + boff;
    char* l_ = nxt + t * 16; char* m_ = l_ + RA * LDR;
    bf16x8 a0[TM], b0[TN], a1[TM], b1[TN];
#define LOADF(A_, B_, ks) do { const int po_ = (((ks) * 2 + hh) ^ sw) * 16; \
      _Pragma("unroll") for (int tm = 0; tm < TM; ++tm) A_[tm] = *(const bf16x8*)(As + tm * 32 * LDR + po_); \
      _Pragma("unroll") for (int tn = 0; tn < TN; ++tn) B_[tn] = *(const bf16x8*)(Bs + tn * 32 * LDR + po_); } while (0)
#define MMF(A_, B_) do { if (SUMSQ) { uint4 u = __builtin_bit_cast(uint4, B_[0]); \
        float e0 = bf_lo(u.x), e1 = bf_hi(u.x), e2 = bf_lo(u.y), e3 = bf_hi(u.y), e4 = bf_lo(u.z), e5 = bf_hi(u.z), e6 = bf_lo(u.w), e7 = bf_hi(u.w); \
        sumsq += e0 * e0 + e1 * e1 + e2 * e2 + e3 * e3 + e4 * e4 + e5 * e5 + e6 * e6 + e7 * e7; } \
      _Pragma("unroll") for (int tm = 0; tm < TM; ++tm) _Pragma("unroll") for (int tn = 0; tn < TN; ++tn) acc[tm][tn] = MFMA(A_[tm], B_[tn], acc[tm][tn]); } while (0)
    LOADF(a0, b0, 0);
    LOADF(a1, b1, 1);
    SB_;
    if (issue) { if (a0v) GLDS(pa0 + ko, l_); if (a1v) GLDS(pa1 + ko, l_ + 8192); }
    SB_;
    __builtin_amdgcn_s_setprio(1);
    MMF(a0, b0);
    LOADF(a0, b0, 2);
    SB_;
    if (issue) { if (a2v) GLDS(pa2 + ko, l_ + 16384); if (a3v) GLDS(pa3 + ko, l_ + 24576); }
    SB_;
    MMF(a1, b1);
    LOADF(a1, b1, 3);
    SB_;
    if (issue) { if (b0v) GLDS(pb0 + ko, m_); if (b1v) GLDS(pb1 + ko, m_ + 8192); }
    SB_;
    MMF(a0, b0);
    SB_;
    if (issue) { if (b2v) GLDS(pb2 + ko, m_ + 16384); if (b3v) GLDS(pb3 + ko, m_ + 24576); }
    SB_;
    MMF(a1, b1);
    __builtin_amdgcn_s_setprio(0);
  };
  for (int kt = 0; kt < nk - 1; ++kt) {
    SB_;
    compute(smem + (kt & 1) * STAGE, smem + ((kt + 1) & 1) * STAGE, (kt + 1) * 64, true);
    SB_;
    wait_vm0(); bar_();
  }
  SB_;
  compute(smem + ((nk - 1) & 1) * STAGE, smem, 0, false);
  SB_;
  lds_sync();
}

template <int TM, int TN, int WM, int WN, class F>
DI void stage_tile(const f32x16 (&acc)[TM][TN], char* tile, int pitch, F f) {
  const int t = tid_(), lane = t & 63, w = t >> 6, r = lane & 31, hh = lane >> 5;
  const int wm = w % WM, wn = w / WM;
#pragma unroll
  for (int tm = 0; tm < TM; ++tm)
#pragma unroll
    for (int tn = 0; tn < TN; ++tn) {
      char* d = tile + (wn * TN * 32 + tn * 32 + r) * pitch + (wm * TM * 32 + tm * 32 + 4 * hh) * 2;
#pragma unroll
      for (int q = 0; q < 4; ++q) {
        uint2 o; o.x = pk_bf16(f(acc[tm][tn][4 * q]), f(acc[tm][tn][4 * q + 1])); o.y = pk_bf16(f(acc[tm][tn][4 * q + 2]), f(acc[tm][tn][4 * q + 3]));
        *(uint2*)(d + 16 * q) = o;
      }
    }
}
template <class RF>
DI void copy_tile(const char* tile, int pitch, int rows, int lch, RF dst, int ch0, int ch1) {
  const int t = tid_();
  const int total = rows << lch;
  for (int id = t; id < total; id += NTH) {
    const int row = id >> lch, ch = id & ((1 << lch) - 1);
    if (ch >= ch0 && ch < ch1) *(uint4*)(dst(row) + ch * 8) = *(const uint4*)(tile + row * pitch + ch * 16);
  }
}

DI void transpose_tile(const TJob& j, int tile, char* smem) {
  const int t = tid_();
  const int tpb = (j.K >> 6) * j.tiles_n;
  const int bi = tile / tpb, rem = tile % tpb;
  const int kt = rem / j.tiles_n, ntile = rem % j.tiles_n;
  const int k0 = kt * 64, n0 = ntile * 64;
  const float* src = j.src + (size_t)bi * j.src_bstride;
  bf16_t* dst = j.dst + (size_t)bi * j.dst_bstride;
  bf16_t* T = (bf16_t*)smem;
  const int nn = t & 63, kq = t >> 6;
  const bool nvalid = (n0 + nn) < j.n_cnt;
  __syncthreads();
#pragma unroll 4
  for (int i = 0; i < 8; ++i) {
    const int kk = kq + 8 * i;
    float v = 0.f;
    if (nvalid) {
      v = src[(size_t)(k0 + kk) * j.ldS + j.n_off + n0 + nn];
      if (j.scale) v *= j.scale[k0 + kk];
    }
    T[nn * 66 + kk] = f2bf(v);
  }
  __syncthreads();
  const int n = t >> 3, part = t & 7;
  if (n0 + n < j.n_cnt) {
    const unsigned* tp = (const unsigned*)(T + n * 66 + part * 8);
    uint4 o0; o0.x = tp[0]; o0.y = tp[1]; o0.z = tp[2]; o0.w = tp[3];
    const int f = n0 + n;
    int drow;
    if (j.mode == 0) drow = j.dst_row0 + f;
    else drow = (f >> 7) * 256 + ((f >> 6) & 1) * 128 + (((f >> 5) & 1) * 2 + (j.mode == 2 ? 1 : 0)) * 32 + (f & 31);
    *(uint4*)(dst + (size_t)drow * j.K + k0 + part * 8) = o0;
  }
}

DI void mod_item(const Params& p, int it, char* smem) {
  const int t = tid_(), cgi = t & 15, kg = t >> 4;
  const int j0 = it * 16;
  float* Ssm = (float*)smem;
  float* red = (float*)(smem + 33 * 128 * 4);
  float acc[33];
#pragma unroll
  for (int r = 0; r < 33; ++r) acc[r] = 0.f;
#pragma unroll 1
  for (int kc = 0; kc < 8; ++kc) {
    __syncthreads();
    for (int idx = t; idx < 33 * 128; idx += NTH) {
      const int r = idx >> 7, kk = idx & 127;
      float v = (r < 32) ? p.c[r * DM + kc * 128 + kk] : p.c_ctx[kc * 128 + kk];
      Ssm[idx] = v * sigmoidf_(v);
    }
    __syncthreads();
    const int k = kc * 128 + kg * 4;
    const float w0 = p.w_mod[(size_t)(k + 0) * 6144 + j0 + cgi];
    const float w1 = p.w_mod[(size_t)(k + 1) * 6144 + j0 + cgi];
    const float w2 = p.w_mod[(size_t)(k + 2) * 6144 + j0 + cgi];
    const float w3 = p.w_mod[(size_t)(k + 3) * 6144 + j0 + cgi];
#pragma unroll
    for (int r = 0; r < 33; ++r) {
      const float4 s = *(const float4*)(Ssm + r * 128 + kg * 4);
      acc[r] += s.x * w0 + s.y * w1 + s.z * w2 + s.w * w3;
    }
  }
  __syncthreads();
#pragma unroll
  for (int r = 0; r < 33; ++r) red[(kg * 33 + r) * 16 + cgi] = acc[r];
  __syncthreads();
  for (int idx = t; idx < 33 * 16; idx += NTH) {
    const int r = idx >> 4, cc = idx & 15;
    float s = 0.f;
#pragma unroll
    for (int g = 0; g < 32; ++g) s += red[(g * 33 + r) * 16 + cc];
    p.mod[r * 6144 + j0 + cc] = s + p.b_mod[j0 + cc];
  }
}

DI void phase0(const Params& p, char* smem) {
  const int t = tid_();
  const int nMod = 384;
  const int nPos = 288;
  const int nMisc = 3;
  const int nT = p.n_ttiles;
  const int total = nMod + nT + nPos + nMisc;
  float* ctab = (float*)(smem + 98304);
  for (int j = t; j < 2048; j += NTH) ctab[j] = cospif((float)j * (1.f / 1024.f));
  __syncthreads();
  for (int it = blockIdx.x; it < total; it += gridDim.x) {
    if (it < nMod) { mod_item(p, it, smem); continue; }
    int u = it - nMod;
    if (u < nT) {
      int jb = 0;
#pragma unroll 1
      for (int q = 1; q < NJOBS; ++q) if (u >= p.jobs[q].tile_start) jb = q;
      transpose_tile(p.jobs[jb], u - p.jobs[jb].tile_start, smem);
      continue;
    }
    u -= nT;
    if (u < nPos) {
      for (int e = t; e < 8 * 256; e += NTH) {
        const int R = u * 8 + (e >> 8), c8 = (e & 255) * 8;
        const int part = R >= 1152 ? 1 : 0, k = R - part * 1152;
        float v[8];
#pragma unroll
        for (int q = 0; q < 8; ++q) {
          const int tt = c8 + q;
          v[q] = (k > 1024) ? 0.f : (part ? ctab[(k * tt - 512) & 2047] : ctab[(k * tt) & 2047]);
        }
        uint4 o; o.x = pk_bf16(v[0], v[1]); o.y = pk_bf16(v[2], v[3]); o.z = pk_bf16(v[4], v[5]); o.w = pk_bf16(v[6], v[7]);
        *(uint4*)(p.posM + (size_t)R * 2048 + c8) = o;
      }
      continue;
    }
    u -= nPos;
    if (u == 0) {
      for (int e = t; e < 256 * 128; e += NTH) {
        const int m2 = e >> 7, cc = e & 127, mm = m2 & 127;
        float v = (m2 < 128) ? ctab[(mm * cc * 16) & 2047] : ctab[(mm * cc * 16 - 512) & 2047];
        p.chanT[e] = f2bf(v);
      }
    } else if (u == 1) {
      for (int e = t; e < 64 * 8; e += NTH) {
        const int pos = e >> 3, jf = e & 7;
        const float inv = 1.0f / powf(10000.0f, (float)jf / 8.0f);
        const float ang = (float)pos * inv;
        p.ropeTab[e * 2 + 0] = cosf(ang);
        p.ropeTab[e * 2 + 1] = sinf(ang);
      }
    } else {
      uint4 z; z.x = z.y = z.z = z.w = 0u;
      uint4* dp = (uint4*)(p.WinT + (size_t)672 * DM);
      for (int e = t; e < 96 * DM / 8; e += NTH) dp[e] = z;
    }
  }
}

DI void phase1(const Params& p) {
  const int t_ = tid_(); const int lane = t_ & 63, w = t_ >> 6;
  const int gw = blockIdx.x * NWV + w, nw = gridDim.x * NWV;
  for (int R0 = gw; R0 < NT + NC; R0 += 2 * nw) {
    const int R1 = R0 + nw; const bool has1 = R1 < NT + NC;
    const float* src0 = (R0 < NT) ? p.x + (size_t)R0 * DM : p.ctx + (size_t)(R0 - NT) * DM;
    const float* src1 = has1 ? ((R1 < NT) ? p.x + (size_t)R1 * DM : p.ctx + (size_t)(R1 - NT) * DM) : src0;
    const float* md0 = p.mod + ((R0 < NT) ? (R0 >> 11) : 32) * 6144;
    const float* md1 = p.mod + ((has1 && R1 < NT) ? (R1 >> 11) : 32) * 6144;
    float4 v0[4], v1[4]; float s0 = 0.f, s1 = 0.f;
#pragma unroll
    for (int i = 0; i < 4; ++i) { v0[i] = *(const float4*)(src0 + lane * 4 + 256 * i); v1[i] = *(const float4*)(src1 + lane * 4 + 256 * i); }
#pragma unroll
    for (int i = 0; i < 4; ++i) { s0 += v0[i].x * v0[i].x + v0[i].y * v0[i].y + v0[i].z * v0[i].z + v0[i].w * v0[i].w; s1 += v1[i].x * v1[i].x + v1[i].y * v1[i].y + v1[i].z * v1[i].z + v1[i].w * v1[i].w; }
    s0 = wave_sum(s0); s1 = wave_sum(s1);
    const float r0 = rsqrtf(s0 * (1.f / DM) + EPS), r1 = rsqrtf(s1 * (1.f / DM) + EPS);
#pragma unroll
    for (int i = 0; i < 4; ++i) {
      const int d = lane * 4 + 256 * i;
      const float4 g = *(const float4*)(p.norm1_g + d);
      {
        const float4 sh = *(const float4*)(md0 + d), sc = *(const float4*)(md0 + 1024 + d);
        uint2 o; o.x = pk_bf16(v0[i].x * r0 * g.x * (1.f + sc.x) + sh.x, v0[i].y * r0 * g.y * (1.f + sc.y) + sh.y);
        o.y = pk_bf16(v0[i].z * r0 * g.z * (1.f + sc.z) + sh.z, v0[i].w * r0 * g.w * (1.f + sc.w) + sh.w);
        *(uint2*)(p.h + (size_t)R0 * DM + d) = o;
      }
      if (has1) {
        const float4 sh = *(const float4*)(md1 + d), sc = *(const float4*)(md1 + 1024 + d);
        uint2 o; o.x = pk_bf16(v1[i].x * r1 * g.x * (1.f + sc.x) + sh.x, v1[i].y * r1 * g.y * (1.f + sc.y) + sh.y);
        o.y = pk_bf16(v1[i].z * r1 * g.z * (1.f + sc.z) + sh.z, v1[i].w * r1 * g.w * (1.f + sc.w) + sh.w);
        *(uint2*)(p.h + (size_t)R1 * DM + d) = o;
      }
    }
  }
}

DI void phase2(const Params& p, char* smem) {
  const int xcd = blockIdx.x & 7, jl = blockIdx.x >> 3, nl = gridDim.x >> 3;
  for (int L = jl; L < 416 + 8; L += nl) {
    int tokTile, ft; const bool lat = L < 416;
    if (lat) { const int tg = L / 104, rem = L % 104; ft = rem >> 3; tokTile = xcd * 32 + tg * 8 + (rem & 7); }
    else { const int u = L - 416; tokTile = 256 + xcd * 4 + (u >> 1); ft = 1 + (u & 1); }
    f32x16 acc[4][2];
#pragma unroll
    for (int a = 0; a < 4; ++a)
#pragma unroll
      for (int b = 0; b < 2; ++b) acc[a][b] = zero16();
    const bf16_t* Ab = p.WinT + (size_t)ft * 256 * DM;
    const bf16_t* Bb = p.h + (size_t)tokTile * 256 * DM;
    float dummy = 0.f;
    gemm8<4, 2, 2, 4, false>(acc, [&](int row) { return Ab + (size_t)row * DM; }, [&](int row) { return Bb + (size_t)row * DM; }, DM, smem, dummy);
    if (ft >= 5) stage_tile<4, 2, 2, 4>(acc, smem, 528, [](float v) { return sigmoidf_(v); });
    else stage_tile<4, 2, 2, 4>(acc, smem, 528, [](float v) { return v; });
    lds_sync();
    if (lat) {
      const size_t tok0 = (size_t)tokTile * 256;
      if (ft < 3) { bf16_t* base = p.pqkv + tok0 * LDQKV + ft * 256; copy_tile(smem, 528, 256, 5, [&](int row) { return base + (size_t)row * LDQKV; }, 0, ft == 2 ? 20 : 32); }
      else if (ft < 5) { bf16_t* base = p.pf + tok0 * 512 + (ft - 3) * 256; copy_tile(smem, 528, 256, 5, [&](int row) { return base + (size_t)row * 512; }, 0, 32); }
      else { bf16_t* base = p.pg + tok0 * 2048 + (ft - 5) * 256; copy_tile(smem, 528, 256, 5, [&](int row) { return base + (size_t)row * 2048; }, 0, 32); }
    } else {
      const size_t ct0 = (size_t)(tokTile - 256) * 256;
      bf16_t* base = p.pckv + ct0 * LDCKV + ft * 256 - 384;
      copy_tile(smem, 528, 256, 5, [&](int row) { return base + (size_t)row * LDCKV; }, ft == 1 ? 16 : 0, ft == 1 ? 32 : 20);
    }
    lds_sync();
  }
}

DI void rope_pair(float& x1, float& x2, const float* tab) { const float c = tab[0], s = tab[1]; const float a = x1 * c - x2 * s, b = x2 * c + x1 * s; x1 = a; x2 = b; }

DI void phase3(const Params& p, char* smem) {
  const int t = tid_(), lane = t & 63, w = t >> 6, r = lane & 31, hh = lane >> 5;
  const int nKV = 288, nQ = 256, nCh = 128;
  const int xcd = blockIdx.x & 7, jl = blockIdx.x >> 3, nl = gridDim.x >> 3;
  for (int it = jl; it < nKV + nQ + nCh; it += nl) {
    if (it < nKV) {
      const int tl_ = it >> 3, hd = it & 7;
      const bool lat = tl_ < 32;
      const bf16_t* Bb; int ldb; const bf16_t* kpeb;
      int b, key0;
      if (lat) { const int tokTile = xcd * 32 + tl_; Bb = p.pqkv + (size_t)tokTile * 256 * LDQKV + QL; ldb = LDQKV; kpeb = p.pqkv + (size_t)tokTile * 256 * LDQKV + 640; b = tokTile >> 3; key0 = (tokTile & 7) * 256; }
      else { const int ct = xcd * 4 + (tl_ - 32); Bb = p.pckv + (size_t)ct * 256 * LDCKV; ldb = LDCKV; kpeb = Bb + 256; b = ct; key0 = SEQ; }
      const bf16_t* Ab = p.WkvT + (size_t)hd * 128 * KVL;
      f32x16 acc[4][1];
#pragma unroll
      for (int a = 0; a < 4; ++a) acc[a][0] = zero16();
      float sumsq = 0.f;
      gemm8<4, 1, 1, 8, true>(acc, [&](int row) { return Ab + (size_t)row * KVL; }, [&](int row) { return Bb + (size_t)row * ldb; }, KVL, smem, sumsq);
      sumsq += __shfl_xor(sumsq, 32);
      const float ra = rsqrtf(sumsq * (1.f / KVL) + EPS);
      const int tl = w * 32 + r;
      const int key = key0 + tl;
      float kp[16];
#pragma unroll
      for (int q = 0; q < 4; ++q) {
        const uint2 u = *(const uint2*)(kpeb + (size_t)tl * ldb + 8 * q + 4 * hh);
        kp[4 * q + 0] = bf_lo(u.x); kp[4 * q + 1] = bf_hi(u.x); kp[4 * q + 2] = bf_lo(u.y); kp[4 * q + 3] = bf_hi(u.y);
      }
      float ss = 0.f;
#pragma unroll
      for (int tm = 0; tm < 4; ++tm)
#pragma unroll
        for (int i = 0; i < 16; ++i) { const float v = acc[tm][0][i] * ra; acc[tm][0][i] = v; if (tm < 2) ss += v * v; }
#pragma unroll
      for (int i = 0; i < 16; ++i) ss += kp[i] * kp[i];
      ss += __shfl_xor(ss, 32);
      const float rk = rsqrtf(ss * (1.f / QKD) + EPS);
#pragma unroll
      for (int i = 0; i < 16; ++i) kp[i] *= rk * p.k_norm_g[64 + crow(i, hh)];
      if (lat) {
        const int pos = key;
        const float* tr = p.ropeTab + ((pos >> 6) * 8 + 4 * hh) * 2;
        const float* tc = p.ropeTab + ((pos & 63) * 8 + 4 * hh) * 2;
#pragma unroll
        for (int i = 0; i < 4; ++i) { rope_pair(kp[i], kp[i + 4], tr + 2 * i); rope_pair(kp[8 + i], kp[12 + i], tc + 2 * i); }
      }
      {
        char* kt_ = smem; char* vt_ = smem + 256 * 208;
        char* kd = kt_ + tl * 208;
#pragma unroll
        for (int tm = 0; tm < 2; ++tm)
#pragma unroll
          for (int q = 0; q < 4; ++q) {
            const int f = tm * 32 + 8 * q + 4 * hh;
            const float4 g = *(const float4*)(p.k_norm_g + f);
            uint2 o; o.x = pk_bf16(acc[tm][0][4 * q] * rk * g.x, acc[tm][0][4 * q + 1] * rk * g.y); o.y = pk_bf16(acc[tm][0][4 * q + 2] * rk * g.z, acc[tm][0][4 * q + 3] * rk * g.w);
            *(uint2*)(kd + f * 2) = o;
          }
#pragma unroll
        for (int q = 0; q < 4; ++q) {
          uint2 o; o.x = pk_bf16(kp[4 * q], kp[4 * q + 1]); o.y = pk_bf16(kp[4 * q + 2], kp[4 * q + 3]);
          *(uint2*)(kd + (64 + 8 * q + 4 * hh) * 2) = o;
        }
#pragma unroll
        for (int tm = 2; tm < 4; ++tm)
#pragma unroll
          for (int i = 0; i < 16; ++i) *(bf16_t*)(vt_ + ((tm - 2) * 32 + crow(i, hh)) * 528 + tl * 2) = f2bf(acc[tm][0][i]);
        lds_sync();
        const int tc_ = tid_();
        bf16_t* Kg = p.K + ((size_t)(b * NH + hd) * NKEY + key0) * QKD;
#pragma unroll
        for (int i = 0; i < 6; ++i) {
          const int id = tc_ + NTH * i, row = id / 12, ch = id % 12;
          *(uint4*)(Kg + row * QKD + ch * 8) = *(const uint4*)(kt_ + row * 208 + ch * 16);
        }
        bf16_t* Vg = p.Vt + (size_t)(b * NH + hd) * VD * NKEY + key0;
#pragma unroll
        for (int i = 0; i < 4; ++i) {
          const int row = (tc_ >> 5) + 16 * i, ch = tc_ & 31;
          *(uint4*)(Vg + (size_t)row * NKEY + ch * 8) = *(const uint4*)(vt_ + row * 528 + ch * 16);
        }
        lds_sync();
      }
    } else if (it < nKV + nQ) {
      const int u = it - nKV;
      const int tokTile = xcd * 32 + (u >> 3), hd = u & 7;
      const bf16_t* Bb = p.pqkv + (size_t)tokTile * 256 * LDQKV;
      const bf16_t* Ab = p.WqT + (size_t)hd * QKD * QL;
      f32x16 acc[3][1];
#pragma unroll
      for (int a = 0; a < 3; ++a) acc[a][0] = zero16();
      float sumsq = 0.f;
      gemm8<3, 1, 1, 8, true>(acc, [&](int row) { return Ab + (size_t)row * QL; }, [&](int row) { return Bb + (size_t)row * LDQKV; }, QL, smem, sumsq);
      sumsq += __shfl_xor(sumsq, 32);
      const float ra = rsqrtf(sumsq * (1.f / QL) + EPS);
      const int tl = w * 32 + r;
      const int b = tokTile >> 3, pos = (tokTile & 7) * 256 + tl;
      float ss = 0.f;
#pragma unroll
      for (int tm = 0; tm < 3; ++tm)
#pragma unroll
        for (int i = 0; i < 16; ++i) { const float v = acc[tm][0][i] * ra; acc[tm][0][i] = v; ss += v * v; }
      ss += __shfl_xor(ss, 32);
      const float rh = rsqrtf(ss * (1.f / QKD) + EPS);
#pragma unroll
      for (int tm = 0; tm < 3; ++tm)
#pragma unroll
        for (int q = 0; q < 4; ++q) {
          const float4 g = *(const float4*)(p.q_norm_g + tm * 32 + 8 * q + 4 * hh);
          acc[tm][0][4 * q] *= rh * g.x; acc[tm][0][4 * q + 1] *= rh * g.y; acc[tm][0][4 * q + 2] *= rh * g.z; acc[tm][0][4 * q + 3] *= rh * g.w;
        }
      {
        const float* tr = p.ropeTab + ((pos >> 6) * 8 + 4 * hh) * 2;
        const float* tc = p.ropeTab + ((pos & 63) * 8 + 4 * hh) * 2;
#pragma unroll
        for (int i = 0; i < 4; ++i) {
          float a0 = acc[2][0][i], a1 = acc[2][0][i + 4], c0 = acc[2][0][8 + i], c1 = acc[2][0][12 + i];
          rope_pair(a0, a1, tr + 2 * i); rope_pair(c0, c1, tc + 2 * i);
          acc[2][0][i] = a0; acc[2][0][i + 4] = a1; acc[2][0][8 + i] = c0; acc[2][0][12 + i] = c1;
        }
      }
      const float qs = 0.10206207261596575f * 1.4426950408889634f;
      {
        char* qd = smem + tl * 208;
#pragma unroll
        for (int tm = 0; tm < 3; ++tm)
#pragma unroll
          for (int q = 0; q < 4; ++q) {
            uint2 o; o.x = pk_bf16(acc[tm][0][4 * q] * qs, acc[tm][0][4 * q + 1] * qs); o.y = pk_bf16(acc[tm][0][4 * q + 2] * qs, acc[tm][0][4 * q + 3] * qs);
            *(uint2*)(qd + (tm * 32 + 8 * q + 4 * hh) * 2) = o;
          }
        lds_sync();
        const int tc_ = tid_();
        bf16_t* Qg = p.Q + ((size_t)(b * NH + hd) * SEQ + (tokTile & 7) * 256) * QKD;
#pragma unroll
        for (int i = 0; i < 6; ++i) {
          const int id = tc_ + NTH * i, row = id / 12, ch = id % 12;
          *(uint4*)(Qg + row * QKD + ch * 8) = *(const uint4*)(smem + row * 208 + ch * 16);
        }
        lds_sync();
      }
    } else {
      const int u = it - nKV - nQ;
      const int tt = u & 7, g = (u >> 3) & 3, b = xcd * 4 + (u >> 5);
      const bf16_t* Tb = p.chanT;
      const bf16_t* Fb = p.pf + (size_t)(b * SEQ + tt * 256) * 512 + g * 128;
      f32x16 acc[4][2];
#pragma unroll
      for (int a = 0; a < 4; ++a)
#pragma unroll
        for (int c = 0; c < 2; ++c) acc[a][c] = zero16();
      float dummy = 0.f;
      gemm8<4, 2, 2, 4, false>(acc, [&](int row) { return Fb + (size_t)row * 512; }, [&](int row) { return Tb + (size_t)row * 128; }, 128, smem, dummy);
      stage_tile<4, 2, 2, 4>(acc, smem, 528, [](float v) { return v; });
      lds_sync();
      bf16_t* dst0 = p.ABt + ((size_t)(b * 512 + g * 128)) * 4096 + tt * 256;
      copy_tile(smem, 528, 256, 5, [&](int row) { return dst0 + (size_t)(row & 127) * 4096 + (row >> 7) * 2048; }, 0, 32);
      lds_sync();
    }
  }
}

DI void attn_item(const Params& p, int it, char* smem) {
  const int t = tid_(), lane = t & 63, w = t >> 6, r = lane & 31, hh = lane >> 5;
  const int qt = it & 7, bh = it >> 3;
  constexpr int KROW = 208, VROW = 136, KBYTES = 64 * KROW, STAGE = KBYTES + 64 * VROW;
  const bf16_t* Kb = p.K + (size_t)bh * NKEY * QKD;
  const bf16_t* Vb = p.Vt + (size_t)bh * VD * NKEY;
  const int qpos = qt * 256 + w * 32 + r;
  const bf16_t* Qp = p.Q + ((size_t)bh * SEQ + qpos) * QKD + hh * 8;
  bf16x8 qf[6];
#pragma unroll
  for (int c = 0; c < 6; ++c) qf[c] = *(const bf16x8*)(Qp + c * 16);
  f32x16 o[2]; o[0] = zero16(); o[1] = zero16();
  float mrun = -INFINITY, lrun = 0.f;
  const int kid0 = t, kid1 = (t & 255) + 512;
  const bool k1v = t < 256;
  const int kgo0 = (kid0 / 12) * QKD + (kid0 % 12) * 8, kgo1 = (kid1 / 12) * QKD + (kid1 % 12) * 8;
  const int klo0 = (kid0 / 12) * KROW + (kid0 % 12) * 16, klo1 = (kid1 / 12) * KROW + (kid1 % 12) * 16;
  const int vgo0 = (t >> 3) * NKEY + (t & 7) * 8;
  const int vlo0 = KBYTES + (t >> 3) * VROW + (t & 7) * 16;
  uint4 rk0, rk1, rv0;
  rk0 = *(const uint4*)(Kb + kgo0); rk1 = *(const uint4*)(Kb + kgo1);
  rv0 = *(const uint4*)(Vb + vgo0);
  SB_;
#define ATT_STORE(base) do { \
    *(uint4*)((base) + klo0) = rk0; if (k1v) *(uint4*)((base) + klo1) = rk1; \
    { uint2* d = (uint2*)((base) + vlo0); d[0] = make_uint2(rv0.x, rv0.y); d[1] = make_uint2(rv0.z, rv0.w); } } while (0)
  ATT_STORE(smem);
  __syncthreads();
  constexpr int NKT = NKEY / 64;
  for (int kt = 0; kt < NKT; ++kt) {
    const char* cur = smem + (kt & 1) * STAGE;
    const bool more = kt + 1 < NKT;
    if (more) {
      const bf16_t* kn = Kb + (size_t)(kt + 1) * 64 * QKD; const bf16_t* vn = Vb + (kt + 1) * 64;
      rk0 = *(const uint4*)(kn + kgo0); rk1 = *(const uint4*)(kn + kgo1);
      rv0 = *(const uint4*)(vn + vgo0);
    }
    SB_;
    f32x16 s[2];
#pragma unroll
    for (int t2 = 0; t2 < 2; ++t2) {
      s[t2] = zero16();
      const char* kp = cur + (t2 * 32 + r) * KROW + hh * 16;
#pragma unroll
      for (int c = 0; c < 6; ++c) { const bf16x8 kf = *(const bf16x8*)(kp + c * 32); s[t2] = MFMA(kf, qf[c], s[t2]); }
    }
    SB_;
    float mx = s[0][0];
#pragma unroll
    for (int i = 0; i < 16; ++i) { mx = fmaxf(mx, s[0][i]); mx = fmaxf(mx, s[1][i]); }
    mx = fmaxf(mx, __shfl_xor(mx, 32));
    const float mnew = fmaxf(mrun, mx);
    const float alpha = __builtin_amdgcn_exp2f(mrun - mnew);
    mrun = mnew;
    float ls = 0.f;
#pragma unroll
    for (int t2 = 0; t2 < 2; ++t2)
#pragma unroll
      for (int i = 0; i < 16; ++i) { const float e = __builtin_amdgcn_exp2f(s[t2][i] - mnew); s[t2][i] = e; ls += e; }
    lrun = lrun * alpha + ls;
#pragma unroll
    for (int i = 0; i < 16; ++i) { o[0][i] *= alpha; o[1][i] *= alpha; }
    SB_;
#pragma unroll
    for (int t2 = 0; t2 < 2; ++t2)
#pragma unroll
      for (int s2 = 0; s2 < 2; ++s2) {
        uint4 pu;
        pu.x = pk_bf16(s[t2][8 * s2 + 0], s[t2][8 * s2 + 1]); pu.y = pk_bf16(s[t2][8 * s2 + 2], s[t2][8 * s2 + 3]);
        pu.z = pk_bf16(s[t2][8 * s2 + 4], s[t2][8 * s2 + 5]); pu.w = pk_bf16(s[t2][8 * s2 + 6], s[t2][8 * s2 + 7]);
        const bf16x8 pb = __builtin_bit_cast(bf16x8, pu);
#pragma unroll
        for (int vt = 0; vt < 2; ++vt) {
          const char* vp = cur + KBYTES + (vt * 32 + r) * VROW + (t2 * 32 + 16 * s2 + 4 * hh) * 2;
          const uint2 lo = *(const uint2*)(vp), hi = *(const uint2*)(vp + 16);
          uint4 vu; vu.x = lo.x; vu.y = lo.y; vu.z = hi.x; vu.w = hi.y;
          o[vt] = MFMA(__builtin_bit_cast(bf16x8, vu), pb, o[vt]);
        }
      }
    SB_;
    if (more) { char* nxt = smem + ((kt + 1) & 1) * STAGE; ATT_STORE(nxt); }
    __syncthreads();
  }
  lrun += __shfl_xor(lrun, 32);
  const float inv = 1.f / lrun;
  const int b = bh >> 3, hd = bh & 7;
  bf16_t* od = p.attn_o + (size_t)(b * SEQ + qpos) * 512 + hd * 64;
#pragma unroll
  for (int vt = 0; vt < 2; ++vt)
#pragma unroll
    for (int q = 0; q < 4; ++q) {
      uint2 ou; ou.x = pk_bf16(o[vt][4 * q] * inv, o[vt][4 * q + 1] * inv); ou.y = pk_bf16(o[vt][4 * q + 2] * inv, o[vt][4 * q + 3] * inv);
      *(uint2*)(od + vt * 32 + 8 * q + 4 * hh) = ou;
    }
}

DI void phase4(const Params& p, char* smem) {
  const int t = tid_(), lane = t & 63, w = t >> 6, r = lane & 31, hh = lane >> 5;
  const int nDft = 72, nAtt = 256;
  const int xcd = blockIdx.x & 7, jl = blockIdx.x >> 3, nl = gridDim.x >> 3;
  for (int it = jl; it < nDft + nAtt; it += nl) {
    if (it < nDft) {
      const int bl = it / 18, rem = it % 18, ct = rem / 9, kt = rem % 9, b = xcd * 4 + bl;
      const int wm = w & 3, wn = w >> 2;
      const bf16_t* Ab = p.ABt + (size_t)(b * 512 + ct * 256) * 4096;
      const bf16_t* Cb = p.posM + (size_t)kt * 128 * 2048;
      const bf16_t* Sb = p.posM + (size_t)(1152 + kt * 128) * 2048;
      f32x16 acc1[2][2], acc2[2][2];
#pragma unroll
      for (int a = 0; a < 2; ++a)
#pragma unroll
        for (int c = 0; c < 2; ++c) { acc1[a][c] = zero16(); acc2[a][c] = zero16(); }
      float dummy = 0.f;
      gemm8<2, 2, 4, 2, false>(acc1, [&](int row) { return Ab + (size_t)row * 4096; }, [&](int row) { return Cb + (size_t)row * 2048; }, 2048, smem, dummy);
      gemm8<2, 2, 4, 2, false>(acc2, [&](int row) { return Ab + (size_t)row * 4096 + 2048; }, [&](int row) { return Sb + (size_t)row * 2048; }, 2048, smem, dummy);
      const float sc = 1.f / 512.f;
#pragma unroll
      for (int tm = 0; tm < 2; ++tm)
#pragma unroll
        for (int tn = 0; tn < 2; ++tn) {
          const int kpos = kt * 128 + wn * 64 + tn * 32 + r;
          const int moff = ct * 256 + wm * 64 + tm * 32 + 4 * hh;
          if (kpos <= 1024) {
            bf16_t* d = p.four_o + (size_t)(b * SEQ + kpos) * 512 + moff;
#pragma unroll
            for (int q = 0; q < 4; ++q) {
              uint2 ou; ou.x = pk_bf16((acc1[tm][tn][4 * q] - acc2[tm][tn][4 * q]) * sc, (acc1[tm][tn][4 * q + 1] - acc2[tm][tn][4 * q + 1]) * sc);
              ou.y = pk_bf16((acc1[tm][tn][4 * q + 2] - acc2[tm][tn][4 * q + 2]) * sc, (acc1[tm][tn][4 * q + 3] - acc2[tm][tn][4 * q + 3]) * sc);
              *(uint2*)(d + 8 * q) = ou;
            }
          }
          if (kpos >= 1 && kpos <= 1023) {
            bf16_t* d = p.four_o + (size_t)(b * SEQ + 2048 - kpos) * 512 + moff;
#pragma unroll
            for (int q = 0; q < 4; ++q) {
              uint2 ou; ou.x = pk_bf16((acc1[tm][tn][4 * q] + acc2[tm][tn][4 * q]) * sc, (acc1[tm][tn][4 * q + 1] + acc2[tm][tn][4 * q + 1]) * sc);
              ou.y = pk_bf16((acc1[tm][tn][4 * q + 2] + acc2[tm][tn][4 * q + 2]) * sc, (acc1[tm][tn][4 * q + 3] + acc2[tm][tn][4 * q + 3]) * sc);
              *(uint2*)(d + 8 * q) = ou;
            }
          }
        }
    } else {
      attn_item(p, xcd * 256 + (it - nDft), smem);
    }
  }
}

DI void phase5(const Params& p, char* smem) {
  const int t = tid_();
  const int xcd = blockIdx.x & 7, jl = blockIdx.x >> 3, nl = gridDim.x >> 3;
  for (int L = jl; L < 256; L += nl) {
    const int tokTile = xcd * 64 + (L >> 5) * 8 + (L & 7), nt = (L >> 3) & 3;
    f32x16 acc1[2][2], acc2[2][2];
#pragma unroll
    for (int a = 0; a < 2; ++a)
#pragma unroll
      for (int c = 0; c < 2; ++c) { acc1[a][c] = zero16(); acc2[a][c] = zero16(); }
    float dummy = 0.f;
    {
      const bf16_t* Ab = p.WoT + (size_t)nt * 256 * 512; const bf16_t* Bb = p.attn_o + (size_t)tokTile * 128 * 512;
      gemm8<2, 2, 4, 2, false>(acc1, [&](int row) { return Ab + (size_t)row * 512; }, [&](int row) { return Bb + (size_t)row * 512; }, 512, smem, dummy);
    }
    {
      const bf16_t* Ab = p.WfT + (size_t)nt * 256 * 512; const bf16_t* Bb = p.four_o + (size_t)tokTile * 128 * 512;
      gemm8<2, 2, 4, 2, false>(acc2, [&](int row) { return Ab + (size_t)row * 512; }, [&](int row) { return Bb + (size_t)row * 512; }, 512, smem, dummy);
    }
    {
      char* t1 = smem; char* t2 = smem + 128 * 528;
      stage_tile<2, 2, 4, 2>(acc1, t1, 528, [](float v) { return v; });
      stage_tile<2, 2, 4, 2>(acc2, t2, 528, [](float v) { return v; });
      lds_sync();
      const int ch = t & 31, r0 = t >> 5;
#pragma unroll
      for (int i = 0; i < 8; ++i) {
        const int row = r0 + 16 * i;
        const size_t tok = (size_t)tokTile * 128 + row;
        const uint4 u1 = *(const uint4*)(t1 + row * 528 + ch * 16), u2 = *(const uint4*)(t2 + row * 528 + ch * 16);
        const uint4 ga = *(const uint4*)(p.pg + tok * 2048 + nt * 256 + ch * 8), gb = *(const uint4*)(p.pg + tok * 2048 + 1024 + nt * 256 + ch * 8);
        uint4 o;
        o.x = pk_bf16(bf_lo(ga.x) * bf_lo(u1.x) + bf_lo(gb.x) * bf_lo(u2.x), bf_hi(ga.x) * bf_hi(u1.x) + bf_hi(gb.x) * bf_hi(u2.x));
        o.y = pk_bf16(bf_lo(ga.y) * bf_lo(u1.y) + bf_lo(gb.y) * bf_lo(u2.y), bf_hi(ga.y) * bf_hi(u1.y) + bf_hi(gb.y) * bf_hi(u2.y));
        o.z = pk_bf16(bf_lo(ga.z) * bf_lo(u1.z) + bf_lo(gb.z) * bf_lo(u2.z), bf_hi(ga.z) * bf_hi(u1.z) + bf_hi(gb.z) * bf_hi(u2.z));
        o.w = pk_bf16(bf_lo(ga.w) * bf_lo(u1.w) + bf_lo(gb.w) * bf_lo(u2.w), bf_hi(ga.w) * bf_hi(u1.w) + bf_hi(gb.w) * bf_hi(u2.w));
        *(uint4*)(p.m + tok * DM + nt * 256 + ch * 8) = o;
      }
      lds_sync();
    }
  }
}

DI void phase6(const Params& p, char* smem) {
  const int t = tid_(), lane = t & 63, w = t >> 6, r = lane & 31, hh = lane >> 5;
  const int wm = w & 1, wn = w >> 1;
  const int xcd = blockIdx.x & 7, jl = blockIdx.x >> 3, nl = gridDim.x >> 3;
  for (int L = jl; L < 128; L += nl) {
    const int tokTile = xcd * 32 + (L >> 5) * 8 + (L & 7), nt = (L >> 3) & 3;
    f32x16 acc[4][2];
#pragma unroll
    for (int a = 0; a < 4; ++a)
#pragma unroll
      for (int c = 0; c < 2; ++c) acc[a][c] = zero16();
    float dummy = 0.f;
    const bf16_t* Wb = p.WoutT + (size_t)nt * 256 * DM; const bf16_t* Mb = p.m + (size_t)tokTile * 256 * DM;
    gemm8<4, 2, 2, 4, false>(acc, [&](int row) { return Wb + (size_t)row * DM; }, [&](int row) { return Mb + (size_t)row * DM; }, DM, smem, dummy);
    const int ch = t & 63, r0 = t >> 6;
    const float4 g = *(const float4*)(p.mod + (tokTile >> 3) * 6144 + 2048 + nt * 256 + ch * 4);
#pragma unroll
    for (int tn = 0; tn < 2; ++tn) {
#pragma unroll
      for (int tm = 0; tm < 4; ++tm) {
        char* d = smem + (wn * 32 + r) * 1040 + (wm * 128 + tm * 32 + 4 * hh) * 4;
#pragma unroll
        for (int q = 0; q < 4; ++q) *(float4*)(d + 32 * q) = make_float4(acc[tm][tn][4 * q], acc[tm][tn][4 * q + 1], acc[tm][tn][4 * q + 2], acc[tm][tn][4 * q + 3]);
      }
      lds_sync();
#pragma unroll 4
      for (int i = 0; i < 16; ++i) {
        const int row = r0 + 8 * i;
        const float4 a = *(const float4*)(smem + row * 1040 + ch * 16);
        const size_t o = ((size_t)tokTile * 256 + (row >> 5) * 64 + tn * 32 + (row & 31)) * DM + nt * 256 + ch * 4;
        const float4 xv = *(const float4*)(p.x + o);
        *(float4*)(p.out + o) = make_float4(xv.x + g.x * a.x, xv.y + g.y * a.y, xv.z + g.z * a.z, xv.w + g.w * a.w);
      }
      lds_sync();
    }
  }
}

DI void phase7(const Params& p, char* smem) {
  const int t = tid_(), lane = t & 63, w = t >> 6;
  float* wr = (float*)smem;
  for (int idx = t; idx < DM * NE; idx += NTH) { const int d = idx >> 4, e = idx & 15; wr[e * DM + d] = p.w_router[idx]; }
  __syncthreads();
  const int gw = blockIdx.x * NWV + w, nw = gridDim.x * NWV;
  for (int R = gw; R < NT; R += nw) {
    asm volatile("" ::: "memory");
    const float* src = p.out + (size_t)R * DM;
    const int b = R >> 11;
    const float* md = p.mod + b * 6144;
    float4 v[4]; float ss = 0.f;
#pragma unroll
    for (int i = 0; i < 4; ++i) { v[i] = *(const float4*)(src + lane * 4 + 256 * i); ss += v[i].x * v[i].x + v[i].y * v[i].y + v[i].z * v[i].z + v[i].w * v[i].w; }
    ss = wave_sum(ss);
    const float rr = rsqrtf(ss * (1.f / DM) + EPS);
#pragma unroll
    for (int i = 0; i < 4; ++i) {
      const int d = lane * 4 + 256 * i;
      const float4 g = *(const float4*)(p.norm2_g + d);
      const float4 sh = *(const float4*)(md + 3072 + d);
      const float4 sc = *(const float4*)(md + 4096 + d);
      v[i].x = v[i].x * rr * g.x * (1.f + sc.x) + sh.x;
      v[i].y = v[i].y * rr * g.y * (1.f + sc.y) + sh.y;
      v[i].z = v[i].z * rr * g.z * (1.f + sc.z) + sh.z;
      v[i].w = v[i].w * rr * g.w * (1.f + sc.w) + sh.w;
      uint2 o; o.x = pk_bf16(v[i].x, v[i].y); o.y = pk_bf16(v[i].z, v[i].w);
      *(uint2*)(p.h2 + (size_t)R * DM + d) = o;
    }
    float a[16];
#pragma unroll
    for (int e = 0; e < 16; ++e) {
      float s = 0.f;
#pragma unroll
      for (int i = 0; i < 4; ++i) { const float4 wv = *(const float4*)(wr + e * DM + lane * 4 + 256 * i); s += v[i].x * wv.x + v[i].y * wv.y + v[i].z * wv.z + v[i].w * wv.w; }
      a[e] = s;
      if ((e & 3) == 3) __builtin_amdgcn_sched_barrier(0);
    }
    float a8[8], a4[4], a2[2], a1;
    {
      const bool up = lane & 32;
#pragma unroll
      for (int j = 0; j < 8; ++j) { const float send = up ? a[j] : a[j + 8]; const float keep = up ? a[j + 8] : a[j]; a8[j] = keep + __shfl_xor(send, 32); }
    }
    {
      const bool up = lane & 16;
#pragma unroll
      for (int j = 0; j < 4; ++j) { const float send = up ? a8[j] : a8[j + 4]; const float keep = up ? a8[j + 4] : a8[j]; a4[j] = keep + __shfl_xor(send, 16); }
    }
    {
      const bool up = lane & 8;
#pragma unroll
      for (int j = 0; j < 2; ++j) { const float send = up ? a4[j] : a4[j + 2]; const float keep = up ? a4[j + 2] : a4[j]; a2[j] = keep + __shfl_xor(send, 8); }
    }
    {
      const bool up = lane & 4;
      const float send = up ? a2[0] : a2[1]; const float keep = up ? a2[1] : a2[0]; a1 = keep + __shfl_xor(send, 4);
    }
    a1 += __shfl_xor(a1, 2);
    a1 += __shfl_xor(a1, 1);
    float mx = a1;
#pragma unroll
    for (int o = 4; o <= 32; o <<= 1) mx = fmaxf(mx, __shfl_xor(mx, o));
    const float ex = __expf(a1 - mx);
    float sm = ex;
#pragma unroll
    for (int o = 4; o <= 32; o <<= 1) sm += __shfl_xor(sm, o);
    if ((lane & 3) == 0) {
      const int e = (lane >> 2) & 15;
      p.aff[((size_t)(b * NE + e)) * SEQ + (R & 2047)] = ex / sm;
    }
  }
}

DI void phase8(const Params& p) {
  const int t_ = tid_(); const int lane = t_ & 63, w = t_ >> 6;
  const int gw = blockIdx.x * NWV + w, nw = gridDim.x * NWV;
  for (int pr = gw; pr < NB * NE; pr += nw) {
    const float* a = p.aff + (size_t)pr * SEQ;
    unsigned u[32];
#pragma unroll
    for (int q = 0; q < 32; ++q) u[q] = __float_as_uint(a[q * 64 + lane]);
    unsigned thr = 0;
    for (int bit = 30; bit >= 0; --bit) {
      const unsigned cand = thr | (1u << bit);
      int cnt = 0;
#pragma unroll
      for (int q = 0; q < 32; ++q) cnt += __popcll(__ballot(u[q] >= cand));
      if (cnt >= CAP) thr = cand;
    }
    int ngt = 0;
#pragma unroll
    for (int q = 0; q < 32; ++q) ngt += __popcll(__ballot(u[q] > thr));
    int cgt = 0, ceq = 0;
    int* io = p.idx + pr * CAP; float* go = p.gate + pr * CAP;
    int* iv = p.inv + (size_t)pr * SEQ;
#pragma unroll
    for (int q = 0; q < 32; ++q) {
      const bool gt = u[q] > thr, eq = u[q] == thr;
      const unsigned long long mg = __ballot(gt), me = __ballot(eq);
      const unsigned long long below = (1ull << lane) - 1ull;
      int myslot = -1;
      if (gt) { const int s = cgt + __popcll(mg & below); io[s] = q * 64 + lane; go[s] = __uint_as_float(u[q]); myslot = s; }
      if (eq) { const int s = ngt + ceq + __popcll(me & below); if (s < CAP) { io[s] = q * 64 + lane; go[s] = __uint_as_float(u[q]); myslot = s; } }
      iv[q * 64 + lane] = myslot;
      cgt += __popcll(mg); ceq += __popcll(me);
    }
  }
}

DI void phase9(const Params& p, char* smem) {
  const int t = tid_(), lane = t & 63, w = t >> 6, r = lane & 31, hh = lane >> 5;
  const int wm = w & 1, wn = w >> 1;
  const int xcd = blockIdx.x & 7, jl = blockIdx.x >> 3, nl = gridDim.x >> 3;
  for (int L = jl; L < 256; L += nl) {
    const int e = xcd * 2 + (L >> 7), rem = L & 127, ft = (rem >> 3) & 3, b = (rem >> 5) * 8 + (rem & 7);
    const int be = b * NE + e;
    const bf16_t* Ab = p.WguT + ((size_t)e * 1024 + ft * 256) * DM;
    const int* ib = p.idx + be * CAP;
    const bf16_t* hb = p.h2 + (size_t)b * SEQ * DM;
    f32x16 acc[4][2];
#pragma unroll
    for (int a = 0; a < 4; ++a)
#pragma unroll
      for (int c = 0; c < 2; ++c) acc[a][c] = zero16();
    float dummy = 0.f;
    gemm8<4, 2, 2, 4, false>(acc, [&](int row) { return Ab + (size_t)row * DM; }, [&](int row) { return hb + (size_t)ib[row] * DM; }, DM, smem, dummy);
#pragma unroll
    for (int tn = 0; tn < 2; ++tn)
#pragma unroll
      for (int pr = 0; pr < 2; ++pr) {
        char* d = smem + (wn * 64 + tn * 32 + r) * 272 + (wm * 64 + pr * 32 + 4 * hh) * 2;
#pragma unroll
        for (int q = 0; q < 4; ++q) {
          float v[4];
#pragma unroll
          for (int j = 0; j < 4; ++j) { const float g = acc[2 * pr][tn][4 * q + j], uu = acc[2 * pr + 1][tn][4 * q + j]; v[j] = g * sigmoidf_(g) * uu; }
          uint2 ou; ou.x = pk_bf16(v[0], v[1]); ou.y = pk_bf16(v[2], v[3]);
          *(uint2*)(d + 16 * q) = ou;
        }
      }
    lds_sync();
    bf16_t* hd_ = p.hmid + (size_t)be * CAP * DE + ft * 128;
    copy_tile(smem, 272, 256, 4, [&](int row) { return hd_ + (size_t)row * DE; }, 0, 16);
    lds_sync();
  }
}

DI void phase10(const Params& p, char* smem) {
  const int xcd = blockIdx.x & 7, jl = blockIdx.x >> 3, nl = gridDim.x >> 3;
  for (int L = jl; L < 256; L += nl) {
    const int e = xcd * 2 + (L >> 7), rem = L & 127, nt = (rem >> 3) & 3, b = (rem >> 5) * 8 + (rem & 7);
    const int be = b * NE + e;
    const bf16_t* Hb = p.hmid + (size_t)be * CAP * DE;
    const bf16_t* Wb = p.WdT + ((size_t)e * DM + nt * 256) * DE;
    f32x16 acc[4][2];
#pragma unroll
    for (int a = 0; a < 4; ++a)
#pragma unroll
      for (int c = 0; c < 2; ++c) acc[a][c] = zero16();
    float dummy = 0.f;
    gemm8<4, 2, 2, 4, false>(acc, [&](int row) { return Wb + (size_t)row * DE; }, [&](int row) { return Hb + (size_t)row * DE; }, DE, smem, dummy);
    stage_tile<4, 2, 2, 4>(acc, smem, 528, [](float v) { return v; });
    lds_sync();
    bf16_t* yb = p.Y + (size_t)be * CAP * DM + nt * 256;
    copy_tile(smem, 528, 256, 5, [&](int row) { return yb + (size_t)row * DM; }, 0, 32);
    lds_sync();
  }
}

DI void phase11(const Params& p) {
  const int t_ = tid_(); const int lane = t_ & 63, w = t_ >> 6;
  const int gw = blockIdx.x * NWV + w, nw = gridDim.x * NWV;
  for (int R = gw; R < NT; R += nw) {
    const int b = R >> 11, tq = R & 2047;
    const int myslot = (lane < NE) ? p.inv[((size_t)(b * NE + lane)) * SEQ + tq] : -1;
    unsigned long long mask = __ballot(myslot >= 0);
    if (mask == 0ull) continue;
    float4 a[4];
#pragma unroll
    for (int i = 0; i < 4; ++i) a[i] = make_float4(0.f, 0.f, 0.f, 0.f);
    while (mask) {
      const int e = __ffsll((long long)mask) - 1; mask &= mask - 1ull;
      const int slot = __shfl(myslot, e);
      const float g = p.gate[(b * NE + e) * CAP + slot];
      const bf16_t* y = p.Y + ((size_t)(b * NE + e) * CAP + slot) * DM + lane * 4;
#pragma unroll
      for (int i = 0; i < 4; ++i) {
        const uint2 u = *(const uint2*)(y + 256 * i);
        a[i].x += g * bf_lo(u.x); a[i].y += g * bf_hi(u.x); a[i].z += g * bf_lo(u.y); a[i].w += g * bf_hi(u.y);
      }
    }
    const float* g2 = p.mod + b * 6144 + 5120;
    float* o = p.out + (size_t)R * DM;
#pragma unroll
    for (int i = 0; i < 4; ++i) {
      const int d = lane * 4 + 256 * i;
      const float4 gv = *(const float4*)(g2 + d);
      float4 xv = *(float4*)(o + d);
      xv.x += gv.x * a[i].x; xv.y += gv.y * a[i].y; xv.z += gv.z * a[i].z; xv.w += gv.w * a[i].w;
      *(float4*)(o + d) = xv;
    }
  }
}

__global__ void __launch_bounds__(NTH, 2) mega_kernel(Params p) {
  cg::grid_group grid = cg::this_grid();
  __shared__ __attribute__((aligned(16))) char smem[SMEM_BYTES];
  phase0(p, smem);  grid.sync();
  phase1(p);        grid.sync();
  phase2(p, smem);  grid.sync();
  phase3(p, smem);  grid.sync();
  phase4(p, smem);  grid.sync();
  phase5(p, smem);  grid.sync();
  phase6(p, smem);  grid.sync();
  phase7(p, smem);  grid.sync();
  phase8(p);        grid.sync();
  phase9(p, smem);  grid.sync();
  phase10(p, smem); grid.sync();
  phase11(p);
}

static inline size_t align_up(size_t v, size_t a) { return (v + a - 1) / a * a; }

extern "C" void kernel_launch(void* const* d_in, const int* in_sizes, int n_in,
                              void* d_out, int out_size, void* d_ws, size_t ws_size,
                              hipStream_t stream) {
  static int grid_blocks = 0;
  if (!grid_blocks) {
    int dev = 0, cus = 0, per_cu = 0;
    (void)hipGetDevice(&dev);
    (void)hipDeviceGetAttribute(&cus, hipDeviceAttributeMultiprocessorCount, dev);
    (void)hipOccupancyMaxActiveBlocksPerMultiprocessor(&per_cu, mega_kernel, NTH, 0);
    if (per_cu > 1) per_cu = 1;
    if (per_cu < 1) per_cu = 1;
    grid_blocks = (cus * per_cu) & ~7;
    if (grid_blocks < 8) grid_blocks = 8;
  }
  Params p;
  memset(&p, 0, sizeof(p));
  p.x = (const float*)d_in[0]; p.c = (const float*)d_in[1]; p.ctx = (const float*)d_in[2]; p.c_ctx = (const float*)d_in[3];
  p.w_mod = (const float*)d_in[4]; p.b_mod = (const float*)d_in[5]; p.norm1_g = (const float*)d_in[6];
  const float* w_in = (const float*)d_in[7];
  const float* q_a_g = (const float*)d_in[8];
  const float* kv_a_g = (const float*)d_in[9];
  const float* w_q_up = (const float*)d_in[10];
  const float* w_kv_up = (const float*)d_in[11];
  p.q_norm_g = (const float*)d_in[12]; p.k_norm_g = (const float*)d_in[13];
  const float* w_o_attn = (const float*)d_in[14];
  const float* w_fourier = (const float*)d_in[15];
  const float* w_out = (const float*)d_in[16];
  p.norm2_g = (const float*)d_in[17]; p.w_router = (const float*)d_in[18];
  const float* w_e_gate = (const float*)d_in[19];
  const float* w_e_up = (const float*)d_in[20];
  const float* w_e_down = (const float*)d_in[21];
  p.out = (float*)d_out;

  char* base = (char*)d_ws; size_t off = 0;
  auto alloc = [&](size_t bytes) { char* q = base + off; off = align_up(off + bytes, 256); return q; };
  p.WinT = (bf16_t*)alloc((size_t)NINP * DM * 2);
  p.WqT = (bf16_t*)alloc((size_t)768 * QL * 2);
  p.WkvT = (bf16_t*)alloc((size_t)1024 * KVL * 2);
  p.WoT = (bf16_t*)alloc((size_t)DM * 512 * 2);
  p.WfT = (bf16_t*)alloc((size_t)DM * 512 * 2);
  p.WoutT = (bf16_t*)alloc((size_t)DM * DM * 2);
  p.WguT = (bf16_t*)alloc((size_t)NE * 1024 * DM * 2);
  p.WdT = (bf16_t*)alloc((size_t)NE * DM * DE * 2);
  p.chanT = (bf16_t*)alloc((size_t)256 * 128 * 2);
  p.posM = (bf16_t*)alloc((size_t)2 * 1152 * 2048 * 2);
  p.ropeTab = (float*)alloc(64 * 8 * 2 * 4);
  p.mod = (float*)alloc(33 * 6144 * 4);
  p.aff = (float*)alloc((size_t)NB * NE * SEQ * 4);
  p.gate = (float*)alloc((size_t)NB * NE * CAP * 4);
  p.idx = (int*)alloc((size_t)NB * NE * CAP * 4);
  p.inv = (int*)alloc((size_t)NB * NE * SEQ * 4);
  p.pckv = (bf16_t*)alloc((size_t)NC * LDCKV * 2 + 4096);
  char* regA = alloc((size_t)(NT + NC) * DM * 2);
  p.h = (bf16_t*)regA; p.ABt = (bf16_t*)regA; p.h2 = (bf16_t*)regA;
  char* regB1 = alloc((size_t)NT * LDQKV * 2);
  p.pqkv = (bf16_t*)regB1; p.attn_o = (bf16_t*)regB1;
  char* regB2 = alloc((size_t)NT * 512 * 2);
  p.pf = (bf16_t*)regB2; p.four_o = (bf16_t*)regB2;
  p.pg = (bf16_t*)alloc((size_t)NT * 2048 * 2);
  p.Y = p.pg;
  const size_t szQ = (size_t)NB * NH * SEQ * QKD * 2, szK = (size_t)NB * NH * NKEY * QKD * 2, szV = (size_t)NB * NH * VD * NKEY * 2;
  char* regC = alloc(szQ + szK + szV + 1024);
  p.Q = (bf16_t*)regC; p.K = (bf16_t*)(regC + align_up(szQ, 256)); p.Vt = (bf16_t*)(regC + align_up(szQ, 256) + align_up(szK, 256));
  p.m = (bf16_t*)regC; p.hmid = (bf16_t*)(regC + (size_t)NT * DM * 2);
  if (off > ws_size) { fprintf(stderr, "workspace too small: need %zu have %zu\n", off, ws_size); return; }

  int ts = 0;
  auto job = [&](int i, const float* src, bf16_t* dst, const float* scale, int K, int ldS, int n_off, int n_cnt, int dst_row0, int mode, int batch, long sbs, long dbs) {
    TJob& j = p.jobs[i];
    j.src = src; j.dst = dst; j.scale = scale; j.K = K; j.ldS = ldS; j.n_off = n_off; j.n_cnt = n_cnt; j.dst_row0 = dst_row0; j.mode = mode; j.batch = batch;
    j.tiles_n = (n_cnt + 63) / 64; j.tile_start = ts; j.src_bstride = sbs; j.dst_bstride = dbs;
    ts += batch * (K / 64) * j.tiles_n;
  };
  job(0, w_e_gate, p.WguT, nullptr, DM, DE, 0, DE, 0, 1, NE, (long)DM * DE, (long)1024 * DM);
  job(1, w_e_up, p.WguT, nullptr, DM, DE, 0, DE, 0, 2, NE, (long)DM * DE, (long)1024 * DM);
  job(2, w_e_down, p.WdT, nullptr, DE, DM, 0, DM, 0, 0, NE, (long)DE * DM, (long)DM * DE);
  job(3, w_in, p.WinT, nullptr, DM, N_IN, 0, 672, 0, 0, 1, 0, 0);
  job(4, w_in, p.WinT, nullptr, DM, N_IN, 672, 2560, 768, 0, 1, 0, 0);
  job(5, w_q_up, p.WqT, q_a_g, QL, 768, 0, 768, 0, 0, 1, 0, 0);
  job(6, w_kv_up, p.WkvT, kv_a_g, KVL, 1024, 0, 1024, 0, 0, 1, 0, 0);
  job(7, w_o_attn, p.WoT, nullptr, 512, DM, 0, DM, 0, 0, 1, 0, 0);
  job(8, w_fourier, p.WfT, nullptr, 512, DM, 0, DM, 0, 0, 1, 0, 0);
  job(9, w_out, p.WoutT, nullptr, DM, DM, 0, DM, 0, 0, 1, 0, 0);
  p.n_ttiles = ts;

  void* args[] = {&p};
  hipError_t e = hipLaunchCooperativeKernel((void*)mega_kernel, dim3(grid_blocks), dim3(NTH), args, 0, stream);
  if (e != hipSuccess) fprintf(stderr, "cooperative launch failed: %s (grid %d)\n", hipGetErrorString(e), grid_blocks);
}
```

```cpp
#include <hip/hip_runtime.h>
#include <hip/hip_cooperative_groups.h>
#include <cstdio>
#include <cstring>
#include <cstdint>
namespace cg = cooperative_groups;

#define DI __device__ __forceinline__
typedef unsigned short bf16_t;
typedef short bf16x8 __attribute__((ext_vector_type(8)));
typedef float f32x16 __attribute__((ext_vector_type(16)));
#define MFMA(a, b, c) __builtin_amdgcn_mfma_f32_32x32x16_bf16((a), (b), (c), 0, 0, 0)

constexpr int NB = 32, SEQ = 2048, DM = 1024, NT = NB * SEQ, CTXL = 256, NC = NB * CTXL;
constexpr int NH = 8, QKD = 96, VD = 64, QL = 384, KVL = 256, NKEY = SEQ + CTXL;
constexpr int N_IN = 3232, NINP = 3328;
constexpr int NE = 16, DE = 512, CAP = 256;
constexpr float EPS = 1e-6f;
constexpr int LDQKV = 672, LDCKV = 288;
constexpr int NTH = 512, NWV = 8;
constexpr int SMEM_BYTES = 147456;

struct TJob {
  const float* src; bf16_t* dst; const float* scale;
  int K, ldS, n_off, n_cnt, dst_row0, mode, batch, tiles_n, tile_start, pad0;
  long src_bstride, dst_bstride;
};
constexpr int NJOBS = 10;

struct Params {
  const float *x, *c, *ctx, *c_ctx, *w_mod, *b_mod, *norm1_g, *q_norm_g, *k_norm_g, *norm2_g, *w_router;
  float* out;
  bf16_t *WinT, *WqT, *WkvT, *WoT, *WfT, *WoutT, *WguT, *WdT, *chanT, *posM;
  float *ropeTab, *mod;
  bf16_t *h, *pqkv, *pckv, *pf, *pg, *Q, *K, *Vt, *attn_o, *ABt, *four_o, *m, *h2, *hmid;
  float *aff, *gate;
  int* idx;
  int* inv;
  bf16_t* Y;
  TJob jobs[NJOBS];
  int n_ttiles, pad1;
};

typedef float f32x2v __attribute__((ext_vector_type(2)));
typedef __bf16 bf16x2v __attribute__((ext_vector_type(2)));
DI unsigned pk_bf16(float lo, float hi) { f32x2v v = {lo, hi}; bf16x2v b = __builtin_convertvector(v, bf16x2v); return __builtin_bit_cast(unsigned, b); }
DI int tid_() { int t = threadIdx.x; asm volatile("" : "+v"(t)); return t; }
DI float bf_lo(unsigned u) { return __uint_as_float(u << 16); }
DI float bf_hi(unsigned u) { return __uint_as_float(u & 0xffff0000u); }
DI bf16_t f2bf(float f) { return (bf16_t)(pk_bf16(f, 0.f) & 0xffffu); }
DI float sigmoidf_(float x) { return 1.f / (1.f + __expf(-x)); }
DI int crow(int i, int hh) { return (i & 3) + 8 * (i >> 2) + 4 * hh; }
DI float wave_sum(float v) {
#pragma unroll
  for (int o = 32; o >= 1; o >>= 1) v += __shfl_xor(v, o);
  return v;
}
DI f32x16 zero16() { f32x16 z;
#pragma unroll
  for (int i = 0; i < 16; ++i) z[i] = 0.f; return z; }
DI void wait_vm0() { asm volatile("s_waitcnt vmcnt(0)" ::: "memory"); }
DI void wait_lgkm0() { asm volatile("s_waitcnt lgkmcnt(0)" ::: "memory"); }
DI void bar_() { __builtin_amdgcn_s_barrier(); }
DI void lds_sync() { wait_lgkm0(); bar_(); }
#define GLDS(gp, lp) __builtin_amdgcn_global_load_lds((const unsigned*)(gp), (__attribute__((address_space(3))) unsigned*)(lp), 16, 0, 0)
#define SB_ __builtin_amdgcn_sched_barrier(0)

constexpr int EPI_OFF = 65536;
template <int TM, int TN, int WM, int WN, bool SUMSQ, class AF, class BF, class AFN, class BFN>
DI void gemm8x(f32x16 (&acc)[TM][TN], AF arow, BF brow, int K, char* smem, float& sumsq, bool pre, bool hasNext, AFN arowN, BFN browN) {
  constexpr int RA = 32 * TM * WM, RB = 32 * TN * WN;
  constexpr int LDR = 128, STAGE = (RA + RB) * LDR;
  static_assert(WM * WN == NWV, "waves");
  static_assert(2 * STAGE <= SMEM_BYTES, "smem");
  static_assert(RA <= 256 && RB <= 256 && RA % 32 == 0 && RB % 32 == 0, "shape");
  const int t = tid_(), lane = t & 63, w = t >> 6, r = lane & 31, hh = lane >> 5;
  const int wm = w % WM, wn = w / WM;
  const int row0 = t >> 3;
  const int c = (t & 7) ^ ((row0 >> 1) & 7);
  const bool a0v = row0 < RA, a1v = row0 + 64 < RA, a2v = row0 + 128 < RA, a3v = row0 + 192 < RA;
  const bool b0v = row0 < RB, b1v = row0 + 64 < RB, b2v = row0 + 128 < RB, b3v = row0 + 192 < RB;
  const bf16_t* pa0 = arow(a0v ? row0 : 0) + c * 8;
  const bf16_t* pa1 = arow(a1v ? row0 + 64 : 0) + c * 8;
  const bf16_t* pa2 = arow(a2v ? row0 + 128 : 0) + c * 8;
  const bf16_t* pa3 = arow(a3v ? row0 + 192 : 0) + c * 8;
  const bf16_t* pb0 = brow(b0v ? row0 : 0) + c * 8;
  const bf16_t* pb1 = brow(b1v ? row0 + 64 : 0) + c * 8;
  const bf16_t* pb2 = brow(b2v ? row0 + 128 : 0) + c * 8;
  const bf16_t* pb3 = brow(b3v ? row0 + 192 : 0) + c * 8;
  if (!pre) {
    char* l_ = smem + t * 16; char* m_ = l_ + RA * LDR;
    if (a0v) GLDS(pa0, l_); if (a1v) GLDS(pa1, l_ + 8192); if (a2v) GLDS(pa2, l_ + 16384); if (a3v) GLDS(pa3, l_ + 24576);
    if (b0v) GLDS(pb0, m_); if (b1v) GLDS(pb1, m_ + 8192); if (b2v) GLDS(pb2, m_ + 16384); if (b3v) GLDS(pb3, m_ + 24576);
  }
  wait_vm0(); bar_();
  const int nk = K >> 6;
  const int sw = (r >> 1) & 7;
  const int aoff = (wm * TM * 32 + r) * LDR, boff = RA * LDR + (wn * TN * 32 + r) * LDR;
  auto compute = [&](const char* cur, char* nxt, bool issue, const bf16_t* q0, const bf16_t* q1, const bf16_t* q2, const bf16_t* q3,
                     const bf16_t* s0, const bf16_t* s1, const bf16_t* s2, const bf16_t* s3) {
    const char* As = cur + aoff;
    const char* Bs = cur + boff;
    char* l_ = nxt + t * 16; char* m_ = l_ + RA * LDR;
    bf16x8 a0[TM], b0[TN], a1[TM], b1[TN];
#define LOADF(A_, B_, ks) do { const int po_ = (((ks) * 2 + hh) ^ sw) * 16; \
      _Pragma("unroll") for (int tm = 0; tm < TM; ++tm) A_[tm] = *(const bf16x8*)(As + tm * 32 * LDR + po_); \
      _Pragma("unroll") for (int tn = 0; tn < TN; ++tn) B_[tn] = *(const bf16x8*)(Bs + tn * 32 * LDR + po_); } while (0)
#define MMF(A_, B_) do { if (SUMSQ) { uint4 u = __builtin_bit_cast(uint4, B_[0]); \
        float e0 = bf_lo(u.x), e1 = bf_hi(u.x), e2 = bf_lo(u.y), e3 = bf_hi(u.y), e4 = bf_lo(u.z), e5 = bf_hi(u.z), e6 = bf_lo(u.w), e7 = bf_hi(u.w); \
        sumsq += e0 * e0 + e1 * e1 + e2 * e2 + e3 * e3 + e4 * e4 + e5 * e5 + e6 * e6 + e7 * e7; } \
      _Pragma("unroll") for (int tm = 0; tm < TM; ++tm) _Pragma("unroll") for (int tn = 0; tn < TN; ++tn) acc[tm][tn] = MFMA(A_[tm], B_[tn], acc[tm][tn]); } while (0)
    LOADF(a0, b0, 0);
    LOADF(a1, b1, 1);
    SB_;
    if (issue) { if (a0v) GLDS(q0, l_); if (a1v) GLDS(q1, l_ + 8192); }
    SB_;
    __builtin_amdgcn_s_setprio(1);
    MMF(a0, b0);
    LOADF(a0, b0, 2);
    SB_;
    if (issue) { if (a2v) GLDS(q2, l_ + 16384); if (a3v) GLDS(q3, l_ + 24576); }
    SB_;
    MMF(a1, b1);
    LOADF(a1, b1, 3);
    SB_;
    if (issue) { if (b0v) GLDS(s0, m_); if (b1v) GLDS(s1, m_ + 8192); }
    SB_;
    MMF(a0, b0);
    SB_;
    if (issue) { if (b2v) GLDS(s2, m_ + 16384); if (b3v) GLDS(s3, m_ + 24576); }
    SB_;
    MMF(a1, b1);
    __builtin_amdgcn_s_setprio(0);
  };
  for (int kt = 0; kt < nk - 1; ++kt) {
    SB_;
    const int ko = (kt + 1) * 64;
    compute(smem + (kt & 1) * STAGE, smem + ((kt + 1) & 1) * STAGE, true, pa0 + ko, pa1 + ko, pa2 + ko, pa3 + ko, pb0 + ko, pb1 + ko, pb2 + ko, pb3 + ko);
    SB_;
    wait_vm0(); bar_();
  }
  {
    const bf16_t *q0 = pa0, *q1 = pa0, *q2 = pa0, *q3 = pa0, *s0 = pa0, *s1 = pa0, *s2 = pa0, *s3 = pa0;
    if (hasNext) {
      q0 = arowN(a0v ? row0 : 0) + c * 8; q1 = arowN(a1v ? row0 + 64 : 0) + c * 8; q2 = arowN(a2v ? row0 + 128 : 0) + c * 8; q3 = arowN(a3v ? row0 + 192 : 0) + c * 8;
      s0 = browN(b0v ? row0 : 0) + c * 8; s1 = browN(b1v ? row0 + 64 : 0) + c * 8; s2 = browN(b2v ? row0 + 128 : 0) + c * 8; s3 = browN(b3v ? row0 + 192 : 0) + c * 8;
    }
    SB_;
    compute(smem + ((nk - 1) & 1) * STAGE, smem, hasNext, q0, q1, q2, q3, s0, s1, s2, s3);
    SB_;
    lds_sync();
  }
}
template <int TM, int TN, int WM, int WN, bool SUMSQ, class AF, class BF>
DI void gemm8(f32x16 (&acc)[TM][TN], AF arow, BF brow, int K, char* smem, float& sumsq) {
  gemm8x<TM, TN, WM, WN, SUMSQ>(acc, arow, brow, K, smem, sumsq, false, false, arow, brow);
}
template <int TM, int WM, int WN, int TNSEL, class F>
DI void stage_half(const f32x16 (&acc)[TM][2], char* tile, int pitch, F f) {
  const int t = tid_(), lane = t & 63, w = t >> 6, r = lane & 31, hh = lane >> 5;
  const int wm = w % WM, wn = w / WM;
#pragma unroll
  for (int tm = 0; tm < TM; ++tm) {
    char* d = tile + (wn * 32 + r) * pitch + (wm * TM * 32 + tm * 32 + 4 * hh) * 2;
#pragma unroll
    for (int q = 0; q < 4; ++q) {
      const f32x16& a = acc[tm][TNSEL];
      uint2 o; o.x = pk_bf16(f(a[4 * q]), f(a[4 * q + 1])); o.y = pk_bf16(f(a[4 * q + 2]), f(a[4 * q + 3]));
      *(uint2*)(d + 16 * q) = o;
    }
  }
}

template <int TM, int TN, int WM, int WN, class F>
DI void stage_tile(const f32x16 (&acc)[TM][TN], char* tile, int pitch, F f) {
  const int t = tid_(), lane = t & 63, w = t >> 6, r = lane & 31, hh = lane >> 5;
  const int wm = w % WM, wn = w / WM;
#pragma unroll
  for (int tm = 0; tm < TM; ++tm)
#pragma unroll
    for (int tn = 0; tn < TN; ++tn) {
      char* d = tile + (wn * TN * 32 + tn * 32 + r) * pitch + (wm * TM * 32 + tm * 32 + 4 * hh) * 2;
#pragma unroll
      for (int q = 0; q < 4; ++q) {
        uint2 o; o.x = pk_bf16(f(acc[tm][tn][4 * q]), f(acc[tm][tn][4 * q + 1])); o.y = pk_bf16(f(acc[tm][tn][4 * q + 2]), f(acc[tm][tn][4 * q + 3]));
        *(uint2*)(d + 16 * q) = o;
      }
    }
}
template <class RF>
DI void copy_tile(const char* tile, int pitch, int rows, int lch, RF dst, int ch0, int ch1) {
  const int t = tid_();
  const int total = rows << lch;
  for (int id = t; id < total; id += NTH) {
    const int row = id >> lch, ch = id & ((1 << lch) - 1);
    if (ch >= ch0 && ch < ch1) *(uint4*)(dst(row) + ch * 8) = *(const uint4*)(tile + row * pitch + ch * 16);
  }
}

DI void transpose_tile(const TJob& j, int tile, char* smem) {
  const int t = tid_();
  const int tpb = (j.K >> 6) * j.tiles_n;
  const int bi = tile / tpb, rem = tile % tpb;
  const int kt = rem / j.tiles_n, ntile = rem % j.tiles_n;
  const int k0 = kt * 64, n0 = ntile * 64;
  const float* src = j.src + (size_t)bi * j.src_bstride;
  bf16_t* dst = j.dst + (size_t)bi * j.dst_bstride;
  bf16_t* T = (bf16_t*)smem;
  const int nn = t & 63, kq = t >> 6;
  const bool nvalid = (n0 + nn) < j.n_cnt;
  __syncthreads();
#pragma unroll 4
  for (int i = 0; i < 8; ++i) {
    const int kk = kq + 8 * i;
    float v = 0.f;
    if (nvalid) {
      v = src[(size_t)(k0 + kk) * j.ldS + j.n_off + n0 + nn];
      if (j.scale) v *= j.scale[k0 + kk];
    }
    T[nn * 66 + kk] = f2bf(v);
  }
  __syncthreads();
  const int n = t >> 3, part = t & 7;
  if (n0 + n < j.n_cnt) {
    const unsigned* tp = (const unsigned*)(T + n * 66 + part * 8);
    uint4 o0; o0.x = tp[0]; o0.y = tp[1]; o0.z = tp[2]; o0.w = tp[3];
    const int f = n0 + n;
    int drow;
    if (j.mode == 0) drow = j.dst_row0 + f;
    else drow = (f >> 7) * 256 + ((f >> 6) & 1) * 128 + (((f >> 5) & 1) * 2 + (j.mode == 2 ? 1 : 0)) * 32 + (f & 31);
    *(uint4*)(dst + (size_t)drow * j.K + k0 + part * 8) = o0;
  }
}

DI void mod_item(const Params& p, int it, char* smem) {
  const int t = tid_(), cgi = t & 15, kg = t >> 4;
  const int j0 = it * 16;
  float* Ssm = (float*)smem;
  float* red = (float*)(smem + 33 * 128 * 4);
  float acc[33];
#pragma unroll
  for (int r = 0; r < 33; ++r) acc[r] = 0.f;
#pragma unroll 1
  for (int kc = 0; kc < 8; ++kc) {
    __syncthreads();
    for (int idx = t; idx < 33 * 128; idx += NTH) {
      const int r = idx >> 7, kk = idx & 127;
      float v = (r < 32) ? p.c[r * DM + kc * 128 + kk] : p.c_ctx[kc * 128 + kk];
      Ssm[idx] = v * sigmoidf_(v);
    }
    __syncthreads();
    const int k = kc * 128 + kg * 4;
    const float w0 = p.w_mod[(size_t)(k + 0) * 6144 + j0 + cgi];
    const float w1 = p.w_mod[(size_t)(k + 1) * 6144 + j0 + cgi];
    const float w2 = p.w_mod[(size_t)(k + 2) * 6144 + j0 + cgi];
    const float w3 = p.w_mod[(size_t)(k + 3) * 6144 + j0 + cgi];
#pragma unroll
    for (int r = 0; r < 33; ++r) {
      const float4 s = *(const float4*)(Ssm + r * 128 + kg * 4);
      acc[r] += s.x * w0 + s.y * w1 + s.z * w2 + s.w * w3;
    }
  }
  __syncthreads();
#pragma unroll
  for (int r = 0; r < 33; ++r) red[(kg * 33 + r) * 16 + cgi] = acc[r];
  __syncthreads();
  for (int idx = t; idx < 33 * 16; idx += NTH) {
    const int r = idx >> 4, cc = idx & 15;
    float s = 0.f;
#pragma unroll
    for (int g = 0; g < 32; ++g) s += red[(g * 33 + r) * 16 + cc];
    p.mod[r * 6144 + j0 + cc] = s + p.b_mod[j0 + cc];
  }
}

DI void phase0(const Params& p, char* smem) {
  const int t = tid_();
  const int nMod = 384;
  const int nPos = 288;
  const int nMisc = 3;
  const int nT = p.n_ttiles;
  const int total = nMod + nT + nPos + nMisc;
  float* ctab = (float*)(smem + 98304);
  for (int j = t; j < 2048; j += NTH) ctab[j] = cospif((float)j * (1.f / 1024.f));
  __syncthreads();
  for (int it = blockIdx.x; it < total; it += gridDim.x) {
    if (it < nMod) { mod_item(p, it, smem); continue; }
    int u = it - nMod;
    if (u < nT) {
      int jb = 0;
#pragma unroll 1
      for (int q = 1; q < NJOBS; ++q) if (u >= p.jobs[q].tile_start) jb = q;
      transpose_tile(p.jobs[jb], u - p.jobs[jb].tile_start, smem);
      continue;
    }
    u -= nT;
    if (u < nPos) {
      for (int e = t; e < 8 * 256; e += NTH) {
        const int R = u * 8 + (e >> 8), c8 = (e & 255) * 8;
        const int part = R >= 1152 ? 1 : 0, k = R - part * 1152;
        float v[8];
#pragma unroll
        for (int q = 0; q < 8; ++q) {
          const int tt = c8 + q;
          v[q] = (k > 1024) ? 0.f : (part ? ctab[(k * tt - 512) & 2047] : ctab[(k * tt) & 2047]);
        }
        uint4 o; o.x = pk_bf16(v[0], v[1]); o.y = pk_bf16(v[2], v[3]); o.z = pk_bf16(v[4], v[5]); o.w = pk_bf16(v[6], v[7]);
        *(uint4*)(p.posM + (size_t)R * 2048 + c8) = o;
      }
      continue;
    }
    u -= nPos;
    if (u == 0) {
      for (int e = t; e < 256 * 128; e += NTH) {
        const int m2 = e >> 7, cc = e & 127, mm = m2 & 127;
        float v = (m2 < 128) ? ctab[(mm * cc * 16) & 2047] : ctab[(mm * cc * 16 - 512) & 2047];
        p.chanT[e] = f2bf(v);
      }
    } else if (u == 1) {
      for (int e = t; e < 64 * 8; e += NTH) {
        const int pos = e >> 3, jf = e & 7;
        const float inv = 1.0f / powf(10000.0f, (float)jf / 8.0f);
        const float ang = (float)pos * inv;
        p.ropeTab[e * 2 + 0] = cosf(ang);
        p.ropeTab[e * 2 + 1] = sinf(ang);
      }
    } else {
      uint4 z; z.x = z.y = z.z = z.w = 0u;
      uint4* dp = (uint4*)(p.WinT + (size_t)672 * DM);
      for (int e = t; e < 96 * DM / 8; e += NTH) dp[e] = z;
    }
  }
}

DI void phase1(const Params& p) {
  const int t_ = tid_(); const int lane = t_ & 63, w = t_ >> 6;
  const int gw = blockIdx.x * NWV + w, nw = gridDim.x * NWV;
  for (int R0 = gw; R0 < NT + NC; R0 += 2 * nw) {
    const int R1 = R0 + nw; const bool has1 = R1 < NT + NC;
    const float* src0 = (R0 < NT) ? p.x + (size_t)R0 * DM : p.ctx + (size_t)(R0 - NT) * DM;
    const float* src1 = has1 ? ((R1 < NT) ? p.x + (size_t)R1 * DM : p.ctx + (size_t)(R1 - NT) * DM) : src0;
    const float* md0 = p.mod + ((R0 < NT) ? (R0 >> 11) : 32) * 6144;
    const float* md1 = p.mod + ((has1 && R1 < NT) ? (R1 >> 11) : 32) * 6144;
    float4 v0[4], v1[4]; float s0 = 0.f, s1 = 0.f;
#pragma unroll
    for (int i = 0; i < 4; ++i) { v0[i] = *(const float4*)(src0 + lane * 4 + 256 * i); v1[i] = *(const float4*)(src1 + lane * 4 + 256 * i); }
#pragma unroll
    for (int i = 0; i < 4; ++i) { s0 += v0[i].x * v0[i].x + v0[i].y * v0[i].y + v0[i].z * v0[i].z + v0[i].w * v0[i].w; s1 += v1[i].x * v1[i].x + v1[i].y * v1[i].y + v1[i].z * v1[i].z + v1[i].w * v1[i].w; }
    s0 = wave_sum(s0); s1 = wave_sum(s1);
    const float r0 = rsqrtf(s0 * (1.f / DM) + EPS), r1 = rsqrtf(s1 * (1.f / DM) + EPS);
#pragma unroll
    for (int i = 0; i < 4; ++i) {
      const int d = lane * 4 + 256 * i;
      const float4 g = *(const float4*)(p.norm1_g + d);
      {
        const float4 sh = *(const float4*)(md0 + d), sc = *(const float4*)(md0 + 1024 + d);
        uint2 o; o.x = pk_bf16(v0[i].x * r0 * g.x * (1.f + sc.x) + sh.x, v0[i].y * r0 * g.y * (1.f + sc.y) + sh.y);
        o.y = pk_bf16(v0[i].z * r0 * g.z * (1.f + sc.z) + sh.z, v0[i].w * r0 * g.w * (1.f + sc.w) + sh.w);
        *(uint2*)(p.h + (size_t)R0 * DM + d) = o;
      }
      if (has1) {
        const float4 sh = *(const float4*)(md1 + d), sc = *(const float4*)(md1 + 1024 + d);
        uint2 o; o.x = pk_bf16(v1[i].x * r1 * g.x * (1.f + sc.x) + sh.x, v1[i].y * r1 * g.y * (1.f + sc.y) + sh.y);
        o.y = pk_bf16(v1[i].z * r1 * g.z * (1.f + sc.z) + sh.z, v1[i].w * r1 * g.w * (1.f + sc.w) + sh.w);
        *(uint2*)(p.h + (size_t)R1 * DM + d) = o;
      }
    }
  }
}

DI void phase2(const Params& p, char* smem) {
  const int xcd = blockIdx.x & 7, jl = blockIdx.x >> 3, nl = gridDim.x >> 3;
  auto decode = [&](int L, int& tokTile, int& ft) {
    if (L < 416) { const int tg = L / 104, rem = L % 104; ft = rem >> 3; tokTile = xcd * 32 + tg * 8 + (rem & 7); }
    else { const int u = L - 416; tokTile = 256 + xcd * 4 + (u >> 1); ft = 1 + (u & 1); }
  };
  bool pre = false;
  for (int L = jl; L < 416 + 8; L += nl) {
    int tokTile, ft, tokTileN = 0, ftN = 0;
    decode(L, tokTile, ft);
    const bool lat = L < 416;
    const int Ln = L + nl; const bool hasNext = Ln < 416 + 8;
    if (hasNext) decode(Ln, tokTileN, ftN);
    f32x16 acc[4][2];
#pragma unroll
    for (int a = 0; a < 4; ++a)
#pragma unroll
      for (int b = 0; b < 2; ++b) acc[a][b] = zero16();
    const bf16_t* Ab = p.WinT + (size_t)ft * 256 * DM;
    const bf16_t* Bb = p.h + (size_t)tokTile * 256 * DM;
    const bf16_t* AbN = p.WinT + (size_t)ftN * 256 * DM;
    const bf16_t* BbN = p.h + (size_t)tokTileN * 256 * DM;
    float dummy = 0.f;
    gemm8x<4, 2, 2, 4, false>(acc, [&](int row) { return Ab + (size_t)row * DM; }, [&](int row) { return Bb + (size_t)row * DM; }, DM, smem, dummy,
                              pre, hasNext, [&](int row) { return AbN + (size_t)row * DM; }, [&](int row) { return BbN + (size_t)row * DM; });
    pre = hasNext;
    char* tile = smem + EPI_OFF;
    bf16_t* base; int ld, c0 = 0, c1 = 32;
    if (lat) {
      const size_t tok0 = (size_t)tokTile * 256;
      if (ft < 3) { base = p.pqkv + tok0 * LDQKV + ft * 256; ld = LDQKV; if (ft == 2) c1 = 20; }
      else if (ft < 5) { base = p.pf + tok0 * 512 + (ft - 3) * 256; ld = 512; }
      else { base = p.pg + tok0 * 2048 + (ft - 5) * 256; ld = 2048; }
    } else {
      const size_t ct0 = (size_t)(tokTile - 256) * 256;
      base = p.pckv + ct0 * LDCKV + ft * 256 - 384; ld = LDCKV;
      if (ft == 1) c0 = 16; else c1 = 20;
    }
    if (ft >= 5) stage_half<4, 2, 4, 0>(acc, tile, 528, [](float v) { return sigmoidf_(v); });
    else stage_half<4, 2, 4, 0>(acc, tile, 528, [](float v) { return v; });
    lds_sync();
    copy_tile(tile, 528, 128, 5, [&](int rl) { return base + (size_t)((rl >> 5) * 64 + (rl & 31)) * ld; }, c0, c1);
    lds_sync();
    if (ft >= 5) stage_half<4, 2, 4, 1>(acc, tile, 528, [](float v) { return sigmoidf_(v); });
    else stage_half<4, 2, 4, 1>(acc, tile, 528, [](float v) { return v; });
    lds_sync();
    copy_tile(tile, 528, 128, 5, [&](int rl) { return base + (size_t)((rl >> 5) * 64 + 32 + (rl & 31)) * ld; }, c0, c1);
  }
}

DI void rope_pair(float& x1, float& x2, const float* tab) { const float c = tab[0], s = tab[1]; const float a = x1 * c - x2 * s, b = x2 * c + x1 * s; x1 = a; x2 = b; }

DI void phase3(const Params& p, char* smem) {
  const int t = tid_(), lane = t & 63, w = t >> 6, r = lane & 31, hh = lane >> 5;
  const int nKV = 288, nQ = 256, nCh = 128;
  const int xcd = blockIdx.x & 7, jl = blockIdx.x >> 3, nl = gridDim.x >> 3;
  for (int it = jl; it < nKV + nQ + nCh; it += nl) {
    if (it < nKV) {
      const int tl_ = it >> 3, hd = it & 7;
      const bool lat = tl_ < 32;
      const bf16_t* Bb; int ldb; const bf16_t* kpeb;
      int b, key0;
      if (lat) { const int tokTile = xcd * 32 + tl_; Bb = p.pqkv + (size_t)tokTile * 256 * LDQKV + QL; ldb = LDQKV; kpeb = p.pqkv + (size_t)tokTile * 256 * LDQKV + 640; b = tokTile >> 3; key0 = (tokTile & 7) * 256; }
      else { const int ct = xcd * 4 + (tl_ - 32); Bb = p.pckv + (size_t)ct * 256 * LDCKV; ldb = LDCKV; kpeb = Bb + 256; b = ct; key0 = SEQ; }
      const bf16_t* Ab = p.WkvT + (size_t)hd * 128 * KVL;
      f32x16 acc[4][1];
#pragma unroll
      for (int a = 0; a < 4; ++a) acc[a][0] = zero16();
      float sumsq = 0.f;
      gemm8<4, 1, 1, 8, true>(acc, [&](int row) { return Ab + (size_t)row * KVL; }, [&](int row) { return Bb + (size_t)row * ldb; }, KVL, smem, sumsq);
      sumsq += __shfl_xor(sumsq, 32);
      const float ra = rsqrtf(sumsq * (1.f / KVL) + EPS);
      const int tl = w * 32 + r;
      const int key = key0 + tl;
      float kp[16];
#pragma unroll
      for (int q = 0; q < 4; ++q) {
        const uint2 u = *(const uint2*)(kpeb + (size_t)tl * ldb + 8 * q + 4 * hh);
        kp[4 * q + 0] = bf_lo(u.x); kp[4 * q + 1] = bf_hi(u.x); kp[4 * q + 2] = bf_lo(u.y); kp[4 * q + 3] = bf_hi(u.y);
      }
      float ss = 0.f;
#pragma unroll
      for (int tm = 0; tm < 4; ++tm)
#pragma unroll
        for (int i = 0; i < 16; ++i) { const float v = acc[tm][0][i] * ra; acc[tm][0][i] = v; if (tm < 2) ss += v * v; }
#pragma unroll
      for (int i = 0; i < 16; ++i) ss += kp[i] * kp[i];
      ss += __shfl_xor(ss, 32);
      const float rk = rsqrtf(ss * (1.f / QKD) + EPS);
#pragma unroll
      for (int i = 0; i < 16; ++i) kp[i] *= rk * p.k_norm_g[64 + crow(i, hh)];
      if (lat) {
        const int pos = key;
        const float* tr = p.ropeTab + ((pos >> 6) * 8 + 4 * hh) * 2;
        const float* tc = p.ropeTab + ((pos & 63) * 8 + 4 * hh) * 2;
#pragma unroll
        for (int i = 0; i < 4; ++i) { rope_pair(kp[i], kp[i + 4], tr + 2 * i); rope_pair(kp[8 + i], kp[12 + i], tc + 2 * i); }
      }
      {
        char* kt_ = smem; char* vt_ = smem + 256 * 208;
        char* kd = kt_ + tl * 208;
#pragma unroll
        for (int tm = 0; tm < 2; ++tm)
#pragma unroll
          for (int q = 0; q < 4; ++q) {
            const int f = tm * 32 + 8 * q + 4 * hh;
            const float4 g = *(const float4*)(p.k_norm_g + f);
            uint2 o; o.x = pk_bf16(acc[tm][0][4 * q] * rk * g.x, acc[tm][0][4 * q + 1] * rk * g.y); o.y = pk_bf16(acc[tm][0][4 * q + 2] * rk * g.z, acc[tm][0][4 * q + 3] * rk * g.w);
            *(uint2*)(kd + f * 2) = o;
          }
#pragma unroll
        for (int q = 0; q < 4; ++q) {
          uint2 o; o.x = pk_bf16(kp[4 * q], kp[4 * q + 1]); o.y = pk_bf16(kp[4 * q + 2], kp[4 * q + 3]);
          *(uint2*)(kd + (64 + 8 * q + 4 * hh) * 2) = o;
        }
#pragma unroll
        for (int tm = 2; tm < 4; ++tm)
#pragma unroll
          for (int i = 0; i < 16; ++i) *(bf16_t*)(vt_ + ((tm - 2) * 32 + crow(i, hh)) * 528 + tl * 2) = f2bf(acc[tm][0][i]);
        lds_sync();
        const int tc_ = tid_();
        bf16_t* Kg = p.K + ((size_t)(b * NH + hd) * NKEY + key0) * QKD;
#pragma unroll
        for (int i = 0; i < 6; ++i) {
          const int id = tc_ + NTH * i, row = id / 12, ch = id % 12;
          *(uint4*)(Kg + row * QKD + ch * 8) = *(const uint4*)(kt_ + row * 208 + ch * 16);
        }
        bf16_t* Vg = p.Vt + (size_t)(b * NH + hd) * VD * NKEY + key0;
#pragma unroll
        for (int i = 0; i < 4; ++i) {
          const int row = (tc_ >> 5) + 16 * i, ch = tc_ & 31;
          *(uint4*)(Vg + (size_t)row * NKEY + ch * 8) = *(const uint4*)(vt_ + row * 528 + ch * 16);
        }
        lds_sync();
      }
    } else if (it < nKV + nQ) {
      const int u = it - nKV;
      const int tokTile = xcd * 32 + (u >> 3), hd = u & 7;
      const bf16_t* Bb = p.pqkv + (size_t)tokTile * 256 * LDQKV;
      const bf16_t* Ab = p.WqT + (size_t)hd * QKD * QL;
      f32x16 acc[3][1];
#pragma unroll
      for (int a = 0; a < 3; ++a) acc[a][0] = zero16();
      float sumsq = 0.f;
      gemm8<3, 1, 1, 8, true>(acc, [&](int row) { return Ab + (size_t)row * QL; }, [&](int row) { return Bb + (size_t)row * LDQKV; }, QL, smem, sumsq);
      sumsq += __shfl_xor(sumsq, 32);
      const float ra = rsqrtf(sumsq * (1.f / QL) + EPS);
      const int tl = w * 32 + r;
      const int b = tokTile >> 3, pos = (tokTile & 7) * 256 + tl;
      float ss = 0.f;
#pragma unroll
      for (int tm = 0; tm < 3; ++tm)
#pragma unroll
        for (int i = 0; i < 16; ++i) { const float v = acc[tm][0][i] * ra; acc[tm][0][i] = v; ss += v * v; }
      ss += __shfl_xor(ss, 32);
      const float rh = rsqrtf(ss * (1.f / QKD) + EPS);
#pragma unroll
      for (int tm = 0; tm < 3; ++tm)
#pragma unroll
        for (int q = 0; q < 4; ++q) {
          const float4 g = *(const float4*)(p.q_norm_g + tm * 32 + 8 * q + 4 * hh);
          acc[tm][0][4 * q] *= rh * g.x; acc[tm][0][4 * q + 1] *= rh * g.y; acc[tm][0][4 * q + 2] *= rh * g.z; acc[tm][0][4 * q + 3] *= rh * g.w;
        }
      {
        const float* tr = p.ropeTab + ((pos >> 6) * 8 + 4 * hh) * 2;
        const float* tc = p.ropeTab + ((pos & 63) * 8 + 4 * hh) * 2;
#pragma unroll
        for (int i = 0; i < 4; ++i) {
          float a0 = acc[2][0][i], a1 = acc[2][0][i + 4], c0 = acc[2][0][8 + i], c1 = acc[2][0][12 + i];
          rope_pair(a0, a1, tr + 2 * i); rope_pair(c0, c1, tc + 2 * i);
          acc[2][0][i] = a0; acc[2][0][i + 4] = a1; acc[2][0][8 + i] = c0; acc[2][0][12 + i] = c1;
        }
      }
      const float qs = 0.10206207261596575f * 1.4426950408889634f;
      {
        char* qd = smem + tl * 208;
#pragma unroll
        for (int tm = 0; tm < 3; ++tm)
#pragma unroll
          for (int q = 0; q < 4; ++q) {
            uint2 o; o.x = pk_bf16(acc[tm][0][4 * q] * qs, acc[tm][0][4 * q + 1] * qs); o.y = pk_bf16(acc[tm][0][4 * q + 2] * qs, acc[tm][0][4 * q + 3] * qs);
            *(uint2*)(qd + (tm * 32 + 8 * q + 4 * hh) * 2) = o;
          }
        lds_sync();
        const int tc_ = tid_();
        bf16_t* Qg = p.Q + ((size_t)(b * NH + hd) * SEQ + (tokTile & 7) * 256) * QKD;
#pragma unroll
        for (int i = 0; i < 6; ++i) {
          const int id = tc_ + NTH * i, row = id / 12, ch = id % 12;
          *(uint4*)(Qg + row * QKD + ch * 8) = *(const uint4*)(smem + row * 208 + ch * 16);
        }
        lds_sync();
      }
    } else {
      const int u = it - nKV - nQ;
      const int tt = u & 7, g = (u >> 3) & 3, b = xcd * 4 + (u >> 5);
      const bf16_t* Tb = p.chanT;
      const bf16_t* Fb = p.pf + (size_t)(b * SEQ + tt * 256) * 512 + g * 128;
      f32x16 acc[4][2];
#pragma unroll
      for (int a = 0; a < 4; ++a)
#pragma unroll
        for (int c = 0; c < 2; ++c) acc[a][c] = zero16();
      float dummy = 0.f;
      gemm8<4, 2, 2, 4, false>(acc, [&](int row) { return Fb + (size_t)row * 512; }, [&](int row) { return Tb + (size_t)row * 128; }, 128, smem, dummy);
      stage_tile<4, 2, 2, 4>(acc, smem, 528, [](float v) { return v; });
      lds_sync();
      bf16_t* dst0 = p.ABt + ((size_t)(b * 512 + g * 128)) * 4096 + tt * 256;
      copy_tile(smem, 528, 256, 5, [&](int row) { return dst0 + (size_t)(row & 127) * 4096 + (row >> 7) * 2048; }, 0, 32);
      lds_sync();
    }
  }
}

DI void attn_item(const Params& p, int it, char* smem) {
  const int t = tid_(), lane = t & 63, w = t >> 6, r = lane & 31, hh = lane >> 5;
  const int qt = it & 7, bh = it >> 3;
  constexpr int KROW = 208, VROW = 136, KBYTES = 64 * KROW, STAGE = KBYTES + 64 * VROW;
  const bf16_t* Kb = p.K + (size_t)bh * NKEY * QKD;
  const bf16_t* Vb = p.Vt + (size_t)bh * VD * NKEY;
  const int qpos = qt * 256 + w * 32 + r;
  const bf16_t* Qp = p.Q + ((size_t)bh * SEQ + qpos) * QKD + hh * 8;
  bf16x8 qf[6];
#pragma unroll
  for (int c = 0; c < 6; ++c) qf[c] = *(const bf16x8*)(Qp + c * 16);
  f32x16 o[2]; o[0] = zero16(); o[1] = zero16();
  float mrun = -INFINITY, lrun = 0.f;
  const int kid0 = t, kid1 = (t & 255) + 512;
  const bool k1v = t < 256;
  const int kgo0 = (kid0 / 12) * QKD + (kid0 % 12) * 8, kgo1 = (kid1 / 12) * QKD + (kid1 % 12) * 8;
  const int klo0 = (kid0 / 12) * KROW + (kid0 % 12) * 16, klo1 = (kid1 / 12) * KROW + (kid1 % 12) * 16;
  const int vgo0 = (t >> 3) * NKEY + (t & 7) * 8;
  const int vlo0 = KBYTES + (t >> 3) * VROW + (t & 7) * 16;
  uint4 rk0, rk1, rv0;
  rk0 = *(const uint4*)(Kb + kgo0); rk1 = *(const uint4*)(Kb + kgo1);
  rv0 = *(const uint4*)(Vb + vgo0);
  SB_;
#define ATT_STORE(base) do { \
    *(uint4*)((base) + klo0) = rk0; if (k1v) *(uint4*)((base) + klo1) = rk1; \
    { uint2* d = (uint2*)((base) + vlo0); d[0] = make_uint2(rv0.x, rv0.y); d[1] = make_uint2(rv0.z, rv0.w); } } while (0)
  ATT_STORE(smem);
  __syncthreads();
  constexpr int NKT = NKEY / 64;
  for (int kt = 0; kt < NKT; ++kt) {
    const char* cur = smem + (kt & 1) * STAGE;
    const bool more = kt + 1 < NKT;
    if (more) {
      const bf16_t* kn = Kb + (size_t)(kt + 1) * 64 * QKD; const bf16_t* vn = Vb + (kt + 1) * 64;
      rk0 = *(const uint4*)(kn + kgo0); rk1 = *(const uint4*)(kn + kgo1);
      rv0 = *(const uint4*)(vn + vgo0);
    }
    SB_;
    f32x16 s[2];
#pragma unroll
    for (int t2 = 0; t2 < 2; ++t2) {
      s[t2] = zero16();
      const char* kp = cur + (t2 * 32 + r) * KROW + hh * 16;
#pragma unroll
      for (int c = 0; c < 6; ++c) { const bf16x8 kf = *(const bf16x8*)(kp + c * 32); s[t2] = MFMA(kf, qf[c], s[t2]); }
    }
    SB_;
    float mx = s[0][0];
#pragma unroll
    for (int i = 0; i < 16; ++i) { mx = fmaxf(mx, s[0][i]); mx = fmaxf(mx, s[1][i]); }
    mx = fmaxf(mx, __shfl_xor(mx, 32));
    const float mnew = fmaxf(mrun, mx);
    const float alpha = __builtin_amdgcn_exp2f(mrun - mnew);
    mrun = mnew;
    float ls = 0.f;
#pragma unroll
    for (int t2 = 0; t2 < 2; ++t2)
#pragma unroll
      for (int i = 0; i < 16; ++i) { const float e = __builtin_amdgcn_exp2f(s[t2][i] - mnew); s[t2][i] = e; ls += e; }
    lrun = lrun * alpha + ls;
#pragma unroll
    for (int i = 0; i < 16; ++i) { o[0][i] *= alpha; o[1][i] *= alpha; }
    SB_;
#pragma unroll
    for (int t2 = 0; t2 < 2; ++t2)
#pragma unroll
      for (int s2 = 0; s2 < 2; ++s2) {
        uint4 pu;
        pu.x = pk_bf16(s[t2][8 * s2 + 0], s[t2][8 * s2 + 1]); pu.y = pk_bf16(s[t2][8 * s2 + 2], s[t2][8 * s2 + 3]);
        pu.z = pk_bf16(s[t2][8 * s2 + 4], s[t2][8 * s2 + 5]); pu.w = pk_bf16(s[t2][8 * s2 + 6], s[t2][8 * s2 + 7]);
        const bf16x8 pb = __builtin_bit_cast(bf16x8, pu);
#pragma unroll
        for (int vt = 0; vt < 2; ++vt) {
          const char* vp = cur + KBYTES + (vt * 32 + r) * VROW + (t2 * 32 + 16 * s2 + 4 * hh) * 2;
          const uint2 lo = *(const uint2*)(vp), hi = *(const uint2*)(vp + 16);
          uint4 vu; vu.x = lo.x; vu.y = lo.y; vu.z = hi.x; vu.w = hi.y;
          o[vt] = MFMA(__builtin_bit_cast(bf16x8, vu), pb, o[vt]);
        }
      }
    SB_;
    if (more) { char* nxt = smem + ((kt + 1) & 1) * STAGE; ATT_STORE(nxt); }
    __syncthreads();
  }
  lrun += __shfl_xor(lrun, 32);
  const float inv = 1.f / lrun;
  const int b = bh >> 3, hd = bh & 7;
  bf16_t* od = p.attn_o + (size_t)(b * SEQ + qpos) * 512 + hd * 64;
#pragma unroll
  for (int vt = 0; vt < 2; ++vt)
#pragma unroll
    for (int q = 0; q < 4; ++q) {
      uint2 ou; ou.x = pk_bf16(o[vt][4 * q] * inv, o[vt][4 * q + 1] * inv); ou.y = pk_bf16(o[vt][4 * q + 2] * inv, o[vt][4 * q + 3] * inv);
      *(uint2*)(od + vt * 32 + 8 * q + 4 * hh) = ou;
    }
}

DI void phase4(const Params& p, char* smem) {
  const int t = tid_(), lane = t & 63, w = t >> 6, r = lane & 31, hh = lane >> 5;
  const int nDft = 64, nAlt = 4, nAtt = 256;
  const int xcd = blockIdx.x & 7, jl = blockIdx.x >> 3, nl = gridDim.x >> 3;
  for (int it = jl; it < nDft + nAlt + nAtt; it += nl) {
    if (it < nDft) {
      const int bl = it >> 4, rem = it & 15, ct = rem >> 3, kt = rem & 7, b = xcd * 4 + bl;
      const int wm = w & 3, wn = w >> 2;
      const bf16_t* Ab = p.ABt + (size_t)(b * 512 + ct * 256) * 4096;
      const bf16_t* Cb = p.posM + (size_t)kt * 128 * 2048;
      const bf16_t* Sb = p.posM + (size_t)(1152 + kt * 128) * 2048;
      f32x16 acc1[2][2], acc2[2][2];
#pragma unroll
      for (int a = 0; a < 2; ++a)
#pragma unroll
        for (int c = 0; c < 2; ++c) { acc1[a][c] = zero16(); acc2[a][c] = zero16(); }
      float dummy = 0.f;
      gemm8<2, 2, 4, 2, false>(acc1, [&](int row) { return Ab + (size_t)row * 4096; }, [&](int row) { return Cb + (size_t)row * 2048; }, 2048, smem, dummy);
      gemm8<2, 2, 4, 2, false>(acc2, [&](int row) { return Ab + (size_t)row * 4096 + 2048; }, [&](int row) { return Sb + (size_t)row * 2048; }, 2048, smem, dummy);
      const float sc = 1.f / 512.f;
#pragma unroll
      for (int tm = 0; tm < 2; ++tm)
#pragma unroll
        for (int tn = 0; tn < 2; ++tn) {
          const int kpos = kt * 128 + wn * 64 + tn * 32 + r;
          const int moff = ct * 256 + wm * 64 + tm * 32 + 4 * hh;
          if (kpos <= 1024) {
            bf16_t* d = p.four_o + (size_t)(b * SEQ + kpos) * 512 + moff;
#pragma unroll
            for (int q = 0; q < 4; ++q) {
              uint2 ou; ou.x = pk_bf16((acc1[tm][tn][4 * q] - acc2[tm][tn][4 * q]) * sc, (acc1[tm][tn][4 * q + 1] - acc2[tm][tn][4 * q + 1]) * sc);
              ou.y = pk_bf16((acc1[tm][tn][4 * q + 2] - acc2[tm][tn][4 * q + 2]) * sc, (acc1[tm][tn][4 * q + 3] - acc2[tm][tn][4 * q + 3]) * sc);
              *(uint2*)(d + 8 * q) = ou;
            }
          }
          if (kpos >= 1 && kpos <= 1023) {
            bf16_t* d = p.four_o + (size_t)(b * SEQ + 2048 - kpos) * 512 + moff;
#pragma unroll
            for (int q = 0; q < 4; ++q) {
              uint2 ou; ou.x = pk_bf16((acc1[tm][tn][4 * q] + acc2[tm][tn][4 * q]) * sc, (acc1[tm][tn][4 * q + 1] + acc2[tm][tn][4 * q + 1]) * sc);
              ou.y = pk_bf16((acc1[tm][tn][4 * q + 2] + acc2[tm][tn][4 * q + 2]) * sc, (acc1[tm][tn][4 * q + 3] + acc2[tm][tn][4 * q + 3]) * sc);
              *(uint2*)(d + 8 * q) = ou;
            }
          }
        }
    } else if (it < nDft + nAlt) {
      const int b = xcd * 4 + (it - nDft);
      for (int m = w; m < 512; m += NWV) {
        const bf16_t* rowp = p.ABt + (size_t)(b * 512 + m) * 4096 + lane * 8;
        float sacc = 0.f;
#pragma unroll
        for (int i = 0; i < 4; ++i) {
          const uint4 u = *(const uint4*)(rowp + 512 * i);
          sacc += (bf_lo(u.x) - bf_hi(u.x)) + (bf_lo(u.y) - bf_hi(u.y)) + (bf_lo(u.z) - bf_hi(u.z)) + (bf_lo(u.w) - bf_hi(u.w));
        }
        sacc = wave_sum(sacc);
        if (lane == 0) p.four_o[(size_t)(b * SEQ + 1024) * 512 + m] = f2bf(sacc * (1.f / 512.f));
      }
    } else {
      attn_item(p, xcd * 256 + (it - nDft - nAlt), smem);
    }
  }
}

DI void phase5(const Params& p, char* smem) {
  const int t = tid_();
  const int xcd = blockIdx.x & 7, jl = blockIdx.x >> 3, nl = gridDim.x >> 3;
  for (int L = jl; L < 256; L += nl) {
    const int tokTile = xcd * 64 + (L >> 5) * 8 + (L & 7), nt = (L >> 3) & 3;
    f32x16 acc1[2][2], acc2[2][2];
#pragma unroll
    for (int a = 0; a < 2; ++a)
#pragma unroll
      for (int c = 0; c < 2; ++c) { acc1[a][c] = zero16(); acc2[a][c] = zero16(); }
    float dummy = 0.f;
    {
      const bf16_t* Ab = p.WoT + (size_t)nt * 256 * 512; const bf16_t* Bb = p.attn_o + (size_t)tokTile * 128 * 512;
      gemm8<2, 2, 4, 2, false>(acc1, [&](int row) { return Ab + (size_t)row * 512; }, [&](int row) { return Bb + (size_t)row * 512; }, 512, smem, dummy);
    }
    {
      const bf16_t* Ab = p.WfT + (size_t)nt * 256 * 512; const bf16_t* Bb = p.four_o + (size_t)tokTile * 128 * 512;
      gemm8<2, 2, 4, 2, false>(acc2, [&](int row) { return Ab + (size_t)row * 512; }, [&](int row) { return Bb + (size_t)row * 512; }, 512, smem, dummy);
    }
    {
      char* t1 = smem; char* t2 = smem + 128 * 528;
      stage_tile<2, 2, 4, 2>(acc1, t1, 528, [](float v) { return v; });
      stage_tile<2, 2, 4, 2>(acc2, t2, 528, [](float v) { return v; });
      lds_sync();
      const int ch = t & 31, r0 = t >> 5;
#pragma unroll
      for (int i = 0; i < 8; ++i) {
        const int row = r0 + 16 * i;
        const size_t tok = (size_t)tokTile * 128 + row;
        const uint4 u1 = *(const uint4*)(t1 + row * 528 + ch * 16), u2 = *(const uint4*)(t2 + row * 528 + ch * 16);
        const uint4 ga = *(const uint4*)(p.pg + tok * 2048 + nt * 256 + ch * 8), gb = *(const uint4*)(p.pg + tok * 2048 + 1024 + nt * 256 + ch * 8);
        uint4 o;
        o.x = pk_bf16(bf_lo(ga.x) * bf_lo(u1.x) + bf_lo(gb.x) * bf_lo(u2.x), bf_hi(ga.x) * bf_hi(u1.x) + bf_hi(gb.x) * bf_hi(u2.x));
        o.y = pk_bf16(bf_lo(ga.y) * bf_lo(u1.y) + bf_lo(gb.y) * bf_lo(u2.y), bf_hi(ga.y) * bf_hi(u1.y) + bf_hi(gb.y) * bf_hi(u2.y));
        o.z = pk_bf16(bf_lo(ga.z) * bf_lo(u1.z) + bf_lo(gb.z) * bf_lo(u2.z), bf_hi(ga.z) * bf_hi(u1.z) + bf_hi(gb.z) * bf_hi(u2.z));
        o.w = pk_bf16(bf_lo(ga.w) * bf_lo(u1.w) + bf_lo(gb.w) * bf_lo(u2.w), bf_hi(ga.w) * bf_hi(u1.w) + bf_hi(gb.w) * bf_hi(u2.w));
        *(uint4*)(p.m + tok * DM + nt * 256 + ch * 8) = o;
      }
      lds_sync();
    }
  }
}

DI void phase6(const Params& p, char* smem) {
  const int t = tid_(), lane = t & 63, w = t >> 6, r = lane & 31, hh = lane >> 5;
  const int wm = w & 1, wn = w >> 1;
  const int xcd = blockIdx.x & 7, jl = blockIdx.x >> 3, nl = gridDim.x >> 3;
  for (int L = jl; L < 128; L += nl) {
    const int tokTile = xcd * 32 + (L >> 5) * 8 + (L & 7), nt = (L >> 3) & 3;
    f32x16 acc[4][2];
#pragma unroll
    for (int a = 0; a < 4; ++a)
#pragma unroll
      for (int c = 0; c < 2; ++c) acc[a][c] = zero16();
    float dummy = 0.f;
    const bf16_t* Wb = p.WoutT + (size_t)nt * 256 * DM; const bf16_t* Mb = p.m + (size_t)tokTile * 256 * DM;
    gemm8<4, 2, 2, 4, false>(acc, [&](int row) { return Wb + (size_t)row * DM; }, [&](int row) { return Mb + (size_t)row * DM; }, DM, smem, dummy);
    const int ch = t & 63, r0 = t >> 6;
    const float4 g = *(const float4*)(p.mod + (tokTile >> 3) * 6144 + 2048 + nt * 256 + ch * 4);
#pragma unroll
    for (int tn = 0; tn < 2; ++tn) {
#pragma unroll
      for (int tm = 0; tm < 4; ++tm) {
        char* d = smem + (wn * 32 + r) * 1040 + (wm * 128 + tm * 32 + 4 * hh) * 4;
#pragma unroll
        for (int q = 0; q < 4; ++q) *(float4*)(d + 32 * q) = make_float4(acc[tm][tn][4 * q], acc[tm][tn][4 * q + 1], acc[tm][tn][4 * q + 2], acc[tm][tn][4 * q + 3]);
      }
      lds_sync();
#pragma unroll 4
      for (int i = 0; i < 16; ++i) {
        const int row = r0 + 8 * i;
        const float4 a = *(const float4*)(smem + row * 1040 + ch * 16);
        const size_t o = ((size_t)tokTile * 256 + (row >> 5) * 64 + tn * 32 + (row & 31)) * DM + nt * 256 + ch * 4;
        const float4 xv = *(const float4*)(p.x + o);
        *(float4*)(p.out + o) = make_float4(xv.x + g.x * a.x, xv.y + g.y * a.y, xv.z + g.z * a.z, xv.w + g.w * a.w);
      }
      lds_sync();
    }
  }
}

DI void phase7(const Params& p, char* smem) {
  const int t = tid_(), lane = t & 63, w = t >> 6;
  float* wr = (float*)smem;
  for (int idx = t; idx < DM * NE; idx += NTH) { const int d = idx >> 4, e = idx & 15; wr[e * DM + d] = p.w_router[idx]; }
  __syncthreads();
  const int gw = blockIdx.x * NWV + w, nw = gridDim.x * NWV;
  for (int R = gw; R < NT; R += nw) {
    asm volatile("" ::: "memory");
    const float* src = p.out + (size_t)R * DM;
    const int b = R >> 11;
    const float* md = p.mod + b * 6144;
    float4 v[4]; float ss = 0.f;
#pragma unroll
    for (int i = 0; i < 4; ++i) { v[i] = *(const float4*)(src + lane * 4 + 256 * i); ss += v[i].x * v[i].x + v[i].y * v[i].y + v[i].z * v[i].z + v[i].w * v[i].w; }
    ss = wave_sum(ss);
    const float rr = rsqrtf(ss * (1.f / DM) + EPS);
#pragma unroll
    for (int i = 0; i < 4; ++i) {
      const int d = lane * 4 + 256 * i;
      const float4 g = *(const float4*)(p.norm2_g + d);
      const float4 sh = *(const float4*)(md + 3072 + d);
      const float4 sc = *(const float4*)(md + 4096 + d);
      v[i].x = v[i].x * rr * g.x * (1.f + sc.x) + sh.x;
      v[i].y = v[i].y * rr * g.y * (1.f + sc.y) + sh.y;
      v[i].z = v[i].z * rr * g.z * (1.f + sc.z) + sh.z;
      v[i].w = v[i].w * rr * g.w * (1.f + sc.w) + sh.w;
      uint2 o; o.x = pk_bf16(v[i].x, v[i].y); o.y = pk_bf16(v[i].z, v[i].w);
      *(uint2*)(p.h2 + (size_t)R * DM + d) = o;
    }
    float a[16];
#pragma unroll
    for (int e = 0; e < 16; ++e) {
      float s = 0.f;
#pragma unroll
      for (int i = 0; i < 4; ++i) { const float4 wv = *(const float4*)(wr + e * DM + lane * 4 + 256 * i); s += v[i].x * wv.x + v[i].y * wv.y + v[i].z * wv.z + v[i].w * wv.w; }
      a[e] = s;
      if ((e & 3) == 3) __builtin_amdgcn_sched_barrier(0);
    }
    float a8[8], a4[4], a2[2], a1;
    {
      const bool up = lane & 32;
#pragma unroll
      for (int j = 0; j < 8; ++j) { const float send = up ? a[j] : a[j + 8]; const float keep = up ? a[j + 8] : a[j]; a8[j] = keep + __shfl_xor(send, 32); }
    }
    {
      const bool up = lane & 16;
#pragma unroll
      for (int j = 0; j < 4; ++j) { const float send = up ? a8[j] : a8[j + 4]; const float keep = up ? a8[j + 4] : a8[j]; a4[j] = keep + __shfl_xor(send, 16); }
    }
    {
      const bool up = lane & 8;
#pragma unroll
      for (int j = 0; j < 2; ++j) { const float send = up ? a4[j] : a4[j + 2]; const float keep = up ? a4[j + 2] : a4[j]; a2[j] = keep + __shfl_xor(send, 8); }
    }
    {
      const bool up = lane & 4;
      const float send = up ? a2[0] : a2[1]; const float keep = up ? a2[1] : a2[0]; a1 = keep + __shfl_xor(send, 4);
    }
    a1 += __shfl_xor(a1, 2);
    a1 += __shfl_xor(a1, 1);
    float mx = a1;
#pragma unroll
    for (int o = 4; o <= 32; o <<= 1) mx = fmaxf(mx, __shfl_xor(mx, o));
    const float ex = __expf(a1 - mx);
    float sm = ex;
#pragma unroll
    for (int o = 4; o <= 32; o <<= 1) sm += __shfl_xor(sm, o);
    if ((lane & 3) == 0) {
      const int e = (lane >> 2) & 15;
      p.aff[((size_t)(b * NE + e)) * SEQ + (R & 2047)] = ex / sm;
    }
  }
}

DI void phase8(const Params& p) {
  const int t_ = tid_(); const int lane = t_ & 63, w = t_ >> 6;
  const int gw = blockIdx.x * NWV + w, nw = gridDim.x * NWV;
  for (int pr = gw; pr < NB * NE; pr += nw) {
    const float* a = p.aff + (size_t)pr * SEQ;
    unsigned u[32];
#pragma unroll
    for (int q = 0; q < 32; ++q) u[q] = __float_as_uint(a[q * 64 + lane]);
    unsigned thr = 0;
    for (int bit = 30; bit >= 0; --bit) {
      const unsigned cand = thr | (1u << bit);
      int cnt = 0;
#pragma unroll
      for (int q = 0; q < 32; ++q) cnt += __popcll(__ballot(u[q] >= cand));
      if (cnt >= CAP) thr = cand;
    }
    int ngt = 0;
#pragma unroll
    for (int q = 0; q < 32; ++q) ngt += __popcll(__ballot(u[q] > thr));
    int cgt = 0, ceq = 0;
    int* io = p.idx + pr * CAP; float* go = p.gate + pr * CAP;
    int* iv = p.inv + (size_t)pr * SEQ;
#pragma unroll
    for (int q = 0; q < 32; ++q) {
      const bool gt = u[q] > thr, eq = u[q] == thr;
      const unsigned long long mg = __ballot(gt), me = __ballot(eq);
      const unsigned long long below = (1ull << lane) - 1ull;
      int myslot = -1;
      if (gt) { const int s = cgt + __popcll(mg & below); io[s] = q * 64 + lane; go[s] = __uint_as_float(u[q]); myslot = s; }
      if (eq) { const int s = ngt + ceq + __popcll(me & below); if (s < CAP) { io[s] = q * 64 + lane; go[s] = __uint_as_float(u[q]); myslot = s; } }
      iv[q * 64 + lane] = myslot;
      cgt += __popcll(mg); ceq += __popcll(me);
    }
  }
}

DI void phase9(const Params& p, char* smem) {
  const int t = tid_(), lane = t & 63, w = t >> 6, r = lane & 31, hh = lane >> 5;
  const int wm = w & 1, wn = w >> 1;
  const int xcd = blockIdx.x & 7, jl = blockIdx.x >> 3, nl = gridDim.x >> 3;
  auto decode = [&](int L, int& e, int& ft, int& b) { e = xcd * 2 + (L >> 7); const int rem = L & 127; ft = (rem >> 3) & 3; b = (rem >> 5) * 8 + (rem & 7); };
  bool pre = false;
  for (int L = jl; L < 256; L += nl) {
    int e, ft, b, eN = 0, ftN = 0, bN = 0;
    decode(L, e, ft, b);
    const int Ln = L + nl; const bool hasNext = Ln < 256;
    if (hasNext) decode(Ln, eN, ftN, bN);
    const int be = b * NE + e;
    const bf16_t* Ab = p.WguT + ((size_t)e * 1024 + ft * 256) * DM;
    const int* ib = p.idx + be * CAP;
    const bf16_t* hb = p.h2 + (size_t)b * SEQ * DM;
    const bf16_t* AbN = p.WguT + ((size_t)eN * 1024 + ftN * 256) * DM;
    const int* ibN = p.idx + (bN * NE + eN) * CAP;
    const bf16_t* hbN = p.h2 + (size_t)bN * SEQ * DM;
    f32x16 acc[4][2];
#pragma unroll
    for (int a = 0; a < 4; ++a)
#pragma unroll
      for (int c = 0; c < 2; ++c) acc[a][c] = zero16();
    float dummy = 0.f;
    gemm8x<4, 2, 2, 4, false>(acc, [&](int row) { return Ab + (size_t)row * DM; }, [&](int row) { return hb + (size_t)ib[row] * DM; }, DM, smem, dummy,
                              pre, hasNext, [&](int row) { return AbN + (size_t)row * DM; }, [&](int row) { return hbN + (size_t)ibN[row] * DM; });
    pre = hasNext;
    char* tile = smem + EPI_OFF;
#pragma unroll
    for (int tn = 0; tn < 2; ++tn)
#pragma unroll
      for (int pr = 0; pr < 2; ++pr) {
        char* d = tile + (wn * 64 + tn * 32 + r) * 272 + (wm * 64 + pr * 32 + 4 * hh) * 2;
#pragma unroll
        for (int q = 0; q < 4; ++q) {
          float v[4];
#pragma unroll
          for (int j = 0; j < 4; ++j) { const float g = acc[2 * pr][tn][4 * q + j], uu = acc[2 * pr + 1][tn][4 * q + j]; v[j] = g * sigmoidf_(g) * uu; }
          uint2 ou; ou.x = pk_bf16(v[0], v[1]); ou.y = pk_bf16(v[2], v[3]);
          *(uint2*)(d + 16 * q) = ou;
        }
      }
    lds_sync();
    bf16_t* hd_ = p.hmid + (size_t)be * CAP * DE + ft * 128;
    copy_tile(tile, 272, 256, 4, [&](int row) { return hd_ + (size_t)row * DE; }, 0, 16);
  }
}

DI void phase10(const Params& p, char* smem) {
  const int xcd = blockIdx.x & 7, jl = blockIdx.x >> 3, nl = gridDim.x >> 3;
  auto decode = [&](int L, int& e, int& nt, int& b) { e = xcd * 2 + (L >> 7); const int rem = L & 127; nt = (rem >> 3) & 3; b = (rem >> 5) * 8 + (rem & 7); };
  bool pre = false;
  for (int L = jl; L < 256; L += nl) {
    int e, nt, b, eN = 0, ntN = 0, bN = 0;
    decode(L, e, nt, b);
    const int Ln = L + nl; const bool hasNext = Ln < 256;
    if (hasNext) decode(Ln, eN, ntN, bN);
    const int be = b * NE + e;
    const bf16_t* Hb = p.hmid + (size_t)be * CAP * DE;
    const bf16_t* Wb = p.WdT + ((size_t)e * DM + nt * 256) * DE;
    const bf16_t* HbN = p.hmid + (size_t)(bN * NE + eN) * CAP * DE;
    const bf16_t* WbN = p.WdT + ((size_t)eN * DM + ntN * 256) * DE;
    f32x16 acc[4][2];
#pragma unroll
    for (int a = 0; a < 4; ++a)
#pragma unroll
      for (int c = 0; c < 2; ++c) acc[a][c] = zero16();
    float dummy = 0.f;
    gemm8x<4, 2, 2, 4, false>(acc, [&](int row) { return Wb + (size_t)row * DE; }, [&](int row) { return Hb + (size_t)row * DE; }, DE, smem, dummy,
                              pre, hasNext, [&](int row) { return WbN + (size_t)row * DE; }, [&](int row) { return HbN + (size_t)row * DE; });
    pre = hasNext;
    char* tile = smem + EPI_OFF;
    bf16_t* yb = p.Y + (size_t)be * CAP * DM + nt * 256;
    stage_half<4, 2, 4, 0>(acc, tile, 528, [](float v) { return v; });
    lds_sync();
    copy_tile(tile, 528, 128, 5, [&](int rl) { return yb + (size_t)((rl >> 5) * 64 + (rl & 31)) * DM; }, 0, 32);
    lds_sync();
    stage_half<4, 2, 4, 1>(acc, tile, 528, [](float v) { return v; });
    lds_sync();
    copy_tile(tile, 528, 128, 5, [&](int rl) { return yb + (size_t)((rl >> 5) * 64 + 32 + (rl & 31)) * DM; }, 0, 32);
  }
}

DI void phase11(const Params& p) {
  const int t_ = tid_(); const int lane = t_ & 63, w = t_ >> 6;
  const int gw = blockIdx.x * NWV + w, nw = gridDim.x * NWV;
  for (int R = gw; R < NT; R += nw) {
    const int b = R >> 11, tq = R & 2047;
    const int myslot = (lane < NE) ? p.inv[((size_t)(b * NE + lane)) * SEQ + tq] : -1;
    unsigned long long mask = __ballot(myslot >= 0);
    if (mask == 0ull) continue;
    float4 a[4];
#pragma unroll
    for (int i = 0; i < 4; ++i) a[i] = make_float4(0.f, 0.f, 0.f, 0.f);
    while (mask) {
      const int e = __ffsll((long long)mask) - 1; mask &= mask - 1ull;
      const int slot = __shfl(myslot, e);
      const float g = p.gate[(b * NE + e) * CAP + slot];
      const bf16_t* y = p.Y + ((size_t)(b * NE + e) * CAP + slot) * DM + lane * 4;
#pragma unroll
      for (int i = 0; i < 4; ++i) {
        const uint2 u = *(const uint2*)(y + 256 * i);
        a[i].x += g * bf_lo(u.x); a[i].y += g * bf_hi(u.x); a[i].z += g * bf_lo(u.y); a[i].w += g * bf_hi(u.y);
      }
    }
    const float* g2 = p.mod + b * 6144 + 5120;
    float* o = p.out + (size_t)R * DM;
#pragma unroll
    for (int i = 0; i < 4; ++i) {
      const int d = lane * 4 + 256 * i;
      const float4 gv = *(const float4*)(g2 + d);
      float4 xv = *(float4*)(o + d);
      xv.x += gv.x * a[i].x; xv.y += gv.y * a[i].y; xv.z += gv.z * a[i].z; xv.w += gv.w * a[i].w;
      *(float4*)(o + d) = xv;
    }
  }
}

__global__ void __launch_bounds__(NTH, 2) mega_kernel(Params p) {
  cg::grid_group grid = cg::this_grid();
  __shared__ __attribute__((aligned(16))) char smem[SMEM_BYTES];
#ifndef REPMASK
#define REPMASK 0
#endif
#define RUNPH(k, call) for (int rep_ = 0; rep_ < (((REPMASK) >> (k)) & 1) + 1; ++rep_) { call; grid.sync(); }
  RUNPH(0, phase0(p, smem))
  RUNPH(1, phase1(p))
  RUNPH(2, phase2(p, smem))
  RUNPH(3, phase3(p, smem))
  RUNPH(4, phase4(p, smem))
  RUNPH(5, phase5(p, smem))
  RUNPH(6, phase6(p, smem))
  RUNPH(7, phase7(p, smem))
  RUNPH(8, phase8(p))
  RUNPH(9, phase9(p, smem))
  RUNPH(10, phase10(p, smem))
  phase11(p);
}

static inline size_t align_up(size_t v, size_t a) { return (v + a - 1) / a * a; }

extern "C" void kernel_launch(void* const* d_in, const int* in_sizes, int n_in,
                              void* d_out, int out_size, void* d_ws, size_t ws_size,
                              hipStream_t stream) {
  static int grid_blocks = 0;
  if (!grid_blocks) {
    int dev = 0, cus = 0, per_cu = 0;
    (void)hipGetDevice(&dev);
    (void)hipDeviceGetAttribute(&cus, hipDeviceAttributeMultiprocessorCount, dev);
    (void)hipOccupancyMaxActiveBlocksPerMultiprocessor(&per_cu, mega_kernel, NTH, 0);
    if (per_cu > 1) per_cu = 1;
    if (per_cu < 1) per_cu = 1;
    grid_blocks = (cus * per_cu) & ~7;
    if (grid_blocks < 8) grid_blocks = 8;
  }
  Params p;
  memset(&p, 0, sizeof(p));
  p.x = (const float*)d_in[0]; p.c = (const float*)d_in[1]; p.ctx = (const float*)d_in[2]; p.c_ctx = (const float*)d_in[3];
  p.w_mod = (const float*)d_in[4]; p.b_mod = (const float*)d_in[5]; p.norm1_g = (const float*)d_in[6];
  const float* w_in = (const float*)d_in[7];
  const float* q_a_g = (const float*)d_in[8];
  const float* kv_a_g = (const float*)d_in[9];
  const float* w_q_up = (const float*)d_in[10];
  const float* w_kv_up = (const float*)d_in[11];
  p.q_norm_g = (const float*)d_in[12]; p.k_norm_g = (const float*)d_in[13];
  const float* w_o_attn = (const float*)d_in[14];
  const float* w_fourier = (const float*)d_in[15];
  const float* w_out = (const float*)d_in[16];
  p.norm2_g = (const float*)d_in[17]; p.w_router = (const float*)d_in[18];
  const float* w_e_gate = (const float*)d_in[19];
  const float* w_e_up = (const float*)d_in[20];
  const float* w_e_down = (const float*)d_in[21];
  p.out = (float*)d_out;

  char* base = (char*)d_ws; size_t off = 0;
  auto alloc = [&](size_t bytes) { char* q = base + off; off = align_up(off + bytes, 256); return q; };
  p.WinT = (bf16_t*)alloc((size_t)NINP * DM * 2);
  p.WqT = (bf16_t*)alloc((size_t)768 * QL * 2);
  p.WkvT = (bf16_t*)alloc((size_t)1024 * KVL * 2);
  p.WoT = (bf16_t*)alloc((size_t)DM * 512 * 2);
  p.WfT = (bf16_t*)alloc((size_t)DM * 512 * 2);
  p.WoutT = (bf16_t*)alloc((size_t)DM * DM * 2);
  p.WguT = (bf16_t*)alloc((size_t)NE * 1024 * DM * 2);
  p.WdT = (bf16_t*)alloc((size_t)NE * DM * DE * 2);
  p.chanT = (bf16_t*)alloc((size_t)256 * 128 * 2);
  p.posM = (bf16_t*)alloc((size_t)2 * 1152 * 2048 * 2);
  p.ropeTab = (float*)alloc(64 * 8 * 2 * 4);
  p.mod = (float*)alloc(33 * 6144 * 4);
  p.aff = (float*)alloc((size_t)NB * NE * SEQ * 4);
  p.gate = (float*)alloc((size_t)NB * NE * CAP * 4);
  p.idx = (int*)alloc((size_t)NB * NE * CAP * 4);
  p.inv = (int*)alloc((size_t)NB * NE * SEQ * 4);
  p.pckv = (bf16_t*)alloc((size_t)NC * LDCKV * 2 + 4096);
  char* regA = alloc((size_t)(NT + NC) * DM * 2);
  p.h = (bf16_t*)regA; p.ABt = (bf16_t*)regA; p.h2 = (bf16_t*)regA;
  char* regB1 = alloc((size_t)NT * LDQKV * 2);
  p.pqkv = (bf16_t*)regB1; p.attn_o = (bf16_t*)regB1;
  char* regB2 = alloc((size_t)NT * 512 * 2);
  p.pf = (bf16_t*)regB2; p.four_o = (bf16_t*)regB2;
  p.pg = (bf16_t*)alloc((size_t)NT * 2048 * 2);
  p.Y = p.pg;
  const size_t szQ = (size_t)NB * NH * SEQ * QKD * 2, szK = (size_t)NB * NH * NKEY * QKD * 2, szV = (size_t)NB * NH * VD * NKEY * 2;
  char* regC = alloc(szQ + szK + szV + 1024);
  p.Q = (bf16_t*)regC; p.K = (bf16_t*)(regC + align_up(szQ, 256)); p.Vt = (bf16_t*)(regC + align_up(szQ, 256) + align_up(szK, 256));
  p.m = (bf16_t*)regC; p.hmid = (bf16_t*)(regC + (size_t)NT * DM * 2);
  if (off > ws_size) { fprintf(stderr, "workspace too small: need %zu have %zu\n", off, ws_size); return; }

  int ts = 0;
  auto job = [&](int i, const float* src, bf16_t* dst, const float* scale, int K, int ldS, int n_off, int n_cnt, int dst_row0, int mode, int batch, long sbs, long dbs) {
    TJob& j = p.jobs[i];
    j.src = src; j.dst = dst; j.scale = scale; j.K = K; j.ldS = ldS; j.n_off = n_off; j.n_cnt = n_cnt; j.dst_row0 = dst_row0; j.mode = mode; j.batch = batch;
    j.tiles_n = (n_cnt + 63) / 64; j.tile_start = ts; j.src_bstride = sbs; j.dst_bstride = dbs;
    ts += batch * (K / 64) * j.tiles_n;
  };
  job(0, w_e_gate, p.WguT, nullptr, DM, DE, 0, DE, 0, 1, NE, (long)DM * DE, (long)1024 * DM);
  job(1, w_e_up, p.WguT, nullptr, DM, DE, 0, DE, 0, 2, NE, (long)DM * DE, (long)1024 * DM);
  job(2, w_e_down, p.WdT, nullptr, DE, DM, 0, DM, 0, 0, NE, (long)DE * DM, (long)DM * DE);
  job(3, w_in, p.WinT, nullptr, DM, N_IN, 0, 672, 0, 0, 1, 0, 0);
  job(4, w_in, p.WinT, nullptr, DM, N_IN, 672, 2560, 768, 0, 1, 0, 0);
  job(5, w_q_up, p.WqT, q_a_g, QL, 768, 0, 768, 0, 0, 1, 0, 0);
  job(6, w_kv_up, p.WkvT, kv_a_g, KVL, 1024, 0, 1024, 0, 0, 1, 0, 0);
  job(7, w_o_attn, p.WoT, nullptr, 512, DM, 0, DM, 0, 0, 1, 0, 0);
  job(8, w_fourier, p.WfT, nullptr, 512, DM, 0, DM, 0, 0, 1, 0, 0);
  job(9, w_out, p.WoutT, nullptr, DM, DM, 0, DM, 0, 0, 1, 0, 0);
  p.n_ttiles = ts;

  void* args[] = {&p};
  hipError_t e = hipLaunchCooperativeKernel((void*)mega_kernel, dim3(grid_blocks), dim3(NTH), args, 0, stream);
  if (e != hipSuccess) fprintf(stderr, "cooperative launch failed: %s (grid %d)\n", hipGetErrorString(e), grid_blocks);
}
```

```cpp
#include <hip/hip_runtime.h>
#include <hip/hip_cooperative_groups.h>
#include <cstdio>
#include <cstring>
#include <cstdint>
namespace cg = cooperative_groups;

#define DI __device__ __forceinline__
typedef unsigned short bf16_t;
typedef short bf16x8 __attribute__((ext_vector_type(8)));
typedef float f32x16 __attribute__((ext_vector_type(16)));
#define MFMA(a, b, c) __builtin_amdgcn_mfma_f32_32x32x16_bf16((a), (b), (c), 0, 0, 0)

constexpr int NB = 32, SEQ = 2048, DM = 1024, NT = NB * SEQ, CTXL = 256, NC = NB * CTXL;
constexpr int NH = 8, QKD = 96, VD = 64, QL = 384, KVL = 256, NKEY = SEQ + CTXL;
constexpr int N_IN = 3232, NINP = 3328;
constexpr int NE = 16, DE = 512, CAP = 256;
constexpr float EPS = 1e-6f;
constexpr int LDQKV = 672, LDCKV = 288;
constexpr int NTH = 512, NWV = 8;
constexpr int SMEM_BYTES = 147456;

struct TJob {
  const float* src; bf16_t* dst; const float* scale;
  int K, ldS, n_off, n_cnt, dst_row0, mode, batch, tiles_n, tile_start, pad0;
  long src_bstride, dst_bstride;
};
constexpr int NJOBS = 10;

struct Params {
  const float *x, *c, *ctx, *c_ctx, *w_mod, *b_mod, *norm1_g, *q_norm_g, *k_norm_g, *norm2_g, *w_router;
  float* out;
  bf16_t *WinT, *WqT, *WkvT, *WoT, *WfT, *WoutT, *WguT, *WdT, *chanT, *posM;
  float *ropeTab, *mod;
  bf16_t *h, *pqkv, *pckv, *pf, *pg, *Q, *K, *Vt, *attn_o, *ABt, *four_o, *m, *h2, *hmid;
  float *aff, *gate;
  int* idx;
  int* inv;
  bf16_t* Y;
  TJob jobs[NJOBS];
  int n_ttiles, pad1;
};

typedef float f32x2v __attribute__((ext_vector_type(2)));
typedef __bf16 bf16x2v __attribute__((ext_vector_type(2)));
DI unsigned pk_bf16(float lo, float hi) { f32x2v v = {lo, hi}; bf16x2v b = __builtin_convertvector(v, bf16x2v); return __builtin_bit_cast(unsigned, b); }
DI int tid_() { int t = threadIdx.x; asm volatile("" : "+v"(t)); return t; }
DI float bf_lo(unsigned u) { return __uint_as_float(u << 16); }
DI float bf_hi(unsigned u) { return __uint_as_float(u & 0xffff0000u); }
DI bf16_t f2bf(float f) { return (bf16_t)(pk_bf16(f, 0.f) & 0xffffu); }
DI float sigmoidf_(float x) { return 1.f / (1.f + __expf(-x)); }
DI int crow(int i, int hh) { return (i & 3) + 8 * (i >> 2) + 4 * hh; }
DI float wave_sum(float v) {
#pragma unroll
  for (int o = 32; o >= 1; o >>= 1) v += __shfl_xor(v, o);
  return v;
}
DI f32x16 zero16() { f32x16 z;
#pragma unroll
  for (int i = 0; i < 16; ++i) z[i] = 0.f; return z; }
DI void wait_vm0() { asm volatile("s_waitcnt vmcnt(0)" ::: "memory"); }
DI void wait_lgkm0() { asm volatile("s_waitcnt lgkmcnt(0)" ::: "memory"); }
DI void bar_() { __builtin_amdgcn_s_barrier(); }
DI void lds_sync() { wait_lgkm0(); bar_(); }
#define GLDS(gp, lp) __builtin_amdgcn_global_load_lds((const unsigned*)(gp), (__attribute__((address_space(3))) unsigned*)(lp), 16, 0, 0)
#define SB_ __builtin_amdgcn_sched_barrier(0)

constexpr int EPI_OFF = 65536;
template <int TM, int TN, int WM, int WN, bool SUMSQ, class AF, class BF, class AFN, class BFN>
DI void gemm8x(f32x16 (&acc)[TM][TN], AF arow, BF brow, int K, char* smem, float& sumsq, bool pre, bool hasNext, AFN arowN, BFN browN) {
  constexpr int RA = 32 * TM * WM, RB = 32 * TN * WN;
  constexpr int LDR = 128, STAGE = (RA + RB) * LDR;
  static_assert(WM * WN == NWV, "waves");
  static_assert(2 * STAGE <= SMEM_BYTES, "smem");
  static_assert(RA <= 256 && RB <= 256 && RA % 32 == 0 && RB % 32 == 0, "shape");
  const int t = tid_(), lane = t & 63, w = t >> 6, r = lane & 31, hh = lane >> 5;
  const int wm = w % WM, wn = w / WM;
  const int row0 = t >> 3;
  const int c = (t & 7) ^ ((row0 >> 1) & 7);
  const bool a0v = row0 < RA, a1v = row0 + 64 < RA, a2v = row0 + 128 < RA, a3v = row0 + 192 < RA;
  const bool b0v = row0 < RB, b1v = row0 + 64 < RB, b2v = row0 + 128 < RB, b3v = row0 + 192 < RB;
  const bf16_t* pa0 = arow(a0v ? row0 : 0) + c * 8;
  const bf16_t* pa1 = arow(a1v ? row0 + 64 : 0) + c * 8;
  const bf16_t* pa2 = arow(a2v ? row0 + 128 : 0) + c * 8;
  const bf16_t* pa3 = arow(a3v ? row0 + 192 : 0) + c * 8;
  const bf16_t* pb0 = brow(b0v ? row0 : 0) + c * 8;
  const bf16_t* pb1 = brow(b1v ? row0 + 64 : 0) + c * 8;
  const bf16_t* pb2 = brow(b2v ? row0 + 128 : 0) + c * 8;
  const bf16_t* pb3 = brow(b3v ? row0 + 192 : 0) + c * 8;
  if (!pre) {
    char* l_ = smem + t * 16; char* m_ = l_ + RA * LDR;
    if (a0v) GLDS(pa0, l_); if (a1v) GLDS(pa1, l_ + 8192); if (a2v) GLDS(pa2, l_ + 16384); if (a3v) GLDS(pa3, l_ + 24576);
    if (b0v) GLDS(pb0, m_); if (b1v) GLDS(pb1, m_ + 8192); if (b2v) GLDS(pb2, m_ + 16384); if (b3v) GLDS(pb3, m_ + 24576);
  }
  wait_vm0(); bar_();
  const int nk = K >> 6;
  const int sw = (r >> 1) & 7;
  const int aoff = (wm * TM * 32 + r) * LDR, boff = RA * LDR + (wn * TN * 32 + r) * LDR;
  auto compute = [&](const char* cur, char* nxt, bool issue, const bf16_t* q0, const bf16_t* q1, const bf16_t* q2, const bf16_t* q3,
                     const bf16_t* s0, const bf16_t* s1, const bf16_t* s2, const bf16_t* s3) {
    const char* As = cur + aoff;
    const char* Bs = cur + boff;
    char* l_ = nxt + t * 16; char* m_ = l_ + RA * LDR;
    bf16x8 a0[TM], b0[TN], a1[TM], b1[TN];
#define LOADF(A_, B_, ks) do { const int po_ = (((ks) * 2 + hh) ^ sw) * 16; \
      _Pragma("unroll") for (int tm = 0; tm < TM; ++tm) A_[tm] = *(const bf16x8*)(As + tm * 32 * LDR + po_); \
      _Pragma("unroll") for (int tn = 0; tn < TN; ++tn) B_[tn] = *(const bf16x8*)(Bs + tn * 32 * LDR + po_); } while (0)
#define MMF(A_, B_) do { if (SUMSQ) { uint4 u = __builtin_bit_cast(uint4, B_[0]); \
        float e0 = bf_lo(u.x), e1 = bf_hi(u.x), e2 = bf_lo(u.y), e3 = bf_hi(u.y), e4 = bf_lo(u.z), e5 = bf_hi(u.z), e6 = bf_lo(u.w), e7 = bf_hi(u.w); \
        sumsq += e0 * e0 + e1 * e1 + e2 * e2 + e3 * e3 + e4 * e4 + e5 * e5 + e6 * e6 + e7 * e7; } \
      _Pragma("unroll") for (int tm = 0; tm < TM; ++tm) _Pragma("unroll") for (int tn = 0; tn < TN; ++tn) acc[tm][tn] = MFMA(A_[tm], B_[tn], acc[tm][tn]); } while (0)
    LOADF(a0, b0, 0);
    LOADF(a1, b1, 1);
    SB_;
    if (issue) { if (a0v) GLDS(q0, l_); if (a1v) GLDS(q1, l_ + 8192); }
    SB_;
    __builtin_amdgcn_s_setprio(1);
    MMF(a0, b0);
    LOADF(a0, b0, 2);
    SB_;
    if (issue) { if (a2v) GLDS(q2, l_ + 16384); if (a3v) GLDS(q3, l_ + 24576); }
    SB_;
    MMF(a1, b1);
    LOADF(a1, b1, 3);
    SB_;
    if (issue) { if (b0v) GLDS(s0, m_); if (b1v) GLDS(s1, m_ + 8192); }
    SB_;
    MMF(a0, b0);
    SB_;
    if (issue) { if (b2v) GLDS(s2, m_ + 16384); if (b3v) GLDS(s3, m_ + 24576); }
    SB_;
    MMF(a1, b1);
    __builtin_amdgcn_s_setprio(0);
  };
  for (int kt = 0; kt < nk - 1; ++kt) {
    SB_;
    const int ko = (kt + 1) * 64;
    compute(smem + (kt & 1) * STAGE, smem + ((kt + 1) & 1) * STAGE, true, pa0 + ko, pa1 + ko, pa2 + ko, pa3 + ko, pb0 + ko, pb1 + ko, pb2 + ko, pb3 + ko);
    SB_;
    wait_vm0(); bar_();
  }
  {
    const bf16_t *q0 = pa0, *q1 = pa0, *q2 = pa0, *q3 = pa0, *s0 = pa0, *s1 = pa0, *s2 = pa0, *s3 = pa0;
    if (hasNext) {
      q0 = arowN(a0v ? row0 : 0) + c * 8; q1 = arowN(a1v ? row0 + 64 : 0) + c * 8; q2 = arowN(a2v ? row0 + 128 : 0) + c * 8; q3 = arowN(a3v ? row0 + 192 : 0) + c * 8;
      s0 = browN(b0v ? row0 : 0) + c * 8; s1 = browN(b1v ? row0 + 64 : 0) + c * 8; s2 = browN(b2v ? row0 + 128 : 0) + c * 8; s3 = browN(b3v ? row0 + 192 : 0) + c * 8;
    }
    SB_;
    compute(smem + ((nk - 1) & 1) * STAGE, smem, hasNext, q0, q1, q2, q3, s0, s1, s2, s3);
    SB_;
    lds_sync();
  }
}
template <int TM, int TN, int WM, int WN, bool SUMSQ, class AF, class BF>
DI void gemm8(f32x16 (&acc)[TM][TN], AF arow, BF brow, int K, char* smem, float& sumsq) {
  gemm8x<TM, TN, WM, WN, SUMSQ>(acc, arow, brow, K, smem, sumsq, false, false, arow, brow);
}
template <int TM, int WM, int WN, int TNSEL, class F>
DI void stage_half(const f32x16 (&acc)[TM][2], char* tile, int pitch, F f) {
  const int t = tid_(), lane = t & 63, w = t >> 6, r = lane & 31, hh = lane >> 5;
  const int wm = w % WM, wn = w / WM;
#pragma unroll
  for (int tm = 0; tm < TM; ++tm) {
    char* d = tile + (wn * 32 + r) * pitch + (wm * TM * 32 + tm * 32 + 4 * hh) * 2;
#pragma unroll
    for (int q = 0; q < 4; ++q) {
      const f32x16& a = acc[tm][TNSEL];
      uint2 o; o.x = pk_bf16(f(a[4 * q]), f(a[4 * q + 1])); o.y = pk_bf16(f(a[4 * q + 2]), f(a[4 * q + 3]));
      *(uint2*)(d + 16 * q) = o;
    }
  }
}

template <int TM, int TN, int WM, int WN, class F>
DI void stage_tile(const f32x16 (&acc)[TM][TN], char* tile, int pitch, F f) {
  const int t = tid_(), lane = t & 63, w = t >> 6, r = lane & 31, hh = lane >> 5;
  const int wm = w % WM, wn = w / WM;
#pragma unroll
  for (int tm = 0; tm < TM; ++tm)
#pragma unroll
    for (int tn = 0; tn < TN; ++tn) {
      char* d = tile + (wn * TN * 32 + tn * 32 + r) * pitch + (wm * TM * 32 + tm * 32 + 4 * hh) * 2;
#pragma unroll
      for (int q = 0; q < 4; ++q) {
        uint2 o; o.x = pk_bf16(f(acc[tm][tn][4 * q]), f(acc[tm][tn][4 * q + 1])); o.y = pk_bf16(f(acc[tm][tn][4 * q + 2]), f(acc[tm][tn][4 * q + 3]));
        *(uint2*)(d + 16 * q) = o;
      }
    }
}
template <class RF>
DI void copy_tile(const char* tile, int pitch, int rows, int lch, RF dst, int ch0, int ch1) {
  const int t = tid_();
  const int total = rows << lch;
  for (int id = t; id < total; id += NTH) {
    const int row = id >> lch, ch = id & ((1 << lch) - 1);
    if (ch >= ch0 && ch < ch1) *(uint4*)(dst(row) + ch * 8) = *(const uint4*)(tile + row * pitch + ch * 16);
  }
}

DI void transpose_tile(const TJob& j, int tile, char* smem) {
  const int t = tid_();
  const int tpb = (j.K >> 6) * j.tiles_n;
  const int bi = tile / tpb, rem = tile % tpb;
  const int kt = rem / j.tiles_n, ntile = rem % j.tiles_n;
  const int k0 = kt * 64, n0 = ntile * 64;
  const float* src = j.src + (size_t)bi * j.src_bstride;
  bf16_t* dst = j.dst + (size_t)bi * j.dst_bstride;
  bf16_t* T = (bf16_t*)smem;
  const int nn = t & 63, kq = t >> 6;
  const bool nvalid = (n0 + nn) < j.n_cnt;
  __syncthreads();
#pragma unroll 4
  for (int i = 0; i < 8; ++i) {
    const int kk = kq + 8 * i;
    float v = 0.f;
    if (nvalid) {
      v = src[(size_t)(k0 + kk) * j.ldS + j.n_off + n0 + nn];
      if (j.scale) v *= j.scale[k0 + kk];
    }
    T[nn * 66 + kk] = f2bf(v);
  }
  __syncthreads();
  const int n = t >> 3, part = t & 7;
  if (n0 + n < j.n_cnt) {
    const unsigned* tp = (const unsigned*)(T + n * 66 + part * 8);
    uint4 o0; o0.x = tp[0]; o0.y = tp[1]; o0.z = tp[2]; o0.w = tp[3];
    const int f = n0 + n;
    int drow;
    if (j.mode == 0) drow = j.dst_row0 + f;
    else drow = (f >> 7) * 256 + ((f >> 6) & 1) * 128 + (((f >> 5) & 1) * 2 + (j.mode == 2 ? 1 : 0)) * 32 + (f & 31);
    *(uint4*)(dst + (size_t)drow * j.K + k0 + part * 8) = o0;
  }
}

DI void mod_item(const Params& p, int it, char* smem) {
  const int t = tid_(), cgi = t & 15, kg = t >> 4;
  const int j0 = it * 16;
  float* Ssm = (float*)smem;
  float* red = (float*)(smem + 33 * 128 * 4);
  float acc[33];
#pragma unroll
  for (int r = 0; r < 33; ++r) acc[r] = 0.f;
#pragma unroll 1
  for (int kc = 0; kc < 8; ++kc) {
    __syncthreads();
    for (int idx = t; idx < 33 * 128; idx += NTH) {
      const int r = idx >> 7, kk = idx & 127;
      float v = (r < 32) ? p.c[r * DM + kc * 128 + kk] : p.c_ctx[kc * 128 + kk];
      Ssm[idx] = v * sigmoidf_(v);
    }
    __syncthreads();
    const int k = kc * 128 + kg * 4;
    const float w0 = p.w_mod[(size_t)(k + 0) * 6144 + j0 + cgi];
    const float w1 = p.w_mod[(size_t)(k + 1) * 6144 + j0 + cgi];
    const float w2 = p.w_mod[(size_t)(k + 2) * 6144 + j0 + cgi];
    const float w3 = p.w_mod[(size_t)(k + 3) * 6144 + j0 + cgi];
#pragma unroll
    for (int r = 0; r < 33; ++r) {
      const float4 s = *(const float4*)(Ssm + r * 128 + kg * 4);
      acc[r] += s.x * w0 + s.y * w1 + s.z * w2 + s.w * w3;
    }
  }
  __syncthreads();
#pragma unroll
  for (int r = 0; r < 33; ++r) red[(kg * 33 + r) * 16 + cgi] = acc[r];
  __syncthreads();
  for (int idx = t; idx < 33 * 16; idx += NTH) {
    const int r = idx >> 4, cc = idx & 15;
    float s = 0.f;
#pragma unroll
    for (int g = 0; g < 32; ++g) s += red[(g * 33 + r) * 16 + cc];
    p.mod[r * 6144 + j0 + cc] = s + p.b_mod[j0 + cc];
  }
}

DI void phase0(const Params& p, char* smem) {
  const int t = tid_();
  const int nMod = 384;
  const int nPos = 288;
  const int nMisc = 3;
  const int nT = p.n_ttiles;
  const int total = nMod + nT + nPos + nMisc;
  float* ctab = (float*)(smem + 98304);
  for (int j = t; j < 2048; j += NTH) ctab[j] = cospif((float)j * (1.f / 1024.f));
  __syncthreads();
  for (int it = blockIdx.x; it < total; it += gridDim.x) {
    if (it < nMod) { mod_item(p, it, smem); continue; }
    int u = it - nMod;
    if (u < nT) {
      int jb = 0;
#pragma unroll 1
      for (int q = 1; q < NJOBS; ++q) if (u >= p.jobs[q].tile_start) jb = q;
      transpose_tile(p.jobs[jb], u - p.jobs[jb].tile_start, smem);
      continue;
    }
    u -= nT;
    if (u < nPos) {
      for (int e = t; e < 8 * 256; e += NTH) {
        const int R = u * 8 + (e >> 8), c8 = (e & 255) * 8;
        const int part = R >= 1152 ? 1 : 0, k = R - part * 1152;
        float v[8];
#pragma unroll
        for (int q = 0; q < 8; ++q) {
          const int tt = c8 + q;
          v[q] = (k > 1024) ? 0.f : (part ? ctab[(k * tt - 512) & 2047] : ctab[(k * tt) & 2047]);
        }
        uint4 o; o.x = pk_bf16(v[0], v[1]); o.y = pk_bf16(v[2], v[3]); o.z = pk_bf16(v[4], v[5]); o.w = pk_bf16(v[6], v[7]);
        *(uint4*)(p.posM + (size_t)R * 2048 + c8) = o;
      }
      continue;
    }
    u -= nPos;
    if (u == 0) {
      for (int e = t; e < 256 * 128; e += NTH) {
        const int m2 = e >> 7, cc = e & 127, mm = m2 & 127;
        float v = (m2 < 128) ? ctab[(mm * cc * 16) & 2047] : ctab[(mm * cc * 16 - 512) & 2047];
        p.chanT[e] = f2bf(v);
      }
    } else if (u == 1) {
      for (int e = t; e < 64 * 8; e += NTH) {
        const int pos = e >> 3, jf = e & 7;
        const float inv = 1.0f / powf(10000.0f, (float)jf / 8.0f);
        const float ang = (float)pos * inv;
        p.ropeTab[e * 2 + 0] = cosf(ang);
        p.ropeTab[e * 2 + 1] = sinf(ang);
      }
    } else {
      uint4 z; z.x = z.y = z.z = z.w = 0u;
      uint4* dp = (uint4*)(p.WinT + (size_t)672 * DM);
      for (int e = t; e < 96 * DM / 8; e += NTH) dp[e] = z;
    }
  }
}

DI void phase1(const Params& p) {
  const int t_ = tid_(); const int lane = t_ & 63, w = t_ >> 6;
  const int gw = blockIdx.x * NWV + w, nw = gridDim.x * NWV;
  for (int R0 = gw; R0 < NT + NC; R0 += 2 * nw) {
    const int R1 = R0 + nw; const bool has1 = R1 < NT + NC;
    const float* src0 = (R0 < NT) ? p.x + (size_t)R0 * DM : p.ctx + (size_t)(R0 - NT) * DM;
    const float* src1 = has1 ? ((R1 < NT) ? p.x + (size_t)R1 * DM : p.ctx + (size_t)(R1 - NT) * DM) : src0;
    const float* md0 = p.mod + ((R0 < NT) ? (R0 >> 11) : 32) * 6144;
    const float* md1 = p.mod + ((has1 && R1 < NT) ? (R1 >> 11) : 32) * 6144;
    float4 v0[4], v1[4]; float s0 = 0.f, s1 = 0.f;
#pragma unroll
    for (int i = 0; i < 4; ++i) { v0[i] = *(const float4*)(src0 + lane * 4 + 256 * i); v1[i] = *(const float4*)(src1 + lane * 4 + 256 * i); }
#pragma unroll
    for (int i = 0; i < 4; ++i) { s0 += v0[i].x * v0[i].x + v0[i].y * v0[i].y + v0[i].z * v0[i].z + v0[i].w * v0[i].w; s1 += v1[i].x * v1[i].x + v1[i].y * v1[i].y + v1[i].z * v1[i].z + v1[i].w * v1[i].w; }
    s0 = wave_sum(s0); s1 = wave_sum(s1);
    const float r0 = rsqrtf(s0 * (1.f / DM) + EPS), r1 = rsqrtf(s1 * (1.f / DM) + EPS);
#pragma unroll
    for (int i = 0; i < 4; ++i) {
      const int d = lane * 4 + 256 * i;
      const float4 g = *(const float4*)(p.norm1_g + d);
      {
        const float4 sh = *(const float4*)(md0 + d), sc = *(const float4*)(md0 + 1024 + d);
        uint2 o; o.x = pk_bf16(v0[i].x * r0 * g.x * (1.f + sc.x) + sh.x, v0[i].y * r0 * g.y * (1.f + sc.y) + sh.y);
        o.y = pk_bf16(v0[i].z * r0 * g.z * (1.f + sc.z) + sh.z, v0[i].w * r0 * g.w * (1.f + sc.w) + sh.w);
        *(uint2*)(p.h + (size_t)R0 * DM + d) = o;
      }
      if (has1) {
        const float4 sh = *(const float4*)(md1 + d), sc = *(const float4*)(md1 + 1024 + d);
        uint2 o; o.x = pk_bf16(v1[i].x * r1 * g.x * (1.f + sc.x) + sh.x, v1[i].y * r1 * g.y * (1.f + sc.y) + sh.y);
        o.y = pk_bf16(v1[i].z * r1 * g.z * (1.f + sc.z) + sh.z, v1[i].w * r1 * g.w * (1.f + sc.w) + sh.w);
        *(uint2*)(p.h + (size_t)R1 * DM + d) = o;
      }
    }
  }
}

DI void phase2(const Params& p, char* smem) {
  const int xcd = blockIdx.x & 7, jl = blockIdx.x >> 3, nl = gridDim.x >> 3;
  auto decode = [&](int L, int& tokTile, int& ft) {
    if (L < 416) { const int tg = L / 104, rem = L % 104; ft = rem >> 3; tokTile = xcd * 32 + tg * 8 + (rem & 7); }
    else { const int u = L - 416; tokTile = 256 + xcd * 4 + (u >> 1); ft = 1 + (u & 1); }
  };
  bool pre = false;
  for (int L = jl; L < 416 + 8; L += nl) {
    int tokTile, ft, tokTileN = 0, ftN = 0;
    decode(L, tokTile, ft);
    const bool lat = L < 416;
    const int Ln = L + nl; const bool hasNext = Ln < 416 + 8;
    if (hasNext) decode(Ln, tokTileN, ftN);
    f32x16 acc[4][2];
#pragma unroll
    for (int a = 0; a < 4; ++a)
#pragma unroll
      for (int b = 0; b < 2; ++b) acc[a][b] = zero16();
    const bf16_t* Ab = p.WinT + (size_t)ft * 256 * DM;
    const bf16_t* Bb = p.h + (size_t)tokTile * 256 * DM;
    const bf16_t* AbN = p.WinT + (size_t)ftN * 256 * DM;
    const bf16_t* BbN = p.h + (size_t)tokTileN * 256 * DM;
    float dummy = 0.f;
    gemm8x<4, 2, 2, 4, false>(acc, [&](int row) { return Ab + (size_t)row * DM; }, [&](int row) { return Bb + (size_t)row * DM; }, DM, smem, dummy,
                              pre, hasNext, [&](int row) { return AbN + (size_t)row * DM; }, [&](int row) { return BbN + (size_t)row * DM; });
    pre = hasNext;
    char* tile = smem + EPI_OFF;
    bf16_t* base; int ld, c0 = 0, c1 = 32;
    if (lat) {
      const size_t tok0 = (size_t)tokTile * 256;
      if (ft < 3) { base = p.pqkv + tok0 * LDQKV + ft * 256; ld = LDQKV; if (ft == 2) c1 = 20; }
      else if (ft < 5) { base = p.pf + tok0 * 512 + (ft - 3) * 256; ld = 512; }
      else { base = p.pg + tok0 * 2048 + (ft - 5) * 256; ld = 2048; }
    } else {
      const size_t ct0 = (size_t)(tokTile - 256) * 256;
      base = p.pckv + ct0 * LDCKV + ft * 256 - 384; ld = LDCKV;
      if (ft == 1) c0 = 16; else c1 = 20;
    }
    if (ft >= 5) stage_half<4, 2, 4, 0>(acc, tile, 528, [](float v) { return sigmoidf_(v); });
    else stage_half<4, 2, 4, 0>(acc, tile, 528, [](float v) { return v; });
    lds_sync();
    copy_tile(tile, 528, 128, 5, [&](int rl) { return base + (size_t)((rl >> 5) * 64 + (rl & 31)) * ld; }, c0, c1);
    lds_sync();
    if (ft >= 5) stage_half<4, 2, 4, 1>(acc, tile, 528, [](float v) { return sigmoidf_(v); });
    else stage_half<4, 2, 4, 1>(acc, tile, 528, [](float v) { return v; });
    lds_sync();
    copy_tile(tile, 528, 128, 5, [&](int rl) { return base + (size_t)((rl >> 5) * 64 + 32 + (rl & 31)) * ld; }, c0, c1);
  }
}

DI void rope_pair(float& x1, float& x2, const float* tab) { const float c = tab[0], s = tab[1]; const float a = x1 * c - x2 * s, b = x2 * c + x1 * s; x1 = a; x2 = b; }

DI void phase3(const Params& p, char* smem) {
  const int t = tid_(), lane = t & 63, w = t >> 6, r = lane & 31, hh = lane >> 5;
  const int nKV = 288, nQ = 256, nCh = 128;
  const int xcd = blockIdx.x & 7, jl = blockIdx.x >> 3, nl = gridDim.x >> 3;
  for (int it = jl; it < nKV + nQ + nCh; it += nl) {
    if (it < nKV) {
      const int tl_ = it >> 3, hd = it & 7;
      const bool lat = tl_ < 32;
      const bf16_t* Bb; int ldb; const bf16_t* kpeb;
      int b, key0;
      if (lat) { const int tokTile = xcd * 32 + tl_; Bb = p.pqkv + (size_t)tokTile * 256 * LDQKV + QL; ldb = LDQKV; kpeb = p.pqkv + (size_t)tokTile * 256 * LDQKV + 640; b = tokTile >> 3; key0 = (tokTile & 7) * 256; }
      else { const int ct = xcd * 4 + (tl_ - 32); Bb = p.pckv + (size_t)ct * 256 * LDCKV; ldb = LDCKV; kpeb = Bb + 256; b = ct; key0 = SEQ; }
      const bf16_t* Ab = p.WkvT + (size_t)hd * 128 * KVL;
      f32x16 acc[4][1];
#pragma unroll
      for (int a = 0; a < 4; ++a) acc[a][0] = zero16();
      float sumsq = 0.f;
      gemm8<4, 1, 1, 8, true>(acc, [&](int row) { return Ab + (size_t)row * KVL; }, [&](int row) { return Bb + (size_t)row * ldb; }, KVL, smem, sumsq);
      sumsq += __shfl_xor(sumsq, 32);
      const float ra = rsqrtf(sumsq * (1.f / KVL) + EPS);
      const int tl = w * 32 + r;
      const int key = key0 + tl;
      float kp[16];
#pragma unroll
      for (int q = 0; q < 4; ++q) {
        const uint2 u = *(const uint2*)(kpeb + (size_t)tl * ldb + 8 * q + 4 * hh);
        kp[4 * q + 0] = bf_lo(u.x); kp[4 * q + 1] = bf_hi(u.x); kp[4 * q + 2] = bf_lo(u.y); kp[4 * q + 3] = bf_hi(u.y);
      }
      float ss = 0.f;
#pragma unroll
      for (int tm = 0; tm < 4; ++tm)
#pragma unroll
        for (int i = 0; i < 16; ++i) { const float v = acc[tm][0][i] * ra; acc[tm][0][i] = v; if (tm < 2) ss += v * v; }
#pragma unroll
      for (int i = 0; i < 16; ++i) ss += kp[i] * kp[i];
      ss += __shfl_xor(ss, 32);
      const float rk = rsqrtf(ss * (1.f / QKD) + EPS);
#pragma unroll
      for (int i = 0; i < 16; ++i) kp[i] *= rk * p.k_norm_g[64 + crow(i, hh)];
      if (lat) {
        const int pos = key;
        const float* tr = p.ropeTab + ((pos >> 6) * 8 + 4 * hh) * 2;
        const float* tc = p.ropeTab + ((pos & 63) * 8 + 4 * hh) * 2;
#pragma unroll
        for (int i = 0; i < 4; ++i) { rope_pair(kp[i], kp[i + 4], tr + 2 * i); rope_pair(kp[8 + i], kp[12 + i], tc + 2 * i); }
      }
      {
        char* kt_ = smem; char* vt_ = smem + 256 * 208;
        char* kd = kt_ + tl * 208;
#pragma unroll
        for (int tm = 0; tm < 2; ++tm)
#pragma unroll
          for (int q = 0; q < 4; ++q) {
            const int f = tm * 32 + 8 * q + 4 * hh;
            const float4 g = *(const float4*)(p.k_norm_g + f);
            uint2 o; o.x = pk_bf16(acc[tm][0][4 * q] * rk * g.x, acc[tm][0][4 * q + 1] * rk * g.y); o.y = pk_bf16(acc[tm][0][4 * q + 2] * rk * g.z, acc[tm][0][4 * q + 3] * rk * g.w);
            *(uint2*)(kd + f * 2) = o;
          }
#pragma unroll
        for (int q = 0; q < 4; ++q) {
          uint2 o; o.x = pk_bf16(kp[4 * q], kp[4 * q + 1]); o.y = pk_bf16(kp[4 * q + 2], kp[4 * q + 3]);
          *(uint2*)(kd + (64 + 8 * q + 4 * hh) * 2) = o;
        }
#pragma unroll
        for (int tm = 2; tm < 4; ++tm)
#pragma unroll
          for (int i = 0; i < 16; ++i) *(bf16_t*)(vt_ + ((tm - 2) * 32 + crow(i, hh)) * 528 + tl * 2) = f2bf(acc[tm][0][i]);
        lds_sync();
        const int tc_ = tid_();
        bf16_t* Kg = p.K + ((size_t)(b * NH + hd) * NKEY + key0) * QKD;
#pragma unroll
        for (int i = 0; i < 6; ++i) {
          const int id = tc_ + NTH * i, row = id / 12, ch = id % 12;
          *(uint4*)(Kg + row * QKD + ch * 8) = *(const uint4*)(kt_ + row * 208 + ch * 16);
        }
        bf16_t* Vg = p.Vt + (size_t)(b * NH + hd) * VD * NKEY + key0;
#pragma unroll
        for (int i = 0; i < 4; ++i) {
          const int row = (tc_ >> 5) + 16 * i, ch = tc_ & 31;
          *(uint4*)(Vg + (size_t)row * NKEY + ch * 8) = *(const uint4*)(vt_ + row * 528 + ch * 16);
        }
        lds_sync();
      }
    } else if (it < nKV + nQ) {
      const int u = it - nKV;
      const int tokTile = xcd * 32 + (u >> 3), hd = u & 7;
      const bf16_t* Bb = p.pqkv + (size_t)tokTile * 256 * LDQKV;
      const bf16_t* Ab = p.WqT + (size_t)hd * QKD * QL;
      f32x16 acc[3][1];
#pragma unroll
      for (int a = 0; a < 3; ++a) acc[a][0] = zero16();
      float sumsq = 0.f;
      gemm8<3, 1, 1, 8, true>(acc, [&](int row) { return Ab + (size_t)row * QL; }, [&](int row) { return Bb + (size_t)row * LDQKV; }, QL, smem, sumsq);
      sumsq += __shfl_xor(sumsq, 32);
      const float ra = rsqrtf(sumsq * (1.f / QL) + EPS);
      const int tl = w * 32 + r;
      const int b = tokTile >> 3, pos = (tokTile & 7) * 256 + tl;
      float ss = 0.f;
#pragma unroll
      for (int tm = 0; tm < 3; ++tm)
#pragma unroll
        for (int i = 0; i < 16; ++i) { const float v = acc[tm][0][i] * ra; acc[tm][0][i] = v; ss += v * v; }
      ss += __shfl_xor(ss, 32);
      const float rh = rsqrtf(ss * (1.f / QKD) + EPS);
#pragma unroll
      for (int tm = 0; tm < 3; ++tm)
#pragma unroll
        for (int q = 0; q < 4; ++q) {
          const float4 g = *(const float4*)(p.q_norm_g + tm * 32 + 8 * q + 4 * hh);
          acc[tm][0][4 * q] *= rh * g.x; acc[tm][0][4 * q + 1] *= rh * g.y; acc[tm][0][4 * q + 2] *= rh * g.z; acc[tm][0][4 * q + 3] *= rh * g.w;
        }
      {
        const float* tr = p.ropeTab + ((pos >> 6) * 8 + 4 * hh) * 2;
        const float* tc = p.ropeTab + ((pos & 63) * 8 + 4 * hh) * 2;
#pragma unroll
        for (int i = 0; i < 4; ++i) {
          float a0 = acc[2][0][i], a1 = acc[2][0][i + 4], c0 = acc[2][0][8 + i], c1 = acc[2][0][12 + i];
          rope_pair(a0, a1, tr + 2 * i); rope_pair(c0, c1, tc + 2 * i);
          acc[2][0][i] = a0; acc[2][0][i + 4] = a1; acc[2][0][8 + i] = c0; acc[2][0][12 + i] = c1;
        }
      }
      const float qs = 0.10206207261596575f * 1.4426950408889634f;
      {
        char* qd = smem + tl * 208;
#pragma unroll
        for (int tm = 0; tm < 3; ++tm)
#pragma unroll
          for (int q = 0; q < 4; ++q) {
            uint2 o; o.x = pk_bf16(acc[tm][0][4 * q] * qs, acc[tm][0][4 * q + 1] * qs); o.y = pk_bf16(acc[tm][0][4 * q + 2] * qs, acc[tm][0][4 * q + 3] * qs);
            *(uint2*)(qd + (tm * 32 + 8 * q + 4 * hh) * 2) = o;
          }
        lds_sync();
        const int tc_ = tid_();
        bf16_t* Qg = p.Q + ((size_t)(b * NH + hd) * SEQ + (tokTile & 7) * 256) * QKD;
#pragma unroll
        for (int i = 0; i < 6; ++i) {
          const int id = tc_ + NTH * i, row = id / 12, ch = id % 12;
          *(uint4*)(Qg + row * QKD + ch * 8) = *(const uint4*)(smem + row * 208 + ch * 16);
        }
        lds_sync();
      }
    } else {
      const int u = it - nKV - nQ;
      const int tt = u & 7, g = (u >> 3) & 3, b = xcd * 4 + (u >> 5);
      const bf16_t* Tb = p.chanT;
      const bf16_t* Fb = p.pf + (size_t)(b * SEQ + tt * 256) * 512 + g * 128;
      f32x16 acc[4][2];
#pragma unroll
      for (int a = 0; a < 4; ++a)
#pragma unroll
        for (int c = 0; c < 2; ++c) acc[a][c] = zero16();
      float dummy = 0.f;
      gemm8<4, 2, 2, 4, false>(acc, [&](int row) { return Fb + (size_t)row * 512; }, [&](int row) { return Tb + (size_t)row * 128; }, 128, smem, dummy);
      stage_tile<4, 2, 2, 4>(acc, smem, 528, [](float v) { return v; });
      lds_sync();
      bf16_t* dst0 = p.ABt + ((size_t)(b * 512 + g * 128)) * 4096 + tt * 256;
      copy_tile(smem, 528, 256, 5, [&](int row) { return dst0 + (size_t)(row & 127) * 4096 + (row >> 7) * 2048; }, 0, 32);
      lds_sync();
    }
  }
}

DI void attn_item(const Params& p, int it, char* smem) {
  const int t = tid_(), lane = t & 63, w = t >> 6, r = lane & 31, hh = lane >> 5;
  const int qt = it & 7, bh = it >> 3;
  constexpr int KROW = 208, VROW = 136, KBYTES = 64 * KROW, STAGE = KBYTES + 64 * VROW;
  const bf16_t* Kb = p.K + (size_t)bh * NKEY * QKD;
  const bf16_t* Vb = p.Vt + (size_t)bh * VD * NKEY;
  const int qpos = qt * 256 + w * 32 + r;
  const bf16_t* Qp = p.Q + ((size_t)bh * SEQ + qpos) * QKD + hh * 8;
  bf16x8 qf[6];
#pragma unroll
  for (int c = 0; c < 6; ++c) qf[c] = *(const bf16x8*)(Qp + c * 16);
  f32x16 o[2]; o[0] = zero16(); o[1] = zero16();
  float gk = 0.f;
  for (int f = 0; f < QKD; ++f) gk = fmaxf(gk, fabsf(p.k_norm_g[f]));
  float qss = 0.f;
#pragma unroll
  for (int c = 0; c < 6; ++c) {
    const uint4 u = __builtin_bit_cast(uint4, qf[c]);
    const float e0 = bf_lo(u.x), e1 = bf_hi(u.x), e2 = bf_lo(u.y), e3 = bf_hi(u.y), e4 = bf_lo(u.z), e5 = bf_hi(u.z), e6 = bf_lo(u.w), e7 = bf_hi(u.w);
    qss += e0 * e0 + e1 * e1 + e2 * e2 + e3 * e3 + e4 * e4 + e5 * e5 + e6 * e6 + e7 * e7;
  }
  qss += __shfl_xor(qss, 32);
  const float negC = -(sqrtf(qss) * gk * 9.797959f * 1.01f);
  f32x16 sinit;
#pragma unroll
  for (int i = 0; i < 16; ++i) sinit[i] = negC;
  float lrun = 0.f;
  const int kid0 = t, kid1 = (t & 255) + 512;
  const bool k1v = t < 256;
  const int kgo0 = (kid0 / 12) * QKD + (kid0 % 12) * 8, kgo1 = (kid1 / 12) * QKD + (kid1 % 12) * 8;
  const int klo0 = (kid0 / 12) * KROW + (kid0 % 12) * 16, klo1 = (kid1 / 12) * KROW + (kid1 % 12) * 16;
  const int vgo0 = (t >> 3) * NKEY + (t & 7) * 8;
  const int vlo0 = KBYTES + (t >> 3) * VROW + (t & 7) * 16;
  uint4 rk0, rk1, rv0;
  rk0 = *(const uint4*)(Kb + kgo0); rk1 = *(const uint4*)(Kb + kgo1);
  rv0 = *(const uint4*)(Vb + vgo0);
  SB_;
#define ATT_STORE(base) do { \
    *(uint4*)((base) + klo0) = rk0; if (k1v) *(uint4*)((base) + klo1) = rk1; \
    { uint2* d = (uint2*)((base) + vlo0); d[0] = make_uint2(rv0.x, rv0.y); d[1] = make_uint2(rv0.z, rv0.w); } } while (0)
  ATT_STORE(smem);
  __syncthreads();
  constexpr int NKT = NKEY / 64;
  for (int kt = 0; kt < NKT; ++kt) {
    const char* cur = smem + (kt & 1) * STAGE;
    const bool more = kt + 1 < NKT;
    if (more) {
      const bf16_t* kn = Kb + (size_t)(kt + 1) * 64 * QKD; const bf16_t* vn = Vb + (kt + 1) * 64;
      rk0 = *(const uint4*)(kn + kgo0); rk1 = *(const uint4*)(kn + kgo1);
      rv0 = *(const uint4*)(vn + vgo0);
    }
    SB_;
    f32x16 s[2];
#pragma unroll
    for (int t2 = 0; t2 < 2; ++t2) {
      const char* kp = cur + (t2 * 32 + r) * KROW + hh * 16;
      { const bf16x8 kf = *(const bf16x8*)(kp); s[t2] = MFMA(kf, qf[0], sinit); }
#pragma unroll
      for (int c = 1; c < 6; ++c) { const bf16x8 kf = *(const bf16x8*)(kp + c * 32); s[t2] = MFMA(kf, qf[c], s[t2]); }
    }
    SB_;
    float ls = 0.f;
#pragma unroll
    for (int t2 = 0; t2 < 2; ++t2)
#pragma unroll
      for (int i = 0; i < 16; ++i) { const float e = __builtin_amdgcn_exp2f(s[t2][i]); s[t2][i] = e; ls += e; }
    lrun += ls;
    SB_;
#pragma unroll
    for (int t2 = 0; t2 < 2; ++t2)
#pragma unroll
      for (int s2 = 0; s2 < 2; ++s2) {
        uint4 pu;
        pu.x = pk_bf16(s[t2][8 * s2 + 0], s[t2][8 * s2 + 1]); pu.y = pk_bf16(s[t2][8 * s2 + 2], s[t2][8 * s2 + 3]);
        pu.z = pk_bf16(s[t2][8 * s2 + 4], s[t2][8 * s2 + 5]); pu.w = pk_bf16(s[t2][8 * s2 + 6], s[t2][8 * s2 + 7]);
        const bf16x8 pb = __builtin_bit_cast(bf16x8, pu);
#pragma unroll
        for (int vt = 0; vt < 2; ++vt) {
          const char* vp = cur + KBYTES + (vt * 32 + r) * VROW + (t2 * 32 + 16 * s2 + 4 * hh) * 2;
          const uint2 lo = *(const uint2*)(vp), hi = *(const uint2*)(vp + 16);
          uint4 vu; vu.x = lo.x; vu.y = lo.y; vu.z = hi.x; vu.w = hi.y;
          o[vt] = MFMA(__builtin_bit_cast(bf16x8, vu), pb, o[vt]);
        }
      }
    SB_;
    if (more) { char* nxt = smem + ((kt + 1) & 1) * STAGE; ATT_STORE(nxt); }
    __syncthreads();
  }
  lrun += __shfl_xor(lrun, 32);
  const float inv = 1.f / lrun;
  const int b = bh >> 3, hd = bh & 7;
  bf16_t* od = p.attn_o + (size_t)(b * SEQ + qpos) * 512 + hd * 64;
#pragma unroll
  for (int vt = 0; vt < 2; ++vt)
#pragma unroll
    for (int q = 0; q < 4; ++q) {
      uint2 ou; ou.x = pk_bf16(o[vt][4 * q] * inv, o[vt][4 * q + 1] * inv); ou.y = pk_bf16(o[vt][4 * q + 2] * inv, o[vt][4 * q + 3] * inv);
      *(uint2*)(od + vt * 32 + 8 * q + 4 * hh) = ou;
    }
}

DI void phase4(const Params& p, char* smem) {
  const int t = tid_(), lane = t & 63, w = t >> 6, r = lane & 31, hh = lane >> 5;
  const int nDft = 64, nAlt = 4, nAtt = 256;
  const int xcd = blockIdx.x & 7, jl = blockIdx.x >> 3, nl = gridDim.x >> 3;
  for (int it = jl; it < nDft + nAlt + nAtt; it += nl) {
    if (it < nDft) {
      const int bl = it >> 4, rem = it & 15, ct = rem >> 3, kt = rem & 7, b = xcd * 4 + bl;
      const int wm = w & 3, wn = w >> 2;
      const bf16_t* Ab = p.ABt + (size_t)(b * 512 + ct * 256) * 4096;
      const bf16_t* Cb = p.posM + (size_t)kt * 128 * 2048;
      const bf16_t* Sb = p.posM + (size_t)(1152 + kt * 128) * 2048;
      f32x16 acc1[2][2], acc2[2][2];
#pragma unroll
      for (int a = 0; a < 2; ++a)
#pragma unroll
        for (int c = 0; c < 2; ++c) { acc1[a][c] = zero16(); acc2[a][c] = zero16(); }
      float dummy = 0.f;
      gemm8<2, 2, 4, 2, false>(acc1, [&](int row) { return Ab + (size_t)row * 4096; }, [&](int row) { return Cb + (size_t)row * 2048; }, 2048, smem, dummy);
      gemm8<2, 2, 4, 2, false>(acc2, [&](int row) { return Ab + (size_t)row * 4096 + 2048; }, [&](int row) { return Sb + (size_t)row * 2048; }, 2048, smem, dummy);
      const float sc = 1.f / 512.f;
#pragma unroll
      for (int tm = 0; tm < 2; ++tm)
#pragma unroll
        for (int tn = 0; tn < 2; ++tn) {
          const int kpos = kt * 128 + wn * 64 + tn * 32 + r;
          const int moff = ct * 256 + wm * 64 + tm * 32 + 4 * hh;
          if (kpos <= 1024) {
            bf16_t* d = p.four_o + (size_t)(b * SEQ + kpos) * 512 + moff;
#pragma unroll
            for (int q = 0; q < 4; ++q) {
              uint2 ou; ou.x = pk_bf16((acc1[tm][tn][4 * q] - acc2[tm][tn][4 * q]) * sc, (acc1[tm][tn][4 * q + 1] - acc2[tm][tn][4 * q + 1]) * sc);
              ou.y = pk_bf16((acc1[tm][tn][4 * q + 2] - acc2[tm][tn][4 * q + 2]) * sc, (acc1[tm][tn][4 * q + 3] - acc2[tm][tn][4 * q + 3]) * sc);
              *(uint2*)(d + 8 * q) = ou;
            }
          }
          if (kpos >= 1 && kpos <= 1023) {
            bf16_t* d = p.four_o + (size_t)(b * SEQ + 2048 - kpos) * 512 + moff;
#pragma unroll
            for (int q = 0; q < 4; ++q) {
              uint2 ou; ou.x = pk_bf16((acc1[tm][tn][4 * q] + acc2[tm][tn][4 * q]) * sc, (acc1[tm][tn][4 * q + 1] + acc2[tm][tn][4 * q + 1]) * sc);
              ou.y = pk_bf16((acc1[tm][tn][4 * q + 2] + acc2[tm][tn][4 * q + 2]) * sc, (acc1[tm][tn][4 * q + 3] + acc2[tm][tn][4 * q + 3]) * sc);
              *(uint2*)(d + 8 * q) = ou;
            }
          }
        }
    } else if (it < nDft + nAlt) {
      const int b = xcd * 4 + (it - nDft);
      for (int m = w; m < 512; m += NWV) {
        const bf16_t* rowp = p.ABt + (size_t)(b * 512 + m) * 4096 + lane * 8;
        float sacc = 0.f;
#pragma unroll
        for (int i = 0; i < 4; ++i) {
          const uint4 u = *(const uint4*)(rowp + 512 * i);
          sacc += (bf_lo(u.x) - bf_hi(u.x)) + (bf_lo(u.y) - bf_hi(u.y)) + (bf_lo(u.z) - bf_hi(u.z)) + (bf_lo(u.w) - bf_hi(u.w));
        }
        sacc = wave_sum(sacc);
        if (lane == 0) p.four_o[(size_t)(b * SEQ + 1024) * 512 + m] = f2bf(sacc * (1.f / 512.f));
      }
    } else {
      attn_item(p, xcd * 256 + (it - nDft - nAlt), smem);
    }
  }
}

DI void phase5(const Params& p, char* smem) {
  const int t = tid_();
  const int xcd = blockIdx.x & 7, jl = blockIdx.x >> 3, nl = gridDim.x >> 3;
  for (int L = jl; L < 256; L += nl) {
    const int tokTile = xcd * 64 + (L >> 5) * 8 + (L & 7), nt = (L >> 3) & 3;
    f32x16 acc1[2][2], acc2[2][2];
#pragma unroll
    for (int a = 0; a < 2; ++a)
#pragma unroll
      for (int c = 0; c < 2; ++c) { acc1[a][c] = zero16(); acc2[a][c] = zero16(); }
    float dummy = 0.f;
    {
      const bf16_t* Ab = p.WoT + (size_t)nt * 256 * 512; const bf16_t* Bb = p.attn_o + (size_t)tokTile * 128 * 512;
      gemm8<2, 2, 4, 2, false>(acc1, [&](int row) { return Ab + (size_t)row * 512; }, [&](int row) { return Bb + (size_t)row * 512; }, 512, smem, dummy);
    }
    {
      const bf16_t* Ab = p.WfT + (size_t)nt * 256 * 512; const bf16_t* Bb = p.four_o + (size_t)tokTile * 128 * 512;
      gemm8<2, 2, 4, 2, false>(acc2, [&](int row) { return Ab + (size_t)row * 512; }, [&](int row) { return Bb + (size_t)row * 512; }, 512, smem, dummy);
    }
    {
      char* t1 = smem; char* t2 = smem + 128 * 528;
      stage_tile<2, 2, 4, 2>(acc1, t1, 528, [](float v) { return v; });
      stage_tile<2, 2, 4, 2>(acc2, t2, 528, [](float v) { return v; });
      lds_sync();
      const int ch = t & 31, r0 = t >> 5;
#pragma unroll
      for (int i = 0; i < 8; ++i) {
        const int row = r0 + 16 * i;
        const size_t tok = (size_t)tokTile * 128 + row;
        const uint4 u1 = *(const uint4*)(t1 + row * 528 + ch * 16), u2 = *(const uint4*)(t2 + row * 528 + ch * 16);
        const uint4 ga = *(const uint4*)(p.pg + tok * 2048 + nt * 256 + ch * 8), gb = *(const uint4*)(p.pg + tok * 2048 + 1024 + nt * 256 + ch * 8);
        uint4 o;
        o.x = pk_bf16(bf_lo(ga.x) * bf_lo(u1.x) + bf_lo(gb.x) * bf_lo(u2.x), bf_hi(ga.x) * bf_hi(u1.x) + bf_hi(gb.x) * bf_hi(u2.x));
        o.y = pk_bf16(bf_lo(ga.y) * bf_lo(u1.y) + bf_lo(gb.y) * bf_lo(u2.y), bf_hi(ga.y) * bf_hi(u1.y) + bf_hi(gb.y) * bf_hi(u2.y));
        o.z = pk_bf16(bf_lo(ga.z) * bf_lo(u1.z) + bf_lo(gb.z) * bf_lo(u2.z), bf_hi(ga.z) * bf_hi(u1.z) + bf_hi(gb.z) * bf_hi(u2.z));
        o.w = pk_bf16(bf_lo(ga.w) * bf_lo(u1.w) + bf_lo(gb.w) * bf_lo(u2.w), bf_hi(ga.w) * bf_hi(u1.w) + bf_hi(gb.w) * bf_hi(u2.w));
        *(uint4*)(p.m + tok * DM + nt * 256 + ch * 8) = o;
      }
      lds_sync();
    }
  }
}

DI void phase6(const Params& p, char* smem) {
  const int t = tid_(), lane = t & 63, w = t >> 6, r = lane & 31, hh = lane >> 5;
  const int wm = w & 1, wn = w >> 1;
  const int xcd = blockIdx.x & 7, jl = blockIdx.x >> 3, nl = gridDim.x >> 3;
  for (int L = jl; L < 128; L += nl) {
    const int tokTile = xcd * 32 + (L >> 5) * 8 + (L & 7), nt = (L >> 3) & 3;
    f32x16 acc[4][2];
#pragma unroll
    for (int a = 0; a < 4; ++a)
#pragma unroll
      for (int c = 0; c < 2; ++c) acc[a][c] = zero16();
    float dummy = 0.f;
    const bf16_t* Wb = p.WoutT + (size_t)nt * 256 * DM; const bf16_t* Mb = p.m + (size_t)tokTile * 256 * DM;
    gemm8<4, 2, 2, 4, false>(acc, [&](int row) { return Wb + (size_t)row * DM; }, [&](int row) { return Mb + (size_t)row * DM; }, DM, smem, dummy);
    const int ch = t & 63, r0 = t >> 6;
    const float4 g = *(const float4*)(p.mod + (tokTile >> 3) * 6144 + 2048 + nt * 256 + ch * 4);
#pragma unroll
    for (int tn = 0; tn < 2; ++tn) {
#pragma unroll
      for (int tm = 0; tm < 4; ++tm) {
        char* d = smem + (wn * 32 + r) * 1040 + (wm * 128 + tm * 32 + 4 * hh) * 4;
#pragma unroll
        for (int q = 0; q < 4; ++q) *(float4*)(d + 32 * q) = make_float4(acc[tm][tn][4 * q], acc[tm][tn][4 * q + 1], acc[tm][tn][4 * q + 2], acc[tm][tn][4 * q + 3]);
      }
      lds_sync();
#pragma unroll 4
      for (int i = 0; i < 16; ++i) {
        const int row = r0 + 8 * i;
        const float4 a = *(const float4*)(smem + row * 1040 + ch * 16);
        const size_t o = ((size_t)tokTile * 256 + (row >> 5) * 64 + tn * 32 + (row & 31)) * DM + nt * 256 + ch * 4;
        const float4 xv = *(const float4*)(p.x + o);
        *(float4*)(p.out + o) = make_float4(xv.x + g.x * a.x, xv.y + g.y * a.y, xv.z + g.z * a.z, xv.w + g.w * a.w);
      }
      lds_sync();
    }
  }
}

DI void phase7(const Params& p, char* smem) {
  const int t = tid_(), lane = t & 63, w = t >> 6;
  float* wr = (float*)smem;
  for (int idx = t; idx < DM * NE; idx += NTH) { const int d = idx >> 4, e = idx & 15; wr[e * DM + d] = p.w_router[idx]; }
  __syncthreads();
  const int gw = blockIdx.x * NWV + w, nw = gridDim.x * NWV;
  for (int R = gw; R < NT; R += nw) {
    asm volatile("" ::: "memory");
    const float* src = p.out + (size_t)R * DM;
    const int b = R >> 11;
    const float* md = p.mod + b * 6144;
    float4 v[4]; float ss = 0.f;
#pragma unroll
    for (int i = 0; i < 4; ++i) { v[i] = *(const float4*)(src + lane * 4 + 256 * i); ss += v[i].x * v[i].x + v[i].y * v[i].y + v[i].z * v[i].z + v[i].w * v[i].w; }
    ss = wave_sum(ss);
    const float rr = rsqrtf(ss * (1.f / DM) + EPS);
#pragma unroll
    for (int i = 0; i < 4; ++i) {
      const int d = lane * 4 + 256 * i;
      const float4 g = *(const float4*)(p.norm2_g + d);
      const float4 sh = *(const float4*)(md + 3072 + d);
      const float4 sc = *(const float4*)(md + 4096 + d);
      v[i].x = v[i].x * rr * g.x * (1.f + sc.x) + sh.x;
      v[i].y = v[i].y * rr * g.y * (1.f + sc.y) + sh.y;
      v[i].z = v[i].z * rr * g.z * (1.f + sc.z) + sh.z;
      v[i].w = v[i].w * rr * g.w * (1.f + sc.w) + sh.w;
      uint2 o; o.x = pk_bf16(v[i].x, v[i].y); o.y = pk_bf16(v[i].z, v[i].w);
      *(uint2*)(p.h2 + (size_t)R * DM + d) = o;
    }
    float a[16];
#pragma unroll
    for (int e = 0; e < 16; ++e) {
      float s = 0.f;
#pragma unroll
      for (int i = 0; i < 4; ++i) { const float4 wv = *(const float4*)(wr + e * DM + lane * 4 + 256 * i); s += v[i].x * wv.x + v[i].y * wv.y + v[i].z * wv.z + v[i].w * wv.w; }
      a[e] = s;
      if ((e & 3) == 3) __builtin_amdgcn_sched_barrier(0);
    }
    float a8[8], a4[4], a2[2], a1;
    {
      const bool up = lane & 32;
#pragma unroll
      for (int j = 0; j < 8; ++j) { const float send = up ? a[j] : a[j + 8]; const float keep = up ? a[j + 8] : a[j]; a8[j] = keep + __shfl_xor(send, 32); }
    }
    {
      const bool up = lane & 16;
#pragma unroll
      for (int j = 0; j < 4; ++j) { const float send = up ? a8[j] : a8[j + 4]; const float keep = up ? a8[j + 4] : a8[j]; a4[j] = keep + __shfl_xor(send, 16); }
    }
    {
      const bool up = lane & 8;
#pragma unroll
      for (int j = 0; j < 2; ++j) { const float send = up ? a4[j] : a4[j + 2]; const float keep = up ? a4[j + 2] : a4[j]; a2[j] = keep + __shfl_xor(send, 8); }
    }
    {
      const bool up = lane & 4;
      const float send = up ? a2[0] : a2[1]; const float keep = up ? a2[1] : a2[0]; a1 = keep + __shfl_xor(send, 4);
    }
    a1 += __shfl_xor(a1, 2);
    a1 += __shfl_xor(a1, 1);
    float mx = a1;
#pragma unroll
    for (int o = 4; o <= 32; o <<= 1) mx = fmaxf(mx, __shfl_xor(mx, o));
    const float ex = __expf(a1 - mx);
    float sm = ex;
#pragma unroll
    for (int o = 4; o <= 32; o <<= 1) sm += __shfl_xor(sm, o);
    if ((lane & 3) == 0) {
      const int e = (lane >> 2) & 15;
      p.aff[((size_t)(b * NE + e)) * SEQ + (R & 2047)] = ex / sm;
    }
  }
}

DI void phase8(const Params& p) {
  const int t_ = tid_(); const int lane = t_ & 63, w = t_ >> 6;
  const int gw = blockIdx.x * NWV + w, nw = gridDim.x * NWV;
  for (int pr = gw; pr < NB * NE; pr += nw) {
    const float* a = p.aff + (size_t)pr * SEQ;
    unsigned u[32];
#pragma unroll
    for (int q = 0; q < 32; ++q) u[q] = __float_as_uint(a[q * 64 + lane]);
    unsigned thr = 0;
    for (int bit = 30; bit >= 0; --bit) {
      const unsigned cand = thr | (1u << bit);
      int cnt = 0;
#pragma unroll
      for (int q = 0; q < 32; ++q) cnt += __popcll(__ballot(u[q] >= cand));
      if (cnt >= CAP) thr = cand;
    }
    int ngt = 0;
#pragma unroll
    for (int q = 0; q < 32; ++q) ngt += __popcll(__ballot(u[q] > thr));
    int cgt = 0, ceq = 0;
    int* io = p.idx + pr * CAP; float* go = p.gate + pr * CAP;
    int* iv = p.inv + (size_t)pr * SEQ;
#pragma unroll
    for (int q = 0; q < 32; ++q) {
      const bool gt = u[q] > thr, eq = u[q] == thr;
      const unsigned long long mg = __ballot(gt), me = __ballot(eq);
      const unsigned long long below = (1ull << lane) - 1ull;
      int myslot = -1;
      if (gt) { const int s = cgt + __popcll(mg & below); io[s] = q * 64 + lane; go[s] = __uint_as_float(u[q]); myslot = s; }
      if (eq) { const int s = ngt + ceq + __popcll(me & below); if (s < CAP) { io[s] = q * 64 + lane; go[s] = __uint_as_float(u[q]); myslot = s; } }
      iv[q * 64 + lane] = myslot;
      cgt += __popcll(mg); ceq += __popcll(me);
    }
  }
}

DI void phase9(const Params& p, char* smem) {
  const int t = tid_(), lane = t & 63, w = t >> 6, r = lane & 31, hh = lane >> 5;
  const int wm = w & 1, wn = w >> 1;
  const int xcd = blockIdx.x & 7, jl = blockIdx.x >> 3, nl = gridDim.x >> 3;
  auto decode = [&](int L, int& e, int& ft, int& b) { e = xcd * 2 + (L >> 7); const int rem = L & 127; ft = (rem >> 3) & 3; b = (rem >> 5) * 8 + (rem & 7); };
  bool pre = false;
  for (int L = jl; L < 256; L += nl) {
    int e, ft, b, eN = 0, ftN = 0, bN = 0;
    decode(L, e, ft, b);
    const int Ln = L + nl; const bool hasNext = Ln < 256;
    if (hasNext) decode(Ln, eN, ftN, bN);
    const int be = b * NE + e;
    const bf16_t* Ab = p.WguT + ((size_t)e * 1024 + ft * 256) * DM;
    const int* ib = p.idx + be * CAP;
    const bf16_t* hb = p.h2 + (size_t)b * SEQ * DM;
    const bf16_t* AbN = p.WguT + ((size_t)eN * 1024 + ftN * 256) * DM;
    const int* ibN = p.idx + (bN * NE + eN) * CAP;
    const bf16_t* hbN = p.h2 + (size_t)bN * SEQ * DM;
    f32x16 acc[4][2];
#pragma unroll
    for (int a = 0; a < 4; ++a)
#pragma unroll
      for (int c = 0; c < 2; ++c) acc[a][c] = zero16();
    float dummy = 0.f;
    gemm8x<4, 2, 2, 4, false>(acc, [&](int row) { return Ab + (size_t)row * DM; }, [&](int row) { return hb + (size_t)ib[row] * DM; }, DM, smem, dummy,
                              pre, hasNext, [&](int row) { return AbN + (size_t)row * DM; }, [&](int row) { return hbN + (size_t)ibN[row] * DM; });
    pre = hasNext;
    char* tile = smem + EPI_OFF;
#pragma unroll
    for (int tn = 0; tn < 2; ++tn)
#pragma unroll
      for (int pr = 0; pr < 2; ++pr) {
        char* d = tile + (wn * 64 + tn * 32 + r) * 272 + (wm * 64 + pr * 32 + 4 * hh) * 2;
#pragma unroll
        for (int q = 0; q < 4; ++q) {
          float v[4];
#pragma unroll
          for (int j = 0; j < 4; ++j) { const float g = acc[2 * pr][tn][4 * q + j], uu = acc[2 * pr + 1][tn][4 * q + j]; v[j] = g * sigmoidf_(g) * uu; }
          uint2 ou; ou.x = pk_bf16(v[0], v[1]); ou.y = pk_bf16(v[2], v[3]);
          *(uint2*)(d + 16 * q) = ou;
        }
      }
    lds_sync();
    bf16_t* hd_ = p.hmid + (size_t)be * CAP * DE + ft * 128;
    copy_tile(tile, 272, 256, 4, [&](int row) { return hd_ + (size_t)row * DE; }, 0, 16);
  }
}

DI void phase10(const Params& p, char* smem) {
  const int xcd = blockIdx.x & 7, jl = blockIdx.x >> 3, nl = gridDim.x >> 3;
  auto decode = [&](int L, int& e, int& nt, int& b) { e = xcd * 2 + (L >> 7); const int rem = L & 127; nt = (rem >> 3) & 3; b = (rem >> 5) * 8 + (rem & 7); };
  bool pre = false;
  for (int L = jl; L < 256; L += nl) {
    int e, nt, b, eN = 0, ntN = 0, bN = 0;
    decode(L, e, nt, b);
    const int Ln = L + nl; const bool hasNext = Ln < 256;
    if (hasNext) decode(Ln, eN, ntN, bN);
    const int be = b * NE + e;
    const bf16_t* Hb = p.hmid + (size_t)be * CAP * DE;
    const bf16_t* Wb = p.WdT + ((size_t)e * DM + nt * 256) * DE;
    const bf16_t* HbN = p.hmid + (size_t)(bN * NE + eN) * CAP * DE;
    const bf16_t* WbN = p.WdT + ((size_t)eN * DM + ntN * 256) * DE;
    f32x16 acc[4][2];
#pragma unroll
    for (int a = 0; a < 4; ++a)
#pragma unroll
      for (int c = 0; c < 2; ++c) acc[a][c] = zero16();
    float dummy = 0.f;
    gemm8x<4, 2, 2, 4, false>(acc, [&](int row) { return Wb + (size_t)row * DE; }, [&](int row) { return Hb + (size_t)row * DE; }, DE, smem, dummy,
                              pre, hasNext, [&](int row) { return WbN + (size_t)row * DE; }, [&](int row) { return HbN + (size_t)row * DE; });
    pre = hasNext;
    char* tile = smem + EPI_OFF;
    bf16_t* yb = p.Y + (size_t)be * CAP * DM + nt * 256;
    stage_half<4, 2, 4, 0>(acc, tile, 528, [](float v) { return v; });
    lds_sync();
    copy_tile(tile, 528, 128, 5, [&](int rl) { return yb + (size_t)((rl >> 5) * 64 + (rl & 31)) * DM; }, 0, 32);
    lds_sync();
    stage_half<4, 2, 4, 1>(acc, tile, 528, [](float v) { return v; });
    lds_sync();
    copy_tile(tile, 528, 128, 5, [&](int rl) { return yb + (size_t)((rl >> 5) * 64 + 32 + (rl & 31)) * DM; }, 0, 32);
  }
}

DI void phase11(const Params& p) {
  const int t_ = tid_(); const int lane = t_ & 63, w = t_ >> 6;
  const int gw = blockIdx.x * NWV + w, nw = gridDim.x * NWV;
  for (int R = gw; R < NT; R += nw) {
    const int b = R >> 11, tq = R & 2047;
    const int myslot = (lane < NE) ? p.inv[((size_t)(b * NE + lane)) * SEQ + tq] : -1;
    unsigned long long mask = __ballot(myslot >= 0);
    if (mask == 0ull) continue;
    float4 a[4];
#pragma unroll
    for (int i = 0; i < 4; ++i) a[i] = make_float4(0.f, 0.f, 0.f, 0.f);
    while (mask) {
      const int e = __ffsll((long long)mask) - 1; mask &= mask - 1ull;
      const int slot = __shfl(myslot, e);
      const float g = p.gate[(b * NE + e) * CAP + slot];
      const bf16_t* y = p.Y + ((size_t)(b * NE + e) * CAP + slot) * DM + lane * 4;
#pragma unroll
      for (int i = 0; i < 4; ++i) {
        const uint2 u = *(const uint2*)(y + 256 * i);
        a[i].x += g * bf_lo(u.x); a[i].y += g * bf_hi(u.x); a[i].z += g * bf_lo(u.y); a[i].w += g * bf_hi(u.y);
      }
    }
    const float* g2 = p.mod + b * 6144 + 5120;
    float* o = p.out + (size_t)R * DM;
#pragma unroll
    for (int i = 0; i < 4; ++i) {
      const int d = lane * 4 + 256 * i;
      const float4 gv = *(const float4*)(g2 + d);
      float4 xv = *(float4*)(o + d);
      xv.x += gv.x * a[i].x; xv.y += gv.y * a[i].y; xv.z += gv.z * a[i].z; xv.w += gv.w * a[i].w;
      *(float4*)(o + d) = xv;
    }
  }
}

__global__ void __launch_bounds__(NTH, 2) mega_kernel(Params p) {
  cg::grid_group grid = cg::this_grid();
  __shared__ __attribute__((aligned(16))) char smem[SMEM_BYTES];
#ifndef REPMASK
#define REPMASK 0
#endif
#define RUNPH(k, call) for (int rep_ = 0; rep_ < (((REPMASK) >> (k)) & 1) + 1; ++rep_) { call; grid.sync(); }
  RUNPH(0, phase0(p, smem))
  RUNPH(1, phase1(p))
  RUNPH(2, phase2(p, smem))
  RUNPH(3, phase3(p, smem))
  RUNPH(4, phase4(p, smem))
  RUNPH(5, phase5(p, smem))
  RUNPH(6, phase6(p, smem))
  RUNPH(7, phase7(p, smem))
  RUNPH(8, phase8(p))
  RUNPH(9, phase9(p, smem))
  RUNPH(10, phase10(p, smem))
  phase11(p);
}

static inline size_t align_up(size_t v, size_t a) { return (v + a - 1) / a * a; }

extern "C" void kernel_launch(void* const* d_in, const int* in_sizes, int n_in,
                              void* d_out, int out_size, void* d_ws, size_t ws_size,
                              hipStream_t stream) {
  static int grid_blocks = 0;
  if (!grid_blocks) {
    int dev = 0, cus = 0, per_cu = 0;
    (void)hipGetDevice(&dev);
    (void)hipDeviceGetAttribute(&cus, hipDeviceAttributeMultiprocessorCount, dev);
    (void)hipOccupancyMaxActiveBlocksPerMultiprocessor(&per_cu, mega_kernel, NTH, 0);
    if (per_cu > 1) per_cu = 1;
    if (per_cu < 1) per_cu = 1;
    grid_blocks = (cus * per_cu) & ~7;
    if (grid_blocks < 8) grid_blocks = 8;
  }
  Params p;
  memset(&p, 0, sizeof(p));
  p.x = (const float*)d_in[0]; p.c = (const float*)d_in[1]; p.ctx = (const float*)d_in[2]; p.c_ctx = (const float*)d_in[3];
  p.w_mod = (const float*)d_in[4]; p.b_mod = (const float*)d_in[5]; p.norm1_g = (const float*)d_in[6];
  const float* w_in = (const float*)d_in[7];
  const float* q_a_g = (const float*)d_in[8];
  const float* kv_a_g = (const float*)d_in[9];
  const float* w_q_up = (const float*)d_in[10];
  const float* w_kv_up = (const float*)d_in[11];
  p.q_norm_g = (const float*)d_in[12]; p.k_norm_g = (const float*)d_in[13];
  const float* w_o_attn = (const float*)d_in[14];
  const float* w_fourier = (const float*)d_in[15];
  const float* w_out = (const float*)d_in[16];
  p.norm2_g = (const float*)d_in[17]; p.w_router = (const float*)d_in[18];
  const float* w_e_gate = (const float*)d_in[19];
  const float* w_e_up = (const float*)d_in[20];
  const float* w_e_down = (const float*)d_in[21];
  p.out = (float*)d_out;

  char* base = (char*)d_ws; size_t off = 0;
  auto alloc = [&](size_t bytes) { char* q = base + off; off = align_up(off + bytes, 256); return q; };
  p.WinT = (bf16_t*)alloc((size_t)NINP * DM * 2);
  p.WqT = (bf16_t*)alloc((size_t)768 * QL * 2);
  p.WkvT = (bf16_t*)alloc((size_t)1024 * KVL * 2);
  p.WoT = (bf16_t*)alloc((size_t)DM * 512 * 2);
  p.WfT = (bf16_t*)alloc((size_t)DM * 512 * 2);
  p.WoutT = (bf16_t*)alloc((size_t)DM * DM * 2);
  p.WguT = (bf16_t*)alloc((size_t)NE * 1024 * DM * 2);
  p.WdT = (bf16_t*)alloc((size_t)NE * DM * DE * 2);
  p.chanT = (bf16_t*)alloc((size_t)256 * 128 * 2);
  p.posM = (bf16_t*)alloc((size_t)2 * 1152 * 2048 * 2);
  p.ropeTab = (float*)alloc(64 * 8 * 2 * 4);
  p.mod = (float*)alloc(33 * 6144 * 4);
  p.aff = (float*)alloc((size_t)NB * NE * SEQ * 4);
  p.gate = (float*)alloc((size_t)NB * NE * CAP * 4);
  p.idx = (int*)alloc((size_t)NB * NE * CAP * 4);
  p.inv = (int*)alloc((size_t)NB * NE * SEQ * 4);
  p.pckv = (bf16_t*)alloc((size_t)NC * LDCKV * 2 + 4096);
  char* regA = alloc((size_t)(NT + NC) * DM * 2);
  p.h = (bf16_t*)regA; p.ABt = (bf16_t*)regA; p.h2 = (bf16_t*)regA;
  char* regB1 = alloc((size_t)NT * LDQKV * 2);
  p.pqkv = (bf16_t*)regB1; p.attn_o = (bf16_t*)regB1;
  char* regB2 = alloc((size_t)NT * 512 * 2);
  p.pf = (bf16_t*)regB2; p.four_o = (bf16_t*)regB2;
  p.pg = (bf16_t*)alloc((size_t)NT * 2048 * 2);
  p.Y = p.pg;
  const size_t szQ = (size_t)NB * NH * SEQ * QKD * 2, szK = (size_t)NB * NH * NKEY * QKD * 2, szV = (size_t)NB * NH * VD * NKEY * 2;
  char* regC = alloc(szQ + szK + szV + 1024);
  p.Q = (bf16_t*)regC; p.K = (bf16_t*)(regC + align_up(szQ, 256)); p.Vt = (bf16_t*)(regC + align_up(szQ, 256) + align_up(szK, 256));
  p.m = (bf16_t*)regC; p.hmid = (bf16_t*)(regC + (size_t)NT * DM * 2);
  if (off > ws_size) { fprintf(stderr, "workspace too small: need %zu have %zu\n", off, ws_size); return; }

  int ts = 0;
  auto job = [&](int i, const float* src, bf16_t* dst, const float* scale, int K, int ldS, int n_off, int n_cnt, int dst_row0, int mode, int batch, long sbs, long dbs) {
    TJob& j = p.jobs[i];
    j.src = src; j.dst = dst; j.scale = scale; j.K = K; j.ldS = ldS; j.n_off = n_off; j.n_cnt = n_cnt; j.dst_row0 = dst_row0; j.mode = mode; j.batch = batch;
    j.tiles_n = (n_cnt + 63) / 64; j.tile_start = ts; j.src_bstride = sbs; j.dst_bstride = dbs;
    ts += batch * (K / 64) * j.tiles_n;
  };
  job(0, w_e_gate, p.WguT, nullptr, DM, DE, 0, DE, 0, 1, NE, (long)DM * DE, (long)1024 * DM);
  job(1, w_e_up, p.WguT, nullptr, DM, DE, 0, DE, 0, 2, NE, (long)DM * DE, (long)1024 * DM);
  job(2, w_e_down, p.WdT, nullptr, DE, DM, 0, DM, 0, 0, NE, (long)DE * DM, (long)DM * DE);
  job(3, w_in, p.WinT, nullptr, DM, N_IN, 0, 672, 0, 0, 1, 0, 0);
  job(4, w_in, p.WinT, nullptr, DM, N_IN, 672, 2560, 768, 0, 1, 0, 0);
  job(5, w_q_up, p.WqT, q_a_g, QL, 768, 0, 768, 0, 0, 1, 0, 0);
  job(6, w_kv_up, p.WkvT, kv_a_g, KVL, 1024, 0, 1024, 0, 0, 1, 0, 0);
  job(7, w_o_attn, p.WoT, nullptr, 512, DM, 0, DM, 0, 0, 1, 0, 0);
  job(8, w_fourier, p.WfT, nullptr, 512, DM, 0, DM, 0, 0, 1, 0, 0);
  job(9, w_out, p.WoutT, nullptr, DM, DM, 0, DM, 0, 0, 1, 0, 0);
  p.n_ttiles = ts;

  void* args[] = {&p};
  hipError_t e = hipLaunchCooperativeKernel((void*)mega_kernel, dim3(grid_blocks), dim3(NTH), args, 0, stream);
  if (e != hipSuccess) fprintf(stderr, "cooperative launch failed: %s (grid %d)\n", hipGetErrorString(e), grid_blocks);
}
```

```cpp
#include <hip/hip_runtime.h>
#include <hip/hip_cooperative_groups.h>
#include <cstdio>
#include <cstring>
#include <cstdint>
namespace cg = cooperative_groups;

#define DI __device__ __forceinline__
typedef unsigned short bf16_t;
typedef short bf16x8 __attribute__((ext_vector_type(8)));
typedef float f32x16 __attribute__((ext_vector_type(16)));
#define MFMA(a, b, c) __builtin_amdgcn_mfma_f32_32x32x16_bf16((a), (b), (c), 0, 0, 0)

constexpr int NB = 32, SEQ = 2048, DM = 1024, NT = NB * SEQ, CTXL = 256, NC = NB * CTXL;
constexpr int NH = 8, QKD = 96, VD = 64, QL = 384, KVL = 256, NKEY = SEQ + CTXL;
constexpr int N_IN = 3232, NINP = 3328;
constexpr int NE = 16, DE = 512, CAP = 256;
constexpr float EPS = 1e-6f;
constexpr int LDQKV = 672, LDCKV = 288;
constexpr int NTH = 512, NWV = 8;
constexpr int SMEM_BYTES = 147456;

struct TJob {
  const float* src; bf16_t* dst; const float* scale;
  int K, ldS, n_off, n_cnt, dst_row0, mode, batch, tiles_n, tile_start, pad0;
  long src_bstride, dst_bstride;
};
constexpr int NJOBS = 10;

struct Params {
  const float *x, *c, *ctx, *c_ctx, *w_mod, *b_mod, *norm1_g, *q_norm_g, *k_norm_g, *norm2_g, *w_router;
  float* out;
  bf16_t *WinT, *WqT, *WkvT, *WoT, *WfT, *WoutT, *WguT, *WdT, *chanT, *posM;
  float *ropeTab, *mod;
  bf16_t *h, *pqkv, *pckv, *pf, *pg, *Q, *K, *Vt, *attn_o, *ABt, *four_o, *m, *h2, *hmid;
  float *aff, *gate;
  int* idx;
  int* inv;
  bf16_t* Y;
  TJob jobs[NJOBS];
  int n_ttiles, pad1;
};

typedef float f32x2v __attribute__((ext_vector_type(2)));
typedef __bf16 bf16x2v __attribute__((ext_vector_type(2)));
DI unsigned pk_bf16(float lo, float hi) { f32x2v v = {lo, hi}; bf16x2v b = __builtin_convertvector(v, bf16x2v); return __builtin_bit_cast(unsigned, b); }
DI int tid_() { int t = threadIdx.x; asm volatile("" : "+v"(t)); return t; }
DI float bf_lo(unsigned u) { return __uint_as_float(u << 16); }
DI float bf_hi(unsigned u) { return __uint_as_float(u & 0xffff0000u); }
DI bf16_t f2bf(float f) { return (bf16_t)(pk_bf16(f, 0.f) & 0xffffu); }
DI float sigmoidf_(float x) { return 1.f / (1.f + __expf(-x)); }
DI int crow(int i, int hh) { return (i & 3) + 8 * (i >> 2) + 4 * hh; }
DI float wave_sum(float v) {
#pragma unroll
  for (int o = 32; o >= 1; o >>= 1) v += __shfl_xor(v, o);
  return v;
}
DI f32x16 zero16() { f32x16 z;
#pragma unroll
  for (int i = 0; i < 16; ++i) z[i] = 0.f; return z; }
DI void wait_vm0() { asm volatile("s_waitcnt vmcnt(0)" ::: "memory"); }
DI void wait_lgkm0() { asm volatile("s_waitcnt lgkmcnt(0)" ::: "memory"); }
DI void bar_() { __builtin_amdgcn_s_barrier(); }
DI void lds_sync() { wait_lgkm0(); bar_(); }
#define GLDS(gp, lp) __builtin_amdgcn_global_load_lds((const unsigned*)(gp), (__attribute__((address_space(3))) unsigned*)(lp), 16, 0, 0)
#define SB_ __builtin_amdgcn_sched_barrier(0)

constexpr int EPI_OFF = 65536;
template <int TM, int TN, int WM, int WN, bool SUMSQ, int NST, class AF, class BF, class AFN, class BFN>
DI void gemm8x(f32x16 (&acc)[TM][TN], AF arow, BF brow, int K, char* smem, float& sumsq, bool pre, bool hasNext, AFN arowN, BFN browN) {
  constexpr int RA = 32 * TM * WM, RB = 32 * TN * WN;
  constexpr int LDR = 128, STAGE = (RA + RB) * LDR;
  static_assert(WM * WN == NWV, "waves");
  static_assert(NST * STAGE <= SMEM_BYTES, "smem");
  static_assert(NST == 2 || (NST == 3 && RA == 256 && RB == 128), "3-stage ring: 6 loads per thread per stage assumed");
  static_assert(RA <= 256 && RB <= 256 && RA % 32 == 0 && RB % 32 == 0, "shape");
  const int t = tid_(), lane = t & 63, w = t >> 6, r = lane & 31, hh = lane >> 5;
  const int wm = w % WM, wn = w / WM;
  const int row0 = t >> 3;
  const int c = (t & 7) ^ ((row0 >> 1) & 7);
  const bool a0v = row0 < RA, a1v = row0 + 64 < RA, a2v = row0 + 128 < RA, a3v = row0 + 192 < RA;
  const bool b0v = row0 < RB, b1v = row0 + 64 < RB, b2v = row0 + 128 < RB, b3v = row0 + 192 < RB;
  const bf16_t* pa0 = arow(a0v ? row0 : 0) + c * 8;
  const bf16_t* pa1 = arow(a1v ? row0 + 64 : 0) + c * 8;
  const bf16_t* pa2 = arow(a2v ? row0 + 128 : 0) + c * 8;
  const bf16_t* pa3 = arow(a3v ? row0 + 192 : 0) + c * 8;
  const bf16_t* pb0 = brow(b0v ? row0 : 0) + c * 8;
  const bf16_t* pb1 = brow(b1v ? row0 + 64 : 0) + c * 8;
  const bf16_t* pb2 = brow(b2v ? row0 + 128 : 0) + c * 8;
  const bf16_t* pb3 = brow(b3v ? row0 + 192 : 0) + c * 8;
  if (!pre) {
    char* l_ = smem + t * 16; char* m_ = l_ + RA * LDR;
    if (a0v) GLDS(pa0, l_); if (a1v) GLDS(pa1, l_ + 8192); if (a2v) GLDS(pa2, l_ + 16384); if (a3v) GLDS(pa3, l_ + 24576);
    if (b0v) GLDS(pb0, m_); if (b1v) GLDS(pb1, m_ + 8192); if (b2v) GLDS(pb2, m_ + 16384); if (b3v) GLDS(pb3, m_ + 24576);
  }
  if (NST == 3) {
    char* l_ = smem + STAGE + t * 16; char* m_ = l_ + RA * LDR;
    GLDS(pa0 + 64, l_); GLDS(pa1 + 64, l_ + 8192); GLDS(pa2 + 64, l_ + 16384); GLDS(pa3 + 64, l_ + 24576);
    GLDS(pb0 + 64, m_); GLDS(pb1 + 64, m_ + 8192);
    asm volatile("s_waitcnt vmcnt(6)" ::: "memory");
  } else wait_vm0();
  bar_();
  const int nk = K >> 6;
  const int sw = (r >> 1) & 7;
  const int aoff = (wm * TM * 32 + r) * LDR, boff = RA * LDR + (wn * TN * 32 + r) * LDR;
  auto compute = [&](const char* cur, char* nxt, bool issue, const bf16_t* q0, const bf16_t* q1, const bf16_t* q2, const bf16_t* q3,
                     const bf16_t* s0, const bf16_t* s1, const bf16_t* s2, const bf16_t* s3) {
    const char* As = cur + aoff;
    const char* Bs = cur + boff;
    char* l_ = nxt + t * 16; char* m_ = l_ + RA * LDR;
    bf16x8 a0[TM], b0[TN], a1[TM], b1[TN];
#define LOADF(A_, B_, ks) do { const int po_ = (((ks) * 2 + hh) ^ sw) * 16; \
      _Pragma("unroll") for (int tm = 0; tm < TM; ++tm) A_[tm] = *(const bf16x8*)(As + tm * 32 * LDR + po_); \
      _Pragma("unroll") for (int tn = 0; tn < TN; ++tn) B_[tn] = *(const bf16x8*)(Bs + tn * 32 * LDR + po_); } while (0)
#define MMF(A_, B_) do { if (SUMSQ) { uint4 u = __builtin_bit_cast(uint4, B_[0]); \
        float e0 = bf_lo(u.x), e1 = bf_hi(u.x), e2 = bf_lo(u.y), e3 = bf_hi(u.y), e4 = bf_lo(u.z), e5 = bf_hi(u.z), e6 = bf_lo(u.w), e7 = bf_hi(u.w); \
        sumsq += e0 * e0 + e1 * e1 + e2 * e2 + e3 * e3 + e4 * e4 + e5 * e5 + e6 * e6 + e7 * e7; } \
      _Pragma("unroll") for (int tm = 0; tm < TM; ++tm) _Pragma("unroll") for (int tn = 0; tn < TN; ++tn) acc[tm][tn] = MFMA(A_[tm], B_[tn], acc[tm][tn]); } while (0)
    LOADF(a0, b0, 0);
    LOADF(a1, b1, 1);
    SB_;
    if (issue) { if (a0v) GLDS(q0, l_); if (a1v) GLDS(q1, l_ + 8192); }
    SB_;
    __builtin_amdgcn_s_setprio(1);
    MMF(a0, b0);
    LOADF(a0, b0, 2);
    SB_;
    if (issue) { if (a2v) GLDS(q2, l_ + 16384); if (a3v) GLDS(q3, l_ + 24576); }
    SB_;
    MMF(a1, b1);
    LOADF(a1, b1, 3);
    SB_;
    if (issue) { if (b0v) GLDS(s0, m_); if (b1v) GLDS(s1, m_ + 8192); }
    SB_;
    MMF(a0, b0);
    SB_;
    if (issue) { if (b2v) GLDS(s2, m_ + 16384); if (b3v) GLDS(s3, m_ + 24576); }
    SB_;
    MMF(a1, b1);
    __builtin_amdgcn_s_setprio(0);
  };
  int sc_ = 0;
  for (int kt = 0; kt < nk - 1; ++kt) {
    SB_;
    if (NST == 2) {
      const int ko = (kt + 1) * 64;
      compute(smem + (kt & 1) * STAGE, smem + ((kt + 1) & 1) * STAGE, true, pa0 + ko, pa1 + ko, pa2 + ko, pa3 + ko, pb0 + ko, pb1 + ko, pb2 + ko, pb3 + ko);
      SB_;
      wait_vm0(); bar_();
    } else {
      const int ko = (kt + 2) * 64; const bool iss = kt + 2 < nk;
      const int sn = (sc_ == 0) ? 2 : sc_ - 1;
      compute(smem + sc_ * STAGE, smem + sn * STAGE, iss, pa0 + ko, pa1 + ko, pa2 + ko, pa3 + ko, pb0 + ko, pb1 + ko, pb2 + ko, pb3 + ko);
      SB_;
      if (iss) asm volatile("s_waitcnt vmcnt(6)" ::: "memory"); else wait_vm0();
      bar_();
      sc_ = (sc_ == 2) ? 0 : sc_ + 1;
    }
  }
  if (NST == 3) {
    SB_;
    compute(smem + sc_ * STAGE, smem, false, pa0, pa0, pa0, pa0, pa0, pa0, pa0, pa0);
    SB_;
    lds_sync();
  } else {
    const bf16_t *q0 = pa0, *q1 = pa0, *q2 = pa0, *q3 = pa0, *s0 = pa0, *s1 = pa0, *s2 = pa0, *s3 = pa0;
    if (hasNext) {
      q0 = arowN(a0v ? row0 : 0) + c * 8; q1 = arowN(a1v ? row0 + 64 : 0) + c * 8; q2 = arowN(a2v ? row0 + 128 : 0) + c * 8; q3 = arowN(a3v ? row0 + 192 : 0) + c * 8;
      s0 = browN(b0v ? row0 : 0) + c * 8; s1 = browN(b1v ? row0 + 64 : 0) + c * 8; s2 = browN(b2v ? row0 + 128 : 0) + c * 8; s3 = browN(b3v ? row0 + 192 : 0) + c * 8;
    }
    SB_;
    compute(smem + ((nk - 1) & 1) * STAGE, smem, hasNext, q0, q1, q2, q3, s0, s1, s2, s3);
    SB_;
    lds_sync();
  }
}
template <int TM, int TN, int WM, int WN, bool SUMSQ, class AF, class BF>
DI void gemm8(f32x16 (&acc)[TM][TN], AF arow, BF brow, int K, char* smem, float& sumsq) {
  gemm8x<TM, TN, WM, WN, SUMSQ, 2>(acc, arow, brow, K, smem, sumsq, false, false, arow, brow);
}
template <class AF, class BF>
DI void gemm8s3(f32x16 (&acc)[2][2], AF arow, BF brow, int K, char* smem) {
  float dummy = 0.f;
  gemm8x<2, 2, 4, 2, false, 3>(acc, arow, brow, K, smem, dummy, false, false, arow, brow);
}
template <int TM, int WM, int WN, int TNSEL, class F>
DI void stage_half(const f32x16 (&acc)[TM][2], char* tile, int pitch, F f) {
  const int t = tid_(), lane = t & 63, w = t >> 6, r = lane & 31, hh = lane >> 5;
  const int wm = w % WM, wn = w / WM;
#pragma unroll
  for (int tm = 0; tm < TM; ++tm) {
    char* d = tile + (wn * 32 + r) * pitch + (wm * TM * 32 + tm * 32 + 4 * hh) * 2;
#pragma unroll
    for (int q = 0; q < 4; ++q) {
      const f32x16& a = acc[tm][TNSEL];
      uint2 o; o.x = pk_bf16(f(a[4 * q]), f(a[4 * q + 1])); o.y = pk_bf16(f(a[4 * q + 2]), f(a[4 * q + 3]));
      *(uint2*)(d + 16 * q) = o;
    }
  }
}

template <int TM, int TN, int WM, int WN, class F>
DI void stage_tile(const f32x16 (&acc)[TM][TN], char* tile, int pitch, F f) {
  const int t = tid_(), lane = t & 63, w = t >> 6, r = lane & 31, hh = lane >> 5;
  const int wm = w % WM, wn = w / WM;
#pragma unroll
  for (int tm = 0; tm < TM; ++tm)
#pragma unroll
    for (int tn = 0; tn < TN; ++tn) {
      char* d = tile + (wn * TN * 32 + tn * 32 + r) * pitch + (wm * TM * 32 + tm * 32 + 4 * hh) * 2;
#pragma unroll
      for (int q = 0; q < 4; ++q) {
        uint2 o; o.x = pk_bf16(f(acc[tm][tn][4 * q]), f(acc[tm][tn][4 * q + 1])); o.y = pk_bf16(f(acc[tm][tn][4 * q + 2]), f(acc[tm][tn][4 * q + 3]));
        *(uint2*)(d + 16 * q) = o;
      }
    }
}
template <class RF>
DI void copy_tile(const char* tile, int pitch, int rows, int lch, RF dst, int ch0, int ch1) {
  const int t = tid_();
  const int total = rows << lch;
  for (int id = t; id < total; id += NTH) {
    const int row = id >> lch, ch = id & ((1 << lch) - 1);
    if (ch >= ch0 && ch < ch1) *(uint4*)(dst(row) + ch * 8) = *(const uint4*)(tile + row * pitch + ch * 16);
  }
}

DI void transpose_tile(const TJob& j, int tile, char* smem) {
  const int t = tid_();
  const int tpb = (j.K >> 6) * j.tiles_n;
  const int bi = tile / tpb, rem = tile % tpb;
  const int kt = rem / j.tiles_n, ntile = rem % j.tiles_n;
  const int k0 = kt * 64, n0 = ntile * 64;
  const float* src = j.src + (size_t)bi * j.src_bstride;
  bf16_t* dst = j.dst + (size_t)bi * j.dst_bstride;
  bf16_t* T = (bf16_t*)smem;
  const int nn = t & 63, kq = t >> 6;
  const bool nvalid = (n0 + nn) < j.n_cnt;
  __syncthreads();
#pragma unroll 4
  for (int i = 0; i < 8; ++i) {
    const int kk = kq + 8 * i;
    float v = 0.f;
    if (nvalid) {
      v = src[(size_t)(k0 + kk) * j.ldS + j.n_off + n0 + nn];
      if (j.scale) v *= j.scale[k0 + kk];
    }
    T[nn * 66 + kk] = f2bf(v);
  }
  __syncthreads();
  const int n = t >> 3, part = t & 7;
  if (n0 + n < j.n_cnt) {
    const unsigned* tp = (const unsigned*)(T + n * 66 + part * 8);
    uint4 o0; o0.x = tp[0]; o0.y = tp[1]; o0.z = tp[2]; o0.w = tp[3];
    const int f = n0 + n;
    int drow;
    if (j.mode == 0) drow = j.dst_row0 + f;
    else drow = (f >> 7) * 256 + ((f >> 6) & 1) * 128 + (((f >> 5) & 1) * 2 + (j.mode == 2 ? 1 : 0)) * 32 + (f & 31);
    *(uint4*)(dst + (size_t)drow * j.K + k0 + part * 8) = o0;
  }
}

DI void mod_item(const Params& p, int it, char* smem) {
  const int t = tid_(), cgi = t & 15, kg = t >> 4;
  const int j0 = it * 16;
  float* Ssm = (float*)smem;
  float* red = (float*)(smem + 33 * 128 * 4);
  float acc[33];
#pragma unroll
  for (int r = 0; r < 33; ++r) acc[r] = 0.f;
#pragma unroll 1
  for (int kc = 0; kc < 8; ++kc) {
    __syncthreads();
    for (int idx = t; idx < 33 * 128; idx += NTH) {
      const int r = idx >> 7, kk = idx & 127;
      float v = (r < 32) ? p.c[r * DM + kc * 128 + kk] : p.c_ctx[kc * 128 + kk];
      Ssm[idx] = v * sigmoidf_(v);
    }
    __syncthreads();
    const int k = kc * 128 + kg * 4;
    const float w0 = p.w_mod[(size_t)(k + 0) * 6144 + j0 + cgi];
    const float w1 = p.w_mod[(size_t)(k + 1) * 6144 + j0 + cgi];
    const float w2 = p.w_mod[(size_t)(k + 2) * 6144 + j0 + cgi];
    const float w3 = p.w_mod[(size_t)(k + 3) * 6144 + j0 + cgi];
#pragma unroll
    for (int r = 0; r < 33; ++r) {
      const float4 s = *(const float4*)(Ssm + r * 128 + kg * 4);
      acc[r] += s.x * w0 + s.y * w1 + s.z * w2 + s.w * w3;
    }
  }
  __syncthreads();
#pragma unroll
  for (int r = 0; r < 33; ++r) red[(kg * 33 + r) * 16 + cgi] = acc[r];
  __syncthreads();
  for (int idx = t; idx < 33 * 16; idx += NTH) {
    const int r = idx >> 4, cc = idx & 15;
    float s = 0.f;
#pragma unroll
    for (int g = 0; g < 32; ++g) s += red[(g * 33 + r) * 16 + cc];
    p.mod[r * 6144 + j0 + cc] = s + p.b_mod[j0 + cc];
  }
}

DI void phase0(const Params& p, char* smem) {
  const int t = tid_();
  const int nMod = 384;
  const int nPos = 288;
  const int nMisc = 3;
  const int nT = p.n_ttiles;
  const int total = nMod + nT + nPos + nMisc;
  float* ctab = (float*)(smem + 98304);
  for (int j = t; j < 2048; j += NTH) ctab[j] = cospif((float)j * (1.f / 1024.f));
  __syncthreads();
  for (int it = blockIdx.x; it < total; it += gridDim.x) {
    if (it < nMod) { mod_item(p, it, smem); continue; }
    int u = it - nMod;
    if (u < nT) {
      int jb = 0;
#pragma unroll 1
      for (int q = 1; q < NJOBS; ++q) if (u >= p.jobs[q].tile_start) jb = q;
      transpose_tile(p.jobs[jb], u - p.jobs[jb].tile_start, smem);
      continue;
    }
    u -= nT;
    if (u < nPos) {
      for (int e = t; e < 8 * 256; e += NTH) {
        const int R = u * 8 + (e >> 8), c8 = (e & 255) * 8;
        const int part = R >= 1152 ? 1 : 0, k = R - part * 1152;
        float v[8];
#pragma unroll
        for (int q = 0; q < 8; ++q) {
          const int tt = c8 + q;
          v[q] = (k > 1024) ? 0.f : (part ? ctab[(k * tt - 512) & 2047] : ctab[(k * tt) & 2047]);
        }
        uint4 o; o.x = pk_bf16(v[0], v[1]); o.y = pk_bf16(v[2], v[3]); o.z = pk_bf16(v[4], v[5]); o.w = pk_bf16(v[6], v[7]);
        *(uint4*)(p.posM + (size_t)R * 2048 + c8) = o;
      }
      continue;
    }
    u -= nPos;
    if (u == 0) {
      for (int e = t; e < 256 * 128; e += NTH) {
        const int m2 = e >> 7, cc = e & 127, mm = m2 & 127;
        float v = (m2 < 128) ? ctab[(mm * cc * 16) & 2047] : ctab[(mm * cc * 16 - 512) & 2047];
        p.chanT[e] = f2bf(v);
      }
    } else if (u == 1) {
      for (int e = t; e < 64 * 8; e += NTH) {
        const int pos = e >> 3, jf = e & 7;
        const float inv = 1.0f / powf(10000.0f, (float)jf / 8.0f);
        const float ang = (float)pos * inv;
        p.ropeTab[e * 2 + 0] = cosf(ang);
        p.ropeTab[e * 2 + 1] = sinf(ang);
      }
    } else {
      uint4 z; z.x = z.y = z.z = z.w = 0u;
      uint4* dp = (uint4*)(p.WinT + (size_t)672 * DM);
      for (int e = t; e < 96 * DM / 8; e += NTH) dp[e] = z;
    }
  }
}

DI void phase1(const Params& p) {
  const int t_ = tid_(); const int lane = t_ & 63, w = t_ >> 6;
  const int gw = blockIdx.x * NWV + w, nw = gridDim.x * NWV;
  for (int R0 = gw; R0 < NT + NC; R0 += 2 * nw) {
    const int R1 = R0 + nw; const bool has1 = R1 < NT + NC;
    const float* src0 = (R0 < NT) ? p.x + (size_t)R0 * DM : p.ctx + (size_t)(R0 - NT) * DM;
    const float* src1 = has1 ? ((R1 < NT) ? p.x + (size_t)R1 * DM : p.ctx + (size_t)(R1 - NT) * DM) : src0;
    const float* md0 = p.mod + ((R0 < NT) ? (R0 >> 11) : 32) * 6144;
    const float* md1 = p.mod + ((has1 && R1 < NT) ? (R1 >> 11) : 32) * 6144;
    float4 v0[4], v1[4]; float s0 = 0.f, s1 = 0.f;
#pragma unroll
    for (int i = 0; i < 4; ++i) { v0[i] = *(const float4*)(src0 + lane * 4 + 256 * i); v1[i] = *(const float4*)(src1 + lane * 4 + 256 * i); }
#pragma unroll
    for (int i = 0; i < 4; ++i) { s0 += v0[i].x * v0[i].x + v0[i].y * v0[i].y + v0[i].z * v0[i].z + v0[i].w * v0[i].w; s1 += v1[i].x * v1[i].x + v1[i].y * v1[i].y + v1[i].z * v1[i].z + v1[i].w * v1[i].w; }
    s0 = wave_sum(s0); s1 = wave_sum(s1);
    const float r0 = rsqrtf(s0 * (1.f / DM) + EPS), r1 = rsqrtf(s1 * (1.f / DM) + EPS);
#pragma unroll
    for (int i = 0; i < 4; ++i) {
      const int d = lane * 4 + 256 * i;
      const float4 g = *(const float4*)(p.norm1_g + d);
      {
        const float4 sh = *(const float4*)(md0 + d), sc = *(const float4*)(md0 + 1024 + d);
        uint2 o; o.x = pk_bf16(v0[i].x * r0 * g.x * (1.f + sc.x) + sh.x, v0[i].y * r0 * g.y * (1.f + sc.y) + sh.y);
        o.y = pk_bf16(v0[i].z * r0 * g.z * (1.f + sc.z) + sh.z, v0[i].w * r0 * g.w * (1.f + sc.w) + sh.w);
        *(uint2*)(p.h + (size_t)R0 * DM + d) = o;
      }
      if (has1) {
        const float4 sh = *(const float4*)(md1 + d), sc = *(const float4*)(md1 + 1024 + d);
        uint2 o; o.x = pk_bf16(v1[i].x * r1 * g.x * (1.f + sc.x) + sh.x, v1[i].y * r1 * g.y * (1.f + sc.y) + sh.y);
        o.y = pk_bf16(v1[i].z * r1 * g.z * (1.f + sc.z) + sh.z, v1[i].w * r1 * g.w * (1.f + sc.w) + sh.w);
        *(uint2*)(p.h + (size_t)R1 * DM + d) = o;
      }
    }
  }
}

DI void phase2(const Params& p, char* smem) {
  const int xcd = blockIdx.x & 7, jl = blockIdx.x >> 3, nl = gridDim.x >> 3;
  auto decode = [&](int L, int& tokTile, int& ft) {
    if (L < 416) { const int tg = L / 104, rem = L % 104; ft = rem >> 3; tokTile = xcd * 32 + tg * 8 + (rem & 7); }
    else { const int u = L - 416; tokTile = 256 + xcd * 4 + (u >> 1); ft = 1 + (u & 1); }
  };
  bool pre = false;
  for (int L = jl; L < 416 + 8; L += nl) {
    int tokTile, ft, tokTileN = 0, ftN = 0;
    decode(L, tokTile, ft);
    const bool lat = L < 416;
    const int Ln = L + nl; const bool hasNext = Ln < 416 + 8;
    if (hasNext) decode(Ln, tokTileN, ftN);
    f32x16 acc[4][2];
#pragma unroll
    for (int a = 0; a < 4; ++a)
#pragma unroll
      for (int b = 0; b < 2; ++b) acc[a][b] = zero16();
    const bf16_t* Ab = p.WinT + (size_t)ft * 256 * DM;
    const bf16_t* Bb = p.h + (size_t)tokTile * 256 * DM;
    const bf16_t* AbN = p.WinT + (size_t)ftN * 256 * DM;
    const bf16_t* BbN = p.h + (size_t)tokTileN * 256 * DM;
    float dummy = 0.f;
    gemm8x<4, 2, 2, 4, false, 2>(acc, [&](int row) { return Ab + (size_t)row * DM; }, [&](int row) { return Bb + (size_t)row * DM; }, DM, smem, dummy,
                              pre, hasNext, [&](int row) { return AbN + (size_t)row * DM; }, [&](int row) { return BbN + (size_t)row * DM; });
    pre = hasNext;
    char* tile = smem + EPI_OFF;
    bf16_t* base; int ld, c0 = 0, c1 = 32;
    if (lat) {
      const size_t tok0 = (size_t)tokTile * 256;
      if (ft < 3) { base = p.pqkv + tok0 * LDQKV + ft * 256; ld = LDQKV; if (ft == 2) c1 = 20; }
      else if (ft < 5) { base = p.pf + tok0 * 512 + (ft - 3) * 256; ld = 512; }
      else { base = p.pg + tok0 * 2048 + (ft - 5) * 256; ld = 2048; }
    } else {
      const size_t ct0 = (size_t)(tokTile - 256) * 256;
      base = p.pckv + ct0 * LDCKV + ft * 256 - 384; ld = LDCKV;
      if (ft == 1) c0 = 16; else c1 = 20;
    }
    if (ft >= 5) stage_half<4, 2, 4, 0>(acc, tile, 528, [](float v) { return sigmoidf_(v); });
    else stage_half<4, 2, 4, 0>(acc, tile, 528, [](float v) { return v; });
    lds_sync();
    copy_tile(tile, 528, 128, 5, [&](int rl) { return base + (size_t)((rl >> 5) * 64 + (rl & 31)) * ld; }, c0, c1);
    lds_sync();
    if (ft >= 5) stage_half<4, 2, 4, 1>(acc, tile, 528, [](float v) { return sigmoidf_(v); });
    else stage_half<4, 2, 4, 1>(acc, tile, 528, [](float v) { return v; });
    lds_sync();
    copy_tile(tile, 528, 128, 5, [&](int rl) { return base + (size_t)((rl >> 5) * 64 + 32 + (rl & 31)) * ld; }, c0, c1);
  }
}

DI void rope_pair(float& x1, float& x2, const float* tab) { const float c = tab[0], s = tab[1]; const float a = x1 * c - x2 * s, b = x2 * c + x1 * s; x1 = a; x2 = b; }

DI void phase3(const Params& p, char* smem) {
  const int t = tid_(), lane = t & 63, w = t >> 6, r = lane & 31, hh = lane >> 5;
  const int nKV = 288, nQ = 256, nCh = 128;
  const int xcd = blockIdx.x & 7, jl = blockIdx.x >> 3, nl = gridDim.x >> 3;
  for (int it = jl; it < nKV + nQ + nCh; it += nl) {
    if (it < nKV) {
      const int tl_ = it >> 3, hd = it & 7;
      const bool lat = tl_ < 32;
      const bf16_t* Bb; int ldb; const bf16_t* kpeb;
      int b, key0;
      if (lat) { const int tokTile = xcd * 32 + tl_; Bb = p.pqkv + (size_t)tokTile * 256 * LDQKV + QL; ldb = LDQKV; kpeb = p.pqkv + (size_t)tokTile * 256 * LDQKV + 640; b = tokTile >> 3; key0 = (tokTile & 7) * 256; }
      else { const int ct = xcd * 4 + (tl_ - 32); Bb = p.pckv + (size_t)ct * 256 * LDCKV; ldb = LDCKV; kpeb = Bb + 256; b = ct; key0 = SEQ; }
      const bf16_t* Ab = p.WkvT + (size_t)hd * 128 * KVL;
      f32x16 acc[4][1];
#pragma unroll
      for (int a = 0; a < 4; ++a) acc[a][0] = zero16();
      float sumsq = 0.f;
      gemm8<4, 1, 1, 8, true>(acc, [&](int row) { return Ab + (size_t)row * KVL; }, [&](int row) { return Bb + (size_t)row * ldb; }, KVL, smem, sumsq);
      sumsq += __shfl_xor(sumsq, 32);
      const float ra = rsqrtf(sumsq * (1.f / KVL) + EPS);
      const int tl = w * 32 + r;
      const int key = key0 + tl;
      float kp[16];
#pragma unroll
      for (int q = 0; q < 4; ++q) {
        const uint2 u = *(const uint2*)(kpeb + (size_t)tl * ldb + 8 * q + 4 * hh);
        kp[4 * q + 0] = bf_lo(u.x); kp[4 * q + 1] = bf_hi(u.x); kp[4 * q + 2] = bf_lo(u.y); kp[4 * q + 3] = bf_hi(u.y);
      }
      float ss = 0.f;
#pragma unroll
      for (int tm = 0; tm < 4; ++tm)
#pragma unroll
        for (int i = 0; i < 16; ++i) { const float v = acc[tm][0][i] * ra; acc[tm][0][i] = v; if (tm < 2) ss += v * v; }
#pragma unroll
      for (int i = 0; i < 16; ++i) ss += kp[i] * kp[i];
      ss += __shfl_xor(ss, 32);
      const float rk = rsqrtf(ss * (1.f / QKD) + EPS);
#pragma unroll
      for (int i = 0; i < 16; ++i) kp[i] *= rk * p.k_norm_g[64 + crow(i, hh)];
      if (lat) {
        const int pos = key;
        const float* tr = p.ropeTab + ((pos >> 6) * 8 + 4 * hh) * 2;
        const float* tc = p.ropeTab + ((pos & 63) * 8 + 4 * hh) * 2;
#pragma unroll
        for (int i = 0; i < 4; ++i) { rope_pair(kp[i], kp[i + 4], tr + 2 * i); rope_pair(kp[8 + i], kp[12 + i], tc + 2 * i); }
      }
      {
        char* kt_ = smem; char* vt_ = smem + 256 * 208;
        char* kd = kt_ + tl * 208;
#pragma unroll
        for (int tm = 0; tm < 2; ++tm)
#pragma unroll
          for (int q = 0; q < 4; ++q) {
            const int f = tm * 32 + 8 * q + 4 * hh;
            const float4 g = *(const float4*)(p.k_norm_g + f);
            uint2 o; o.x = pk_bf16(acc[tm][0][4 * q] * rk * g.x, acc[tm][0][4 * q + 1] * rk * g.y); o.y = pk_bf16(acc[tm][0][4 * q + 2] * rk * g.z, acc[tm][0][4 * q + 3] * rk * g.w);
            *(uint2*)(kd + f * 2) = o;
          }
#pragma unroll
        for (int q = 0; q < 4; ++q) {
          uint2 o; o.x = pk_bf16(kp[4 * q], kp[4 * q + 1]); o.y = pk_bf16(kp[4 * q + 2], kp[4 * q + 3]);
          *(uint2*)(kd + (64 + 8 * q + 4 * hh) * 2) = o;
        }
#pragma unroll
        for (int tm = 2; tm < 4; ++tm)
#pragma unroll
          for (int i = 0; i < 16; ++i) *(bf16_t*)(vt_ + ((tm - 2) * 32 + crow(i, hh)) * 528 + tl * 2) = f2bf(acc[tm][0][i]);
        lds_sync();
        const int tc_ = tid_();
        bf16_t* Kg = p.K + ((size_t)(b * NH + hd) * NKEY + key0) * QKD;
#pragma unroll
        for (int i = 0; i < 6; ++i) {
          const int id = tc_ + NTH * i, row = id / 12, ch = id % 12;
          *(uint4*)(Kg + row * QKD + ch * 8) = *(const uint4*)(kt_ + row * 208 + ch * 16);
        }
        bf16_t* Vg = p.Vt + (size_t)(b * NH + hd) * VD * NKEY + key0;
#pragma unroll
        for (int i = 0; i < 4; ++i) {
          const int row = (tc_ >> 5) + 16 * i, ch = tc_ & 31;
          *(uint4*)(Vg + (size_t)row * NKEY + ch * 8) = *(const uint4*)(vt_ + row * 528 + ch * 16);
        }
        lds_sync();
      }
    } else if (it < nKV + nQ) {
      const int u = it - nKV;
      const int tokTile = xcd * 32 + (u >> 3), hd = u & 7;
      const bf16_t* Bb = p.pqkv + (size_t)tokTile * 256 * LDQKV;
      const bf16_t* Ab = p.WqT + (size_t)hd * QKD * QL;
      f32x16 acc[3][1];
#pragma unroll
      for (int a = 0; a < 3; ++a) acc[a][0] = zero16();
      float sumsq = 0.f;
      gemm8<3, 1, 1, 8, true>(acc, [&](int row) { return Ab + (size_t)row * QL; }, [&](int row) { return Bb + (size_t)row * LDQKV; }, QL, smem, sumsq);
      sumsq += __shfl_xor(sumsq, 32);
      const float ra = rsqrtf(sumsq * (1.f / QL) + EPS);
      const int tl = w * 32 + r;
      const int b = tokTile >> 3, pos = (tokTile & 7) * 256 + tl;
      float ss = 0.f;
#pragma unroll
      for (int tm = 0; tm < 3; ++tm)
#pragma unroll
        for (int i = 0; i < 16; ++i) { const float v = acc[tm][0][i] * ra; acc[tm][0][i] = v; ss += v * v; }
      ss += __shfl_xor(ss, 32);
      const float rh = rsqrtf(ss * (1.f / QKD) + EPS);
#pragma unroll
      for (int tm = 0; tm < 3; ++tm)
#pragma unroll
        for (int q = 0; q < 4; ++q) {
          const float4 g = *(const float4*)(p.q_norm_g + tm * 32 + 8 * q + 4 * hh);
          acc[tm][0][4 * q] *= rh * g.x; acc[tm][0][4 * q + 1] *= rh * g.y; acc[tm][0][4 * q + 2] *= rh * g.z; acc[tm][0][4 * q + 3] *= rh * g.w;
        }
      {
        const float* tr = p.ropeTab + ((pos >> 6) * 8 + 4 * hh) * 2;
        const float* tc = p.ropeTab + ((pos & 63) * 8 + 4 * hh) * 2;
#pragma unroll
        for (int i = 0; i < 4; ++i) {
          float a0 = acc[2][0][i], a1 = acc[2][0][i + 4], c0 = acc[2][0][8 + i], c1 = acc[2][0][12 + i];
          rope_pair(a0, a1, tr + 2 * i); rope_pair(c0, c1, tc + 2 * i);
          acc[2][0][i] = a0; acc[2][0][i + 4] = a1; acc[2][0][8 + i] = c0; acc[2][0][12 + i] = c1;
        }
      }
      const float qs = 0.10206207261596575f * 1.4426950408889634f;
      {
        char* qd = smem + tl * 208;
#pragma unroll
        for (int tm = 0; tm < 3; ++tm)
#pragma unroll
          for (int q = 0; q < 4; ++q) {
            uint2 o; o.x = pk_bf16(acc[tm][0][4 * q] * qs, acc[tm][0][4 * q + 1] * qs); o.y = pk_bf16(acc[tm][0][4 * q + 2] * qs, acc[tm][0][4 * q + 3] * qs);
            *(uint2*)(qd + (tm * 32 + 8 * q + 4 * hh) * 2) = o;
          }
        lds_sync();
        const int tc_ = tid_();
        bf16_t* Qg = p.Q + ((size_t)(b * NH + hd) * SEQ + (tokTile & 7) * 256) * QKD;
#pragma unroll
        for (int i = 0; i < 6; ++i) {
          const int id = tc_ + NTH * i, row = id / 12, ch = id % 12;
          *(uint4*)(Qg + row * QKD + ch * 8) = *(const uint4*)(smem + row * 208 + ch * 16);
        }
        lds_sync();
      }
    } else {
      const int u = it - nKV - nQ;
      const int tt = u & 7, g = (u >> 3) & 3, b = xcd * 4 + (u >> 5);
      const bf16_t* Tb = p.chanT;
      const bf16_t* Fb = p.pf + (size_t)(b * SEQ + tt * 256) * 512 + g * 128;
      f32x16 acc[4][2];
#pragma unroll
      for (int a = 0; a < 4; ++a)
#pragma unroll
        for (int c = 0; c < 2; ++c) acc[a][c] = zero16();
      float dummy = 0.f;
      gemm8<4, 2, 2, 4, false>(acc, [&](int row) { return Fb + (size_t)row * 512; }, [&](int row) { return Tb + (size_t)row * 128; }, 128, smem, dummy);
      stage_tile<4, 2, 2, 4>(acc, smem, 528, [](float v) { return v; });
      lds_sync();
      bf16_t* dst0 = p.ABt + ((size_t)(b * 512 + g * 128)) * 4096 + tt * 256;
      copy_tile(smem, 528, 256, 5, [&](int row) { return dst0 + (size_t)(row & 127) * 4096 + (row >> 7) * 2048; }, 0, 32);
      lds_sync();
    }
  }
}

DI void attn_item(const Params& p, int it, char* smem) {
  const int t = tid_(), lane = t & 63, w = t >> 6, r = lane & 31, hh = lane >> 5;
  const int qt = it & 7, bh = it >> 3;
  constexpr int KROW = 208, VROW = 136, KBYTES = 64 * KROW, STAGE = KBYTES + 64 * VROW;
  const bf16_t* Kb = p.K + (size_t)bh * NKEY * QKD;
  const bf16_t* Vb = p.Vt + (size_t)bh * VD * NKEY;
  const int qpos = qt * 256 + w * 32 + r;
  const bf16_t* Qp = p.Q + ((size_t)bh * SEQ + qpos) * QKD + hh * 8;
  bf16x8 qf[6];
#pragma unroll
  for (int c = 0; c < 6; ++c) qf[c] = *(const bf16x8*)(Qp + c * 16);
  f32x16 o[2]; o[0] = zero16(); o[1] = zero16();
  float gk = 0.f;
  for (int f = 0; f < QKD; ++f) gk = fmaxf(gk, fabsf(p.k_norm_g[f]));
  float qss = 0.f;
#pragma unroll
  for (int c = 0; c < 6; ++c) {
    const uint4 u = __builtin_bit_cast(uint4, qf[c]);
    const float e0 = bf_lo(u.x), e1 = bf_hi(u.x), e2 = bf_lo(u.y), e3 = bf_hi(u.y), e4 = bf_lo(u.z), e5 = bf_hi(u.z), e6 = bf_lo(u.w), e7 = bf_hi(u.w);
    qss += e0 * e0 + e1 * e1 + e2 * e2 + e3 * e3 + e4 * e4 + e5 * e5 + e6 * e6 + e7 * e7;
  }
  qss += __shfl_xor(qss, 32);
  const float negC = -(sqrtf(qss) * gk * 9.797959f * 1.01f);
  f32x16 sinit;
#pragma unroll
  for (int i = 0; i < 16; ++i) sinit[i] = negC;
  float lrun = 0.f;
  const int kid0 = t, kid1 = (t & 255) + 512;
  const bool k1v = t < 256;
  const int kgo0 = (kid0 / 12) * QKD + (kid0 % 12) * 8, kgo1 = (kid1 / 12) * QKD + (kid1 % 12) * 8;
  const int klo0 = (kid0 / 12) * KROW + (kid0 % 12) * 16, klo1 = (kid1 / 12) * KROW + (kid1 % 12) * 16;
  const int vgo0 = (t >> 3) * NKEY + (t & 7) * 8;
  const int vlo0 = KBYTES + (t >> 3) * VROW + (t & 7) * 16;
  uint4 rk0, rk1, rv0;
  rk0 = *(const uint4*)(Kb + kgo0); rk1 = *(const uint4*)(Kb + kgo1);
  rv0 = *(const uint4*)(Vb + vgo0);
  SB_;
#define ATT_STORE(base) do { \
    *(uint4*)((base) + klo0) = rk0; if (k1v) *(uint4*)((base) + klo1) = rk1; \
    { uint2* d = (uint2*)((base) + vlo0); d[0] = make_uint2(rv0.x, rv0.y); d[1] = make_uint2(rv0.z, rv0.w); } } while (0)
  ATT_STORE(smem);
  __syncthreads();
  constexpr int NKT = NKEY / 64;
  for (int kt = 0; kt < NKT; ++kt) {
    const char* cur = smem + (kt & 1) * STAGE;
    const bool more = kt + 1 < NKT;
    if (more) {
      const bf16_t* kn = Kb + (size_t)(kt + 1) * 64 * QKD; const bf16_t* vn = Vb + (kt + 1) * 64;
      rk0 = *(const uint4*)(kn + kgo0); rk1 = *(const uint4*)(kn + kgo1);
      rv0 = *(const uint4*)(vn + vgo0);
    }
    SB_;
    f32x16 s[2];
#pragma unroll
    for (int t2 = 0; t2 < 2; ++t2) {
      const char* kp = cur + (t2 * 32 + r) * KROW + hh * 16;
      { const bf16x8 kf = *(const bf16x8*)(kp); s[t2] = MFMA(kf, qf[0], sinit); }
#pragma unroll
      for (int c = 1; c < 6; ++c) { const bf16x8 kf = *(const bf16x8*)(kp + c * 32); s[t2] = MFMA(kf, qf[c], s[t2]); }
    }
    SB_;
    float ls = 0.f;
#pragma unroll
    for (int t2 = 0; t2 < 2; ++t2)
#pragma unroll
      for (int i = 0; i < 16; ++i) { const float e = __builtin_amdgcn_exp2f(s[t2][i]); s[t2][i] = e; ls += e; }
    lrun += ls;
    SB_;
#pragma unroll
    for (int t2 = 0; t2 < 2; ++t2)
#pragma unroll
      for (int s2 = 0; s2 < 2; ++s2) {
        uint4 pu;
        pu.x = pk_bf16(s[t2][8 * s2 + 0], s[t2][8 * s2 + 1]); pu.y = pk_bf16(s[t2][8 * s2 + 2], s[t2][8 * s2 + 3]);
        pu.z = pk_bf16(s[t2][8 * s2 + 4], s[t2][8 * s2 + 5]); pu.w = pk_bf16(s[t2][8 * s2 + 6], s[t2][8 * s2 + 7]);
        const bf16x8 pb = __builtin_bit_cast(bf16x8, pu);
#pragma unroll
        for (int vt = 0; vt < 2; ++vt) {
          const char* vp = cur + KBYTES + (vt * 32 + r) * VROW + (t2 * 32 + 16 * s2 + 4 * hh) * 2;
          const uint2 lo = *(const uint2*)(vp), hi = *(const uint2*)(vp + 16);
          uint4 vu; vu.x = lo.x; vu.y = lo.y; vu.z = hi.x; vu.w = hi.y;
          o[vt] = MFMA(__builtin_bit_cast(bf16x8, vu), pb, o[vt]);
        }
      }
    SB_;
    if (more) { char* nxt = smem + ((kt + 1) & 1) * STAGE; ATT_STORE(nxt); }
    __syncthreads();
  }
  lrun += __shfl_xor(lrun, 32);
  const float inv = 1.f / lrun;
  const int b = bh >> 3, hd = bh & 7;
  bf16_t* od = p.attn_o + (size_t)(b * SEQ + qpos) * 512 + hd * 64;
#pragma unroll
  for (int vt = 0; vt < 2; ++vt)
#pragma unroll
    for (int q = 0; q < 4; ++q) {
      uint2 ou; ou.x = pk_bf16(o[vt][4 * q] * inv, o[vt][4 * q + 1] * inv); ou.y = pk_bf16(o[vt][4 * q + 2] * inv, o[vt][4 * q + 3] * inv);
      *(uint2*)(od + vt * 32 + 8 * q + 4 * hh) = ou;
    }
}

DI void phase4(const Params& p, char* smem) {
  const int t = tid_(), lane = t & 63, w = t >> 6, r = lane & 31, hh = lane >> 5;
  const int nDft = 64, nAlt = 4, nAtt = 256;
  const int xcd = blockIdx.x & 7, jl = blockIdx.x >> 3, nl = gridDim.x >> 3;
  for (int it = jl; it < nDft + nAlt + nAtt; it += nl) {
    if (it < nDft) {
      const int bl = it >> 4, rem = it & 15, ct = rem >> 3, kt = rem & 7, b = xcd * 4 + bl;
      const int wm = w & 3, wn = w >> 2;
      const bf16_t* Ab = p.ABt + (size_t)(b * 512 + ct * 256) * 4096;
      const bf16_t* Cb = p.posM + (size_t)kt * 128 * 2048;
      const bf16_t* Sb = p.posM + (size_t)(1152 + kt * 128) * 2048;
      f32x16 acc1[2][2], acc2[2][2];
#pragma unroll
      for (int a = 0; a < 2; ++a)
#pragma unroll
        for (int c = 0; c < 2; ++c) { acc1[a][c] = zero16(); acc2[a][c] = zero16(); }
      float dummy = 0.f;
      gemm8s3(acc1, [&](int row) { return Ab + (size_t)row * 4096; }, [&](int row) { return Cb + (size_t)row * 2048; }, 2048, smem);
      gemm8s3(acc2, [&](int row) { return Ab + (size_t)row * 4096 + 2048; }, [&](int row) { return Sb + (size_t)row * 2048; }, 2048, smem);
      const float sc = 1.f / 512.f;
#pragma unroll
      for (int tm = 0; tm < 2; ++tm)
#pragma unroll
        for (int tn = 0; tn < 2; ++tn) {
          const int kpos = kt * 128 + wn * 64 + tn * 32 + r;
          const int moff = ct * 256 + wm * 64 + tm * 32 + 4 * hh;
          if (kpos <= 1024) {
            bf16_t* d = p.four_o + (size_t)(b * SEQ + kpos) * 512 + moff;
#pragma unroll
            for (int q = 0; q < 4; ++q) {
              uint2 ou; ou.x = pk_bf16((acc1[tm][tn][4 * q] - acc2[tm][tn][4 * q]) * sc, (acc1[tm][tn][4 * q + 1] - acc2[tm][tn][4 * q + 1]) * sc);
              ou.y = pk_bf16((acc1[tm][tn][4 * q + 2] - acc2[tm][tn][4 * q + 2]) * sc, (acc1[tm][tn][4 * q + 3] - acc2[tm][tn][4 * q + 3]) * sc);
              *(uint2*)(d + 8 * q) = ou;
            }
          }
          if (kpos >= 1 && kpos <= 1023) {
            bf16_t* d = p.four_o + (size_t)(b * SEQ + 2048 - kpos) * 512 + moff;
#pragma unroll
            for (int q = 0; q < 4; ++q) {
              uint2 ou; ou.x = pk_bf16((acc1[tm][tn][4 * q] + acc2[tm][tn][4 * q]) * sc, (acc1[tm][tn][4 * q + 1] + acc2[tm][tn][4 * q + 1]) * sc);
              ou.y = pk_bf16((acc1[tm][tn][4 * q + 2] + acc2[tm][tn][4 * q + 2]) * sc, (acc1[tm][tn][4 * q + 3] + acc2[tm][tn][4 * q + 3]) * sc);
              *(uint2*)(d + 8 * q) = ou;
            }
          }
        }
    } else if (it < nDft + nAlt) {
      const int b = xcd * 4 + (it - nDft);
      for (int m = w; m < 512; m += NWV) {
        const bf16_t* rowp = p.ABt + (size_t)(b * 512 + m) * 4096 + lane * 8;
        float sacc = 0.f;
#pragma unroll
        for (int i = 0; i < 4; ++i) {
          const uint4 u = *(const uint4*)(rowp + 512 * i);
          sacc += (bf_lo(u.x) - bf_hi(u.x)) + (bf_lo(u.y) - bf_hi(u.y)) + (bf_lo(u.z) - bf_hi(u.z)) + (bf_lo(u.w) - bf_hi(u.w));
        }
        sacc = wave_sum(sacc);
        if (lane == 0) p.four_o[(size_t)(b * SEQ + 1024) * 512 + m] = f2bf(sacc * (1.f / 512.f));
      }
    } else {
      attn_item(p, xcd * 256 + (it - nDft - nAlt), smem);
    }
  }
}

DI void phase5(const Params& p, char* smem) {
  const int t = tid_();
  const int xcd = blockIdx.x & 7, jl = blockIdx.x >> 3, nl = gridDim.x >> 3;
  for (int L = jl; L < 256; L += nl) {
    const int tokTile = xcd * 64 + (L >> 5) * 8 + (L & 7), nt = (L >> 3) & 3;
    f32x16 acc1[2][2], acc2[2][2];
#pragma unroll
    for (int a = 0; a < 2; ++a)
#pragma unroll
      for (int c = 0; c < 2; ++c) { acc1[a][c] = zero16(); acc2[a][c] = zero16(); }
    float dummy = 0.f;
    {
      const bf16_t* Ab = p.WoT + (size_t)nt * 256 * 512; const bf16_t* Bb = p.attn_o + (size_t)tokTile * 128 * 512;
      gemm8s3(acc1, [&](int row) { return Ab + (size_t)row * 512; }, [&](int row) { return Bb + (size_t)row * 512; }, 512, smem);
    }
    {
      const bf16_t* Ab = p.WfT + (size_t)nt * 256 * 512; const bf16_t* Bb = p.four_o + (size_t)tokTile * 128 * 512;
      gemm8s3(acc2, [&](int row) { return Ab + (size_t)row * 512; }, [&](int row) { return Bb + (size_t)row * 512; }, 512, smem);
    }
    {
      char* t1 = smem; char* t2 = smem + 128 * 528;
      stage_tile<2, 2, 4, 2>(acc1, t1, 528, [](float v) { return v; });
      stage_tile<2, 2, 4, 2>(acc2, t2, 528, [](float v) { return v; });
      lds_sync();
      const int ch = t & 31, r0 = t >> 5;
#pragma unroll
      for (int i = 0; i < 8; ++i) {
        const int row = r0 + 16 * i;
        const size_t tok = (size_t)tokTile * 128 + row;
        const uint4 u1 = *(const uint4*)(t1 + row * 528 + ch * 16), u2 = *(const uint4*)(t2 + row * 528 + ch * 16);
        const uint4 ga = *(const uint4*)(p.pg + tok * 2048 + nt * 256 + ch * 8), gb = *(const uint4*)(p.pg + tok * 2048 + 1024 + nt * 256 + ch * 8);
        uint4 o;
        o.x = pk_bf16(bf_lo(ga.x) * bf_lo(u1.x) + bf_lo(gb.x) * bf_lo(u2.x), bf_hi(ga.x) * bf_hi(u1.x) + bf_hi(gb.x) * bf_hi(u2.x));
        o.y = pk_bf16(bf_lo(ga.y) * bf_lo(u1.y) + bf_lo(gb.y) * bf_lo(u2.y), bf_hi(ga.y) * bf_hi(u1.y) + bf_hi(gb.y) * bf_hi(u2.y));
        o.z = pk_bf16(bf_lo(ga.z) * bf_lo(u1.z) + bf_lo(gb.z) * bf_lo(u2.z), bf_hi(ga.z) * bf_hi(u1.z) + bf_hi(gb.z) * bf_hi(u2.z));
        o.w = pk_bf16(bf_lo(ga.w) * bf_lo(u1.w) + bf_lo(gb.w) * bf_lo(u2.w), bf_hi(ga.w) * bf_hi(u1.w) + bf_hi(gb.w) * bf_hi(u2.w));
        *(uint4*)(p.m + tok * DM + nt * 256 + ch * 8) = o;
      }
      lds_sync();
    }
  }
}

DI void phase6(const Params& p, char* smem) {
  const int t = tid_(), lane = t & 63, w = t >> 6, r = lane & 31, hh = lane >> 5;
  const int wm = w & 1, wn = w >> 1;
  const int xcd = blockIdx.x & 7, jl = blockIdx.x >> 3, nl = gridDim.x >> 3;
  for (int L = jl; L < 128; L += nl) {
    const int tokTile = xcd * 32 + (L >> 5) * 8 + (L & 7), nt = (L >> 3) & 3;
    f32x16 acc[4][2];
#pragma unroll
    for (int a = 0; a < 4; ++a)
#pragma unroll
      for (int c = 0; c < 2; ++c) acc[a][c] = zero16();
    float dummy = 0.f;
    const bf16_t* Wb = p.WoutT + (size_t)nt * 256 * DM; const bf16_t* Mb = p.m + (size_t)tokTile * 256 * DM;
    gemm8<4, 2, 2, 4, false>(acc, [&](int row) { return Wb + (size_t)row * DM; }, [&](int row) { return Mb + (size_t)row * DM; }, DM, smem, dummy);
    const int ch = t & 63, r0 = t >> 6;
    const float4 g = *(const float4*)(p.mod + (tokTile >> 3) * 6144 + 2048 + nt * 256 + ch * 4);
#pragma unroll
    for (int tn = 0; tn < 2; ++tn) {
#pragma unroll
      for (int tm = 0; tm < 4; ++tm) {
        char* d = smem + (wn * 32 + r) * 1040 + (wm * 128 + tm * 32 + 4 * hh) * 4;
#pragma unroll
        for (int q = 0; q < 4; ++q) *(float4*)(d + 32 * q) = make_float4(acc[tm][tn][4 * q], acc[tm][tn][4 * q + 1], acc[tm][tn][4 * q + 2], acc[tm][tn][4 * q + 3]);
      }
      lds_sync();
#pragma unroll 4
      for (int i = 0; i < 16; ++i) {
        const int row = r0 + 8 * i;
        const float4 a = *(const float4*)(smem + row * 1040 + ch * 16);
        const size_t o = ((size_t)tokTile * 256 + (row >> 5) * 64 + tn * 32 + (row & 31)) * DM + nt * 256 + ch * 4;
        const float4 xv = *(const float4*)(p.x + o);
        *(float4*)(p.out + o) = make_float4(xv.x + g.x * a.x, xv.y + g.y * a.y, xv.z + g.z * a.z, xv.w + g.w * a.w);
      }
      lds_sync();
    }
  }
}

DI void phase7(const Params& p, char* smem) {
  const int t = tid_(), lane = t & 63, w = t >> 6;
  float* wr = (float*)smem;
  for (int idx = t; idx < DM * NE; idx += NTH) { const int d = idx >> 4, e = idx & 15; wr[e * DM + d] = p.w_router[idx]; }
  __syncthreads();
  const int gw = blockIdx.x * NWV + w, nw = gridDim.x * NWV;
  auto router = [&](const float4 (&v)[4], int R) {
    asm volatile("" ::: "memory");
    float a[16];
#pragma unroll
    for (int e = 0; e < 16; ++e) {
      float s = 0.f;
#pragma unroll
      for (int i = 0; i < 4; ++i) { const float4 wv = *(const float4*)(wr + e * DM + lane * 4 + 256 * i); s += v[i].x * wv.x + v[i].y * wv.y + v[i].z * wv.z + v[i].w * wv.w; }
      a[e] = s;
      if ((e & 3) == 3) __builtin_amdgcn_sched_barrier(0);
    }
    float a8[8], a4[4], a2[2], a1;
    {
      const bool up = lane & 32;
#pragma unroll
      for (int j = 0; j < 8; ++j) { const float send = up ? a[j] : a[j + 8]; const float keep = up ? a[j + 8] : a[j]; a8[j] = keep + __shfl_xor(send, 32); }
    }
    {
      const bool up = lane & 16;
#pragma unroll
      for (int j = 0; j < 4; ++j) { const float send = up ? a8[j] : a8[j + 4]; const float keep = up ? a8[j + 4] : a8[j]; a4[j] = keep + __shfl_xor(send, 16); }
    }
    {
      const bool up = lane & 8;
#pragma unroll
      for (int j = 0; j < 2; ++j) { const float send = up ? a4[j] : a4[j + 2]; const float keep = up ? a4[j + 2] : a4[j]; a2[j] = keep + __shfl_xor(send, 8); }
    }
    {
      const bool up = lane & 4;
      const float send = up ? a2[0] : a2[1]; const float keep = up ? a2[1] : a2[0]; a1 = keep + __shfl_xor(send, 4);
    }
    a1 += __shfl_xor(a1, 2);
    a1 += __shfl_xor(a1, 1);
    float mx = a1;
#pragma unroll
    for (int o = 4; o <= 32; o <<= 1) mx = fmaxf(mx, __shfl_xor(mx, o));
    const float ex = __expf(a1 - mx);
    float sm = ex;
#pragma unroll
    for (int o = 4; o <= 32; o <<= 1) sm += __shfl_xor(sm, o);
    if ((lane & 3) == 0) {
      const int e = (lane >> 2) & 15;
      p.aff[((size_t)((R >> 11) * NE + e)) * SEQ + (R & 2047)] = ex / sm;
    }
  };
  for (int R0 = gw; R0 < NT; R0 += 2 * nw) {
    const int R1 = R0 + nw;
    const bool has1 = R1 < NT;
    const float* src0 = p.out + (size_t)R0 * DM;
    const float* src1 = p.out + (size_t)(has1 ? R1 : R0) * DM;
    const float* md0 = p.mod + (R0 >> 11) * 6144;
    const float* md1 = p.mod + ((has1 ? R1 : R0) >> 11) * 6144;
    float4 v0[4], v1[4]; float s0 = 0.f, s1 = 0.f;
#pragma unroll
    for (int i = 0; i < 4; ++i) { v0[i] = *(const float4*)(src0 + lane * 4 + 256 * i); v1[i] = *(const float4*)(src1 + lane * 4 + 256 * i); }
#pragma unroll
    for (int i = 0; i < 4; ++i) { s0 += v0[i].x * v0[i].x + v0[i].y * v0[i].y + v0[i].z * v0[i].z + v0[i].w * v0[i].w; s1 += v1[i].x * v1[i].x + v1[i].y * v1[i].y + v1[i].z * v1[i].z + v1[i].w * v1[i].w; }
    s0 = wave_sum(s0); s1 = wave_sum(s1);
    const float r0 = rsqrtf(s0 * (1.f / DM) + EPS), r1 = rsqrtf(s1 * (1.f / DM) + EPS);
#pragma unroll
    for (int i = 0; i < 4; ++i) {
      const int d = lane * 4 + 256 * i;
      const float4 g = *(const float4*)(p.norm2_g + d);
      {
        const float4 sh = *(const float4*)(md0 + 3072 + d), sc = *(const float4*)(md0 + 4096 + d);
        v0[i].x = v0[i].x * r0 * g.x * (1.f + sc.x) + sh.x; v0[i].y = v0[i].y * r0 * g.y * (1.f + sc.y) + sh.y;
        v0[i].z = v0[i].z * r0 * g.z * (1.f + sc.z) + sh.z; v0[i].w = v0[i].w * r0 * g.w * (1.f + sc.w) + sh.w;
        uint2 o; o.x = pk_bf16(v0[i].x, v0[i].y); o.y = pk_bf16(v0[i].z, v0[i].w);
        *(uint2*)(p.h2 + (size_t)R0 * DM + d) = o;
      }
      if (has1) {
        const float4 sh = *(const float4*)(md1 + 3072 + d), sc = *(const float4*)(md1 + 4096 + d);
        v1[i].x = v1[i].x * r1 * g.x * (1.f + sc.x) + sh.x; v1[i].y = v1[i].y * r1 * g.y * (1.f + sc.y) + sh.y;
        v1[i].z = v1[i].z * r1 * g.z * (1.f + sc.z) + sh.z; v1[i].w = v1[i].w * r1 * g.w * (1.f + sc.w) + sh.w;
        uint2 o; o.x = pk_bf16(v1[i].x, v1[i].y); o.y = pk_bf16(v1[i].z, v1[i].w);
        *(uint2*)(p.h2 + (size_t)R1 * DM + d) = o;
      }
    }
    SB_;
    router(v0, R0);
    SB_;
    if (has1) router(v1, R1);
    SB_;
  }
}

DI void phase8(const Params& p) {
  const int t_ = tid_(); const int lane = t_ & 63, w = t_ >> 6;
  const int gw = blockIdx.x * NWV + w, nw = gridDim.x * NWV;
  for (int pr = gw; pr < NB * NE; pr += nw) {
    const float* a = p.aff + (size_t)pr * SEQ;
    unsigned u[32];
#pragma unroll
    for (int q = 0; q < 32; ++q) u[q] = __float_as_uint(a[q * 64 + lane]);
    unsigned thr = 0;
    for (int bit = 30; bit >= 0; --bit) {
      const unsigned cand = thr | (1u << bit);
      int cnt = 0;
#pragma unroll
      for (int q = 0; q < 32; ++q) cnt += __popcll(__ballot(u[q] >= cand));
      if (cnt >= CAP) thr = cand;
    }
    int ngt = 0;
#pragma unroll
    for (int q = 0; q < 32; ++q) ngt += __popcll(__ballot(u[q] > thr));
    int cgt = 0, ceq = 0;
    int* io = p.idx + pr * CAP; float* go = p.gate + pr * CAP;
    int* iv = p.inv + (size_t)pr * SEQ;
#pragma unroll
    for (int q = 0; q < 32; ++q) {
      const bool gt = u[q] > thr, eq = u[q] == thr;
      const unsigned long long mg = __ballot(gt), me = __ballot(eq);
      const unsigned long long below = (1ull << lane) - 1ull;
      int myslot = -1;
      if (gt) { const int s = cgt + __popcll(mg & below); io[s] = q * 64 + lane; go[s] = __uint_as_float(u[q]); myslot = s; }
      if (eq) { const int s = ngt + ceq + __popcll(me & below); if (s < CAP) { io[s] = q * 64 + lane; go[s] = __uint_as_float(u[q]); myslot = s; } }
      iv[q * 64 + lane] = myslot;
      cgt += __popcll(mg); ceq += __popcll(me);
    }
  }
}

DI void phase9(const Params& p, char* smem) {
  const int t = tid_(), lane = t & 63, w = t >> 6, r = lane & 31, hh = lane >> 5;
  const int wm = w & 1, wn = w >> 1;
  const int xcd = blockIdx.x & 7, jl = blockIdx.x >> 3, nl = gridDim.x >> 3;
  auto decode = [&](int L, int& e, int& ft, int& b) { e = xcd * 2 + (L >> 7); const int rem = L & 127; ft = (rem >> 3) & 3; b = (rem >> 5) * 8 + (rem & 7); };
  bool pre = false;
  for (int L = jl; L < 256; L += nl) {
    int e, ft, b, eN = 0, ftN = 0, bN = 0;
    decode(L, e, ft, b);
    const int Ln = L + nl; const bool hasNext = Ln < 256;
    if (hasNext) decode(Ln, eN, ftN, bN);
    const int be = b * NE + e;
    const bf16_t* Ab = p.WguT + ((size_t)e * 1024 + ft * 256) * DM;
    const int* ib = p.idx + be * CAP;
    const bf16_t* hb = p.h2 + (size_t)b * SEQ * DM;
    const bf16_t* AbN = p.WguT + ((size_t)eN * 1024 + ftN * 256) * DM;
    const int* ibN = p.idx + (bN * NE + eN) * CAP;
    const bf16_t* hbN = p.h2 + (size_t)bN * SEQ * DM;
    f32x16 acc[4][2];
#pragma unroll
    for (int a = 0; a < 4; ++a)
#pragma unroll
      for (int c = 0; c < 2; ++c) acc[a][c] = zero16();
    float dummy = 0.f;
    gemm8x<4, 2, 2, 4, false, 2>(acc, [&](int row) { return Ab + (size_t)row * DM; }, [&](int row) { return hb + (size_t)ib[row] * DM; }, DM, smem, dummy,
                              pre, hasNext, [&](int row) { return AbN + (size_t)row * DM; }, [&](int row) { return hbN + (size_t)ibN[row] * DM; });
    pre = hasNext;
    char* tile = smem + EPI_OFF;
#pragma unroll
    for (int tn = 0; tn < 2; ++tn)
#pragma unroll
      for (int pr = 0; pr < 2; ++pr) {
        char* d = tile + (wn * 64 + tn * 32 + r) * 272 + (wm * 64 + pr * 32 + 4 * hh) * 2;
#pragma unroll
        for (int q = 0; q < 4; ++q) {
          float v[4];
#pragma unroll
          for (int j = 0; j < 4; ++j) { const float g = acc[2 * pr][tn][4 * q + j], uu = acc[2 * pr + 1][tn][4 * q + j]; v[j] = g * sigmoidf_(g) * uu; }
          uint2 ou; ou.x = pk_bf16(v[0], v[1]); ou.y = pk_bf16(v[2], v[3]);
          *(uint2*)(d + 16 * q) = ou;
        }
      }
    lds_sync();
    bf16_t* hd_ = p.hmid + (size_t)be * CAP * DE + ft * 128;
    copy_tile(tile, 272, 256, 4, [&](int row) { return hd_ + (size_t)row * DE; }, 0, 16);
  }
}

DI void phase10(const Params& p, char* smem) {
  const int xcd = blockIdx.x & 7, jl = blockIdx.x >> 3, nl = gridDim.x >> 3;
  for (int L = jl; L < 512; L += nl) {
    const int e = xcd * 2 + (L >> 8), rem = L & 255, nt = (rem >> 3) & 3, st = (rem >> 5) & 1, b = (rem >> 6) * 8 + (rem & 7);
    const int be = b * NE + e;
    const bf16_t* Hb = p.hmid + ((size_t)be * CAP + st * 128) * DE;
    const bf16_t* Wb = p.WdT + ((size_t)e * DM + nt * 256) * DE;
    f32x16 acc[2][2];
#pragma unroll
    for (int a = 0; a < 2; ++a)
#pragma unroll
      for (int c = 0; c < 2; ++c) acc[a][c] = zero16();
    gemm8s3(acc, [&](int row) { return Wb + (size_t)row * DE; }, [&](int row) { return Hb + (size_t)row * DE; }, DE, smem);
    stage_tile<2, 2, 4, 2>(acc, smem, 528, [](float v) { return v; });
    lds_sync();
    bf16_t* yb = p.Y + ((size_t)be * CAP + st * 128) * DM + nt * 256;
    copy_tile(smem, 528, 128, 5, [&](int row) { return yb + (size_t)row * DM; }, 0, 32);
    lds_sync();
  }
}

DI void phase11(const Params& p) {
  const int t_ = tid_(); const int lane = t_ & 63, w = t_ >> 6;
  const int gw = blockIdx.x * NWV + w, nw = gridDim.x * NWV;
  for (int R = gw; R < NT; R += nw) {
    const int b = R >> 11, tq = R & 2047;
    const int myslot = (lane < NE) ? p.inv[((size_t)(b * NE + lane)) * SEQ + tq] : -1;
    unsigned long long mask = __ballot(myslot >= 0);
    if (mask == 0ull) continue;
    float* o = p.out + (size_t)R * DM;
    float4 xv[4];
#pragma unroll
    for (int i = 0; i < 4; ++i) xv[i] = *(const float4*)(o + lane * 4 + 256 * i);
    float4 a[4];
#pragma unroll
    for (int i = 0; i < 4; ++i) a[i] = make_float4(0.f, 0.f, 0.f, 0.f);
    while (mask) {
      const int e = __ffsll((long long)mask) - 1; mask &= mask - 1ull;
      const int slot = __shfl(myslot, e);
      const float g = p.gate[(b * NE + e) * CAP + slot];
      const bf16_t* y = p.Y + ((size_t)(b * NE + e) * CAP + slot) * DM + lane * 4;
#pragma unroll
      for (int i = 0; i < 4; ++i) {
        const uint2 u = *(const uint2*)(y + 256 * i);
        a[i].x += g * bf_lo(u.x); a[i].y += g * bf_hi(u.x); a[i].z += g * bf_lo(u.y); a[i].w += g * bf_hi(u.y);
      }
    }
    const float* g2 = p.mod + b * 6144 + 5120;
#pragma unroll
    for (int i = 0; i < 4; ++i) {
      const int d = lane * 4 + 256 * i;
      const float4 gv = *(const float4*)(g2 + d);
      *(float4*)(o + d) = make_float4(xv[i].x + gv.x * a[i].x, xv[i].y + gv.y * a[i].y, xv[i].z + gv.z * a[i].z, xv[i].w + gv.w * a[i].w);
    }
  }
}

__global__ void __launch_bounds__(NTH, 2) mega_kernel(Params p) {
  cg::grid_group grid = cg::this_grid();
  __shared__ __attribute__((aligned(16))) char smem[SMEM_BYTES];
#ifndef REPMASK
#define REPMASK 0
#endif
#define RUNPH(k, call) for (int rep_ = 0; rep_ < (((REPMASK) >> (k)) & 1) + 1; ++rep_) { call; grid.sync(); }
  RUNPH(0, phase0(p, smem))
  RUNPH(1, phase1(p))
  RUNPH(2, phase2(p, smem))
  RUNPH(3, phase3(p, smem))
  RUNPH(4, phase4(p, smem))
  RUNPH(5, phase5(p, smem))
  RUNPH(6, phase6(p, smem))
  RUNPH(7, phase7(p, smem))
  RUNPH(8, phase8(p))
  RUNPH(9, phase9(p, smem))
  RUNPH(10, phase10(p, smem))
  phase11(p);
}

static inline size_t align_up(size_t v, size_t a) { return (v + a - 1) / a * a; }

extern "C" void kernel_launch(void* const* d_in, const int* in_sizes, int n_in,
                              void* d_out, int out_size, void* d_ws, size_t ws_size,
                              hipStream_t stream) {
  static int grid_blocks = 0;
  if (!grid_blocks) {
    int dev = 0, cus = 0, per_cu = 0;
    (void)hipGetDevice(&dev);
    (void)hipDeviceGetAttribute(&cus, hipDeviceAttributeMultiprocessorCount, dev);
    (void)hipOccupancyMaxActiveBlocksPerMultiprocessor(&per_cu, mega_kernel, NTH, 0);
    if (per_cu > 1) per_cu = 1;
    if (per_cu < 1) per_cu = 1;
    grid_blocks = (cus * per_cu) & ~7;
    if (grid_blocks < 8) grid_blocks = 8;
  }
  Params p;
  memset(&p, 0, sizeof(p));
  p.x = (const float*)d_in[0]; p.c = (const float*)d_in[1]; p.ctx = (const float*)d_in[2]; p.c_ctx = (const float*)d_in[3];
  p.w_mod = (const float*)d_in[4]; p.b_mod = (const float*)d_in[5]; p.norm1_g = (const float*)d_in[6];
  const float* w_in = (const float*)d_in[7];
  const float* q_a_g = (const float*)d_in[8];
  const float* kv_a_g = (const float*)d_in[9];
  const float* w_q_up = (const float*)d_in[10];
  const float* w_kv_up = (const float*)d_in[11];
  p.q_norm_g = (const float*)d_in[12]; p.k_norm_g = (const float*)d_in[13];
  const float* w_o_attn = (const float*)d_in[14];
  const float* w_fourier = (const float*)d_in[15];
  const float* w_out = (const float*)d_in[16];
  p.norm2_g = (const float*)d_in[17]; p.w_router = (const float*)d_in[18];
  const float* w_e_gate = (const float*)d_in[19];
  const float* w_e_up = (const float*)d_in[20];
  const float* w_e_down = (const float*)d_in[21];
  p.out = (float*)d_out;

  char* base = (char*)d_ws; size_t off = 0;
  auto alloc = [&](size_t bytes) { char* q = base + off; off = align_up(off + bytes, 256); return q; };
  p.WinT = (bf16_t*)alloc((size_t)NINP * DM * 2);
  p.WqT = (bf16_t*)alloc((size_t)768 * QL * 2);
  p.WkvT = (bf16_t*)alloc((size_t)1024 * KVL * 2);
  p.WoT = (bf16_t*)alloc((size_t)DM * 512 * 2);
  p.WfT = (bf16_t*)alloc((size_t)DM * 512 * 2);
  p.WoutT = (bf16_t*)alloc((size_t)DM * DM * 2);
  p.WguT = (bf16_t*)alloc((size_t)NE * 1024 * DM * 2);
  p.WdT = (bf16_t*)alloc((size_t)NE * DM * DE * 2);
  p.chanT = (bf16_t*)alloc((size_t)256 * 128 * 2);
  p.posM = (bf16_t*)alloc((size_t)2 * 1152 * 2048 * 2);
  p.ropeTab = (float*)alloc(64 * 8 * 2 * 4);
  p.mod = (float*)alloc(33 * 6144 * 4);
  p.aff = (float*)alloc((size_t)NB * NE * SEQ * 4);
  p.gate = (float*)alloc((size_t)NB * NE * CAP * 4);
  p.idx = (int*)alloc((size_t)NB * NE * CAP * 4);
  p.inv = (int*)alloc((size_t)NB * NE * SEQ * 4);
  p.pckv = (bf16_t*)alloc((size_t)NC * LDCKV * 2 + 4096);
  char* regA = alloc((size_t)(NT + NC) * DM * 2);
  p.h = (bf16_t*)regA; p.ABt = (bf16_t*)regA; p.h2 = (bf16_t*)regA;
  char* regB1 = alloc((size_t)NT * LDQKV * 2);
  p.pqkv = (bf16_t*)regB1; p.attn_o = (bf16_t*)regB1;
  char* regB2 = alloc((size_t)NT * 512 * 2);
  p.pf = (bf16_t*)regB2; p.four_o = (bf16_t*)regB2;
  p.pg = (bf16_t*)alloc((size_t)NT * 2048 * 2);
  p.Y = p.pg;
  const size_t szQ = (size_t)NB * NH * SEQ * QKD * 2, szK = (size_t)NB * NH * NKEY * QKD * 2, szV = (size_t)NB * NH * VD * NKEY * 2;
  char* regC = alloc(szQ + szK + szV + 1024);
  p.Q = (bf16_t*)regC; p.K = (bf16_t*)(regC + align_up(szQ, 256)); p.Vt = (bf16_t*)(regC + align_up(szQ, 256) + align_up(szK, 256));
  p.m = (bf16_t*)regC; p.hmid = (bf16_t*)(regC + (size_t)NT * DM * 2);
  if (off > ws_size) { fprintf(stderr, "workspace too small: need %zu have %zu\n", off, ws_size); return; }

  int ts = 0;
  auto job = [&](int i, const float* src, bf16_t* dst, const float* scale, int K, int ldS, int n_off, int n_cnt, int dst_row0, int mode, int batch, long sbs, long dbs) {
    TJob& j = p.jobs[i];
    j.src = src; j.dst = dst; j.scale = scale; j.K = K; j.ldS = ldS; j.n_off = n_off; j.n_cnt = n_cnt; j.dst_row0 = dst_row0; j.mode = mode; j.batch = batch;
    j.tiles_n = (n_cnt + 63) / 64; j.tile_start = ts; j.src_bstride = sbs; j.dst_bstride = dbs;
    ts += batch * (K / 64) * j.tiles_n;
  };
  job(0, w_e_gate, p.WguT, nullptr, DM, DE, 0, DE, 0, 1, NE, (long)DM * DE, (long)1024 * DM);
  job(1, w_e_up, p.WguT, nullptr, DM, DE, 0, DE, 0, 2, NE, (long)DM * DE, (long)1024 * DM);
  job(2, w_e_down, p.WdT, nullptr, DE, DM, 0, DM, 0, 0, NE, (long)DE * DM, (long)DM * DE);
  job(3, w_in, p.WinT, nullptr, DM, N_IN, 0, 672, 0, 0, 1, 0, 0);
  job(4, w_in, p.WinT, nullptr, DM, N_IN, 672, 2560, 768, 0, 1, 0, 0);
  job(5, w_q_up, p.WqT, q_a_g, QL, 768, 0, 768, 0, 0, 1, 0, 0);
  job(6, w_kv_up, p.WkvT, kv_a_g, KVL, 1024, 0, 1024, 0, 0, 1, 0, 0);
  job(7, w_o_attn, p.WoT, nullptr, 512, DM, 0, DM, 0, 0, 1, 0, 0);
  job(8, w_fourier, p.WfT, nullptr, 512, DM, 0, DM, 0, 0, 1, 0, 0);
  job(9, w_out, p.WoutT, nullptr, DM, DM, 0, DM, 0, 0, 1, 0, 0);
  p.n_ttiles = ts;

  void* args[] = {&p};
  hipError_t e = hipLaunchCooperativeKernel((void*)mega_kernel, dim3(grid_blocks), dim3(NTH), args, 0, stream);
  if (e != hipSuccess) fprintf(stderr, "cooperative launch failed: %s (grid %d)\n", hipGetErrorString(e), grid_blocks);
}
```

```cpp
#include <hip/hip_runtime.h>
#include <hip/hip_cooperative_groups.h>
#include <cstdio>
#include <cstring>
#include <cstdint>
namespace cg = cooperative_groups;

#define DI __device__ __forceinline__
typedef unsigned short bf16_t;
typedef short bf16x8 __attribute__((ext_vector_type(8)));
typedef float f32x16 __attribute__((ext_vector_type(16)));
#define MFMA(a, b, c) __builtin_amdgcn_mfma_f32_32x32x16_bf16((a), (b), (c), 0, 0, 0)

constexpr int NB = 32, SEQ = 2048, DM = 1024, NT = NB * SEQ, CTXL = 256, NC = NB * CTXL;
constexpr int NH = 8, QKD = 96, VD = 64, QL = 384, KVL = 256, NKEY = SEQ + CTXL;
constexpr int N_IN = 3232, NINP = 3328;
constexpr int NE = 16, DE = 512, CAP = 256;
constexpr float EPS = 1e-6f;
constexpr int LDQKV = 672, LDCKV = 288;
constexpr int NTH = 512, NWV = 8;
constexpr int SMEM_BYTES = 147456;

struct TJob {
  const float* src; bf16_t* dst; const float* scale;
  int K, ldS, n_off, n_cnt, dst_row0, mode, batch, tiles_n, tile_start, pad0;
  long src_bstride, dst_bstride;
};
constexpr int NJOBS = 10;

struct Params {
  const float *x, *c, *ctx, *c_ctx, *w_mod, *b_mod, *norm1_g, *q_norm_g, *k_norm_g, *norm2_g, *w_router;
  float* out;
  bf16_t *WinT, *WqT, *WkvT, *WoT, *WfT, *WoutT, *WguT, *WdT, *chanT, *posM;
  float *ropeTab, *mod;
  bf16_t *h, *pqkv, *pckv, *pf, *pg, *Q, *K, *Vt, *attn_o, *ABt, *four_o, *m, *h2, *hmid;
  float *aff, *gate;
  int* idx;
  int* inv;
  bf16_t* Y;
  TJob jobs[NJOBS];
  int n_ttiles, pad1;
};

typedef float f32x2v __attribute__((ext_vector_type(2)));
typedef __bf16 bf16x2v __attribute__((ext_vector_type(2)));
DI unsigned pk_bf16(float lo, float hi) { f32x2v v = {lo, hi}; bf16x2v b = __builtin_convertvector(v, bf16x2v); return __builtin_bit_cast(unsigned, b); }
DI int tid_() { int t = threadIdx.x; asm volatile("" : "+v"(t)); return t; }
DI float bf_lo(unsigned u) { return __uint_as_float(u << 16); }
DI float bf_hi(unsigned u) { return __uint_as_float(u & 0xffff0000u); }
DI bf16_t f2bf(float f) { return (bf16_t)(pk_bf16(f, 0.f) & 0xffffu); }
DI float sigmoidf_(float x) { return 1.f / (1.f + __expf(-x)); }
DI int crow(int i, int hh) { return (i & 3) + 8 * (i >> 2) + 4 * hh; }
DI float wave_sum(float v) {
#pragma unroll
  for (int o = 32; o >= 1; o >>= 1) v += __shfl_xor(v, o);
  return v;
}
DI f32x16 zero16() { f32x16 z;
#pragma unroll
  for (int i = 0; i < 16; ++i) z[i] = 0.f; return z; }
DI void wait_vm0() { asm volatile("s_waitcnt vmcnt(0)" ::: "memory"); }
DI void wait_lgkm0() { asm volatile("s_waitcnt lgkmcnt(0)" ::: "memory"); }
DI void bar_() { __builtin_amdgcn_s_barrier(); }
DI void lds_sync() { wait_lgkm0(); bar_(); }
#define GLDS(gp, lp) __builtin_amdgcn_global_load_lds((const unsigned*)(gp), (__attribute__((address_space(3))) unsigned*)(lp), 16, 0, 0)
#define SB_ __builtin_amdgcn_sched_barrier(0)

constexpr int EPI_OFF = 65536;
template <int TM, int TN, int WM, int WN, bool SUMSQ, int NST, class AF, class BF, class AFN, class BFN>
DI void gemm8x(f32x16 (&acc)[TM][TN], AF arow, BF brow, int K, char* smem, float& sumsq, bool pre, bool hasNext, AFN arowN, BFN browN) {
  constexpr int RA = 32 * TM * WM, RB = 32 * TN * WN;
  constexpr int LDR = 128, STAGE = (RA + RB) * LDR;
  static_assert(WM * WN == NWV, "waves");
  static_assert(NST * STAGE <= SMEM_BYTES, "smem");
  static_assert(NST == 2 || (NST == 3 && RA == 256 && RB == 128), "3-stage ring: 6 loads per thread per stage assumed");
  static_assert(RA <= 256 && RB <= 256 && RA % 32 == 0 && RB % 32 == 0, "shape");
  const int t = tid_(), lane = t & 63, w = t >> 6, r = lane & 31, hh = lane >> 5;
  const int wm = w % WM, wn = w / WM;
  const int row0 = t >> 3;
  const int c = (t & 7) ^ ((row0 >> 1) & 7);
  const bool a0v = row0 < RA, a1v = row0 + 64 < RA, a2v = row0 + 128 < RA, a3v = row0 + 192 < RA;
  const bool b0v = row0 < RB, b1v = row0 + 64 < RB, b2v = row0 + 128 < RB, b3v = row0 + 192 < RB;
  const bf16_t* pa0 = arow(a0v ? row0 : 0) + c * 8;
  const bf16_t* pa1 = arow(a1v ? row0 + 64 : 0) + c * 8;
  const bf16_t* pa2 = arow(a2v ? row0 + 128 : 0) + c * 8;
  const bf16_t* pa3 = arow(a3v ? row0 + 192 : 0) + c * 8;
  const bf16_t* pb0 = brow(b0v ? row0 : 0) + c * 8;
  const bf16_t* pb1 = brow(b1v ? row0 + 64 : 0) + c * 8;
  const bf16_t* pb2 = brow(b2v ? row0 + 128 : 0) + c * 8;
  const bf16_t* pb3 = brow(b3v ? row0 + 192 : 0) + c * 8;
  if (!pre) {
    char* l_ = smem + t * 16; char* m_ = l_ + RA * LDR;
    if (a0v) GLDS(pa0, l_); if (a1v) GLDS(pa1, l_ + 8192); if (a2v) GLDS(pa2, l_ + 16384); if (a3v) GLDS(pa3, l_ + 24576);
    if (b0v) GLDS(pb0, m_); if (b1v) GLDS(pb1, m_ + 8192); if (b2v) GLDS(pb2, m_ + 16384); if (b3v) GLDS(pb3, m_ + 24576);
  }
  if (NST == 3) {
    char* l_ = smem + STAGE + t * 16; char* m_ = l_ + RA * LDR;
    GLDS(pa0 + 64, l_); GLDS(pa1 + 64, l_ + 8192); GLDS(pa2 + 64, l_ + 16384); GLDS(pa3 + 64, l_ + 24576);
    GLDS(pb0 + 64, m_); GLDS(pb1 + 64, m_ + 8192);
    asm volatile("s_waitcnt vmcnt(6)" ::: "memory");
  } else wait_vm0();
  bar_();
  const int nk = K >> 6;
  const int sw = (r >> 1) & 7;
  const int aoff = (wm * TM * 32 + r) * LDR, boff = RA * LDR + (wn * TN * 32 + r) * LDR;
  auto compute = [&](const char* cur, char* nxt, bool issue, const bf16_t* q0, const bf16_t* q1, const bf16_t* q2, const bf16_t* q3,
                     const bf16_t* s0, const bf16_t* s1, const bf16_t* s2, const bf16_t* s3) {
    const char* As = cur + aoff;
    const char* Bs = cur + boff;
    char* l_ = nxt + t * 16; char* m_ = l_ + RA * LDR;
    bf16x8 a0[TM], b0[TN], a1[TM], b1[TN];
#define LOADF(A_, B_, ks) do { const int po_ = (((ks) * 2 + hh) ^ sw) * 16; \
      _Pragma("unroll") for (int tm = 0; tm < TM; ++tm) A_[tm] = *(const bf16x8*)(As + tm * 32 * LDR + po_); \
      _Pragma("unroll") for (int tn = 0; tn < TN; ++tn) B_[tn] = *(const bf16x8*)(Bs + tn * 32 * LDR + po_); } while (0)
#define MMF(A_, B_) do { if (SUMSQ) { uint4 u = __builtin_bit_cast(uint4, B_[0]); \
        float e0 = bf_lo(u.x), e1 = bf_hi(u.x), e2 = bf_lo(u.y), e3 = bf_hi(u.y), e4 = bf_lo(u.z), e5 = bf_hi(u.z), e6 = bf_lo(u.w), e7 = bf_hi(u.w); \
        sumsq += e0 * e0 + e1 * e1 + e2 * e2 + e3 * e3 + e4 * e4 + e5 * e5 + e6 * e6 + e7 * e7; } \
      _Pragma("unroll") for (int tm = 0; tm < TM; ++tm) _Pragma("unroll") for (int tn = 0; tn < TN; ++tn) acc[tm][tn] = MFMA(A_[tm], B_[tn], acc[tm][tn]); } while (0)
    LOADF(a0, b0, 0);
    LOADF(a1, b1, 1);
    SB_;
    if (issue) { if (a0v) GLDS(q0, l_); if (a1v) GLDS(q1, l_ + 8192); }
    SB_;
    __builtin_amdgcn_s_setprio(1);
    MMF(a0, b0);
    LOADF(a0, b0, 2);
    SB_;
    if (issue) { if (a2v) GLDS(q2, l_ + 16384); if (a3v) GLDS(q3, l_ + 24576); }
    SB_;
    MMF(a1, b1);
    LOADF(a1, b1, 3);
    SB_;
    if (issue) { if (b0v) GLDS(s0, m_); if (b1v) GLDS(s1, m_ + 8192); }
    SB_;
    MMF(a0, b0);
    SB_;
    if (issue) { if (b2v) GLDS(s2, m_ + 16384); if (b3v) GLDS(s3, m_ + 24576); }
    SB_;
    MMF(a1, b1);
    __builtin_amdgcn_s_setprio(0);
  };
  int sc_ = 0;
  for (int kt = 0; kt < nk - 1; ++kt) {
    SB_;
    if (NST == 2) {
      const int ko = (kt + 1) * 64;
      compute(smem + (kt & 1) * STAGE, smem + ((kt + 1) & 1) * STAGE, true, pa0 + ko, pa1 + ko, pa2 + ko, pa3 + ko, pb0 + ko, pb1 + ko, pb2 + ko, pb3 + ko);
      SB_;
      wait_vm0(); bar_();
    } else {
      const int ko = (kt + 2) * 64; const bool iss = kt + 2 < nk;
      const int sn = (sc_ == 0) ? 2 : sc_ - 1;
      compute(smem + sc_ * STAGE, smem + sn * STAGE, iss, pa0 + ko, pa1 + ko, pa2 + ko, pa3 + ko, pb0 + ko, pb1 + ko, pb2 + ko, pb3 + ko);
      SB_;
      if (iss) asm volatile("s_waitcnt vmcnt(6)" ::: "memory"); else wait_vm0();
      bar_();
      sc_ = (sc_ == 2) ? 0 : sc_ + 1;
    }
  }
  if (NST == 3) {
    SB_;
    compute(smem + sc_ * STAGE, smem, false, pa0, pa0, pa0, pa0, pa0, pa0, pa0, pa0);
    SB_;
    lds_sync();
  } else {
    const bf16_t *q0 = pa0, *q1 = pa0, *q2 = pa0, *q3 = pa0, *s0 = pa0, *s1 = pa0, *s2 = pa0, *s3 = pa0;
    if (hasNext) {
      q0 = arowN(a0v ? row0 : 0) + c * 8; q1 = arowN(a1v ? row0 + 64 : 0) + c * 8; q2 = arowN(a2v ? row0 + 128 : 0) + c * 8; q3 = arowN(a3v ? row0 + 192 : 0) + c * 8;
      s0 = browN(b0v ? row0 : 0) + c * 8; s1 = browN(b1v ? row0 + 64 : 0) + c * 8; s2 = browN(b2v ? row0 + 128 : 0) + c * 8; s3 = browN(b3v ? row0 + 192 : 0) + c * 8;
    }
    SB_;
    compute(smem + ((nk - 1) & 1) * STAGE, smem, hasNext, q0, q1, q2, q3, s0, s1, s2, s3);
    SB_;
    lds_sync();
  }
}
template <int TM, int TN, int WM, int WN, bool SUMSQ, class AF, class BF>
DI void gemm8(f32x16 (&acc)[TM][TN], AF arow, BF brow, int K, char* smem, float& sumsq) {
  gemm8x<TM, TN, WM, WN, SUMSQ, 2>(acc, arow, brow, K, smem, sumsq, false, false, arow, brow);
}
template <class AF, class BF>
DI void gemm8s3(f32x16 (&acc)[2][2], AF arow, BF brow, int K, char* smem) {
  float dummy = 0.f;
  gemm8x<2, 2, 4, 2, false, 3>(acc, arow, brow, K, smem, dummy, false, false, arow, brow);
}
template <int TM, int WM, int WN, int TNSEL, class F>
DI void stage_half(const f32x16 (&acc)[TM][2], char* tile, int pitch, F f) {
  const int t = tid_(), lane = t & 63, w = t >> 6, r = lane & 31, hh = lane >> 5;
  const int wm = w % WM, wn = w / WM;
#pragma unroll
  for (int tm = 0; tm < TM; ++tm) {
    char* d = tile + (wn * 32 + r) * pitch + (wm * TM * 32 + tm * 32 + 4 * hh) * 2;
#pragma unroll
    for (int q = 0; q < 4; ++q) {
      const f32x16& a = acc[tm][TNSEL];
      uint2 o; o.x = pk_bf16(f(a[4 * q]), f(a[4 * q + 1])); o.y = pk_bf16(f(a[4 * q + 2]), f(a[4 * q + 3]));
      *(uint2*)(d + 16 * q) = o;
    }
  }
}

template <int TM, int TN, int WM, int WN, class F>
DI void stage_tile(const f32x16 (&acc)[TM][TN], char* tile, int pitch, F f) {
  const int t = tid_(), lane = t & 63, w = t >> 6, r = lane & 31, hh = lane >> 5;
  const int wm = w % WM, wn = w / WM;
#pragma unroll
  for (int tm = 0; tm < TM; ++tm)
#pragma unroll
    for (int tn = 0; tn < TN; ++tn) {
      char* d = tile + (wn * TN * 32 + tn * 32 + r) * pitch + (wm * TM * 32 + tm * 32 + 4 * hh) * 2;
#pragma unroll
      for (int q = 0; q < 4; ++q) {
        uint2 o; o.x = pk_bf16(f(acc[tm][tn][4 * q]), f(acc[tm][tn][4 * q + 1])); o.y = pk_bf16(f(acc[tm][tn][4 * q + 2]), f(acc[tm][tn][4 * q + 3]));
        *(uint2*)(d + 16 * q) = o;
      }
    }
}
template <class RF>
DI void copy_tile(const char* tile, int pitch, int rows, int lch, RF dst, int ch0, int ch1) {
  const int t = tid_();
  const int total = rows << lch;
  for (int id = t; id < total; id += NTH) {
    const int row = id >> lch, ch = id & ((1 << lch) - 1);
    if (ch >= ch0 && ch < ch1) *(uint4*)(dst(row) + ch * 8) = *(const uint4*)(tile + row * pitch + ch * 16);
  }
}

DI void transpose_tile(const TJob& j, int tile, char* smem) {
  const int t = tid_();
  const int tpb = (j.K >> 6) * j.tiles_n;
  const int bi = tile / tpb, rem = tile % tpb;
  const int kt = rem / j.tiles_n, ntile = rem % j.tiles_n;
  const int k0 = kt * 64, n0 = ntile * 64;
  const float* src = j.src + (size_t)bi * j.src_bstride;
  bf16_t* dst = j.dst + (size_t)bi * j.dst_bstride;
  bf16_t* T = (bf16_t*)smem;
  const int nn = t & 63, kq = t >> 6;
  const bool nvalid = (n0 + nn) < j.n_cnt;
  __syncthreads();
#pragma unroll 4
  for (int i = 0; i < 8; ++i) {
    const int kk = kq + 8 * i;
    float v = 0.f;
    if (nvalid) {
      v = src[(size_t)(k0 + kk) * j.ldS + j.n_off + n0 + nn];
      if (j.scale) v *= j.scale[k0 + kk];
    }
    T[nn * 66 + kk] = f2bf(v);
  }
  __syncthreads();
  const int n = t >> 3, part = t & 7;
  if (n0 + n < j.n_cnt) {
    const unsigned* tp = (const unsigned*)(T + n * 66 + part * 8);
    uint4 o0; o0.x = tp[0]; o0.y = tp[1]; o0.z = tp[2]; o0.w = tp[3];
    const int f = n0 + n;
    int drow;
    if (j.mode == 0) drow = j.dst_row0 + f;
    else drow = (f >> 7) * 256 + ((f >> 6) & 1) * 128 + (((f >> 5) & 1) * 2 + (j.mode == 2 ? 1 : 0)) * 32 + (f & 31);
    *(uint4*)(dst + (size_t)drow * j.K + k0 + part * 8) = o0;
  }
}

DI void mod_item(const Params& p, int it, char* smem) {
  const int t = tid_(), cgi = t & 15, kg = t >> 4;
  const int j0 = it * 16;
  float* Ssm = (float*)smem;
  float* red = (float*)(smem + 33 * 128 * 4);
  float acc[33];
#pragma unroll
  for (int r = 0; r < 33; ++r) acc[r] = 0.f;
#pragma unroll 1
  for (int kc = 0; kc < 8; ++kc) {
    __syncthreads();
    for (int idx = t; idx < 33 * 128; idx += NTH) {
      const int r = idx >> 7, kk = idx & 127;
      float v = (r < 32) ? p.c[r * DM + kc * 128 + kk] : p.c_ctx[kc * 128 + kk];
      Ssm[idx] = v * sigmoidf_(v);
    }
    __syncthreads();
    const int k = kc * 128 + kg * 4;
    const float w0 = p.w_mod[(size_t)(k + 0) * 6144 + j0 + cgi];
    const float w1 = p.w_mod[(size_t)(k + 1) * 6144 + j0 + cgi];
    const float w2 = p.w_mod[(size_t)(k + 2) * 6144 + j0 + cgi];
    const float w3 = p.w_mod[(size_t)(k + 3) * 6144 + j0 + cgi];
#pragma unroll
    for (int r = 0; r < 33; ++r) {
      const float4 s = *(const float4*)(Ssm + r * 128 + kg * 4);
      acc[r] += s.x * w0 + s.y * w1 + s.z * w2 + s.w * w3;
    }
  }
  __syncthreads();
#pragma unroll
  for (int r = 0; r < 33; ++r) red[(kg * 33 + r) * 16 + cgi] = acc[r];
  __syncthreads();
  for (int idx = t; idx < 33 * 16; idx += NTH) {
    const int r = idx >> 4, cc = idx & 15;
    float s = 0.f;
#pragma unroll
    for (int g = 0; g < 32; ++g) s += red[(g * 33 + r) * 16 + cc];
    p.mod[r * 6144 + j0 + cc] = s + p.b_mod[j0 + cc];
  }
}

DI void phase0(const Params& p, char* smem) {
  const int t = tid_();
  const int nMod = 384;
  const int nPos = 288;
  const int nMisc = 3;
  const int nT = p.n_ttiles;
  const int total = nMod + nT + nPos + nMisc;
  float* ctab = (float*)(smem + 98304);
  for (int j = t; j < 2048; j += NTH) ctab[j] = cospif((float)j * (1.f / 1024.f));
  __syncthreads();
  for (int it = blockIdx.x; it < total; it += gridDim.x) {
    if (it < nMod) { mod_item(p, it, smem); continue; }
    int u = it - nMod;
    if (u < nT) {
      int jb = 0;
#pragma unroll 1
      for (int q = 1; q < NJOBS; ++q) if (u >= p.jobs[q].tile_start) jb = q;
      transpose_tile(p.jobs[jb], u - p.jobs[jb].tile_start, smem);
      continue;
    }
    u -= nT;
    if (u < nPos) {
      for (int e = t; e < 8 * 256; e += NTH) {
        const int R = u * 8 + (e >> 8), c8 = (e & 255) * 8;
        const int part = R >= 1152 ? 1 : 0, k = R - part * 1152;
        float v[8];
#pragma unroll
        for (int q = 0; q < 8; ++q) {
          const int tt = c8 + q;
          v[q] = (k > 1024) ? 0.f : (part ? ctab[(k * tt - 512) & 2047] : ctab[(k * tt) & 2047]);
        }
        uint4 o; o.x = pk_bf16(v[0], v[1]); o.y = pk_bf16(v[2], v[3]); o.z = pk_bf16(v[4], v[5]); o.w = pk_bf16(v[6], v[7]);
        *(uint4*)(p.posM + (size_t)R * 2048 + c8) = o;
      }
      continue;
    }
    u -= nPos;
    if (u == 0) {
      for (int e = t; e < 256 * 128; e += NTH) {
        const int m2 = e >> 7, cc = e & 127, mm = m2 & 127;
        float v = (m2 < 128) ? ctab[(mm * cc * 16) & 2047] : ctab[(mm * cc * 16 - 512) & 2047];
        p.chanT[e] = f2bf(v);
      }
    } else if (u == 1) {
      for (int e = t; e < 64 * 8; e += NTH) {
        const int pos = e >> 3, jf = e & 7;
        const float inv = 1.0f / powf(10000.0f, (float)jf / 8.0f);
        const float ang = (float)pos * inv;
        p.ropeTab[e * 2 + 0] = cosf(ang);
        p.ropeTab[e * 2 + 1] = sinf(ang);
      }
    } else {
      uint4 z; z.x = z.y = z.z = z.w = 0u;
      uint4* dp = (uint4*)(p.WinT + (size_t)672 * DM);
      for (int e = t; e < 96 * DM / 8; e += NTH) dp[e] = z;
    }
  }
}

DI void phase1(const Params& p) {
  const int t_ = tid_(); const int lane = t_ & 63, w = t_ >> 6;
  const int gw = blockIdx.x * NWV + w, nw = gridDim.x * NWV;
  for (int R0 = gw; R0 < NT + NC; R0 += 2 * nw) {
    const int R1 = R0 + nw; const bool has1 = R1 < NT + NC;
    const float* src0 = (R0 < NT) ? p.x + (size_t)R0 * DM : p.ctx + (size_t)(R0 - NT) * DM;
    const float* src1 = has1 ? ((R1 < NT) ? p.x + (size_t)R1 * DM : p.ctx + (size_t)(R1 - NT) * DM) : src0;
    const float* md0 = p.mod + ((R0 < NT) ? (R0 >> 11) : 32) * 6144;
    const float* md1 = p.mod + ((has1 && R1 < NT) ? (R1 >> 11) : 32) * 6144;
    float4 v0[4], v1[4]; float s0 = 0.f, s1 = 0.f;
#pragma unroll
    for (int i = 0; i < 4; ++i) { v0[i] = *(const float4*)(src0 + lane * 4 + 256 * i); v1[i] = *(const float4*)(src1 + lane * 4 + 256 * i); }
#pragma unroll
    for (int i = 0; i < 4; ++i) { s0 += v0[i].x * v0[i].x + v0[i].y * v0[i].y + v0[i].z * v0[i].z + v0[i].w * v0[i].w; s1 += v1[i].x * v1[i].x + v1[i].y * v1[i].y + v1[i].z * v1[i].z + v1[i].w * v1[i].w; }
    s0 = wave_sum(s0); s1 = wave_sum(s1);
    const float r0 = rsqrtf(s0 * (1.f / DM) + EPS), r1 = rsqrtf(s1 * (1.f / DM) + EPS);
#pragma unroll
    for (int i = 0; i < 4; ++i) {
      const int d = lane * 4 + 256 * i;
      const float4 g = *(const float4*)(p.norm1_g + d);
      {
        const float4 sh = *(const float4*)(md0 + d), sc = *(const float4*)(md0 + 1024 + d);
        uint2 o; o.x = pk_bf16(v0[i].x * r0 * g.x * (1.f + sc.x) + sh.x, v0[i].y * r0 * g.y * (1.f + sc.y) + sh.y);
        o.y = pk_bf16(v0[i].z * r0 * g.z * (1.f + sc.z) + sh.z, v0[i].w * r0 * g.w * (1.f + sc.w) + sh.w);
        *(uint2*)(p.h + (size_t)R0 * DM + d) = o;
      }
      if (has1) {
        const float4 sh = *(const float4*)(md1 + d), sc = *(const float4*)(md1 + 1024 + d);
        uint2 o; o.x = pk_bf16(v1[i].x * r1 * g.x * (1.f + sc.x) + sh.x, v1[i].y * r1 * g.y * (1.f + sc.y) + sh.y);
        o.y = pk_bf16(v1[i].z * r1 * g.z * (1.f + sc.z) + sh.z, v1[i].w * r1 * g.w * (1.f + sc.w) + sh.w);
        *(uint2*)(p.h + (size_t)R1 * DM + d) = o;
      }
    }
  }
}

DI void phase2(const Params& p, char* smem) {
  const int xcd = blockIdx.x & 7, jl = blockIdx.x >> 3, nl = gridDim.x >> 3;
  auto decode = [&](int L, int& tokTile, int& ft) {
    if (L < 416) { const int tg = L / 104, rem = L % 104; ft = rem >> 3; tokTile = xcd * 32 + tg * 8 + (rem & 7); }
    else { const int u = L - 416; tokTile = 256 + xcd * 4 + (u >> 1); ft = 1 + (u & 1); }
  };
  bool pre = false;
  for (int L = jl; L < 416 + 8; L += nl) {
    int tokTile, ft, tokTileN = 0, ftN = 0;
    decode(L, tokTile, ft);
    const bool lat = L < 416;
    const int Ln = L + nl; const bool hasNext = Ln < 416 + 8;
    if (hasNext) decode(Ln, tokTileN, ftN);
    f32x16 acc[4][2];
#pragma unroll
    for (int a = 0; a < 4; ++a)
#pragma unroll
      for (int b = 0; b < 2; ++b) acc[a][b] = zero16();
    const bf16_t* Ab = p.WinT + (size_t)ft * 256 * DM;
    const bf16_t* Bb = p.h + (size_t)tokTile * 256 * DM;
    const bf16_t* AbN = p.WinT + (size_t)ftN * 256 * DM;
    const bf16_t* BbN = p.h + (size_t)tokTileN * 256 * DM;
    float dummy = 0.f;
    gemm8x<4, 2, 2, 4, false, 2>(acc, [&](int row) { return Ab + (size_t)row * DM; }, [&](int row) { return Bb + (size_t)row * DM; }, DM, smem, dummy,
                              pre, hasNext, [&](int row) { return AbN + (size_t)row * DM; }, [&](int row) { return BbN + (size_t)row * DM; });
    pre = hasNext;
    char* tile = smem + EPI_OFF;
    bf16_t* base; int ld, c0 = 0, c1 = 32;
    if (lat) {
      const size_t tok0 = (size_t)tokTile * 256;
      if (ft < 3) { base = p.pqkv + tok0 * LDQKV + ft * 256; ld = LDQKV; if (ft == 2) c1 = 20; }
      else if (ft < 5) { base = p.pf + tok0 * 512 + (ft - 3) * 256; ld = 512; }
      else { base = p.pg + tok0 * 2048 + (ft - 5) * 256; ld = 2048; }
    } else {
      const size_t ct0 = (size_t)(tokTile - 256) * 256;
      base = p.pckv + ct0 * LDCKV + ft * 256 - 384; ld = LDCKV;
      if (ft == 1) c0 = 16; else c1 = 20;
    }
    if (ft >= 5) stage_half<4, 2, 4, 0>(acc, tile, 528, [](float v) { return sigmoidf_(v); });
    else stage_half<4, 2, 4, 0>(acc, tile, 528, [](float v) { return v; });
    lds_sync();
    copy_tile(tile, 528, 128, 5, [&](int rl) { return base + (size_t)((rl >> 5) * 64 + (rl & 31)) * ld; }, c0, c1);
    lds_sync();
    if (ft >= 5) stage_half<4, 2, 4, 1>(acc, tile, 528, [](float v) { return sigmoidf_(v); });
    else stage_half<4, 2, 4, 1>(acc, tile, 528, [](float v) { return v; });
    lds_sync();
    copy_tile(tile, 528, 128, 5, [&](int rl) { return base + (size_t)((rl >> 5) * 64 + 32 + (rl & 31)) * ld; }, c0, c1);
  }
}

DI void rope_pair(float& x1, float& x2, const float* tab) { const float c = tab[0], s = tab[1]; const float a = x1 * c - x2 * s, b = x2 * c + x1 * s; x1 = a; x2 = b; }

DI void phase3(const Params& p, char* smem) {
  const int t = tid_(), lane = t & 63, w = t >> 6, r = lane & 31, hh = lane >> 5;
  const int nKV = 288, nQ = 256, nCh = 128;
  const int xcd = blockIdx.x & 7, jl = blockIdx.x >> 3, nl = gridDim.x >> 3;
  for (int it = jl; it < nKV + nQ + nCh; it += nl) {
    if (it < nKV) {
      const int tl_ = it >> 3, hd = it & 7;
      const bool lat = tl_ < 32;
      const bf16_t* Bb; int ldb; const bf16_t* kpeb;
      int b, key0;
      if (lat) { const int tokTile = xcd * 32 + tl_; Bb = p.pqkv + (size_t)tokTile * 256 * LDQKV + QL; ldb = LDQKV; kpeb = p.pqkv + (size_t)tokTile * 256 * LDQKV + 640; b = tokTile >> 3; key0 = (tokTile & 7) * 256; }
      else { const int ct = xcd * 4 + (tl_ - 32); Bb = p.pckv + (size_t)ct * 256 * LDCKV; ldb = LDCKV; kpeb = Bb + 256; b = ct; key0 = SEQ; }
      const bf16_t* Ab = p.WkvT + (size_t)hd * 128 * KVL;
      f32x16 acc[4][1];
#pragma unroll
      for (int a = 0; a < 4; ++a) acc[a][0] = zero16();
      float sumsq = 0.f;
      gemm8<4, 1, 1, 8, true>(acc, [&](int row) { return Ab + (size_t)row * KVL; }, [&](int row) { return Bb + (size_t)row * ldb; }, KVL, smem, sumsq);
      sumsq += __shfl_xor(sumsq, 32);
      const float ra = rsqrtf(sumsq * (1.f / KVL) + EPS);
      const int tl = w * 32 + r;
      const int key = key0 + tl;
      float kp[16];
#pragma unroll
      for (int q = 0; q < 4; ++q) {
        const uint2 u = *(const uint2*)(kpeb + (size_t)tl * ldb + 8 * q + 4 * hh);
        kp[4 * q + 0] = bf_lo(u.x); kp[4 * q + 1] = bf_hi(u.x); kp[4 * q + 2] = bf_lo(u.y); kp[4 * q + 3] = bf_hi(u.y);
      }
      float ss = 0.f;
#pragma unroll
      for (int tm = 0; tm < 4; ++tm)
#pragma unroll
        for (int i = 0; i < 16; ++i) { const float v = acc[tm][0][i] * ra; acc[tm][0][i] = v; if (tm < 2) ss += v * v; }
#pragma unroll
      for (int i = 0; i < 16; ++i) ss += kp[i] * kp[i];
      ss += __shfl_xor(ss, 32);
      const float rk = rsqrtf(ss * (1.f / QKD) + EPS);
#pragma unroll
      for (int i = 0; i < 16; ++i) kp[i] *= rk * p.k_norm_g[64 + crow(i, hh)];
      if (lat) {
        const int pos = key;
        const float* tr = p.ropeTab + ((pos >> 6) * 8 + 4 * hh) * 2;
        const float* tc = p.ropeTab + ((pos & 63) * 8 + 4 * hh) * 2;
#pragma unroll
        for (int i = 0; i < 4; ++i) { rope_pair(kp[i], kp[i + 4], tr + 2 * i); rope_pair(kp[8 + i], kp[12 + i], tc + 2 * i); }
      }
      {
        char* kt_ = smem; char* vt_ = smem + 256 * 208;
        char* kd = kt_ + tl * 208;
#pragma unroll
        for (int tm = 0; tm < 2; ++tm)
#pragma unroll
          for (int q = 0; q < 4; ++q) {
            const int f = tm * 32 + 8 * q + 4 * hh;
            const float4 g = *(const float4*)(p.k_norm_g + f);
            uint2 o; o.x = pk_bf16(acc[tm][0][4 * q] * rk * g.x, acc[tm][0][4 * q + 1] * rk * g.y); o.y = pk_bf16(acc[tm][0][4 * q + 2] * rk * g.z, acc[tm][0][4 * q + 3] * rk * g.w);
            *(uint2*)(kd + f * 2) = o;
          }
#pragma unroll
        for (int q = 0; q < 4; ++q) {
          uint2 o; o.x = pk_bf16(kp[4 * q], kp[4 * q + 1]); o.y = pk_bf16(kp[4 * q + 2], kp[4 * q + 3]);
          *(uint2*)(kd + (64 + 8 * q + 4 * hh) * 2) = o;
        }
#pragma unroll
        for (int tm = 2; tm < 4; ++tm)
#pragma unroll
          for (int i = 0; i < 16; ++i) *(bf16_t*)(vt_ + ((tm - 2) * 32 + crow(i, hh)) * 528 + tl * 2) = f2bf(acc[tm][0][i]);
        lds_sync();
        const int tc_ = tid_();
        bf16_t* Kg = p.K + ((size_t)(b * NH + hd) * NKEY + key0) * QKD;
#pragma unroll
        for (int i = 0; i < 6; ++i) {
          const int id = tc_ + NTH * i, row = id / 12, ch = id % 12;
          *(uint4*)(Kg + row * QKD + ch * 8) = *(const uint4*)(kt_ + row * 208 + ch * 16);
        }
        bf16_t* Vg = p.Vt + (size_t)(b * NH + hd) * VD * NKEY + key0;
#pragma unroll
        for (int i = 0; i < 4; ++i) {
          const int row = (tc_ >> 5) + 16 * i, ch = tc_ & 31;
          *(uint4*)(Vg + (size_t)row * NKEY + ch * 8) = *(const uint4*)(vt_ + row * 528 + ch * 16);
        }
        lds_sync();
      }
    } else if (it < nKV + nQ) {
      const int u = it - nKV;
      const int tokTile = xcd * 32 + (u >> 3), hd = u & 7;
      const bf16_t* Bb = p.pqkv + (size_t)tokTile * 256 * LDQKV;
      const bf16_t* Ab = p.WqT + (size_t)hd * QKD * QL;
      f32x16 acc[3][1];
#pragma unroll
      for (int a = 0; a < 3; ++a) acc[a][0] = zero16();
      float sumsq = 0.f;
      gemm8<3, 1, 1, 8, true>(acc, [&](int row) { return Ab + (size_t)row * QL; }, [&](int row) { return Bb + (size_t)row * LDQKV; }, QL, smem, sumsq);
      sumsq += __shfl_xor(sumsq, 32);
      const float ra = rsqrtf(sumsq * (1.f / QL) + EPS);
      const int tl = w * 32 + r;
      const int b = tokTile >> 3, pos = (tokTile & 7) * 256 + tl;
      float ss = 0.f;
#pragma unroll
      for (int tm = 0; tm < 3; ++tm)
#pragma unroll
        for (int i = 0; i < 16; ++i) { const float v = acc[tm][0][i] * ra; acc[tm][0][i] = v; ss += v * v; }
      ss += __shfl_xor(ss, 32);
      const float rh = rsqrtf(ss * (1.f / QKD) + EPS);
#pragma unroll
      for (int tm = 0; tm < 3; ++tm)
#pragma unroll
        for (int q = 0; q < 4; ++q) {
          const float4 g = *(const float4*)(p.q_norm_g + tm * 32 + 8 * q + 4 * hh);
          acc[tm][0][4 * q] *= rh * g.x; acc[tm][0][4 * q + 1] *= rh * g.y; acc[tm][0][4 * q + 2] *= rh * g.z; acc[tm][0][4 * q + 3] *= rh * g.w;
        }
      {
        const float* tr = p.ropeTab + ((pos >> 6) * 8 + 4 * hh) * 2;
        const float* tc = p.ropeTab + ((pos & 63) * 8 + 4 * hh) * 2;
#pragma unroll
        for (int i = 0; i < 4; ++i) {
          float a0 = acc[2][0][i], a1 = acc[2][0][i + 4], c0 = acc[2][0][8 + i], c1 = acc[2][0][12 + i];
          rope_pair(a0, a1, tr + 2 * i); rope_pair(c0, c1, tc + 2 * i);
          acc[2][0][i] = a0; acc[2][0][i + 4] = a1; acc[2][0][8 + i] = c0; acc[2][0][12 + i] = c1;
        }
      }
      const float qs = 0.10206207261596575f * 1.4426950408889634f;
      {
        char* qd = smem + tl * 208;
#pragma unroll
        for (int tm = 0; tm < 3; ++tm)
#pragma unroll
          for (int q = 0; q < 4; ++q) {
            uint2 o; o.x = pk_bf16(acc[tm][0][4 * q] * qs, acc[tm][0][4 * q + 1] * qs); o.y = pk_bf16(acc[tm][0][4 * q + 2] * qs, acc[tm][0][4 * q + 3] * qs);
            *(uint2*)(qd + (tm * 32 + 8 * q + 4 * hh) * 2) = o;
          }
        lds_sync();
        const int tc_ = tid_();
        bf16_t* Qg = p.Q + ((size_t)(b * NH + hd) * SEQ + (tokTile & 7) * 256) * QKD;
#pragma unroll
        for (int i = 0; i < 6; ++i) {
          const int id = tc_ + NTH * i, row = id / 12, ch = id % 12;
          *(uint4*)(Qg + row * QKD + ch * 8) = *(const uint4*)(smem + row * 208 + ch * 16);
        }
        lds_sync();
      }
    } else {
      const int u = it - nKV - nQ;
      const int tt = u & 7, g = (u >> 3) & 3, b = xcd * 4 + (u >> 5);
      const bf16_t* Tb = p.chanT;
      const bf16_t* Fb = p.pf + (size_t)(b * SEQ + tt * 256) * 512 + g * 128;
      f32x16 acc[4][2];
#pragma unroll
      for (int a = 0; a < 4; ++a)
#pragma unroll
        for (int c = 0; c < 2; ++c) acc[a][c] = zero16();
      float dummy = 0.f;
      gemm8<4, 2, 2, 4, false>(acc, [&](int row) { return Fb + (size_t)row * 512; }, [&](int row) { return Tb + (size_t)row * 128; }, 128, smem, dummy);
      stage_tile<4, 2, 2, 4>(acc, smem, 528, [](float v) { return v; });
      lds_sync();
      bf16_t* dst0 = p.ABt + ((size_t)(b * 512 + g * 128)) * 4096 + tt * 256;
      copy_tile(smem, 528, 256, 5, [&](int row) { return dst0 + (size_t)(row & 127) * 4096 + (row >> 7) * 2048; }, 0, 32);
      lds_sync();
    }
  }
}

DI void attn_item(const Params& p, int it, char* smem) {
  const int t = tid_(), lane = t & 63, w = t >> 6, r = lane & 31, hh = lane >> 5;
  const int qt = it & 7, bh = it >> 3;
  constexpr int KROW = 208, VROW = 136, KBYTES = 64 * KROW, STAGE = KBYTES + 64 * VROW;
  const bf16_t* Kb = p.K + (size_t)bh * NKEY * QKD;
  const bf16_t* Vb = p.Vt + (size_t)bh * VD * NKEY;
  const int qpos = qt * 256 + w * 32 + r;
  const bf16_t* Qp = p.Q + ((size_t)bh * SEQ + qpos) * QKD + hh * 8;
  bf16x8 qf[6];
#pragma unroll
  for (int c = 0; c < 6; ++c) qf[c] = *(const bf16x8*)(Qp + c * 16);
  f32x16 o[2]; o[0] = zero16(); o[1] = zero16();
  float gk = 0.f;
  for (int f = 0; f < QKD; ++f) gk = fmaxf(gk, fabsf(p.k_norm_g[f]));
  float qss = 0.f;
#pragma unroll
  for (int c = 0; c < 6; ++c) {
    const uint4 u = __builtin_bit_cast(uint4, qf[c]);
    const float e0 = bf_lo(u.x), e1 = bf_hi(u.x), e2 = bf_lo(u.y), e3 = bf_hi(u.y), e4 = bf_lo(u.z), e5 = bf_hi(u.z), e6 = bf_lo(u.w), e7 = bf_hi(u.w);
    qss += e0 * e0 + e1 * e1 + e2 * e2 + e3 * e3 + e4 * e4 + e5 * e5 + e6 * e6 + e7 * e7;
  }
  qss += __shfl_xor(qss, 32);
  const float negC = -(sqrtf(qss) * gk * 9.797959f * 1.01f);
  f32x16 sinit;
#pragma unroll
  for (int i = 0; i < 16; ++i) sinit[i] = negC;
  float lrun = 0.f;
  const int kid0 = t, kid1 = (t & 255) + 512;
  const bool k1v = t < 256;
  const int kgo0 = (kid0 / 12) * QKD + (kid0 % 12) * 8, kgo1 = (kid1 / 12) * QKD + (kid1 % 12) * 8;
  const int klo0 = (kid0 / 12) * KROW + (kid0 % 12) * 16, klo1 = (kid1 / 12) * KROW + (kid1 % 12) * 16;
  const int vgo0 = (t >> 3) * NKEY + (t & 7) * 8;
  const int vlo0 = KBYTES + (t >> 3) * VROW + (t & 7) * 16;
  uint4 rk0, rk1, rv0;
  rk0 = *(const uint4*)(Kb + kgo0); rk1 = *(const uint4*)(Kb + kgo1);
  rv0 = *(const uint4*)(Vb + vgo0);
  SB_;
#define ATT_STORE(base) do { \
    *(uint4*)((base) + klo0) = rk0; if (k1v) *(uint4*)((base) + klo1) = rk1; \
    { uint2* d = (uint2*)((base) + vlo0); d[0] = make_uint2(rv0.x, rv0.y); d[1] = make_uint2(rv0.z, rv0.w); } } while (0)
  ATT_STORE(smem);
  __syncthreads();
  constexpr int NKT = NKEY / 64;
  for (int kt = 0; kt < NKT; ++kt) {
    const char* cur = smem + (kt & 1) * STAGE;
    const bool more = kt + 1 < NKT;
    if (more) {
      const bf16_t* kn = Kb + (size_t)(kt + 1) * 64 * QKD; const bf16_t* vn = Vb + (kt + 1) * 64;
      rk0 = *(const uint4*)(kn + kgo0); rk1 = *(const uint4*)(kn + kgo1);
      rv0 = *(const uint4*)(vn + vgo0);
    }
    SB_;
    f32x16 s[2];
#pragma unroll
    for (int t2 = 0; t2 < 2; ++t2) {
      const char* kp = cur + (t2 * 32 + r) * KROW + hh * 16;
      { const bf16x8 kf = *(const bf16x8*)(kp); s[t2] = MFMA(kf, qf[0], sinit); }
#pragma unroll
      for (int c = 1; c < 6; ++c) { const bf16x8 kf = *(const bf16x8*)(kp + c * 32); s[t2] = MFMA(kf, qf[c], s[t2]); }
    }
    SB_;
    float ls = 0.f;
#pragma unroll
    for (int t2 = 0; t2 < 2; ++t2)
#pragma unroll
      for (int i = 0; i < 16; ++i) { const float e = __builtin_amdgcn_exp2f(s[t2][i]); s[t2][i] = e; ls += e; }
    lrun += ls;
    SB_;
#pragma unroll
    for (int t2 = 0; t2 < 2; ++t2)
#pragma unroll
      for (int s2 = 0; s2 < 2; ++s2) {
        uint4 pu;
        pu.x = pk_bf16(s[t2][8 * s2 + 0], s[t2][8 * s2 + 1]); pu.y = pk_bf16(s[t2][8 * s2 + 2], s[t2][8 * s2 + 3]);
        pu.z = pk_bf16(s[t2][8 * s2 + 4], s[t2][8 * s2 + 5]); pu.w = pk_bf16(s[t2][8 * s2 + 6], s[t2][8 * s2 + 7]);
        const bf16x8 pb = __builtin_bit_cast(bf16x8, pu);
#pragma unroll
        for (int vt = 0; vt < 2; ++vt) {
          const char* vp = cur + KBYTES + (vt * 32 + r) * VROW + (t2 * 32 + 16 * s2 + 4 * hh) * 2;
          const uint2 lo = *(const uint2*)(vp), hi = *(const uint2*)(vp + 16);
          uint4 vu; vu.x = lo.x; vu.y = lo.y; vu.z = hi.x; vu.w = hi.y;
          o[vt] = MFMA(__builtin_bit_cast(bf16x8, vu), pb, o[vt]);
        }
      }
    SB_;
    if (more) { char* nxt = smem + ((kt + 1) & 1) * STAGE; ATT_STORE(nxt); }
    __syncthreads();
  }
  lrun += __shfl_xor(lrun, 32);
  const float inv = 1.f / lrun;
  const int b = bh >> 3, hd = bh & 7;
  bf16_t* od = p.attn_o + (size_t)(b * SEQ + qpos) * 512 + hd * 64;
#pragma unroll
  for (int vt = 0; vt < 2; ++vt)
#pragma unroll
    for (int q = 0; q < 4; ++q) {
      uint2 ou; ou.x = pk_bf16(o[vt][4 * q] * inv, o[vt][4 * q + 1] * inv); ou.y = pk_bf16(o[vt][4 * q + 2] * inv, o[vt][4 * q + 3] * inv);
      *(uint2*)(od + vt * 32 + 8 * q + 4 * hh) = ou;
    }
}

DI void phase4(const Params& p, char* smem) {
  const int t = tid_(), lane = t & 63, w = t >> 6, r = lane & 31, hh = lane >> 5;
  const int nDft = 64, nAlt = 4, nAtt = 256;
  const int xcd = blockIdx.x & 7, jl = blockIdx.x >> 3, nl = gridDim.x >> 3;
  for (int it = jl; it < nDft + nAlt + nAtt; it += nl) {
    if (it < nDft) {
      const int bl = it >> 4, rem = it & 15, ct = rem >> 3, kt = rem & 7, b = xcd * 4 + bl;
      const int wm = w & 3, wn = w >> 2;
      const bf16_t* Ab = p.ABt + (size_t)(b * 512 + ct * 256) * 4096;
      const bf16_t* Cb = p.posM + (size_t)kt * 128 * 2048;
      const bf16_t* Sb = p.posM + (size_t)(1152 + kt * 128) * 2048;
      f32x16 acc1[2][2], acc2[2][2];
#pragma unroll
      for (int a = 0; a < 2; ++a)
#pragma unroll
        for (int c = 0; c < 2; ++c) { acc1[a][c] = zero16(); acc2[a][c] = zero16(); }
      float dummy = 0.f;
      gemm8s3(acc1, [&](int row) { return Ab + (size_t)row * 4096; }, [&](int row) { return Cb + (size_t)row * 2048; }, 2048, smem);
      gemm8s3(acc2, [&](int row) { return Ab + (size_t)row * 4096 + 2048; }, [&](int row) { return Sb + (size_t)row * 2048; }, 2048, smem);
      const float sc = 1.f / 512.f;
#pragma unroll
      for (int tm = 0; tm < 2; ++tm)
#pragma unroll
        for (int tn = 0; tn < 2; ++tn) {
          const int kpos = kt * 128 + wn * 64 + tn * 32 + r;
          const int moff = ct * 256 + wm * 64 + tm * 32 + 4 * hh;
          if (kpos <= 1024) {
            bf16_t* d = p.four_o + (size_t)(b * SEQ + kpos) * 512 + moff;
#pragma unroll
            for (int q = 0; q < 4; ++q) {
              uint2 ou; ou.x = pk_bf16((acc1[tm][tn][4 * q] - acc2[tm][tn][4 * q]) * sc, (acc1[tm][tn][4 * q + 1] - acc2[tm][tn][4 * q + 1]) * sc);
              ou.y = pk_bf16((acc1[tm][tn][4 * q + 2] - acc2[tm][tn][4 * q + 2]) * sc, (acc1[tm][tn][4 * q + 3] - acc2[tm][tn][4 * q + 3]) * sc);
              *(uint2*)(d + 8 * q) = ou;
            }
          }
          if (kpos >= 1 && kpos <= 1023) {
            bf16_t* d = p.four_o + (size_t)(b * SEQ + 2048 - kpos) * 512 + moff;
#pragma unroll
            for (int q = 0; q < 4; ++q) {
              uint2 ou; ou.x = pk_bf16((acc1[tm][tn][4 * q] + acc2[tm][tn][4 * q]) * sc, (acc1[tm][tn][4 * q + 1] + acc2[tm][tn][4 * q + 1]) * sc);
              ou.y = pk_bf16((acc1[tm][tn][4 * q + 2] + acc2[tm][tn][4 * q + 2]) * sc, (acc1[tm][tn][4 * q + 3] + acc2[tm][tn][4 * q + 3]) * sc);
              *(uint2*)(d + 8 * q) = ou;
            }
          }
        }
    } else if (it < nDft + nAlt) {
      const int b = xcd * 4 + (it - nDft);
      for (int m = w; m < 512; m += NWV) {
        const bf16_t* rowp = p.ABt + (size_t)(b * 512 + m) * 4096 + lane * 8;
        float sacc = 0.f;
#pragma unroll
        for (int i = 0; i < 4; ++i) {
          const uint4 u = *(const uint4*)(rowp + 512 * i);
          sacc += (bf_lo(u.x) - bf_hi(u.x)) + (bf_lo(u.y) - bf_hi(u.y)) + (bf_lo(u.z) - bf_hi(u.z)) + (bf_lo(u.w) - bf_hi(u.w));
        }
        sacc = wave_sum(sacc);
        if (lane == 0) p.four_o[(size_t)(b * SEQ + 1024) * 512 + m] = f2bf(sacc * (1.f / 512.f));
      }
    } else {
      attn_item(p, xcd * 256 + (it - nDft - nAlt), smem);
    }
  }
}

DI void phase5(const Params& p, char* smem) {
  const int t = tid_();
  const int xcd = blockIdx.x & 7, jl = blockIdx.x >> 3, nl = gridDim.x >> 3;
  for (int L = jl; L < 256; L += nl) {
    const int tokTile = xcd * 64 + (L >> 5) * 8 + (L & 7), nt = (L >> 3) & 3;
    f32x16 acc1[2][2], acc2[2][2];
#pragma unroll
    for (int a = 0; a < 2; ++a)
#pragma unroll
      for (int c = 0; c < 2; ++c) { acc1[a][c] = zero16(); acc2[a][c] = zero16(); }
    float dummy = 0.f;
    {
      const bf16_t* Ab = p.WoT + (size_t)nt * 256 * 512; const bf16_t* Bb = p.attn_o + (size_t)tokTile * 128 * 512;
      gemm8s3(acc1, [&](int row) { return Ab + (size_t)row * 512; }, [&](int row) { return Bb + (size_t)row * 512; }, 512, smem);
    }
    {
      const bf16_t* Ab = p.WfT + (size_t)nt * 256 * 512; const bf16_t* Bb = p.four_o + (size_t)tokTile * 128 * 512;
      gemm8s3(acc2, [&](int row) { return Ab + (size_t)row * 512; }, [&](int row) { return Bb + (size_t)row * 512; }, 512, smem);
    }
    {
      char* t1 = smem; char* t2 = smem + 128 * 528;
      const int ch = t & 31, r0 = t >> 5;
      stage_tile<2, 2, 4, 2>(acc1, t1, 528, [](float v) { return v; });
      stage_tile<2, 2, 4, 2>(acc2, t2, 528, [](float v) { return v; });
      lds_sync();
#pragma unroll
      for (int hb = 0; hb < 2; ++hb) {
        uint4 gav[4], gbv[4];
#pragma unroll
        for (int i = 0; i < 4; ++i) {
          const size_t tok = (size_t)tokTile * 128 + r0 + 16 * (hb * 4 + i);
          gav[i] = *(const uint4*)(p.pg + tok * 2048 + nt * 256 + ch * 8); gbv[i] = *(const uint4*)(p.pg + tok * 2048 + 1024 + nt * 256 + ch * 8);
        }
#pragma unroll
        for (int i = 0; i < 4; ++i) {
          const int row = r0 + 16 * (hb * 4 + i);
          const size_t tok = (size_t)tokTile * 128 + row;
          const uint4 u1 = *(const uint4*)(t1 + row * 528 + ch * 16), u2 = *(const uint4*)(t2 + row * 528 + ch * 16);
          const uint4 ga = gav[i], gb = gbv[i];
          uint4 o;
          o.x = pk_bf16(bf_lo(ga.x) * bf_lo(u1.x) + bf_lo(gb.x) * bf_lo(u2.x), bf_hi(ga.x) * bf_hi(u1.x) + bf_hi(gb.x) * bf_hi(u2.x));
          o.y = pk_bf16(bf_lo(ga.y) * bf_lo(u1.y) + bf_lo(gb.y) * bf_lo(u2.y), bf_hi(ga.y) * bf_hi(u1.y) + bf_hi(gb.y) * bf_hi(u2.y));
          o.z = pk_bf16(bf_lo(ga.z) * bf_lo(u1.z) + bf_lo(gb.z) * bf_lo(u2.z), bf_hi(ga.z) * bf_hi(u1.z) + bf_hi(gb.z) * bf_hi(u2.z));
          o.w = pk_bf16(bf_lo(ga.w) * bf_lo(u1.w) + bf_lo(gb.w) * bf_lo(u2.w), bf_hi(ga.w) * bf_hi(u1.w) + bf_hi(gb.w) * bf_hi(u2.w));
          *(uint4*)(p.m + tok * DM + nt * 256 + ch * 8) = o;
        }
      }
      lds_sync();
    }
  }
}

DI void phase6(const Params& p, char* smem) {
  const int t = tid_(), lane = t & 63, w = t >> 6, r = lane & 31, hh = lane >> 5;
  const int wm = w & 1, wn = w >> 1;
  const int xcd = blockIdx.x & 7, jl = blockIdx.x >> 3, nl = gridDim.x >> 3;
  for (int L = jl; L < 128; L += nl) {
    const int tokTile = xcd * 32 + (L >> 5) * 8 + (L & 7), nt = (L >> 3) & 3;
    f32x16 acc[4][2];
#pragma unroll
    for (int a = 0; a < 4; ++a)
#pragma unroll
      for (int c = 0; c < 2; ++c) acc[a][c] = zero16();
    float dummy = 0.f;
    const bf16_t* Wb = p.WoutT + (size_t)nt * 256 * DM; const bf16_t* Mb = p.m + (size_t)tokTile * 256 * DM;
    gemm8<4, 2, 2, 4, false>(acc, [&](int row) { return Wb + (size_t)row * DM; }, [&](int row) { return Mb + (size_t)row * DM; }, DM, smem, dummy);
    const int tc_ = tid_();
    const int ch = tc_ & 63, r0 = tc_ >> 6;
    const float4 g = *(const float4*)(p.mod + (tokTile >> 3) * 6144 + 2048 + nt * 256 + ch * 4);
#pragma unroll
    for (int tn = 0; tn < 2; ++tn) {
      const size_t obase = ((size_t)tokTile * 256 + tn * 32) * DM + nt * 256 + ch * 4;
#pragma unroll
      for (int tm = 0; tm < 4; ++tm) {
        char* d = smem + (wn * 32 + r) * 1040 + (wm * 128 + tm * 32 + 4 * hh) * 4;
#pragma unroll
        for (int q = 0; q < 4; ++q) *(float4*)(d + 32 * q) = make_float4(acc[tm][tn][4 * q], acc[tm][tn][4 * q + 1], acc[tm][tn][4 * q + 2], acc[tm][tn][4 * q + 3]);
      }
      lds_sync();
#pragma unroll
      for (int hb = 0; hb < 2; ++hb) {
        float4 xv[8];
#pragma unroll
        for (int i = 0; i < 8; ++i) {
          const int row = r0 + 8 * (hb * 8 + i);
          xv[i] = *(const float4*)(p.x + obase + (size_t)((row >> 5) * 64 + (row & 31)) * DM);
        }
#pragma unroll
        for (int i = 0; i < 8; ++i) {
          const int row = r0 + 8 * (hb * 8 + i);
          const float4 a = *(const float4*)(smem + row * 1040 + ch * 16);
          *(float4*)(p.out + obase + (size_t)((row >> 5) * 64 + (row & 31)) * DM) = make_float4(xv[i].x + g.x * a.x, xv[i].y + g.y * a.y, xv[i].z + g.z * a.z, xv[i].w + g.w * a.w);
        }
      }
      lds_sync();
    }
  }
}

DI void phase7(const Params& p, char* smem) {
  const int t = tid_(), lane = t & 63, w = t >> 6;
  float* wr = (float*)smem;
  for (int idx = t; idx < DM * NE; idx += NTH) { const int d = idx >> 4, e = idx & 15; wr[e * DM + d] = p.w_router[idx]; }
  __syncthreads();
  const int gw = blockIdx.x * NWV + w, nw = gridDim.x * NWV;
  auto router = [&](const float4 (&v)[4], int R) {
    asm volatile("" ::: "memory");
    float a[16];
#pragma unroll
    for (int e = 0; e < 16; ++e) {
      float s = 0.f;
#pragma unroll
      for (int i = 0; i < 4; ++i) { const float4 wv = *(const float4*)(wr + e * DM + lane * 4 + 256 * i); s += v[i].x * wv.x + v[i].y * wv.y + v[i].z * wv.z + v[i].w * wv.w; }
      a[e] = s;
      if ((e & 3) == 3) __builtin_amdgcn_sched_barrier(0);
    }
    float a8[8], a4[4], a2[2], a1;
    {
      const bool up = lane & 32;
#pragma unroll
      for (int j = 0; j < 8; ++j) { const float send = up ? a[j] : a[j + 8]; const float keep = up ? a[j + 8] : a[j]; a8[j] = keep + __shfl_xor(send, 32); }
    }
    {
      const bool up = lane & 16;
#pragma unroll
      for (int j = 0; j < 4; ++j) { const float send = up ? a8[j] : a8[j + 4]; const float keep = up ? a8[j + 4] : a8[j]; a4[j] = keep + __shfl_xor(send, 16); }
    }
    {
      const bool up = lane & 8;
#pragma unroll
      for (int j = 0; j < 2; ++j) { const float send = up ? a4[j] : a4[j + 2]; const float keep = up ? a4[j + 2] : a4[j]; a2[j] = keep + __shfl_xor(send, 8); }
    }
    {
      const bool up = lane & 4;
      const float send = up ? a2[0] : a2[1]; const float keep = up ? a2[1] : a2[0]; a1 = keep + __shfl_xor(send, 4);
    }
    a1 += __shfl_xor(a1, 2);
    a1 += __shfl_xor(a1, 1);
    float mx = a1;
#pragma unroll
    for (int o = 4; o <= 32; o <<= 1) mx = fmaxf(mx, __shfl_xor(mx, o));
    const float ex = __expf(a1 - mx);
    float sm = ex;
#pragma unroll
    for (int o = 4; o <= 32; o <<= 1) sm += __shfl_xor(sm, o);
    if ((lane & 3) == 0) {
      const int e = (lane >> 2) & 15;
      p.aff[((size_t)((R >> 11) * NE + e)) * SEQ + (R & 2047)] = ex / sm;
    }
  };
  for (int R0 = gw; R0 < NT; R0 += 2 * nw) {
    const int R1 = R0 + nw;
    const bool has1 = R1 < NT;
    const float* src0 = p.out + (size_t)R0 * DM;
    const float* src1 = p.out + (size_t)(has1 ? R1 : R0) * DM;
    const float* md0 = p.mod + (R0 >> 11) * 6144;
    const float* md1 = p.mod + ((has1 ? R1 : R0) >> 11) * 6144;
    float4 v0[4], v1[4]; float s0 = 0.f, s1 = 0.f;
#pragma unroll
    for (int i = 0; i < 4; ++i) { v0[i] = *(const float4*)(src0 + lane * 4 + 256 * i); v1[i] = *(const float4*)(src1 + lane * 4 + 256 * i); }
#pragma unroll
    for (int i = 0; i < 4; ++i) { s0 += v0[i].x * v0[i].x + v0[i].y * v0[i].y + v0[i].z * v0[i].z + v0[i].w * v0[i].w; s1 += v1[i].x * v1[i].x + v1[i].y * v1[i].y + v1[i].z * v1[i].z + v1[i].w * v1[i].w; }
    s0 = wave_sum(s0); s1 = wave_sum(s1);
    const float r0 = rsqrtf(s0 * (1.f / DM) + EPS), r1 = rsqrtf(s1 * (1.f / DM) + EPS);
#pragma unroll
    for (int i = 0; i < 4; ++i) {
      const int d = lane * 4 + 256 * i;
      const float4 g = *(const float4*)(p.norm2_g + d);
      {
        const float4 sh = *(const float4*)(md0 + 3072 + d), sc = *(const float4*)(md0 + 4096 + d);
        v0[i].x = v0[i].x * r0 * g.x * (1.f + sc.x) + sh.x; v0[i].y = v0[i].y * r0 * g.y * (1.f + sc.y) + sh.y;
        v0[i].z = v0[i].z * r0 * g.z * (1.f + sc.z) + sh.z; v0[i].w = v0[i].w * r0 * g.w * (1.f + sc.w) + sh.w;
        uint2 o; o.x = pk_bf16(v0[i].x, v0[i].y); o.y = pk_bf16(v0[i].z, v0[i].w);
        *(uint2*)(p.h2 + (size_t)R0 * DM + d) = o;
      }
      if (has1) {
        const float4 sh = *(const float4*)(md1 + 3072 + d), sc = *(const float4*)(md1 + 4096 + d);
        v1[i].x = v1[i].x * r1 * g.x * (1.f + sc.x) + sh.x; v1[i].y = v1[i].y * r1 * g.y * (1.f + sc.y) + sh.y;
        v1[i].z = v1[i].z * r1 * g.z * (1.f + sc.z) + sh.z; v1[i].w = v1[i].w * r1 * g.w * (1.f + sc.w) + sh.w;
        uint2 o; o.x = pk_bf16(v1[i].x, v1[i].y); o.y = pk_bf16(v1[i].z, v1[i].w);
        *(uint2*)(p.h2 + (size_t)R1 * DM + d) = o;
      }
    }
    SB_;
    router(v0, R0);
    SB_;
    if (has1) router(v1, R1);
    SB_;
  }
}

DI void phase8(const Params& p) {
  const int t_ = tid_(); const int lane = t_ & 63, w = t_ >> 6;
  const int gw = blockIdx.x * NWV + w, nw = gridDim.x * NWV;
  for (int pr = gw; pr < NB * NE; pr += nw) {
    const float* a = p.aff + (size_t)pr * SEQ;
    unsigned u[32];
#pragma unroll
    for (int q = 0; q < 32; ++q) u[q] = __float_as_uint(a[q * 64 + lane]);
    unsigned thr = 0;
    for (int bit = 30; bit >= 0; --bit) {
      const unsigned cand = thr | (1u << bit);
      int cnt = 0;
#pragma unroll
      for (int q = 0; q < 32; ++q) cnt += __popcll(__ballot(u[q] >= cand));
      if (cnt >= CAP) thr = cand;
    }
    int ngt = 0;
#pragma unroll
    for (int q = 0; q < 32; ++q) ngt += __popcll(__ballot(u[q] > thr));
    int cgt = 0, ceq = 0;
    int* io = p.idx + pr * CAP; float* go = p.gate + pr * CAP;
    int* iv = p.inv + (size_t)pr * SEQ;
#pragma unroll
    for (int q = 0; q < 32; ++q) {
      const bool gt = u[q] > thr, eq = u[q] == thr;
      const unsigned long long mg = __ballot(gt), me = __ballot(eq);
      const unsigned long long below = (1ull << lane) - 1ull;
      int myslot = -1;
      if (gt) { const int s = cgt + __popcll(mg & below); io[s] = q * 64 + lane; go[s] = __uint_as_float(u[q]); myslot = s; }
      if (eq) { const int s = ngt + ceq + __popcll(me & below); if (s < CAP) { io[s] = q * 64 + lane; go[s] = __uint_as_float(u[q]); myslot = s; } }
      iv[q * 64 + lane] = myslot;
      cgt += __popcll(mg); ceq += __popcll(me);
    }
  }
}

DI void phase9(const Params& p, char* smem) {
  const int t = tid_(), lane = t & 63, w = t >> 6, r = lane & 31, hh = lane >> 5;
  const int wm = w & 1, wn = w >> 1;
  const int xcd = blockIdx.x & 7, jl = blockIdx.x >> 3, nl = gridDim.x >> 3;
  auto decode = [&](int L, int& e, int& ft, int& b) { e = xcd * 2 + (L >> 7); const int rem = L & 127; ft = (rem >> 3) & 3; b = (rem >> 5) * 8 + (rem & 7); };
  bool pre = false;
  for (int L = jl; L < 256; L += nl) {
    int e, ft, b, eN = 0, ftN = 0, bN = 0;
    decode(L, e, ft, b);
    const int Ln = L + nl; const bool hasNext = Ln < 256;
    if (hasNext) decode(Ln, eN, ftN, bN);
    const int be = b * NE + e;
    const bf16_t* Ab = p.WguT + ((size_t)e * 1024 + ft * 256) * DM;
    const int* ib = p.idx + be * CAP;
    const bf16_t* hb = p.h2 + (size_t)b * SEQ * DM;
    const bf16_t* AbN = p.WguT + ((size_t)eN * 1024 + ftN * 256) * DM;
    const int* ibN = p.idx + (bN * NE + eN) * CAP;
    const bf16_t* hbN = p.h2 + (size_t)bN * SEQ * DM;
    f32x16 acc[4][2];
#pragma unroll
    for (int a = 0; a < 4; ++a)
#pragma unroll
      for (int c = 0; c < 2; ++c) acc[a][c] = zero16();
    float dummy = 0.f;
    gemm8x<4, 2, 2, 4, false, 2>(acc, [&](int row) { return Ab + (size_t)row * DM; }, [&](int row) { return hb + (size_t)ib[row] * DM; }, DM, smem, dummy,
                              pre, hasNext, [&](int row) { return AbN + (size_t)row * DM; }, [&](int row) { return hbN + (size_t)ibN[row] * DM; });
    pre = hasNext;
    char* tile = smem + EPI_OFF;
#pragma unroll
    for (int tn = 0; tn < 2; ++tn)
#pragma unroll
      for (int pr = 0; pr < 2; ++pr) {
        char* d = tile + (wn * 64 + tn * 32 + r) * 272 + (wm * 64 + pr * 32 + 4 * hh) * 2;
#pragma unroll
        for (int q = 0; q < 4; ++q) {
          float v[4];
#pragma unroll
          for (int j = 0; j < 4; ++j) { const float g = acc[2 * pr][tn][4 * q + j], uu = acc[2 * pr + 1][tn][4 * q + j]; v[j] = g * sigmoidf_(g) * uu; }
          uint2 ou; ou.x = pk_bf16(v[0], v[1]); ou.y = pk_bf16(v[2], v[3]);
          *(uint2*)(d + 16 * q) = ou;
        }
      }
    lds_sync();
    bf16_t* hd_ = p.hmid + (size_t)be * CAP * DE + ft * 128;
    copy_tile(tile, 272, 256, 4, [&](int row) { return hd_ + (size_t)row * DE; }, 0, 16);
  }
}

DI void phase10(const Params& p, char* smem) {
  const int xcd = blockIdx.x & 7, jl = blockIdx.x >> 3, nl = gridDim.x >> 3;
  for (int L = jl; L < 512; L += nl) {
    const int e = xcd * 2 + (L >> 8), rem = L & 255, nt = (rem >> 3) & 3, st = (rem >> 5) & 1, b = (rem >> 6) * 8 + (rem & 7);
    const int be = b * NE + e;
    const bf16_t* Hb = p.hmid + ((size_t)be * CAP + st * 128) * DE;
    const bf16_t* Wb = p.WdT + ((size_t)e * DM + nt * 256) * DE;
    f32x16 acc[2][2];
#pragma unroll
    for (int a = 0; a < 2; ++a)
#pragma unroll
      for (int c = 0; c < 2; ++c) acc[a][c] = zero16();
    gemm8s3(acc, [&](int row) { return Wb + (size_t)row * DE; }, [&](int row) { return Hb + (size_t)row * DE; }, DE, smem);
    stage_tile<2, 2, 4, 2>(acc, smem, 528, [](float v) { return v; });
    lds_sync();
    bf16_t* yb = p.Y + ((size_t)be * CAP + st * 128) * DM + nt * 256;
    copy_tile(smem, 528, 128, 5, [&](int row) { return yb + (size_t)row * DM; }, 0, 32);
    lds_sync();
  }
}

DI void phase11(const Params& p) {
  const int t_ = tid_(); const int lane = t_ & 63, w = t_ >> 6;
  const int gw = blockIdx.x * NWV + w, nw = gridDim.x * NWV;
  for (int R = gw; R < NT; R += nw) {
    const int b = R >> 11, tq = R & 2047;
    const int myslot = (lane < NE) ? p.inv[((size_t)(b * NE + lane)) * SEQ + tq] : -1;
    unsigned long long mask = __ballot(myslot >= 0);
    if (mask == 0ull) continue;
    float* o = p.out + (size_t)R * DM;
    float4 xv[4];
#pragma unroll
    for (int i = 0; i < 4; ++i) xv[i] = *(const float4*)(o + lane * 4 + 256 * i);
    float4 a[4];
#pragma unroll
    for (int i = 0; i < 4; ++i) a[i] = make_float4(0.f, 0.f, 0.f, 0.f);
    while (mask) {
      const int e = __ffsll((long long)mask) - 1; mask &= mask - 1ull;
      const int slot = __shfl(myslot, e);
      const float g = p.gate[(b * NE + e) * CAP + slot];
      const bf16_t* y = p.Y + ((size_t)(b * NE + e) * CAP + slot) * DM + lane * 4;
#pragma unroll
      for (int i = 0; i < 4; ++i) {
        const uint2 u = *(const uint2*)(y + 256 * i);
        a[i].x += g * bf_lo(u.x); a[i].y += g * bf_hi(u.x); a[i].z += g * bf_lo(u.y); a[i].w += g * bf_hi(u.y);
      }
    }
    const float* g2 = p.mod + b * 6144 + 5120;
#pragma unroll
    for (int i = 0; i < 4; ++i) {
      const int d = lane * 4 + 256 * i;
      const float4 gv = *(const float4*)(g2 + d);
      *(float4*)(o + d) = make_float4(xv[i].x + gv.x * a[i].x, xv[i].y + gv.y * a[i].y, xv[i].z + gv.z * a[i].z, xv[i].w + gv.w * a[i].w);
    }
  }
}

__global__ void __launch_bounds__(NTH, 2) mega_kernel(Params p) {
  cg::grid_group grid = cg::this_grid();
  __shared__ __attribute__((aligned(16))) char smem[SMEM_BYTES];
#ifndef REPMASK
#define REPMASK 0
#endif
#define RUNPH(k, call) for (int rep_ = 0; rep_ < (((REPMASK) >> (k)) & 1) + 1; ++rep_) { call; grid.sync(); }
  RUNPH(0, phase0(p, smem))
  RUNPH(1, phase1(p))
  RUNPH(2, phase2(p, smem))
  RUNPH(3, phase3(p, smem))
  RUNPH(4, phase4(p, smem))
  RUNPH(5, phase5(p, smem))
  RUNPH(6, phase6(p, smem))
  RUNPH(7, phase7(p, smem))
  RUNPH(8, phase8(p))
  RUNPH(9, phase9(p, smem))
  RUNPH(10, phase10(p, smem))
  phase11(p);
}

static inline size_t align_up(size_t v, size_t a) { return (v + a - 1) / a * a; }

extern "C" void kernel_launch(void* const* d_in, const int* in_sizes, int n_in,
                              void* d_out, int out_size, void* d_ws, size_t ws_size,
                              hipStream_t stream) {
  static int grid_blocks = 0;
  if (!grid_blocks) {
    int dev = 0, cus = 0, per_cu = 0;
    (void)hipGetDevice(&dev);
    (void)hipDeviceGetAttribute(&cus, hipDeviceAttributeMultiprocessorCount, dev);
    (void)hipOccupancyMaxActiveBlocksPerMultiprocessor(&per_cu, mega_kernel, NTH, 0);
    if (per_cu > 1) per_cu = 1;
    if (per_cu < 1) per_cu = 1;
    grid_blocks = (cus * per_cu) & ~7;
    if (grid_blocks < 8) grid_blocks = 8;
  }
  Params p;
  memset(&p, 0, sizeof(p));
  p.x = (const float*)d_in[0]; p.c = (const float*)d_in[1]; p.ctx = (const float*)d_in[2]; p.c_ctx = (const float*)d_in[3];
  p.w_mod = (const float*)d_in[4]; p.b_mod = (const float*)d_in[5]; p.norm1_g = (const float*)d_in[6];
  const float* w_in = (const float*)d_in[7];
  const float* q_a_g = (const float*)d_in[8];
  const float* kv_a_g = (const float*)d_in[9];
  const float* w_q_up = (const float*)d_in[10];
  const float* w_kv_up = (const float*)d_in[11];
  p.q_norm_g = (const float*)d_in[12]; p.k_norm_g = (const float*)d_in[13];
  const float* w_o_attn = (const float*)d_in[14];
  const float* w_fourier = (const float*)d_in[15];
  const float* w_out = (const float*)d_in[16];
  p.norm2_g = (const float*)d_in[17]; p.w_router = (const float*)d_in[18];
  const float* w_e_gate = (const float*)d_in[19];
  const float* w_e_up = (const float*)d_in[20];
  const float* w_e_down = (const float*)d_in[21];
  p.out = (float*)d_out;

  char* base = (char*)d_ws; size_t off = 0;
  auto alloc = [&](size_t bytes) { char* q = base + off; off = align_up(off + bytes, 256); return q; };
  p.WinT = (bf16_t*)alloc((size_t)NINP * DM * 2);
  p.WqT = (bf16_t*)alloc((size_t)768 * QL * 2);
  p.WkvT = (bf16_t*)alloc((size_t)1024 * KVL * 2);
  p.WoT = (bf16_t*)alloc((size_t)DM * 512 * 2);
  p.WfT = (bf16_t*)alloc((size_t)DM * 512 * 2);
  p.WoutT = (bf16_t*)alloc((size_t)DM * DM * 2);
  p.WguT = (bf16_t*)alloc((size_t)NE * 1024 * DM * 2);
  p.WdT = (bf16_t*)alloc((size_t)NE * DM * DE * 2);
  p.chanT = (bf16_t*)alloc((size_t)256 * 128 * 2);
  p.posM = (bf16_t*)alloc((size_t)2 * 1152 * 2048 * 2);
  p.ropeTab = (float*)alloc(64 * 8 * 2 * 4);
  p.mod = (float*)alloc(33 * 6144 * 4);
  p.aff = (float*)alloc((size_t)NB * NE * SEQ * 4);
  p.gate = (float*)alloc((size_t)NB * NE * CAP * 4);
  p.idx = (int*)alloc((size_t)NB * NE * CAP * 4);
  p.inv = (int*)alloc((size_t)NB * NE * SEQ * 4);
  p.pckv = (bf16_t*)alloc((size_t)NC * LDCKV * 2 + 4096);
  char* regA = alloc((size_t)(NT + NC) * DM * 2);
  p.h = (bf16_t*)regA; p.ABt = (bf16_t*)regA; p.h2 = (bf16_t*)regA;
  char* regB1 = alloc((size_t)NT * LDQKV * 2);
  p.pqkv = (bf16_t*)regB1; p.attn_o = (bf16_t*)regB1;
  char* regB2 = alloc((size_t)NT * 512 * 2);
  p.pf = (bf16_t*)regB2; p.four_o = (bf16_t*)regB2;
  p.pg = (bf16_t*)alloc((size_t)NT * 2048 * 2);
  p.Y = p.pg;
  const size_t szQ = (size_t)NB * NH * SEQ * QKD * 2, szK = (size_t)NB * NH * NKEY * QKD * 2, szV = (size_t)NB * NH * VD * NKEY * 2;
  char* regC = alloc(szQ + szK + szV + 1024);
  p.Q = (bf16_t*)regC; p.K = (bf16_t*)(regC + align_up(szQ, 256)); p.Vt = (bf16_t*)(regC + align_up(szQ, 256) + align_up(szK, 256));
  p.m = (bf16_t*)regC; p.hmid = (bf16_t*)(regC + (size_t)NT * DM * 2);
  if (off > ws_size) { fprintf(stderr, "workspace too small: need %zu have %zu\n", off, ws_size); return; }

  int ts = 0;
  auto job = [&](int i, const float* src, bf16_t* dst, const float* scale, int K, int ldS, int n_off, int n_cnt, int dst_row0, int mode, int batch, long sbs, long dbs) {
    TJob& j = p.jobs[i];
    j.src = src; j.dst = dst; j.scale = scale; j.K = K; j.ldS = ldS; j.n_off = n_off; j.n_cnt = n_cnt; j.dst_row0 = dst_row0; j.mode = mode; j.batch = batch;
    j.tiles_n = (n_cnt + 63) / 64; j.tile_start = ts; j.src_bstride = sbs; j.dst_bstride = dbs;
    ts += batch * (K / 64) * j.tiles_n;
  };
  job(0, w_e_gate, p.WguT, nullptr, DM, DE, 0, DE, 0, 1, NE, (long)DM * DE, (long)1024 * DM);
  job(1, w_e_up, p.WguT, nullptr, DM, DE, 0, DE, 0, 2, NE, (long)DM * DE, (long)1024 * DM);
  job(2, w_e_down, p.WdT, nullptr, DE, DM, 0, DM, 0, 0, NE, (long)DE * DM, (long)DM * DE);
  job(3, w_in, p.WinT, nullptr, DM, N_IN, 0, 672, 0, 0, 1, 0, 0);
  job(4, w_in, p.WinT, nullptr, DM, N_IN, 672, 2560, 768, 0, 1, 0, 0);
  job(5, w_q_up, p.WqT, q_a_g, QL, 768, 0, 768, 0, 0, 1, 0, 0);
  job(6, w_kv_up, p.WkvT, kv_a_g, KVL, 1024, 0, 1024, 0, 0, 1, 0, 0);
  job(7, w_o_attn, p.WoT, nullptr, 512, DM, 0, DM, 0, 0, 1, 0, 0);
  job(8, w_fourier, p.WfT, nullptr, 512, DM, 0, DM, 0, 0, 1, 0, 0);
  job(9, w_out, p.WoutT, nullptr, DM, DM, 0, DM, 0, 0, 1, 0, 0);
  p.n_ttiles = ts;

  void* args[] = {&p};
  hipError_t e = hipLaunchCooperativeKernel((void*)mega_kernel, dim3(grid_blocks), dim3(NTH), args, 0, stream);
  if (e != hipSuccess) fprintf(stderr, "cooperative launch failed: %s (grid %d)\n", hipGetErrorString(e), grid_blocks);
}
```

```cpp
#include <hip/hip_runtime.h>
#include <hip/hip_cooperative_groups.h>
#include <cstdio>
#include <cstring>
#include <cstdint>
namespace cg = cooperative_groups;

#define DI __device__ __forceinline__
typedef unsigned short bf16_t;
typedef short bf16x8 __attribute__((ext_vector_type(8)));
typedef float f32x16 __attribute__((ext_vector_type(16)));
#define MFMA(a, b, c) __builtin_amdgcn_mfma_f32_32x32x16_bf16((a), (b), (c), 0, 0, 0)

constexpr int NB = 32, SEQ = 2048, DM = 1024, NT = NB * SEQ, CTXL = 256, NC = NB * CTXL;
constexpr int NH = 8, QKD = 96, VD = 64, QL = 384, KVL = 256, NKEY = SEQ + CTXL;
constexpr int N_IN = 3232, NINP = 3328;
constexpr int NE = 16, DE = 512, CAP = 256;
constexpr float EPS = 1e-6f;
constexpr int LDQKV = 672, LDCKV = 288;
constexpr int NTH = 512, NWV = 8;
constexpr int SMEM_BYTES = 147456;

struct TJob {
  const float* src; bf16_t* dst; const float* scale;
  int K, ldS, n_off, n_cnt, dst_row0, mode, batch, tiles_n, tile_start, pad0;
  long src_bstride, dst_bstride;
};
constexpr int NJOBS = 10;

struct Params {
  const float *x, *c, *ctx, *c_ctx, *w_mod, *b_mod, *norm1_g, *q_norm_g, *k_norm_g, *norm2_g, *w_router;
  float* out;
  bf16_t *WinT, *WqT, *WkvT, *WoT, *WfT, *WoutT, *WguT, *WdT, *chanT, *posM;
  float *ropeTab, *mod;
  bf16_t *h, *pqkv, *pckv, *pf, *pg, *Q, *K, *Vt, *attn_o, *ABt, *four_o, *m, *h2, *hmid;
  float *aff, *gate;
  int* idx;
  int* inv;
  bf16_t* Y;
  bf16_t* x1b;
  TJob jobs[NJOBS];
  int n_ttiles, pad1;
};

typedef float f32x2v __attribute__((ext_vector_type(2)));
typedef __bf16 bf16x2v __attribute__((ext_vector_type(2)));
DI unsigned pk_bf16(float lo, float hi) { f32x2v v = {lo, hi}; bf16x2v b = __builtin_convertvector(v, bf16x2v); return __builtin_bit_cast(unsigned, b); }
DI int tid_() { int t = threadIdx.x; asm volatile("" : "+v"(t)); return t; }
DI float bf_lo(unsigned u) { return __uint_as_float(u << 16); }
DI float bf_hi(unsigned u) { return __uint_as_float(u & 0xffff0000u); }
DI bf16_t f2bf(float f) { return (bf16_t)(pk_bf16(f, 0.f) & 0xffffu); }
DI float sigmoidf_(float x) { return 1.f / (1.f + __expf(-x)); }
DI int crow(int i, int hh) { return (i & 3) + 8 * (i >> 2) + 4 * hh; }
DI float wave_sum(float v) {
#pragma unroll
  for (int o = 32; o >= 1; o >>= 1) v += __shfl_xor(v, o);
  return v;
}
DI f32x16 zero16() { f32x16 z;
#pragma unroll
  for (int i = 0; i < 16; ++i) z[i] = 0.f; return z; }
DI void wait_vm0() { asm volatile("s_waitcnt vmcnt(0)" ::: "memory"); }
DI void wait_lgkm0() { asm volatile("s_waitcnt lgkmcnt(0)" ::: "memory"); }
DI void bar_() { __builtin_amdgcn_s_barrier(); }
DI void lds_sync() { wait_lgkm0(); bar_(); }
#define GLDS(gp, lp) __builtin_amdgcn_global_load_lds((const unsigned*)(gp), (__attribute__((address_space(3))) unsigned*)(lp), 16, 0, 0)
#define SB_ __builtin_amdgcn_sched_barrier(0)

constexpr int EPI_OFF = 65536;
template <int TM, int TN, int WM, int WN, bool SUMSQ, int NST, class AF, class BF, class AFN, class BFN>
DI void gemm8x(f32x16 (&acc)[TM][TN], AF arow, BF brow, int K, char* smem, float& sumsq, bool pre, bool hasNext, AFN arowN, BFN browN) {
  constexpr int RA = 32 * TM * WM, RB = 32 * TN * WN;
  constexpr int LDR = 128, STAGE = (RA + RB) * LDR;
  static_assert(WM * WN == NWV, "waves");
  static_assert(NST * STAGE <= SMEM_BYTES, "smem");
  static_assert(NST == 2 || (NST == 3 && RA == 256 && RB == 128), "3-stage ring: 6 loads per thread per stage assumed");
  static_assert(RA <= 256 && RB <= 256 && RA % 32 == 0 && RB % 32 == 0, "shape");
  const int t = tid_(), lane = t & 63, w = t >> 6, r = lane & 31, hh = lane >> 5;
  const int wm = w % WM, wn = w / WM;
  const int row0 = t >> 3;
  const int c = (t & 7) ^ ((row0 >> 1) & 7);
  const bool a0v = row0 < RA, a1v = row0 + 64 < RA, a2v = row0 + 128 < RA, a3v = row0 + 192 < RA;
  const bool b0v = row0 < RB, b1v = row0 + 64 < RB, b2v = row0 + 128 < RB, b3v = row0 + 192 < RB;
  const bf16_t* pa0 = arow(a0v ? row0 : 0) + c * 8;
  const bf16_t* pa1 = arow(a1v ? row0 + 64 : 0) + c * 8;
  const bf16_t* pa2 = arow(a2v ? row0 + 128 : 0) + c * 8;
  const bf16_t* pa3 = arow(a3v ? row0 + 192 : 0) + c * 8;
  const bf16_t* pb0 = brow(b0v ? row0 : 0) + c * 8;
  const bf16_t* pb1 = brow(b1v ? row0 + 64 : 0) + c * 8;
  const bf16_t* pb2 = brow(b2v ? row0 + 128 : 0) + c * 8;
  const bf16_t* pb3 = brow(b3v ? row0 + 192 : 0) + c * 8;
  if (!pre) {
    char* l_ = smem + t * 16; char* m_ = l_ + RA * LDR;
    if (a0v) GLDS(pa0, l_); if (a1v) GLDS(pa1, l_ + 8192); if (a2v) GLDS(pa2, l_ + 16384); if (a3v) GLDS(pa3, l_ + 24576);
    if (b0v) GLDS(pb0, m_); if (b1v) GLDS(pb1, m_ + 8192); if (b2v) GLDS(pb2, m_ + 16384); if (b3v) GLDS(pb3, m_ + 24576);
  }
  if (NST == 3) {
    char* l_ = smem + STAGE + t * 16; char* m_ = l_ + RA * LDR;
    GLDS(pa0 + 64, l_); GLDS(pa1 + 64, l_ + 8192); GLDS(pa2 + 64, l_ + 16384); GLDS(pa3 + 64, l_ + 24576);
    GLDS(pb0 + 64, m_); GLDS(pb1 + 64, m_ + 8192);
    asm volatile("s_waitcnt vmcnt(6)" ::: "memory");
  } else wait_vm0();
  bar_();
  const int nk = K >> 6;
  const int sw = (r >> 1) & 7;
  const int aoff = (wm * TM * 32 + r) * LDR, boff = RA * LDR + (wn * TN * 32 + r) * LDR;
  auto compute = [&](const char* cur, char* nxt, bool issue, const bf16_t* q0, const bf16_t* q1, const bf16_t* q2, const bf16_t* q3,
                     const bf16_t* s0, const bf16_t* s1, const bf16_t* s2, const bf16_t* s3) {
    const char* As = cur + aoff;
    const char* Bs = cur + boff;
    char* l_ = nxt + t * 16; char* m_ = l_ + RA * LDR;
    bf16x8 a0[TM], b0[TN], a1[TM], b1[TN];
#define LOADF(A_, B_, ks) do { const int po_ = (((ks) * 2 + hh) ^ sw) * 16; \
      _Pragma("unroll") for (int tm = 0; tm < TM; ++tm) A_[tm] = *(const bf16x8*)(As + tm * 32 * LDR + po_); \
      _Pragma("unroll") for (int tn = 0; tn < TN; ++tn) B_[tn] = *(const bf16x8*)(Bs + tn * 32 * LDR + po_); } while (0)
#define MMF(A_, B_) do { if (SUMSQ) { uint4 u = __builtin_bit_cast(uint4, B_[0]); \
        float e0 = bf_lo(u.x), e1 = bf_hi(u.x), e2 = bf_lo(u.y), e3 = bf_hi(u.y), e4 = bf_lo(u.z), e5 = bf_hi(u.z), e6 = bf_lo(u.w), e7 = bf_hi(u.w); \
        sumsq += e0 * e0 + e1 * e1 + e2 * e2 + e3 * e3 + e4 * e4 + e5 * e5 + e6 * e6 + e7 * e7; } \
      _Pragma("unroll") for (int tm = 0; tm < TM; ++tm) _Pragma("unroll") for (int tn = 0; tn < TN; ++tn) acc[tm][tn] = MFMA(A_[tm], B_[tn], acc[tm][tn]); } while (0)
    LOADF(a0, b0, 0);
    LOADF(a1, b1, 1);
    SB_;
    if (issue) { if (a0v) GLDS(q0, l_); if (a1v) GLDS(q1, l_ + 8192); }
    SB_;
    __builtin_amdgcn_s_setprio(1);
    MMF(a0, b0);
    LOADF(a0, b0, 2);
    SB_;
    if (issue) { if (a2v) GLDS(q2, l_ + 16384); if (a3v) GLDS(q3, l_ + 24576); }
    SB_;
    MMF(a1, b1);
    LOADF(a1, b1, 3);
    SB_;
    if (issue) { if (b0v) GLDS(s0, m_); if (b1v) GLDS(s1, m_ + 8192); }
    SB_;
    MMF(a0, b0);
    SB_;
    if (issue) { if (b2v) GLDS(s2, m_ + 16384); if (b3v) GLDS(s3, m_ + 24576); }
    SB_;
    MMF(a1, b1);
    __builtin_amdgcn_s_setprio(0);
  };
  int sc_ = 0;
  for (int kt = 0; kt < nk - 1; ++kt) {
    SB_;
    if (NST == 2) {
      const int ko = (kt + 1) * 64;
      compute(smem + (kt & 1) * STAGE, smem + ((kt + 1) & 1) * STAGE, true, pa0 + ko, pa1 + ko, pa2 + ko, pa3 + ko, pb0 + ko, pb1 + ko, pb2 + ko, pb3 + ko);
      SB_;
      wait_vm0(); bar_();
    } else {
      const int ko = (kt + 2) * 64; const bool iss = kt + 2 < nk;
      const int sn = (sc_ == 0) ? 2 : sc_ - 1;
      compute(smem + sc_ * STAGE, smem + sn * STAGE, iss, pa0 + ko, pa1 + ko, pa2 + ko, pa3 + ko, pb0 + ko, pb1 + ko, pb2 + ko, pb3 + ko);
      SB_;
      if (iss) asm volatile("s_waitcnt vmcnt(6)" ::: "memory"); else wait_vm0();
      bar_();
      sc_ = (sc_ == 2) ? 0 : sc_ + 1;
    }
  }
  if (NST == 3) {
    SB_;
    compute(smem + sc_ * STAGE, smem, false, pa0, pa0, pa0, pa0, pa0, pa0, pa0, pa0);
    SB_;
    lds_sync();
  } else {
    const bf16_t *q0 = pa0, *q1 = pa0, *q2 = pa0, *q3 = pa0, *s0 = pa0, *s1 = pa0, *s2 = pa0, *s3 = pa0;
    if (hasNext) {
      q0 = arowN(a0v ? row0 : 0) + c * 8; q1 = arowN(a1v ? row0 + 64 : 0) + c * 8; q2 = arowN(a2v ? row0 + 128 : 0) + c * 8; q3 = arowN(a3v ? row0 + 192 : 0) + c * 8;
      s0 = browN(b0v ? row0 : 0) + c * 8; s1 = browN(b1v ? row0 + 64 : 0) + c * 8; s2 = browN(b2v ? row0 + 128 : 0) + c * 8; s3 = browN(b3v ? row0 + 192 : 0) + c * 8;
    }
    SB_;
    compute(smem + ((nk - 1) & 1) * STAGE, smem, hasNext, q0, q1, q2, q3, s0, s1, s2, s3);
    SB_;
    lds_sync();
  }
}
template <int TM, int TN, int WM, int WN, bool SUMSQ, class AF, class BF>
DI void gemm8(f32x16 (&acc)[TM][TN], AF arow, BF brow, int K, char* smem, float& sumsq) {
  gemm8x<TM, TN, WM, WN, SUMSQ, 2>(acc, arow, brow, K, smem, sumsq, false, false, arow, brow);
}
template <class AF, class BF>
DI void gemm8s3(f32x16 (&acc)[2][2], AF arow, BF brow, int K, char* smem) {
  float dummy = 0.f;
  gemm8x<2, 2, 4, 2, false, 3>(acc, arow, brow, K, smem, dummy, false, false, arow, brow);
}
template <int TM, int WM, int WN, int TNSEL, class F>
DI void stage_half(const f32x16 (&acc)[TM][2], char* tile, int pitch, F f) {
  const int t = tid_(), lane = t & 63, w = t >> 6, r = lane & 31, hh = lane >> 5;
  const int wm = w % WM, wn = w / WM;
#pragma unroll
  for (int tm = 0; tm < TM; ++tm) {
    char* d = tile + (wn * 32 + r) * pitch + (wm * TM * 32 + tm * 32 + 4 * hh) * 2;
#pragma unroll
    for (int q = 0; q < 4; ++q) {
      const f32x16& a = acc[tm][TNSEL];
      uint2 o; o.x = pk_bf16(f(a[4 * q]), f(a[4 * q + 1])); o.y = pk_bf16(f(a[4 * q + 2]), f(a[4 * q + 3]));
      *(uint2*)(d + 16 * q) = o;
    }
  }
}

template <int TM, int TN, int WM, int WN, class F>
DI void stage_tile(const f32x16 (&acc)[TM][TN], char* tile, int pitch, F f) {
  const int t = tid_(), lane = t & 63, w = t >> 6, r = lane & 31, hh = lane >> 5;
  const int wm = w % WM, wn = w / WM;
#pragma unroll
  for (int tm = 0; tm < TM; ++tm)
#pragma unroll
    for (int tn = 0; tn < TN; ++tn) {
      char* d = tile + (wn * TN * 32 + tn * 32 + r) * pitch + (wm * TM * 32 + tm * 32 + 4 * hh) * 2;
#pragma unroll
      for (int q = 0; q < 4; ++q) {
        uint2 o; o.x = pk_bf16(f(acc[tm][tn][4 * q]), f(acc[tm][tn][4 * q + 1])); o.y = pk_bf16(f(acc[tm][tn][4 * q + 2]), f(acc[tm][tn][4 * q + 3]));
        *(uint2*)(d + 16 * q) = o;
      }
    }
}
template <class RF>
DI void copy_tile(const char* tile, int pitch, int rows, int lch, RF dst, int ch0, int ch1) {
  const int t = tid_();
  const int total = rows << lch;
  for (int id = t; id < total; id += NTH) {
    const int row = id >> lch, ch = id & ((1 << lch) - 1);
    if (ch >= ch0 && ch < ch1) *(uint4*)(dst(row) + ch * 8) = *(const uint4*)(tile + row * pitch + ch * 16);
  }
}

DI void transpose_tile(const TJob& j, int tile, char* smem) {
  const int t = tid_();
  const int tpb = (j.K >> 6) * j.tiles_n;
  const int bi = tile / tpb, rem = tile % tpb;
  const int kt = rem / j.tiles_n, ntile = rem % j.tiles_n;
  const int k0 = kt * 64, n0 = ntile * 64;
  const float* src = j.src + (size_t)bi * j.src_bstride;
  bf16_t* dst = j.dst + (size_t)bi * j.dst_bstride;
  bf16_t* T = (bf16_t*)smem;
  const int nn = t & 63, kq = t >> 6;
  const bool nvalid = (n0 + nn) < j.n_cnt;
  __syncthreads();
#pragma unroll 4
  for (int i = 0; i < 8; ++i) {
    const int kk = kq + 8 * i;
    float v = 0.f;
    if (nvalid) {
      v = src[(size_t)(k0 + kk) * j.ldS + j.n_off + n0 + nn];
      if (j.scale) v *= j.scale[k0 + kk];
    }
    T[nn * 66 + kk] = f2bf(v);
  }
  __syncthreads();
  const int n = t >> 3, part = t & 7;
  if (n0 + n < j.n_cnt) {
    const unsigned* tp = (const unsigned*)(T + n * 66 + part * 8);
    uint4 o0; o0.x = tp[0]; o0.y = tp[1]; o0.z = tp[2]; o0.w = tp[3];
    const int f = n0 + n;
    int drow;
    if (j.mode == 0) drow = j.dst_row0 + f;
    else drow = (f >> 7) * 256 + ((f >> 6) & 1) * 128 + (((f >> 5) & 1) * 2 + (j.mode == 2 ? 1 : 0)) * 32 + (f & 31);
    *(uint4*)(dst + (size_t)drow * j.K + k0 + part * 8) = o0;
  }
}

DI void mod_item(const Params& p, int it, char* smem) {
  const int t = tid_(), cgi = t & 15, kg = t >> 4;
  const int j0 = it * 16;
  float* Ssm = (float*)smem;
  float* red = (float*)(smem + 33 * 128 * 4);
  float acc[33];
#pragma unroll
  for (int r = 0; r < 33; ++r) acc[r] = 0.f;
#pragma unroll 1
  for (int kc = 0; kc < 8; ++kc) {
    __syncthreads();
    for (int idx = t; idx < 33 * 128; idx += NTH) {
      const int r = idx >> 7, kk = idx & 127;
      float v = (r < 32) ? p.c[r * DM + kc * 128 + kk] : p.c_ctx[kc * 128 + kk];
      Ssm[idx] = v * sigmoidf_(v);
    }
    __syncthreads();
    const int k = kc * 128 + kg * 4;
    const float w0 = p.w_mod[(size_t)(k + 0) * 6144 + j0 + cgi];
    const float w1 = p.w_mod[(size_t)(k + 1) * 6144 + j0 + cgi];
    const float w2 = p.w_mod[(size_t)(k + 2) * 6144 + j0 + cgi];
    const float w3 = p.w_mod[(size_t)(k + 3) * 6144 + j0 + cgi];
#pragma unroll
    for (int r = 0; r < 33; ++r) {
      const float4 s = *(const float4*)(Ssm + r * 128 + kg * 4);
      acc[r] += s.x * w0 + s.y * w1 + s.z * w2 + s.w * w3;
    }
  }
  __syncthreads();
#pragma unroll
  for (int r = 0; r < 33; ++r) red[(kg * 33 + r) * 16 + cgi] = acc[r];
  __syncthreads();
  for (int idx = t; idx < 33 * 16; idx += NTH) {
    const int r = idx >> 4, cc = idx & 15;
    float s = 0.f;
#pragma unroll
    for (int g = 0; g < 32; ++g) s += red[(g * 33 + r) * 16 + cc];
    p.mod[r * 6144 + j0 + cc] = s + p.b_mod[j0 + cc];
  }
}

DI void phase0(const Params& p, char* smem) {
  const int t = tid_();
  const int nMod = 384;
  const int nPos = 288;
  const int nMisc = 3;
  const int nT = p.n_ttiles;
  const int total = nMod + nT + nPos + nMisc;
  float* ctab = (float*)(smem + 98304);
  for (int j = t; j < 2048; j += NTH) ctab[j] = cospif((float)j * (1.f / 1024.f));
  __syncthreads();
  for (int it = blockIdx.x; it < total; it += gridDim.x) {
    if (it < nMod) { mod_item(p, it, smem); continue; }
    int u = it - nMod;
    if (u < nT) {
      int jb = 0;
#pragma unroll 1
      for (int q = 1; q < NJOBS; ++q) if (u >= p.jobs[q].tile_start) jb = q;
      transpose_tile(p.jobs[jb], u - p.jobs[jb].tile_start, smem);
      continue;
    }
    u -= nT;
    if (u < nPos) {
      for (int e = t; e < 8 * 256; e += NTH) {
        const int R = u * 8 + (e >> 8), c8 = (e & 255) * 8;
        const int part = R >= 1152 ? 1 : 0, k = R - part * 1152;
        float v[8];
#pragma unroll
        for (int q = 0; q < 8; ++q) {
          const int tt = c8 + q;
          v[q] = (k > 1024) ? 0.f : (part ? ctab[(k * tt - 512) & 2047] : ctab[(k * tt) & 2047]);
        }
        uint4 o; o.x = pk_bf16(v[0], v[1]); o.y = pk_bf16(v[2], v[3]); o.z = pk_bf16(v[4], v[5]); o.w = pk_bf16(v[6], v[7]);
        *(uint4*)(p.posM + (size_t)R * 2048 + c8) = o;
      }
      continue;
    }
    u -= nPos;
    if (u == 0) {
      for (int e = t; e < 256 * 128; e += NTH) {
        const int m2 = e >> 7, cc = e & 127, mm = m2 & 127;
        float v = (m2 < 128) ? ctab[(mm * cc * 16) & 2047] : ctab[(mm * cc * 16 - 512) & 2047];
        p.chanT[e] = f2bf(v);
      }
    } else if (u == 1) {
      for (int e = t; e < 64 * 8; e += NTH) {
        const int pos = e >> 3, jf = e & 7;
        const float inv = 1.0f / powf(10000.0f, (float)jf / 8.0f);
        const float ang = (float)pos * inv;
        p.ropeTab[e * 2 + 0] = cosf(ang);
        p.ropeTab[e * 2 + 1] = sinf(ang);
      }
    } else {
      uint4 z; z.x = z.y = z.z = z.w = 0u;
      uint4* dp = (uint4*)(p.WinT + (size_t)672 * DM);
      for (int e = t; e < 96 * DM / 8; e += NTH) dp[e] = z;
    }
  }
}

DI void phase1(const Params& p) {
  const int t_ = tid_(); const int lane = t_ & 63, w = t_ >> 6;
  const int gw = blockIdx.x * NWV + w, nw = gridDim.x * NWV;
  for (int R0 = gw; R0 < NT + NC; R0 += 2 * nw) {
    const int R1 = R0 + nw; const bool has1 = R1 < NT + NC;
    const float* src0 = (R0 < NT) ? p.x + (size_t)R0 * DM : p.ctx + (size_t)(R0 - NT) * DM;
    const float* src1 = has1 ? ((R1 < NT) ? p.x + (size_t)R1 * DM : p.ctx + (size_t)(R1 - NT) * DM) : src0;
    const float* md0 = p.mod + ((R0 < NT) ? (R0 >> 11) : 32) * 6144;
    const float* md1 = p.mod + ((has1 && R1 < NT) ? (R1 >> 11) : 32) * 6144;
    float4 v0[4], v1[4]; float s0 = 0.f, s1 = 0.f;
#pragma unroll
    for (int i = 0; i < 4; ++i) { v0[i] = *(const float4*)(src0 + lane * 4 + 256 * i); v1[i] = *(const float4*)(src1 + lane * 4 + 256 * i); }
#pragma unroll
    for (int i = 0; i < 4; ++i) { s0 += v0[i].x * v0[i].x + v0[i].y * v0[i].y + v0[i].z * v0[i].z + v0[i].w * v0[i].w; s1 += v1[i].x * v1[i].x + v1[i].y * v1[i].y + v1[i].z * v1[i].z + v1[i].w * v1[i].w; }
    s0 = wave_sum(s0); s1 = wave_sum(s1);
    const float r0 = rsqrtf(s0 * (1.f / DM) + EPS), r1 = rsqrtf(s1 * (1.f / DM) + EPS);
#pragma unroll
    for (int i = 0; i < 4; ++i) {
      const int d = lane * 4 + 256 * i;
      const float4 g = *(const float4*)(p.norm1_g + d);
      {
        const float4 sh = *(const float4*)(md0 + d), sc = *(const float4*)(md0 + 1024 + d);
        uint2 o; o.x = pk_bf16(v0[i].x * r0 * g.x * (1.f + sc.x) + sh.x, v0[i].y * r0 * g.y * (1.f + sc.y) + sh.y);
        o.y = pk_bf16(v0[i].z * r0 * g.z * (1.f + sc.z) + sh.z, v0[i].w * r0 * g.w * (1.f + sc.w) + sh.w);
        *(uint2*)(p.h + (size_t)R0 * DM + d) = o;
      }
      if (has1) {
        const float4 sh = *(const float4*)(md1 + d), sc = *(const float4*)(md1 + 1024 + d);
        uint2 o; o.x = pk_bf16(v1[i].x * r1 * g.x * (1.f + sc.x) + sh.x, v1[i].y * r1 * g.y * (1.f + sc.y) + sh.y);
        o.y = pk_bf16(v1[i].z * r1 * g.z * (1.f + sc.z) + sh.z, v1[i].w * r1 * g.w * (1.f + sc.w) + sh.w);
        *(uint2*)(p.h + (size_t)R1 * DM + d) = o;
      }
    }
  }
}

DI void phase2(const Params& p, char* smem) {
  const int xcd = blockIdx.x & 7, jl = blockIdx.x >> 3, nl = gridDim.x >> 3;
  auto decode = [&](int L, int& tokTile, int& ft) {
    if (L < 416) { const int tg = L / 104, rem = L % 104; ft = rem >> 3; tokTile = xcd * 32 + tg * 8 + (rem & 7); }
    else { const int u = L - 416; tokTile = 256 + xcd * 4 + (u >> 1); ft = 1 + (u & 1); }
  };
  bool pre = false;
  for (int L = jl; L < 416 + 8; L += nl) {
    int tokTile, ft, tokTileN = 0, ftN = 0;
    decode(L, tokTile, ft);
    const bool lat = L < 416;
    const int Ln = L + nl; const bool hasNext = Ln < 416 + 8;
    if (hasNext) decode(Ln, tokTileN, ftN);
    f32x16 acc[4][2];
#pragma unroll
    for (int a = 0; a < 4; ++a)
#pragma unroll
      for (int b = 0; b < 2; ++b) acc[a][b] = zero16();
    const bf16_t* Ab = p.WinT + (size_t)ft * 256 * DM;
    const bf16_t* Bb = p.h + (size_t)tokTile * 256 * DM;
    const bf16_t* AbN = p.WinT + (size_t)ftN * 256 * DM;
    const bf16_t* BbN = p.h + (size_t)tokTileN * 256 * DM;
    float dummy = 0.f;
    gemm8x<4, 2, 2, 4, false, 2>(acc, [&](int row) { return Ab + (size_t)row * DM; }, [&](int row) { return Bb + (size_t)row * DM; }, DM, smem, dummy,
                              pre, hasNext, [&](int row) { return AbN + (size_t)row * DM; }, [&](int row) { return BbN + (size_t)row * DM; });
    pre = hasNext;
    char* tile = smem + EPI_OFF;
    bf16_t* base; int ld, c0 = 0, c1 = 32;
    if (lat) {
      const size_t tok0 = (size_t)tokTile * 256;
      if (ft < 3) { base = p.pqkv + tok0 * LDQKV + ft * 256; ld = LDQKV; if (ft == 2) c1 = 20; }
      else if (ft < 5) { base = p.pf + tok0 * 512 + (ft - 3) * 256; ld = 512; }
      else { base = p.pg + tok0 * 2048 + (ft - 5) * 256; ld = 2048; }
    } else {
      const size_t ct0 = (size_t)(tokTile - 256) * 256;
      base = p.pckv + ct0 * LDCKV + ft * 256 - 384; ld = LDCKV;
      if (ft == 1) c0 = 16; else c1 = 20;
    }
    if (ft >= 5) stage_half<4, 2, 4, 0>(acc, tile, 528, [](float v) { return sigmoidf_(v); });
    else stage_half<4, 2, 4, 0>(acc, tile, 528, [](float v) { return v; });
    lds_sync();
    copy_tile(tile, 528, 128, 5, [&](int rl) { return base + (size_t)((rl >> 5) * 64 + (rl & 31)) * ld; }, c0, c1);
    lds_sync();
    if (ft >= 5) stage_half<4, 2, 4, 1>(acc, tile, 528, [](float v) { return sigmoidf_(v); });
    else stage_half<4, 2, 4, 1>(acc, tile, 528, [](float v) { return v; });
    lds_sync();
    copy_tile(tile, 528, 128, 5, [&](int rl) { return base + (size_t)((rl >> 5) * 64 + 32 + (rl & 31)) * ld; }, c0, c1);
  }
}

DI void rope_pair(float& x1, float& x2, const float* tab) { const float c = tab[0], s = tab[1]; const float a = x1 * c - x2 * s, b = x2 * c + x1 * s; x1 = a; x2 = b; }

DI void phase3(const Params& p, char* smem) {
  const int t = tid_(), lane = t & 63, w = t >> 6, r = lane & 31, hh = lane >> 5;
  const int nKV = 288, nQ = 256, nCh = 128;
  const int xcd = blockIdx.x & 7, jl = blockIdx.x >> 3, nl = gridDim.x >> 3;
  for (int it = jl; it < nKV + nQ + nCh; it += nl) {
    if (it < nKV) {
      const int tl_ = it >> 3, hd = it & 7;
      const bool lat = tl_ < 32;
      const bf16_t* Bb; int ldb; const bf16_t* kpeb;
      int b, key0;
      if (lat) { const int tokTile = xcd * 32 + tl_; Bb = p.pqkv + (size_t)tokTile * 256 * LDQKV + QL; ldb = LDQKV; kpeb = p.pqkv + (size_t)tokTile * 256 * LDQKV + 640; b = tokTile >> 3; key0 = (tokTile & 7) * 256; }
      else { const int ct = xcd * 4 + (tl_ - 32); Bb = p.pckv + (size_t)ct * 256 * LDCKV; ldb = LDCKV; kpeb = Bb + 256; b = ct; key0 = SEQ; }
      const bf16_t* Ab = p.WkvT + (size_t)hd * 128 * KVL;
      f32x16 acc[4][1];
#pragma unroll
      for (int a = 0; a < 4; ++a) acc[a][0] = zero16();
      float sumsq = 0.f;
      gemm8<4, 1, 1, 8, true>(acc, [&](int row) { return Ab + (size_t)row * KVL; }, [&](int row) { return Bb + (size_t)row * ldb; }, KVL, smem, sumsq);
      sumsq += __shfl_xor(sumsq, 32);
      const float ra = rsqrtf(sumsq * (1.f / KVL) + EPS);
      const int tl = w * 32 + r;
      const int key = key0 + tl;
      float kp[16];
#pragma unroll
      for (int q = 0; q < 4; ++q) {
        const uint2 u = *(const uint2*)(kpeb + (size_t)tl * ldb + 8 * q + 4 * hh);
        kp[4 * q + 0] = bf_lo(u.x); kp[4 * q + 1] = bf_hi(u.x); kp[4 * q + 2] = bf_lo(u.y); kp[4 * q + 3] = bf_hi(u.y);
      }
      float ss = 0.f;
#pragma unroll
      for (int tm = 0; tm < 4; ++tm)
#pragma unroll
        for (int i = 0; i < 16; ++i) { const float v = acc[tm][0][i] * ra; acc[tm][0][i] = v; if (tm < 2) ss += v * v; }
#pragma unroll
      for (int i = 0; i < 16; ++i) ss += kp[i] * kp[i];
      ss += __shfl_xor(ss, 32);
      const float rk = rsqrtf(ss * (1.f / QKD) + EPS);
#pragma unroll
      for (int i = 0; i < 16; ++i) kp[i] *= rk * p.k_norm_g[64 + crow(i, hh)];
      if (lat) {
        const int pos = key;
        const float* tr = p.ropeTab + ((pos >> 6) * 8 + 4 * hh) * 2;
        const float* tc = p.ropeTab + ((pos & 63) * 8 + 4 * hh) * 2;
#pragma unroll
        for (int i = 0; i < 4; ++i) { rope_pair(kp[i], kp[i + 4], tr + 2 * i); rope_pair(kp[8 + i], kp[12 + i], tc + 2 * i); }
      }
      {
        char* kt_ = smem; char* vt_ = smem + 256 * 208;
        char* kd = kt_ + tl * 208;
#pragma unroll
        for (int tm = 0; tm < 2; ++tm)
#pragma unroll
          for (int q = 0; q < 4; ++q) {
            const int f = tm * 32 + 8 * q + 4 * hh;
            const float4 g = *(const float4*)(p.k_norm_g + f);
            uint2 o; o.x = pk_bf16(acc[tm][0][4 * q] * rk * g.x, acc[tm][0][4 * q + 1] * rk * g.y); o.y = pk_bf16(acc[tm][0][4 * q + 2] * rk * g.z, acc[tm][0][4 * q + 3] * rk * g.w);
            *(uint2*)(kd + f * 2) = o;
          }
#pragma unroll
        for (int q = 0; q < 4; ++q) {
          uint2 o; o.x = pk_bf16(kp[4 * q], kp[4 * q + 1]); o.y = pk_bf16(kp[4 * q + 2], kp[4 * q + 3]);
          *(uint2*)(kd + (64 + 8 * q + 4 * hh) * 2) = o;
        }
#pragma unroll
        for (int tm = 2; tm < 4; ++tm)
#pragma unroll
          for (int i = 0; i < 16; ++i) *(bf16_t*)(vt_ + ((tm - 2) * 32 + crow(i, hh)) * 528 + tl * 2) = f2bf(acc[tm][0][i]);
        lds_sync();
        const int tc_ = tid_();
        bf16_t* Kg = p.K + ((size_t)(b * NH + hd) * NKEY + key0) * QKD;
#pragma unroll
        for (int i = 0; i < 6; ++i) {
          const int id = tc_ + NTH * i, row = id / 12, ch = id % 12;
          *(uint4*)(Kg + row * QKD + ch * 8) = *(const uint4*)(kt_ + row * 208 + ch * 16);
        }
        bf16_t* Vg = p.Vt + (size_t)(b * NH + hd) * VD * NKEY + key0;
#pragma unroll
        for (int i = 0; i < 4; ++i) {
          const int row = (tc_ >> 5) + 16 * i, ch = tc_ & 31;
          *(uint4*)(Vg + (size_t)row * NKEY + ch * 8) = *(const uint4*)(vt_ + row * 528 + ch * 16);
        }
        lds_sync();
      }
    } else if (it < nKV + nQ) {
      const int u = it - nKV;
      const int tokTile = xcd * 32 + (u >> 3), hd = u & 7;
      const bf16_t* Bb = p.pqkv + (size_t)tokTile * 256 * LDQKV;
      const bf16_t* Ab = p.WqT + (size_t)hd * QKD * QL;
      f32x16 acc[3][1];
#pragma unroll
      for (int a = 0; a < 3; ++a) acc[a][0] = zero16();
      float sumsq = 0.f;
      gemm8<3, 1, 1, 8, true>(acc, [&](int row) { return Ab + (size_t)row * QL; }, [&](int row) { return Bb + (size_t)row * LDQKV; }, QL, smem, sumsq);
      sumsq += __shfl_xor(sumsq, 32);
      const float ra = rsqrtf(sumsq * (1.f / QL) + EPS);
      const int tl = w * 32 + r;
      const int b = tokTile >> 3, pos = (tokTile & 7) * 256 + tl;
      float ss = 0.f;
#pragma unroll
      for (int tm = 0; tm < 3; ++tm)
#pragma unroll
        for (int i = 0; i < 16; ++i) { const float v = acc[tm][0][i] * ra; acc[tm][0][i] = v; ss += v * v; }
      ss += __shfl_xor(ss, 32);
      const float rh = rsqrtf(ss * (1.f / QKD) + EPS);
#pragma unroll
      for (int tm = 0; tm < 3; ++tm)
#pragma unroll
        for (int q = 0; q < 4; ++q) {
          const float4 g = *(const float4*)(p.q_norm_g + tm * 32 + 8 * q + 4 * hh);
          acc[tm][0][4 * q] *= rh * g.x; acc[tm][0][4 * q + 1] *= rh * g.y; acc[tm][0][4 * q + 2] *= rh * g.z; acc[tm][0][4 * q + 3] *= rh * g.w;
        }
      {
        const float* tr = p.ropeTab + ((pos >> 6) * 8 + 4 * hh) * 2;
        const float* tc = p.ropeTab + ((pos & 63) * 8 + 4 * hh) * 2;
#pragma unroll
        for (int i = 0; i < 4; ++i) {
          float a0 = acc[2][0][i], a1 = acc[2][0][i + 4], c0 = acc[2][0][8 + i], c1 = acc[2][0][12 + i];
          rope_pair(a0, a1, tr + 2 * i); rope_pair(c0, c1, tc + 2 * i);
          acc[2][0][i] = a0; acc[2][0][i + 4] = a1; acc[2][0][8 + i] = c0; acc[2][0][12 + i] = c1;
        }
      }
      const float qs = 0.10206207261596575f * 1.4426950408889634f;
      {
        char* qd = smem + tl * 208;
#pragma unroll
        for (int tm = 0; tm < 3; ++tm)
#pragma unroll
          for (int q = 0; q < 4; ++q) {
            uint2 o; o.x = pk_bf16(acc[tm][0][4 * q] * qs, acc[tm][0][4 * q + 1] * qs); o.y = pk_bf16(acc[tm][0][4 * q + 2] * qs, acc[tm][0][4 * q + 3] * qs);
            *(uint2*)(qd + (tm * 32 + 8 * q + 4 * hh) * 2) = o;
          }
        lds_sync();
        const int tc_ = tid_();
        bf16_t* Qg = p.Q + ((size_t)(b * NH + hd) * SEQ + (tokTile & 7) * 256) * QKD;
#pragma unroll
        for (int i = 0; i < 6; ++i) {
          const int id = tc_ + NTH * i, row = id / 12, ch = id % 12;
          *(uint4*)(Qg + row * QKD + ch * 8) = *(const uint4*)(smem + row * 208 + ch * 16);
        }
        lds_sync();
      }
    } else {
      const int u = it - nKV - nQ;
      const int tt = u & 7, g = (u >> 3) & 3, b = xcd * 4 + (u >> 5);
      const bf16_t* Tb = p.chanT;
      const bf16_t* Fb = p.pf + (size_t)(b * SEQ + tt * 256) * 512 + g * 128;
      f32x16 acc[4][2];
#pragma unroll
      for (int a = 0; a < 4; ++a)
#pragma unroll
        for (int c = 0; c < 2; ++c) acc[a][c] = zero16();
      float dummy = 0.f;
      gemm8<4, 2, 2, 4, false>(acc, [&](int row) { return Fb + (size_t)row * 512; }, [&](int row) { return Tb + (size_t)row * 128; }, 128, smem, dummy);
      stage_tile<4, 2, 2, 4>(acc, smem, 528, [](float v) { return v; });
      lds_sync();
      bf16_t* dst0 = p.ABt + ((size_t)(b * 512 + g * 128)) * 4096 + tt * 256;
      copy_tile(smem, 528, 256, 5, [&](int row) { return dst0 + (size_t)(row & 127) * 4096 + (row >> 7) * 2048; }, 0, 32);
      lds_sync();
    }
  }
}

DI void attn_item(const Params& p, int it, char* smem) {
  const int t = tid_(), lane = t & 63, w = t >> 6, r = lane & 31, hh = lane >> 5;
  const int qt = it & 7, bh = it >> 3;
  constexpr int KROW = 208, VROW = 136, KBYTES = 64 * KROW, STAGE = KBYTES + 64 * VROW;
  const bf16_t* Kb = p.K + (size_t)bh * NKEY * QKD;
  const bf16_t* Vb = p.Vt + (size_t)bh * VD * NKEY;
  const int qpos = qt * 256 + w * 32 + r;
  const bf16_t* Qp = p.Q + ((size_t)bh * SEQ + qpos) * QKD + hh * 8;
  bf16x8 qf[6];
#pragma unroll
  for (int c = 0; c < 6; ++c) qf[c] = *(const bf16x8*)(Qp + c * 16);
  f32x16 o[2]; o[0] = zero16(); o[1] = zero16();
  float gk = 0.f;
  for (int f = 0; f < QKD; ++f) gk = fmaxf(gk, fabsf(p.k_norm_g[f]));
  float qss = 0.f;
#pragma unroll
  for (int c = 0; c < 6; ++c) {
    const uint4 u = __builtin_bit_cast(uint4, qf[c]);
    const float e0 = bf_lo(u.x), e1 = bf_hi(u.x), e2 = bf_lo(u.y), e3 = bf_hi(u.y), e4 = bf_lo(u.z), e5 = bf_hi(u.z), e6 = bf_lo(u.w), e7 = bf_hi(u.w);
    qss += e0 * e0 + e1 * e1 + e2 * e2 + e3 * e3 + e4 * e4 + e5 * e5 + e6 * e6 + e7 * e7;
  }
  qss += __shfl_xor(qss, 32);
  const float negC = -(sqrtf(qss) * gk * 9.797959f * 1.01f);
  f32x16 sinit;
#pragma unroll
  for (int i = 0; i < 16; ++i) sinit[i] = negC;
  float lrun = 0.f;
  const int kid0 = t, kid1 = (t & 255) + 512;
  const bool k1v = t < 256;
  const int kgo0 = (kid0 / 12) * QKD + (kid0 % 12) * 8, kgo1 = (kid1 / 12) * QKD + (kid1 % 12) * 8;
  const int klo0 = (kid0 / 12) * KROW + (kid0 % 12) * 16, klo1 = (kid1 / 12) * KROW + (kid1 % 12) * 16;
  const int vgo0 = (t >> 3) * NKEY + (t & 7) * 8;
  const int vlo0 = KBYTES + (t >> 3) * VROW + (t & 7) * 16;
  uint4 rk0, rk1, rv0;
  rk0 = *(const uint4*)(Kb + kgo0); rk1 = *(const uint4*)(Kb + kgo1);
  rv0 = *(const uint4*)(Vb + vgo0);
  SB_;
#define ATT_STORE(base) do { \
    *(uint4*)((base) + klo0) = rk0; if (k1v) *(uint4*)((base) + klo1) = rk1; \
    { uint2* d = (uint2*)((base) + vlo0); d[0] = make_uint2(rv0.x, rv0.y); d[1] = make_uint2(rv0.z, rv0.w); } } while (0)
  ATT_STORE(smem);
  __syncthreads();
  constexpr int NKT = NKEY / 64;
  for (int kt = 0; kt < NKT; ++kt) {
    const char* cur = smem + (kt & 1) * STAGE;
    const bool more = kt + 1 < NKT;
    if (more) {
      const bf16_t* kn = Kb + (size_t)(kt + 1) * 64 * QKD; const bf16_t* vn = Vb + (kt + 1) * 64;
      rk0 = *(const uint4*)(kn + kgo0); rk1 = *(const uint4*)(kn + kgo1);
      rv0 = *(const uint4*)(vn + vgo0);
    }
    SB_;
    f32x16 s[2];
#pragma unroll
    for (int t2 = 0; t2 < 2; ++t2) {
      const char* kp = cur + (t2 * 32 + r) * KROW + hh * 16;
      { const bf16x8 kf = *(const bf16x8*)(kp); s[t2] = MFMA(kf, qf[0], sinit); }
#pragma unroll
      for (int c = 1; c < 6; ++c) { const bf16x8 kf = *(const bf16x8*)(kp + c * 32); s[t2] = MFMA(kf, qf[c], s[t2]); }
    }
    SB_;
    float ls = 0.f;
#pragma unroll
    for (int t2 = 0; t2 < 2; ++t2)
#pragma unroll
      for (int i = 0; i < 16; ++i) { const float e = __builtin_amdgcn_exp2f(s[t2][i]); s[t2][i] = e; ls += e; }
    lrun += ls;
    SB_;
#pragma unroll
    for (int t2 = 0; t2 < 2; ++t2)
#pragma unroll
      for (int s2 = 0; s2 < 2; ++s2) {
        uint4 pu;
        pu.x = pk_bf16(s[t2][8 * s2 + 0], s[t2][8 * s2 + 1]); pu.y = pk_bf16(s[t2][8 * s2 + 2], s[t2][8 * s2 + 3]);
        pu.z = pk_bf16(s[t2][8 * s2 + 4], s[t2][8 * s2 + 5]); pu.w = pk_bf16(s[t2][8 * s2 + 6], s[t2][8 * s2 + 7]);
        const bf16x8 pb = __builtin_bit_cast(bf16x8, pu);
#pragma unroll
        for (int vt = 0; vt < 2; ++vt) {
          const char* vp = cur + KBYTES + (vt * 32 + r) * VROW + (t2 * 32 + 16 * s2 + 4 * hh) * 2;
          const uint2 lo = *(const uint2*)(vp), hi = *(const uint2*)(vp + 16);
          uint4 vu; vu.x = lo.x; vu.y = lo.y; vu.z = hi.x; vu.w = hi.y;
          o[vt] = MFMA(__builtin_bit_cast(bf16x8, vu), pb, o[vt]);
        }
      }
    SB_;
    if (more) { char* nxt = smem + ((kt + 1) & 1) * STAGE; ATT_STORE(nxt); }
    __syncthreads();
  }
  lrun += __shfl_xor(lrun, 32);
  const float inv = 1.f / lrun;
  const int b = bh >> 3, hd = bh & 7;
  bf16_t* od = p.attn_o + (size_t)(b * SEQ + qpos) * 512 + hd * 64;
#pragma unroll
  for (int vt = 0; vt < 2; ++vt)
#pragma unroll
    for (int q = 0; q < 4; ++q) {
      uint2 ou; ou.x = pk_bf16(o[vt][4 * q] * inv, o[vt][4 * q + 1] * inv); ou.y = pk_bf16(o[vt][4 * q + 2] * inv, o[vt][4 * q + 3] * inv);
      *(uint2*)(od + vt * 32 + 8 * q + 4 * hh) = ou;
    }
}

DI void phase4(const Params& p, char* smem) {
  const int t = tid_(), lane = t & 63, w = t >> 6, r = lane & 31, hh = lane >> 5;
  const int nDft = 64, nAlt = 4, nAtt = 256;
  const int xcd = blockIdx.x & 7, jl = blockIdx.x >> 3, nl = gridDim.x >> 3;
  for (int it = jl; it < nDft + nAlt + nAtt; it += nl) {
    if (it < nDft) {
      const int bl = it >> 4, rem = it & 15, ct = rem >> 3, kt = rem & 7, b = xcd * 4 + bl;
      const int wm = w & 3, wn = w >> 2;
      const bf16_t* Ab = p.ABt + (size_t)(b * 512 + ct * 256) * 4096;
      const bf16_t* Cb = p.posM + (size_t)kt * 128 * 2048;
      const bf16_t* Sb = p.posM + (size_t)(1152 + kt * 128) * 2048;
      f32x16 acc1[2][2], acc2[2][2];
#pragma unroll
      for (int a = 0; a < 2; ++a)
#pragma unroll
        for (int c = 0; c < 2; ++c) { acc1[a][c] = zero16(); acc2[a][c] = zero16(); }
      float dummy = 0.f;
      gemm8s3(acc1, [&](int row) { return Ab + (size_t)row * 4096; }, [&](int row) { return Cb + (size_t)row * 2048; }, 2048, smem);
      gemm8s3(acc2, [&](int row) { return Ab + (size_t)row * 4096 + 2048; }, [&](int row) { return Sb + (size_t)row * 2048; }, 2048, smem);
      const float sc = 1.f / 512.f;
#pragma unroll
      for (int tm = 0; tm < 2; ++tm)
#pragma unroll
        for (int tn = 0; tn < 2; ++tn) {
          const int kpos = kt * 128 + wn * 64 + tn * 32 + r;
          const int moff = ct * 256 + wm * 64 + tm * 32 + 4 * hh;
          if (kpos <= 1024) {
            bf16_t* d = p.four_o + (size_t)(b * SEQ + kpos) * 512 + moff;
#pragma unroll
            for (int q = 0; q < 4; ++q) {
              uint2 ou; ou.x = pk_bf16((acc1[tm][tn][4 * q] - acc2[tm][tn][4 * q]) * sc, (acc1[tm][tn][4 * q + 1] - acc2[tm][tn][4 * q + 1]) * sc);
              ou.y = pk_bf16((acc1[tm][tn][4 * q + 2] - acc2[tm][tn][4 * q + 2]) * sc, (acc1[tm][tn][4 * q + 3] - acc2[tm][tn][4 * q + 3]) * sc);
              *(uint2*)(d + 8 * q) = ou;
            }
          }
          if (kpos >= 1 && kpos <= 1023) {
            bf16_t* d = p.four_o + (size_t)(b * SEQ + 2048 - kpos) * 512 + moff;
#pragma unroll
            for (int q = 0; q < 4; ++q) {
              uint2 ou; ou.x = pk_bf16((acc1[tm][tn][4 * q] + acc2[tm][tn][4 * q]) * sc, (acc1[tm][tn][4 * q + 1] + acc2[tm][tn][4 * q + 1]) * sc);
              ou.y = pk_bf16((acc1[tm][tn][4 * q + 2] + acc2[tm][tn][4 * q + 2]) * sc, (acc1[tm][tn][4 * q + 3] + acc2[tm][tn][4 * q + 3]) * sc);
              *(uint2*)(d + 8 * q) = ou;
            }
          }
        }
    } else if (it < nDft + nAlt) {
      const int b = xcd * 4 + (it - nDft);
      for (int m = w; m < 512; m += NWV) {
        const bf16_t* rowp = p.ABt + (size_t)(b * 512 + m) * 4096 + lane * 8;
        float sacc = 0.f;
#pragma unroll
        for (int i = 0; i < 4; ++i) {
          const uint4 u = *(const uint4*)(rowp + 512 * i);
          sacc += (bf_lo(u.x) - bf_hi(u.x)) + (bf_lo(u.y) - bf_hi(u.y)) + (bf_lo(u.z) - bf_hi(u.z)) + (bf_lo(u.w) - bf_hi(u.w));
        }
        sacc = wave_sum(sacc);
        if (lane == 0) p.four_o[(size_t)(b * SEQ + 1024) * 512 + m] = f2bf(sacc * (1.f / 512.f));
      }
    } else {
      attn_item(p, xcd * 256 + (it - nDft - nAlt), smem);
    }
  }
}

DI void phase5(const Params& p, char* smem) {
  const int t = tid_();
  const int xcd = blockIdx.x & 7, jl = blockIdx.x >> 3, nl = gridDim.x >> 3;
  for (int L = jl; L < 256; L += nl) {
    const int tokTile = xcd * 64 + (L >> 5) * 8 + (L & 7), nt = (L >> 3) & 3;
    f32x16 acc1[2][2], acc2[2][2];
#pragma unroll
    for (int a = 0; a < 2; ++a)
#pragma unroll
      for (int c = 0; c < 2; ++c) { acc1[a][c] = zero16(); acc2[a][c] = zero16(); }
    float dummy = 0.f;
    {
      const bf16_t* Ab = p.WoT + (size_t)nt * 256 * 512; const bf16_t* Bb = p.attn_o + (size_t)tokTile * 128 * 512;
      gemm8s3(acc1, [&](int row) { return Ab + (size_t)row * 512; }, [&](int row) { return Bb + (size_t)row * 512; }, 512, smem);
    }
    {
      const bf16_t* Ab = p.WfT + (size_t)nt * 256 * 512; const bf16_t* Bb = p.four_o + (size_t)tokTile * 128 * 512;
      gemm8s3(acc2, [&](int row) { return Ab + (size_t)row * 512; }, [&](int row) { return Bb + (size_t)row * 512; }, 512, smem);
    }
    {
      char* t1 = smem; char* t2 = smem + 128 * 528;
      const int ch = t & 31, r0 = t >> 5;
      stage_tile<2, 2, 4, 2>(acc1, t1, 528, [](float v) { return v; });
      stage_tile<2, 2, 4, 2>(acc2, t2, 528, [](float v) { return v; });
      lds_sync();
#pragma unroll
      for (int hb = 0; hb < 2; ++hb) {
        uint4 gav[4], gbv[4];
#pragma unroll
        for (int i = 0; i < 4; ++i) {
          const size_t tok = (size_t)tokTile * 128 + r0 + 16 * (hb * 4 + i);
          gav[i] = *(const uint4*)(p.pg + tok * 2048 + nt * 256 + ch * 8); gbv[i] = *(const uint4*)(p.pg + tok * 2048 + 1024 + nt * 256 + ch * 8);
        }
#pragma unroll
        for (int i = 0; i < 4; ++i) {
          const int row = r0 + 16 * (hb * 4 + i);
          const size_t tok = (size_t)tokTile * 128 + row;
          const uint4 u1 = *(const uint4*)(t1 + row * 528 + ch * 16), u2 = *(const uint4*)(t2 + row * 528 + ch * 16);
          const uint4 ga = gav[i], gb = gbv[i];
          uint4 o;
          o.x = pk_bf16(bf_lo(ga.x) * bf_lo(u1.x) + bf_lo(gb.x) * bf_lo(u2.x), bf_hi(ga.x) * bf_hi(u1.x) + bf_hi(gb.x) * bf_hi(u2.x));
          o.y = pk_bf16(bf_lo(ga.y) * bf_lo(u1.y) + bf_lo(gb.y) * bf_lo(u2.y), bf_hi(ga.y) * bf_hi(u1.y) + bf_hi(gb.y) * bf_hi(u2.y));
          o.z = pk_bf16(bf_lo(ga.z) * bf_lo(u1.z) + bf_lo(gb.z) * bf_lo(u2.z), bf_hi(ga.z) * bf_hi(u1.z) + bf_hi(gb.z) * bf_hi(u2.z));
          o.w = pk_bf16(bf_lo(ga.w) * bf_lo(u1.w) + bf_lo(gb.w) * bf_lo(u2.w), bf_hi(ga.w) * bf_hi(u1.w) + bf_hi(gb.w) * bf_hi(u2.w));
          *(uint4*)(p.m + tok * DM + nt * 256 + ch * 8) = o;
        }
      }
      lds_sync();
    }
  }
}

DI void phase6(const Params& p, char* smem) {
  const int t = tid_(), lane = t & 63, w = t >> 6, r = lane & 31, hh = lane >> 5;
  const int wm = w & 1, wn = w >> 1;
  const int xcd = blockIdx.x & 7, jl = blockIdx.x >> 3, nl = gridDim.x >> 3;
  for (int L = jl; L < 128; L += nl) {
    const int tokTile = xcd * 32 + (L >> 5) * 8 + (L & 7), nt = (L >> 3) & 3;
    f32x16 acc[4][2];
#pragma unroll
    for (int a = 0; a < 4; ++a)
#pragma unroll
      for (int c = 0; c < 2; ++c) acc[a][c] = zero16();
    float dummy = 0.f;
    const bf16_t* Wb = p.WoutT + (size_t)nt * 256 * DM; const bf16_t* Mb = p.m + (size_t)tokTile * 256 * DM;
    gemm8<4, 2, 2, 4, false>(acc, [&](int row) { return Wb + (size_t)row * DM; }, [&](int row) { return Mb + (size_t)row * DM; }, DM, smem, dummy);
    const int tc_ = tid_();
    const int ch = tc_ & 63, r0 = tc_ >> 6;
    const float4 g = *(const float4*)(p.mod + (tokTile >> 3) * 6144 + 2048 + nt * 256 + ch * 4);
#pragma unroll
    for (int tn = 0; tn < 2; ++tn) {
      const size_t obase = ((size_t)tokTile * 256 + tn * 32) * DM + nt * 256 + ch * 4;
#pragma unroll
      for (int tm = 0; tm < 4; ++tm) {
        char* d = smem + (wn * 32 + r) * 1040 + (wm * 128 + tm * 32 + 4 * hh) * 4;
#pragma unroll
        for (int q = 0; q < 4; ++q) *(float4*)(d + 32 * q) = make_float4(acc[tm][tn][4 * q], acc[tm][tn][4 * q + 1], acc[tm][tn][4 * q + 2], acc[tm][tn][4 * q + 3]);
      }
      lds_sync();
#pragma unroll
      for (int hb = 0; hb < 2; ++hb) {
        float4 xv[8];
#pragma unroll
        for (int i = 0; i < 8; ++i) {
          const int row = r0 + 8 * (hb * 8 + i);
          xv[i] = *(const float4*)(p.x + obase + (size_t)((row >> 5) * 64 + (row & 31)) * DM);
        }
#pragma unroll
        for (int i = 0; i < 8; ++i) {
          const int row = r0 + 8 * (hb * 8 + i);
          const float4 a = *(const float4*)(smem + row * 1040 + ch * 16);
          uint2 ob; ob.x = pk_bf16(xv[i].x + g.x * a.x, xv[i].y + g.y * a.y); ob.y = pk_bf16(xv[i].z + g.z * a.z, xv[i].w + g.w * a.w);
          *(uint2*)(p.x1b + obase + (size_t)((row >> 5) * 64 + (row & 31)) * DM) = ob;
        }
      }
      lds_sync();
    }
  }
}

DI void phase7(const Params& p, char* smem) {
  const int t = tid_(), lane = t & 63, w = t >> 6;
  float* wr = (float*)smem;
  for (int idx = t; idx < DM * NE; idx += NTH) { const int d = idx >> 4, e = idx & 15; wr[e * DM + d] = p.w_router[idx]; }
  __syncthreads();
  const int gw = blockIdx.x * NWV + w, nw = gridDim.x * NWV;
  auto router = [&](const float4 (&v)[4], int R) {
    asm volatile("" ::: "memory");
    float a[16];
#pragma unroll
    for (int e = 0; e < 16; ++e) {
      float s = 0.f;
#pragma unroll
      for (int i = 0; i < 4; ++i) { const float4 wv = *(const float4*)(wr + e * DM + lane * 4 + 256 * i); s += v[i].x * wv.x + v[i].y * wv.y + v[i].z * wv.z + v[i].w * wv.w; }
      a[e] = s;
      if ((e & 3) == 3) __builtin_amdgcn_sched_barrier(0);
    }
    float a8[8], a4[4], a2[2], a1;
    {
      const bool up = lane & 32;
#pragma unroll
      for (int j = 0; j < 8; ++j) { const float send = up ? a[j] : a[j + 8]; const float keep = up ? a[j + 8] : a[j]; a8[j] = keep + __shfl_xor(send, 32); }
    }
    {
      const bool up = lane & 16;
#pragma unroll
      for (int j = 0; j < 4; ++j) { const float send = up ? a8[j] : a8[j + 4]; const float keep = up ? a8[j + 4] : a8[j]; a4[j] = keep + __shfl_xor(send, 16); }
    }
    {
      const bool up = lane & 8;
#pragma unroll
      for (int j = 0; j < 2; ++j) { const float send = up ? a4[j] : a4[j + 2]; const float keep = up ? a4[j + 2] : a4[j]; a2[j] = keep + __shfl_xor(send, 8); }
    }
    {
      const bool up = lane & 4;
      const float send = up ? a2[0] : a2[1]; const float keep = up ? a2[1] : a2[0]; a1 = keep + __shfl_xor(send, 4);
    }
    a1 += __shfl_xor(a1, 2);
    a1 += __shfl_xor(a1, 1);
    float mx = a1;
#pragma unroll
    for (int o = 4; o <= 32; o <<= 1) mx = fmaxf(mx, __shfl_xor(mx, o));
    const float ex = __expf(a1 - mx);
    float sm = ex;
#pragma unroll
    for (int o = 4; o <= 32; o <<= 1) sm += __shfl_xor(sm, o);
    if ((lane & 3) == 0) {
      const int e = (lane >> 2) & 15;
      p.aff[((size_t)((R >> 11) * NE + e)) * SEQ + (R & 2047)] = ex / sm;
    }
  };
  for (int R0 = gw; R0 < NT; R0 += 2 * nw) {
    const int R1 = R0 + nw;
    const bool has1 = R1 < NT;
    const bf16_t* src0 = p.x1b + (size_t)R0 * DM;
    const bf16_t* src1 = p.x1b + (size_t)(has1 ? R1 : R0) * DM;
    const float* md0 = p.mod + (R0 >> 11) * 6144;
    const float* md1 = p.mod + ((has1 ? R1 : R0) >> 11) * 6144;
    float4 v0[4], v1[4]; float s0 = 0.f, s1 = 0.f;
#pragma unroll
    for (int i = 0; i < 4; ++i) {
      const uint2 u0 = *(const uint2*)(src0 + lane * 4 + 256 * i), u1 = *(const uint2*)(src1 + lane * 4 + 256 * i);
      v0[i] = make_float4(bf_lo(u0.x), bf_hi(u0.x), bf_lo(u0.y), bf_hi(u0.y)); v1[i] = make_float4(bf_lo(u1.x), bf_hi(u1.x), bf_lo(u1.y), bf_hi(u1.y));
    }
#pragma unroll
    for (int i = 0; i < 4; ++i) { s0 += v0[i].x * v0[i].x + v0[i].y * v0[i].y + v0[i].z * v0[i].z + v0[i].w * v0[i].w; s1 += v1[i].x * v1[i].x + v1[i].y * v1[i].y + v1[i].z * v1[i].z + v1[i].w * v1[i].w; }
    s0 = wave_sum(s0); s1 = wave_sum(s1);
    const float r0 = rsqrtf(s0 * (1.f / DM) + EPS), r1 = rsqrtf(s1 * (1.f / DM) + EPS);
#pragma unroll
    for (int i = 0; i < 4; ++i) {
      const int d = lane * 4 + 256 * i;
      const float4 g = *(const float4*)(p.norm2_g + d);
      {
        const float4 sh = *(const float4*)(md0 + 3072 + d), sc = *(const float4*)(md0 + 4096 + d);
        v0[i].x = v0[i].x * r0 * g.x * (1.f + sc.x) + sh.x; v0[i].y = v0[i].y * r0 * g.y * (1.f + sc.y) + sh.y;
        v0[i].z = v0[i].z * r0 * g.z * (1.f + sc.z) + sh.z; v0[i].w = v0[i].w * r0 * g.w * (1.f + sc.w) + sh.w;
        uint2 o; o.x = pk_bf16(v0[i].x, v0[i].y); o.y = pk_bf16(v0[i].z, v0[i].w);
        *(uint2*)(p.h2 + (size_t)R0 * DM + d) = o;
      }
      if (has1) {
        const float4 sh = *(const float4*)(md1 + 3072 + d), sc = *(const float4*)(md1 + 4096 + d);
        v1[i].x = v1[i].x * r1 * g.x * (1.f + sc.x) + sh.x; v1[i].y = v1[i].y * r1 * g.y * (1.f + sc.y) + sh.y;
        v1[i].z = v1[i].z * r1 * g.z * (1.f + sc.z) + sh.z; v1[i].w = v1[i].w * r1 * g.w * (1.f + sc.w) + sh.w;
        uint2 o; o.x = pk_bf16(v1[i].x, v1[i].y); o.y = pk_bf16(v1[i].z, v1[i].w);
        *(uint2*)(p.h2 + (size_t)R1 * DM + d) = o;
      }
    }
    SB_;
    router(v0, R0);
    SB_;
    if (has1) router(v1, R1);
    SB_;
  }
}

DI void phase8(const Params& p) {
  const int t_ = tid_(); const int lane = t_ & 63, w = t_ >> 6;
  const int gw = blockIdx.x * NWV + w, nw = gridDim.x * NWV;
  for (int pr = gw; pr < NB * NE; pr += nw) {
    const float* a = p.aff + (size_t)pr * SEQ;
    unsigned u[32];
#pragma unroll
    for (int q = 0; q < 32; ++q) u[q] = __float_as_uint(a[q * 64 + lane]);
    unsigned thr = 0;
    for (int bit = 30; bit >= 0; --bit) {
      const unsigned cand = thr | (1u << bit);
      int cnt = 0;
#pragma unroll
      for (int q = 0; q < 32; ++q) cnt += __popcll(__ballot(u[q] >= cand));
      if (cnt >= CAP) thr = cand;
    }
    int ngt = 0;
#pragma unroll
    for (int q = 0; q < 32; ++q) ngt += __popcll(__ballot(u[q] > thr));
    int cgt = 0, ceq = 0;
    int* io = p.idx + pr * CAP; float* go = p.gate + pr * CAP;
    int* iv = p.inv + (size_t)pr * SEQ;
#pragma unroll
    for (int q = 0; q < 32; ++q) {
      const bool gt = u[q] > thr, eq = u[q] == thr;
      const unsigned long long mg = __ballot(gt), me = __ballot(eq);
      const unsigned long long below = (1ull << lane) - 1ull;
      int myslot = -1;
      if (gt) { const int s = cgt + __popcll(mg & below); io[s] = q * 64 + lane; go[s] = __uint_as_float(u[q]); myslot = s; }
      if (eq) { const int s = ngt + ceq + __popcll(me & below); if (s < CAP) { io[s] = q * 64 + lane; go[s] = __uint_as_float(u[q]); myslot = s; } }
      iv[q * 64 + lane] = myslot;
      cgt += __popcll(mg); ceq += __popcll(me);
    }
  }
}

DI void phase9(const Params& p, char* smem) {
  const int t = tid_(), lane = t & 63, w = t >> 6, r = lane & 31, hh = lane >> 5;
  const int wm = w & 1, wn = w >> 1;
  const int xcd = blockIdx.x & 7, jl = blockIdx.x >> 3, nl = gridDim.x >> 3;
  auto decode = [&](int L, int& e, int& ft, int& b) { e = xcd * 2 + (L >> 7); const int rem = L & 127; ft = (rem >> 3) & 3; b = (rem >> 5) * 8 + (rem & 7); };
  bool pre = false;
  for (int L = jl; L < 256; L += nl) {
    int e, ft, b, eN = 0, ftN = 0, bN = 0;
    decode(L, e, ft, b);
    const int Ln = L + nl; const bool hasNext = Ln < 256;
    if (hasNext) decode(Ln, eN, ftN, bN);
    const int be = b * NE + e;
    const bf16_t* Ab = p.WguT + ((size_t)e * 1024 + ft * 256) * DM;
    const int* ib = p.idx + be * CAP;
    const bf16_t* hb = p.h2 + (size_t)b * SEQ * DM;
    const bf16_t* AbN = p.WguT + ((size_t)eN * 1024 + ftN * 256) * DM;
    const int* ibN = p.idx + (bN * NE + eN) * CAP;
    const bf16_t* hbN = p.h2 + (size_t)bN * SEQ * DM;
    f32x16 acc[4][2];
#pragma unroll
    for (int a = 0; a < 4; ++a)
#pragma unroll
      for (int c = 0; c < 2; ++c) acc[a][c] = zero16();
    float dummy = 0.f;
    gemm8x<4, 2, 2, 4, false, 2>(acc, [&](int row) { return Ab + (size_t)row * DM; }, [&](int row) { return hb + (size_t)ib[row] * DM; }, DM, smem, dummy,
                              pre, hasNext, [&](int row) { return AbN + (size_t)row * DM; }, [&](int row) { return hbN + (size_t)ibN[row] * DM; });
    pre = hasNext;
    char* tile = smem + EPI_OFF;
#pragma unroll
    for (int tn = 0; tn < 2; ++tn)
#pragma unroll
      for (int pr = 0; pr < 2; ++pr) {
        char* d = tile + (wn * 64 + tn * 32 + r) * 272 + (wm * 64 + pr * 32 + 4 * hh) * 2;
#pragma unroll
        for (int q = 0; q < 4; ++q) {
          float v[4];
#pragma unroll
          for (int j = 0; j < 4; ++j) { const float g = acc[2 * pr][tn][4 * q + j], uu = acc[2 * pr + 1][tn][4 * q + j]; v[j] = g * sigmoidf_(g) * uu; }
          uint2 ou; ou.x = pk_bf16(v[0], v[1]); ou.y = pk_bf16(v[2], v[3]);
          *(uint2*)(d + 16 * q) = ou;
        }
      }
    lds_sync();
    bf16_t* hd_ = p.hmid + (size_t)be * CAP * DE + ft * 128;
    copy_tile(tile, 272, 256, 4, [&](int row) { return hd_ + (size_t)row * DE; }, 0, 16);
  }
}

DI void phase10(const Params& p, char* smem) {
  const int xcd = blockIdx.x & 7, jl = blockIdx.x >> 3, nl = gridDim.x >> 3;
  for (int L = jl; L < 512; L += nl) {
    const int e = xcd * 2 + (L >> 8), rem = L & 255, nt = (rem >> 3) & 3, st = (rem >> 5) & 1, b = (rem >> 6) * 8 + (rem & 7);
    const int be = b * NE + e;
    const bf16_t* Hb = p.hmid + ((size_t)be * CAP + st * 128) * DE;
    const bf16_t* Wb = p.WdT + ((size_t)e * DM + nt * 256) * DE;
    f32x16 acc[2][2];
#pragma unroll
    for (int a = 0; a < 2; ++a)
#pragma unroll
      for (int c = 0; c < 2; ++c) acc[a][c] = zero16();
    gemm8s3(acc, [&](int row) { return Wb + (size_t)row * DE; }, [&](int row) { return Hb + (size_t)row * DE; }, DE, smem);
    stage_tile<2, 2, 4, 2>(acc, smem, 528, [](float v) { return v; });
    lds_sync();
    bf16_t* yb = p.Y + ((size_t)be * CAP + st * 128) * DM + nt * 256;
    copy_tile(smem, 528, 128, 5, [&](int row) { return yb + (size_t)row * DM; }, 0, 32);
    lds_sync();
  }
}

DI void phase11(const Params& p) {
  const int t_ = tid_(); const int lane = t_ & 63, w = t_ >> 6;
  const int gw = blockIdx.x * NWV + w, nw = gridDim.x * NWV;
  for (int R = gw; R < NT; R += nw) {
    const int b = R >> 11, tq = R & 2047;
    const int myslot = (lane < NE) ? p.inv[((size_t)(b * NE + lane)) * SEQ + tq] : -1;
    unsigned long long mask = __ballot(myslot >= 0);
    const bf16_t* xs = p.x1b + (size_t)R * DM + lane * 4;
    uint2 xu[4];
#pragma unroll
    for (int i = 0; i < 4; ++i) xu[i] = *(const uint2*)(xs + 256 * i);
    float4 a[4];
#pragma unroll
    for (int i = 0; i < 4; ++i) a[i] = make_float4(0.f, 0.f, 0.f, 0.f);
    while (mask) {
      const int e = __ffsll((long long)mask) - 1; mask &= mask - 1ull;
      const int slot = __shfl(myslot, e);
      const float g = p.gate[(b * NE + e) * CAP + slot];
      const bf16_t* y = p.Y + ((size_t)(b * NE + e) * CAP + slot) * DM + lane * 4;
#pragma unroll
      for (int i = 0; i < 4; ++i) {
        const uint2 u = *(const uint2*)(y + 256 * i);
        a[i].x += g * bf_lo(u.x); a[i].y += g * bf_hi(u.x); a[i].z += g * bf_lo(u.y); a[i].w += g * bf_hi(u.y);
      }
    }
    const float* g2 = p.mod + b * 6144 + 5120;
    float* o = p.out + (size_t)R * DM;
#pragma unroll
    for (int i = 0; i < 4; ++i) {
      const int d = lane * 4 + 256 * i;
      const float4 gv = *(const float4*)(g2 + d);
      *(float4*)(o + d) = make_float4(bf_lo(xu[i].x) + gv.x * a[i].x, bf_hi(xu[i].x) + gv.y * a[i].y, bf_lo(xu[i].y) + gv.z * a[i].z, bf_hi(xu[i].y) + gv.w * a[i].w);
    }
  }
}

__global__ void __launch_bounds__(NTH, 2) mega_kernel(Params p) {
  cg::grid_group grid = cg::this_grid();
  __shared__ __attribute__((aligned(16))) char smem[SMEM_BYTES];
#ifndef REPMASK
#define REPMASK 0
#endif
#define RUNPH(k, call) for (int rep_ = 0; rep_ < (((REPMASK) >> (k)) & 1) + 1; ++rep_) { call; grid.sync(); }
  RUNPH(0, phase0(p, smem))
  RUNPH(1, phase1(p))
  RUNPH(2, phase2(p, smem))
  RUNPH(3, phase3(p, smem))
  RUNPH(4, phase4(p, smem))
  RUNPH(5, phase5(p, smem))
  RUNPH(6, phase6(p, smem))
  RUNPH(7, phase7(p, smem))
  RUNPH(8, phase8(p))
  RUNPH(9, phase9(p, smem))
  RUNPH(10, phase10(p, smem))
  phase11(p);
}

static inline size_t align_up(size_t v, size_t a) { return (v + a - 1) / a * a; }

extern "C" void kernel_launch(void* const* d_in, const int* in_sizes, int n_in,
                              void* d_out, int out_size, void* d_ws, size_t ws_size,
                              hipStream_t stream) {
  static int grid_blocks = 0;
  if (!grid_blocks) {
    int dev = 0, cus = 0, per_cu = 0;
    (void)hipGetDevice(&dev);
    (void)hipDeviceGetAttribute(&cus, hipDeviceAttributeMultiprocessorCount, dev);
    (void)hipOccupancyMaxActiveBlocksPerMultiprocessor(&per_cu, mega_kernel, NTH, 0);
    if (per_cu > 1) per_cu = 1;
    if (per_cu < 1) per_cu = 1;
    grid_blocks = (cus * per_cu) & ~7;
    if (grid_blocks < 8) grid_blocks = 8;
  }
  Params p;
  memset(&p, 0, sizeof(p));
  p.x = (const float*)d_in[0]; p.c = (const float*)d_in[1]; p.ctx = (const float*)d_in[2]; p.c_ctx = (const float*)d_in[3];
  p.w_mod = (const float*)d_in[4]; p.b_mod = (const float*)d_in[5]; p.norm1_g = (const float*)d_in[6];
  const float* w_in = (const float*)d_in[7];
  const float* q_a_g = (const float*)d_in[8];
  const float* kv_a_g = (const float*)d_in[9];
  const float* w_q_up = (const float*)d_in[10];
  const float* w_kv_up = (const float*)d_in[11];
  p.q_norm_g = (const float*)d_in[12]; p.k_norm_g = (const float*)d_in[13];
  const float* w_o_attn = (const float*)d_in[14];
  const float* w_fourier = (const float*)d_in[15];
  const float* w_out = (const float*)d_in[16];
  p.norm2_g = (const float*)d_in[17]; p.w_router = (const float*)d_in[18];
  const float* w_e_gate = (const float*)d_in[19];
  const float* w_e_up = (const float*)d_in[20];
  const float* w_e_down = (const float*)d_in[21];
  p.out = (float*)d_out;

  char* base = (char*)d_ws; size_t off = 0;
  auto alloc = [&](size_t bytes) { char* q = base + off; off = align_up(off + bytes, 256); return q; };
  p.WinT = (bf16_t*)alloc((size_t)NINP * DM * 2);
  p.WqT = (bf16_t*)alloc((size_t)768 * QL * 2);
  p.WkvT = (bf16_t*)alloc((size_t)1024 * KVL * 2);
  p.WoT = (bf16_t*)alloc((size_t)DM * 512 * 2);
  p.WfT = (bf16_t*)alloc((size_t)DM * 512 * 2);
  p.WoutT = (bf16_t*)alloc((size_t)DM * DM * 2);
  p.WguT = (bf16_t*)alloc((size_t)NE * 1024 * DM * 2);
  p.WdT = (bf16_t*)alloc((size_t)NE * DM * DE * 2);
  p.chanT = (bf16_t*)alloc((size_t)256 * 128 * 2);
  p.posM = (bf16_t*)alloc((size_t)2 * 1152 * 2048 * 2);
  p.ropeTab = (float*)alloc(64 * 8 * 2 * 4);
  p.mod = (float*)alloc(33 * 6144 * 4);
  p.aff = (float*)alloc((size_t)NB * NE * SEQ * 4);
  p.gate = (float*)alloc((size_t)NB * NE * CAP * 4);
  p.idx = (int*)alloc((size_t)NB * NE * CAP * 4);
  p.inv = (int*)alloc((size_t)NB * NE * SEQ * 4);
  p.pckv = (bf16_t*)alloc((size_t)NC * LDCKV * 2 + 4096);
  char* regA = alloc((size_t)(NT + NC) * DM * 2);
  p.h = (bf16_t*)regA; p.ABt = (bf16_t*)regA; p.h2 = (bf16_t*)regA;
  char* regB1 = alloc((size_t)NT * LDQKV * 2);
  p.pqkv = (bf16_t*)regB1; p.attn_o = (bf16_t*)regB1;
  char* regB2 = alloc((size_t)NT * 512 * 2);
  p.pf = (bf16_t*)regB2; p.four_o = (bf16_t*)regB2;
  p.x1b = (bf16_t*)regB1;
  if ((size_t)(regB2 - regB1) + (size_t)NT * 512 * 2 < (size_t)NT * DM * 2) { fprintf(stderr, "x1b does not fit\n"); return; }
  p.pg = (bf16_t*)alloc((size_t)NT * 2048 * 2);
  p.Y = p.pg;
  const size_t szQ = (size_t)NB * NH * SEQ * QKD * 2, szK = (size_t)NB * NH * NKEY * QKD * 2, szV = (size_t)NB * NH * VD * NKEY * 2;
  char* regC = alloc(szQ + szK + szV + 1024);
  p.Q = (bf16_t*)regC; p.K = (bf16_t*)(regC + align_up(szQ, 256)); p.Vt = (bf16_t*)(regC + align_up(szQ, 256) + align_up(szK, 256));
  p.m = (bf16_t*)regC; p.hmid = (bf16_t*)(regC + (size_t)NT * DM * 2);
  if (off > ws_size) { fprintf(stderr, "workspace too small: need %zu have %zu\n", off, ws_size); return; }

  int ts = 0;
  auto job = [&](int i, const float* src, bf16_t* dst, const float* scale, int K, int ldS, int n_off, int n_cnt, int dst_row0, int mode, int batch, long sbs, long dbs) {
    TJob& j = p.jobs[i];
    j.src = src; j.dst = dst; j.scale = scale; j.K = K; j.ldS = ldS; j.n_off = n_off; j.n_cnt = n_cnt; j.dst_row0 = dst_row0; j.mode = mode; j.batch = batch;
    j.tiles_n = (n_cnt + 63) / 64; j.tile_start = ts; j.src_bstride = sbs; j.dst_bstride = dbs;
    ts += batch * (K / 64) * j.tiles_n;
  };
  job(0, w_e_gate, p.WguT, nullptr, DM, DE, 0, DE, 0, 1, NE, (long)DM * DE, (long)1024 * DM);
  job(1, w_e_up, p.WguT, nullptr, DM, DE, 0, DE, 0, 2, NE, (long)DM * DE, (long)1024 * DM);
  job(2, w_e_down, p.WdT, nullptr, DE, DM, 0, DM, 0, 0, NE, (long)DE * DM, (long)DM * DE);
  job(3, w_in, p.WinT, nullptr, DM, N_IN, 0, 672, 0, 0, 1, 0, 0);
  job(4, w_in, p.WinT, nullptr, DM, N_IN, 672, 2560, 768, 0, 1, 0, 0);
  job(5, w_q_up, p.WqT, q_a_g, QL, 768, 0, 768, 0, 0, 1, 0, 0);
  job(6, w_kv_up, p.WkvT, kv_a_g, KVL, 1024, 0, 1024, 0, 0, 1, 0, 0);
  job(7, w_o_attn, p.WoT, nullptr, 512, DM, 0, DM, 0, 0, 1, 0, 0);
  job(8, w_fourier, p.WfT, nullptr, 512, DM, 0, DM, 0, 0, 1, 0, 0);
  job(9, w_out, p.WoutT, nullptr, DM, DM, 0, DM, 0, 0, 1, 0, 0);
  p.n_ttiles = ts;

  void* args[] = {&p};
  hipError_t e = hipLaunchCooperativeKernel((void*)mega_kernel, dim3(grid_blocks), dim3(NTH), args, 0, stream);
  if (e != hipSuccess) fprintf(stderr, "cooperative launch failed: %s (grid %d)\n", hipGetErrorString(e), grid_blocks);
}
```

```cpp
#include <hip/hip_runtime.h>
#include <hip/hip_cooperative_groups.h>
#include <cstdio>
#include <cstring>
#include <cstdint>
namespace cg = cooperative_groups;

#define DI __device__ __forceinline__
typedef unsigned short bf16_t;
typedef short bf16x8 __attribute__((ext_vector_type(8)));
typedef float f32x16 __attribute__((ext_vector_type(16)));
#define MFMA(a, b, c) __builtin_amdgcn_mfma_f32_32x32x16_bf16((a), (b), (c), 0, 0, 0)

constexpr int NB = 32, SEQ = 2048, DM = 1024, NT = NB * SEQ, CTXL = 256, NC = NB * CTXL;
constexpr int NH = 8, QKD = 96, VD = 64, QL = 384, KVL = 256, NKEY = SEQ + CTXL;
constexpr int N_IN = 3232, NINP = 3328;
constexpr int NE = 16, DE = 512, CAP = 256;
constexpr float EPS = 1e-6f;
constexpr int LDQKV = 672, LDCKV = 288;
constexpr int NTH = 512, NWV = 8;
constexpr int SMEM_BYTES = 147456;

struct TJob {
  const float* src; bf16_t* dst; const float* scale;
  int K, ldS, n_off, n_cnt, dst_row0, mode, batch, tiles_n, tile_start, pad0;
  long src_bstride, dst_bstride;
};
constexpr int NJOBS = 10;

struct Params {
  const float *x, *c, *ctx, *c_ctx, *w_mod, *b_mod, *norm1_g, *q_norm_g, *k_norm_g, *norm2_g, *w_router;
  float* out;
  bf16_t *WinT, *WqT, *WkvT, *WoT, *WfT, *WoutT, *WguT, *WdT, *chanT, *posM;
  float *ropeTab, *mod;
  bf16_t *h, *pqkv, *pckv, *pf, *pg, *Q, *K, *Vt, *attn_o, *ABt, *four_o, *m, *h2, *hmid;
  float *aff, *gate;
  int* idx;
  int* inv;
  bf16_t* Y;
  bf16_t* x1b;
  TJob jobs[NJOBS];
  int n_ttiles, pad1;
};

typedef float f32x2v __attribute__((ext_vector_type(2)));
typedef __bf16 bf16x2v __attribute__((ext_vector_type(2)));
DI unsigned pk_bf16(float lo, float hi) { f32x2v v = {lo, hi}; bf16x2v b = __builtin_convertvector(v, bf16x2v); return __builtin_bit_cast(unsigned, b); }
DI int tid_() { int t = threadIdx.x; asm volatile("" : "+v"(t)); return t; }
DI float bf_lo(unsigned u) { return __uint_as_float(u << 16); }
DI float bf_hi(unsigned u) { return __uint_as_float(u & 0xffff0000u); }
DI bf16_t f2bf(float f) { return (bf16_t)(pk_bf16(f, 0.f) & 0xffffu); }
DI float sigmoidf_(float x) { return 1.f / (1.f + __expf(-x)); }
DI int crow(int i, int hh) { return (i & 3) + 8 * (i >> 2) + 4 * hh; }
DI float wave_sum(float v) {
#pragma unroll
  for (int o = 32; o >= 1; o >>= 1) v += __shfl_xor(v, o);
  return v;
}
DI f32x16 zero16() { f32x16 z;
#pragma unroll
  for (int i = 0; i < 16; ++i) z[i] = 0.f; return z; }
DI void wait_vm0() { asm volatile("s_waitcnt vmcnt(0)" ::: "memory"); }
DI void wait_lgkm0() { asm volatile("s_waitcnt lgkmcnt(0)" ::: "memory"); }
DI void bar_() { __builtin_amdgcn_s_barrier(); }
DI void lds_sync() { wait_lgkm0(); bar_(); }
#define GLDS(gp, lp) __builtin_amdgcn_global_load_lds((const unsigned*)(gp), (__attribute__((address_space(3))) unsigned*)(lp), 16, 0, 0)
#define SB_ __builtin_amdgcn_sched_barrier(0)

constexpr int EPI_OFF = 65536;
template <int TM, int TN, int WM, int WN, bool SUMSQ, int NST, class AF, class BF, class AFN, class BFN>
DI void gemm8x(f32x16 (&acc)[TM][TN], AF arow, BF brow, int K, char* smem, float& sumsq, bool pre, bool hasNext, AFN arowN, BFN browN) {
  constexpr int RA = 32 * TM * WM, RB = 32 * TN * WN;
  constexpr int LDR = 128, STAGE = (RA + RB) * LDR;
  static_assert(WM * WN == NWV, "waves");
  static_assert(NST * STAGE <= SMEM_BYTES, "smem");
  static_assert(NST == 2 || (NST == 3 && RA == 256 && RB == 128), "3-stage ring: 6 loads per thread per stage assumed");
  static_assert(RA <= 256 && RB <= 256 && RA % 32 == 0 && RB % 32 == 0, "shape");
  const int t = tid_(), lane = t & 63, w = t >> 6, r = lane & 31, hh = lane >> 5;
  const int wm = w % WM, wn = w / WM;
  const int row0 = t >> 3;
  const int c = (t & 7) ^ ((row0 >> 1) & 7);
  const bool a0v = row0 < RA, a1v = row0 + 64 < RA, a2v = row0 + 128 < RA, a3v = row0 + 192 < RA;
  const bool b0v = row0 < RB, b1v = row0 + 64 < RB, b2v = row0 + 128 < RB, b3v = row0 + 192 < RB;
  const bf16_t* pa0 = arow(a0v ? row0 : 0) + c * 8;
  const bf16_t* pa1 = arow(a1v ? row0 + 64 : 0) + c * 8;
  const bf16_t* pa2 = arow(a2v ? row0 + 128 : 0) + c * 8;
  const bf16_t* pa3 = arow(a3v ? row0 + 192 : 0) + c * 8;
  const bf16_t* pb0 = brow(b0v ? row0 : 0) + c * 8;
  const bf16_t* pb1 = brow(b1v ? row0 + 64 : 0) + c * 8;
  const bf16_t* pb2 = brow(b2v ? row0 + 128 : 0) + c * 8;
  const bf16_t* pb3 = brow(b3v ? row0 + 192 : 0) + c * 8;
  if (!pre) {
    char* l_ = smem + t * 16; char* m_ = l_ + RA * LDR;
    if (a0v) GLDS(pa0, l_); if (a1v) GLDS(pa1, l_ + 8192); if (a2v) GLDS(pa2, l_ + 16384); if (a3v) GLDS(pa3, l_ + 24576);
    if (b0v) GLDS(pb0, m_); if (b1v) GLDS(pb1, m_ + 8192); if (b2v) GLDS(pb2, m_ + 16384); if (b3v) GLDS(pb3, m_ + 24576);
  }
  if (NST == 3) {
    char* l_ = smem + STAGE + t * 16; char* m_ = l_ + RA * LDR;
    GLDS(pa0 + 64, l_); GLDS(pa1 + 64, l_ + 8192); GLDS(pa2 + 64, l_ + 16384); GLDS(pa3 + 64, l_ + 24576);
    GLDS(pb0 + 64, m_); GLDS(pb1 + 64, m_ + 8192);
    asm volatile("s_waitcnt vmcnt(6)" ::: "memory");
  } else wait_vm0();
  bar_();
  const int nk = K >> 6;
  const int sw = (r >> 1) & 7;
  const int aoff = (wm * TM * 32 + r) * LDR, boff = RA * LDR + (wn * TN * 32 + r) * LDR;
  auto compute = [&](const char* cur, char* nxt, bool issue, const bf16_t* q0, const bf16_t* q1, const bf16_t* q2, const bf16_t* q3,
                     const bf16_t* s0, const bf16_t* s1, const bf16_t* s2, const bf16_t* s3) {
    const char* As = cur + aoff;
    const char* Bs = cur + boff;
    char* l_ = nxt + t * 16; char* m_ = l_ + RA * LDR;
    bf16x8 a0[TM], b0[TN], a1[TM], b1[TN];
#define LOADF(A_, B_, ks) do { const int po_ = (((ks) * 2 + hh) ^ sw) * 16; \
      _Pragma("unroll") for (int tm = 0; tm < TM; ++tm) A_[tm] = *(const bf16x8*)(As + tm * 32 * LDR + po_); \
      _Pragma("unroll") for (int tn = 0; tn < TN; ++tn) B_[tn] = *(const bf16x8*)(Bs + tn * 32 * LDR + po_); } while (0)
#define MMF(A_, B_) do { if (SUMSQ) { uint4 u = __builtin_bit_cast(uint4, B_[0]); \
        float e0 = bf_lo(u.x), e1 = bf_hi(u.x), e2 = bf_lo(u.y), e3 = bf_hi(u.y), e4 = bf_lo(u.z), e5 = bf_hi(u.z), e6 = bf_lo(u.w), e7 = bf_hi(u.w); \
        sumsq += e0 * e0 + e1 * e1 + e2 * e2 + e3 * e3 + e4 * e4 + e5 * e5 + e6 * e6 + e7 * e7; } \
      _Pragma("unroll") for (int tm = 0; tm < TM; ++tm) _Pragma("unroll") for (int tn = 0; tn < TN; ++tn) acc[tm][tn] = MFMA(A_[tm], B_[tn], acc[tm][tn]); } while (0)
    LOADF(a0, b0, 0);
    LOADF(a1, b1, 1);
    SB_;
    if (issue) { if (a0v) GLDS(q0, l_); if (a1v) GLDS(q1, l_ + 8192); }
    SB_;
    __builtin_amdgcn_s_setprio(1);
    MMF(a0, b0);
    LOADF(a0, b0, 2);
    SB_;
    if (issue) { if (a2v) GLDS(q2, l_ + 16384); if (a3v) GLDS(q3, l_ + 24576); }
    SB_;
    MMF(a1, b1);
    LOADF(a1, b1, 3);
    SB_;
    if (issue) { if (b0v) GLDS(s0, m_); if (b1v) GLDS(s1, m_ + 8192); }
    SB_;
    MMF(a0, b0);
    SB_;
    if (issue) { if (b2v) GLDS(s2, m_ + 16384); if (b3v) GLDS(s3, m_ + 24576); }
    SB_;
    MMF(a1, b1);
    __builtin_amdgcn_s_setprio(0);
  };
  int sc_ = 0;
  for (int kt = 0; kt < nk - 1; ++kt) {
    SB_;
    if (NST == 2) {
      const int ko = (kt + 1) * 64;
      compute(smem + (kt & 1) * STAGE, smem + ((kt + 1) & 1) * STAGE, true, pa0 + ko, pa1 + ko, pa2 + ko, pa3 + ko, pb0 + ko, pb1 + ko, pb2 + ko, pb3 + ko);
      SB_;
      wait_vm0(); bar_();
    } else {
      const int ko = (kt + 2) * 64; const bool iss = kt + 2 < nk;
      const int sn = (sc_ == 0) ? 2 : sc_ - 1;
      compute(smem + sc_ * STAGE, smem + sn * STAGE, iss, pa0 + ko, pa1 + ko, pa2 + ko, pa3 + ko, pb0 + ko, pb1 + ko, pb2 + ko, pb3 + ko);
      SB_;
      if (iss) asm volatile("s_waitcnt vmcnt(6)" ::: "memory"); else wait_vm0();
      bar_();
      sc_ = (sc_ == 2) ? 0 : sc_ + 1;
    }
  }
  if (NST == 3) {
    SB_;
    compute(smem + sc_ * STAGE, smem, false, pa0, pa0, pa0, pa0, pa0, pa0, pa0, pa0);
    SB_;
    lds_sync();
  } else {
    const bf16_t *q0 = pa0, *q1 = pa0, *q2 = pa0, *q3 = pa0, *s0 = pa0, *s1 = pa0, *s2 = pa0, *s3 = pa0;
    if (hasNext) {
      q0 = arowN(a0v ? row0 : 0) + c * 8; q1 = arowN(a1v ? row0 + 64 : 0) + c * 8; q2 = arowN(a2v ? row0 + 128 : 0) + c * 8; q3 = arowN(a3v ? row0 + 192 : 0) + c * 8;
      s0 = browN(b0v ? row0 : 0) + c * 8; s1 = browN(b1v ? row0 + 64 : 0) + c * 8; s2 = browN(b2v ? row0 + 128 : 0) + c * 8; s3 = browN(b3v ? row0 + 192 : 0) + c * 8;
    }
    SB_;
    compute(smem + ((nk - 1) & 1) * STAGE, smem, hasNext, q0, q1, q2, q3, s0, s1, s2, s3);
    SB_;
    lds_sync();
  }
}
template <int TM, int TN, int WM, int WN, bool SUMSQ, class AF, class BF>
DI void gemm8(f32x16 (&acc)[TM][TN], AF arow, BF brow, int K, char* smem, float& sumsq) {
  gemm8x<TM, TN, WM, WN, SUMSQ, 2>(acc, arow, brow, K, smem, sumsq, false, false, arow, brow);
}
template <class AF, class BF>
DI void gemm8s3(f32x16 (&acc)[2][2], AF arow, BF brow, int K, char* smem) {
  float dummy = 0.f;
  gemm8x<2, 2, 4, 2, false, 3>(acc, arow, brow, K, smem, dummy, false, false, arow, brow);
}
template <int TM, int WM, int WN, int TNSEL, class F>
DI void stage_half(const f32x16 (&acc)[TM][2], char* tile, int pitch, F f) {
  const int t = tid_(), lane = t & 63, w = t >> 6, r = lane & 31, hh = lane >> 5;
  const int wm = w % WM, wn = w / WM;
#pragma unroll
  for (int tm = 0; tm < TM; ++tm) {
    char* d = tile + (wn * 32 + r) * pitch + (wm * TM * 32 + tm * 32 + 4 * hh) * 2;
#pragma unroll
    for (int q = 0; q < 4; ++q) {
      const f32x16& a = acc[tm][TNSEL];
      uint2 o; o.x = pk_bf16(f(a[4 * q]), f(a[4 * q + 1])); o.y = pk_bf16(f(a[4 * q + 2]), f(a[4 * q + 3]));
      *(uint2*)(d + 16 * q) = o;
    }
  }
}

template <int TM, int TN, int WM, int WN, class F>
DI void stage_tile(const f32x16 (&acc)[TM][TN], char* tile, int pitch, F f) {
  const int t = tid_(), lane = t & 63, w = t >> 6, r = lane & 31, hh = lane >> 5;
  const int wm = w % WM, wn = w / WM;
#pragma unroll
  for (int tm = 0; tm < TM; ++tm)
#pragma unroll
    for (int tn = 0; tn < TN; ++tn) {
      char* d = tile + (wn * TN * 32 + tn * 32 + r) * pitch + (wm * TM * 32 + tm * 32 + 4 * hh) * 2;
#pragma unroll
      for (int q = 0; q < 4; ++q) {
        uint2 o; o.x = pk_bf16(f(acc[tm][tn][4 * q]), f(acc[tm][tn][4 * q + 1])); o.y = pk_bf16(f(acc[tm][tn][4 * q + 2]), f(acc[tm][tn][4 * q + 3]));
        *(uint2*)(d + 16 * q) = o;
      }
    }
}
template <class RF>
DI void copy_tile(const char* tile, int pitch, int rows, int lch, RF dst, int ch0, int ch1) {
  const int t = tid_();
  const int total = rows << lch;
  for (int id = t; id < total; id += NTH) {
    const int row = id >> lch, ch = id & ((1 << lch) - 1);
    if (ch >= ch0 && ch < ch1) *(uint4*)(dst(row) + ch * 8) = *(const uint4*)(tile + row * pitch + ch * 16);
  }
}

struct TTile { const float* src; const float* scale; bf16_t* dst; int K, ldS, n0, n_cnt, k0, dst_row0, mode; };
DI TTile ttile_decode(const Params& p, int u) {
  int jb = 0;
#pragma unroll 1
  for (int q = 1; q < NJOBS; ++q) if (u >= p.jobs[q].tile_start) jb = q;
  const TJob& j = p.jobs[jb];
  const int tile = u - j.tile_start;
  const int tpb = (j.K >> 6) * j.tiles_n;
  const int bi = tile / tpb, rem = tile % tpb;
  const int kt = rem / j.tiles_n, ntile = rem % j.tiles_n;
  TTile tt;
  tt.src = j.src + (size_t)bi * j.src_bstride + j.n_off; tt.scale = j.scale; tt.dst = j.dst + (size_t)bi * j.dst_bstride;
  tt.K = j.K; tt.ldS = j.ldS; tt.n0 = ntile * 64; tt.n_cnt = j.n_cnt; tt.k0 = kt * 64; tt.dst_row0 = j.dst_row0; tt.mode = j.mode;
  return tt;
}
DI void ttile_load(const TTile& tt, int t, float (&v)[8]) {
  const int nn = t & 63, kq = t >> 6;
  const bool nvalid = (tt.n0 + nn) < tt.n_cnt;
#pragma unroll
  for (int i = 0; i < 8; ++i) {
    const int kk = kq + 8 * i;
    float x = 0.f;
    if (nvalid) { x = tt.src[(size_t)(tt.k0 + kk) * tt.ldS + tt.n0 + nn]; if (tt.scale) x *= tt.scale[tt.k0 + kk]; }
    v[i] = x;
  }
}
DI void ttile_store(const TTile& tt, int t, const float (&v)[8], char* smem) {
  bf16_t* T = (bf16_t*)smem;
  const int nn = t & 63, kq = t >> 6;
#pragma unroll
  for (int i = 0; i < 8; ++i) T[nn * 66 + kq + 8 * i] = f2bf(v[i]);
  __syncthreads();
  const int n = t >> 3, part = t & 7;
  if (tt.n0 + n < tt.n_cnt) {
    const unsigned* tp = (const unsigned*)(T + n * 66 + part * 8);
    uint4 o0; o0.x = tp[0]; o0.y = tp[1]; o0.z = tp[2]; o0.w = tp[3];
    const int f = tt.n0 + n;
    int drow;
    if (tt.mode == 0) drow = tt.dst_row0 + f;
    else drow = (f >> 7) * 256 + ((f >> 6) & 1) * 128 + (((f >> 5) & 1) * 2 + (tt.mode == 2 ? 1 : 0)) * 32 + (f & 31);
    *(uint4*)(tt.dst + (size_t)drow * tt.K + tt.k0 + part * 8) = o0;
  }
  __syncthreads();
}

DI void mod_item(const Params& p, int it, char* smem) {
  const int t = tid_(), cgi = t & 15, kg = t >> 4;
  const int j0 = it * 16;
  float* Ssm = (float*)smem;
  float* red = (float*)(smem + 33 * 128 * 4);
  float acc[33];
#pragma unroll
  for (int r = 0; r < 33; ++r) acc[r] = 0.f;
#pragma unroll 1
  for (int kc = 0; kc < 8; ++kc) {
    __syncthreads();
    for (int idx = t; idx < 33 * 128; idx += NTH) {
      const int r = idx >> 7, kk = idx & 127;
      float v = (r < 32) ? p.c[r * DM + kc * 128 + kk] : p.c_ctx[kc * 128 + kk];
      Ssm[idx] = v * sigmoidf_(v);
    }
    __syncthreads();
    const int k = kc * 128 + kg * 4;
    const float w0 = p.w_mod[(size_t)(k + 0) * 6144 + j0 + cgi];
    const float w1 = p.w_mod[(size_t)(k + 1) * 6144 + j0 + cgi];
    const float w2 = p.w_mod[(size_t)(k + 2) * 6144 + j0 + cgi];
    const float w3 = p.w_mod[(size_t)(k + 3) * 6144 + j0 + cgi];
#pragma unroll
    for (int r = 0; r < 33; ++r) {
      const float4 s = *(const float4*)(Ssm + r * 128 + kg * 4);
      acc[r] += s.x * w0 + s.y * w1 + s.z * w2 + s.w * w3;
    }
  }
  __syncthreads();
#pragma unroll
  for (int r = 0; r < 33; ++r) red[(kg * 33 + r) * 16 + cgi] = acc[r];
  __syncthreads();
  for (int idx = t; idx < 33 * 16; idx += NTH) {
    const int r = idx >> 4, cc = idx & 15;
    float s = 0.f;
#pragma unroll
    for (int g = 0; g < 32; ++g) s += red[(g * 33 + r) * 16 + cc];
    p.mod[r * 6144 + j0 + cc] = s + p.b_mod[j0 + cc];
  }
}

DI void phase0(const Params& p, char* smem) {
  const int t = tid_();
  const int nMod = 384;
  const int nPos = 288;
  const int nMisc = 3;
  const int nT = p.n_ttiles;
  const int total = nMod + nPos + nMisc;
  float* ctab = (float*)(smem + 98304);
  for (int j = t; j < 2048; j += NTH) ctab[j] = cospif((float)j * (1.f / 1024.f));
  __syncthreads();
  for (int it = blockIdx.x; it < total; it += gridDim.x) {
    if (it < nMod) { mod_item(p, it, smem); continue; }
    int u = it - nMod;
    if (u < nPos) {
      for (int e = t; e < 8 * 256; e += NTH) {
        const int R = u * 8 + (e >> 8), c8 = (e & 255) * 8;
        const int part = R >= 1152 ? 1 : 0, k = R - part * 1152;
        float v[8];
#pragma unroll
        for (int q = 0; q < 8; ++q) {
          const int tt = c8 + q;
          v[q] = (k > 1024) ? 0.f : (part ? ctab[(k * tt - 512) & 2047] : ctab[(k * tt) & 2047]);
        }
        uint4 o; o.x = pk_bf16(v[0], v[1]); o.y = pk_bf16(v[2], v[3]); o.z = pk_bf16(v[4], v[5]); o.w = pk_bf16(v[6], v[7]);
        *(uint4*)(p.posM + (size_t)R * 2048 + c8) = o;
      }
      continue;
    }
    u -= nPos;
    if (u == 0) {
      for (int e = t; e < 256 * 128; e += NTH) {
        const int m2 = e >> 7, cc = e & 127, mm = m2 & 127;
        float v = (m2 < 128) ? ctab[(mm * cc * 16) & 2047] : ctab[(mm * cc * 16 - 512) & 2047];
        p.chanT[e] = f2bf(v);
      }
    } else if (u == 1) {
      for (int e = t; e < 64 * 8; e += NTH) {
        const int pos = e >> 3, jf = e & 7;
        const float inv = 1.0f / powf(10000.0f, (float)jf / 8.0f);
        const float ang = (float)pos * inv;
        p.ropeTab[e * 2 + 0] = cosf(ang);
        p.ropeTab[e * 2 + 1] = sinf(ang);
      }
    } else {
      uint4 z; z.x = z.y = z.z = z.w = 0u;
      uint4* dp = (uint4*)(p.WinT + (size_t)672 * DM);
      for (int e = t; e < 96 * DM / 8; e += NTH) dp[e] = z;
    }
  }
  __syncthreads();
  {
    const int G = gridDim.x;
    int u = (int)((blockIdx.x + 128u) % (unsigned)G);
    float vn[8];
    TTile tn_ = ttile_decode(p, u < nT ? u : 0);
    if (u < nT) ttile_load(tn_, t, vn);
    for (; u < nT; u += G) {
      const TTile tc = tn_;
      float vc[8];
#pragma unroll
      for (int i = 0; i < 8; ++i) vc[i] = vn[i];
      if (u + G < nT) { tn_ = ttile_decode(p, u + G); ttile_load(tn_, t, vn); }
      ttile_store(tc, t, vc, smem);
    }
  }
}

DI void phase1(const Params& p) {
  const int t_ = tid_(); const int lane = t_ & 63, w = t_ >> 6;
  const int gw = blockIdx.x * NWV + w, nw = gridDim.x * NWV;
  for (int R0 = gw; R0 < NT + NC; R0 += 2 * nw) {
    const int R1 = R0 + nw; const bool has1 = R1 < NT + NC;
    const float* src0 = (R0 < NT) ? p.x + (size_t)R0 * DM : p.ctx + (size_t)(R0 - NT) * DM;
    const float* src1 = has1 ? ((R1 < NT) ? p.x + (size_t)R1 * DM : p.ctx + (size_t)(R1 - NT) * DM) : src0;
    const float* md0 = p.mod + ((R0 < NT) ? (R0 >> 11) : 32) * 6144;
    const float* md1 = p.mod + ((has1 && R1 < NT) ? (R1 >> 11) : 32) * 6144;
    float4 v0[4], v1[4]; float s0 = 0.f, s1 = 0.f;
#pragma unroll
    for (int i = 0; i < 4; ++i) { v0[i] = *(const float4*)(src0 + lane * 4 + 256 * i); v1[i] = *(const float4*)(src1 + lane * 4 + 256 * i); }
#pragma unroll
    for (int i = 0; i < 4; ++i) { s0 += v0[i].x * v0[i].x + v0[i].y * v0[i].y + v0[i].z * v0[i].z + v0[i].w * v0[i].w; s1 += v1[i].x * v1[i].x + v1[i].y * v1[i].y + v1[i].z * v1[i].z + v1[i].w * v1[i].w; }
    s0 = wave_sum(s0); s1 = wave_sum(s1);
    const float r0 = rsqrtf(s0 * (1.f / DM) + EPS), r1 = rsqrtf(s1 * (1.f / DM) + EPS);
#pragma unroll
    for (int i = 0; i < 4; ++i) {
      const int d = lane * 4 + 256 * i;
      const float4 g = *(const float4*)(p.norm1_g + d);
      {
        const float4 sh = *(const float4*)(md0 + d), sc = *(const float4*)(md0 + 1024 + d);
        uint2 o; o.x = pk_bf16(v0[i].x * r0 * g.x * (1.f + sc.x) + sh.x, v0[i].y * r0 * g.y * (1.f + sc.y) + sh.y);
        o.y = pk_bf16(v0[i].z * r0 * g.z * (1.f + sc.z) + sh.z, v0[i].w * r0 * g.w * (1.f + sc.w) + sh.w);
        *(uint2*)(p.h + (size_t)R0 * DM + d) = o;
      }
      if (has1) {
        const float4 sh = *(const float4*)(md1 + d), sc = *(const float4*)(md1 + 1024 + d);
        uint2 o; o.x = pk_bf16(v1[i].x * r1 * g.x * (1.f + sc.x) + sh.x, v1[i].y * r1 * g.y * (1.f + sc.y) + sh.y);
        o.y = pk_bf16(v1[i].z * r1 * g.z * (1.f + sc.z) + sh.z, v1[i].w * r1 * g.w * (1.f + sc.w) + sh.w);
        *(uint2*)(p.h + (size_t)R1 * DM + d) = o;
      }
    }
  }
}

DI void phase2(const Params& p, char* smem) {
  const int xcd = blockIdx.x & 7, jl = blockIdx.x >> 3, nl = gridDim.x >> 3;
  auto decode = [&](int L, int& tokTile, int& ft) {
    if (L < 416) { const int tg = L / 104, rem = L % 104; ft = rem >> 3; tokTile = xcd * 32 + tg * 8 + (rem & 7); }
    else { const int u = L - 416; tokTile = 256 + xcd * 4 + (u >> 1); ft = 1 + (u & 1); }
  };
  bool pre = false;
  for (int L = jl; L < 416 + 8; L += nl) {
    int tokTile, ft, tokTileN = 0, ftN = 0;
    decode(L, tokTile, ft);
    const bool lat = L < 416;
    const int Ln = L + nl; const bool hasNext = Ln < 416 + 8;
    if (hasNext) decode(Ln, tokTileN, ftN);
    f32x16 acc[4][2];
#pragma unroll
    for (int a = 0; a < 4; ++a)
#pragma unroll
      for (int b = 0; b < 2; ++b) acc[a][b] = zero16();
    const bf16_t* Ab = p.WinT + (size_t)ft * 256 * DM;
    const bf16_t* Bb = p.h + (size_t)tokTile * 256 * DM;
    const bf16_t* AbN = p.WinT + (size_t)ftN * 256 * DM;
    const bf16_t* BbN = p.h + (size_t)tokTileN * 256 * DM;
    float dummy = 0.f;
    gemm8x<4, 2, 2, 4, false, 2>(acc, [&](int row) { return Ab + (size_t)row * DM; }, [&](int row) { return Bb + (size_t)row * DM; }, DM, smem, dummy,
                              pre, hasNext, [&](int row) { return AbN + (size_t)row * DM; }, [&](int row) { return BbN + (size_t)row * DM; });
    pre = hasNext;
    char* tile = smem + EPI_OFF;
    bf16_t* base; int ld, c0 = 0, c1 = 32;
    if (lat) {
      const size_t tok0 = (size_t)tokTile * 256;
      if (ft < 3) { base = p.pqkv + tok0 * LDQKV + ft * 256; ld = LDQKV; if (ft == 2) c1 = 20; }
      else if (ft < 5) { base = p.pf + tok0 * 512 + (ft - 3) * 256; ld = 512; }
      else { base = p.pg + tok0 * 2048 + (ft - 5) * 256; ld = 2048; }
    } else {
      const size_t ct0 = (size_t)(tokTile - 256) * 256;
      base = p.pckv + ct0 * LDCKV + ft * 256 - 384; ld = LDCKV;
      if (ft == 1) c0 = 16; else c1 = 20;
    }
    if (ft >= 5) stage_half<4, 2, 4, 0>(acc, tile, 528, [](float v) { return sigmoidf_(v); });
    else stage_half<4, 2, 4, 0>(acc, tile, 528, [](float v) { return v; });
    lds_sync();
    copy_tile(tile, 528, 128, 5, [&](int rl) { return base + (size_t)((rl >> 5) * 64 + (rl & 31)) * ld; }, c0, c1);
    lds_sync();
    if (ft >= 5) stage_half<4, 2, 4, 1>(acc, tile, 528, [](float v) { return sigmoidf_(v); });
    else stage_half<4, 2, 4, 1>(acc, tile, 528, [](float v) { return v; });
    lds_sync();
    copy_tile(tile, 528, 128, 5, [&](int rl) { return base + (size_t)((rl >> 5) * 64 + 32 + (rl & 31)) * ld; }, c0, c1);
  }
}

DI void rope_pair(float& x1, float& x2, const float* tab) { const float c = tab[0], s = tab[1]; const float a = x1 * c - x2 * s, b = x2 * c + x1 * s; x1 = a; x2 = b; }

DI void phase3(const Params& p, char* smem) {
  const int t = tid_(), lane = t & 63, w = t >> 6, r = lane & 31, hh = lane >> 5;
  const int nKV = 288, nQ = 256, nCh = 128;
  const int xcd = blockIdx.x & 7, jl = blockIdx.x >> 3, nl = gridDim.x >> 3;
  for (int it = jl; it < nKV + nQ + nCh; it += nl) {
    if (it < nKV) {
      const int tl_ = it >> 3, hd = it & 7;
      const bool lat = tl_ < 32;
      const bf16_t* Bb; int ldb; const bf16_t* kpeb;
      int b, key0;
      if (lat) { const int tokTile = xcd * 32 + tl_; Bb = p.pqkv + (size_t)tokTile * 256 * LDQKV + QL; ldb = LDQKV; kpeb = p.pqkv + (size_t)tokTile * 256 * LDQKV + 640; b = tokTile >> 3; key0 = (tokTile & 7) * 256; }
      else { const int ct = xcd * 4 + (tl_ - 32); Bb = p.pckv + (size_t)ct * 256 * LDCKV; ldb = LDCKV; kpeb = Bb + 256; b = ct; key0 = SEQ; }
      const bf16_t* Ab = p.WkvT + (size_t)hd * 128 * KVL;
      f32x16 acc[4][1];
#pragma unroll
      for (int a = 0; a < 4; ++a) acc[a][0] = zero16();
      float sumsq = 0.f;
      gemm8<4, 1, 1, 8, true>(acc, [&](int row) { return Ab + (size_t)row * KVL; }, [&](int row) { return Bb + (size_t)row * ldb; }, KVL, smem, sumsq);
      sumsq += __shfl_xor(sumsq, 32);
      const float ra = rsqrtf(sumsq * (1.f / KVL) + EPS);
      const int tl = w * 32 + r;
      const int key = key0 + tl;
      float kp[16];
#pragma unroll
      for (int q = 0; q < 4; ++q) {
        const uint2 u = *(const uint2*)(kpeb + (size_t)tl * ldb + 8 * q + 4 * hh);
        kp[4 * q + 0] = bf_lo(u.x); kp[4 * q + 1] = bf_hi(u.x); kp[4 * q + 2] = bf_lo(u.y); kp[4 * q + 3] = bf_hi(u.y);
      }
      float ss = 0.f;
#pragma unroll
      for (int tm = 0; tm < 4; ++tm)
#pragma unroll
        for (int i = 0; i < 16; ++i) { const float v = acc[tm][0][i] * ra; acc[tm][0][i] = v; if (tm < 2) ss += v * v; }
#pragma unroll
      for (int i = 0; i < 16; ++i) ss += kp[i] * kp[i];
      ss += __shfl_xor(ss, 32);
      const float rk = rsqrtf(ss * (1.f / QKD) + EPS);
#pragma unroll
      for (int i = 0; i < 16; ++i) kp[i] *= rk * p.k_norm_g[64 + crow(i, hh)];
      if (lat) {
        const int pos = key;
        const float* tr = p.ropeTab + ((pos >> 6) * 8 + 4 * hh) * 2;
        const float* tc = p.ropeTab + ((pos & 63) * 8 + 4 * hh) * 2;
#pragma unroll
        for (int i = 0; i < 4; ++i) { rope_pair(kp[i], kp[i + 4], tr + 2 * i); rope_pair(kp[8 + i], kp[12 + i], tc + 2 * i); }
      }
      {
        char* kt_ = smem; char* vt_ = smem + 256 * 208;
        char* kd = kt_ + tl * 208;
#pragma unroll
        for (int tm = 0; tm < 2; ++tm)
#pragma unroll
          for (int q = 0; q < 4; ++q) {
            const int f = tm * 32 + 8 * q + 4 * hh;
            const float4 g = *(const float4*)(p.k_norm_g + f);
            uint2 o; o.x = pk_bf16(acc[tm][0][4 * q] * rk * g.x, acc[tm][0][4 * q + 1] * rk * g.y); o.y = pk_bf16(acc[tm][0][4 * q + 2] * rk * g.z, acc[tm][0][4 * q + 3] * rk * g.w);
            *(uint2*)(kd + f * 2) = o;
          }
#pragma unroll
        for (int q = 0; q < 4; ++q) {
          uint2 o; o.x = pk_bf16(kp[4 * q], kp[4 * q + 1]); o.y = pk_bf16(kp[4 * q + 2], kp[4 * q + 3]);
          *(uint2*)(kd + (64 + 8 * q + 4 * hh) * 2) = o;
        }
#pragma unroll
        for (int tm = 2; tm < 4; ++tm)
#pragma unroll
          for (int i = 0; i < 16; ++i) *(bf16_t*)(vt_ + ((tm - 2) * 32 + crow(i, hh)) * 528 + tl * 2) = f2bf(acc[tm][0][i]);
        lds_sync();
        const int tc_ = tid_();
        bf16_t* Kg = p.K + ((size_t)(b * NH + hd) * NKEY + key0) * QKD;
#pragma unroll
        for (int i = 0; i < 6; ++i) {
          const int id = tc_ + NTH * i, row = id / 12, ch = id % 12;
          *(uint4*)(Kg + row * QKD + ch * 8) = *(const uint4*)(kt_ + row * 208 + ch * 16);
        }
        bf16_t* Vg = p.Vt + (size_t)(b * NH + hd) * VD * NKEY + key0;
#pragma unroll
        for (int i = 0; i < 4; ++i) {
          const int row = (tc_ >> 5) + 16 * i, ch = tc_ & 31;
          *(uint4*)(Vg + (size_t)row * NKEY + ch * 8) = *(const uint4*)(vt_ + row * 528 + ch * 16);
        }
        lds_sync();
      }
    } else if (it < nKV + nQ) {
      const int u = it - nKV;
      const int tokTile = xcd * 32 + (u >> 3), hd = u & 7;
      const bf16_t* Bb = p.pqkv + (size_t)tokTile * 256 * LDQKV;
      const bf16_t* Ab = p.WqT + (size_t)hd * QKD * QL;
      f32x16 acc[3][1];
#pragma unroll
      for (int a = 0; a < 3; ++a) acc[a][0] = zero16();
      float sumsq = 0.f;
      gemm8<3, 1, 1, 8, true>(acc, [&](int row) { return Ab + (size_t)row * QL; }, [&](int row) { return Bb + (size_t)row * LDQKV; }, QL, smem, sumsq);
      sumsq += __shfl_xor(sumsq, 32);
      const float ra = rsqrtf(sumsq * (1.f / QL) + EPS);
      const int tl = w * 32 + r;
      const int b = tokTile >> 3, pos = (tokTile & 7) * 256 + tl;
      float ss = 0.f;
#pragma unroll
      for (int tm = 0; tm < 3; ++tm)
#pragma unroll
        for (int i = 0; i < 16; ++i) { const float v = acc[tm][0][i] * ra; acc[tm][0][i] = v; ss += v * v; }
      ss += __shfl_xor(ss, 32);
      const float rh = rsqrtf(ss * (1.f / QKD) + EPS);
#pragma unroll
      for (int tm = 0; tm < 3; ++tm)
#pragma unroll
        for (int q = 0; q < 4; ++q) {
          const float4 g = *(const float4*)(p.q_norm_g + tm * 32 + 8 * q + 4 * hh);
          acc[tm][0][4 * q] *= rh * g.x; acc[tm][0][4 * q + 1] *= rh * g.y; acc[tm][0][4 * q + 2] *= rh * g.z; acc[tm][0][4 * q + 3] *= rh * g.w;
        }
      {
        const float* tr = p.ropeTab + ((pos >> 6) * 8 + 4 * hh) * 2;
        const float* tc = p.ropeTab + ((pos & 63) * 8 + 4 * hh) * 2;
#pragma unroll
        for (int i = 0; i < 4; ++i) {
          float a0 = acc[2][0][i], a1 = acc[2][0][i + 4], c0 = acc[2][0][8 + i], c1 = acc[2][0][12 + i];
          rope_pair(a0, a1, tr + 2 * i); rope_pair(c0, c1, tc + 2 * i);
          acc[2][0][i] = a0; acc[2][0][i + 4] = a1; acc[2][0][8 + i] = c0; acc[2][0][12 + i] = c1;
        }
      }
      const float qs = 0.10206207261596575f * 1.4426950408889634f;
      {
        char* qd = smem + tl * 208;
#pragma unroll
        for (int tm = 0; tm < 3; ++tm)
#pragma unroll
          for (int q = 0; q < 4; ++q) {
            uint2 o; o.x = pk_bf16(acc[tm][0][4 * q] * qs, acc[tm][0][4 * q + 1] * qs); o.y = pk_bf16(acc[tm][0][4 * q + 2] * qs, acc[tm][0][4 * q + 3] * qs);
            *(uint2*)(qd + (tm * 32 + 8 * q + 4 * hh) * 2) = o;
          }
        lds_sync();
        const int tc_ = tid_();
        bf16_t* Qg = p.Q + ((size_t)(b * NH + hd) * SEQ + (tokTile & 7) * 256) * QKD;
#pragma unroll
        for (int i = 0; i < 6; ++i) {
          const int id = tc_ + NTH * i, row = id / 12, ch = id % 12;
          *(uint4*)(Qg + row * QKD + ch * 8) = *(const uint4*)(smem + row * 208 + ch * 16);
        }
        lds_sync();
      }
    } else {
      const int u = it - nKV - nQ;
      const int tt = u & 7, g = (u >> 3) & 3, b = xcd * 4 + (u >> 5);
      const bf16_t* Tb = p.chanT;
      const bf16_t* Fb = p.pf + (size_t)(b * SEQ + tt * 256) * 512 + g * 128;
      f32x16 acc[4][2];
#pragma unroll
      for (int a = 0; a < 4; ++a)
#pragma unroll
        for (int c = 0; c < 2; ++c) acc[a][c] = zero16();
      float dummy = 0.f;
      gemm8<4, 2, 2, 4, false>(acc, [&](int row) { return Fb + (size_t)row * 512; }, [&](int row) { return Tb + (size_t)row * 128; }, 128, smem, dummy);
      stage_tile<4, 2, 2, 4>(acc, smem, 528, [](float v) { return v; });
      lds_sync();
      bf16_t* dst0 = p.ABt + ((size_t)(b * 512 + g * 128)) * 4096 + tt * 256;
      copy_tile(smem, 528, 256, 5, [&](int row) { return dst0 + (size_t)(row & 127) * 4096 + (row >> 7) * 2048; }, 0, 32);
      lds_sync();
    }
  }
}

DI void attn_item(const Params& p, int it, char* smem) {
  const int t = tid_(), lane = t & 63, w = t >> 6, r = lane & 31, hh = lane >> 5;
  const int qt = it & 7, bh = it >> 3;
  constexpr int KROW = 208, VROW = 136, KBYTES = 64 * KROW, STAGE = KBYTES + 64 * VROW;
  const bf16_t* Kb = p.K + (size_t)bh * NKEY * QKD;
  const bf16_t* Vb = p.Vt + (size_t)bh * VD * NKEY;
  const int qpos = qt * 256 + w * 32 + r;
  const bf16_t* Qp = p.Q + ((size_t)bh * SEQ + qpos) * QKD + hh * 8;
  bf16x8 qf[6];
#pragma unroll
  for (int c = 0; c < 6; ++c) qf[c] = *(const bf16x8*)(Qp + c * 16);
  f32x16 o[2]; o[0] = zero16(); o[1] = zero16();
  float gk = 0.f;
  for (int f = 0; f < QKD; ++f) gk = fmaxf(gk, fabsf(p.k_norm_g[f]));
  float qss = 0.f;
#pragma unroll
  for (int c = 0; c < 6; ++c) {
    const uint4 u = __builtin_bit_cast(uint4, qf[c]);
    const float e0 = bf_lo(u.x), e1 = bf_hi(u.x), e2 = bf_lo(u.y), e3 = bf_hi(u.y), e4 = bf_lo(u.z), e5 = bf_hi(u.z), e6 = bf_lo(u.w), e7 = bf_hi(u.w);
    qss += e0 * e0 + e1 * e1 + e2 * e2 + e3 * e3 + e4 * e4 + e5 * e5 + e6 * e6 + e7 * e7;
  }
  qss += __shfl_xor(qss, 32);
  const float negC = -(sqrtf(qss) * gk * 9.797959f * 1.01f);
  f32x16 sinit;
#pragma unroll
  for (int i = 0; i < 16; ++i) sinit[i] = negC;
  float lrun = 0.f;
  const int kid0 = t, kid1 = (t & 255) + 512;
  const bool k1v = t < 256;
  const int kgo0 = (kid0 / 12) * QKD + (kid0 % 12) * 8, kgo1 = (kid1 / 12) * QKD + (kid1 % 12) * 8;
  const int klo0 = (kid0 / 12) * KROW + (kid0 % 12) * 16, klo1 = (kid1 / 12) * KROW + (kid1 % 12) * 16;
  const int vgo0 = (t >> 3) * NKEY + (t & 7) * 8;
  const int vlo0 = KBYTES + (t >> 3) * VROW + (t & 7) * 16;
  uint4 rk0, rk1, rv0;
  rk0 = *(const uint4*)(Kb + kgo0); rk1 = *(const uint4*)(Kb + kgo1);
  rv0 = *(const uint4*)(Vb + vgo0);
  SB_;
#define ATT_STORE(base) do { \
    *(uint4*)((base) + klo0) = rk0; if (k1v) *(uint4*)((base) + klo1) = rk1; \
    { uint2* d = (uint2*)((base) + vlo0); d[0] = make_uint2(rv0.x, rv0.y); d[1] = make_uint2(rv0.z, rv0.w); } } while (0)
  ATT_STORE(smem);
  __syncthreads();
  constexpr int NKT = NKEY / 64;
  for (int kt = 0; kt < NKT; ++kt) {
    const char* cur = smem + (kt & 1) * STAGE;
    const bool more = kt + 1 < NKT;
    if (more) {
      const bf16_t* kn = Kb + (size_t)(kt + 1) * 64 * QKD; const bf16_t* vn = Vb + (kt + 1) * 64;
      rk0 = *(const uint4*)(kn + kgo0); rk1 = *(const uint4*)(kn + kgo1);
      rv0 = *(const uint4*)(vn + vgo0);
    }
    SB_;
    f32x16 s[2];
#pragma unroll
    for (int t2 = 0; t2 < 2; ++t2) {
      const char* kp = cur + (t2 * 32 + r) * KROW + hh * 16;
      { const bf16x8 kf = *(const bf16x8*)(kp); s[t2] = MFMA(kf, qf[0], sinit); }
#pragma unroll
      for (int c = 1; c < 6; ++c) { const bf16x8 kf = *(const bf16x8*)(kp + c * 32); s[t2] = MFMA(kf, qf[c], s[t2]); }
    }
    SB_;
    float ls = 0.f;
#pragma unroll
    for (int t2 = 0; t2 < 2; ++t2)
#pragma unroll
      for (int i = 0; i < 16; ++i) { const float e = __builtin_amdgcn_exp2f(s[t2][i]); s[t2][i] = e; ls += e; }
    lrun += ls;
    SB_;
#pragma unroll
    for (int t2 = 0; t2 < 2; ++t2)
#pragma unroll
      for (int s2 = 0; s2 < 2; ++s2) {
        uint4 pu;
        pu.x = pk_bf16(s[t2][8 * s2 + 0], s[t2][8 * s2 + 1]); pu.y = pk_bf16(s[t2][8 * s2 + 2], s[t2][8 * s2 + 3]);
        pu.z = pk_bf16(s[t2][8 * s2 + 4], s[t2][8 * s2 + 5]); pu.w = pk_bf16(s[t2][8 * s2 + 6], s[t2][8 * s2 + 7]);
        const bf16x8 pb = __builtin_bit_cast(bf16x8, pu);
#pragma unroll
        for (int vt = 0; vt < 2; ++vt) {
          const char* vp = cur + KBYTES + (vt * 32 + r) * VROW + (t2 * 32 + 16 * s2 + 4 * hh) * 2;
          const uint2 lo = *(const uint2*)(vp), hi = *(const uint2*)(vp + 16);
          uint4 vu; vu.x = lo.x; vu.y = lo.y; vu.z = hi.x; vu.w = hi.y;
          o[vt] = MFMA(__builtin_bit_cast(bf16x8, vu), pb, o[vt]);
        }
      }
    SB_;
    if (more) { char* nxt = smem + ((kt + 1) & 1) * STAGE; ATT_STORE(nxt); }
    __syncthreads();
  }
  lrun += __shfl_xor(lrun, 32);
  const float inv = 1.f / lrun;
  const int b = bh >> 3, hd = bh & 7;
  bf16_t* od = p.attn_o + (size_t)(b * SEQ + qpos) * 512 + hd * 64;
#pragma unroll
  for (int vt = 0; vt < 2; ++vt)
#pragma unroll
    for (int q = 0; q < 4; ++q) {
      uint2 ou; ou.x = pk_bf16(o[vt][4 * q] * inv, o[vt][4 * q + 1] * inv); ou.y = pk_bf16(o[vt][4 * q + 2] * inv, o[vt][4 * q + 3] * inv);
      *(uint2*)(od + vt * 32 + 8 * q + 4 * hh) = ou;
    }
}

DI void phase4(const Params& p, char* smem) {
  const int t = tid_(), lane = t & 63, w = t >> 6, r = lane & 31, hh = lane >> 5;
  const int nDft = 64, nAlt = 4, nAtt = 256;
  const int xcd = blockIdx.x & 7, jl = blockIdx.x >> 3, nl = gridDim.x >> 3;
  for (int it = jl; it < nDft + nAlt + nAtt; it += nl) {
    if (it < nDft) {
      const int bl = it >> 4, rem = it & 15, ct = rem >> 3, kt = rem & 7, b = xcd * 4 + bl;
      const int wm = w & 3, wn = w >> 2;
      const bf16_t* Ab = p.ABt + (size_t)(b * 512 + ct * 256) * 4096;
      const bf16_t* Cb = p.posM + (size_t)kt * 128 * 2048;
      const bf16_t* Sb = p.posM + (size_t)(1152 + kt * 128) * 2048;
      f32x16 acc1[2][2], acc2[2][2];
#pragma unroll
      for (int a = 0; a < 2; ++a)
#pragma unroll
        for (int c = 0; c < 2; ++c) { acc1[a][c] = zero16(); acc2[a][c] = zero16(); }
      float dummy = 0.f;
      gemm8s3(acc1, [&](int row) { return Ab + (size_t)row * 4096; }, [&](int row) { return Cb + (size_t)row * 2048; }, 2048, smem);
      gemm8s3(acc2, [&](int row) { return Ab + (size_t)row * 4096 + 2048; }, [&](int row) { return Sb + (size_t)row * 2048; }, 2048, smem);
      const float sc = 1.f / 512.f;
#pragma unroll
      for (int tm = 0; tm < 2; ++tm)
#pragma unroll
        for (int tn = 0; tn < 2; ++tn) {
          const int kpos = kt * 128 + wn * 64 + tn * 32 + r;
          const int moff = ct * 256 + wm * 64 + tm * 32 + 4 * hh;
          if (kpos <= 1024) {
            bf16_t* d = p.four_o + (size_t)(b * SEQ + kpos) * 512 + moff;
#pragma unroll
            for (int q = 0; q < 4; ++q) {
              uint2 ou; ou.x = pk_bf16((acc1[tm][tn][4 * q] - acc2[tm][tn][4 * q]) * sc, (acc1[tm][tn][4 * q + 1] - acc2[tm][tn][4 * q + 1]) * sc);
              ou.y = pk_bf16((acc1[tm][tn][4 * q + 2] - acc2[tm][tn][4 * q + 2]) * sc, (acc1[tm][tn][4 * q + 3] - acc2[tm][tn][4 * q + 3]) * sc);
              *(uint2*)(d + 8 * q) = ou;
            }
          }
          if (kpos >= 1 && kpos <= 1023) {
            bf16_t* d = p.four_o + (size_t)(b * SEQ + 2048 - kpos) * 512 + moff;
#pragma unroll
            for (int q = 0; q < 4; ++q) {
              uint2 ou; ou.x = pk_bf16((acc1[tm][tn][4 * q] + acc2[tm][tn][4 * q]) * sc, (acc1[tm][tn][4 * q + 1] + acc2[tm][tn][4 * q + 1]) * sc);
              ou.y = pk_bf16((acc1[tm][tn][4 * q + 2] + acc2[tm][tn][4 * q + 2]) * sc, (acc1[tm][tn][4 * q + 3] + acc2[tm][tn][4 * q + 3]) * sc);
              *(uint2*)(d + 8 * q) = ou;
            }
          }
        }
    } else if (it < nDft + nAlt) {
      const int b = xcd * 4 + (it - nDft);
      for (int m = w; m < 512; m += NWV) {
        const bf16_t* rowp = p.ABt + (size_t)(b * 512 + m) * 4096 + lane * 8;
        float sacc = 0.f;
#pragma unroll
        for (int i = 0; i < 4; ++i) {
          const uint4 u = *(const uint4*)(rowp + 512 * i);
          sacc += (bf_lo(u.x) - bf_hi(u.x)) + (bf_lo(u.y) - bf_hi(u.y)) + (bf_lo(u.z) - bf_hi(u.z)) + (bf_lo(u.w) - bf_hi(u.w));
        }
        sacc = wave_sum(sacc);
        if (lane == 0) p.four_o[(size_t)(b * SEQ + 1024) * 512 + m] = f2bf(sacc * (1.f / 512.f));
      }
    } else {
      attn_item(p, xcd * 256 + (it - nDft - nAlt), smem);
    }
  }
}

DI void phase5(const Params& p, char* smem) {
  const int t = tid_();
  const int xcd = blockIdx.x & 7, jl = blockIdx.x >> 3, nl = gridDim.x >> 3;
  for (int L = jl; L < 256; L += nl) {
    const int tokTile = xcd * 64 + (L >> 5) * 8 + (L & 7), nt = (L >> 3) & 3;
    f32x16 acc1[2][2], acc2[2][2];
#pragma unroll
    for (int a = 0; a < 2; ++a)
#pragma unroll
      for (int c = 0; c < 2; ++c) { acc1[a][c] = zero16(); acc2[a][c] = zero16(); }
    float dummy = 0.f;
    {
      const bf16_t* Ab = p.WoT + (size_t)nt * 256 * 512; const bf16_t* Bb = p.attn_o + (size_t)tokTile * 128 * 512;
      gemm8s3(acc1, [&](int row) { return Ab + (size_t)row * 512; }, [&](int row) { return Bb + (size_t)row * 512; }, 512, smem);
    }
    {
      const bf16_t* Ab = p.WfT + (size_t)nt * 256 * 512; const bf16_t* Bb = p.four_o + (size_t)tokTile * 128 * 512;
      gemm8s3(acc2, [&](int row) { return Ab + (size_t)row * 512; }, [&](int row) { return Bb + (size_t)row * 512; }, 512, smem);
    }
    {
      char* t1 = smem; char* t2 = smem + 128 * 528;
      const int ch = t & 31, r0 = t >> 5;
      stage_tile<2, 2, 4, 2>(acc1, t1, 528, [](float v) { return v; });
      stage_tile<2, 2, 4, 2>(acc2, t2, 528, [](float v) { return v; });
      lds_sync();
#pragma unroll
      for (int hb = 0; hb < 2; ++hb) {
        uint4 gav[4], gbv[4];
#pragma unroll
        for (int i = 0; i < 4; ++i) {
          const size_t tok = (size_t)tokTile * 128 + r0 + 16 * (hb * 4 + i);
          gav[i] = *(const uint4*)(p.pg + tok * 2048 + nt * 256 + ch * 8); gbv[i] = *(const uint4*)(p.pg + tok * 2048 + 1024 + nt * 256 + ch * 8);
        }
#pragma unroll
        for (int i = 0; i < 4; ++i) {
          const int row = r0 + 16 * (hb * 4 + i);
          const size_t tok = (size_t)tokTile * 128 + row;
          const uint4 u1 = *(const uint4*)(t1 + row * 528 + ch * 16), u2 = *(const uint4*)(t2 + row * 528 + ch * 16);
          const uint4 ga = gav[i], gb = gbv[i];
          uint4 o;
          o.x = pk_bf16(bf_lo(ga.x) * bf_lo(u1.x) + bf_lo(gb.x) * bf_lo(u2.x), bf_hi(ga.x) * bf_hi(u1.x) + bf_hi(gb.x) * bf_hi(u2.x));
          o.y = pk_bf16(bf_lo(ga.y) * bf_lo(u1.y) + bf_lo(gb.y) * bf_lo(u2.y), bf_hi(ga.y) * bf_hi(u1.y) + bf_hi(gb.y) * bf_hi(u2.y));
          o.z = pk_bf16(bf_lo(ga.z) * bf_lo(u1.z) + bf_lo(gb.z) * bf_lo(u2.z), bf_hi(ga.z) * bf_hi(u1.z) + bf_hi(gb.z) * bf_hi(u2.z));
          o.w = pk_bf16(bf_lo(ga.w) * bf_lo(u1.w) + bf_lo(gb.w) * bf_lo(u2.w), bf_hi(ga.w) * bf_hi(u1.w) + bf_hi(gb.w) * bf_hi(u2.w));
          *(uint4*)(p.m + tok * DM + nt * 256 + ch * 8) = o;
        }
      }
      lds_sync();
    }
  }
}

DI void phase6(const Params& p, char* smem) {
  const int t = tid_(), lane = t & 63, w = t >> 6, r = lane & 31, hh = lane >> 5;
  const int wm = w & 1, wn = w >> 1;
  const int xcd = blockIdx.x & 7, jl = blockIdx.x >> 3, nl = gridDim.x >> 3;
  for (int L = jl; L < 128; L += nl) {
    const int tokTile = xcd * 32 + (L >> 5) * 8 + (L & 7), nt = (L >> 3) & 3;
    f32x16 acc[4][2];
#pragma unroll
    for (int a = 0; a < 4; ++a)
#pragma unroll
      for (int c = 0; c < 2; ++c) acc[a][c] = zero16();
    float dummy = 0.f;
    const bf16_t* Wb = p.WoutT + (size_t)nt * 256 * DM; const bf16_t* Mb = p.m + (size_t)tokTile * 256 * DM;
    gemm8<4, 2, 2, 4, false>(acc, [&](int row) { return Wb + (size_t)row * DM; }, [&](int row) { return Mb + (size_t)row * DM; }, DM, smem, dummy);
    const int tc_ = tid_();
    const int ch = tc_ & 63, r0 = tc_ >> 6;
    const float4 g = *(const float4*)(p.mod + (tokTile >> 3) * 6144 + 2048 + nt * 256 + ch * 4);
#pragma unroll
    for (int tn = 0; tn < 2; ++tn) {
      const size_t obase = ((size_t)tokTile * 256 + tn * 32) * DM + nt * 256 + ch * 4;
#pragma unroll
      for (int tm = 0; tm < 4; ++tm) {
        char* d = smem + (wn * 32 + r) * 1040 + (wm * 128 + tm * 32 + 4 * hh) * 4;
#pragma unroll
        for (int q = 0; q < 4; ++q) *(float4*)(d + 32 * q) = make_float4(acc[tm][tn][4 * q], acc[tm][tn][4 * q + 1], acc[tm][tn][4 * q + 2], acc[tm][tn][4 * q + 3]);
      }
      lds_sync();
#pragma unroll
      for (int hb = 0; hb < 2; ++hb) {
        float4 xv[8];
#pragma unroll
        for (int i = 0; i < 8; ++i) {
          const int row = r0 + 8 * (hb * 8 + i);
          xv[i] = *(const float4*)(p.x + obase + (size_t)((row >> 5) * 64 + (row & 31)) * DM);
        }
#pragma unroll
        for (int i = 0; i < 8; ++i) {
          const int row = r0 + 8 * (hb * 8 + i);
          const float4 a = *(const float4*)(smem + row * 1040 + ch * 16);
          uint2 ob; ob.x = pk_bf16(xv[i].x + g.x * a.x, xv[i].y + g.y * a.y); ob.y = pk_bf16(xv[i].z + g.z * a.z, xv[i].w + g.w * a.w);
          *(uint2*)(p.x1b + obase + (size_t)((row >> 5) * 64 + (row & 31)) * DM) = ob;
        }
      }
      lds_sync();
    }
  }
}

DI void phase7(const Params& p, char* smem) {
  const int t = tid_(), lane = t & 63, w = t >> 6;
  float* wr = (float*)smem;
  for (int idx = t; idx < DM * NE; idx += NTH) { const int d = idx >> 4, e = idx & 15; wr[e * DM + d] = p.w_router[idx]; }
  __syncthreads();
  const int gw = blockIdx.x * NWV + w, nw = gridDim.x * NWV;
  auto router = [&](const float4 (&v)[4], int R) {
    asm volatile("" ::: "memory");
    float a[16];
#pragma unroll
    for (int e = 0; e < 16; ++e) {
      float s = 0.f;
#pragma unroll
      for (int i = 0; i < 4; ++i) { const float4 wv = *(const float4*)(wr + e * DM + lane * 4 + 256 * i); s += v[i].x * wv.x + v[i].y * wv.y + v[i].z * wv.z + v[i].w * wv.w; }
      a[e] = s;
      if ((e & 3) == 3) __builtin_amdgcn_sched_barrier(0);
    }
    float a8[8], a4[4], a2[2], a1;
    {
      const bool up = lane & 32;
#pragma unroll
      for (int j = 0; j < 8; ++j) { const float send = up ? a[j] : a[j + 8]; const float keep = up ? a[j + 8] : a[j]; a8[j] = keep + __shfl_xor(send, 32); }
    }
    {
      const bool up = lane & 16;
#pragma unroll
      for (int j = 0; j < 4; ++j) { const float send = up ? a8[j] : a8[j + 4]; const float keep = up ? a8[j + 4] : a8[j]; a4[j] = keep + __shfl_xor(send, 16); }
    }
    {
      const bool up = lane & 8;
#pragma unroll
      for (int j = 0; j < 2; ++j) { const float send = up ? a4[j] : a4[j + 2]; const float keep = up ? a4[j + 2] : a4[j]; a2[j] = keep + __shfl_xor(send, 8); }
    }
    {
      const bool up = lane & 4;
      const float send = up ? a2[0] : a2[1]; const float keep = up ? a2[1] : a2[0]; a1 = keep + __shfl_xor(send, 4);
    }
    a1 += __shfl_xor(a1, 2);
    a1 += __shfl_xor(a1, 1);
    float mx = a1;
#pragma unroll
    for (int o = 4; o <= 32; o <<= 1) mx = fmaxf(mx, __shfl_xor(mx, o));
    const float ex = __expf(a1 - mx);
    float sm = ex;
#pragma unroll
    for (int o = 4; o <= 32; o <<= 1) sm += __shfl_xor(sm, o);
    if ((lane & 3) == 0) {
      const int e = (lane >> 2) & 15;
      p.aff[((size_t)((R >> 11) * NE + e)) * SEQ + (R & 2047)] = ex / sm;
    }
  };
  for (int R0 = gw; R0 < NT; R0 += 2 * nw) {
    const int R1 = R0 + nw;
    const bool has1 = R1 < NT;
    const bf16_t* src0 = p.x1b + (size_t)R0 * DM;
    const bf16_t* src1 = p.x1b + (size_t)(has1 ? R1 : R0) * DM;
    const float* md0 = p.mod + (R0 >> 11) * 6144;
    const float* md1 = p.mod + ((has1 ? R1 : R0) >> 11) * 6144;
    float4 v0[4], v1[4]; float s0 = 0.f, s1 = 0.f;
#pragma unroll
    for (int i = 0; i < 4; ++i) {
      const uint2 u0 = *(const uint2*)(src0 + lane * 4 + 256 * i), u1 = *(const uint2*)(src1 + lane * 4 + 256 * i);
      v0[i] = make_float4(bf_lo(u0.x), bf_hi(u0.x), bf_lo(u0.y), bf_hi(u0.y)); v1[i] = make_float4(bf_lo(u1.x), bf_hi(u1.x), bf_lo(u1.y), bf_hi(u1.y));
    }
#pragma unroll
    for (int i = 0; i < 4; ++i) { s0 += v0[i].x * v0[i].x + v0[i].y * v0[i].y + v0[i].z * v0[i].z + v0[i].w * v0[i].w; s1 += v1[i].x * v1[i].x + v1[i].y * v1[i].y + v1[i].z * v1[i].z + v1[i].w * v1[i].w; }
    s0 = wave_sum(s0); s1 = wave_sum(s1);
    const float r0 = rsqrtf(s0 * (1.f / DM) + EPS), r1 = rsqrtf(s1 * (1.f / DM) + EPS);
#pragma unroll
    for (int i = 0; i < 4; ++i) {
      const int d = lane * 4 + 256 * i;
      const float4 g = *(const float4*)(p.norm2_g + d);
      {
        const float4 sh = *(const float4*)(md0 + 3072 + d), sc = *(const float4*)(md0 + 4096 + d);
        v0[i].x = v0[i].x * r0 * g.x * (1.f + sc.x) + sh.x; v0[i].y = v0[i].y * r0 * g.y * (1.f + sc.y) + sh.y;
        v0[i].z = v0[i].z * r0 * g.z * (1.f + sc.z) + sh.z; v0[i].w = v0[i].w * r0 * g.w * (1.f + sc.w) + sh.w;
        uint2 o; o.x = pk_bf16(v0[i].x, v0[i].y); o.y = pk_bf16(v0[i].z, v0[i].w);
        *(uint2*)(p.h2 + (size_t)R0 * DM + d) = o;
      }
      if (has1) {
        const float4 sh = *(const float4*)(md1 + 3072 + d), sc = *(const float4*)(md1 + 4096 + d);
        v1[i].x = v1[i].x * r1 * g.x * (1.f + sc.x) + sh.x; v1[i].y = v1[i].y * r1 * g.y * (1.f + sc.y) + sh.y;
        v1[i].z = v1[i].z * r1 * g.z * (1.f + sc.z) + sh.z; v1[i].w = v1[i].w * r1 * g.w * (1.f + sc.w) + sh.w;
        uint2 o; o.x = pk_bf16(v1[i].x, v1[i].y); o.y = pk_bf16(v1[i].z, v1[i].w);
        *(uint2*)(p.h2 + (size_t)R1 * DM + d) = o;
      }
    }
    SB_;
    router(v0, R0);
    SB_;
    if (has1) router(v1, R1);
    SB_;
  }
}

DI void phase8(const Params& p) {
  const int t_ = tid_(); const int lane = t_ & 63, w = t_ >> 6;
  const int gw = blockIdx.x * NWV + w, nw = gridDim.x * NWV;
  for (int pr = gw; pr < NB * NE; pr += nw) {
    const float* a = p.aff + (size_t)pr * SEQ;
    unsigned u[32];
#pragma unroll
    for (int q = 0; q < 32; ++q) u[q] = __float_as_uint(a[q * 64 + lane]);
    unsigned thr = 0;
    for (int bit = 30; bit >= 0; --bit) {
      const unsigned cand = thr | (1u << bit);
      int cnt = 0;
#pragma unroll
      for (int q = 0; q < 32; ++q) cnt += __popcll(__ballot(u[q] >= cand));
      if (cnt >= CAP) thr = cand;
    }
    int ngt = 0;
#pragma unroll
    for (int q = 0; q < 32; ++q) ngt += __popcll(__ballot(u[q] > thr));
    int cgt = 0, ceq = 0;
    int* io = p.idx + pr * CAP; float* go = p.gate + pr * CAP;
    int* iv = p.inv + (size_t)pr * SEQ;
#pragma unroll
    for (int q = 0; q < 32; ++q) {
      const bool gt = u[q] > thr, eq = u[q] == thr;
      const unsigned long long mg = __ballot(gt), me = __ballot(eq);
      const unsigned long long below = (1ull << lane) - 1ull;
      int myslot = -1;
      if (gt) { const int s = cgt + __popcll(mg & below); io[s] = q * 64 + lane; go[s] = __uint_as_float(u[q]); myslot = s; }
      if (eq) { const int s = ngt + ceq + __popcll(me & below); if (s < CAP) { io[s] = q * 64 + lane; go[s] = __uint_as_float(u[q]); myslot = s; } }
      iv[q * 64 + lane] = myslot;
      cgt += __popcll(mg); ceq += __popcll(me);
    }
  }
}

DI void phase9(const Params& p, char* smem) {
  const int t = tid_(), lane = t & 63, w = t >> 6, r = lane & 31, hh = lane >> 5;
  const int wm = w & 1, wn = w >> 1;
  const int xcd = blockIdx.x & 7, jl = blockIdx.x >> 3, nl = gridDim.x >> 3;
  auto decode = [&](int L, int& e, int& ft, int& b) { e = xcd * 2 + (L >> 7); const int rem = L & 127; ft = (rem >> 3) & 3; b = (rem >> 5) * 8 + (rem & 7); };
  bool pre = false;
  for (int L = jl; L < 256; L += nl) {
    int e, ft, b, eN = 0, ftN = 0, bN = 0;
    decode(L, e, ft, b);
    const int Ln = L + nl; const bool hasNext = Ln < 256;
    if (hasNext) decode(Ln, eN, ftN, bN);
    const int be = b * NE + e;
    const bf16_t* Ab = p.WguT + ((size_t)e * 1024 + ft * 256) * DM;
    const int* ib = p.idx + be * CAP;
    const bf16_t* hb = p.h2 + (size_t)b * SEQ * DM;
    const bf16_t* AbN = p.WguT + ((size_t)eN * 1024 + ftN * 256) * DM;
    const int* ibN = p.idx + (bN * NE + eN) * CAP;
    const bf16_t* hbN = p.h2 + (size_t)bN * SEQ * DM;
    f32x16 acc[4][2];
#pragma unroll
    for (int a = 0; a < 4; ++a)
#pragma unroll
      for (int c = 0; c < 2; ++c) acc[a][c] = zero16();
    float dummy = 0.f;
    gemm8x<4, 2, 2, 4, false, 2>(acc, [&](int row) { return Ab + (size_t)row * DM; }, [&](int row) { return hb + (size_t)ib[row] * DM; }, DM, smem, dummy,
                              pre, hasNext, [&](int row) { return AbN + (size_t)row * DM; }, [&](int row) { return hbN + (size_t)ibN[row] * DM; });
    pre = hasNext;
    char* tile = smem + EPI_OFF;
#pragma unroll
    for (int tn = 0; tn < 2; ++tn)
#pragma unroll
      for (int pr = 0; pr < 2; ++pr) {
        char* d = tile + (wn * 64 + tn * 32 + r) * 272 + (wm * 64 + pr * 32 + 4 * hh) * 2;
#pragma unroll
        for (int q = 0; q < 4; ++q) {
          float v[4];
#pragma unroll
          for (int j = 0; j < 4; ++j) { const float g = acc[2 * pr][tn][4 * q + j], uu = acc[2 * pr + 1][tn][4 * q + j]; v[j] = g * sigmoidf_(g) * uu; }
          uint2 ou; ou.x = pk_bf16(v[0], v[1]); ou.y = pk_bf16(v[2], v[3]);
          *(uint2*)(d + 16 * q) = ou;
        }
      }
    lds_sync();
    bf16_t* hd_ = p.hmid + (size_t)be * CAP * DE + ft * 128;
    copy_tile(tile, 272, 256, 4, [&](int row) { return hd_ + (size_t)row * DE; }, 0, 16);
  }
}

DI void phase10(const Params& p, char* smem) {
  const int xcd = blockIdx.x & 7, jl = blockIdx.x >> 3, nl = gridDim.x >> 3;
  for (int L = jl; L < 512; L += nl) {
    const int e = xcd * 2 + (L >> 8), rem = L & 255, nt = (rem >> 3) & 3, st = (rem >> 5) & 1, b = (rem >> 6) * 8 + (rem & 7);
    const int be = b * NE + e;
    const bf16_t* Hb = p.hmid + ((size_t)be * CAP + st * 128) * DE;
    const bf16_t* Wb = p.WdT + ((size_t)e * DM + nt * 256) * DE;
    f32x16 acc[2][2];
#pragma unroll
    for (int a = 0; a < 2; ++a)
#pragma unroll
      for (int c = 0; c < 2; ++c) acc[a][c] = zero16();
    gemm8s3(acc, [&](int row) { return Wb + (size_t)row * DE; }, [&](int row) { return Hb + (size_t)row * DE; }, DE, smem);
    stage_tile<2, 2, 4, 2>(acc, smem, 528, [](float v) { return v; });
    lds_sync();
    bf16_t* yb = p.Y + ((size_t)be * CAP + st * 128) * DM + nt * 256;
    copy_tile(smem, 528, 128, 5, [&](int row) { return yb + (size_t)row * DM; }, 0, 32);
    lds_sync();
  }
}

DI void phase11(const Params& p) {
  const int t_ = tid_(); const int lane = t_ & 63, w = t_ >> 6;
  const int gw = blockIdx.x * NWV + w, nw = gridDim.x * NWV;
  for (int R = gw; R < NT; R += nw) {
    const int b = R >> 11, tq = R & 2047;
    const int myslot = (lane < NE) ? p.inv[((size_t)(b * NE + lane)) * SEQ + tq] : -1;
    unsigned long long mask = __ballot(myslot >= 0);
    const bf16_t* xs = p.x1b + (size_t)R * DM + lane * 4;
    uint2 xu[4];
#pragma unroll
    for (int i = 0; i < 4; ++i) xu[i] = *(const uint2*)(xs + 256 * i);
    float4 a[4];
#pragma unroll
    for (int i = 0; i < 4; ++i) a[i] = make_float4(0.f, 0.f, 0.f, 0.f);
    while (mask) {
      const int e = __ffsll((long long)mask) - 1; mask &= mask - 1ull;
      const int slot = __shfl(myslot, e);
      const float g = p.gate[(b * NE + e) * CAP + slot];
      const bf16_t* y = p.Y + ((size_t)(b * NE + e) * CAP + slot) * DM + lane * 4;
#pragma unroll
      for (int i = 0; i < 4; ++i) {
        const uint2 u = *(const uint2*)(y + 256 * i);
        a[i].x += g * bf_lo(u.x); a[i].y += g * bf_hi(u.x); a[i].z += g * bf_lo(u.y); a[i].w += g * bf_hi(u.y);
      }
    }
    const float* g2 = p.mod + b * 6144 + 5120;
    float* o = p.out + (size_t)R * DM;
#pragma unroll
    for (int i = 0; i < 4; ++i) {
      const int d = lane * 4 + 256 * i;
      const float4 gv = *(const float4*)(g2 + d);
      *(float4*)(o + d) = make_float4(bf_lo(xu[i].x) + gv.x * a[i].x, bf_hi(xu[i].x) + gv.y * a[i].y, bf_lo(xu[i].y) + gv.z * a[i].z, bf_hi(xu[i].y) + gv.w * a[i].w);
    }
  }
}

__global__ void __launch_bounds__(NTH, 2) mega_kernel(Params p) {
  cg::grid_group grid = cg::this_grid();
  __shared__ __attribute__((aligned(16))) char smem[SMEM_BYTES];
#ifndef REPMASK
#define REPMASK 0
#endif
#define RUNPH(k, call) for (int rep_ = 0; rep_ < (((REPMASK) >> (k)) & 1) + 1; ++rep_) { call; grid.sync(); }
  RUNPH(0, phase0(p, smem))
  RUNPH(1, phase1(p))
  RUNPH(2, phase2(p, smem))
  RUNPH(3, phase3(p, smem))
  RUNPH(4, phase4(p, smem))
  RUNPH(5, phase5(p, smem))
  RUNPH(6, phase6(p, smem))
  RUNPH(7, phase7(p, smem))
  RUNPH(8, phase8(p))
  RUNPH(9, phase9(p, smem))
  RUNPH(10, phase10(p, smem))
  phase11(p);
}

static inline size_t align_up(size_t v, size_t a) { return (v + a - 1) / a * a; }

extern "C" void kernel_launch(void* const* d_in, const int* in_sizes, int n_in,
                              void* d_out, int out_size, void* d_ws, size_t ws_size,
                              hipStream_t stream) {
  static int grid_blocks = 0;
  if (!grid_blocks) {
    int dev = 0, cus = 0, per_cu = 0;
    (void)hipGetDevice(&dev);
    (void)hipDeviceGetAttribute(&cus, hipDeviceAttributeMultiprocessorCount, dev);
    (void)hipOccupancyMaxActiveBlocksPerMultiprocessor(&per_cu, mega_kernel, NTH, 0);
    if (per_cu > 1) per_cu = 1;
    if (per_cu < 1) per_cu = 1;
    grid_blocks = (cus * per_cu) & ~7;
    if (grid_blocks < 8) grid_blocks = 8;
  }
  Params p;
  memset(&p, 0, sizeof(p));
  p.x = (const float*)d_in[0]; p.c = (const float*)d_in[1]; p.ctx = (const float*)d_in[2]; p.c_ctx = (const float*)d_in[3];
  p.w_mod = (const float*)d_in[4]; p.b_mod = (const float*)d_in[5]; p.norm1_g = (const float*)d_in[6];
  const float* w_in = (const float*)d_in[7];
  const float* q_a_g = (const float*)d_in[8];
  const float* kv_a_g = (const float*)d_in[9];
  const float* w_q_up = (const float*)d_in[10];
  const float* w_kv_up = (const float*)d_in[11];
  p.q_norm_g = (const float*)d_in[12]; p.k_norm_g = (const float*)d_in[13];
  const float* w_o_attn = (const float*)d_in[14];
  const float* w_fourier = (const float*)d_in[15];
  const float* w_out = (const float*)d_in[16];
  p.norm2_g = (const float*)d_in[17]; p.w_router = (const float*)d_in[18];
  const float* w_e_gate = (const float*)d_in[19];
  const float* w_e_up = (const float*)d_in[20];
  const float* w_e_down = (const float*)d_in[21];
  p.out = (float*)d_out;

  char* base = (char*)d_ws; size_t off = 0;
  auto alloc = [&](size_t bytes) { char* q = base + off; off = align_up(off + bytes, 256); return q; };
  p.WinT = (bf16_t*)alloc((size_t)NINP * DM * 2);
  p.WqT = (bf16_t*)alloc((size_t)768 * QL * 2);
  p.WkvT = (bf16_t*)alloc((size_t)1024 * KVL * 2);
  p.WoT = (bf16_t*)alloc((size_t)DM * 512 * 2);
  p.WfT = (bf16_t*)alloc((size_t)DM * 512 * 2);
  p.WoutT = (bf16_t*)alloc((size_t)DM * DM * 2);
  p.WguT = (bf16_t*)alloc((size_t)NE * 1024 * DM * 2);
  p.WdT = (bf16_t*)alloc((size_t)NE * DM * DE * 2);
  p.chanT = (bf16_t*)alloc((size_t)256 * 128 * 2);
  p.posM = (bf16_t*)alloc((size_t)2 * 1152 * 2048 * 2);
  p.ropeTab = (float*)alloc(64 * 8 * 2 * 4);
  p.mod = (float*)alloc(33 * 6144 * 4);
  p.aff = (float*)alloc((size_t)NB * NE * SEQ * 4);
  p.gate = (float*)alloc((size_t)NB * NE * CAP * 4);
  p.idx = (int*)alloc((size_t)NB * NE * CAP * 4);
  p.inv = (int*)alloc((size_t)NB * NE * SEQ * 4);
  p.pckv = (bf16_t*)alloc((size_t)NC * LDCKV * 2 + 4096);
  char* regA = alloc((size_t)(NT + NC) * DM * 2);
  p.h = (bf16_t*)regA; p.ABt = (bf16_t*)regA; p.h2 = (bf16_t*)regA;
  char* regB1 = alloc((size_t)NT * LDQKV * 2);
  p.pqkv = (bf16_t*)regB1; p.attn_o = (bf16_t*)regB1;
  char* regB2 = alloc((size_t)NT * 512 * 2);
  p.pf = (bf16_t*)regB2; p.four_o = (bf16_t*)regB2;
  p.x1b = (bf16_t*)regB1;
  if ((size_t)(regB2 - regB1) + (size_t)NT * 512 * 2 < (size_t)NT * DM * 2) { fprintf(stderr, "x1b does not fit\n"); return; }
  p.pg = (bf16_t*)alloc((size_t)NT * 2048 * 2);
  p.Y = p.pg;
  const size_t szQ = (size_t)NB * NH * SEQ * QKD * 2, szK = (size_t)NB * NH * NKEY * QKD * 2, szV = (size_t)NB * NH * VD * NKEY * 2;
  char* regC = alloc(szQ + szK + szV + 1024);
  p.Q = (bf16_t*)regC; p.K = (bf16_t*)(regC + align_up(szQ, 256)); p.Vt = (bf16_t*)(regC + align_up(szQ, 256) + align_up(szK, 256));
  p.m = (bf16_t*)regC; p.hmid = (bf16_t*)(regC + (size_t)NT * DM * 2);
  if (off > ws_size) { fprintf(stderr, "workspace too small: need %zu have %zu\n", off, ws_size); return; }

  int ts = 0;
  auto job = [&](int i, const float* src, bf16_t* dst, const float* scale, int K, int ldS, int n_off, int n_cnt, int dst_row0, int mode, int batch, long sbs, long dbs) {
    TJob& j = p.jobs[i];
    j.src = src; j.dst = dst; j.scale = scale; j.K = K; j.ldS = ldS; j.n_off = n_off; j.n_cnt = n_cnt; j.dst_row0 = dst_row0; j.mode = mode; j.batch = batch;
    j.tiles_n = (n_cnt + 63) / 64; j.tile_start = ts; j.src_bstride = sbs; j.dst_bstride = dbs;
    ts += batch * (K / 64) * j.tiles_n;
  };
  job(0, w_e_gate, p.WguT, nullptr, DM, DE, 0, DE, 0, 1, NE, (long)DM * DE, (long)1024 * DM);
  job(1, w_e_up, p.WguT, nullptr, DM, DE, 0, DE, 0, 2, NE, (long)DM * DE, (long)1024 * DM);
  job(2, w_e_down, p.WdT, nullptr, DE, DM, 0, DM, 0, 0, NE, (long)DE * DM, (long)DM * DE);
  job(3, w_in, p.WinT, nullptr, DM, N_IN, 0, 672, 0, 0, 1, 0, 0);
  job(4, w_in, p.WinT, nullptr, DM, N_IN, 672, 2560, 768, 0, 1, 0, 0);
  job(5, w_q_up, p.WqT, q_a_g, QL, 768, 0, 768, 0, 0, 1, 0, 0);
  job(6, w_kv_up, p.WkvT, kv_a_g, KVL, 1024, 0, 1024, 0, 0, 1, 0, 0);
  job(7, w_o_attn, p.WoT, nullptr, 512, DM, 0, DM, 0, 0, 1, 0, 0);
  job(8, w_fourier, p.WfT, nullptr, 512, DM, 0, DM, 0, 0, 1, 0, 0);
  job(9, w_out, p.WoutT, nullptr, DM, DM, 0, DM, 0, 0, 1, 0, 0);
  p.n_ttiles = ts;

  void* args[] = {&p};
  hipError_t e = hipLaunchCooperativeKernel((void*)mega_kernel, dim3(grid_blocks), dim3(NTH), args, 0, stream);
  if (e != hipSuccess) fprintf(stderr, "cooperative launch failed: %s (grid %d)\n", hipGetErrorString(e), grid_blocks);
}
```

```cpp
#include <hip/hip_runtime.h>
#include <hip/hip_cooperative_groups.h>
#include <cstdio>
#include <cstring>
#include <cstdint>
namespace cg = cooperative_groups;

#define DI __device__ __forceinline__
typedef unsigned short bf16_t;
typedef short bf16x8 __attribute__((ext_vector_type(8)));
typedef float f32x16 __attribute__((ext_vector_type(16)));
#define MFMA(a, b, c) __builtin_amdgcn_mfma_f32_32x32x16_bf16((a), (b), (c), 0, 0, 0)

constexpr int NB = 32, SEQ = 2048, DM = 1024, NT = NB * SEQ, CTXL = 256, NC = NB * CTXL;
constexpr int NH = 8, QKD = 96, VD = 64, QL = 384, KVL = 256, NKEY = SEQ + CTXL;
constexpr int N_IN = 3232, NINP = 3328;
constexpr int NE = 16, DE = 512, CAP = 256;
constexpr float EPS = 1e-6f;
constexpr int LDQKV = 672, LDCKV = 288;
constexpr int NTH = 512, NWV = 8;
constexpr int SMEM_BYTES = 147456;

struct TJob {
  const float* src; bf16_t* dst; const float* scale;
  int K, ldS, n_off, n_cnt, dst_row0, mode, batch, tiles_n, tile_start, pad0;
  long src_bstride, dst_bstride;
};
constexpr int NJOBS = 10;

struct Params {
  const float *x, *c, *ctx, *c_ctx, *w_mod, *b_mod, *norm1_g, *q_norm_g, *k_norm_g, *norm2_g, *w_router;
  float* out;
  bf16_t *WinT, *WqT, *WkvT, *WoT, *WfT, *WoutT, *WguT, *WdT, *chanT, *posM;
  float *ropeTab, *mod;
  bf16_t *h, *pqkv, *pckv, *pf, *pg, *Q, *K, *Vt, *attn_o, *ABt, *four_o, *m, *h2, *hmid;
  float *aff, *gate;
  int* idx;
  int* inv;
  bf16_t* Y;
  bf16_t* x1b;
  TJob jobs[NJOBS];
  int n_ttiles, pad1;
};

typedef float f32x2v __attribute__((ext_vector_type(2)));
typedef __bf16 bf16x2v __attribute__((ext_vector_type(2)));
DI unsigned pk_bf16(float lo, float hi) { f32x2v v = {lo, hi}; bf16x2v b = __builtin_convertvector(v, bf16x2v); return __builtin_bit_cast(unsigned, b); }
DI int tid_() { int t = threadIdx.x; asm volatile("" : "+v"(t)); return t; }
DI float bf_lo(unsigned u) { return __uint_as_float(u << 16); }
DI float bf_hi(unsigned u) { return __uint_as_float(u & 0xffff0000u); }
DI bf16_t f2bf(float f) { return (bf16_t)(pk_bf16(f, 0.f) & 0xffffu); }
DI float sigmoidf_(float x) { return 1.f / (1.f + __expf(-x)); }
DI int crow(int i, int hh) { return (i & 3) + 8 * (i >> 2) + 4 * hh; }
DI float wave_sum(float v) {
#pragma unroll
  for (int o = 32; o >= 1; o >>= 1) v += __shfl_xor(v, o);
  return v;
}
DI f32x16 zero16() { f32x16 z;
#pragma unroll
  for (int i = 0; i < 16; ++i) z[i] = 0.f; return z; }
DI void wait_vm0() { asm volatile("s_waitcnt vmcnt(0)" ::: "memory"); }
DI void wait_lgkm0() { asm volatile("s_waitcnt lgkmcnt(0)" ::: "memory"); }
DI void bar_() { __builtin_amdgcn_s_barrier(); }
DI void lds_sync() { wait_lgkm0(); bar_(); }
#define GLDS(gp, lp) __builtin_amdgcn_global_load_lds((const unsigned*)(gp), (__attribute__((address_space(3))) unsigned*)(lp), 16, 0, 0)
#define SB_ __builtin_amdgcn_sched_barrier(0)

constexpr int EPI_OFF = 65536;
template <int TM, int TN, int WM, int WN, bool SUMSQ, int NST, class AF, class BF, class AFN, class BFN>
DI void gemm8x(f32x16 (&acc)[TM][TN], AF arow, BF brow, int K, char* smem, float& sumsq, bool pre, bool hasNext, AFN arowN, BFN browN) {
  constexpr int RA = 32 * TM * WM, RB = 32 * TN * WN;
  constexpr int LDR = 128, STAGE = (RA + RB) * LDR;
  static_assert(WM * WN == NWV, "waves");
  static_assert(NST * STAGE <= SMEM_BYTES, "smem");
  static_assert(NST == 2 || (NST == 3 && RA == 256 && RB == 128), "3-stage ring: 6 loads per thread per stage assumed");
  static_assert(RA <= 256 && RB <= 256 && RA % 32 == 0 && RB % 32 == 0, "shape");
  const int t = tid_(), lane = t & 63, w = t >> 6, r = lane & 31, hh = lane >> 5;
  const int wm = w % WM, wn = w / WM;
  const int row0 = t >> 3;
  const int c = (t & 7) ^ ((row0 >> 1) & 7);
  const bool a0v = row0 < RA, a1v = row0 + 64 < RA, a2v = row0 + 128 < RA, a3v = row0 + 192 < RA;
  const bool b0v = row0 < RB, b1v = row0 + 64 < RB, b2v = row0 + 128 < RB, b3v = row0 + 192 < RB;
  const bf16_t* pa0 = arow(a0v ? row0 : 0) + c * 8;
  const bf16_t* pa1 = arow(a1v ? row0 + 64 : 0) + c * 8;
  const bf16_t* pa2 = arow(a2v ? row0 + 128 : 0) + c * 8;
  const bf16_t* pa3 = arow(a3v ? row0 + 192 : 0) + c * 8;
  const bf16_t* pb0 = brow(b0v ? row0 : 0) + c * 8;
  const bf16_t* pb1 = brow(b1v ? row0 + 64 : 0) + c * 8;
  const bf16_t* pb2 = brow(b2v ? row0 + 128 : 0) + c * 8;
  const bf16_t* pb3 = brow(b3v ? row0 + 192 : 0) + c * 8;
  if (!pre) {
    char* l_ = smem + t * 16; char* m_ = l_ + RA * LDR;
    if (a0v) GLDS(pa0, l_); if (a1v) GLDS(pa1, l_ + 8192); if (a2v) GLDS(pa2, l_ + 16384); if (a3v) GLDS(pa3, l_ + 24576);
    if (b0v) GLDS(pb0, m_); if (b1v) GLDS(pb1, m_ + 8192); if (b2v) GLDS(pb2, m_ + 16384); if (b3v) GLDS(pb3, m_ + 24576);
  }
  if (NST == 3) {
    char* l_ = smem + STAGE + t * 16; char* m_ = l_ + RA * LDR;
    GLDS(pa0 + 64, l_); GLDS(pa1 + 64, l_ + 8192); GLDS(pa2 + 64, l_ + 16384); GLDS(pa3 + 64, l_ + 24576);
    GLDS(pb0 + 64, m_); GLDS(pb1 + 64, m_ + 8192);
    asm volatile("s_waitcnt vmcnt(6)" ::: "memory");
  } else wait_vm0();
  bar_();
  const int nk = K >> 6;
  const int sw = (r >> 1) & 7;
  const int aoff = (wm * TM * 32 + r) * LDR, boff = RA * LDR + (wn * TN * 32 + r) * LDR;
  auto compute = [&](const char* cur, char* nxt, bool issue, const bf16_t* q0, const bf16_t* q1, const bf16_t* q2, const bf16_t* q3,
                     const bf16_t* s0, const bf16_t* s1, const bf16_t* s2, const bf16_t* s3) {
    const char* As = cur + aoff;
    const char* Bs = cur + boff;
    char* l_ = nxt + t * 16; char* m_ = l_ + RA * LDR;
    bf16x8 a0[TM], b0[TN], a1[TM], b1[TN];
#define LOADF(A_, B_, ks) do { const int po_ = (((ks) * 2 + hh) ^ sw) * 16; \
      _Pragma("unroll") for (int tm = 0; tm < TM; ++tm) A_[tm] = *(const bf16x8*)(As + tm * 32 * LDR + po_); \
      _Pragma("unroll") for (int tn = 0; tn < TN; ++tn) B_[tn] = *(const bf16x8*)(Bs + tn * 32 * LDR + po_); } while (0)
#define MMF(A_, B_) do { if (SUMSQ) { uint4 u = __builtin_bit_cast(uint4, B_[0]); \
        float e0 = bf_lo(u.x), e1 = bf_hi(u.x), e2 = bf_lo(u.y), e3 = bf_hi(u.y), e4 = bf_lo(u.z), e5 = bf_hi(u.z), e6 = bf_lo(u.w), e7 = bf_hi(u.w); \
        sumsq += e0 * e0 + e1 * e1 + e2 * e2 + e3 * e3 + e4 * e4 + e5 * e5 + e6 * e6 + e7 * e7; } \
      _Pragma("unroll") for (int tm = 0; tm < TM; ++tm) _Pragma("unroll") for (int tn = 0; tn < TN; ++tn) acc[tm][tn] = MFMA(A_[tm], B_[tn], acc[tm][tn]); } while (0)
    LOADF(a0, b0, 0);
    LOADF(a1, b1, 1);
    SB_;
    if (issue) { if (a0v) GLDS(q0, l_); if (a1v) GLDS(q1, l_ + 8192); }
    SB_;
    __builtin_amdgcn_s_setprio(1);
    MMF(a0, b0);
    LOADF(a0, b0, 2);
    SB_;
    if (issue) { if (a2v) GLDS(q2, l_ + 16384); if (a3v) GLDS(q3, l_ + 24576); }
    SB_;
    MMF(a1, b1);
    LOADF(a1, b1, 3);
    SB_;
    if (issue) { if (b0v) GLDS(s0, m_); if (b1v) GLDS(s1, m_ + 8192); }
    SB_;
    MMF(a0, b0);
    SB_;
    if (issue) { if (b2v) GLDS(s2, m_ + 16384); if (b3v) GLDS(s3, m_ + 24576); }
    SB_;
    MMF(a1, b1);
    __builtin_amdgcn_s_setprio(0);
  };
  int sc_ = 0;
  for (int kt = 0; kt < nk - 1; ++kt) {
    SB_;
    if (NST == 2) {
      const int ko = (kt + 1) * 64;
      compute(smem + (kt & 1) * STAGE, smem + ((kt + 1) & 1) * STAGE, true, pa0 + ko, pa1 + ko, pa2 + ko, pa3 + ko, pb0 + ko, pb1 + ko, pb2 + ko, pb3 + ko);
      SB_;
      wait_vm0(); bar_();
    } else {
      const int ko = (kt + 2) * 64; const bool iss = kt + 2 < nk;
      const int sn = (sc_ == 0) ? 2 : sc_ - 1;
      compute(smem + sc_ * STAGE, smem + sn * STAGE, iss, pa0 + ko, pa1 + ko, pa2 + ko, pa3 + ko, pb0 + ko, pb1 + ko, pb2 + ko, pb3 + ko);
      SB_;
      if (iss) asm volatile("s_waitcnt vmcnt(6)" ::: "memory"); else wait_vm0();
      bar_();
      sc_ = (sc_ == 2) ? 0 : sc_ + 1;
    }
  }
  if (NST == 3) {
    SB_;
    compute(smem + sc_ * STAGE, smem, false, pa0, pa0, pa0, pa0, pa0, pa0, pa0, pa0);
    SB_;
    lds_sync();
  } else {
    const bf16_t *q0 = pa0, *q1 = pa0, *q2 = pa0, *q3 = pa0, *s0 = pa0, *s1 = pa0, *s2 = pa0, *s3 = pa0;
    if (hasNext) {
      q0 = arowN(a0v ? row0 : 0) + c * 8; q1 = arowN(a1v ? row0 + 64 : 0) + c * 8; q2 = arowN(a2v ? row0 + 128 : 0) + c * 8; q3 = arowN(a3v ? row0 + 192 : 0) + c * 8;
      s0 = browN(b0v ? row0 : 0) + c * 8; s1 = browN(b1v ? row0 + 64 : 0) + c * 8; s2 = browN(b2v ? row0 + 128 : 0) + c * 8; s3 = browN(b3v ? row0 + 192 : 0) + c * 8;
    }
    SB_;
    compute(smem + ((nk - 1) & 1) * STAGE, smem, hasNext, q0, q1, q2, q3, s0, s1, s2, s3);
    SB_;
    lds_sync();
  }
}
template <int TM, int TN, int WM, int WN, bool SUMSQ, class AF, class BF>
DI void gemm8(f32x16 (&acc)[TM][TN], AF arow, BF brow, int K, char* smem, float& sumsq) {
  gemm8x<TM, TN, WM, WN, SUMSQ, 2>(acc, arow, brow, K, smem, sumsq, false, false, arow, brow);
}
template <class AF, class BF>
DI void gemm8s3(f32x16 (&acc)[2][2], AF arow, BF brow, int K, char* smem) {
  float dummy = 0.f;
  gemm8x<2, 2, 4, 2, false, 3>(acc, arow, brow, K, smem, dummy, false, false, arow, brow);
}
template <int TM, int WM, int WN, int TNSEL, class F>
DI void stage_half(const f32x16 (&acc)[TM][2], char* tile, int pitch, F f) {
  const int t = tid_(), lane = t & 63, w = t >> 6, r = lane & 31, hh = lane >> 5;
  const int wm = w % WM, wn = w / WM;
#pragma unroll
  for (int tm = 0; tm < TM; ++tm) {
    char* d = tile + (wn * 32 + r) * pitch + (wm * TM * 32 + tm * 32 + 4 * hh) * 2;
#pragma unroll
    for (int q = 0; q < 4; ++q) {
      const f32x16& a = acc[tm][TNSEL];
      uint2 o; o.x = pk_bf16(f(a[4 * q]), f(a[4 * q + 1])); o.y = pk_bf16(f(a[4 * q + 2]), f(a[4 * q + 3]));
      *(uint2*)(d + 16 * q) = o;
    }
  }
}

template <int TM, int TN, int WM, int WN, class F>
DI void stage_tile(const f32x16 (&acc)[TM][TN], char* tile, int pitch, F f) {
  const int t = tid_(), lane = t & 63, w = t >> 6, r = lane & 31, hh = lane >> 5;
  const int wm = w % WM, wn = w / WM;
#pragma unroll
  for (int tm = 0; tm < TM; ++tm)
#pragma unroll
    for (int tn = 0; tn < TN; ++tn) {
      char* d = tile + (wn * TN * 32 + tn * 32 + r) * pitch + (wm * TM * 32 + tm * 32 + 4 * hh) * 2;
#pragma unroll
      for (int q = 0; q < 4; ++q) {
        uint2 o; o.x = pk_bf16(f(acc[tm][tn][4 * q]), f(acc[tm][tn][4 * q + 1])); o.y = pk_bf16(f(acc[tm][tn][4 * q + 2]), f(acc[tm][tn][4 * q + 3]));
        *(uint2*)(d + 16 * q) = o;
      }
    }
}
template <class RF>
DI void copy_tile(const char* tile, int pitch, int rows, int lch, RF dst, int ch0, int ch1) {
  const int t = tid_();
  const int total = rows << lch;
  for (int id = t; id < total; id += NTH) {
    const int row = id >> lch, ch = id & ((1 << lch) - 1);
    if (ch >= ch0 && ch < ch1) *(uint4*)(dst(row) + ch * 8) = *(const uint4*)(tile + row * pitch + ch * 16);
  }
}

struct TTile { const float* src; const float* scale; bf16_t* dst; int K, ldS, n0, n_cnt, k0, dst_row0, mode; };
DI TTile ttile_decode(const Params& p, int u) {
  int jb = 0;
#pragma unroll 1
  for (int q = 1; q < NJOBS; ++q) if (u >= p.jobs[q].tile_start) jb = q;
  const TJob& j = p.jobs[jb];
  const int tile = u - j.tile_start;
  const int tpb = (j.K >> 6) * j.tiles_n;
  const int bi = tile / tpb, rem = tile % tpb;
  const int kt = rem / j.tiles_n, ntile = rem % j.tiles_n;
  TTile tt;
  tt.src = j.src + (size_t)bi * j.src_bstride + j.n_off; tt.scale = j.scale; tt.dst = j.dst + (size_t)bi * j.dst_bstride;
  tt.K = j.K; tt.ldS = j.ldS; tt.n0 = ntile * 64; tt.n_cnt = j.n_cnt; tt.k0 = kt * 64; tt.dst_row0 = j.dst_row0; tt.mode = j.mode;
  return tt;
}
DI void ttile_load(const TTile& tt, int t, float (&v)[8]) {
  const int nn = t & 63, kq = t >> 6;
  const bool nvalid = (tt.n0 + nn) < tt.n_cnt;
#pragma unroll
  for (int i = 0; i < 8; ++i) {
    const int kk = kq + 8 * i;
    float x = 0.f;
    if (nvalid) { x = tt.src[(size_t)(tt.k0 + kk) * tt.ldS + tt.n0 + nn]; if (tt.scale) x *= tt.scale[tt.k0 + kk]; }
    v[i] = x;
  }
}
DI void ttile_store(const TTile& tt, int t, const float (&v)[8], char* smem) {
  bf16_t* T = (bf16_t*)smem;
  const int nn = t & 63, kq = t >> 6;
#pragma unroll
  for (int i = 0; i < 8; ++i) T[nn * 66 + kq + 8 * i] = f2bf(v[i]);
  __syncthreads();
  const int n = t >> 3, part = t & 7;
  if (tt.n0 + n < tt.n_cnt) {
    const unsigned* tp = (const unsigned*)(T + n * 66 + part * 8);
    uint4 o0; o0.x = tp[0]; o0.y = tp[1]; o0.z = tp[2]; o0.w = tp[3];
    const int f = tt.n0 + n;
    int drow;
    if (tt.mode == 0) drow = tt.dst_row0 + f;
    else drow = (f >> 7) * 256 + ((f >> 6) & 1) * 128 + (((f >> 5) & 1) * 2 + (tt.mode == 2 ? 1 : 0)) * 32 + (f & 31);
    *(uint4*)(tt.dst + (size_t)drow * tt.K + tt.k0 + part * 8) = o0;
  }
  __syncthreads();
}

DI void mod_item(const Params& p, int it, char* smem) {
  const int t = tid_(), cgi = t & 15, kg = t >> 4;
  const int j0 = it * 16;
  float* Ssm = (float*)smem;
  float* red = (float*)(smem + 33 * 128 * 4);
  float acc[33];
#pragma unroll
  for (int r = 0; r < 33; ++r) acc[r] = 0.f;
  const float* wp = p.w_mod + (size_t)(kg * 4) * 6144 + j0 + cgi;
  float n0 = wp[0], n1 = wp[6144], n2 = wp[2 * 6144], n3 = wp[3 * 6144];
#pragma unroll 1
  for (int kc = 0; kc < 8; ++kc) {
    __syncthreads();
    for (int idx = t; idx < 33 * 128; idx += NTH) {
      const int r = idx >> 7, kk = idx & 127;
      float v = (r < 32) ? p.c[r * DM + kc * 128 + kk] : p.c_ctx[kc * 128 + kk];
      Ssm[idx] = v * sigmoidf_(v);
    }
    const float w0 = n0, w1 = n1, w2 = n2, w3 = n3;
    if (kc < 7) { const float* wq = wp + (size_t)(kc + 1) * 128 * 6144; n0 = wq[0]; n1 = wq[6144]; n2 = wq[2 * 6144]; n3 = wq[3 * 6144]; }
    __syncthreads();
#pragma unroll
    for (int r = 0; r < 33; ++r) {
      const float4 s = *(const float4*)(Ssm + r * 128 + kg * 4);
      acc[r] += s.x * w0 + s.y * w1 + s.z * w2 + s.w * w3;
    }
  }
  __syncthreads();
#pragma unroll
  for (int r = 0; r < 33; ++r) red[(kg * 33 + r) * 16 + cgi] = acc[r];
  __syncthreads();
  for (int idx = t; idx < 33 * 16; idx += NTH) {
    const int r = idx >> 4, cc = idx & 15;
    float s = 0.f;
#pragma unroll
    for (int g = 0; g < 32; ++g) s += red[(g * 33 + r) * 16 + cc];
    p.mod[r * 6144 + j0 + cc] = s + p.b_mod[j0 + cc];
  }
}

DI void phase0(const Params& p, char* smem) {
  const int t = tid_();
  const int nMod = 384;
  const int nPos = 288;
  const int nMisc = 3;
  const int nT = p.n_ttiles;
  const int total = nMod + nPos + nMisc;
  float* ctab = (float*)(smem + 98304);
  for (int j = t; j < 2048; j += NTH) ctab[j] = cospif((float)j * (1.f / 1024.f));
  __syncthreads();
  for (int it = blockIdx.x; it < total; it += gridDim.x) {
    if (it < nMod) { mod_item(p, it, smem); continue; }
    int u = it - nMod;
    if (u < nPos) {
      for (int e = t; e < 8 * 256; e += NTH) {
        const int R = u * 8 + (e >> 8), c8 = (e & 255) * 8;
        const int part = R >= 1152 ? 1 : 0, k = R - part * 1152;
        float v[8];
#pragma unroll
        for (int q = 0; q < 8; ++q) {
          const int tt = c8 + q;
          v[q] = (k > 1024) ? 0.f : (part ? ctab[(k * tt - 512) & 2047] : ctab[(k * tt) & 2047]);
        }
        uint4 o; o.x = pk_bf16(v[0], v[1]); o.y = pk_bf16(v[2], v[3]); o.z = pk_bf16(v[4], v[5]); o.w = pk_bf16(v[6], v[7]);
        *(uint4*)(p.posM + (size_t)R * 2048 + c8) = o;
      }
      continue;
    }
    u -= nPos;
    if (u == 0) {
      for (int e = t; e < 256 * 128; e += NTH) {
        const int m2 = e >> 7, cc = e & 127, mm = m2 & 127;
        float v = (m2 < 128) ? ctab[(mm * cc * 16) & 2047] : ctab[(mm * cc * 16 - 512) & 2047];
        p.chanT[e] = f2bf(v);
      }
    } else if (u == 1) {
      for (int e = t; e < 64 * 8; e += NTH) {
        const int pos = e >> 3, jf = e & 7;
        const float inv = 1.0f / powf(10000.0f, (float)jf / 8.0f);
        const float ang = (float)pos * inv;
        p.ropeTab[e * 2 + 0] = cosf(ang);
        p.ropeTab[e * 2 + 1] = sinf(ang);
      }
    } else {
      uint4 z; z.x = z.y = z.z = z.w = 0u;
      uint4* dp = (uint4*)(p.WinT + (size_t)672 * DM);
      for (int e = t; e < 96 * DM / 8; e += NTH) dp[e] = z;
    }
  }
  __syncthreads();
  {
    const int G = gridDim.x;
    int u = (int)((blockIdx.x + 128u) % (unsigned)G);
    float vn[8];
    TTile tn_ = ttile_decode(p, u < nT ? u : 0);
    if (u < nT) ttile_load(tn_, t, vn);
    for (; u < nT; u += G) {
      const TTile tc = tn_;
      float vc[8];
#pragma unroll
      for (int i = 0; i < 8; ++i) vc[i] = vn[i];
      if (u + G < nT) { tn_ = ttile_decode(p, u + G); ttile_load(tn_, t, vn); }
      ttile_store(tc, t, vc, smem);
    }
  }
}

DI void phase1(const Params& p) {
  const int t_ = tid_(); const int lane = t_ & 63, w = t_ >> 6;
  const int gw = blockIdx.x * NWV + w, nw = gridDim.x * NWV;
  for (int R0 = gw; R0 < NT + NC; R0 += 2 * nw) {
    const int R1 = R0 + nw; const bool has1 = R1 < NT + NC;
    const float* src0 = (R0 < NT) ? p.x + (size_t)R0 * DM : p.ctx + (size_t)(R0 - NT) * DM;
    const float* src1 = has1 ? ((R1 < NT) ? p.x + (size_t)R1 * DM : p.ctx + (size_t)(R1 - NT) * DM) : src0;
    const float* md0 = p.mod + ((R0 < NT) ? (R0 >> 11) : 32) * 6144;
    const float* md1 = p.mod + ((has1 && R1 < NT) ? (R1 >> 11) : 32) * 6144;
    float4 v0[4], v1[4]; float s0 = 0.f, s1 = 0.f;
#pragma unroll
    for (int i = 0; i < 4; ++i) { v0[i] = *(const float4*)(src0 + lane * 4 + 256 * i); v1[i] = *(const float4*)(src1 + lane * 4 + 256 * i); }
#pragma unroll
    for (int i = 0; i < 4; ++i) { s0 += v0[i].x * v0[i].x + v0[i].y * v0[i].y + v0[i].z * v0[i].z + v0[i].w * v0[i].w; s1 += v1[i].x * v1[i].x + v1[i].y * v1[i].y + v1[i].z * v1[i].z + v1[i].w * v1[i].w; }
    s0 = wave_sum(s0); s1 = wave_sum(s1);
    const float r0 = rsqrtf(s0 * (1.f / DM) + EPS), r1 = rsqrtf(s1 * (1.f / DM) + EPS);
#pragma unroll
    for (int i = 0; i < 4; ++i) {
      const int d = lane * 4 + 256 * i;
      const float4 g = *(const float4*)(p.norm1_g + d);
      {
        const float4 sh = *(const float4*)(md0 + d), sc = *(const float4*)(md0 + 1024 + d);
        uint2 o; o.x = pk_bf16(v0[i].x * r0 * g.x * (1.f + sc.x) + sh.x, v0[i].y * r0 * g.y * (1.f + sc.y) + sh.y);
        o.y = pk_bf16(v0[i].z * r0 * g.z * (1.f + sc.z) + sh.z, v0[i].w * r0 * g.w * (1.f + sc.w) + sh.w);
        *(uint2*)(p.h + (size_t)R0 * DM + d) = o;
      }
      if (has1) {
        const float4 sh = *(const float4*)(md1 + d), sc = *(const float4*)(md1 + 1024 + d);
        uint2 o; o.x = pk_bf16(v1[i].x * r1 * g.x * (1.f + sc.x) + sh.x, v1[i].y * r1 * g.y * (1.f + sc.y) + sh.y);
        o.y = pk_bf16(v1[i].z * r1 * g.z * (1.f + sc.z) + sh.z, v1[i].w * r1 * g.w * (1.f + sc.w) + sh.w);
        *(uint2*)(p.h + (size_t)R1 * DM + d) = o;
      }
    }
  }
}

DI void phase2(const Params& p, char* smem) {
  const int xcd = blockIdx.x & 7, jl = blockIdx.x >> 3, nl = gridDim.x >> 3;
  auto decode = [&](int L, int& tokTile, int& ft) {
    if (L < 416) { const int tg = L / 104, rem = L % 104; ft = rem >> 3; tokTile = xcd * 32 + tg * 8 + (rem & 7); }
    else { const int u = L - 416; tokTile = 256 + xcd * 4 + (u >> 1); ft = 1 + (u & 1); }
  };
  bool pre = false;
  for (int L = jl; L < 416 + 8; L += nl) {
    int tokTile, ft, tokTileN = 0, ftN = 0;
    decode(L, tokTile, ft);
    const bool lat = L < 416;
    const int Ln = L + nl; const bool hasNext = Ln < 416 + 8;
    if (hasNext) decode(Ln, tokTileN, ftN);
    f32x16 acc[4][2];
#pragma unroll
    for (int a = 0; a < 4; ++a)
#pragma unroll
      for (int b = 0; b < 2; ++b) acc[a][b] = zero16();
    const bf16_t* Ab = p.WinT + (size_t)ft * 256 * DM;
    const bf16_t* Bb = p.h + (size_t)tokTile * 256 * DM;
    const bf16_t* AbN = p.WinT + (size_t)ftN * 256 * DM;
    const bf16_t* BbN = p.h + (size_t)tokTileN * 256 * DM;
    float dummy = 0.f;
    gemm8x<4, 2, 2, 4, false, 2>(acc, [&](int row) { return Ab + (size_t)row * DM; }, [&](int row) { return Bb + (size_t)row * DM; }, DM, smem, dummy,
                              pre, hasNext, [&](int row) { return AbN + (size_t)row * DM; }, [&](int row) { return BbN + (size_t)row * DM; });
    pre = hasNext;
    char* tile = smem + EPI_OFF;
    bf16_t* base; int ld, c0 = 0, c1 = 32;
    if (lat) {
      const size_t tok0 = (size_t)tokTile * 256;
      if (ft < 3) { base = p.pqkv + tok0 * LDQKV + ft * 256; ld = LDQKV; if (ft == 2) c1 = 20; }
      else if (ft < 5) { base = p.pf + tok0 * 512 + (ft - 3) * 256; ld = 512; }
      else { base = p.pg + tok0 * 2048 + (ft - 5) * 256; ld = 2048; }
    } else {
      const size_t ct0 = (size_t)(tokTile - 256) * 256;
      base = p.pckv + ct0 * LDCKV + ft * 256 - 384; ld = LDCKV;
      if (ft == 1) c0 = 16; else c1 = 20;
    }
    if (ft >= 5) stage_half<4, 2, 4, 0>(acc, tile, 528, [](float v) { return sigmoidf_(v); });
    else stage_half<4, 2, 4, 0>(acc, tile, 528, [](float v) { return v; });
    lds_sync();
    copy_tile(tile, 528, 128, 5, [&](int rl) { return base + (size_t)((rl >> 5) * 64 + (rl & 31)) * ld; }, c0, c1);
    lds_sync();
    if (ft >= 5) stage_half<4, 2, 4, 1>(acc, tile, 528, [](float v) { return sigmoidf_(v); });
    else stage_half<4, 2, 4, 1>(acc, tile, 528, [](float v) { return v; });
    lds_sync();
    copy_tile(tile, 528, 128, 5, [&](int rl) { return base + (size_t)((rl >> 5) * 64 + 32 + (rl & 31)) * ld; }, c0, c1);
  }
}

DI void rope_pair(float& x1, float& x2, const float* tab) { const float c = tab[0], s = tab[1]; const float a = x1 * c - x2 * s, b = x2 * c + x1 * s; x1 = a; x2 = b; }

DI void phase3(const Params& p, char* smem) {
  const int t = tid_(), lane = t & 63, w = t >> 6, r = lane & 31, hh = lane >> 5;
  const int nKV = 288, nQ = 256, nCh = 128;
  const int xcd = blockIdx.x & 7, jl = blockIdx.x >> 3, nl = gridDim.x >> 3;
  for (int it = jl; it < nKV + nQ + nCh; it += nl) {
    if (it < nKV) {
      const int tl_ = it >> 3, hd = it & 7;
      const bool lat = tl_ < 32;
      const bf16_t* Bb; int ldb; const bf16_t* kpeb;
      int b, key0;
      if (lat) { const int tokTile = xcd * 32 + tl_; Bb = p.pqkv + (size_t)tokTile * 256 * LDQKV + QL; ldb = LDQKV; kpeb = p.pqkv + (size_t)tokTile * 256 * LDQKV + 640; b = tokTile >> 3; key0 = (tokTile & 7) * 256; }
      else { const int ct = xcd * 4 + (tl_ - 32); Bb = p.pckv + (size_t)ct * 256 * LDCKV; ldb = LDCKV; kpeb = Bb + 256; b = ct; key0 = SEQ; }
      const bf16_t* Ab = p.WkvT + (size_t)hd * 128 * KVL;
      f32x16 acc[4][1];
#pragma unroll
      for (int a = 0; a < 4; ++a) acc[a][0] = zero16();
      float sumsq = 0.f;
      gemm8<4, 1, 1, 8, true>(acc, [&](int row) { return Ab + (size_t)row * KVL; }, [&](int row) { return Bb + (size_t)row * ldb; }, KVL, smem, sumsq);
      sumsq += __shfl_xor(sumsq, 32);
      const float ra = rsqrtf(sumsq * (1.f / KVL) + EPS);
      const int tl = w * 32 + r;
      const int key = key0 + tl;
      float kp[16];
#pragma unroll
      for (int q = 0; q < 4; ++q) {
        const uint2 u = *(const uint2*)(kpeb + (size_t)tl * ldb + 8 * q + 4 * hh);
        kp[4 * q + 0] = bf_lo(u.x); kp[4 * q + 1] = bf_hi(u.x); kp[4 * q + 2] = bf_lo(u.y); kp[4 * q + 3] = bf_hi(u.y);
      }
      float ss = 0.f;
#pragma unroll
      for (int tm = 0; tm < 4; ++tm)
#pragma unroll
        for (int i = 0; i < 16; ++i) { const float v = acc[tm][0][i] * ra; acc[tm][0][i] = v; if (tm < 2) ss += v * v; }
#pragma unroll
      for (int i = 0; i < 16; ++i) ss += kp[i] * kp[i];
      ss += __shfl_xor(ss, 32);
      const float rk = rsqrtf(ss * (1.f / QKD) + EPS);
#pragma unroll
      for (int i = 0; i < 16; ++i) kp[i] *= rk * p.k_norm_g[64 + crow(i, hh)];
      if (lat) {
        const int pos = key;
        const float* tr = p.ropeTab + ((pos >> 6) * 8 + 4 * hh) * 2;
        const float* tc = p.ropeTab + ((pos & 63) * 8 + 4 * hh) * 2;
#pragma unroll
        for (int i = 0; i < 4; ++i) { rope_pair(kp[i], kp[i + 4], tr + 2 * i); rope_pair(kp[8 + i], kp[12 + i], tc + 2 * i); }
      }
      {
        char* kt_ = smem; char* vt_ = smem + 256 * 208;
        char* kd = kt_ + tl * 208;
#pragma unroll
        for (int tm = 0; tm < 2; ++tm)
#pragma unroll
          for (int q = 0; q < 4; ++q) {
            const int f = tm * 32 + 8 * q + 4 * hh;
            const float4 g = *(const float4*)(p.k_norm_g + f);
            uint2 o; o.x = pk_bf16(acc[tm][0][4 * q] * rk * g.x, acc[tm][0][4 * q + 1] * rk * g.y); o.y = pk_bf16(acc[tm][0][4 * q + 2] * rk * g.z, acc[tm][0][4 * q + 3] * rk * g.w);
            *(uint2*)(kd + f * 2) = o;
          }
#pragma unroll
        for (int q = 0; q < 4; ++q) {
          uint2 o; o.x = pk_bf16(kp[4 * q], kp[4 * q + 1]); o.y = pk_bf16(kp[4 * q + 2], kp[4 * q + 3]);
          *(uint2*)(kd + (64 + 8 * q + 4 * hh) * 2) = o;
        }
#pragma unroll
        for (int tm = 2; tm < 4; ++tm)
#pragma unroll
          for (int i = 0; i < 16; ++i) *(bf16_t*)(vt_ + ((tm - 2) * 32 + crow(i, hh)) * 528 + tl * 2) = f2bf(acc[tm][0][i]);
        lds_sync();
        const int tc_ = tid_();
        bf16_t* Kg = p.K + ((size_t)(b * NH + hd) * NKEY + key0) * QKD;
#pragma unroll
        for (int i = 0; i < 6; ++i) {
          const int id = tc_ + NTH * i, row = id / 12, ch = id % 12;
          *(uint4*)(Kg + row * QKD + ch * 8) = *(const uint4*)(kt_ + row * 208 + ch * 16);
        }
        bf16_t* Vg = p.Vt + (size_t)(b * NH + hd) * VD * NKEY + key0;
#pragma unroll
        for (int i = 0; i < 4; ++i) {
          const int row = (tc_ >> 5) + 16 * i, ch = tc_ & 31;
          *(uint4*)(Vg + (size_t)row * NKEY + ch * 8) = *(const uint4*)(vt_ + row * 528 + ch * 16);
        }
        lds_sync();
      }
    } else if (it < nKV + nQ) {
      const int u = it - nKV;
      const int tokTile = xcd * 32 + (u >> 3), hd = u & 7;
      const bf16_t* Bb = p.pqkv + (size_t)tokTile * 256 * LDQKV;
      const bf16_t* Ab = p.WqT + (size_t)hd * QKD * QL;
      f32x16 acc[3][1];
#pragma unroll
      for (int a = 0; a < 3; ++a) acc[a][0] = zero16();
      float sumsq = 0.f;
      gemm8<3, 1, 1, 8, true>(acc, [&](int row) { return Ab + (size_t)row * QL; }, [&](int row) { return Bb + (size_t)row * LDQKV; }, QL, smem, sumsq);
      sumsq += __shfl_xor(sumsq, 32);
      const float ra = rsqrtf(sumsq * (1.f / QL) + EPS);
      const int tl = w * 32 + r;
      const int b = tokTile >> 3, pos = (tokTile & 7) * 256 + tl;
      float ss = 0.f;
#pragma unroll
      for (int tm = 0; tm < 3; ++tm)
#pragma unroll
        for (int i = 0; i < 16; ++i) { const float v = acc[tm][0][i] * ra; acc[tm][0][i] = v; ss += v * v; }
      ss += __shfl_xor(ss, 32);
      const float rh = rsqrtf(ss * (1.f / QKD) + EPS);
#pragma unroll
      for (int tm = 0; tm < 3; ++tm)
#pragma unroll
        for (int q = 0; q < 4; ++q) {
          const float4 g = *(const float4*)(p.q_norm_g + tm * 32 + 8 * q + 4 * hh);
          acc[tm][0][4 * q] *= rh * g.x; acc[tm][0][4 * q + 1] *= rh * g.y; acc[tm][0][4 * q + 2] *= rh * g.z; acc[tm][0][4 * q + 3] *= rh * g.w;
        }
      {
        const float* tr = p.ropeTab + ((pos >> 6) * 8 + 4 * hh) * 2;
        const float* tc = p.ropeTab + ((pos & 63) * 8 + 4 * hh) * 2;
#pragma unroll
        for (int i = 0; i < 4; ++i) {
          float a0 = acc[2][0][i], a1 = acc[2][0][i + 4], c0 = acc[2][0][8 + i], c1 = acc[2][0][12 + i];
          rope_pair(a0, a1, tr + 2 * i); rope_pair(c0, c1, tc + 2 * i);
          acc[2][0][i] = a0; acc[2][0][i + 4] = a1; acc[2][0][8 + i] = c0; acc[2][0][12 + i] = c1;
        }
      }
      const float qs = 0.10206207261596575f * 1.4426950408889634f;
      {
        char* qd = smem + tl * 208;
#pragma unroll
        for (int tm = 0; tm < 3; ++tm)
#pragma unroll
          for (int q = 0; q < 4; ++q) {
            uint2 o; o.x = pk_bf16(acc[tm][0][4 * q] * qs, acc[tm][0][4 * q + 1] * qs); o.y = pk_bf16(acc[tm][0][4 * q + 2] * qs, acc[tm][0][4 * q + 3] * qs);
            *(uint2*)(qd + (tm * 32 + 8 * q + 4 * hh) * 2) = o;
          }
        lds_sync();
        const int tc_ = tid_();
        bf16_t* Qg = p.Q + ((size_t)(b * NH + hd) * SEQ + (tokTile & 7) * 256) * QKD;
#pragma unroll
        for (int i = 0; i < 6; ++i) {
          const int id = tc_ + NTH * i, row = id / 12, ch = id % 12;
          *(uint4*)(Qg + row * QKD + ch * 8) = *(const uint4*)(smem + row * 208 + ch * 16);
        }
        lds_sync();
      }
    } else {
      const int u = it - nKV - nQ;
      const int tt = u & 7, g = (u >> 3) & 3, b = xcd * 4 + (u >> 5);
      const bf16_t* Tb = p.chanT;
      const bf16_t* Fb = p.pf + (size_t)(b * SEQ + tt * 256) * 512 + g * 128;
      f32x16 acc[4][2];
#pragma unroll
      for (int a = 0; a < 4; ++a)
#pragma unroll
        for (int c = 0; c < 2; ++c) acc[a][c] = zero16();
      float dummy = 0.f;
      gemm8<4, 2, 2, 4, false>(acc, [&](int row) { return Fb + (size_t)row * 512; }, [&](int row) { return Tb + (size_t)row * 128; }, 128, smem, dummy);
      stage_tile<4, 2, 2, 4>(acc, smem, 528, [](float v) { return v; });
      lds_sync();
      bf16_t* dst0 = p.ABt + ((size_t)(b * 512 + g * 128)) * 4096 + tt * 256;
      copy_tile(smem, 528, 256, 5, [&](int row) { return dst0 + (size_t)(row & 127) * 4096 + (row >> 7) * 2048; }, 0, 32);
      lds_sync();
    }
  }
}

DI void attn_item(const Params& p, int it, char* smem) {
  const int t = tid_(), lane = t & 63, w = t >> 6, r = lane & 31, hh = lane >> 5;
  const int qt = it & 7, bh = it >> 3;
  constexpr int KROW = 208, VROW = 136, KBYTES = 64 * KROW, STAGE = KBYTES + 64 * VROW;
  const bf16_t* Kb = p.K + (size_t)bh * NKEY * QKD;
  const bf16_t* Vb = p.Vt + (size_t)bh * VD * NKEY;
  const int qpos = qt * 256 + w * 32 + r;
  const bf16_t* Qp = p.Q + ((size_t)bh * SEQ + qpos) * QKD + hh * 8;
  bf16x8 qf[6];
#pragma unroll
  for (int c = 0; c < 6; ++c) qf[c] = *(const bf16x8*)(Qp + c * 16);
  f32x16 o[2]; o[0] = zero16(); o[1] = zero16();
  float gk = 0.f;
  for (int f = 0; f < QKD; ++f) gk = fmaxf(gk, fabsf(p.k_norm_g[f]));
  float qss = 0.f;
#pragma unroll
  for (int c = 0; c < 6; ++c) {
    const uint4 u = __builtin_bit_cast(uint4, qf[c]);
    const float e0 = bf_lo(u.x), e1 = bf_hi(u.x), e2 = bf_lo(u.y), e3 = bf_hi(u.y), e4 = bf_lo(u.z), e5 = bf_hi(u.z), e6 = bf_lo(u.w), e7 = bf_hi(u.w);
    qss += e0 * e0 + e1 * e1 + e2 * e2 + e3 * e3 + e4 * e4 + e5 * e5 + e6 * e6 + e7 * e7;
  }
  qss += __shfl_xor(qss, 32);
  const float negC = -(sqrtf(qss) * gk * 9.797959f * 1.01f);
  f32x16 sinit;
#pragma unroll
  for (int i = 0; i < 16; ++i) sinit[i] = negC;
  float lrun = 0.f;
  const int kid0 = t, kid1 = (t & 255) + 512;
  const bool k1v = t < 256;
  const int kgo0 = (kid0 / 12) * QKD + (kid0 % 12) * 8, kgo1 = (kid1 / 12) * QKD + (kid1 % 12) * 8;
  const int klo0 = (kid0 / 12) * KROW + (kid0 % 12) * 16, klo1 = (kid1 / 12) * KROW + (kid1 % 12) * 16;
  const int vgo0 = (t >> 3) * NKEY + (t & 7) * 8;
  const int vlo0 = KBYTES + (t >> 3) * VROW + (t & 7) * 16;
  uint4 rk0, rk1, rv0;
  rk0 = *(const uint4*)(Kb + kgo0); rk1 = *(const uint4*)(Kb + kgo1);
  rv0 = *(const uint4*)(Vb + vgo0);
  SB_;
#define ATT_STORE(base) do { \
    *(uint4*)((base) + klo0) = rk0; if (k1v) *(uint4*)((base) + klo1) = rk1; \
    { uint2* d = (uint2*)((base) + vlo0); d[0] = make_uint2(rv0.x, rv0.y); d[1] = make_uint2(rv0.z, rv0.w); } } while (0)
  ATT_STORE(smem);
  __syncthreads();
  constexpr int NKT = NKEY / 64;
  for (int kt = 0; kt < NKT; ++kt) {
    const char* cur = smem + (kt & 1) * STAGE;
    const bool more = kt + 1 < NKT;
    if (more) {
      const bf16_t* kn = Kb + (size_t)(kt + 1) * 64 * QKD; const bf16_t* vn = Vb + (kt + 1) * 64;
      rk0 = *(const uint4*)(kn + kgo0); rk1 = *(const uint4*)(kn + kgo1);
      rv0 = *(const uint4*)(vn + vgo0);
    }
    SB_;
    f32x16 s[2];
#pragma unroll
    for (int t2 = 0; t2 < 2; ++t2) {
      const char* kp = cur + (t2 * 32 + r) * KROW + hh * 16;
      { const bf16x8 kf = *(const bf16x8*)(kp); s[t2] = MFMA(kf, qf[0], sinit); }
#pragma unroll
      for (int c = 1; c < 6; ++c) { const bf16x8 kf = *(const bf16x8*)(kp + c * 32); s[t2] = MFMA(kf, qf[c], s[t2]); }
    }
    SB_;
    float ls = 0.f;
#pragma unroll
    for (int t2 = 0; t2 < 2; ++t2)
#pragma unroll
      for (int i = 0; i < 16; ++i) { const float e = __builtin_amdgcn_exp2f(s[t2][i]); s[t2][i] = e; ls += e; }
    lrun += ls;
    SB_;
#pragma unroll
    for (int t2 = 0; t2 < 2; ++t2)
#pragma unroll
      for (int s2 = 0; s2 < 2; ++s2) {
        uint4 pu;
        pu.x = pk_bf16(s[t2][8 * s2 + 0], s[t2][8 * s2 + 1]); pu.y = pk_bf16(s[t2][8 * s2 + 2], s[t2][8 * s2 + 3]);
        pu.z = pk_bf16(s[t2][8 * s2 + 4], s[t2][8 * s2 + 5]); pu.w = pk_bf16(s[t2][8 * s2 + 6], s[t2][8 * s2 + 7]);
        const bf16x8 pb = __builtin_bit_cast(bf16x8, pu);
#pragma unroll
        for (int vt = 0; vt < 2; ++vt) {
          const char* vp = cur + KBYTES + (vt * 32 + r) * VROW + (t2 * 32 + 16 * s2 + 4 * hh) * 2;
          const uint2 lo = *(const uint2*)(vp), hi = *(const uint2*)(vp + 16);
          uint4 vu; vu.x = lo.x; vu.y = lo.y; vu.z = hi.x; vu.w = hi.y;
          o[vt] = MFMA(__builtin_bit_cast(bf16x8, vu), pb, o[vt]);
        }
      }
    SB_;
    if (more) { char* nxt = smem + ((kt + 1) & 1) * STAGE; ATT_STORE(nxt); }
    __syncthreads();
  }
  lrun += __shfl_xor(lrun, 32);
  const float inv = 1.f / lrun;
  const int b = bh >> 3, hd = bh & 7;
  bf16_t* od = p.attn_o + (size_t)(b * SEQ + qpos) * 512 + hd * 64;
#pragma unroll
  for (int vt = 0; vt < 2; ++vt)
#pragma unroll
    for (int q = 0; q < 4; ++q) {
      uint2 ou; ou.x = pk_bf16(o[vt][4 * q] * inv, o[vt][4 * q + 1] * inv); ou.y = pk_bf16(o[vt][4 * q + 2] * inv, o[vt][4 * q + 3] * inv);
      *(uint2*)(od + vt * 32 + 8 * q + 4 * hh) = ou;
    }
}

DI void phase4(const Params& p, char* smem) {
  const int t = tid_(), lane = t & 63, w = t >> 6, r = lane & 31, hh = lane >> 5;
  const int nDft = 64, nAlt = 4, nAtt = 256;
  const int xcd = blockIdx.x & 7, jl = blockIdx.x >> 3, nl = gridDim.x >> 3;
  for (int it = jl; it < nDft + nAlt + nAtt; it += nl) {
    if (it < nDft) {
      const int bl = it >> 4, rem = it & 15, ct = rem >> 3, kt = rem & 7, b = xcd * 4 + bl;
      const int wm = w & 3, wn = w >> 2;
      const bf16_t* Ab = p.ABt + (size_t)(b * 512 + ct * 256) * 4096;
      const bf16_t* Cb = p.posM + (size_t)kt * 128 * 2048;
      const bf16_t* Sb = p.posM + (size_t)(1152 + kt * 128) * 2048;
      f32x16 acc1[2][2], acc2[2][2];
#pragma unroll
      for (int a = 0; a < 2; ++a)
#pragma unroll
        for (int c = 0; c < 2; ++c) { acc1[a][c] = zero16(); acc2[a][c] = zero16(); }
      float dummy = 0.f;
      gemm8s3(acc1, [&](int row) { return Ab + (size_t)row * 4096; }, [&](int row) { return Cb + (size_t)row * 2048; }, 2048, smem);
      gemm8s3(acc2, [&](int row) { return Ab + (size_t)row * 4096 + 2048; }, [&](int row) { return Sb + (size_t)row * 2048; }, 2048, smem);
      const float sc = 1.f / 512.f;
#pragma unroll
      for (int tm = 0; tm < 2; ++tm)
#pragma unroll
        for (int tn = 0; tn < 2; ++tn) {
          const int kpos = kt * 128 + wn * 64 + tn * 32 + r;
          const int moff = ct * 256 + wm * 64 + tm * 32 + 4 * hh;
          if (kpos <= 1024) {
            bf16_t* d = p.four_o + (size_t)(b * SEQ + kpos) * 512 + moff;
#pragma unroll
            for (int q = 0; q < 4; ++q) {
              uint2 ou; ou.x = pk_bf16((acc1[tm][tn][4 * q] - acc2[tm][tn][4 * q]) * sc, (acc1[tm][tn][4 * q + 1] - acc2[tm][tn][4 * q + 1]) * sc);
              ou.y = pk_bf16((acc1[tm][tn][4 * q + 2] - acc2[tm][tn][4 * q + 2]) * sc, (acc1[tm][tn][4 * q + 3] - acc2[tm][tn][4 * q + 3]) * sc);
              *(uint2*)(d + 8 * q) = ou;
            }
          }
          if (kpos >= 1 && kpos <= 1023) {
            bf16_t* d = p.four_o + (size_t)(b * SEQ + 2048 - kpos) * 512 + moff;
#pragma unroll
            for (int q = 0; q < 4; ++q) {
              uint2 ou; ou.x = pk_bf16((acc1[tm][tn][4 * q] + acc2[tm][tn][4 * q]) * sc, (acc1[tm][tn][4 * q + 1] + acc2[tm][tn][4 * q + 1]) * sc);
              ou.y = pk_bf16((acc1[tm][tn][4 * q + 2] + acc2[tm][tn][4 * q + 2]) * sc, (acc1[tm][tn][4 * q + 3] + acc2[tm][tn][4 * q + 3]) * sc);
              *(uint2*)(d + 8 * q) = ou;
            }
          }
        }
    } else if (it < nDft + nAlt) {
      const int b = xcd * 4 + (it - nDft);
      for (int m = w; m < 512; m += NWV) {
        const bf16_t* rowp = p.ABt + (size_t)(b * 512 + m) * 4096 + lane * 8;
        float sacc = 0.f;
#pragma unroll
        for (int i = 0; i < 4; ++i) {
          const uint4 u = *(const uint4*)(rowp + 512 * i);
          sacc += (bf_lo(u.x) - bf_hi(u.x)) + (bf_lo(u.y) - bf_hi(u.y)) + (bf_lo(u.z) - bf_hi(u.z)) + (bf_lo(u.w) - bf_hi(u.w));
        }
        sacc = wave_sum(sacc);
        if (lane == 0) p.four_o[(size_t)(b * SEQ + 1024) * 512 + m] = f2bf(sacc * (1.f / 512.f));
      }
    } else {
      attn_item(p, xcd * 256 + (it - nDft - nAlt), smem);
    }
  }
}

DI void phase5(const Params& p, char* smem) {
  const int t = tid_();
  const int xcd = blockIdx.x & 7, jl = blockIdx.x >> 3, nl = gridDim.x >> 3;
  for (int L = jl; L < 256; L += nl) {
    const int tokTile = xcd * 64 + (L >> 5) * 8 + (L & 7), nt = (L >> 3) & 3;
    f32x16 acc1[2][2], acc2[2][2];
#pragma unroll
    for (int a = 0; a < 2; ++a)
#pragma unroll
      for (int c = 0; c < 2; ++c) { acc1[a][c] = zero16(); acc2[a][c] = zero16(); }
    float dummy = 0.f;
    {
      const bf16_t* Ab = p.WoT + (size_t)nt * 256 * 512; const bf16_t* Bb = p.attn_o + (size_t)tokTile * 128 * 512;
      gemm8s3(acc1, [&](int row) { return Ab + (size_t)row * 512; }, [&](int row) { return Bb + (size_t)row * 512; }, 512, smem);
    }
    {
      const bf16_t* Ab = p.WfT + (size_t)nt * 256 * 512; const bf16_t* Bb = p.four_o + (size_t)tokTile * 128 * 512;
      gemm8s3(acc2, [&](int row) { return Ab + (size_t)row * 512; }, [&](int row) { return Bb + (size_t)row * 512; }, 512, smem);
    }
    {
      char* t1 = smem; char* t2 = smem + 128 * 528;
      const int ch = t & 31, r0 = t >> 5;
      stage_tile<2, 2, 4, 2>(acc1, t1, 528, [](float v) { return v; });
      stage_tile<2, 2, 4, 2>(acc2, t2, 528, [](float v) { return v; });
      lds_sync();
#pragma unroll
      for (int hb = 0; hb < 2; ++hb) {
        uint4 gav[4], gbv[4];
#pragma unroll
        for (int i = 0; i < 4; ++i) {
          const size_t tok = (size_t)tokTile * 128 + r0 + 16 * (hb * 4 + i);
          gav[i] = *(const uint4*)(p.pg + tok * 2048 + nt * 256 + ch * 8); gbv[i] = *(const uint4*)(p.pg + tok * 2048 + 1024 + nt * 256 + ch * 8);
        }
#pragma unroll
        for (int i = 0; i < 4; ++i) {
          const int row = r0 + 16 * (hb * 4 + i);
          const size_t tok = (size_t)tokTile * 128 + row;
          const uint4 u1 = *(const uint4*)(t1 + row * 528 + ch * 16), u2 = *(const uint4*)(t2 + row * 528 + ch * 16);
          const uint4 ga = gav[i], gb = gbv[i];
          uint4 o;
          o.x = pk_bf16(bf_lo(ga.x) * bf_lo(u1.x) + bf_lo(gb.x) * bf_lo(u2.x), bf_hi(ga.x) * bf_hi(u1.x) + bf_hi(gb.x) * bf_hi(u2.x));
          o.y = pk_bf16(bf_lo(ga.y) * bf_lo(u1.y) + bf_lo(gb.y) * bf_lo(u2.y), bf_hi(ga.y) * bf_hi(u1.y) + bf_hi(gb.y) * bf_hi(u2.y));
          o.z = pk_bf16(bf_lo(ga.z) * bf_lo(u1.z) + bf_lo(gb.z) * bf_lo(u2.z), bf_hi(ga.z) * bf_hi(u1.z) + bf_hi(gb.z) * bf_hi(u2.z));
          o.w = pk_bf16(bf_lo(ga.w) * bf_lo(u1.w) + bf_lo(gb.w) * bf_lo(u2.w), bf_hi(ga.w) * bf_hi(u1.w) + bf_hi(gb.w) * bf_hi(u2.w));
          *(uint4*)(p.m + tok * DM + nt * 256 + ch * 8) = o;
        }
      }
      lds_sync();
    }
  }
}

DI void phase6(const Params& p, char* smem) {
  const int t = tid_(), lane = t & 63, w = t >> 6, r = lane & 31, hh = lane >> 5;
  const int wm = w & 1, wn = w >> 1;
  const int xcd = blockIdx.x & 7, jl = blockIdx.x >> 3, nl = gridDim.x >> 3;
  for (int L = jl; L < 128; L += nl) {
    const int tokTile = xcd * 32 + (L >> 5) * 8 + (L & 7), nt = (L >> 3) & 3;
    f32x16 acc[4][2];
#pragma unroll
    for (int a = 0; a < 4; ++a)
#pragma unroll
      for (int c = 0; c < 2; ++c) acc[a][c] = zero16();
    float dummy = 0.f;
    const bf16_t* Wb = p.WoutT + (size_t)nt * 256 * DM; const bf16_t* Mb = p.m + (size_t)tokTile * 256 * DM;
    gemm8<4, 2, 2, 4, false>(acc, [&](int row) { return Wb + (size_t)row * DM; }, [&](int row) { return Mb + (size_t)row * DM; }, DM, smem, dummy);
    const int tc_ = tid_();
    const int ch = tc_ & 63, r0 = tc_ >> 6;
    const float4 g = *(const float4*)(p.mod + (tokTile >> 3) * 6144 + 2048 + nt * 256 + ch * 4);
#pragma unroll
    for (int tn = 0; tn < 2; ++tn) {
      const size_t obase = ((size_t)tokTile * 256 + tn * 32) * DM + nt * 256 + ch * 4;
#pragma unroll
      for (int tm = 0; tm < 4; ++tm) {
        char* d = smem + (wn * 32 + r) * 1040 + (wm * 128 + tm * 32 + 4 * hh) * 4;
#pragma unroll
        for (int q = 0; q < 4; ++q) *(float4*)(d + 32 * q) = make_float4(acc[tm][tn][4 * q], acc[tm][tn][4 * q + 1], acc[tm][tn][4 * q + 2], acc[tm][tn][4 * q + 3]);
      }
      lds_sync();
#pragma unroll
      for (int hb = 0; hb < 2; ++hb) {
        float4 xv[8];
#pragma unroll
        for (int i = 0; i < 8; ++i) {
          const int row = r0 + 8 * (hb * 8 + i);
          xv[i] = *(const float4*)(p.x + obase + (size_t)((row >> 5) * 64 + (row & 31)) * DM);
        }
#pragma unroll
        for (int i = 0; i < 8; ++i) {
          const int row = r0 + 8 * (hb * 8 + i);
          const float4 a = *(const float4*)(smem + row * 1040 + ch * 16);
          uint2 ob; ob.x = pk_bf16(xv[i].x + g.x * a.x, xv[i].y + g.y * a.y); ob.y = pk_bf16(xv[i].z + g.z * a.z, xv[i].w + g.w * a.w);
          *(uint2*)(p.x1b + obase + (size_t)((row >> 5) * 64 + (row & 31)) * DM) = ob;
        }
      }
      lds_sync();
    }
  }
}

DI void phase7(const Params& p, char* smem) {
  const int t = tid_(), lane = t & 63, w = t >> 6;
  float* wr = (float*)smem;
  for (int idx = t; idx < DM * NE; idx += NTH) { const int d = idx >> 4, e = idx & 15; wr[e * DM + d] = p.w_router[idx]; }
  __syncthreads();
  const int gw = blockIdx.x * NWV + w, nw = gridDim.x * NWV;
  auto router = [&](const float4 (&v)[4], int R) {
    asm volatile("" ::: "memory");
    float a[16];
#pragma unroll
    for (int e = 0; e < 16; ++e) {
      float s = 0.f;
#pragma unroll
      for (int i = 0; i < 4; ++i) { const float4 wv = *(const float4*)(wr + e * DM + lane * 4 + 256 * i); s += v[i].x * wv.x + v[i].y * wv.y + v[i].z * wv.z + v[i].w * wv.w; }
      a[e] = s;
      if ((e & 3) == 3) __builtin_amdgcn_sched_barrier(0);
    }
    float a8[8], a4[4], a2[2], a1;
    {
      const bool up = lane & 32;
#pragma unroll
      for (int j = 0; j < 8; ++j) { const float send = up ? a[j] : a[j + 8]; const float keep = up ? a[j + 8] : a[j]; a8[j] = keep + __shfl_xor(send, 32); }
    }
    {
      const bool up = lane & 16;
#pragma unroll
      for (int j = 0; j < 4; ++j) { const float send = up ? a8[j] : a8[j + 4]; const float keep = up ? a8[j + 4] : a8[j]; a4[j] = keep + __shfl_xor(send, 16); }
    }
    {
      const bool up = lane & 8;
#pragma unroll
      for (int j = 0; j < 2; ++j) { const float send = up ? a4[j] : a4[j + 2]; const float keep = up ? a4[j + 2] : a4[j]; a2[j] = keep + __shfl_xor(send, 8); }
    }
    {
      const bool up = lane & 4;
      const float send = up ? a2[0] : a2[1]; const float keep = up ? a2[1] : a2[0]; a1 = keep + __shfl_xor(send, 4);
    }
    a1 += __shfl_xor(a1, 2);
    a1 += __shfl_xor(a1, 1);
    float mx = a1;
#pragma unroll
    for (int o = 4; o <= 32; o <<= 1) mx = fmaxf(mx, __shfl_xor(mx, o));
    const float ex = __expf(a1 - mx);
    float sm = ex;
#pragma unroll
    for (int o = 4; o <= 32; o <<= 1) sm += __shfl_xor(sm, o);
    if ((lane & 3) == 0) {
      const int e = (lane >> 2) & 15;
      p.aff[((size_t)((R >> 11) * NE + e)) * SEQ + (R & 2047)] = ex / sm;
    }
  };
  for (int R0 = gw; R0 < NT; R0 += 2 * nw) {
    const int R1 = R0 + nw;
    const bool has1 = R1 < NT;
    const bf16_t* src0 = p.x1b + (size_t)R0 * DM;
    const bf16_t* src1 = p.x1b + (size_t)(has1 ? R1 : R0) * DM;
    const float* md0 = p.mod + (R0 >> 11) * 6144;
    const float* md1 = p.mod + ((has1 ? R1 : R0) >> 11) * 6144;
    float4 v0[4], v1[4]; float s0 = 0.f, s1 = 0.f;
#pragma unroll
    for (int i = 0; i < 4; ++i) {
      const uint2 u0 = *(const uint2*)(src0 + lane * 4 + 256 * i), u1 = *(const uint2*)(src1 + lane * 4 + 256 * i);
      v0[i] = make_float4(bf_lo(u0.x), bf_hi(u0.x), bf_lo(u0.y), bf_hi(u0.y)); v1[i] = make_float4(bf_lo(u1.x), bf_hi(u1.x), bf_lo(u1.y), bf_hi(u1.y));
    }
#pragma unroll
    for (int i = 0; i < 4; ++i) { s0 += v0[i].x * v0[i].x + v0[i].y * v0[i].y + v0[i].z * v0[i].z + v0[i].w * v0[i].w; s1 += v1[i].x * v1[i].x + v1[i].y * v1[i].y + v1[i].z * v1[i].z + v1[i].w * v1[i].w; }
    s0 = wave_sum(s0); s1 = wave_sum(s1);
    const float r0 = rsqrtf(s0 * (1.f / DM) + EPS), r1 = rsqrtf(s1 * (1.f / DM) + EPS);
#pragma unroll
    for (int i = 0; i < 4; ++i) {
      const int d = lane * 4 + 256 * i;
      const float4 g = *(const float4*)(p.norm2_g + d);
      {
        const float4 sh = *(const float4*)(md0 + 3072 + d), sc = *(const float4*)(md0 + 4096 + d);
        v0[i].x = v0[i].x * r0 * g.x * (1.f + sc.x) + sh.x; v0[i].y = v0[i].y * r0 * g.y * (1.f + sc.y) + sh.y;
        v0[i].z = v0[i].z * r0 * g.z * (1.f + sc.z) + sh.z; v0[i].w = v0[i].w * r0 * g.w * (1.f + sc.w) + sh.w;
        uint2 o; o.x = pk_bf16(v0[i].x, v0[i].y); o.y = pk_bf16(v0[i].z, v0[i].w);
        *(uint2*)(p.h2 + (size_t)R0 * DM + d) = o;
      }
      if (has1) {
        const float4 sh = *(const float4*)(md1 + 3072 + d), sc = *(const float4*)(md1 + 4096 + d);
        v1[i].x = v1[i].x * r1 * g.x * (1.f + sc.x) + sh.x; v1[i].y = v1[i].y * r1 * g.y * (1.f + sc.y) + sh.y;
        v1[i].z = v1[i].z * r1 * g.z * (1.f + sc.z) + sh.z; v1[i].w = v1[i].w * r1 * g.w * (1.f + sc.w) + sh.w;
        uint2 o; o.x = pk_bf16(v1[i].x, v1[i].y); o.y = pk_bf16(v1[i].z, v1[i].w);
        *(uint2*)(p.h2 + (size_t)R1 * DM + d) = o;
      }
    }
    SB_;
    router(v0, R0);
    SB_;
    if (has1) router(v1, R1);
    SB_;
  }
}

DI void phase8(const Params& p) {
  const int t_ = tid_(); const int lane = t_ & 63, w = t_ >> 6;
  const int gw = w * gridDim.x + blockIdx.x, nw = gridDim.x * NWV;
  for (int pr = gw; pr < NB * NE; pr += nw) {
    const float* a = p.aff + (size_t)pr * SEQ;
    unsigned u[32];
#pragma unroll
    for (int q = 0; q < 32; ++q) u[q] = __float_as_uint(a[q * 64 + lane]);
    unsigned thr = 0;
    for (int bit = 30; bit >= 0; --bit) {
      const unsigned cand = thr | (1u << bit);
      int cnt = 0;
#pragma unroll
      for (int q = 0; q < 32; ++q) cnt += __popcll(__ballot(u[q] >= cand));
      if (cnt >= CAP) thr = cand;
    }
    int ngt = 0;
#pragma unroll
    for (int q = 0; q < 32; ++q) ngt += __popcll(__ballot(u[q] > thr));
    int cgt = 0, ceq = 0;
    int* io = p.idx + pr * CAP; float* go = p.gate + pr * CAP;
    int* iv = p.inv + (size_t)pr * SEQ;
#pragma unroll
    for (int q = 0; q < 32; ++q) {
      const bool gt = u[q] > thr, eq = u[q] == thr;
      const unsigned long long mg = __ballot(gt), me = __ballot(eq);
      const unsigned long long below = (1ull << lane) - 1ull;
      int myslot = -1;
      if (gt) { const int s = cgt + __popcll(mg & below); io[s] = q * 64 + lane; go[s] = __uint_as_float(u[q]); myslot = s; }
      if (eq) { const int s = ngt + ceq + __popcll(me & below); if (s < CAP) { io[s] = q * 64 + lane; go[s] = __uint_as_float(u[q]); myslot = s; } }
      iv[q * 64 + lane] = myslot;
      cgt += __popcll(mg); ceq += __popcll(me);
    }
  }
}

DI void phase9(const Params& p, char* smem) {
  const int t = tid_(), lane = t & 63, w = t >> 6, r = lane & 31, hh = lane >> 5;
  const int wm = w & 1, wn = w >> 1;
  const int xcd = blockIdx.x & 7, jl = blockIdx.x >> 3, nl = gridDim.x >> 3;
  auto decode = [&](int L, int& e, int& ft, int& b) { e = xcd * 2 + (L >> 7); const int rem = L & 127; ft = (rem >> 3) & 3; b = (rem >> 5) * 8 + (rem & 7); };
  bool pre = false;
  for (int L = jl; L < 256; L += nl) {
    int e, ft, b, eN = 0, ftN = 0, bN = 0;
    decode(L, e, ft, b);
    const int Ln = L + nl; const bool hasNext = Ln < 256;
    if (hasNext) decode(Ln, eN, ftN, bN);
    const int be = b * NE + e;
    const bf16_t* Ab = p.WguT + ((size_t)e * 1024 + ft * 256) * DM;
    const int* ib = p.idx + be * CAP;
    const bf16_t* hb = p.h2 + (size_t)b * SEQ * DM;
    const bf16_t* AbN = p.WguT + ((size_t)eN * 1024 + ftN * 256) * DM;
    const int* ibN = p.idx + (bN * NE + eN) * CAP;
    const bf16_t* hbN = p.h2 + (size_t)bN * SEQ * DM;
    f32x16 acc[4][2];
#pragma unroll
    for (int a = 0; a < 4; ++a)
#pragma unroll
      for (int c = 0; c < 2; ++c) acc[a][c] = zero16();
    float dummy = 0.f;
    gemm8x<4, 2, 2, 4, false, 2>(acc, [&](int row) { return Ab + (size_t)row * DM; }, [&](int row) { return hb + (size_t)ib[row] * DM; }, DM, smem, dummy,
                              pre, hasNext, [&](int row) { return AbN + (size_t)row * DM; }, [&](int row) { return hbN + (size_t)ibN[row] * DM; });
    pre = hasNext;
    char* tile = smem + EPI_OFF;
#pragma unroll
    for (int tn = 0; tn < 2; ++tn)
#pragma unroll
      for (int pr = 0; pr < 2; ++pr) {
        char* d = tile + (wn * 64 + tn * 32 + r) * 272 + (wm * 64 + pr * 32 + 4 * hh) * 2;
#pragma unroll
        for (int q = 0; q < 4; ++q) {
          float v[4];
#pragma unroll
          for (int j = 0; j < 4; ++j) { const float g = acc[2 * pr][tn][4 * q + j], uu = acc[2 * pr + 1][tn][4 * q + j]; v[j] = g * sigmoidf_(g) * uu; }
          uint2 ou; ou.x = pk_bf16(v[0], v[1]); ou.y = pk_bf16(v[2], v[3]);
          *(uint2*)(d + 16 * q) = ou;
        }
      }
    lds_sync();
    bf16_t* hd_ = p.hmid + (size_t)be * CAP * DE + ft * 128;
    copy_tile(tile, 272, 256, 4, [&](int row) { return hd_ + (size_t)row * DE; }, 0, 16);
  }
}

DI void phase10(const Params& p, char* smem) {
  const int xcd = blockIdx.x & 7, jl = blockIdx.x >> 3, nl = gridDim.x >> 3;
  for (int L = jl; L < 512; L += nl) {
    const int e = xcd * 2 + (L >> 8), rem = L & 255, nt = (rem >> 3) & 3, st = (rem >> 5) & 1, b = (rem >> 6) * 8 + (rem & 7);
    const int be = b * NE + e;
    const bf16_t* Hb = p.hmid + ((size_t)be * CAP + st * 128) * DE;
    const bf16_t* Wb = p.WdT + ((size_t)e * DM + nt * 256) * DE;
    f32x16 acc[2][2];
#pragma unroll
    for (int a = 0; a < 2; ++a)
#pragma unroll
      for (int c = 0; c < 2; ++c) acc[a][c] = zero16();
    gemm8s3(acc, [&](int row) { return Wb + (size_t)row * DE; }, [&](int row) { return Hb + (size_t)row * DE; }, DE, smem);
    stage_tile<2, 2, 4, 2>(acc, smem, 528, [](float v) { return v; });
    lds_sync();
    bf16_t* yb = p.Y + ((size_t)be * CAP + st * 128) * DM + nt * 256;
    copy_tile(smem, 528, 128, 5, [&](int row) { return yb + (size_t)row * DM; }, 0, 32);
    lds_sync();
  }
}

DI void phase11(const Params& p) {
  const int t_ = tid_(); const int lane = t_ & 63, w = t_ >> 6;
  const int gw = blockIdx.x * NWV + w, nw = gridDim.x * NWV;
  auto slotOf = [&](int R) { return (lane < NE && R < NT) ? p.inv[((size_t)((R >> 11) * NE + lane)) * SEQ + (R & 2047)] : -1; };
  int nslot = slotOf(gw);
  uint2 nx[4];
  {
    const bf16_t* xs = p.x1b + (size_t)(gw < NT ? gw : 0) * DM + lane * 4;
#pragma unroll
    for (int i = 0; i < 4; ++i) nx[i] = *(const uint2*)(xs + 256 * i);
  }
  for (int R = gw; R < NT; R += nw) {
    const int b = R >> 11;
    const int myslot = nslot;
    uint2 xu[4];
#pragma unroll
    for (int i = 0; i < 4; ++i) xu[i] = nx[i];
    {
      const int Rn = R + nw;
      nslot = slotOf(Rn);
      const bf16_t* xs = p.x1b + (size_t)(Rn < NT ? Rn : 0) * DM + lane * 4;
#pragma unroll
      for (int i = 0; i < 4; ++i) nx[i] = *(const uint2*)(xs + 256 * i);
    }
    unsigned long long mask = __ballot(myslot >= 0);
    float4 a[4];
#pragma unroll
    for (int i = 0; i < 4; ++i) a[i] = make_float4(0.f, 0.f, 0.f, 0.f);
    while (mask) {
      const int e = __ffsll((long long)mask) - 1; mask &= mask - 1ull;
      const int slot = __shfl(myslot, e);
      const float g = p.gate[(b * NE + e) * CAP + slot];
      const bf16_t* y = p.Y + ((size_t)(b * NE + e) * CAP + slot) * DM + lane * 4;
#pragma unroll
      for (int i = 0; i < 4; ++i) {
        const uint2 u = *(const uint2*)(y + 256 * i);
        a[i].x += g * bf_lo(u.x); a[i].y += g * bf_hi(u.x); a[i].z += g * bf_lo(u.y); a[i].w += g * bf_hi(u.y);
      }
    }
    const float* g2 = p.mod + b * 6144 + 5120;
    float* o = p.out + (size_t)R * DM;
#pragma unroll
    for (int i = 0; i < 4; ++i) {
      const int d = lane * 4 + 256 * i;
      const float4 gv = *(const float4*)(g2 + d);
      *(float4*)(o + d) = make_float4(bf_lo(xu[i].x) + gv.x * a[i].x, bf_hi(xu[i].x) + gv.y * a[i].y, bf_lo(xu[i].y) + gv.z * a[i].z, bf_hi(xu[i].y) + gv.w * a[i].w);
    }
  }
}

__global__ void __launch_bounds__(NTH, 2) mega_kernel(Params p) {
  cg::grid_group grid = cg::this_grid();
  __shared__ __attribute__((aligned(16))) char smem[SMEM_BYTES];
#ifndef REPMASK
#define REPMASK 0
#endif
#define RUNPH(k, call) for (int rep_ = 0; rep_ < (((REPMASK) >> (k)) & 1) + 1; ++rep_) { call; grid.sync(); }
  RUNPH(0, phase0(p, smem))
  RUNPH(1, phase1(p))
  RUNPH(2, phase2(p, smem))
  RUNPH(3, phase3(p, smem))
  RUNPH(4, phase4(p, smem))
  RUNPH(5, phase5(p, smem))
  RUNPH(6, phase6(p, smem))
  RUNPH(7, phase7(p, smem))
  RUNPH(8, phase8(p))
  RUNPH(9, phase9(p, smem))
  RUNPH(10, phase10(p, smem))
  phase11(p);
}

static inline size_t align_up(size_t v, size_t a) { return (v + a - 1) / a * a; }

extern "C" void kernel_launch(void* const* d_in, const int* in_sizes, int n_in,
                              void* d_out, int out_size, void* d_ws, size_t ws_size,
                              hipStream_t stream) {
  static int grid_blocks = 0;
  if (!grid_blocks) {
    int dev = 0, cus = 0, per_cu = 0;
    (void)hipGetDevice(&dev);
    (void)hipDeviceGetAttribute(&cus, hipDeviceAttributeMultiprocessorCount, dev);
    (void)hipOccupancyMaxActiveBlocksPerMultiprocessor(&per_cu, mega_kernel, NTH, 0);
    if (per_cu > 1) per_cu = 1;
    if (per_cu < 1) per_cu = 1;
    grid_blocks = (cus * per_cu) & ~7;
    if (grid_blocks < 8) grid_blocks = 8;
  }
  Params p;
  memset(&p, 0, sizeof(p));
  p.x = (const float*)d_in[0]; p.c = (const float*)d_in[1]; p.ctx = (const float*)d_in[2]; p.c_ctx = (const float*)d_in[3];
  p.w_mod = (const float*)d_in[4]; p.b_mod = (const float*)d_in[5]; p.norm1_g = (const float*)d_in[6];
  const float* w_in = (const float*)d_in[7];
  const float* q_a_g = (const float*)d_in[8];
  const float* kv_a_g = (const float*)d_in[9];
  const float* w_q_up = (const float*)d_in[10];
  const float* w_kv_up = (const float*)d_in[11];
  p.q_norm_g = (const float*)d_in[12]; p.k_norm_g = (const float*)d_in[13];
  const float* w_o_attn = (const float*)d_in[14];
  const float* w_fourier = (const float*)d_in[15];
  const float* w_out = (const float*)d_in[16];
  p.norm2_g = (const float*)d_in[17]; p.w_router = (const float*)d_in[18];
  const float* w_e_gate = (const float*)d_in[19];
  const float* w_e_up = (const float*)d_in[20];
  const float* w_e_down = (const float*)d_in[21];
  p.out = (float*)d_out;

  char* base = (char*)d_ws; size_t off = 0;
  auto alloc = [&](size_t bytes) { char* q = base + off; off = align_up(off + bytes, 256); return q; };
  p.WinT = (bf16_t*)alloc((size_t)NINP * DM * 2);
  p.WqT = (bf16_t*)alloc((size_t)768 * QL * 2);
  p.WkvT = (bf16_t*)alloc((size_t)1024 * KVL * 2);
  p.WoT = (bf16_t*)alloc((size_t)DM * 512 * 2);
  p.WfT = (bf16_t*)alloc((size_t)DM * 512 * 2);
  p.WoutT = (bf16_t*)alloc((size_t)DM * DM * 2);
  p.WguT = (bf16_t*)alloc((size_t)NE * 1024 * DM * 2);
  p.WdT = (bf16_t*)alloc((size_t)NE * DM * DE * 2);
  p.chanT = (bf16_t*)alloc((size_t)256 * 128 * 2);
  p.posM = (bf16_t*)alloc((size_t)2 * 1152 * 2048 * 2);
  p.ropeTab = (float*)alloc(64 * 8 * 2 * 4);
  p.mod = (float*)alloc(33 * 6144 * 4);
  p.aff = (float*)alloc((size_t)NB * NE * SEQ * 4);
  p.gate = (float*)alloc((size_t)NB * NE * CAP * 4);
  p.idx = (int*)alloc((size_t)NB * NE * CAP * 4);
  p.inv = (int*)alloc((size_t)NB * NE * SEQ * 4);
  p.pckv = (bf16_t*)alloc((size_t)NC * LDCKV * 2 + 4096);
  char* regA = alloc((size_t)(NT + NC) * DM * 2);
  p.h = (bf16_t*)regA; p.ABt = (bf16_t*)regA; p.h2 = (bf16_t*)regA;
  char* regB1 = alloc((size_t)NT * LDQKV * 2);
  p.pqkv = (bf16_t*)regB1; p.attn_o = (bf16_t*)regB1;
  char* regB2 = alloc((size_t)NT * 512 * 2);
  p.pf = (bf16_t*)regB2; p.four_o = (bf16_t*)regB2;
  p.x1b = (bf16_t*)regB1;
  if ((size_t)(regB2 - regB1) + (size_t)NT * 512 * 2 < (size_t)NT * DM * 2) { fprintf(stderr, "x1b does not fit\n"); return; }
  p.pg = (bf16_t*)alloc((size_t)NT * 2048 * 2);
  p.Y = p.pg;
  const size_t szQ = (size_t)NB * NH * SEQ * QKD * 2, szK = (size_t)NB * NH * NKEY * QKD * 2, szV = (size_t)NB * NH * VD * NKEY * 2;
  char* regC = alloc(szQ + szK + szV + 1024);
  p.Q = (bf16_t*)regC; p.K = (bf16_t*)(regC + align_up(szQ, 256)); p.Vt = (bf16_t*)(regC + align_up(szQ, 256) + align_up(szK, 256));
  p.m = (bf16_t*)regC; p.hmid = (bf16_t*)(regC + (size_t)NT * DM * 2);
  if (off > ws_size) { fprintf(stderr, "workspace too small: need %zu have %zu\n", off, ws_size); return; }

  int ts = 0;
  auto job = [&](int i, const float* src, bf16_t* dst, const float* scale, int K, int ldS, int n_off, int n_cnt, int dst_row0, int mode, int batch, long sbs, long dbs) {
    TJob& j = p.jobs[i];
    j.src = src; j.dst = dst; j.scale = scale; j.K = K; j.ldS = ldS; j.n_off = n_off; j.n_cnt = n_cnt; j.dst_row0 = dst_row0; j.mode = mode; j.batch = batch;
    j.tiles_n = (n_cnt + 63) / 64; j.tile_start = ts; j.src_bstride = sbs; j.dst_bstride = dbs;
    ts += batch * (K / 64) * j.tiles_n;
  };
  job(0, w_e_gate, p.WguT, nullptr, DM, DE, 0, DE, 0, 1, NE, (long)DM * DE, (long)1024 * DM);
  job(1, w_e_up, p.WguT, nullptr, DM, DE, 0, DE, 0, 2, NE, (long)DM * DE, (long)1024 * DM);
  job(2, w_e_down, p.WdT, nullptr, DE, DM, 0, DM, 0, 0, NE, (long)DE * DM, (long)DM * DE);
  job(3, w_in, p.WinT, nullptr, DM, N_IN, 0, 672, 0, 0, 1, 0, 0);
  job(4, w_in, p.WinT, nullptr, DM, N_IN, 672, 2560, 768, 0, 1, 0, 0);
  job(5, w_q_up, p.WqT, q_a_g, QL, 768, 0, 768, 0, 0, 1, 0, 0);
  job(6, w_kv_up, p.WkvT, kv_a_g, KVL, 1024, 0, 1024, 0, 0, 1, 0, 0);
  job(7, w_o_attn, p.WoT, nullptr, 512, DM, 0, DM, 0, 0, 1, 0, 0);
  job(8, w_fourier, p.WfT, nullptr, 512, DM, 0, DM, 0, 0, 1, 0, 0);
  job(9, w_out, p.WoutT, nullptr, DM, DM, 0, DM, 0, 0, 1, 0, 0);
  p.n_ttiles = ts;

  void* args[] = {&p};
  hipError_t e = hipLaunchCooperativeKernel((void*)mega_kernel, dim3(grid_blocks), dim3(NTH), args, 0, stream);
  if (e != hipSuccess) fprintf(stderr, "cooperative launch failed: %s (grid %d)\n", hipGetErrorString(e), grid_blocks);
}
```

```cpp
#include <hip/hip_runtime.h>
#include <hip/hip_cooperative_groups.h>
#include <cstdio>
#include <cstring>
#include <cstdint>
namespace cg = cooperative_groups;

#define DI __device__ __forceinline__
typedef unsigned short bf16_t;
typedef short bf16x8 __attribute__((ext_vector_type(8)));
typedef float f32x16 __attribute__((ext_vector_type(16)));
#define MFMA(a, b, c) __builtin_amdgcn_mfma_f32_32x32x16_bf16((a), (b), (c), 0, 0, 0)

constexpr int NB = 32, SEQ = 2048, DM = 1024, NT = NB * SEQ, CTXL = 256, NC = NB * CTXL;
constexpr int NH = 8, QKD = 96, VD = 64, QL = 384, KVL = 256, NKEY = SEQ + CTXL;
constexpr int N_IN = 3232, NINP = 3328;
constexpr int NE = 16, DE = 512, CAP = 256;
constexpr float EPS = 1e-6f;
constexpr int LDQKV = 672, LDCKV = 288;
constexpr int NTH = 512, NWV = 8;
constexpr int SMEM_BYTES = 147456;

struct TJob {
  const float* src; bf16_t* dst; const float* scale;
  int K, ldS, n_off, n_cnt, dst_row0, mode, batch, tiles_n, tile_start, pad0;
  long src_bstride, dst_bstride;
};
constexpr int NJOBS = 10;

struct Params {
  const float *x, *c, *ctx, *c_ctx, *w_mod, *b_mod, *norm1_g, *q_norm_g, *k_norm_g, *norm2_g, *w_router;
  float* out;
  bf16_t *WinT, *WqT, *WkvT, *WoT, *WfT, *WoutT, *WguT, *WdT, *chanT, *posM;
  float *ropeTab, *mod;
  bf16_t *h, *pqkv, *pckv, *pf, *pg, *Q, *K, *Vt, *attn_o, *ABt, *four_o, *m, *h2, *hmid;
  float *aff, *gate;
  int* idx;
  int* inv;
  bf16_t* Y;
  bf16_t* x1b;
  TJob jobs[NJOBS];
  int n_ttiles, pad1;
};

typedef float f32x2v __attribute__((ext_vector_type(2)));
typedef __bf16 bf16x2v __attribute__((ext_vector_type(2)));
DI unsigned pk_bf16(float lo, float hi) { f32x2v v = {lo, hi}; bf16x2v b = __builtin_convertvector(v, bf16x2v); return __builtin_bit_cast(unsigned, b); }
DI int tid_() { int t = threadIdx.x; asm volatile("" : "+v"(t)); return t; }
DI float bf_lo(unsigned u) { return __uint_as_float(u << 16); }
DI float bf_hi(unsigned u) { return __uint_as_float(u & 0xffff0000u); }
DI bf16_t f2bf(float f) { return (bf16_t)(pk_bf16(f, 0.f) & 0xffffu); }
DI float sigmoidf_(float x) { return 1.f / (1.f + __expf(-x)); }
DI int crow(int i, int hh) { return (i & 3) + 8 * (i >> 2) + 4 * hh; }
DI float wave_sum(float v) {
#pragma unroll
  for (int o = 32; o >= 1; o >>= 1) v += __shfl_xor(v, o);
  return v;
}
DI f32x16 zero16() { f32x16 z;
#pragma unroll
  for (int i = 0; i < 16; ++i) z[i] = 0.f; return z; }
DI void wait_vm0() { asm volatile("s_waitcnt vmcnt(0)" ::: "memory"); }
DI void wait_lgkm0() { asm volatile("s_waitcnt lgkmcnt(0)" ::: "memory"); }
DI void bar_() { __builtin_amdgcn_s_barrier(); }
DI void lds_sync() { wait_lgkm0(); bar_(); }
#define GLDS(gp, lp) __builtin_amdgcn_global_load_lds((const unsigned*)(gp), (__attribute__((address_space(3))) unsigned*)(lp), 16, 0, 0)
#define SB_ __builtin_amdgcn_sched_barrier(0)

constexpr int EPI_OFF = 65536;
template <int TM, int TN, int WM, int WN, bool SUMSQ, int NST, class AF, class BF, class AFN, class BFN>
DI void gemm8x(f32x16 (&acc)[TM][TN], AF arow, BF brow, int K, char* smem, float& sumsq, bool pre, bool hasNext, AFN arowN, BFN browN) {
  constexpr int RA = 32 * TM * WM, RB = 32 * TN * WN;
  constexpr int LDR = 128, STAGE = (RA + RB) * LDR;
  static_assert(WM * WN == NWV, "waves");
  static_assert(NST * STAGE <= SMEM_BYTES, "smem");
  static_assert(NST == 2 || (NST == 3 && RA == 256 && RB == 128), "3-stage ring: 6 loads per thread per stage assumed");
  static_assert(RA <= 256 && RB <= 256 && RA % 32 == 0 && RB % 32 == 0, "shape");
  const int t = tid_(), lane = t & 63, w = t >> 6, r = lane & 31, hh = lane >> 5;
  const int wm = w % WM, wn = w / WM;
  const int row0 = t >> 3;
  const int c = (t & 7) ^ ((row0 >> 1) & 7);
  const bool a0v = row0 < RA, a1v = row0 + 64 < RA, a2v = row0 + 128 < RA, a3v = row0 + 192 < RA;
  const bool b0v = row0 < RB, b1v = row0 + 64 < RB, b2v = row0 + 128 < RB, b3v = row0 + 192 < RB;
  const bf16_t* pa0 = arow(a0v ? row0 : 0) + c * 8;
  const bf16_t* pa1 = arow(a1v ? row0 + 64 : 0) + c * 8;
  const bf16_t* pa2 = arow(a2v ? row0 + 128 : 0) + c * 8;
  const bf16_t* pa3 = arow(a3v ? row0 + 192 : 0) + c * 8;
  const bf16_t* pb0 = brow(b0v ? row0 : 0) + c * 8;
  const bf16_t* pb1 = brow(b1v ? row0 + 64 : 0) + c * 8;
  const bf16_t* pb2 = brow(b2v ? row0 + 128 : 0) + c * 8;
  const bf16_t* pb3 = brow(b3v ? row0 + 192 : 0) + c * 8;
  if (!pre) {
    char* l_ = smem + t * 16; char* m_ = l_ + RA * LDR;
    if (a0v) GLDS(pa0, l_); if (a1v) GLDS(pa1, l_ + 8192); if (a2v) GLDS(pa2, l_ + 16384); if (a3v) GLDS(pa3, l_ + 24576);
    if (b0v) GLDS(pb0, m_); if (b1v) GLDS(pb1, m_ + 8192); if (b2v) GLDS(pb2, m_ + 16384); if (b3v) GLDS(pb3, m_ + 24576);
  }
  if (NST == 3) {
    char* l_ = smem + STAGE + t * 16; char* m_ = l_ + RA * LDR;
    GLDS(pa0 + 64, l_); GLDS(pa1 + 64, l_ + 8192); GLDS(pa2 + 64, l_ + 16384); GLDS(pa3 + 64, l_ + 24576);
    GLDS(pb0 + 64, m_); GLDS(pb1 + 64, m_ + 8192);
    asm volatile("s_waitcnt vmcnt(6)" ::: "memory");
  } else wait_vm0();
  bar_();
  const int nk = K >> 6;
  const int sw = (r >> 1) & 7;
  const int aoff = (wm * TM * 32 + r) * LDR, boff = RA * LDR + (wn * TN * 32 + r) * LDR;
  auto compute = [&](const char* cur, char* nxt, bool issue, const bf16_t* q0, const bf16_t* q1, const bf16_t* q2, const bf16_t* q3,
                     const bf16_t* s0, const bf16_t* s1, const bf16_t* s2, const bf16_t* s3) {
    const char* As = cur + aoff;
    const char* Bs = cur + boff;
    char* l_ = nxt + t * 16; char* m_ = l_ + RA * LDR;
    bf16x8 a0[TM], b0[TN], a1[TM], b1[TN];
#define LOADF(A_, B_, ks) do { const int po_ = (((ks) * 2 + hh) ^ sw) * 16; \
      _Pragma("unroll") for (int tm = 0; tm < TM; ++tm) A_[tm] = *(const bf16x8*)(As + tm * 32 * LDR + po_); \
      _Pragma("unroll") for (int tn = 0; tn < TN; ++tn) B_[tn] = *(const bf16x8*)(Bs + tn * 32 * LDR + po_); } while (0)
#define MMF(A_, B_) do { if (SUMSQ) { uint4 u = __builtin_bit_cast(uint4, B_[0]); \
        float e0 = bf_lo(u.x), e1 = bf_hi(u.x), e2 = bf_lo(u.y), e3 = bf_hi(u.y), e4 = bf_lo(u.z), e5 = bf_hi(u.z), e6 = bf_lo(u.w), e7 = bf_hi(u.w); \
        sumsq += e0 * e0 + e1 * e1 + e2 * e2 + e3 * e3 + e4 * e4 + e5 * e5 + e6 * e6 + e7 * e7; } \
      _Pragma("unroll") for (int tm = 0; tm < TM; ++tm) _Pragma("unroll") for (int tn = 0; tn < TN; ++tn) acc[tm][tn] = MFMA(A_[tm], B_[tn], acc[tm][tn]); } while (0)
    LOADF(a0, b0, 0);
    LOADF(a1, b1, 1);
    SB_;
    if (issue) { if (a0v) GLDS(q0, l_); if (a1v) GLDS(q1, l_ + 8192); }
    SB_;
    __builtin_amdgcn_s_setprio(1);
    MMF(a0, b0);
    LOADF(a0, b0, 2);
    SB_;
    if (issue) { if (a2v) GLDS(q2, l_ + 16384); if (a3v) GLDS(q3, l_ + 24576); }
    SB_;
    MMF(a1, b1);
    LOADF(a1, b1, 3);
    SB_;
    if (issue) { if (b0v) GLDS(s0, m_); if (b1v) GLDS(s1, m_ + 8192); }
    SB_;
    MMF(a0, b0);
    SB_;
    if (issue) { if (b2v) GLDS(s2, m_ + 16384); if (b3v) GLDS(s3, m_ + 24576); }
    SB_;
    MMF(a1, b1);
    __builtin_amdgcn_s_setprio(0);
  };
  int sc_ = 0;
  for (int kt = 0; kt < nk - 1; ++kt) {
    SB_;
    if (NST == 2) {
      const int ko = (kt + 1) * 64;
      compute(smem + (kt & 1) * STAGE, smem + ((kt + 1) & 1) * STAGE, true, pa0 + ko, pa1 + ko, pa2 + ko, pa3 + ko, pb0 + ko, pb1 + ko, pb2 + ko, pb3 + ko);
      SB_;
      wait_vm0(); bar_();
    } else {
      const int ko = (kt + 2) * 64; const bool iss = kt + 2 < nk;
      const int sn = (sc_ == 0) ? 2 : sc_ - 1;
      compute(smem + sc_ * STAGE, smem + sn * STAGE, iss, pa0 + ko, pa1 + ko, pa2 + ko, pa3 + ko, pb0 + ko, pb1 + ko, pb2 + ko, pb3 + ko);
      SB_;
      if (iss) asm volatile("s_waitcnt vmcnt(6)" ::: "memory"); else wait_vm0();
      bar_();
      sc_ = (sc_ == 2) ? 0 : sc_ + 1;
    }
  }
  if (NST == 3) {
    SB_;
    compute(smem + sc_ * STAGE, smem, false, pa0, pa0, pa0, pa0, pa0, pa0, pa0, pa0);
    SB_;
    lds_sync();
  } else {
    const bf16_t *q0 = pa0, *q1 = pa0, *q2 = pa0, *q3 = pa0, *s0 = pa0, *s1 = pa0, *s2 = pa0, *s3 = pa0;
    if (hasNext) {
      q0 = arowN(a0v ? row0 : 0) + c * 8; q1 = arowN(a1v ? row0 + 64 : 0) + c * 8; q2 = arowN(a2v ? row0 + 128 : 0) + c * 8; q3 = arowN(a3v ? row0 + 192 : 0) + c * 8;
      s0 = browN(b0v ? row0 : 0) + c * 8; s1 = browN(b1v ? row0 + 64 : 0) + c * 8; s2 = browN(b2v ? row0 + 128 : 0) + c * 8; s3 = browN(b3v ? row0 + 192 : 0) + c * 8;
    }
    SB_;
    compute(smem + ((nk - 1) & 1) * STAGE, smem, hasNext, q0, q1, q2, q3, s0, s1, s2, s3);
    SB_;
    lds_sync();
  }
}
template <int TM, int TN, int WM, int WN, bool SUMSQ, class AF, class BF>
DI void gemm8(f32x16 (&acc)[TM][TN], AF arow, BF brow, int K, char* smem, float& sumsq) {
  gemm8x<TM, TN, WM, WN, SUMSQ, 2>(acc, arow, brow, K, smem, sumsq, false, false, arow, brow);
}
template <class AF, class BF>
DI void gemm8s3(f32x16 (&acc)[2][2], AF arow, BF brow, int K, char* smem) {
  float dummy = 0.f;
  gemm8x<2, 2, 4, 2, false, 3>(acc, arow, brow, K, smem, dummy, false, false, arow, brow);
}
template <int TM, int WM, int WN, int TNSEL, class F>
DI void stage_half(const f32x16 (&acc)[TM][2], char* tile, int pitch, F f) {
  const int t = tid_(), lane = t & 63, w = t >> 6, r = lane & 31, hh = lane >> 5;
  const int wm = w % WM, wn = w / WM;
#pragma unroll
  for (int tm = 0; tm < TM; ++tm) {
    char* d = tile + (wn * 32 + r) * pitch + (wm * TM * 32 + tm * 32 + 4 * hh) * 2;
#pragma unroll
    for (int q = 0; q < 4; ++q) {
      const f32x16& a = acc[tm][TNSEL];
      uint2 o; o.x = pk_bf16(f(a[4 * q]), f(a[4 * q + 1])); o.y = pk_bf16(f(a[4 * q + 2]), f(a[4 * q + 3]));
      *(uint2*)(d + 16 * q) = o;
    }
  }
}

template <int TM, int TN, int WM, int WN, class F>
DI void stage_tile(const f32x16 (&acc)[TM][TN], char* tile, int pitch, F f) {
  const int t = tid_(), lane = t & 63, w = t >> 6, r = lane & 31, hh = lane >> 5;
  const int wm = w % WM, wn = w / WM;
#pragma unroll
  for (int tm = 0; tm < TM; ++tm)
#pragma unroll
    for (int tn = 0; tn < TN; ++tn) {
      char* d = tile + (wn * TN * 32 + tn * 32 + r) * pitch + (wm * TM * 32 + tm * 32 + 4 * hh) * 2;
#pragma unroll
      for (int q = 0; q < 4; ++q) {
        uint2 o; o.x = pk_bf16(f(acc[tm][tn][4 * q]), f(acc[tm][tn][4 * q + 1])); o.y = pk_bf16(f(acc[tm][tn][4 * q + 2]), f(acc[tm][tn][4 * q + 3]));
        *(uint2*)(d + 16 * q) = o;
      }
    }
}
template <class RF>
DI void copy_tile(const char* tile, int pitch, int rows, int lch, RF dst, int ch0, int ch1) {
  const int t = tid_();
  const int total = rows << lch;
  for (int id = t; id < total; id += NTH) {
    const int row = id >> lch, ch = id & ((1 << lch) - 1);
    if (ch >= ch0 && ch < ch1) *(uint4*)(dst(row) + ch * 8) = *(const uint4*)(tile + row * pitch + ch * 16);
  }
}

struct TTile { const float* src; const float* scale; bf16_t* dst; int K, ldS, n0, n_cnt, k0, dst_row0, mode; };
DI TTile ttile_decode(const Params& p, int u) {
  int jb = 0;
#pragma unroll 1
  for (int q = 1; q < NJOBS; ++q) if (u >= p.jobs[q].tile_start) jb = q;
  const TJob& j = p.jobs[jb];
  const int tile = u - j.tile_start;
  const int tpb = (j.K >> 6) * j.tiles_n;
  const int bi = tile / tpb, rem = tile % tpb;
  const int kt = rem / j.tiles_n, ntile = rem % j.tiles_n;
  TTile tt;
  tt.src = j.src + (size_t)bi * j.src_bstride + j.n_off; tt.scale = j.scale; tt.dst = j.dst + (size_t)bi * j.dst_bstride;
  tt.K = j.K; tt.ldS = j.ldS; tt.n0 = ntile * 64; tt.n_cnt = j.n_cnt; tt.k0 = kt * 64; tt.dst_row0 = j.dst_row0; tt.mode = j.mode;
  return tt;
}
DI void ttile_load(const TTile& tt, int t, float (&v)[8]) {
  const int nn = t & 63, kq = t >> 6;
  const bool nvalid = (tt.n0 + nn) < tt.n_cnt;
#pragma unroll
  for (int i = 0; i < 8; ++i) {
    const int kk = kq + 8 * i;
    float x = 0.f;
    if (nvalid) { x = tt.src[(size_t)(tt.k0 + kk) * tt.ldS + tt.n0 + nn]; if (tt.scale) x *= tt.scale[tt.k0 + kk]; }
    v[i] = x;
  }
}
DI void ttile_store(const TTile& tt, int t, const float (&v)[8], char* smem) {
  bf16_t* T = (bf16_t*)smem;
  const int nn = t & 63, kq = t >> 6;
#pragma unroll
  for (int i = 0; i < 8; ++i) T[nn * 66 + kq + 8 * i] = f2bf(v[i]);
  __syncthreads();
  const int n = t >> 3, part = t & 7;
  if (tt.n0 + n < tt.n_cnt) {
    const unsigned* tp = (const unsigned*)(T + n * 66 + part * 8);
    uint4 o0; o0.x = tp[0]; o0.y = tp[1]; o0.z = tp[2]; o0.w = tp[3];
    const int f = tt.n0 + n;
    int drow;
    if (tt.mode == 0) drow = tt.dst_row0 + f;
    else drow = (f >> 7) * 256 + ((f >> 6) & 1) * 128 + (((f >> 5) & 1) * 2 + (tt.mode == 2 ? 1 : 0)) * 32 + (f & 31);
    *(uint4*)(tt.dst + (size_t)drow * tt.K + tt.k0 + part * 8) = o0;
  }
  __syncthreads();
}

DI void mod_item(const Params& p, int it, char* smem) {
  const int t = tid_(), cgi = t & 15, kg = t >> 4;
  const int j0 = it * 16;
  float* Ssm = (float*)smem;
  float* red = (float*)(smem + 33 * 128 * 4);
  float acc[33];
#pragma unroll
  for (int r = 0; r < 33; ++r) acc[r] = 0.f;
  const float* wp = p.w_mod + (size_t)(kg * 4) * 6144 + j0 + cgi;
  float n0 = wp[0], n1 = wp[6144], n2 = wp[2 * 6144], n3 = wp[3 * 6144];
#pragma unroll 1
  for (int kc = 0; kc < 8; ++kc) {
    __syncthreads();
    for (int idx = t; idx < 33 * 128; idx += NTH) {
      const int r = idx >> 7, kk = idx & 127;
      float v = (r < 32) ? p.c[r * DM + kc * 128 + kk] : p.c_ctx[kc * 128 + kk];
      Ssm[idx] = v * sigmoidf_(v);
    }
    const float w0 = n0, w1 = n1, w2 = n2, w3 = n3;
    if (kc < 7) { const float* wq = wp + (size_t)(kc + 1) * 128 * 6144; n0 = wq[0]; n1 = wq[6144]; n2 = wq[2 * 6144]; n3 = wq[3 * 6144]; }
    __syncthreads();
#pragma unroll
    for (int r = 0; r < 33; ++r) {
      const float4 s = *(const float4*)(Ssm + r * 128 + kg * 4);
      acc[r] += s.x * w0 + s.y * w1 + s.z * w2 + s.w * w3;
    }
  }
  __syncthreads();
#pragma unroll
  for (int r = 0; r < 33; ++r) red[(kg * 33 + r) * 16 + cgi] = acc[r];
  __syncthreads();
  for (int idx = t; idx < 33 * 16; idx += NTH) {
    const int r = idx >> 4, cc = idx & 15;
    float s = 0.f;
#pragma unroll
    for (int g = 0; g < 32; ++g) s += red[(g * 33 + r) * 16 + cc];
    p.mod[r * 6144 + j0 + cc] = s + p.b_mod[j0 + cc];
  }
}

DI void phase0(const Params& p, char* smem) {
  const int t = tid_();
  const int nMod = 384;
  const int nPos = 288;
  const int nMisc = 3;
  const int nT = p.n_ttiles;
  const int total = nMod + nPos + nMisc;
  float* ctab = (float*)(smem + 98304);
  for (int j = t; j < 2048; j += NTH) ctab[j] = cospif((float)j * (1.f / 1024.f));
  __syncthreads();
  for (int it = blockIdx.x; it < total; it += gridDim.x) {
    if (it < nMod) { mod_item(p, it, smem); continue; }
    int u = it - nMod;
    if (u < nPos) {
      for (int e = t; e < 8 * 256; e += NTH) {
        const int R = u * 8 + (e >> 8), c8 = (e & 255) * 8;
        const int part = R >= 1152 ? 1 : 0, k = R - part * 1152;
        float v[8];
#pragma unroll
        for (int q = 0; q < 8; ++q) {
          const int tt = c8 + q;
          v[q] = (k > 1024) ? 0.f : (part ? ctab[(k * tt - 512) & 2047] : ctab[(k * tt) & 2047]);
        }
        uint4 o; o.x = pk_bf16(v[0], v[1]); o.y = pk_bf16(v[2], v[3]); o.z = pk_bf16(v[4], v[5]); o.w = pk_bf16(v[6], v[7]);
        *(uint4*)(p.posM + (size_t)R * 2048 + c8) = o;
      }
      continue;
    }
    u -= nPos;
    if (u == 0) {
      for (int e = t; e < 256 * 128; e += NTH) {
        const int m2 = e >> 7, cc = e & 127, mm = m2 & 127;
        float v = (m2 < 128) ? ctab[(mm * cc * 16) & 2047] : ctab[(mm * cc * 16 - 512) & 2047];
        p.chanT[e] = f2bf(v);
      }
    } else if (u == 1) {
      for (int e = t; e < 64 * 8; e += NTH) {
        const int pos = e >> 3, jf = e & 7;
        const float inv = 1.0f / powf(10000.0f, (float)jf / 8.0f);
        const float ang = (float)pos * inv;
        p.ropeTab[e * 2 + 0] = cosf(ang);
        p.ropeTab[e * 2 + 1] = sinf(ang);
      }
    } else {
      uint4 z; z.x = z.y = z.z = z.w = 0u;
      uint4* dp = (uint4*)(p.WinT + (size_t)672 * DM);
      for (int e = t; e < 96 * DM / 8; e += NTH) dp[e] = z;
    }
  }
  __syncthreads();
  {
    const int G = gridDim.x;
    int u = (int)((blockIdx.x + 128u) % (unsigned)G);
    float vn[8];
    TTile tn_ = ttile_decode(p, u < nT ? u : 0);
    if (u < nT) ttile_load(tn_, t, vn);
    for (; u < nT; u += G) {
      const TTile tc = tn_;
      float vc[8];
#pragma unroll
      for (int i = 0; i < 8; ++i) vc[i] = vn[i];
      if (u + G < nT) { tn_ = ttile_decode(p, u + G); ttile_load(tn_, t, vn); }
      ttile_store(tc, t, vc, smem);
    }
  }
}

DI void phase1(const Params& p) {
  const int t_ = tid_(); const int lane = t_ & 63, w = t_ >> 6;
  const int gw = blockIdx.x * NWV + w, nw = gridDim.x * NWV;
  for (int R0 = gw; R0 < NT + NC; R0 += 2 * nw) {
    const int R1 = R0 + nw; const bool has1 = R1 < NT + NC;
    const float* src0 = (R0 < NT) ? p.x + (size_t)R0 * DM : p.ctx + (size_t)(R0 - NT) * DM;
    const float* src1 = has1 ? ((R1 < NT) ? p.x + (size_t)R1 * DM : p.ctx + (size_t)(R1 - NT) * DM) : src0;
    const float* md0 = p.mod + ((R0 < NT) ? (R0 >> 11) : 32) * 6144;
    const float* md1 = p.mod + ((has1 && R1 < NT) ? (R1 >> 11) : 32) * 6144;
    float4 v0[4], v1[4]; float s0 = 0.f, s1 = 0.f;
#pragma unroll
    for (int i = 0; i < 4; ++i) { v0[i] = *(const float4*)(src0 + lane * 4 + 256 * i); v1[i] = *(const float4*)(src1 + lane * 4 + 256 * i); }
#pragma unroll
    for (int i = 0; i < 4; ++i) { s0 += v0[i].x * v0[i].x + v0[i].y * v0[i].y + v0[i].z * v0[i].z + v0[i].w * v0[i].w; s1 += v1[i].x * v1[i].x + v1[i].y * v1[i].y + v1[i].z * v1[i].z + v1[i].w * v1[i].w; }
    s0 = wave_sum(s0); s1 = wave_sum(s1);
    const float r0 = rsqrtf(s0 * (1.f / DM) + EPS), r1 = rsqrtf(s1 * (1.f / DM) + EPS);
#pragma unroll
    for (int i = 0; i < 4; ++i) {
      const int d = lane * 4 + 256 * i;
      const float4 g = *(const float4*)(p.norm1_g + d);
      {
        const float4 sh = *(const float4*)(md0 + d), sc = *(const float4*)(md0 + 1024 + d);
        uint2 o; o.x = pk_bf16(v0[i].x * r0 * g.x * (1.f + sc.x) + sh.x, v0[i].y * r0 * g.y * (1.f + sc.y) + sh.y);
        o.y = pk_bf16(v0[i].z * r0 * g.z * (1.f + sc.z) + sh.z, v0[i].w * r0 * g.w * (1.f + sc.w) + sh.w);
        *(uint2*)(p.h + (size_t)R0 * DM + d) = o;
      }
      if (has1) {
        const float4 sh = *(const float4*)(md1 + d), sc = *(const float4*)(md1 + 1024 + d);
        uint2 o; o.x = pk_bf16(v1[i].x * r1 * g.x * (1.f + sc.x) + sh.x, v1[i].y * r1 * g.y * (1.f + sc.y) + sh.y);
        o.y = pk_bf16(v1[i].z * r1 * g.z * (1.f + sc.z) + sh.z, v1[i].w * r1 * g.w * (1.f + sc.w) + sh.w);
        *(uint2*)(p.h + (size_t)R1 * DM + d) = o;
      }
    }
  }
}

DI void phase2(const Params& p, char* smem) {
  const int xcd = blockIdx.x & 7, jl = blockIdx.x >> 3, nl = gridDim.x >> 3;
  auto decode = [&](int L, int& tokTile, int& ft) {
    if (L < 416) { const int tg = L / 104, rem = L % 104; ft = rem >> 3; tokTile = xcd * 32 + tg * 8 + (rem & 7); }
    else { const int u = L - 416; tokTile = 256 + xcd * 4 + (u >> 1); ft = 1 + (u & 1); }
  };
  bool pre = false;
  for (int L = jl; L < 416 + 8; L += nl) {
    int tokTile, ft, tokTileN = 0, ftN = 0;
    decode(L, tokTile, ft);
    const bool lat = L < 416;
    const int Ln = L + nl; const bool hasNext = Ln < 416 + 8;
    if (hasNext) decode(Ln, tokTileN, ftN);
    f32x16 acc[4][2];
#pragma unroll
    for (int a = 0; a < 4; ++a)
#pragma unroll
      for (int b = 0; b < 2; ++b) acc[a][b] = zero16();
    const bf16_t* Ab = p.WinT + (size_t)ft * 256 * DM;
    const bf16_t* Bb = p.h + (size_t)tokTile * 256 * DM;
    const bf16_t* AbN = p.WinT + (size_t)ftN * 256 * DM;
    const bf16_t* BbN = p.h + (size_t)tokTileN * 256 * DM;
    float dummy = 0.f;
    gemm8x<4, 2, 2, 4, false, 2>(acc, [&](int row) { return Ab + (size_t)row * DM; }, [&](int row) { return Bb + (size_t)row * DM; }, DM, smem, dummy,
                              pre, hasNext, [&](int row) { return AbN + (size_t)row * DM; }, [&](int row) { return BbN + (size_t)row * DM; });
    pre = hasNext;
    char* tile = smem + EPI_OFF;
    bf16_t* base; int ld, c0 = 0, c1 = 32;
    if (lat) {
      const size_t tok0 = (size_t)tokTile * 256;
      if (ft < 3) { base = p.pqkv + tok0 * LDQKV + ft * 256; ld = LDQKV; if (ft == 2) c1 = 20; }
      else if (ft < 5) { base = p.pf + tok0 * 512 + (ft - 3) * 256; ld = 512; }
      else { base = p.pg + tok0 * 2048 + (ft - 5) * 256; ld = 2048; }
    } else {
      const size_t ct0 = (size_t)(tokTile - 256) * 256;
      base = p.pckv + ct0 * LDCKV + ft * 256 - 384; ld = LDCKV;
      if (ft == 1) c0 = 16; else c1 = 20;
    }
    if (ft >= 5) stage_half<4, 2, 4, 0>(acc, tile, 528, [](float v) { return sigmoidf_(v); });
    else stage_half<4, 2, 4, 0>(acc, tile, 528, [](float v) { return v; });
    lds_sync();
    copy_tile(tile, 528, 128, 5, [&](int rl) { return base + (size_t)((rl >> 5) * 64 + (rl & 31)) * ld; }, c0, c1);
    lds_sync();
    if (ft >= 5) stage_half<4, 2, 4, 1>(acc, tile, 528, [](float v) { return sigmoidf_(v); });
    else stage_half<4, 2, 4, 1>(acc, tile, 528, [](float v) { return v; });
    lds_sync();
    copy_tile(tile, 528, 128, 5, [&](int rl) { return base + (size_t)((rl >> 5) * 64 + 32 + (rl & 31)) * ld; }, c0, c1);
  }
}

DI void rope_pair(float& x1, float& x2, const float* tab) { const float c = tab[0], s = tab[1]; const float a = x1 * c - x2 * s, b = x2 * c + x1 * s; x1 = a; x2 = b; }

DI void phase3(const Params& p, char* smem) {
  const int t = tid_(), lane = t & 63, w = t >> 6, r = lane & 31, hh = lane >> 5;
  const int nKV = 288, nQ = 256, nCh = 128;
  const int xcd = blockIdx.x & 7, jl = blockIdx.x >> 3, nl = gridDim.x >> 3;
  for (int it = jl; it < nKV + nQ + nCh; it += nl) {
    if (it < nKV) {
      const int tl_ = it >> 3, hd = it & 7;
      const bool lat = tl_ < 32;
      const bf16_t* Bb; int ldb; const bf16_t* kpeb;
      int b, key0;
      if (lat) { const int tokTile = xcd * 32 + tl_; Bb = p.pqkv + (size_t)tokTile * 256 * LDQKV + QL; ldb = LDQKV; kpeb = p.pqkv + (size_t)tokTile * 256 * LDQKV + 640; b = tokTile >> 3; key0 = (tokTile & 7) * 256; }
      else { const int ct = xcd * 4 + (tl_ - 32); Bb = p.pckv + (size_t)ct * 256 * LDCKV; ldb = LDCKV; kpeb = Bb + 256; b = ct; key0 = SEQ; }
      const bf16_t* Ab = p.WkvT + (size_t)hd * 128 * KVL;
      f32x16 acc[4][1];
#pragma unroll
      for (int a = 0; a < 4; ++a) acc[a][0] = zero16();
      float sumsq = 0.f;
      gemm8<4, 1, 1, 8, true>(acc, [&](int row) { return Ab + (size_t)row * KVL; }, [&](int row) { return Bb + (size_t)row * ldb; }, KVL, smem, sumsq);
      sumsq += __shfl_xor(sumsq, 32);
      const float ra = rsqrtf(sumsq * (1.f / KVL) + EPS);
      const int tl = w * 32 + r;
      const int key = key0 + tl;
      float kp[16];
#pragma unroll
      for (int q = 0; q < 4; ++q) {
        const uint2 u = *(const uint2*)(kpeb + (size_t)tl * ldb + 8 * q + 4 * hh);
        kp[4 * q + 0] = bf_lo(u.x); kp[4 * q + 1] = bf_hi(u.x); kp[4 * q + 2] = bf_lo(u.y); kp[4 * q + 3] = bf_hi(u.y);
      }
      float ss = 0.f;
#pragma unroll
      for (int tm = 0; tm < 4; ++tm)
#pragma unroll
        for (int i = 0; i < 16; ++i) { const float v = acc[tm][0][i] * ra; acc[tm][0][i] = v; if (tm < 2) ss += v * v; }
#pragma unroll
      for (int i = 0; i < 16; ++i) ss += kp[i] * kp[i];
      ss += __shfl_xor(ss, 32);
      const float rk = rsqrtf(ss * (1.f / QKD) + EPS);
#pragma unroll
      for (int i = 0; i < 16; ++i) kp[i] *= rk * p.k_norm_g[64 + crow(i, hh)];
      if (lat) {
        const int pos = key;
        const float* tr = p.ropeTab + ((pos >> 6) * 8 + 4 * hh) * 2;
        const float* tc = p.ropeTab + ((pos & 63) * 8 + 4 * hh) * 2;
#pragma unroll
        for (int i = 0; i < 4; ++i) { rope_pair(kp[i], kp[i + 4], tr + 2 * i); rope_pair(kp[8 + i], kp[12 + i], tc + 2 * i); }
      }
      {
        char* kt_ = smem; char* vt_ = smem + 256 * 208;
        char* kd = kt_ + tl * 208;
#pragma unroll
        for (int tm = 0; tm < 2; ++tm)
#pragma unroll
          for (int q = 0; q < 4; ++q) {
            const int f = tm * 32 + 8 * q + 4 * hh;
            const float4 g = *(const float4*)(p.k_norm_g + f);
            uint2 o; o.x = pk_bf16(acc[tm][0][4 * q] * rk * g.x, acc[tm][0][4 * q + 1] * rk * g.y); o.y = pk_bf16(acc[tm][0][4 * q + 2] * rk * g.z, acc[tm][0][4 * q + 3] * rk * g.w);
            *(uint2*)(kd + f * 2) = o;
          }
#pragma unroll
        for (int q = 0; q < 4; ++q) {
          uint2 o; o.x = pk_bf16(kp[4 * q], kp[4 * q + 1]); o.y = pk_bf16(kp[4 * q + 2], kp[4 * q + 3]);
          *(uint2*)(kd + (64 + 8 * q + 4 * hh) * 2) = o;
        }
#pragma unroll
        for (int tm = 2; tm < 4; ++tm)
#pragma unroll
          for (int i = 0; i < 16; ++i) *(bf16_t*)(vt_ + ((tm - 2) * 32 + crow(i, hh)) * 528 + tl * 2) = f2bf(acc[tm][0][i]);
        lds_sync();
        const int tc_ = tid_();
        bf16_t* Kg = p.K + ((size_t)(b * NH + hd) * NKEY + key0) * QKD;
#pragma unroll
        for (int i = 0; i < 6; ++i) {
          const int id = tc_ + NTH * i, row = id / 12, ch = id % 12;
          *(uint4*)(Kg + row * QKD + ch * 8) = *(const uint4*)(kt_ + row * 208 + ch * 16);
        }
        bf16_t* Vg = p.Vt + (size_t)(b * NH + hd) * VD * NKEY + key0;
#pragma unroll
        for (int i = 0; i < 4; ++i) {
          const int row = (tc_ >> 5) + 16 * i, ch = tc_ & 31;
          *(uint4*)(Vg + (size_t)row * NKEY + ch * 8) = *(const uint4*)(vt_ + row * 528 + ch * 16);
        }
        lds_sync();
      }
    } else if (it < nKV + nQ) {
      const int u = it - nKV;
      const int tokTile = xcd * 32 + (u >> 3), hd = u & 7;
      const bf16_t* Bb = p.pqkv + (size_t)tokTile * 256 * LDQKV;
      const bf16_t* Ab = p.WqT + (size_t)hd * QKD * QL;
      f32x16 acc[3][1];
#pragma unroll
      for (int a = 0; a < 3; ++a) acc[a][0] = zero16();
      float sumsq = 0.f;
      gemm8<3, 1, 1, 8, true>(acc, [&](int row) { return Ab + (size_t)row * QL; }, [&](int row) { return Bb + (size_t)row * LDQKV; }, QL, smem, sumsq);
      sumsq += __shfl_xor(sumsq, 32);
      const float ra = rsqrtf(sumsq * (1.f / QL) + EPS);
      const int tl = w * 32 + r;
      const int b = tokTile >> 3, pos = (tokTile & 7) * 256 + tl;
      float ss = 0.f;
#pragma unroll
      for (int tm = 0; tm < 3; ++tm)
#pragma unroll
        for (int i = 0; i < 16; ++i) { const float v = acc[tm][0][i] * ra; acc[tm][0][i] = v; ss += v * v; }
      ss += __shfl_xor(ss, 32);
      const float rh = rsqrtf(ss * (1.f / QKD) + EPS);
#pragma unroll
      for (int tm = 0; tm < 3; ++tm)
#pragma unroll
        for (int q = 0; q < 4; ++q) {
          const float4 g = *(const float4*)(p.q_norm_g + tm * 32 + 8 * q + 4 * hh);
          acc[tm][0][4 * q] *= rh * g.x; acc[tm][0][4 * q + 1] *= rh * g.y; acc[tm][0][4 * q + 2] *= rh * g.z; acc[tm][0][4 * q + 3] *= rh * g.w;
        }
      {
        const float* tr = p.ropeTab + ((pos >> 6) * 8 + 4 * hh) * 2;
        const float* tc = p.ropeTab + ((pos & 63) * 8 + 4 * hh) * 2;
#pragma unroll
        for (int i = 0; i < 4; ++i) {
          float a0 = acc[2][0][i], a1 = acc[2][0][i + 4], c0 = acc[2][0][8 + i], c1 = acc[2][0][12 + i];
          rope_pair(a0, a1, tr + 2 * i); rope_pair(c0, c1, tc + 2 * i);
          acc[2][0][i] = a0; acc[2][0][i + 4] = a1; acc[2][0][8 + i] = c0; acc[2][0][12 + i] = c1;
        }
      }
      const float qs = 0.10206207261596575f * 1.4426950408889634f;
      {
        char* qd = smem + tl * 208;
#pragma unroll
        for (int tm = 0; tm < 3; ++tm)
#pragma unroll
          for (int q = 0; q < 4; ++q) {
            uint2 o; o.x = pk_bf16(acc[tm][0][4 * q] * qs, acc[tm][0][4 * q + 1] * qs); o.y = pk_bf16(acc[tm][0][4 * q + 2] * qs, acc[tm][0][4 * q + 3] * qs);
            *(uint2*)(qd + (tm * 32 + 8 * q + 4 * hh) * 2) = o;
          }
        lds_sync();
        const int tc_ = tid_();
        bf16_t* Qg = p.Q + ((size_t)(b * NH + hd) * SEQ + (tokTile & 7) * 256) * QKD;
#pragma unroll
        for (int i = 0; i < 6; ++i) {
          const int id = tc_ + NTH * i, row = id / 12, ch = id % 12;
          *(uint4*)(Qg + row * QKD + ch * 8) = *(const uint4*)(smem + row * 208 + ch * 16);
        }
        lds_sync();
      }
    } else {
      const int u = it - nKV - nQ;
      const int tt = u & 7, g = (u >> 3) & 3, b = xcd * 4 + (u >> 5);
      const bf16_t* Tb = p.chanT;
      const bf16_t* Fb = p.pf + (size_t)(b * SEQ + tt * 256) * 512 + g * 128;
      f32x16 acc[4][2];
#pragma unroll
      for (int a = 0; a < 4; ++a)
#pragma unroll
        for (int c = 0; c < 2; ++c) acc[a][c] = zero16();
      float dummy = 0.f;
      gemm8<4, 2, 2, 4, false>(acc, [&](int row) { return Fb + (size_t)row * 512; }, [&](int row) { return Tb + (size_t)row * 128; }, 128, smem, dummy);
      stage_tile<4, 2, 2, 4>(acc, smem, 528, [](float v) { return v; });
      lds_sync();
      bf16_t* dst0 = p.ABt + ((size_t)(b * 512 + g * 128)) * 4096 + tt * 256;
      copy_tile(smem, 528, 256, 5, [&](int row) { return dst0 + (size_t)(row & 127) * 4096 + (row >> 7) * 2048; }, 0, 32);
      lds_sync();
    }
  }
}

DI void attn_item(const Params& p, int it, char* smem) {
  const int t = tid_(), lane = t & 63, w = t >> 6, r = lane & 31, hh = lane >> 5;
  const int qt = it & 7, bh = it >> 3;
  constexpr int KROW = 208, VROW = 136, KBYTES = 64 * KROW, STAGE = KBYTES + 64 * VROW;
  const bf16_t* Kb = p.K + (size_t)bh * NKEY * QKD;
  const bf16_t* Vb = p.Vt + (size_t)bh * VD * NKEY;
  const int qpos = qt * 256 + w * 32 + r;
  const bf16_t* Qp = p.Q + ((size_t)bh * SEQ + qpos) * QKD + hh * 8;
  bf16x8 qf[6];
#pragma unroll
  for (int c = 0; c < 6; ++c) qf[c] = *(const bf16x8*)(Qp + c * 16);
  f32x16 o[2]; o[0] = zero16(); o[1] = zero16();
  float gk = 0.f;
  for (int f = 0; f < QKD; ++f) gk = fmaxf(gk, fabsf(p.k_norm_g[f]));
  float qss = 0.f;
#pragma unroll
  for (int c = 0; c < 6; ++c) {
    const uint4 u = __builtin_bit_cast(uint4, qf[c]);
    const float e0 = bf_lo(u.x), e1 = bf_hi(u.x), e2 = bf_lo(u.y), e3 = bf_hi(u.y), e4 = bf_lo(u.z), e5 = bf_hi(u.z), e6 = bf_lo(u.w), e7 = bf_hi(u.w);
    qss += e0 * e0 + e1 * e1 + e2 * e2 + e3 * e3 + e4 * e4 + e5 * e5 + e6 * e6 + e7 * e7;
  }
  qss += __shfl_xor(qss, 32);
  const float negC = -(sqrtf(qss) * gk * 9.797959f * 1.01f);
  f32x16 sinit;
#pragma unroll
  for (int i = 0; i < 16; ++i) sinit[i] = negC;
  float lrun = 0.f;
  const int kid0 = t, kid1 = (t & 255) + 512;
  const bool k1v = t < 256;
  const int kgo0 = (kid0 / 12) * QKD + (kid0 % 12) * 8, kgo1 = (kid1 / 12) * QKD + (kid1 % 12) * 8;
  const int klo0 = (kid0 / 12) * KROW + (kid0 % 12) * 16, klo1 = (kid1 / 12) * KROW + (kid1 % 12) * 16;
  const int vgo0 = (t >> 3) * NKEY + (t & 7) * 8;
  const int vlo0 = KBYTES + (t >> 3) * VROW + (t & 7) * 16;
  uint4 rk0, rk1, rv0;
  rk0 = *(const uint4*)(Kb + kgo0); rk1 = *(const uint4*)(Kb + kgo1);
  rv0 = *(const uint4*)(Vb + vgo0);
  SB_;
#define ATT_STORE(base) do { \
    *(uint4*)((base) + klo0) = rk0; if (k1v) *(uint4*)((base) + klo1) = rk1; \
    { uint2* d = (uint2*)((base) + vlo0); d[0] = make_uint2(rv0.x, rv0.y); d[1] = make_uint2(rv0.z, rv0.w); } } while (0)
  ATT_STORE(smem);
  __syncthreads();
  constexpr int NKT = NKEY / 64;
  for (int kt = 0; kt < NKT; ++kt) {
    const char* cur = smem + (kt & 1) * STAGE;
    const bool more = kt + 1 < NKT;
    if (more) {
      const bf16_t* kn = Kb + (size_t)(kt + 1) * 64 * QKD; const bf16_t* vn = Vb + (kt + 1) * 64;
      rk0 = *(const uint4*)(kn + kgo0); rk1 = *(const uint4*)(kn + kgo1);
      rv0 = *(const uint4*)(vn + vgo0);
    }
    SB_;
    f32x16 s[2];
#pragma unroll
    for (int t2 = 0; t2 < 2; ++t2) {
      const char* kp = cur + (t2 * 32 + r) * KROW + hh * 16;
      { const bf16x8 kf = *(const bf16x8*)(kp); s[t2] = MFMA(kf, qf[0], sinit); }
#pragma unroll
      for (int c = 1; c < 6; ++c) { const bf16x8 kf = *(const bf16x8*)(kp + c * 32); s[t2] = MFMA(kf, qf[c], s[t2]); }
    }
    SB_;
    float ls = 0.f;
#pragma unroll
    for (int t2 = 0; t2 < 2; ++t2)
#pragma unroll
      for (int i = 0; i < 16; ++i) { const float e = __builtin_amdgcn_exp2f(s[t2][i]); s[t2][i] = e; ls += e; }
    lrun += ls;
    SB_;
#pragma unroll
    for (int t2 = 0; t2 < 2; ++t2)
#pragma unroll
      for (int s2 = 0; s2 < 2; ++s2) {
        uint4 pu;
        pu.x = pk_bf16(s[t2][8 * s2 + 0], s[t2][8 * s2 + 1]); pu.y = pk_bf16(s[t2][8 * s2 + 2], s[t2][8 * s2 + 3]);
        pu.z = pk_bf16(s[t2][8 * s2 + 4], s[t2][8 * s2 + 5]); pu.w = pk_bf16(s[t2][8 * s2 + 6], s[t2][8 * s2 + 7]);
        const bf16x8 pb = __builtin_bit_cast(bf16x8, pu);
#pragma unroll
        for (int vt = 0; vt < 2; ++vt) {
          const char* vp = cur + KBYTES + (vt * 32 + r) * VROW + (t2 * 32 + 16 * s2 + 4 * hh) * 2;
          const uint2 lo = *(const uint2*)(vp), hi = *(const uint2*)(vp + 16);
          uint4 vu; vu.x = lo.x; vu.y = lo.y; vu.z = hi.x; vu.w = hi.y;
          o[vt] = MFMA(__builtin_bit_cast(bf16x8, vu), pb, o[vt]);
        }
      }
    SB_;
    if (more) { char* nxt = smem + ((kt + 1) & 1) * STAGE; ATT_STORE(nxt); }
    __syncthreads();
  }
  lrun += __shfl_xor(lrun, 32);
  const float inv = 1.f / lrun;
  const int b = bh >> 3, hd = bh & 7;
  bf16_t* od = p.attn_o + (size_t)(b * SEQ + qpos) * 512 + hd * 64;
#pragma unroll
  for (int vt = 0; vt < 2; ++vt)
#pragma unroll
    for (int q = 0; q < 4; ++q) {
      uint2 ou; ou.x = pk_bf16(o[vt][4 * q] * inv, o[vt][4 * q + 1] * inv); ou.y = pk_bf16(o[vt][4 * q + 2] * inv, o[vt][4 * q + 3] * inv);
      *(uint2*)(od + vt * 32 + 8 * q + 4 * hh) = ou;
    }
}

DI void attn_item64(const Params& p, int it, char* smem) {
  const int t = tid_(), lane = t & 63, w = t >> 6, r = lane & 31, hh = lane >> 5;
  const int qt = it & 3, bh = it >> 2;
  constexpr int KROW = 208, VROW = 136, KBYTES = 64 * KROW, STAGE = KBYTES + 64 * VROW;
  const bf16_t* Kb = p.K + (size_t)bh * NKEY * QKD;
  const bf16_t* Vb = p.Vt + (size_t)bh * VD * NKEY;
  const int qposa = qt * 512 + w * 64 + r, qposb = qposa + 32;
  const bf16_t* Qa = p.Q + ((size_t)bh * SEQ + qposa) * QKD + hh * 8;
  bf16x8 qfa[6], qfb[6];
#pragma unroll
  for (int c = 0; c < 6; ++c) { qfa[c] = *(const bf16x8*)(Qa + c * 16); qfb[c] = *(const bf16x8*)(Qa + 32 * QKD + c * 16); }
  f32x16 oa[2], ob[2]; oa[0] = zero16(); oa[1] = zero16(); ob[0] = zero16(); ob[1] = zero16();
  float gk = 0.f;
  for (int f = 0; f < QKD; ++f) gk = fmaxf(gk, fabsf(p.k_norm_g[f]));
  float qsa = 0.f, qsb = 0.f;
#pragma unroll
  for (int c = 0; c < 6; ++c) {
    const uint4 u = __builtin_bit_cast(uint4, qfa[c]), v = __builtin_bit_cast(uint4, qfb[c]);
    qsa += bf_lo(u.x) * bf_lo(u.x) + bf_hi(u.x) * bf_hi(u.x) + bf_lo(u.y) * bf_lo(u.y) + bf_hi(u.y) * bf_hi(u.y) + bf_lo(u.z) * bf_lo(u.z) + bf_hi(u.z) * bf_hi(u.z) + bf_lo(u.w) * bf_lo(u.w) + bf_hi(u.w) * bf_hi(u.w);
    qsb += bf_lo(v.x) * bf_lo(v.x) + bf_hi(v.x) * bf_hi(v.x) + bf_lo(v.y) * bf_lo(v.y) + bf_hi(v.y) * bf_hi(v.y) + bf_lo(v.z) * bf_lo(v.z) + bf_hi(v.z) * bf_hi(v.z) + bf_lo(v.w) * bf_lo(v.w) + bf_hi(v.w) * bf_hi(v.w);
  }
  qsa += __shfl_xor(qsa, 32); qsb += __shfl_xor(qsb, 32);
  const float negC = -(sqrtf(fmaxf(qsa, qsb)) * gk * 9.797959f * 1.01f);
  f32x16 sinit;
#pragma unroll
  for (int i = 0; i < 16; ++i) sinit[i] = negC;
  float la = 0.f, lb = 0.f;
  const int kid0 = t, kid1 = (t & 255) + 512;
  const bool k1v = t < 256;
  const int kgo0 = (kid0 / 12) * QKD + (kid0 % 12) * 8, kgo1 = (kid1 / 12) * QKD + (kid1 % 12) * 8;
  const int klo0 = (kid0 / 12) * KROW + (kid0 % 12) * 16, klo1 = (kid1 / 12) * KROW + (kid1 % 12) * 16;
  const int vgo0 = (t >> 3) * NKEY + (t & 7) * 8;
  const int vlo0 = KBYTES + (t >> 3) * VROW + (t & 7) * 16;
  uint4 rk0, rk1, rv0;
  rk0 = *(const uint4*)(Kb + kgo0); rk1 = *(const uint4*)(Kb + kgo1);
  rv0 = *(const uint4*)(Vb + vgo0);
  SB_;
#define ATT64_STORE(base) do { \
    *(uint4*)((base) + klo0) = rk0; if (k1v) *(uint4*)((base) + klo1) = rk1; \
    { uint2* d = (uint2*)((base) + vlo0); d[0] = make_uint2(rv0.x, rv0.y); d[1] = make_uint2(rv0.z, rv0.w); } } while (0)
  ATT64_STORE(smem);
  __syncthreads();
  constexpr int NKT = NKEY / 64;
  for (int kt = 0; kt < NKT; ++kt) {
    const char* cur = smem + (kt & 1) * STAGE;
    const bool more = kt + 1 < NKT;
    if (more) {
      const bf16_t* kn = Kb + (size_t)(kt + 1) * 64 * QKD; const bf16_t* vn = Vb + (kt + 1) * 64;
      rk0 = *(const uint4*)(kn + kgo0); rk1 = *(const uint4*)(kn + kgo1);
      rv0 = *(const uint4*)(vn + vgo0);
    }
    SB_;
#pragma unroll
    for (int t2 = 0; t2 < 2; ++t2) {
      const char* kp = cur + (t2 * 32 + r) * KROW + hh * 16;
      f32x16 sa, sb;
      { const bf16x8 kf = *(const bf16x8*)(kp); sa = MFMA(kf, qfa[0], sinit); sb = MFMA(kf, qfb[0], sinit); }
#pragma unroll
      for (int c = 1; c < 6; ++c) { const bf16x8 kf = *(const bf16x8*)(kp + c * 32); sa = MFMA(kf, qfa[c], sa); sb = MFMA(kf, qfb[c], sb); }
      SB_;
      float lsa = 0.f, lsb = 0.f;
#pragma unroll
      for (int i = 0; i < 16; ++i) { const float e = __builtin_amdgcn_exp2f(sa[i]); sa[i] = e; lsa += e; const float f = __builtin_amdgcn_exp2f(sb[i]); sb[i] = f; lsb += f; }
      la += lsa; lb += lsb;
      SB_;
#pragma unroll
      for (int s2 = 0; s2 < 2; ++s2) {
        uint4 pu, pv;
        pu.x = pk_bf16(sa[8 * s2 + 0], sa[8 * s2 + 1]); pu.y = pk_bf16(sa[8 * s2 + 2], sa[8 * s2 + 3]); pu.z = pk_bf16(sa[8 * s2 + 4], sa[8 * s2 + 5]); pu.w = pk_bf16(sa[8 * s2 + 6], sa[8 * s2 + 7]);
        pv.x = pk_bf16(sb[8 * s2 + 0], sb[8 * s2 + 1]); pv.y = pk_bf16(sb[8 * s2 + 2], sb[8 * s2 + 3]); pv.z = pk_bf16(sb[8 * s2 + 4], sb[8 * s2 + 5]); pv.w = pk_bf16(sb[8 * s2 + 6], sb[8 * s2 + 7]);
        const bf16x8 pa_ = __builtin_bit_cast(bf16x8, pu), pb_ = __builtin_bit_cast(bf16x8, pv);
#pragma unroll
        for (int vt = 0; vt < 2; ++vt) {
          const char* vp = cur + KBYTES + (vt * 32 + r) * VROW + (t2 * 32 + 16 * s2 + 4 * hh) * 2;
          const uint2 lo = *(const uint2*)(vp), hi = *(const uint2*)(vp + 16);
          uint4 vu; vu.x = lo.x; vu.y = lo.y; vu.z = hi.x; vu.w = hi.y;
          const bf16x8 vf = __builtin_bit_cast(bf16x8, vu);
          oa[vt] = MFMA(vf, pa_, oa[vt]);
          ob[vt] = MFMA(vf, pb_, ob[vt]);
        }
      }
      SB_;
    }
    SB_;
    if (more) { char* nxt = smem + ((kt + 1) & 1) * STAGE; ATT64_STORE(nxt); }
    __syncthreads();
  }
  la += __shfl_xor(la, 32); lb += __shfl_xor(lb, 32);
  const float inva = 1.f / la, invb = 1.f / lb;
  const int b = bh >> 3, hd = bh & 7;
  bf16_t* oda = p.attn_o + (size_t)(b * SEQ + qposa) * 512 + hd * 64;
  bf16_t* odb = oda + (size_t)32 * 512;
#pragma unroll
  for (int vt = 0; vt < 2; ++vt)
#pragma unroll
    for (int q = 0; q < 4; ++q) {
      uint2 ou; ou.x = pk_bf16(oa[vt][4 * q] * inva, oa[vt][4 * q + 1] * inva); ou.y = pk_bf16(oa[vt][4 * q + 2] * inva, oa[vt][4 * q + 3] * inva);
      *(uint2*)(oda + vt * 32 + 8 * q + 4 * hh) = ou;
      uint2 ov; ov.x = pk_bf16(ob[vt][4 * q] * invb, ob[vt][4 * q + 1] * invb); ov.y = pk_bf16(ob[vt][4 * q + 2] * invb, ob[vt][4 * q + 3] * invb);
      *(uint2*)(odb + vt * 32 + 8 * q + 4 * hh) = ov;
    }
}

DI void phase4(const Params& p, char* smem) {
  const int t = tid_(), lane = t & 63, w = t >> 6, r = lane & 31, hh = lane >> 5;
  const int nDft = 64, nAlt = 4, nAtt = 128;
  const int xcd = blockIdx.x & 7, jl = blockIdx.x >> 3, nl = gridDim.x >> 3;
  for (int it = jl; it < nDft + nAlt + nAtt; it += nl) {
    if (it < nDft) {
      const int bl = it >> 4, rem = it & 15, ct = rem >> 3, kt = rem & 7, b = xcd * 4 + bl;
      const int wm = w & 3, wn = w >> 2;
      const bf16_t* Ab = p.ABt + (size_t)(b * 512 + ct * 256) * 4096;
      const bf16_t* Cb = p.posM + (size_t)kt * 128 * 2048;
      const bf16_t* Sb = p.posM + (size_t)(1152 + kt * 128) * 2048;
      f32x16 acc1[2][2], acc2[2][2];
#pragma unroll
      for (int a = 0; a < 2; ++a)
#pragma unroll
        for (int c = 0; c < 2; ++c) { acc1[a][c] = zero16(); acc2[a][c] = zero16(); }
      float dummy = 0.f;
      gemm8s3(acc1, [&](int row) { return Ab + (size_t)row * 4096; }, [&](int row) { return Cb + (size_t)row * 2048; }, 2048, smem);
      gemm8s3(acc2, [&](int row) { return Ab + (size_t)row * 4096 + 2048; }, [&](int row) { return Sb + (size_t)row * 2048; }, 2048, smem);
      const float sc = 1.f / 512.f;
#pragma unroll
      for (int tm = 0; tm < 2; ++tm)
#pragma unroll
        for (int tn = 0; tn < 2; ++tn) {
          const int kpos = kt * 128 + wn * 64 + tn * 32 + r;
          const int moff = ct * 256 + wm * 64 + tm * 32 + 4 * hh;
          if (kpos <= 1024) {
            bf16_t* d = p.four_o + (size_t)(b * SEQ + kpos) * 512 + moff;
#pragma unroll
            for (int q = 0; q < 4; ++q) {
              uint2 ou; ou.x = pk_bf16((acc1[tm][tn][4 * q] - acc2[tm][tn][4 * q]) * sc, (acc1[tm][tn][4 * q + 1] - acc2[tm][tn][4 * q + 1]) * sc);
              ou.y = pk_bf16((acc1[tm][tn][4 * q + 2] - acc2[tm][tn][4 * q + 2]) * sc, (acc1[tm][tn][4 * q + 3] - acc2[tm][tn][4 * q + 3]) * sc);
              *(uint2*)(d + 8 * q) = ou;
            }
          }
          if (kpos >= 1 && kpos <= 1023) {
            bf16_t* d = p.four_o + (size_t)(b * SEQ + 2048 - kpos) * 512 + moff;
#pragma unroll
            for (int q = 0; q < 4; ++q) {
              uint2 ou; ou.x = pk_bf16((acc1[tm][tn][4 * q] + acc2[tm][tn][4 * q]) * sc, (acc1[tm][tn][4 * q + 1] + acc2[tm][tn][4 * q + 1]) * sc);
              ou.y = pk_bf16((acc1[tm][tn][4 * q + 2] + acc2[tm][tn][4 * q + 2]) * sc, (acc1[tm][tn][4 * q + 3] + acc2[tm][tn][4 * q + 3]) * sc);
              *(uint2*)(d + 8 * q) = ou;
            }
          }
        }
    } else if (it < nDft + nAlt) {
      const int b = xcd * 4 + (it - nDft);
      for (int m = w; m < 512; m += NWV) {
        const bf16_t* rowp = p.ABt + (size_t)(b * 512 + m) * 4096 + lane * 8;
        float sacc = 0.f;
#pragma unroll
        for (int i = 0; i < 4; ++i) {
          const uint4 u = *(const uint4*)(rowp + 512 * i);
          sacc += (bf_lo(u.x) - bf_hi(u.x)) + (bf_lo(u.y) - bf_hi(u.y)) + (bf_lo(u.z) - bf_hi(u.z)) + (bf_lo(u.w) - bf_hi(u.w));
        }
        sacc = wave_sum(sacc);
        if (lane == 0) p.four_o[(size_t)(b * SEQ + 1024) * 512 + m] = f2bf(sacc * (1.f / 512.f));
      }
    } else {
      attn_item64(p, xcd * 128 + (it - nDft - nAlt), smem);
    }
  }
}

DI void phase5(const Params& p, char* smem) {
  const int t = tid_();
  const int xcd = blockIdx.x & 7, jl = blockIdx.x >> 3, nl = gridDim.x >> 3;
  for (int L = jl; L < 256; L += nl) {
    const int tokTile = xcd * 64 + (L >> 5) * 8 + (L & 7), nt = (L >> 3) & 3;
    f32x16 acc1[2][2], acc2[2][2];
#pragma unroll
    for (int a = 0; a < 2; ++a)
#pragma unroll
      for (int c = 0; c < 2; ++c) { acc1[a][c] = zero16(); acc2[a][c] = zero16(); }
    float dummy = 0.f;
    {
      const bf16_t* Ab = p.WoT + (size_t)nt * 256 * 512; const bf16_t* Bb = p.attn_o + (size_t)tokTile * 128 * 512;
      gemm8s3(acc1, [&](int row) { return Ab + (size_t)row * 512; }, [&](int row) { return Bb + (size_t)row * 512; }, 512, smem);
    }
    {
      const bf16_t* Ab = p.WfT + (size_t)nt * 256 * 512; const bf16_t* Bb = p.four_o + (size_t)tokTile * 128 * 512;
      gemm8s3(acc2, [&](int row) { return Ab + (size_t)row * 512; }, [&](int row) { return Bb + (size_t)row * 512; }, 512, smem);
    }
    {
      char* t1 = smem; char* t2 = smem + 128 * 528;
      const int ch = t & 31, r0 = t >> 5;
      stage_tile<2, 2, 4, 2>(acc1, t1, 528, [](float v) { return v; });
      stage_tile<2, 2, 4, 2>(acc2, t2, 528, [](float v) { return v; });
      lds_sync();
#pragma unroll
      for (int hb = 0; hb < 2; ++hb) {
        uint4 gav[4], gbv[4];
#pragma unroll
        for (int i = 0; i < 4; ++i) {
          const size_t tok = (size_t)tokTile * 128 + r0 + 16 * (hb * 4 + i);
          gav[i] = *(const uint4*)(p.pg + tok * 2048 + nt * 256 + ch * 8); gbv[i] = *(const uint4*)(p.pg + tok * 2048 + 1024 + nt * 256 + ch * 8);
        }
#pragma unroll
        for (int i = 0; i < 4; ++i) {
          const int row = r0 + 16 * (hb * 4 + i);
          const size_t tok = (size_t)tokTile * 128 + row;
          const uint4 u1 = *(const uint4*)(t1 + row * 528 + ch * 16), u2 = *(const uint4*)(t2 + row * 528 + ch * 16);
          const uint4 ga = gav[i], gb = gbv[i];
          uint4 o;
          o.x = pk_bf16(bf_lo(ga.x) * bf_lo(u1.x) + bf_lo(gb.x) * bf_lo(u2.x), bf_hi(ga.x) * bf_hi(u1.x) + bf_hi(gb.x) * bf_hi(u2.x));
          o.y = pk_bf16(bf_lo(ga.y) * bf_lo(u1.y) + bf_lo(gb.y) * bf_lo(u2.y), bf_hi(ga.y) * bf_hi(u1.y) + bf_hi(gb.y) * bf_hi(u2.y));
          o.z = pk_bf16(bf_lo(ga.z) * bf_lo(u1.z) + bf_lo(gb.z) * bf_lo(u2.z), bf_hi(ga.z) * bf_hi(u1.z) + bf_hi(gb.z) * bf_hi(u2.z));
          o.w = pk_bf16(bf_lo(ga.w) * bf_lo(u1.w) + bf_lo(gb.w) * bf_lo(u2.w), bf_hi(ga.w) * bf_hi(u1.w) + bf_hi(gb.w) * bf_hi(u2.w));
          *(uint4*)(p.m + tok * DM + nt * 256 + ch * 8) = o;
        }
      }
      lds_sync();
    }
  }
}

DI void phase6(const Params& p, char* smem) {
  const int t = tid_(), lane = t & 63, w = t >> 6, r = lane & 31, hh = lane >> 5;
  const int wm = w & 1, wn = w >> 1;
  const int xcd = blockIdx.x & 7, jl = blockIdx.x >> 3, nl = gridDim.x >> 3;
  for (int L = jl; L < 128; L += nl) {
    const int tokTile = xcd * 32 + (L >> 5) * 8 + (L & 7), nt = (L >> 3) & 3;
    f32x16 acc[4][2];
#pragma unroll
    for (int a = 0; a < 4; ++a)
#pragma unroll
      for (int c = 0; c < 2; ++c) acc[a][c] = zero16();
    float dummy = 0.f;
    const bf16_t* Wb = p.WoutT + (size_t)nt * 256 * DM; const bf16_t* Mb = p.m + (size_t)tokTile * 256 * DM;
    gemm8<4, 2, 2, 4, false>(acc, [&](int row) { return Wb + (size_t)row * DM; }, [&](int row) { return Mb + (size_t)row * DM; }, DM, smem, dummy);
    const int tc_ = tid_();
    const int ch = tc_ & 63, r0 = tc_ >> 6;
    const float4 g = *(const float4*)(p.mod + (tokTile >> 3) * 6144 + 2048 + nt * 256 + ch * 4);
#pragma unroll
    for (int tn = 0; tn < 2; ++tn) {
      const size_t obase = ((size_t)tokTile * 256 + tn * 32) * DM + nt * 256 + ch * 4;
#pragma unroll
      for (int tm = 0; tm < 4; ++tm) {
        char* d = smem + (wn * 32 + r) * 1040 + (wm * 128 + tm * 32 + 4 * hh) * 4;
#pragma unroll
        for (int q = 0; q < 4; ++q) *(float4*)(d + 32 * q) = make_float4(acc[tm][tn][4 * q], acc[tm][tn][4 * q + 1], acc[tm][tn][4 * q + 2], acc[tm][tn][4 * q + 3]);
      }
      lds_sync();
#pragma unroll
      for (int hb = 0; hb < 2; ++hb) {
        float4 xv[8];
#pragma unroll
        for (int i = 0; i < 8; ++i) {
          const int row = r0 + 8 * (hb * 8 + i);
          xv[i] = *(const float4*)(p.x + obase + (size_t)((row >> 5) * 64 + (row & 31)) * DM);
        }
#pragma unroll
        for (int i = 0; i < 8; ++i) {
          const int row = r0 + 8 * (hb * 8 + i);
          const float4 a = *(const float4*)(smem + row * 1040 + ch * 16);
          uint2 ob; ob.x = pk_bf16(xv[i].x + g.x * a.x, xv[i].y + g.y * a.y); ob.y = pk_bf16(xv[i].z + g.z * a.z, xv[i].w + g.w * a.w);
          *(uint2*)(p.x1b + obase + (size_t)((row >> 5) * 64 + (row & 31)) * DM) = ob;
        }
      }
      lds_sync();
    }
  }
}

DI void phase7(const Params& p, char* smem) {
  const int t = tid_(), lane = t & 63, w = t >> 6;
  float* wr = (float*)smem;
  for (int idx = t; idx < DM * NE; idx += NTH) { const int d = idx >> 4, e = idx & 15; wr[e * DM + d] = p.w_router[idx]; }
  __syncthreads();
  const int gw = blockIdx.x * NWV + w, nw = gridDim.x * NWV;
  auto router = [&](const float4 (&v)[4], int R) {
    asm volatile("" ::: "memory");
    float a[16];
#pragma unroll
    for (int e = 0; e < 16; ++e) {
      float s = 0.f;
#pragma unroll
      for (int i = 0; i < 4; ++i) { const float4 wv = *(const float4*)(wr + e * DM + lane * 4 + 256 * i); s += v[i].x * wv.x + v[i].y * wv.y + v[i].z * wv.z + v[i].w * wv.w; }
      a[e] = s;
      if ((e & 3) == 3) __builtin_amdgcn_sched_barrier(0);
    }
    float a8[8], a4[4], a2[2], a1;
    {
      const bool up = lane & 32;
#pragma unroll
      for (int j = 0; j < 8; ++j) { const float send = up ? a[j] : a[j + 8]; const float keep = up ? a[j + 8] : a[j]; a8[j] = keep + __shfl_xor(send, 32); }
    }
    {
      const bool up = lane & 16;
#pragma unroll
      for (int j = 0; j < 4; ++j) { const float send = up ? a8[j] : a8[j + 4]; const float keep = up ? a8[j + 4] : a8[j]; a4[j] = keep + __shfl_xor(send, 16); }
    }
    {
      const bool up = lane & 8;
#pragma unroll
      for (int j = 0; j < 2; ++j) { const float send = up ? a4[j] : a4[j + 2]; const float keep = up ? a4[j + 2] : a4[j]; a2[j] = keep + __shfl_xor(send, 8); }
    }
    {
      const bool up = lane & 4;
      const float send = up ? a2[0] : a2[1]; const float keep = up ? a2[1] : a2[0]; a1 = keep + __shfl_xor(send, 4);
    }
    a1 += __shfl_xor(a1, 2);
    a1 += __shfl_xor(a1, 1);
    float mx = a1;
#pragma unroll
    for (int o = 4; o <= 32; o <<= 1) mx = fmaxf(mx, __shfl_xor(mx, o));
    const float ex = __expf(a1 - mx);
    float sm = ex;
#pragma unroll
    for (int o = 4; o <= 32; o <<= 1) sm += __shfl_xor(sm, o);
    if ((lane & 3) == 0) {
      const int e = (lane >> 2) & 15;
      p.aff[((size_t)((R >> 11) * NE + e)) * SEQ + (R & 2047)] = ex / sm;
    }
  };
  for (int R0 = gw; R0 < NT; R0 += 2 * nw) {
    const int R1 = R0 + nw;
    const bool has1 = R1 < NT;
    const bf16_t* src0 = p.x1b + (size_t)R0 * DM;
    const bf16_t* src1 = p.x1b + (size_t)(has1 ? R1 : R0) * DM;
    const float* md0 = p.mod + (R0 >> 11) * 6144;
    const float* md1 = p.mod + ((has1 ? R1 : R0) >> 11) * 6144;
    float4 v0[4], v1[4]; float s0 = 0.f, s1 = 0.f;
#pragma unroll
    for (int i = 0; i < 4; ++i) {
      const uint2 u0 = *(const uint2*)(src0 + lane * 4 + 256 * i), u1 = *(const uint2*)(src1 + lane * 4 + 256 * i);
      v0[i] = make_float4(bf_lo(u0.x), bf_hi(u0.x), bf_lo(u0.y), bf_hi(u0.y)); v1[i] = make_float4(bf_lo(u1.x), bf_hi(u1.x), bf_lo(u1.y), bf_hi(u1.y));
    }
#pragma unroll
    for (int i = 0; i < 4; ++i) { s0 += v0[i].x * v0[i].x + v0[i].y * v0[i].y + v0[i].z * v0[i].z + v0[i].w * v0[i].w; s1 += v1[i].x * v1[i].x + v1[i].y * v1[i].y + v1[i].z * v1[i].z + v1[i].w * v1[i].w; }
    s0 = wave_sum(s0); s1 = wave_sum(s1);
    const float r0 = rsqrtf(s0 * (1.f / DM) + EPS), r1 = rsqrtf(s1 * (1.f / DM) + EPS);
#pragma unroll
    for (int i = 0; i < 4; ++i) {
      const int d = lane * 4 + 256 * i;
      const float4 g = *(const float4*)(p.norm2_g + d);
      {
        const float4 sh = *(const float4*)(md0 + 3072 + d), sc = *(const float4*)(md0 + 4096 + d);
        v0[i].x = v0[i].x * r0 * g.x * (1.f + sc.x) + sh.x; v0[i].y = v0[i].y * r0 * g.y * (1.f + sc.y) + sh.y;
        v0[i].z = v0[i].z * r0 * g.z * (1.f + sc.z) + sh.z; v0[i].w = v0[i].w * r0 * g.w * (1.f + sc.w) + sh.w;
        uint2 o; o.x = pk_bf16(v0[i].x, v0[i].y); o.y = pk_bf16(v0[i].z, v0[i].w);
        *(uint2*)(p.h2 + (size_t)R0 * DM + d) = o;
      }
      if (has1) {
        const float4 sh = *(const float4*)(md1 + 3072 + d), sc = *(const float4*)(md1 + 4096 + d);
        v1[i].x = v1[i].x * r1 * g.x * (1.f + sc.x) + sh.x; v1[i].y = v1[i].y * r1 * g.y * (1.f + sc.y) + sh.y;
        v1[i].z = v1[i].z * r1 * g.z * (1.f + sc.z) + sh.z; v1[i].w = v1[i].w * r1 * g.w * (1.f + sc.w) + sh.w;
        uint2 o; o.x = pk_bf16(v1[i].x, v1[i].y); o.y = pk_bf16(v1[i].z, v1[i].w);
        *(uint2*)(p.h2 + (size_t)R1 * DM + d) = o;
      }
    }
    SB_;
    router(v0, R0);
    SB_;
    if (has1) router(v1, R1);
    SB_;
  }
}

DI void phase8(const Params& p) {
  const int t_ = tid_(); const int lane = t_ & 63, w = t_ >> 6;
  const int gw = w * gridDim.x + blockIdx.x, nw = gridDim.x * NWV;
  for (int pr = gw; pr < NB * NE; pr += nw) {
    const float* a = p.aff + (size_t)pr * SEQ;
    unsigned u[32];
#pragma unroll
    for (int q = 0; q < 32; ++q) u[q] = __float_as_uint(a[q * 64 + lane]);
    unsigned thr = 0;
    for (int bit = 30; bit >= 0; --bit) {
      const unsigned cand = thr | (1u << bit);
      int cnt = 0;
#pragma unroll
      for (int q = 0; q < 32; ++q) cnt += __popcll(__ballot(u[q] >= cand));
      if (cnt >= CAP) thr = cand;
    }
    int ngt = 0;
#pragma unroll
    for (int q = 0; q < 32; ++q) ngt += __popcll(__ballot(u[q] > thr));
    int cgt = 0, ceq = 0;
    int* io = p.idx + pr * CAP; float* go = p.gate + pr * CAP;
    int* iv = p.inv + (size_t)pr * SEQ;
#pragma unroll
    for (int q = 0; q < 32; ++q) {
      const bool gt = u[q] > thr, eq = u[q] == thr;
      const unsigned long long mg = __ballot(gt), me = __ballot(eq);
      const unsigned long long below = (1ull << lane) - 1ull;
      int myslot = -1;
      if (gt) { const int s = cgt + __popcll(mg & below); io[s] = q * 64 + lane; go[s] = __uint_as_float(u[q]); myslot = s; }
      if (eq) { const int s = ngt + ceq + __popcll(me & below); if (s < CAP) { io[s] = q * 64 + lane; go[s] = __uint_as_float(u[q]); myslot = s; } }
      iv[q * 64 + lane] = myslot;
      cgt += __popcll(mg); ceq += __popcll(me);
    }
  }
}

DI void phase9(const Params& p, char* smem) {
  const int t = tid_(), lane = t & 63, w = t >> 6, r = lane & 31, hh = lane >> 5;
  const int wm = w & 1, wn = w >> 1;
  const int xcd = blockIdx.x & 7, jl = blockIdx.x >> 3, nl = gridDim.x >> 3;
  auto decode = [&](int L, int& e, int& ft, int& b) { e = xcd * 2 + (L >> 7); const int rem = L & 127; ft = (rem >> 3) & 3; b = (rem >> 5) * 8 + (rem & 7); };
  bool pre = false;
  for (int L = jl; L < 256; L += nl) {
    int e, ft, b, eN = 0, ftN = 0, bN = 0;
    decode(L, e, ft, b);
    const int Ln = L + nl; const bool hasNext = Ln < 256;
    if (hasNext) decode(Ln, eN, ftN, bN);
    const int be = b * NE + e;
    const bf16_t* Ab = p.WguT + ((size_t)e * 1024 + ft * 256) * DM;
    const int* ib = p.idx + be * CAP;
    const bf16_t* hb = p.h2 + (size_t)b * SEQ * DM;
    const bf16_t* AbN = p.WguT + ((size_t)eN * 1024 + ftN * 256) * DM;
    const int* ibN = p.idx + (bN * NE + eN) * CAP;
    const bf16_t* hbN = p.h2 + (size_t)bN * SEQ * DM;
    f32x16 acc[4][2];
#pragma unroll
    for (int a = 0; a < 4; ++a)
#pragma unroll
      for (int c = 0; c < 2; ++c) acc[a][c] = zero16();
    float dummy = 0.f;
    gemm8x<4, 2, 2, 4, false, 2>(acc, [&](int row) { return Ab + (size_t)row * DM; }, [&](int row) { return hb + (size_t)ib[row] * DM; }, DM, smem, dummy,
                              pre, hasNext, [&](int row) { return AbN + (size_t)row * DM; }, [&](int row) { return hbN + (size_t)ibN[row] * DM; });
    pre = hasNext;
    char* tile = smem + EPI_OFF;
#pragma unroll
    for (int tn = 0; tn < 2; ++tn)
#pragma unroll
      for (int pr = 0; pr < 2; ++pr) {
        char* d = tile + (wn * 64 + tn * 32 + r) * 272 + (wm * 64 + pr * 32 + 4 * hh) * 2;
#pragma unroll
        for (int q = 0; q < 4; ++q) {
          float v[4];
#pragma unroll
          for (int j = 0; j < 4; ++j) { const float g = acc[2 * pr][tn][4 * q + j], uu = acc[2 * pr + 1][tn][4 * q + j]; v[j] = g * sigmoidf_(g) * uu; }
          uint2 ou; ou.x = pk_bf16(v[0], v[1]); ou.y = pk_bf16(v[2], v[3]);
          *(uint2*)(d + 16 * q) = ou;
        }
      }
    lds_sync();
    bf16_t* hd_ = p.hmid + (size_t)be * CAP * DE + ft * 128;
    copy_tile(tile, 272, 256, 4, [&](int row) { return hd_ + (size_t)row * DE; }, 0, 16);
  }
}

DI void phase10(const Params& p, char* smem) {
  const int xcd = blockIdx.x & 7, jl = blockIdx.x >> 3, nl = gridDim.x >> 3;
  for (int L = jl; L < 512; L += nl) {
    const int e = xcd * 2 + (L >> 8), rem = L & 255, nt = (rem >> 3) & 3, st = (rem >> 5) & 1, b = (rem >> 6) * 8 + (rem & 7);
    const int be = b * NE + e;
    const bf16_t* Hb = p.hmid + ((size_t)be * CAP + st * 128) * DE;
    const bf16_t* Wb = p.WdT + ((size_t)e * DM + nt * 256) * DE;
    f32x16 acc[2][2];
#pragma unroll
    for (int a = 0; a < 2; ++a)
#pragma unroll
      for (int c = 0; c < 2; ++c) acc[a][c] = zero16();
    gemm8s3(acc, [&](int row) { return Wb + (size_t)row * DE; }, [&](int row) { return Hb + (size_t)row * DE; }, DE, smem);
    stage_tile<2, 2, 4, 2>(acc, smem, 528, [](float v) { return v; });
    lds_sync();
    bf16_t* yb = p.Y + ((size_t)be * CAP + st * 128) * DM + nt * 256;
    copy_tile(smem, 528, 128, 5, [&](int row) { return yb + (size_t)row * DM; }, 0, 32);
    lds_sync();
  }
}

DI void phase11(const Params& p) {
  const int t_ = tid_(); const int lane = t_ & 63, w = t_ >> 6;
  const int gw = blockIdx.x * NWV + w, nw = gridDim.x * NWV;
  auto slotOf = [&](int R) { return (lane < NE && R < NT) ? p.inv[((size_t)((R >> 11) * NE + lane)) * SEQ + (R & 2047)] : -1; };
  int nslot = slotOf(gw);
  uint2 nx[4];
  {
    const bf16_t* xs = p.x1b + (size_t)(gw < NT ? gw : 0) * DM + lane * 4;
#pragma unroll
    for (int i = 0; i < 4; ++i) nx[i] = *(const uint2*)(xs + 256 * i);
  }
  for (int R = gw; R < NT; R += nw) {
    const int b = R >> 11;
    const int myslot = nslot;
    uint2 xu[4];
#pragma unroll
    for (int i = 0; i < 4; ++i) xu[i] = nx[i];
    {
      const int Rn = R + nw;
      nslot = slotOf(Rn);
      const bf16_t* xs = p.x1b + (size_t)(Rn < NT ? Rn : 0) * DM + lane * 4;
#pragma unroll
      for (int i = 0; i < 4; ++i) nx[i] = *(const uint2*)(xs + 256 * i);
    }
    unsigned long long mask = __ballot(myslot >= 0);
    float4 a[4];
#pragma unroll
    for (int i = 0; i < 4; ++i) a[i] = make_float4(0.f, 0.f, 0.f, 0.f);
    while (mask) {
      const int e = __ffsll((long long)mask) - 1; mask &= mask - 1ull;
      const int slot = __shfl(myslot, e);
      const float g = p.gate[(b * NE + e) * CAP + slot];
      const bf16_t* y = p.Y + ((size_t)(b * NE + e) * CAP + slot) * DM + lane * 4;
#pragma unroll
      for (int i = 0; i < 4; ++i) {
        const uint2 u = *(const uint2*)(y + 256 * i);
        a[i].x += g * bf_lo(u.x); a[i].y += g * bf_hi(u.x); a[i].z += g * bf_lo(u.y); a[i].w += g * bf_hi(u.y);
      }
    }
    const float* g2 = p.mod + b * 6144 + 5120;
    float* o = p.out + (size_t)R * DM;
#pragma unroll
    for (int i = 0; i < 4; ++i) {
      const int d = lane * 4 + 256 * i;
      const float4 gv = *(const float4*)(g2 + d);
      *(float4*)(o + d) = make_float4(bf_lo(xu[i].x) + gv.x * a[i].x, bf_hi(xu[i].x) + gv.y * a[i].y, bf_lo(xu[i].y) + gv.z * a[i].z, bf_hi(xu[i].y) + gv.w * a[i].w);
    }
  }
}

__global__ void __launch_bounds__(NTH, 2) mega_kernel(Params p) {
  cg::grid_group grid = cg::this_grid();
  __shared__ __attribute__((aligned(16))) char smem[SMEM_BYTES];
#ifndef REPMASK
#define REPMASK 0
#endif
#define RUNPH(k, call) for (int rep_ = 0; rep_ < (((REPMASK) >> (k)) & 1) + 1; ++rep_) { call; grid.sync(); }
  RUNPH(0, phase0(p, smem))
  RUNPH(1, phase1(p))
  RUNPH(2, phase2(p, smem))
  RUNPH(3, phase3(p, smem))
  RUNPH(4, phase4(p, smem))
  RUNPH(5, phase5(p, smem))
  RUNPH(6, phase6(p, smem))
  RUNPH(7, phase7(p, smem))
  RUNPH(8, phase8(p))
  RUNPH(9, phase9(p, smem))
  RUNPH(10, phase10(p, smem))
  phase11(p);
}

static inline size_t align_up(size_t v, size_t a) { return (v + a - 1) / a * a; }

extern "C" void kernel_launch(void* const* d_in, const int* in_sizes, int n_in,
                              void* d_out, int out_size, void* d_ws, size_t ws_size,
                              hipStream_t stream) {
  static int grid_blocks = 0;
  if (!grid_blocks) {
    int dev = 0, cus = 0, per_cu = 0;
    (void)hipGetDevice(&dev);
    (void)hipDeviceGetAttribute(&cus, hipDeviceAttributeMultiprocessorCount, dev);
    (void)hipOccupancyMaxActiveBlocksPerMultiprocessor(&per_cu, mega_kernel, NTH, 0);
    if (per_cu > 1) per_cu = 1;
    if (per_cu < 1) per_cu = 1;
    grid_blocks = (cus * per_cu) & ~7;
    if (grid_blocks < 8) grid_blocks = 8;
  }
  Params p;
  memset(&p, 0, sizeof(p));
  p.x = (const float*)d_in[0]; p.c = (const float*)d_in[1]; p.ctx = (const float*)d_in[2]; p.c_ctx = (const float*)d_in[3];
  p.w_mod = (const float*)d_in[4]; p.b_mod = (const float*)d_in[5]; p.norm1_g = (const float*)d_in[6];
  const float* w_in = (const float*)d_in[7];
  const float* q_a_g = (const float*)d_in[8];
  const float* kv_a_g = (const float*)d_in[9];
  const float* w_q_up = (const float*)d_in[10];
  const float* w_kv_up = (const float*)d_in[11];
  p.q_norm_g = (const float*)d_in[12]; p.k_norm_g = (const float*)d_in[13];
  const float* w_o_attn = (const float*)d_in[14];
  const float* w_fourier = (const float*)d_in[15];
  const float* w_out = (const float*)d_in[16];
  p.norm2_g = (const float*)d_in[17]; p.w_router = (const float*)d_in[18];
  const float* w_e_gate = (const float*)d_in[19];
  const float* w_e_up = (const float*)d_in[20];
  const float* w_e_down = (const float*)d_in[21];
  p.out = (float*)d_out;

  char* base = (char*)d_ws; size_t off = 0;
  auto alloc = [&](size_t bytes) { char* q = base + off; off = align_up(off + bytes, 256); return q; };
  p.WinT = (bf16_t*)alloc((size_t)NINP * DM * 2);
  p.WqT = (bf16_t*)alloc((size_t)768 * QL * 2);
  p.WkvT = (bf16_t*)alloc((size_t)1024 * KVL * 2);
  p.WoT = (bf16_t*)alloc((size_t)DM * 512 * 2);
  p.WfT = (bf16_t*)alloc((size_t)DM * 512 * 2);
  p.WoutT = (bf16_t*)alloc((size_t)DM * DM * 2);
  p.WguT = (bf16_t*)alloc((size_t)NE * 1024 * DM * 2);
  p.WdT = (bf16_t*)alloc((size_t)NE * DM * DE * 2);
  p.chanT = (bf16_t*)alloc((size_t)256 * 128 * 2);
  p.posM = (bf16_t*)alloc((size_t)2 * 1152 * 2048 * 2);
  p.ropeTab = (float*)alloc(64 * 8 * 2 * 4);
  p.mod = (float*)alloc(33 * 6144 * 4);
  p.aff = (float*)alloc((size_t)NB * NE * SEQ * 4);
  p.gate = (float*)alloc((size_t)NB * NE * CAP * 4);
  p.idx = (int*)alloc((size_t)NB * NE * CAP * 4);
  p.inv = (int*)alloc((size_t)NB * NE * SEQ * 4);
  p.pckv = (bf16_t*)alloc((size_t)NC * LDCKV * 2 + 4096);
  char* regA = alloc((size_t)(NT + NC) * DM * 2);
  p.h = (bf16_t*)regA; p.ABt = (bf16_t*)regA; p.h2 = (bf16_t*)regA;
  char* regB1 = alloc((size_t)NT * LDQKV * 2);
  p.pqkv = (bf16_t*)regB1; p.attn_o = (bf16_t*)regB1;
  char* regB2 = alloc((size_t)NT * 512 * 2);
  p.pf = (bf16_t*)regB2; p.four_o = (bf16_t*)regB2;
  p.x1b = (bf16_t*)regB1;
  if ((size_t)(regB2 - regB1) + (size_t)NT * 512 * 2 < (size_t)NT * DM * 2) { fprintf(stderr, "x1b does not fit\n"); return; }
  p.pg = (bf16_t*)alloc((size_t)NT * 2048 * 2);
  p.Y = p.pg;
  const size_t szQ = (size_t)NB * NH * SEQ * QKD * 2, szK = (size_t)NB * NH * NKEY * QKD * 2, szV = (size_t)NB * NH * VD * NKEY * 2;
  char* regC = alloc(szQ + szK + szV + 1024);
  p.Q = (bf16_t*)regC; p.K = (bf16_t*)(regC + align_up(szQ, 256)); p.Vt = (bf16_t*)(regC + align_up(szQ, 256) + align_up(szK, 256));
  p.m = (bf16_t*)regC; p.hmid = (bf16_t*)(regC + (size_t)NT * DM * 2);
  if (off > ws_size) { fprintf(stderr, "workspace too small: need %zu have %zu\n", off, ws_size); return; }

  int ts = 0;
  auto job = [&](int i, const float* src, bf16_t* dst, const float* scale, int K, int ldS, int n_off, int n_cnt, int dst_row0, int mode, int batch, long sbs, long dbs) {
    TJob& j = p.jobs[i];
    j.src = src; j.dst = dst; j.scale = scale; j.K = K; j.ldS = ldS; j.n_off = n_off; j.n_cnt = n_cnt; j.dst_row0 = dst_row0; j.mode = mode; j.batch = batch;
    j.tiles_n = (n_cnt + 63) / 64; j.tile_start = ts; j.src_bstride = sbs; j.dst_bstride = dbs;
    ts += batch * (K / 64) * j.tiles_n;
  };
  job(0, w_e_gate, p.WguT, nullptr, DM, DE, 0, DE, 0, 1, NE, (long)DM * DE, (long)1024 * DM);
  job(1, w_e_up, p.WguT, nullptr, DM, DE, 0, DE, 0, 2, NE, (long)DM * DE, (long)1024 * DM);
  job(2, w_e_down, p.WdT, nullptr, DE, DM, 0, DM, 0, 0, NE, (long)DE * DM, (long)DM * DE);
  job(3, w_in, p.WinT, nullptr, DM, N_IN, 0, 672, 0, 0, 1, 0, 0);
  job(4, w_in, p.WinT, nullptr, DM, N_IN, 672, 2560, 768, 0, 1, 0, 0);
  job(5, w_q_up, p.WqT, q_a_g, QL, 768, 0, 768, 0, 0, 1, 0, 0);
  job(6, w_kv_up, p.WkvT, kv_a_g, KVL, 1024, 0, 1024, 0, 0, 1, 0, 0);
  job(7, w_o_attn, p.WoT, nullptr, 512, DM, 0, DM, 0, 0, 1, 0, 0);
  job(8, w_fourier, p.WfT, nullptr, 512, DM, 0, DM, 0, 0, 1, 0, 0);
  job(9, w_out, p.WoutT, nullptr, DM, DM, 0, DM, 0, 0, 1, 0, 0);
  p.n_ttiles = ts;

  void* args[] = {&p};
  hipError_t e = hipLaunchCooperativeKernel((void*)mega_kernel, dim3(grid_blocks), dim3(NTH), args, 0, stream);
  if (e != hipSuccess) fprintf(stderr, "cooperative launch failed: %s (grid %d)\n", hipGetErrorString(e), grid_blocks);
}
```

```cpp
#include <hip/hip_runtime.h>
#include <hip/hip_cooperative_groups.h>
#include <cstdio>
#include <cstring>
#include <cstdint>
namespace cg = cooperative_groups;

#define DI __device__ __forceinline__
typedef unsigned short bf16_t;
typedef short bf16x8 __attribute__((ext_vector_type(8)));
typedef float f32x16 __attribute__((ext_vector_type(16)));
#define MFMA(a, b, c) __builtin_amdgcn_mfma_f32_32x32x16_bf16((a), (b), (c), 0, 0, 0)

constexpr int NB = 32, SEQ = 2048, DM = 1024, NT = NB * SEQ, CTXL = 256, NC = NB * CTXL;
constexpr int NH = 8, QKD = 96, VD = 64, QL = 384, KVL = 256, NKEY = SEQ + CTXL;
constexpr int N_IN = 3232, NINP = 3328;
constexpr int NE = 16, DE = 512, CAP = 256;
constexpr float EPS = 1e-6f;
constexpr int LDQKV = 672, LDCKV = 288;
constexpr int NTH = 512, NWV = 8;
constexpr int SMEM_BYTES = 147456;

struct TJob {
  const float* src; bf16_t* dst; const float* scale;
  int K, ldS, n_off, n_cnt, dst_row0, mode, batch, tiles_n, tile_start, pad0;
  long src_bstride, dst_bstride;
};
constexpr int NJOBS = 10;

struct Params {
  const float *x, *c, *ctx, *c_ctx, *w_mod, *b_mod, *norm1_g, *q_norm_g, *k_norm_g, *norm2_g, *w_router;
  float* out;
  bf16_t *WinT, *WqT, *WkvT, *WoT, *WfT, *WoutT, *WguT, *WdT, *chanT, *posM;
  float *ropeTab, *mod;
  bf16_t *h, *pqkv, *pckv, *pf, *pg, *Q, *K, *Vt, *attn_o, *ABt, *four_o, *m, *h2, *hmid;
  float *aff, *gate;
  int* idx;
  int* inv;
  bf16_t* Y;
  bf16_t* x1b;
  TJob jobs[NJOBS];
  int n_ttiles, pad1;
};

typedef float f32x2v __attribute__((ext_vector_type(2)));
typedef __bf16 bf16x2v __attribute__((ext_vector_type(2)));
DI unsigned pk_bf16(float lo, float hi) { f32x2v v = {lo, hi}; bf16x2v b = __builtin_convertvector(v, bf16x2v); return __builtin_bit_cast(unsigned, b); }
DI int tid_() { int t = threadIdx.x; asm volatile("" : "+v"(t)); return t; }
DI float bf_lo(unsigned u) { return __uint_as_float(u << 16); }
DI float bf_hi(unsigned u) { return __uint_as_float(u & 0xffff0000u); }
DI bf16_t f2bf(float f) { return (bf16_t)(pk_bf16(f, 0.f) & 0xffffu); }
DI float sigmoidf_(float x) { return 1.f / (1.f + __expf(-x)); }
DI int crow(int i, int hh) { return (i & 3) + 8 * (i >> 2) + 4 * hh; }
DI float wave_sum(float v) {
#pragma unroll
  for (int o = 32; o >= 1; o >>= 1) v += __shfl_xor(v, o);
  return v;
}
DI f32x16 zero16() { f32x16 z;
#pragma unroll
  for (int i = 0; i < 16; ++i) z[i] = 0.f; return z; }
DI void wait_vm0() { asm volatile("s_waitcnt vmcnt(0)" ::: "memory"); }
DI void wait_lgkm0() { asm volatile("s_waitcnt lgkmcnt(0)" ::: "memory"); }
DI void bar_() { __builtin_amdgcn_s_barrier(); }
DI void lds_sync() { wait_lgkm0(); bar_(); }
#define GLDS(gp, lp) __builtin_amdgcn_global_load_lds((const unsigned*)(gp), (__attribute__((address_space(3))) unsigned*)(lp), 16, 0, 0)
#define SB_ __builtin_amdgcn_sched_barrier(0)

constexpr int EPI_OFF = 65536;
template <int TM, int TN, int WM, int WN, bool SUMSQ, int NST, class AF, class BF, class AFN, class BFN>
DI void gemm8x(f32x16 (&acc)[TM][TN], AF arow, BF brow, int K, char* smem, float& sumsq, bool pre, bool hasNext, AFN arowN, BFN browN) {
  constexpr int RA = 32 * TM * WM, RB = 32 * TN * WN;
  constexpr int LDR = 128, STAGE = (RA + RB) * LDR;
  static_assert(WM * WN == NWV, "waves");
  static_assert(NST * STAGE <= SMEM_BYTES, "smem");
  static_assert(NST == 2 || (NST == 3 && RA == 256 && RB == 128), "3-stage ring: 6 loads per thread per stage assumed");
  static_assert(RA <= 256 && RB <= 256 && RA % 32 == 0 && RB % 32 == 0, "shape");
  const int t = tid_(), lane = t & 63, w = t >> 6, r = lane & 31, hh = lane >> 5;
  const int wm = w % WM, wn = w / WM;
  const int row0 = t >> 3;
  const int c = (t & 7) ^ ((row0 >> 1) & 7);
  const bool a0v = row0 < RA, a1v = row0 + 64 < RA, a2v = row0 + 128 < RA, a3v = row0 + 192 < RA;
  const bool b0v = row0 < RB, b1v = row0 + 64 < RB, b2v = row0 + 128 < RB, b3v = row0 + 192 < RB;
  const bf16_t* pa0 = arow(a0v ? row0 : 0) + c * 8;
  const bf16_t* pa1 = arow(a1v ? row0 + 64 : 0) + c * 8;
  const bf16_t* pa2 = arow(a2v ? row0 + 128 : 0) + c * 8;
  const bf16_t* pa3 = arow(a3v ? row0 + 192 : 0) + c * 8;
  const bf16_t* pb0 = brow(b0v ? row0 : 0) + c * 8;
  const bf16_t* pb1 = brow(b1v ? row0 + 64 : 0) + c * 8;
  const bf16_t* pb2 = brow(b2v ? row0 + 128 : 0) + c * 8;
  const bf16_t* pb3 = brow(b3v ? row0 + 192 : 0) + c * 8;
  if (!pre) {
    char* l_ = smem + t * 16; char* m_ = l_ + RA * LDR;
    if (a0v) GLDS(pa0, l_); if (a1v) GLDS(pa1, l_ + 8192); if (a2v) GLDS(pa2, l_ + 16384); if (a3v) GLDS(pa3, l_ + 24576);
    if (b0v) GLDS(pb0, m_); if (b1v) GLDS(pb1, m_ + 8192); if (b2v) GLDS(pb2, m_ + 16384); if (b3v) GLDS(pb3, m_ + 24576);
  }
  if (NST == 3) {
    char* l_ = smem + STAGE + t * 16; char* m_ = l_ + RA * LDR;
    GLDS(pa0 + 64, l_); GLDS(pa1 + 64, l_ + 8192); GLDS(pa2 + 64, l_ + 16384); GLDS(pa3 + 64, l_ + 24576);
    GLDS(pb0 + 64, m_); GLDS(pb1 + 64, m_ + 8192);
    asm volatile("s_waitcnt vmcnt(6)" ::: "memory");
  } else wait_vm0();
  bar_();
  const int nk = K >> 6;
  const int sw = (r >> 1) & 7;
  const int aoff = (wm * TM * 32 + r) * LDR, boff = RA * LDR + (wn * TN * 32 + r) * LDR;
  auto compute = [&](const char* cur, char* nxt, bool issue, const bf16_t* q0, const bf16_t* q1, const bf16_t* q2, const bf16_t* q3,
                     const bf16_t* s0, const bf16_t* s1, const bf16_t* s2, const bf16_t* s3) {
    const char* As = cur + aoff;
    const char* Bs = cur + boff;
    char* l_ = nxt + t * 16; char* m_ = l_ + RA * LDR;
    bf16x8 a0[TM], b0[TN], a1[TM], b1[TN];
#define LOADF(A_, B_, ks) do { const int po_ = (((ks) * 2 + hh) ^ sw) * 16; \
      _Pragma("unroll") for (int tm = 0; tm < TM; ++tm) A_[tm] = *(const bf16x8*)(As + tm * 32 * LDR + po_); \
      _Pragma("unroll") for (int tn = 0; tn < TN; ++tn) B_[tn] = *(const bf16x8*)(Bs + tn * 32 * LDR + po_); } while (0)
#define MMF(A_, B_) do { if (SUMSQ) { uint4 u = __builtin_bit_cast(uint4, B_[0]); \
        float e0 = bf_lo(u.x), e1 = bf_hi(u.x), e2 = bf_lo(u.y), e3 = bf_hi(u.y), e4 = bf_lo(u.z), e5 = bf_hi(u.z), e6 = bf_lo(u.w), e7 = bf_hi(u.w); \
        sumsq += e0 * e0 + e1 * e1 + e2 * e2 + e3 * e3 + e4 * e4 + e5 * e5 + e6 * e6 + e7 * e7; } \
      _Pragma("unroll") for (int tm = 0; tm < TM; ++tm) _Pragma("unroll") for (int tn = 0; tn < TN; ++tn) acc[tm][tn] = MFMA(A_[tm], B_[tn], acc[tm][tn]); } while (0)
    LOADF(a0, b0, 0);
    LOADF(a1, b1, 1);
    SB_;
    if (issue) { if (a0v) GLDS(q0, l_); if (a1v) GLDS(q1, l_ + 8192); }
    SB_;
    __builtin_amdgcn_s_setprio(1);
    MMF(a0, b0);
    LOADF(a0, b0, 2);
    SB_;
    if (issue) { if (a2v) GLDS(q2, l_ + 16384); if (a3v) GLDS(q3, l_ + 24576); }
    SB_;
    MMF(a1, b1);
    LOADF(a1, b1, 3);
    SB_;
    if (issue) { if (b0v) GLDS(s0, m_); if (b1v) GLDS(s1, m_ + 8192); }
    SB_;
    MMF(a0, b0);
    SB_;
    if (issue) { if (b2v) GLDS(s2, m_ + 16384); if (b3v) GLDS(s3, m_ + 24576); }
    SB_;
    MMF(a1, b1);
    __builtin_amdgcn_s_setprio(0);
  };
  int sc_ = 0;
  for (int kt = 0; kt < nk - 1; ++kt) {
    SB_;
    if (NST == 2) {
      const int ko = (kt + 1) * 64;
      compute(smem + (kt & 1) * STAGE, smem + ((kt + 1) & 1) * STAGE, true, pa0 + ko, pa1 + ko, pa2 + ko, pa3 + ko, pb0 + ko, pb1 + ko, pb2 + ko, pb3 + ko);
      SB_;
      wait_vm0(); bar_();
    } else {
      const int ko = (kt + 2) * 64; const bool iss = kt + 2 < nk;
      const int sn = (sc_ == 0) ? 2 : sc_ - 1;
      compute(smem + sc_ * STAGE, smem + sn * STAGE, iss, pa0 + ko, pa1 + ko, pa2 + ko, pa3 + ko, pb0 + ko, pb1 + ko, pb2 + ko, pb3 + ko);
      SB_;
      if (iss) asm volatile("s_waitcnt vmcnt(6)" ::: "memory"); else wait_vm0();
      bar_();
      sc_ = (sc_ == 2) ? 0 : sc_ + 1;
    }
  }
  if (NST == 3) {
    SB_;
    compute(smem + sc_ * STAGE, smem, false, pa0, pa0, pa0, pa0, pa0, pa0, pa0, pa0);
    SB_;
    lds_sync();
  } else {
    const bf16_t *q0 = pa0, *q1 = pa0, *q2 = pa0, *q3 = pa0, *s0 = pa0, *s1 = pa0, *s2 = pa0, *s3 = pa0;
    if (hasNext) {
      q0 = arowN(a0v ? row0 : 0) + c * 8; q1 = arowN(a1v ? row0 + 64 : 0) + c * 8; q2 = arowN(a2v ? row0 + 128 : 0) + c * 8; q3 = arowN(a3v ? row0 + 192 : 0) + c * 8;
      s0 = browN(b0v ? row0 : 0) + c * 8; s1 = browN(b1v ? row0 + 64 : 0) + c * 8; s2 = browN(b2v ? row0 + 128 : 0) + c * 8; s3 = browN(b3v ? row0 + 192 : 0) + c * 8;
    }
    SB_;
    compute(smem + ((nk - 1) & 1) * STAGE, smem, hasNext, q0, q1, q2, q3, s0, s1, s2, s3);
    SB_;
    lds_sync();
  }
}
template <int TM, int TN, int WM, int WN, bool SUMSQ, class AF, class BF>
DI void gemm8(f32x16 (&acc)[TM][TN], AF arow, BF brow, int K, char* smem, float& sumsq) {
  gemm8x<TM, TN, WM, WN, SUMSQ, 2>(acc, arow, brow, K, smem, sumsq, false, false, arow, brow);
}
template <class AF, class BF>
DI void gemm8s3(f32x16 (&acc)[2][2], AF arow, BF brow, int K, char* smem) {
  float dummy = 0.f;
  gemm8x<2, 2, 4, 2, false, 3>(acc, arow, brow, K, smem, dummy, false, false, arow, brow);
}
template <int TM, int WM, int WN, int TNSEL, class F>
DI void stage_half(const f32x16 (&acc)[TM][2], char* tile, int pitch, F f) {
  const int t = tid_(), lane = t & 63, w = t >> 6, r = lane & 31, hh = lane >> 5;
  const int wm = w % WM, wn = w / WM;
#pragma unroll
  for (int tm = 0; tm < TM; ++tm) {
    char* d = tile + (wn * 32 + r) * pitch + (wm * TM * 32 + tm * 32 + 4 * hh) * 2;
#pragma unroll
    for (int q = 0; q < 4; ++q) {
      const f32x16& a = acc[tm][TNSEL];
      uint2 o; o.x = pk_bf16(f(a[4 * q]), f(a[4 * q + 1])); o.y = pk_bf16(f(a[4 * q + 2]), f(a[4 * q + 3]));
      *(uint2*)(d + 16 * q) = o;
    }
  }
}

template <int TM, int TN, int WM, int WN, class F>
DI void stage_tile(const f32x16 (&acc)[TM][TN], char* tile, int pitch, F f) {
  const int t = tid_(), lane = t & 63, w = t >> 6, r = lane & 31, hh = lane >> 5;
  const int wm = w % WM, wn = w / WM;
#pragma unroll
  for (int tm = 0; tm < TM; ++tm)
#pragma unroll
    for (int tn = 0; tn < TN; ++tn) {
      char* d = tile + (wn * TN * 32 + tn * 32 + r) * pitch + (wm * TM * 32 + tm * 32 + 4 * hh) * 2;
#pragma unroll
      for (int q = 0; q < 4; ++q) {
        uint2 o; o.x = pk_bf16(f(acc[tm][tn][4 * q]), f(acc[tm][tn][4 * q + 1])); o.y = pk_bf16(f(acc[tm][tn][4 * q + 2]), f(acc[tm][tn][4 * q + 3]));
        *(uint2*)(d + 16 * q) = o;
      }
    }
}
template <class RF>
DI void copy_tile(const char* tile, int pitch, int rows, int lch, RF dst, int ch0, int ch1) {
  const int t = tid_();
  const int total = rows << lch;
  for (int id = t; id < total; id += NTH) {
    const int row = id >> lch, ch = id & ((1 << lch) - 1);
    if (ch >= ch0 && ch < ch1) *(uint4*)(dst(row) + ch * 8) = *(const uint4*)(tile + row * pitch + ch * 16);
  }
}

struct TTile { const float* src; const float* scale; bf16_t* dst; int K, ldS, n0, n_cnt, k0, dst_row0, mode; };
DI TTile ttile_decode(const Params& p, int u) {
  int jb = 0;
#pragma unroll 1
  for (int q = 1; q < NJOBS; ++q) if (u >= p.jobs[q].tile_start) jb = q;
  const TJob& j = p.jobs[jb];
  const int tile = u - j.tile_start;
  const int tpb = (j.K >> 6) * j.tiles_n;
  const int bi = tile / tpb, rem = tile % tpb;
  const int kt = rem / j.tiles_n, ntile = rem % j.tiles_n;
  TTile tt;
  tt.src = j.src + (size_t)bi * j.src_bstride + j.n_off; tt.scale = j.scale; tt.dst = j.dst + (size_t)bi * j.dst_bstride;
  tt.K = j.K; tt.ldS = j.ldS; tt.n0 = ntile * 64; tt.n_cnt = j.n_cnt; tt.k0 = kt * 64; tt.dst_row0 = j.dst_row0; tt.mode = j.mode;
  return tt;
}
DI void ttile_load(const TTile& tt, int t, float (&v)[8]) {
  const int nn = t & 63, kq = t >> 6;
  const bool nvalid = (tt.n0 + nn) < tt.n_cnt;
#pragma unroll
  for (int i = 0; i < 8; ++i) {
    const int kk = kq + 8 * i;
    float x = 0.f;
    if (nvalid) { x = tt.src[(size_t)(tt.k0 + kk) * tt.ldS + tt.n0 + nn]; if (tt.scale) x *= tt.scale[tt.k0 + kk]; }
    v[i] = x;
  }
}
DI void ttile_store(const TTile& tt, int t, const float (&v)[8], char* smem) {
  bf16_t* T = (bf16_t*)smem;
  const int nn = t & 63, kq = t >> 6;
#pragma unroll
  for (int i = 0; i < 8; ++i) T[nn * 66 + kq + 8 * i] = f2bf(v[i]);
  __syncthreads();
  const int n = t >> 3, part = t & 7;
  if (tt.n0 + n < tt.n_cnt) {
    const unsigned* tp = (const unsigned*)(T + n * 66 + part * 8);
    uint4 o0; o0.x = tp[0]; o0.y = tp[1]; o0.z = tp[2]; o0.w = tp[3];
    const int f = tt.n0 + n;
    int drow;
    if (tt.mode == 0) drow = tt.dst_row0 + f;
    else drow = (f >> 7) * 256 + ((f >> 6) & 1) * 128 + (((f >> 5) & 1) * 2 + (tt.mode == 2 ? 1 : 0)) * 32 + (f & 31);
    *(uint4*)(tt.dst + (size_t)drow * tt.K + tt.k0 + part * 8) = o0;
  }
  __syncthreads();
}

DI void mod_item(const Params& p, int it, char* smem) {
  const int t = tid_(), cgi = t & 15, kg = t >> 4;
  const int j0 = it * 16;
  float* Ssm = (float*)smem;
  float* red = (float*)(smem + 33 * 128 * 4);
  float acc[33];
#pragma unroll
  for (int r = 0; r < 33; ++r) acc[r] = 0.f;
  const float* wp = p.w_mod + (size_t)(kg * 4) * 6144 + j0 + cgi;
  float n0 = wp[0], n1 = wp[6144], n2 = wp[2 * 6144], n3 = wp[3 * 6144];
#pragma unroll 1
  for (int kc = 0; kc < 8; ++kc) {
    __syncthreads();
    for (int idx = t; idx < 33 * 128; idx += NTH) {
      const int r = idx >> 7, kk = idx & 127;
      float v = (r < 32) ? p.c[r * DM + kc * 128 + kk] : p.c_ctx[kc * 128 + kk];
      Ssm[idx] = v * sigmoidf_(v);
    }
    const float w0 = n0, w1 = n1, w2 = n2, w3 = n3;
    if (kc < 7) { const float* wq = wp + (size_t)(kc + 1) * 128 * 6144; n0 = wq[0]; n1 = wq[6144]; n2 = wq[2 * 6144]; n3 = wq[3 * 6144]; }
    __syncthreads();
#pragma unroll
    for (int r = 0; r < 33; ++r) {
      const float4 s = *(const float4*)(Ssm + r * 128 + kg * 4);
      acc[r] += s.x * w0 + s.y * w1 + s.z * w2 + s.w * w3;
    }
  }
  __syncthreads();
#pragma unroll
  for (int r = 0; r < 33; ++r) red[(kg * 33 + r) * 16 + cgi] = acc[r];
  __syncthreads();
  for (int idx = t; idx < 33 * 16; idx += NTH) {
    const int r = idx >> 4, cc = idx & 15;
    float s = 0.f;
#pragma unroll
    for (int g = 0; g < 32; ++g) s += red[(g * 33 + r) * 16 + cc];
    p.mod[r * 6144 + j0 + cc] = s + p.b_mod[j0 + cc];
  }
}

DI void phase0(const Params& p, char* smem) {
  const int t = tid_();
  const int nMod = 384;
  const int nPos = 288;
  const int nMisc = 3;
  const int nT = p.n_ttiles;
  const int total = nMod + nPos + nMisc;
  float* ctab = (float*)(smem + 98304);
  for (int j = t; j < 2048; j += NTH) ctab[j] = cospif((float)j * (1.f / 1024.f));
  __syncthreads();
  for (int it = blockIdx.x; it < total; it += gridDim.x) {
    if (it < nMod) { mod_item(p, it, smem); continue; }
    int u = it - nMod;
    if (u < nPos) {
      for (int e = t; e < 8 * 256; e += NTH) {
        const int R = u * 8 + (e >> 8), c8 = (e & 255) * 8;
        const int part = R >= 1152 ? 1 : 0, k = R - part * 1152;
        float v[8];
#pragma unroll
        for (int q = 0; q < 8; ++q) {
          const int tt = c8 + q;
          v[q] = (k > 1024) ? 0.f : (part ? ctab[(k * tt - 512) & 2047] : ctab[(k * tt) & 2047]);
        }
        uint4 o; o.x = pk_bf16(v[0], v[1]); o.y = pk_bf16(v[2], v[3]); o.z = pk_bf16(v[4], v[5]); o.w = pk_bf16(v[6], v[7]);
        *(uint4*)(p.posM + (size_t)R * 2048 + c8) = o;
      }
      continue;
    }
    u -= nPos;
    if (u == 0) {
      for (int e = t; e < 256 * 128; e += NTH) {
        const int m2 = e >> 7, cc = e & 127, mm = m2 & 127;
        float v = (m2 < 128) ? ctab[(mm * cc * 16) & 2047] : ctab[(mm * cc * 16 - 512) & 2047];
        p.chanT[e] = f2bf(v);
      }
    } else if (u == 1) {
      for (int e = t; e < 64 * 8; e += NTH) {
        const int pos = e >> 3, jf = e & 7;
        const float inv = 1.0f / powf(10000.0f, (float)jf / 8.0f);
        const float ang = (float)pos * inv;
        p.ropeTab[e * 2 + 0] = cosf(ang);
        p.ropeTab[e * 2 + 1] = sinf(ang);
      }
    } else {
      uint4 z; z.x = z.y = z.z = z.w = 0u;
      uint4* dp = (uint4*)(p.WinT + (size_t)672 * DM);
      for (int e = t; e < 96 * DM / 8; e += NTH) dp[e] = z;
    }
  }
  __syncthreads();
  {
    const int G = gridDim.x;
    int u = (int)((blockIdx.x + 128u) % (unsigned)G);
    float vn[8];
    TTile tn_ = ttile_decode(p, u < nT ? u : 0);
    if (u < nT) ttile_load(tn_, t, vn);
    for (; u < nT; u += G) {
      const TTile tc = tn_;
      float vc[8];
#pragma unroll
      for (int i = 0; i < 8; ++i) vc[i] = vn[i];
      if (u + G < nT) { tn_ = ttile_decode(p, u + G); ttile_load(tn_, t, vn); }
      ttile_store(tc, t, vc, smem);
    }
  }
}

DI void phase1(const Params& p) {
  const int t_ = tid_(); const int lane = t_ & 63, w = t_ >> 6;
  const int gw = blockIdx.x * NWV + w, nw = gridDim.x * NWV;
  for (int R0 = gw; R0 < NT + NC; R0 += 2 * nw) {
    const int R1 = R0 + nw; const bool has1 = R1 < NT + NC;
    const float* src0 = (R0 < NT) ? p.x + (size_t)R0 * DM : p.ctx + (size_t)(R0 - NT) * DM;
    const float* src1 = has1 ? ((R1 < NT) ? p.x + (size_t)R1 * DM : p.ctx + (size_t)(R1 - NT) * DM) : src0;
    const float* md0 = p.mod + ((R0 < NT) ? (R0 >> 11) : 32) * 6144;
    const float* md1 = p.mod + ((has1 && R1 < NT) ? (R1 >> 11) : 32) * 6144;
    float4 v0[4], v1[4]; float s0 = 0.f, s1 = 0.f;
#pragma unroll
    for (int i = 0; i < 4; ++i) { v0[i] = *(const float4*)(src0 + lane * 4 + 256 * i); v1[i] = *(const float4*)(src1 + lane * 4 + 256 * i); }
#pragma unroll
    for (int i = 0; i < 4; ++i) { s0 += v0[i].x * v0[i].x + v0[i].y * v0[i].y + v0[i].z * v0[i].z + v0[i].w * v0[i].w; s1 += v1[i].x * v1[i].x + v1[i].y * v1[i].y + v1[i].z * v1[i].z + v1[i].w * v1[i].w; }
    s0 = wave_sum(s0); s1 = wave_sum(s1);
    const float r0 = rsqrtf(s0 * (1.f / DM) + EPS), r1 = rsqrtf(s1 * (1.f / DM) + EPS);
#pragma unroll
    for (int i = 0; i < 4; ++i) {
      const int d = lane * 4 + 256 * i;
      const float4 g = *(const float4*)(p.norm1_g + d);
      {
        const float4 sh = *(const float4*)(md0 + d), sc = *(const float4*)(md0 + 1024 + d);
        uint2 o; o.x = pk_bf16(v0[i].x * r0 * g.x * (1.f + sc.x) + sh.x, v0[i].y * r0 * g.y * (1.f + sc.y) + sh.y);
        o.y = pk_bf16(v0[i].z * r0 * g.z * (1.f + sc.z) + sh.z, v0[i].w * r0 * g.w * (1.f + sc.w) + sh.w);
        *(uint2*)(p.h + (size_t)R0 * DM + d) = o;
      }
      if (has1) {
        const float4 sh = *(const float4*)(md1 + d), sc = *(const float4*)(md1 + 1024 + d);
        uint2 o; o.x = pk_bf16(v1[i].x * r1 * g.x * (1.f + sc.x) + sh.x, v1[i].y * r1 * g.y * (1.f + sc.y) + sh.y);
        o.y = pk_bf16(v1[i].z * r1 * g.z * (1.f + sc.z) + sh.z, v1[i].w * r1 * g.w * (1.f + sc.w) + sh.w);
        *(uint2*)(p.h + (size_t)R1 * DM + d) = o;
      }
    }
  }
}

DI void phase2(const Params& p, char* smem) {
  const int xcd = blockIdx.x & 7, jl = blockIdx.x >> 3, nl = gridDim.x >> 3;
  auto decode = [&](int L, int& tokTile, int& ft) {
    if (L < 416) { const int tg = L / 104, rem = L % 104; ft = rem >> 3; tokTile = xcd * 32 + tg * 8 + (rem & 7); }
    else { const int u = L - 416; tokTile = 256 + xcd * 4 + (u >> 1); ft = 1 + (u & 1); }
  };
  bool pre = false;
  for (int L = jl; L < 416 + 8; L += nl) {
    int tokTile, ft, tokTileN = 0, ftN = 0;
    decode(L, tokTile, ft);
    const bool lat = L < 416;
    const int Ln = L + nl; const bool hasNext = Ln < 416 + 8;
    if (hasNext) decode(Ln, tokTileN, ftN);
    f32x16 acc[4][2];
#pragma unroll
    for (int a = 0; a < 4; ++a)
#pragma unroll
      for (int b = 0; b < 2; ++b) acc[a][b] = zero16();
    const bf16_t* Ab = p.WinT + (size_t)ft * 256 * DM;
    const bf16_t* Bb = p.h + (size_t)tokTile * 256 * DM;
    const bf16_t* AbN = p.WinT + (size_t)ftN * 256 * DM;
    const bf16_t* BbN = p.h + (size_t)tokTileN * 256 * DM;
    float dummy = 0.f;
    gemm8x<4, 2, 2, 4, false, 2>(acc, [&](int row) { return Ab + (size_t)row * DM; }, [&](int row) { return Bb + (size_t)row * DM; }, DM, smem, dummy,
                              pre, hasNext, [&](int row) { return AbN + (size_t)row * DM; }, [&](int row) { return BbN + (size_t)row * DM; });
    pre = hasNext;
    char* tile = smem + EPI_OFF;
    bf16_t* base; int ld, c0 = 0, c1 = 32;
    if (lat) {
      const size_t tok0 = (size_t)tokTile * 256;
      if (ft < 3) { base = p.pqkv + tok0 * LDQKV + ft * 256; ld = LDQKV; if (ft == 2) c1 = 20; }
      else if (ft < 5) { base = p.pf + tok0 * 512 + (ft - 3) * 256; ld = 512; }
      else { base = p.pg + tok0 * 2048 + (ft - 5) * 256; ld = 2048; }
    } else {
      const size_t ct0 = (size_t)(tokTile - 256) * 256;
      base = p.pckv + ct0 * LDCKV + ft * 256 - 384; ld = LDCKV;
      if (ft == 1) c0 = 16; else c1 = 20;
    }
    if (ft >= 5) stage_half<4, 2, 4, 0>(acc, tile, 528, [](float v) { return sigmoidf_(v); });
    else stage_half<4, 2, 4, 0>(acc, tile, 528, [](float v) { return v; });
    lds_sync();
    copy_tile(tile, 528, 128, 5, [&](int rl) { return base + (size_t)((rl >> 5) * 64 + (rl & 31)) * ld; }, c0, c1);
    lds_sync();
    if (ft >= 5) stage_half<4, 2, 4, 1>(acc, tile, 528, [](float v) { return sigmoidf_(v); });
    else stage_half<4, 2, 4, 1>(acc, tile, 528, [](float v) { return v; });
    lds_sync();
    copy_tile(tile, 528, 128, 5, [&](int rl) { return base + (size_t)((rl >> 5) * 64 + 32 + (rl & 31)) * ld; }, c0, c1);
  }
}

DI void rope_pair(float& x1, float& x2, const float* tab) { const float c = tab[0], s = tab[1]; const float a = x1 * c - x2 * s, b = x2 * c + x1 * s; x1 = a; x2 = b; }

DI void phase3(const Params& p, char* smem) {
  const int t = tid_(), lane = t & 63, w = t >> 6, r = lane & 31, hh = lane >> 5;
  const int nKV = 288, nQ = 256, nCh = 128;
  const int xcd = blockIdx.x & 7, jl = blockIdx.x >> 3, nl = gridDim.x >> 3;
  for (int it = jl; it < nKV + nQ + nCh; it += nl) {
    if (it < nKV) {
      const int tl_ = it >> 3, hd = it & 7;
      const bool lat = tl_ < 32;
      const bf16_t* Bb; int ldb; const bf16_t* kpeb;
      int b, key0;
      if (lat) { const int tokTile = xcd * 32 + tl_; Bb = p.pqkv + (size_t)tokTile * 256 * LDQKV + QL; ldb = LDQKV; kpeb = p.pqkv + (size_t)tokTile * 256 * LDQKV + 640; b = tokTile >> 3; key0 = (tokTile & 7) * 256; }
      else { const int ct = xcd * 4 + (tl_ - 32); Bb = p.pckv + (size_t)ct * 256 * LDCKV; ldb = LDCKV; kpeb = Bb + 256; b = ct; key0 = SEQ; }
      const bf16_t* Ab = p.WkvT + (size_t)hd * 128 * KVL;
      f32x16 acc[4][1];
#pragma unroll
      for (int a = 0; a < 4; ++a) acc[a][0] = zero16();
      float sumsq = 0.f;
      gemm8<4, 1, 1, 8, true>(acc, [&](int row) { return Ab + (size_t)row * KVL; }, [&](int row) { return Bb + (size_t)row * ldb; }, KVL, smem, sumsq);
      sumsq += __shfl_xor(sumsq, 32);
      const float ra = rsqrtf(sumsq * (1.f / KVL) + EPS);
      const int tl = w * 32 + r;
      const int key = key0 + tl;
      float kp[16];
#pragma unroll
      for (int q = 0; q < 4; ++q) {
        const uint2 u = *(const uint2*)(kpeb + (size_t)tl * ldb + 8 * q + 4 * hh);
        kp[4 * q + 0] = bf_lo(u.x); kp[4 * q + 1] = bf_hi(u.x); kp[4 * q + 2] = bf_lo(u.y); kp[4 * q + 3] = bf_hi(u.y);
      }
      float ss = 0.f;
#pragma unroll
      for (int tm = 0; tm < 4; ++tm)
#pragma unroll
        for (int i = 0; i < 16; ++i) { const float v = acc[tm][0][i] * ra; acc[tm][0][i] = v; if (tm < 2) ss += v * v; }
#pragma unroll
      for (int i = 0; i < 16; ++i) ss += kp[i] * kp[i];
      ss += __shfl_xor(ss, 32);
      const float rk = rsqrtf(ss * (1.f / QKD) + EPS);
#pragma unroll
      for (int i = 0; i < 16; ++i) kp[i] *= rk * p.k_norm_g[64 + crow(i, hh)];
      if (lat) {
        const int pos = key;
        const float* tr = p.ropeTab + ((pos >> 6) * 8 + 4 * hh) * 2;
        const float* tc = p.ropeTab + ((pos & 63) * 8 + 4 * hh) * 2;
#pragma unroll
        for (int i = 0; i < 4; ++i) { rope_pair(kp[i], kp[i + 4], tr + 2 * i); rope_pair(kp[8 + i], kp[12 + i], tc + 2 * i); }
      }
      {
        char* kt_ = smem; char* vt_ = smem + 256 * 208;
        char* kd = kt_ + tl * 208;
#pragma unroll
        for (int tm = 0; tm < 2; ++tm)
#pragma unroll
          for (int q = 0; q < 4; ++q) {
            const int f = tm * 32 + 8 * q + 4 * hh;
            const float4 g = *(const float4*)(p.k_norm_g + f);
            uint2 o; o.x = pk_bf16(acc[tm][0][4 * q] * rk * g.x, acc[tm][0][4 * q + 1] * rk * g.y); o.y = pk_bf16(acc[tm][0][4 * q + 2] * rk * g.z, acc[tm][0][4 * q + 3] * rk * g.w);
            *(uint2*)(kd + f * 2) = o;
          }
#pragma unroll
        for (int q = 0; q < 4; ++q) {
          uint2 o; o.x = pk_bf16(kp[4 * q], kp[4 * q + 1]); o.y = pk_bf16(kp[4 * q + 2], kp[4 * q + 3]);
          *(uint2*)(kd + (64 + 8 * q + 4 * hh) * 2) = o;
        }
#pragma unroll
        for (int tm = 2; tm < 4; ++tm)
#pragma unroll
          for (int i = 0; i < 16; ++i) *(bf16_t*)(vt_ + ((tm - 2) * 32 + crow(i, hh)) * 528 + tl * 2) = f2bf(acc[tm][0][i]);
        lds_sync();
        const int tc_ = tid_();
        bf16_t* Kg = p.K + ((size_t)(b * NH + hd) * NKEY + key0) * QKD;
#pragma unroll
        for (int i = 0; i < 6; ++i) {
          const int id = tc_ + NTH * i, row = id / 12, ch = id % 12;
          *(uint4*)(Kg + row * QKD + ch * 8) = *(const uint4*)(kt_ + row * 208 + ch * 16);
        }
        bf16_t* Vg = p.Vt + (size_t)(b * NH + hd) * VD * NKEY + key0;
#pragma unroll
        for (int i = 0; i < 4; ++i) {
          const int row = (tc_ >> 5) + 16 * i, ch = tc_ & 31;
          *(uint4*)(Vg + (size_t)row * NKEY + ch * 8) = *(const uint4*)(vt_ + row * 528 + ch * 16);
        }
        lds_sync();
      }
    } else if (it < nKV + nQ) {
      const int u = it - nKV;
      const int tokTile = xcd * 32 + (u >> 3), hd = u & 7;
      const bf16_t* Bb = p.pqkv + (size_t)tokTile * 256 * LDQKV;
      const bf16_t* Ab = p.WqT + (size_t)hd * QKD * QL;
      f32x16 acc[3][1];
#pragma unroll
      for (int a = 0; a < 3; ++a) acc[a][0] = zero16();
      float sumsq = 0.f;
      gemm8<3, 1, 1, 8, true>(acc, [&](int row) { return Ab + (size_t)row * QL; }, [&](int row) { return Bb + (size_t)row * LDQKV; }, QL, smem, sumsq);
      sumsq += __shfl_xor(sumsq, 32);
      const float ra = rsqrtf(sumsq * (1.f / QL) + EPS);
      const int tl = w * 32 + r;
      const int b = tokTile >> 3, pos = (tokTile & 7) * 256 + tl;
      float ss = 0.f;
#pragma unroll
      for (int tm = 0; tm < 3; ++tm)
#pragma unroll
        for (int i = 0; i < 16; ++i) { const float v = acc[tm][0][i] * ra; acc[tm][0][i] = v; ss += v * v; }
      ss += __shfl_xor(ss, 32);
      const float rh = rsqrtf(ss * (1.f / QKD) + EPS);
#pragma unroll
      for (int tm = 0; tm < 3; ++tm)
#pragma unroll
        for (int q = 0; q < 4; ++q) {
          const float4 g = *(const float4*)(p.q_norm_g + tm * 32 + 8 * q + 4 * hh);
          acc[tm][0][4 * q] *= rh * g.x; acc[tm][0][4 * q + 1] *= rh * g.y; acc[tm][0][4 * q + 2] *= rh * g.z; acc[tm][0][4 * q + 3] *= rh * g.w;
        }
      {
        const float* tr = p.ropeTab + ((pos >> 6) * 8 + 4 * hh) * 2;
        const float* tc = p.ropeTab + ((pos & 63) * 8 + 4 * hh) * 2;
#pragma unroll
        for (int i = 0; i < 4; ++i) {
          float a0 = acc[2][0][i], a1 = acc[2][0][i + 4], c0 = acc[2][0][8 + i], c1 = acc[2][0][12 + i];
          rope_pair(a0, a1, tr + 2 * i); rope_pair(c0, c1, tc + 2 * i);
          acc[2][0][i] = a0; acc[2][0][i + 4] = a1; acc[2][0][8 + i] = c0; acc[2][0][12 + i] = c1;
        }
      }
      const float qs = 0.10206207261596575f * 1.4426950408889634f;
      {
        char* qd = smem + tl * 208;
#pragma unroll
        for (int tm = 0; tm < 3; ++tm)
#pragma unroll
          for (int q = 0; q < 4; ++q) {
            uint2 o; o.x = pk_bf16(acc[tm][0][4 * q] * qs, acc[tm][0][4 * q + 1] * qs); o.y = pk_bf16(acc[tm][0][4 * q + 2] * qs, acc[tm][0][4 * q + 3] * qs);
            *(uint2*)(qd + (tm * 32 + 8 * q + 4 * hh) * 2) = o;
          }
        lds_sync();
        const int tc_ = tid_();
        bf16_t* Qg = p.Q + ((size_t)(b * NH + hd) * SEQ + (tokTile & 7) * 256) * QKD;
#pragma unroll
        for (int i = 0; i < 6; ++i) {
          const int id = tc_ + NTH * i, row = id / 12, ch = id % 12;
          *(uint4*)(Qg + row * QKD + ch * 8) = *(const uint4*)(smem + row * 208 + ch * 16);
        }
        lds_sync();
      }
    } else {
      const int u = it - nKV - nQ;
      const int tt = u & 7, g = (u >> 3) & 3, b = xcd * 4 + (u >> 5);
      const bf16_t* Tb = p.chanT;
      const bf16_t* Fb = p.pf + (size_t)(b * SEQ + tt * 256) * 512 + g * 128;
      f32x16 acc[4][2];
#pragma unroll
      for (int a = 0; a < 4; ++a)
#pragma unroll
        for (int c = 0; c < 2; ++c) acc[a][c] = zero16();
      float dummy = 0.f;
      gemm8<4, 2, 2, 4, false>(acc, [&](int row) { return Fb + (size_t)row * 512; }, [&](int row) { return Tb + (size_t)row * 128; }, 128, smem, dummy);
      stage_tile<4, 2, 2, 4>(acc, smem, 528, [](float v) { return v; });
      lds_sync();
      bf16_t* dst0 = p.ABt + ((size_t)(b * 512 + g * 128)) * 4096 + tt * 256;
      copy_tile(smem, 528, 256, 5, [&](int row) { return dst0 + (size_t)(row & 127) * 4096 + (row >> 7) * 2048; }, 0, 32);
      lds_sync();
    }
  }
}

DI void attn_item(const Params& p, int it, char* smem) {
  const int t = tid_(), lane = t & 63, w = t >> 6, r = lane & 31, hh = lane >> 5;
  const int qt = it & 7, bh = it >> 3;
  constexpr int KROW = 208, VROW = 136, KBYTES = 64 * KROW, STAGE = KBYTES + 64 * VROW;
  const bf16_t* Kb = p.K + (size_t)bh * NKEY * QKD;
  const bf16_t* Vb = p.Vt + (size_t)bh * VD * NKEY;
  const int qpos = qt * 256 + w * 32 + r;
  const bf16_t* Qp = p.Q + ((size_t)bh * SEQ + qpos) * QKD + hh * 8;
  bf16x8 qf[6];
#pragma unroll
  for (int c = 0; c < 6; ++c) qf[c] = *(const bf16x8*)(Qp + c * 16);
  f32x16 o[2]; o[0] = zero16(); o[1] = zero16();
  float gk = 0.f;
  for (int f = 0; f < QKD; ++f) gk = fmaxf(gk, fabsf(p.k_norm_g[f]));
  float qss = 0.f;
#pragma unroll
  for (int c = 0; c < 6; ++c) {
    const uint4 u = __builtin_bit_cast(uint4, qf[c]);
    const float e0 = bf_lo(u.x), e1 = bf_hi(u.x), e2 = bf_lo(u.y), e3 = bf_hi(u.y), e4 = bf_lo(u.z), e5 = bf_hi(u.z), e6 = bf_lo(u.w), e7 = bf_hi(u.w);
    qss += e0 * e0 + e1 * e1 + e2 * e2 + e3 * e3 + e4 * e4 + e5 * e5 + e6 * e6 + e7 * e7;
  }
  qss += __shfl_xor(qss, 32);
  const float negC = -(sqrtf(qss) * gk * 9.797959f * 1.01f);
  f32x16 sinit;
#pragma unroll
  for (int i = 0; i < 16; ++i) sinit[i] = negC;
  float lrun = 0.f;
  const int kid0 = t, kid1 = (t & 255) + 512;
  const bool k1v = t < 256;
  const int kgo0 = (kid0 / 12) * QKD + (kid0 % 12) * 8, kgo1 = (kid1 / 12) * QKD + (kid1 % 12) * 8;
  const int klo0 = (kid0 / 12) * KROW + (kid0 % 12) * 16, klo1 = (kid1 / 12) * KROW + (kid1 % 12) * 16;
  const int vgo0 = (t >> 3) * NKEY + (t & 7) * 8;
  const int vlo0 = KBYTES + (t >> 3) * VROW + (t & 7) * 16;
  uint4 rk0, rk1, rv0;
  rk0 = *(const uint4*)(Kb + kgo0); rk1 = *(const uint4*)(Kb + kgo1);
  rv0 = *(const uint4*)(Vb + vgo0);
  SB_;
#define ATT_STORE(base) do { \
    *(uint4*)((base) + klo0) = rk0; if (k1v) *(uint4*)((base) + klo1) = rk1; \
    { uint2* d = (uint2*)((base) + vlo0); d[0] = make_uint2(rv0.x, rv0.y); d[1] = make_uint2(rv0.z, rv0.w); } } while (0)
  ATT_STORE(smem);
  __syncthreads();
  constexpr int NKT = NKEY / 64;
  for (int kt = 0; kt < NKT; ++kt) {
    const char* cur = smem + (kt & 1) * STAGE;
    const bool more = kt + 1 < NKT;
    if (more) {
      const bf16_t* kn = Kb + (size_t)(kt + 1) * 64 * QKD; const bf16_t* vn = Vb + (kt + 1) * 64;
      rk0 = *(const uint4*)(kn + kgo0); rk1 = *(const uint4*)(kn + kgo1);
      rv0 = *(const uint4*)(vn + vgo0);
    }
    SB_;
    f32x16 s[2];
#pragma unroll
    for (int t2 = 0; t2 < 2; ++t2) {
      const char* kp = cur + (t2 * 32 + r) * KROW + hh * 16;
      { const bf16x8 kf = *(const bf16x8*)(kp); s[t2] = MFMA(kf, qf[0], sinit); }
#pragma unroll
      for (int c = 1; c < 6; ++c) { const bf16x8 kf = *(const bf16x8*)(kp + c * 32); s[t2] = MFMA(kf, qf[c], s[t2]); }
    }
    SB_;
    float ls = 0.f;
#pragma unroll
    for (int t2 = 0; t2 < 2; ++t2)
#pragma unroll
      for (int i = 0; i < 16; ++i) { const float e = __builtin_amdgcn_exp2f(s[t2][i]); s[t2][i] = e; ls += e; }
    lrun += ls;
    SB_;
#pragma unroll
    for (int t2 = 0; t2 < 2; ++t2)
#pragma unroll
      for (int s2 = 0; s2 < 2; ++s2) {
        uint4 pu;
        pu.x = pk_bf16(s[t2][8 * s2 + 0], s[t2][8 * s2 + 1]); pu.y = pk_bf16(s[t2][8 * s2 + 2], s[t2][8 * s2 + 3]);
        pu.z = pk_bf16(s[t2][8 * s2 + 4], s[t2][8 * s2 + 5]); pu.w = pk_bf16(s[t2][8 * s2 + 6], s[t2][8 * s2 + 7]);
        const bf16x8 pb = __builtin_bit_cast(bf16x8, pu);
#pragma unroll
        for (int vt = 0; vt < 2; ++vt) {
          const char* vp = cur + KBYTES + (vt * 32 + r) * VROW + (t2 * 32 + 16 * s2 + 4 * hh) * 2;
          const uint2 lo = *(const uint2*)(vp), hi = *(const uint2*)(vp + 16);
          uint4 vu; vu.x = lo.x; vu.y = lo.y; vu.z = hi.x; vu.w = hi.y;
          o[vt] = MFMA(__builtin_bit_cast(bf16x8, vu), pb, o[vt]);
        }
      }
    SB_;
    if (more) { char* nxt = smem + ((kt + 1) & 1) * STAGE; ATT_STORE(nxt); }
    __syncthreads();
  }
  lrun += __shfl_xor(lrun, 32);
  const float inv = 1.f / lrun;
  const int b = bh >> 3, hd = bh & 7;
  bf16_t* od = p.attn_o + (size_t)(b * SEQ + qpos) * 512 + hd * 64;
#pragma unroll
  for (int vt = 0; vt < 2; ++vt)
#pragma unroll
    for (int q = 0; q < 4; ++q) {
      uint2 ou; ou.x = pk_bf16(o[vt][4 * q] * inv, o[vt][4 * q + 1] * inv); ou.y = pk_bf16(o[vt][4 * q + 2] * inv, o[vt][4 * q + 3] * inv);
      *(uint2*)(od + vt * 32 + 8 * q + 4 * hh) = ou;
    }
}

DI void attn_item64(const Params& p, int it, char* smem) {
  const int t = tid_(), lane = t & 63, w = t >> 6, r = lane & 31, hh = lane >> 5;
  const int qt = it & 3, bh = it >> 2;
  constexpr int KROW = 192, VROW = 136, KBYTES = 64 * KROW, STAGE = KBYTES + 64 * VROW;
  const bf16_t* Kb = p.K + (size_t)bh * NKEY * QKD;
  const bf16_t* Vb = p.Vt + (size_t)bh * VD * NKEY;
  const int qposa = qt * 512 + w * 64 + r, qposb = qposa + 32;
  const bf16_t* Qa = p.Q + ((size_t)bh * SEQ + qposa) * QKD + hh * 8;
  bf16x8 qfa[6], qfb[6];
#pragma unroll
  for (int c = 0; c < 6; ++c) { qfa[c] = *(const bf16x8*)(Qa + c * 16); qfb[c] = *(const bf16x8*)(Qa + 32 * QKD + c * 16); }
  f32x16 oa[2], ob[2]; oa[0] = zero16(); oa[1] = zero16(); ob[0] = zero16(); ob[1] = zero16();
  float gk = 0.f;
  for (int f = 0; f < QKD; ++f) gk = fmaxf(gk, fabsf(p.k_norm_g[f]));
  float qsa = 0.f, qsb = 0.f;
#pragma unroll
  for (int c = 0; c < 6; ++c) {
    const uint4 u = __builtin_bit_cast(uint4, qfa[c]), v = __builtin_bit_cast(uint4, qfb[c]);
    qsa += bf_lo(u.x) * bf_lo(u.x) + bf_hi(u.x) * bf_hi(u.x) + bf_lo(u.y) * bf_lo(u.y) + bf_hi(u.y) * bf_hi(u.y) + bf_lo(u.z) * bf_lo(u.z) + bf_hi(u.z) * bf_hi(u.z) + bf_lo(u.w) * bf_lo(u.w) + bf_hi(u.w) * bf_hi(u.w);
    qsb += bf_lo(v.x) * bf_lo(v.x) + bf_hi(v.x) * bf_hi(v.x) + bf_lo(v.y) * bf_lo(v.y) + bf_hi(v.y) * bf_hi(v.y) + bf_lo(v.z) * bf_lo(v.z) + bf_hi(v.z) * bf_hi(v.z) + bf_lo(v.w) * bf_lo(v.w) + bf_hi(v.w) * bf_hi(v.w);
  }
  qsa += __shfl_xor(qsa, 32); qsb += __shfl_xor(qsb, 32);
  const float negC = -(sqrtf(fmaxf(qsa, qsb)) * gk * 9.797959f * 1.01f);
  f32x16 sinit;
#pragma unroll
  for (int i = 0; i < 16; ++i) sinit[i] = negC;
  float la = 0.f, lb = 0.f;
  const int kid0 = t, kid1 = (t & 255) + 512;
  const bool k1v = t < 256;
  const int kgo0 = (kid0 / 12) * QKD + (((kid0 % 12) ^ (((kid0 / 12) >> 2) & 3))) * 8, kgo1 = (kid1 / 12) * QKD + (((kid1 % 12) ^ (((kid1 / 12) >> 2) & 3))) * 8;
  const int klo0 = kid0 * 16, klo1 = kid1 * 16;
  const int vgo0 = (t >> 3) * NKEY + (t & 7) * 8;
  const int vlo0 = KBYTES + (t >> 3) * VROW + (t & 7) * 16;
  uint4 rv0;
  GLDS(Kb + kgo0, smem + klo0); if (k1v) GLDS(Kb + kgo1, smem + klo1);
  rv0 = *(const uint4*)(Vb + vgo0);
  SB_;
#define ATT64_STORE(base) do { \
    { uint2* d = (uint2*)((base) + vlo0); d[0] = make_uint2(rv0.x, rv0.y); d[1] = make_uint2(rv0.z, rv0.w); } } while (0)
  ATT64_STORE(smem);
  __syncthreads();
  const int sw = (r >> 2) & 3;
  const int sb32 = ((sw >> 1) & 1) * 32;
  const int swo = ((hh ^ (sw & 1)) << 4) + sb32;
  constexpr int NKT = NKEY / 64;
  for (int kt = 0; kt < NKT; ++kt) {
    const char* cur = smem + (kt & 1) * STAGE;
    const bool more = kt + 1 < NKT;
    if (more) {
      const bf16_t* kn = Kb + (size_t)(kt + 1) * 64 * QKD; const bf16_t* vn = Vb + (kt + 1) * 64;
      char* nx = smem + ((kt + 1) & 1) * STAGE;
      GLDS(kn + kgo0, nx + klo0); if (k1v) GLDS(kn + kgo1, nx + klo1);
      rv0 = *(const uint4*)(vn + vgo0);
    }
    SB_;
#pragma unroll
    for (int t2 = 0; t2 < 2; ++t2) {
      const char* kpe = cur + (t2 * 32 + r) * KROW + swo;
      const char* kpo = kpe - 2 * sb32;
      f32x16 sa, sb;
      { const bf16x8 kf = *(const bf16x8*)(kpe); sa = MFMA(kf, qfa[0], sinit); sb = MFMA(kf, qfb[0], sinit); }
#pragma unroll
      for (int c = 1; c < 6; ++c) { const bf16x8 kf = *(const bf16x8*)(((c & 1) ? kpo : kpe) + c * 32); sa = MFMA(kf, qfa[c], sa); sb = MFMA(kf, qfb[c], sb); }
      SB_;
      float lsa = 0.f, lsb = 0.f;
#pragma unroll
      for (int i = 0; i < 16; ++i) { const float e = __builtin_amdgcn_exp2f(sa[i]); sa[i] = e; lsa += e; const float f = __builtin_amdgcn_exp2f(sb[i]); sb[i] = f; lsb += f; }
      la += lsa; lb += lsb;
      SB_;
#pragma unroll
      for (int s2 = 0; s2 < 2; ++s2) {
        uint4 pu, pv;
        pu.x = pk_bf16(sa[8 * s2 + 0], sa[8 * s2 + 1]); pu.y = pk_bf16(sa[8 * s2 + 2], sa[8 * s2 + 3]); pu.z = pk_bf16(sa[8 * s2 + 4], sa[8 * s2 + 5]); pu.w = pk_bf16(sa[8 * s2 + 6], sa[8 * s2 + 7]);
        pv.x = pk_bf16(sb[8 * s2 + 0], sb[8 * s2 + 1]); pv.y = pk_bf16(sb[8 * s2 + 2], sb[8 * s2 + 3]); pv.z = pk_bf16(sb[8 * s2 + 4], sb[8 * s2 + 5]); pv.w = pk_bf16(sb[8 * s2 + 6], sb[8 * s2 + 7]);
        const bf16x8 pa_ = __builtin_bit_cast(bf16x8, pu), pb_ = __builtin_bit_cast(bf16x8, pv);
#pragma unroll
        for (int vt = 0; vt < 2; ++vt) {
          const char* vp = cur + KBYTES + (vt * 32 + r) * VROW + (t2 * 32 + 16 * s2 + 4 * hh) * 2;
          const uint2 lo = *(const uint2*)(vp), hi = *(const uint2*)(vp + 16);
          uint4 vu; vu.x = lo.x; vu.y = lo.y; vu.z = hi.x; vu.w = hi.y;
          const bf16x8 vf = __builtin_bit_cast(bf16x8, vu);
          oa[vt] = MFMA(vf, pa_, oa[vt]);
          ob[vt] = MFMA(vf, pb_, ob[vt]);
        }
      }
      SB_;
    }
    SB_;
    if (more) { char* nxt = smem + ((kt + 1) & 1) * STAGE; ATT64_STORE(nxt); }
    __syncthreads();
  }
  la += __shfl_xor(la, 32); lb += __shfl_xor(lb, 32);
  const float inva = 1.f / la, invb = 1.f / lb;
  const int b = bh >> 3, hd = bh & 7;
  const int te_ = tid_();
  bf16_t* oda = p.attn_o + (size_t)(b * SEQ + qt * 512 + (te_ >> 6) * 64 + (te_ & 31)) * 512 + hd * 64;
  bf16_t* odb = oda + (size_t)32 * 512;
#pragma unroll
  for (int vt = 0; vt < 2; ++vt)
#pragma unroll
    for (int q = 0; q < 4; ++q) {
      uint2 ou; ou.x = pk_bf16(oa[vt][4 * q] * inva, oa[vt][4 * q + 1] * inva); ou.y = pk_bf16(oa[vt][4 * q + 2] * inva, oa[vt][4 * q + 3] * inva);
      *(uint2*)(oda + vt * 32 + 8 * q + 4 * hh) = ou;
      uint2 ov; ov.x = pk_bf16(ob[vt][4 * q] * invb, ob[vt][4 * q + 1] * invb); ov.y = pk_bf16(ob[vt][4 * q + 2] * invb, ob[vt][4 * q + 3] * invb);
      *(uint2*)(odb + vt * 32 + 8 * q + 4 * hh) = ov;
    }
}

DI void phase4(const Params& p, char* smem) {
  const int t = tid_(), lane = t & 63, w = t >> 6, r = lane & 31, hh = lane >> 5;
  const int nDft = 64, nAlt = 4, nAtt = 128;
  const int xcd = blockIdx.x & 7, jl = blockIdx.x >> 3, nl = gridDim.x >> 3;
  for (int it = jl; it < nDft + nAlt + nAtt; it += nl) {
    if (it < nDft) {
      const int bl = it >> 4, rem = it & 15, ct = rem >> 3, kt = rem & 7, b = xcd * 4 + bl;
      const int wm = w & 3, wn = w >> 2;
      const bf16_t* Ab = p.ABt + (size_t)(b * 512 + ct * 256) * 4096;
      const bf16_t* Cb = p.posM + (size_t)kt * 128 * 2048;
      const bf16_t* Sb = p.posM + (size_t)(1152 + kt * 128) * 2048;
      f32x16 acc1[2][2], acc2[2][2];
#pragma unroll
      for (int a = 0; a < 2; ++a)
#pragma unroll
        for (int c = 0; c < 2; ++c) { acc1[a][c] = zero16(); acc2[a][c] = zero16(); }
      float dummy = 0.f;
      gemm8s3(acc1, [&](int row) { return Ab + (size_t)row * 4096; }, [&](int row) { return Cb + (size_t)row * 2048; }, 2048, smem);
      gemm8s3(acc2, [&](int row) { return Ab + (size_t)row * 4096 + 2048; }, [&](int row) { return Sb + (size_t)row * 2048; }, 2048, smem);
      const float sc = 1.f / 512.f;
#pragma unroll
      for (int tm = 0; tm < 2; ++tm)
#pragma unroll
        for (int tn = 0; tn < 2; ++tn) {
          const int kpos = kt * 128 + wn * 64 + tn * 32 + r;
          const int moff = ct * 256 + wm * 64 + tm * 32 + 4 * hh;
          if (kpos <= 1024) {
            bf16_t* d = p.four_o + (size_t)(b * SEQ + kpos) * 512 + moff;
#pragma unroll
            for (int q = 0; q < 4; ++q) {
              uint2 ou; ou.x = pk_bf16((acc1[tm][tn][4 * q] - acc2[tm][tn][4 * q]) * sc, (acc1[tm][tn][4 * q + 1] - acc2[tm][tn][4 * q + 1]) * sc);
              ou.y = pk_bf16((acc1[tm][tn][4 * q + 2] - acc2[tm][tn][4 * q + 2]) * sc, (acc1[tm][tn][4 * q + 3] - acc2[tm][tn][4 * q + 3]) * sc);
              *(uint2*)(d + 8 * q) = ou;
            }
          }
          if (kpos >= 1 && kpos <= 1023) {
            bf16_t* d = p.four_o + (size_t)(b * SEQ + 2048 - kpos) * 512 + moff;
#pragma unroll
            for (int q = 0; q < 4; ++q) {
              uint2 ou; ou.x = pk_bf16((acc1[tm][tn][4 * q] + acc2[tm][tn][4 * q]) * sc, (acc1[tm][tn][4 * q + 1] + acc2[tm][tn][4 * q + 1]) * sc);
              ou.y = pk_bf16((acc1[tm][tn][4 * q + 2] + acc2[tm][tn][4 * q + 2]) * sc, (acc1[tm][tn][4 * q + 3] + acc2[tm][tn][4 * q + 3]) * sc);
              *(uint2*)(d + 8 * q) = ou;
            }
          }
        }
    } else if (it < nDft + nAlt) {
      const int b = xcd * 4 + (it - nDft);
      const int tl_ = tid_();
      const int lane_ = tl_ & 63;
      for (int m = tl_ >> 6; m < 512; m += NWV) {
        const bf16_t* rowp = p.ABt + (size_t)(b * 512 + m) * 4096 + lane_ * 8;
        float sacc = 0.f;
#pragma unroll
        for (int i = 0; i < 4; ++i) {
          const uint4 u = *(const uint4*)(rowp + 512 * i);
          sacc += (bf_lo(u.x) - bf_hi(u.x)) + (bf_lo(u.y) - bf_hi(u.y)) + (bf_lo(u.z) - bf_hi(u.z)) + (bf_lo(u.w) - bf_hi(u.w));
        }
        sacc = wave_sum(sacc);
        if (lane_ == 0) p.four_o[(size_t)(b * SEQ + 1024) * 512 + m] = f2bf(sacc * (1.f / 512.f));
      }
    } else {
      attn_item64(p, xcd * 128 + (it - nDft - nAlt), smem);
    }
  }
}

DI void phase5(const Params& p, char* smem) {
  const int t = tid_();
  const int xcd = blockIdx.x & 7, jl = blockIdx.x >> 3, nl = gridDim.x >> 3;
  for (int L = jl; L < 256; L += nl) {
    const int tokTile = xcd * 64 + (L >> 5) * 8 + (L & 7), nt = (L >> 3) & 3;
    f32x16 acc1[2][2], acc2[2][2];
#pragma unroll
    for (int a = 0; a < 2; ++a)
#pragma unroll
      for (int c = 0; c < 2; ++c) { acc1[a][c] = zero16(); acc2[a][c] = zero16(); }
    float dummy = 0.f;
    {
      const bf16_t* Ab = p.WoT + (size_t)nt * 256 * 512; const bf16_t* Bb = p.attn_o + (size_t)tokTile * 128 * 512;
      gemm8s3(acc1, [&](int row) { return Ab + (size_t)row * 512; }, [&](int row) { return Bb + (size_t)row * 512; }, 512, smem);
    }
    {
      const bf16_t* Ab = p.WfT + (size_t)nt * 256 * 512; const bf16_t* Bb = p.four_o + (size_t)tokTile * 128 * 512;
      gemm8s3(acc2, [&](int row) { return Ab + (size_t)row * 512; }, [&](int row) { return Bb + (size_t)row * 512; }, 512, smem);
    }
    {
      char* t1 = smem; char* t2 = smem + 128 * 528;
      const int ch = t & 31, r0 = t >> 5;
      stage_tile<2, 2, 4, 2>(acc1, t1, 528, [](float v) { return v; });
      stage_tile<2, 2, 4, 2>(acc2, t2, 528, [](float v) { return v; });
      lds_sync();
#pragma unroll
      for (int hb = 0; hb < 2; ++hb) {
        uint4 gav[4], gbv[4];
#pragma unroll
        for (int i = 0; i < 4; ++i) {
          const size_t tok = (size_t)tokTile * 128 + r0 + 16 * (hb * 4 + i);
          gav[i] = *(const uint4*)(p.pg + tok * 2048 + nt * 256 + ch * 8); gbv[i] = *(const uint4*)(p.pg + tok * 2048 + 1024 + nt * 256 + ch * 8);
        }
#pragma unroll
        for (int i = 0; i < 4; ++i) {
          const int row = r0 + 16 * (hb * 4 + i);
          const size_t tok = (size_t)tokTile * 128 + row;
          const uint4 u1 = *(const uint4*)(t1 + row * 528 + ch * 16), u2 = *(const uint4*)(t2 + row * 528 + ch * 16);
          const uint4 ga = gav[i], gb = gbv[i];
          uint4 o;
          o.x = pk_bf16(bf_lo(ga.x) * bf_lo(u1.x) + bf_lo(gb.x) * bf_lo(u2.x), bf_hi(ga.x) * bf_hi(u1.x) + bf_hi(gb.x) * bf_hi(u2.x));
          o.y = pk_bf16(bf_lo(ga.y) * bf_lo(u1.y) + bf_lo(gb.y) * bf_lo(u2.y), bf_hi(ga.y) * bf_hi(u1.y) + bf_hi(gb.y) * bf_hi(u2.y));
          o.z = pk_bf16(bf_lo(ga.z) * bf_lo(u1.z) + bf_lo(gb.z) * bf_lo(u2.z), bf_hi(ga.z) * bf_hi(u1.z) + bf_hi(gb.z) * bf_hi(u2.z));
          o.w = pk_bf16(bf_lo(ga.w) * bf_lo(u1.w) + bf_lo(gb.w) * bf_lo(u2.w), bf_hi(ga.w) * bf_hi(u1.w) + bf_hi(gb.w) * bf_hi(u2.w));
          *(uint4*)(p.m + tok * DM + nt * 256 + ch * 8) = o;
        }
      }
      lds_sync();
    }
  }
}

DI void phase6(const Params& p, char* smem) {
  const int t = tid_(), lane = t & 63, w = t >> 6, r = lane & 31, hh = lane >> 5;
  const int wm = w & 1, wn = w >> 1;
  const int xcd = blockIdx.x & 7, jl = blockIdx.x >> 3, nl = gridDim.x >> 3;
  for (int L = jl; L < 128; L += nl) {
    const int tokTile = xcd * 32 + (L >> 5) * 8 + (L & 7), nt = (L >> 3) & 3;
    f32x16 acc[4][2];
#pragma unroll
    for (int a = 0; a < 4; ++a)
#pragma unroll
      for (int c = 0; c < 2; ++c) acc[a][c] = zero16();
    float dummy = 0.f;
    const bf16_t* Wb = p.WoutT + (size_t)nt * 256 * DM; const bf16_t* Mb = p.m + (size_t)tokTile * 256 * DM;
    gemm8<4, 2, 2, 4, false>(acc, [&](int row) { return Wb + (size_t)row * DM; }, [&](int row) { return Mb + (size_t)row * DM; }, DM, smem, dummy);
    const int tc_ = tid_();
    const int ch = tc_ & 63, r0 = tc_ >> 6;
    const float4 g = *(const float4*)(p.mod + (tokTile >> 3) * 6144 + 2048 + nt * 256 + ch * 4);
#pragma unroll
    for (int tn = 0; tn < 2; ++tn) {
      const size_t obase = ((size_t)tokTile * 256 + tn * 32) * DM + nt * 256 + ch * 4;
#pragma unroll
      for (int tm = 0; tm < 4; ++tm) {
        char* d = smem + (wn * 32 + r) * 1040 + (wm * 128 + tm * 32 + 4 * hh) * 4;
#pragma unroll
        for (int q = 0; q < 4; ++q) *(float4*)(d + 32 * q) = make_float4(acc[tm][tn][4 * q], acc[tm][tn][4 * q + 1], acc[tm][tn][4 * q + 2], acc[tm][tn][4 * q + 3]);
      }
      lds_sync();
#pragma unroll
      for (int hb = 0; hb < 2; ++hb) {
        float4 xv[8];
#pragma unroll
        for (int i = 0; i < 8; ++i) {
          const int row = r0 + 8 * (hb * 8 + i);
          xv[i] = *(const float4*)(p.x + obase + (size_t)((row >> 5) * 64 + (row & 31)) * DM);
        }
#pragma unroll
        for (int i = 0; i < 8; ++i) {
          const int row = r0 + 8 * (hb * 8 + i);
          const float4 a = *(const float4*)(smem + row * 1040 + ch * 16);
          uint2 ob; ob.x = pk_bf16(xv[i].x + g.x * a.x, xv[i].y + g.y * a.y); ob.y = pk_bf16(xv[i].z + g.z * a.z, xv[i].w + g.w * a.w);
          *(uint2*)(p.x1b + obase + (size_t)((row >> 5) * 64 + (row & 31)) * DM) = ob;
        }
      }
      lds_sync();
    }
  }
}

DI void phase7(const Params& p, char* smem) {
  const int t = tid_(), lane = t & 63, w = t >> 6;
  float* wr = (float*)smem;
  for (int idx = t; idx < DM * NE; idx += NTH) { const int d = idx >> 4, e = idx & 15; wr[e * DM + d] = p.w_router[idx]; }
  __syncthreads();
  const int gw = blockIdx.x * NWV + w, nw = gridDim.x * NWV;
  auto router = [&](const float4 (&v)[4], int R) {
    asm volatile("" ::: "memory");
    float a[16];
#pragma unroll
    for (int e = 0; e < 16; ++e) {
      float s = 0.f;
#pragma unroll
      for (int i = 0; i < 4; ++i) { const float4 wv = *(const float4*)(wr + e * DM + lane * 4 + 256 * i); s += v[i].x * wv.x + v[i].y * wv.y + v[i].z * wv.z + v[i].w * wv.w; }
      a[e] = s;
      if ((e & 3) == 3) __builtin_amdgcn_sched_barrier(0);
    }
    float a8[8], a4[4], a2[2], a1;
    {
      const bool up = lane & 32;
#pragma unroll
      for (int j = 0; j < 8; ++j) { const float send = up ? a[j] : a[j + 8]; const float keep = up ? a[j + 8] : a[j]; a8[j] = keep + __shfl_xor(send, 32); }
    }
    {
      const bool up = lane & 16;
#pragma unroll
      for (int j = 0; j < 4; ++j) { const float send = up ? a8[j] : a8[j + 4]; const float keep = up ? a8[j + 4] : a8[j]; a4[j] = keep + __shfl_xor(send, 16); }
    }
    {
      const bool up = lane & 8;
#pragma unroll
      for (int j = 0; j < 2; ++j) { const float send = up ? a4[j] : a4[j + 2]; const float keep = up ? a4[j + 2] : a4[j]; a2[j] = keep + __shfl_xor(send, 8); }
    }
    {
      const bool up = lane & 4;
      const float send = up ? a2[0] : a2[1]; const float keep = up ? a2[1] : a2[0]; a1 = keep + __shfl_xor(send, 4);
    }
    a1 += __shfl_xor(a1, 2);
    a1 += __shfl_xor(a1, 1);
    float mx = a1;
#pragma unroll
    for (int o = 4; o <= 32; o <<= 1) mx = fmaxf(mx, __shfl_xor(mx, o));
    const float ex = __expf(a1 - mx);
    float sm = ex;
#pragma unroll
    for (int o = 4; o <= 32; o <<= 1) sm += __shfl_xor(sm, o);
    if ((lane & 3) == 0) {
      const int e = (lane >> 2) & 15;
      p.aff[((size_t)((R >> 11) * NE + e)) * SEQ + (R & 2047)] = ex / sm;
    }
  };
  for (int R0 = gw; R0 < NT; R0 += 2 * nw) {
    const int R1 = R0 + nw;
    const bool has1 = R1 < NT;
    const bf16_t* src0 = p.x1b + (size_t)R0 * DM;
    const bf16_t* src1 = p.x1b + (size_t)(has1 ? R1 : R0) * DM;
    const float* md0 = p.mod + (R0 >> 11) * 6144;
    const float* md1 = p.mod + ((has1 ? R1 : R0) >> 11) * 6144;
    float4 v0[4], v1[4]; float s0 = 0.f, s1 = 0.f;
#pragma unroll
    for (int i = 0; i < 4; ++i) {
      const uint2 u0 = *(const uint2*)(src0 + lane * 4 + 256 * i), u1 = *(const uint2*)(src1 + lane * 4 + 256 * i);
      v0[i] = make_float4(bf_lo(u0.x), bf_hi(u0.x), bf_lo(u0.y), bf_hi(u0.y)); v1[i] = make_float4(bf_lo(u1.x), bf_hi(u1.x), bf_lo(u1.y), bf_hi(u1.y));
    }
#pragma unroll
    for (int i = 0; i < 4; ++i) { s0 += v0[i].x * v0[i].x + v0[i].y * v0[i].y + v0[i].z * v0[i].z + v0[i].w * v0[i].w; s1 += v1[i].x * v1[i].x + v1[i].y * v1[i].y + v1[i].z * v1[i].z + v1[i].w * v1[i].w; }
    s0 = wave_sum(s0); s1 = wave_sum(s1);
    const float r0 = rsqrtf(s0 * (1.f / DM) + EPS), r1 = rsqrtf(s1 * (1.f / DM) + EPS);
#pragma unroll
    for (int i = 0; i < 4; ++i) {
      const int d = lane * 4 + 256 * i;
      const float4 g = *(const float4*)(p.norm2_g + d);
      {
        const float4 sh = *(const float4*)(md0 + 3072 + d), sc = *(const float4*)(md0 + 4096 + d);
        v0[i].x = v0[i].x * r0 * g.x * (1.f + sc.x) + sh.x; v0[i].y = v0[i].y * r0 * g.y * (1.f + sc.y) + sh.y;
        v0[i].z = v0[i].z * r0 * g.z * (1.f + sc.z) + sh.z; v0[i].w = v0[i].w * r0 * g.w * (1.f + sc.w) + sh.w;
        uint2 o; o.x = pk_bf16(v0[i].x, v0[i].y); o.y = pk_bf16(v0[i].z, v0[i].w);
        *(uint2*)(p.h2 + (size_t)R0 * DM + d) = o;
      }
      if (has1) {
        const float4 sh = *(const float4*)(md1 + 3072 + d), sc = *(const float4*)(md1 + 4096 + d);
        v1[i].x = v1[i].x * r1 * g.x * (1.f + sc.x) + sh.x; v1[i].y = v1[i].y * r1 * g.y * (1.f + sc.y) + sh.y;
        v1[i].z = v1[i].z * r1 * g.z * (1.f + sc.z) + sh.z; v1[i].w = v1[i].w * r1 * g.w * (1.f + sc.w) + sh.w;
        uint2 o; o.x = pk_bf16(v1[i].x, v1[i].y); o.y = pk_bf16(v1[i].z, v1[i].w);
        *(uint2*)(p.h2 + (size_t)R1 * DM + d) = o;
      }
    }
    SB_;
    router(v0, R0);
    SB_;
    if (has1) router(v1, R1);
    SB_;
  }
}

DI void phase8(const Params& p) {
  const int t_ = tid_(); const int lane = t_ & 63, w = t_ >> 6;
  const int gw = w * gridDim.x + blockIdx.x, nw = gridDim.x * NWV;
  for (int pr = gw; pr < NB * NE; pr += nw) {
    const float* a = p.aff + (size_t)pr * SEQ;
    unsigned u[32];
#pragma unroll
    for (int q = 0; q < 32; ++q) u[q] = __float_as_uint(a[q * 64 + lane]);
    unsigned thr = 0;
    for (int bit = 30; bit >= 0; --bit) {
      const unsigned cand = thr | (1u << bit);
      int cnt = 0;
#pragma unroll
      for (int q = 0; q < 32; ++q) cnt += __popcll(__ballot(u[q] >= cand));
      if (cnt >= CAP) thr = cand;
    }
    int ngt = 0;
#pragma unroll
    for (int q = 0; q < 32; ++q) ngt += __popcll(__ballot(u[q] > thr));
    int cgt = 0, ceq = 0;
    int* io = p.idx + pr * CAP; float* go = p.gate + pr * CAP;
    int* iv = p.inv + (size_t)pr * SEQ;
#pragma unroll
    for (int q = 0; q < 32; ++q) {
      const bool gt = u[q] > thr, eq = u[q] == thr;
      const unsigned long long mg = __ballot(gt), me = __ballot(eq);
      const unsigned long long below = (1ull << lane) - 1ull;
      int myslot = -1;
      if (gt) { const int s = cgt + __popcll(mg & below); io[s] = q * 64 + lane; go[s] = __uint_as_float(u[q]); myslot = s; }
      if (eq) { const int s = ngt + ceq + __popcll(me & below); if (s < CAP) { io[s] = q * 64 + lane; go[s] = __uint_as_float(u[q]); myslot = s; } }
      iv[q * 64 + lane] = myslot;
      cgt += __popcll(mg); ceq += __popcll(me);
    }
  }
}

DI void phase9(const Params& p, char* smem) {
  const int t = tid_(), lane = t & 63, w = t >> 6, r = lane & 31, hh = lane >> 5;
  const int wm = w & 1, wn = w >> 1;
  const int xcd = blockIdx.x & 7, jl = blockIdx.x >> 3, nl = gridDim.x >> 3;
  auto decode = [&](int L, int& e, int& ft, int& b) { e = xcd * 2 + (L >> 7); const int rem = L & 127; ft = (rem >> 3) & 3; b = (rem >> 5) * 8 + (rem & 7); };
  bool pre = false;
  for (int L = jl; L < 256; L += nl) {
    int e, ft, b, eN = 0, ftN = 0, bN = 0;
    decode(L, e, ft, b);
    const int Ln = L + nl; const bool hasNext = Ln < 256;
    if (hasNext) decode(Ln, eN, ftN, bN);
    const int be = b * NE + e;
    const bf16_t* Ab = p.WguT + ((size_t)e * 1024 + ft * 256) * DM;
    const int* ib = p.idx + be * CAP;
    const bf16_t* hb = p.h2 + (size_t)b * SEQ * DM;
    const bf16_t* AbN = p.WguT + ((size_t)eN * 1024 + ftN * 256) * DM;
    const int* ibN = p.idx + (bN * NE + eN) * CAP;
    const bf16_t* hbN = p.h2 + (size_t)bN * SEQ * DM;
    f32x16 acc[4][2];
#pragma unroll
    for (int a = 0; a < 4; ++a)
#pragma unroll
      for (int c = 0; c < 2; ++c) acc[a][c] = zero16();
    float dummy = 0.f;
    gemm8x<4, 2, 2, 4, false, 2>(acc, [&](int row) { return Ab + (size_t)row * DM; }, [&](int row) { return hb + (size_t)ib[row] * DM; }, DM, smem, dummy,
                              pre, hasNext, [&](int row) { return AbN + (size_t)row * DM; }, [&](int row) { return hbN + (size_t)ibN[row] * DM; });
    pre = hasNext;
    char* tile = smem + EPI_OFF;
#pragma unroll
    for (int tn = 0; tn < 2; ++tn)
#pragma unroll
      for (int pr = 0; pr < 2; ++pr) {
        char* d = tile + (wn * 64 + tn * 32 + r) * 272 + (wm * 64 + pr * 32 + 4 * hh) * 2;
#pragma unroll
        for (int q = 0; q < 4; ++q) {
          float v[4];
#pragma unroll
          for (int j = 0; j < 4; ++j) { const float g = acc[2 * pr][tn][4 * q + j], uu = acc[2 * pr + 1][tn][4 * q + j]; v[j] = g * sigmoidf_(g) * uu; }
          uint2 ou; ou.x = pk_bf16(v[0], v[1]); ou.y = pk_bf16(v[2], v[3]);
          *(uint2*)(d + 16 * q) = ou;
        }
      }
    lds_sync();
    bf16_t* hd_ = p.hmid + (size_t)be * CAP * DE + ft * 128;
    copy_tile(tile, 272, 256, 4, [&](int row) { return hd_ + (size_t)row * DE; }, 0, 16);
  }
}

DI void phase10(const Params& p, char* smem) {
  const int xcd = blockIdx.x & 7, jl = blockIdx.x >> 3, nl = gridDim.x >> 3;
  for (int L = jl; L < 512; L += nl) {
    const int e = xcd * 2 + (L >> 8), rem = L & 255, nt = (rem >> 3) & 3, st = (rem >> 5) & 1, b = (rem >> 6) * 8 + (rem & 7);
    const int be = b * NE + e;
    const bf16_t* Hb = p.hmid + ((size_t)be * CAP + st * 128) * DE;
    const bf16_t* Wb = p.WdT + ((size_t)e * DM + nt * 256) * DE;
    f32x16 acc[2][2];
#pragma unroll
    for (int a = 0; a < 2; ++a)
#pragma unroll
      for (int c = 0; c < 2; ++c) acc[a][c] = zero16();
    gemm8s3(acc, [&](int row) { return Wb + (size_t)row * DE; }, [&](int row) { return Hb + (size_t)row * DE; }, DE, smem);
    stage_tile<2, 2, 4, 2>(acc, smem, 528, [](float v) { return v; });
    lds_sync();
    bf16_t* yb = p.Y + ((size_t)be * CAP + st * 128) * DM + nt * 256;
    copy_tile(smem, 528, 128, 5, [&](int row) { return yb + (size_t)row * DM; }, 0, 32);
    lds_sync();
  }
}

DI void phase11(const Params& p) {
  const int t_ = tid_(); const int lane = t_ & 63, w = t_ >> 6;
  const int gw = blockIdx.x * NWV + w, nw = gridDim.x * NWV;
  auto slotOf = [&](int R) { return (lane < NE && R < NT) ? p.inv[((size_t)((R >> 11) * NE + lane)) * SEQ + (R & 2047)] : -1; };
  int nslot = slotOf(gw);
  uint2 nx[4];
  {
    const bf16_t* xs = p.x1b + (size_t)(gw < NT ? gw : 0) * DM + lane * 4;
#pragma unroll
    for (int i = 0; i < 4; ++i) nx[i] = *(const uint2*)(xs + 256 * i);
  }
  for (int R = gw; R < NT; R += nw) {
    const int b = R >> 11;
    const int myslot = nslot;
    uint2 xu[4];
#pragma unroll
    for (int i = 0; i < 4; ++i) xu[i] = nx[i];
    {
      const int Rn = R + nw;
      nslot = slotOf(Rn);
      const bf16_t* xs = p.x1b + (size_t)(Rn < NT ? Rn : 0) * DM + lane * 4;
#pragma unroll
      for (int i = 0; i < 4; ++i) nx[i] = *(const uint2*)(xs + 256 * i);
    }
    unsigned long long mask = __ballot(myslot >= 0);
    float4 a[4];
#pragma unroll
    for (int i = 0; i < 4; ++i) a[i] = make_float4(0.f, 0.f, 0.f, 0.f);
    while (mask) {
      const int e = __ffsll((long long)mask) - 1; mask &= mask - 1ull;
      const int slot = __shfl(myslot, e);
      const float g = p.gate[(b * NE + e) * CAP + slot];
      const bf16_t* y = p.Y + ((size_t)(b * NE + e) * CAP + slot) * DM + lane * 4;
#pragma unroll
      for (int i = 0; i < 4; ++i) {
        const uint2 u = *(const uint2*)(y + 256 * i);
        a[i].x += g * bf_lo(u.x); a[i].y += g * bf_hi(u.x); a[i].z += g * bf_lo(u.y); a[i].w += g * bf_hi(u.y);
      }
    }
    const float* g2 = p.mod + b * 6144 + 5120;
    float* o = p.out + (size_t)R * DM;
#pragma unroll
    for (int i = 0; i < 4; ++i) {
      const int d = lane * 4 + 256 * i;
      const float4 gv = *(const float4*)(g2 + d);
      *(float4*)(o + d) = make_float4(bf_lo(xu[i].x) + gv.x * a[i].x, bf_hi(xu[i].x) + gv.y * a[i].y, bf_lo(xu[i].y) + gv.z * a[i].z, bf_hi(xu[i].y) + gv.w * a[i].w);
    }
  }
}

__global__ void __launch_bounds__(NTH, 2) mega_kernel(Params p) {
  cg::grid_group grid = cg::this_grid();
  __shared__ __attribute__((aligned(16))) char smem[SMEM_BYTES];
#ifndef REPMASK
#define REPMASK 0
#endif
#define RUNPH(k, call) for (int rep_ = 0; rep_ < (((REPMASK) >> (k)) & 1) + 1; ++rep_) { call; grid.sync(); }
  RUNPH(0, phase0(p, smem))
  RUNPH(1, phase1(p))
  RUNPH(2, phase2(p, smem))
  RUNPH(3, phase3(p, smem))
  RUNPH(4, phase4(p, smem))
  RUNPH(5, phase5(p, smem))
  RUNPH(6, phase6(p, smem))
  RUNPH(7, phase7(p, smem))
  RUNPH(8, phase8(p))
  RUNPH(9, phase9(p, smem))
  RUNPH(10, phase10(p, smem))
  phase11(p);
}

static inline size_t align_up(size_t v, size_t a) { return (v + a - 1) / a * a; }

extern "C" void kernel_launch(void* const* d_in, const int* in_sizes, int n_in,
                              void* d_out, int out_size, void* d_ws, size_t ws_size,
                              hipStream_t stream) {
  static int grid_blocks = 0;
  if (!grid_blocks) {
    int dev = 0, cus = 0, per_cu = 0;
    (void)hipGetDevice(&dev);
    (void)hipDeviceGetAttribute(&cus, hipDeviceAttributeMultiprocessorCount, dev);
    (void)hipOccupancyMaxActiveBlocksPerMultiprocessor(&per_cu, mega_kernel, NTH, 0);
    if (per_cu > 1) per_cu = 1;
    if (per_cu < 1) per_cu = 1;
    grid_blocks = (cus * per_cu) & ~7;
    if (grid_blocks < 8) grid_blocks = 8;
  }
  Params p;
  memset(&p, 0, sizeof(p));
  p.x = (const float*)d_in[0]; p.c = (const float*)d_in[1]; p.ctx = (const float*)d_in[2]; p.c_ctx = (const float*)d_in[3];
  p.w_mod = (const float*)d_in[4]; p.b_mod = (const float*)d_in[5]; p.norm1_g = (const float*)d_in[6];
  const float* w_in = (const float*)d_in[7];
  const float* q_a_g = (const float*)d_in[8];
  const float* kv_a_g = (const float*)d_in[9];
  const float* w_q_up = (const float*)d_in[10];
  const float* w_kv_up = (const float*)d_in[11];
  p.q_norm_g = (const float*)d_in[12]; p.k_norm_g = (const float*)d_in[13];
  const float* w_o_attn = (const float*)d_in[14];
  const float* w_fourier = (const float*)d_in[15];
  const float* w_out = (const float*)d_in[16];
  p.norm2_g = (const float*)d_in[17]; p.w_router = (const float*)d_in[18];
  const float* w_e_gate = (const float*)d_in[19];
  const float* w_e_up = (const float*)d_in[20];
  const float* w_e_down = (const float*)d_in[21];
  p.out = (float*)d_out;

  char* base = (char*)d_ws; size_t off = 0;
  auto alloc = [&](size_t bytes) { char* q = base + off; off = align_up(off + bytes, 256); return q; };
  p.WinT = (bf16_t*)alloc((size_t)NINP * DM * 2);
  p.WqT = (bf16_t*)alloc((size_t)768 * QL * 2);
  p.WkvT = (bf16_t*)alloc((size_t)1024 * KVL * 2);
  p.WoT = (bf16_t*)alloc((size_t)DM * 512 * 2);
  p.WfT = (bf16_t*)alloc((size_t)DM * 512 * 2);
  p.WoutT = (bf16_t*)alloc((size_t)DM * DM * 2);
  p.WguT = (bf16_t*)alloc((size_t)NE * 1024 * DM * 2);
  p.WdT = (bf16_t*)alloc((size_t)NE * DM * DE * 2);
  p.chanT = (bf16_t*)alloc((size_t)256 * 128 * 2);
  p.posM = (bf16_t*)alloc((size_t)2 * 1152 * 2048 * 2);
  p.ropeTab = (float*)alloc(64 * 8 * 2 * 4);
  p.mod = (float*)alloc(33 * 6144 * 4);
  p.aff = (float*)alloc((size_t)NB * NE * SEQ * 4);
  p.gate = (float*)alloc((size_t)NB * NE * CAP * 4);
  p.idx = (int*)alloc((size_t)NB * NE * CAP * 4);
  p.inv = (int*)alloc((size_t)NB * NE * SEQ * 4);
  p.pckv = (bf16_t*)alloc((size_t)NC * LDCKV * 2 + 4096);
  char* regA = alloc((size_t)(NT + NC) * DM * 2);
  p.h = (bf16_t*)regA; p.ABt = (bf16_t*)regA; p.h2 = (bf16_t*)regA;
  char* regB1 = alloc((size_t)NT * LDQKV * 2);
  p.pqkv = (bf16_t*)regB1; p.attn_o = (bf16_t*)regB1;
  char* regB2 = alloc((size_t)NT * 512 * 2);
  p.pf = (bf16_t*)regB2; p.four_o = (bf16_t*)regB2;
  p.x1b = (bf16_t*)regB1;
  if ((size_t)(regB2 - regB1) + (size_t)NT * 512 * 2 < (size_t)NT * DM * 2) { fprintf(stderr, "x1b does not fit\n"); return; }
  p.pg = (bf16_t*)alloc((size_t)NT * 2048 * 2);
  p.Y = p.pg;
  const size_t szQ = (size_t)NB * NH * SEQ * QKD * 2, szK = (size_t)NB * NH * NKEY * QKD * 2, szV = (size_t)NB * NH * VD * NKEY * 2;
  char* regC = alloc(szQ + szK + szV + 1024);
  p.Q = (bf16_t*)regC; p.K = (bf16_t*)(regC + align_up(szQ, 256)); p.Vt = (bf16_t*)(regC + align_up(szQ, 256) + align_up(szK, 256));
  p.m = (bf16_t*)regC; p.hmid = (bf16_t*)(regC + (size_t)NT * DM * 2);
  if (off > ws_size) { fprintf(stderr, "workspace too small: need %zu have %zu\n", off, ws_size); return; }

  int ts = 0;
  auto job = [&](int i, const float* src, bf16_t* dst, const float* scale, int K, int ldS, int n_off, int n_cnt, int dst_row0, int mode, int batch, long sbs, long dbs) {
    TJob& j = p.jobs[i];
    j.src = src; j.dst = dst; j.scale = scale; j.K = K; j.ldS = ldS; j.n_off = n_off; j.n_cnt = n_cnt; j.dst_row0 = dst_row0; j.mode = mode; j.batch = batch;
    j.tiles_n = (n_cnt + 63) / 64; j.tile_start = ts; j.src_bstride = sbs; j.dst_bstride = dbs;
    ts += batch * (K / 64) * j.tiles_n;
  };
  job(0, w_e_gate, p.WguT, nullptr, DM, DE, 0, DE, 0, 1, NE, (long)DM * DE, (long)1024 * DM);
  job(1, w_e_up, p.WguT, nullptr, DM, DE, 0, DE, 0, 2, NE, (long)DM * DE, (long)1024 * DM);
  job(2, w_e_down, p.WdT, nullptr, DE, DM, 0, DM, 0, 0, NE, (long)DE * DM, (long)DM * DE);
  job(3, w_in, p.WinT, nullptr, DM, N_IN, 0, 672, 0, 0, 1, 0, 0);
  job(4, w_in, p.WinT, nullptr, DM, N_IN, 672, 2560, 768, 0, 1, 0, 0);
  job(5, w_q_up, p.WqT, q_a_g, QL, 768, 0, 768, 0, 0, 1, 0, 0);
  job(6, w_kv_up, p.WkvT, kv_a_g, KVL, 1024, 0, 1024, 0, 0, 1, 0, 0);
  job(7, w_o_attn, p.WoT, nullptr, 512, DM, 0, DM, 0, 0, 1, 0, 0);
  job(8, w_fourier, p.WfT, nullptr, 512, DM, 0, DM, 0, 0, 1, 0, 0);
  job(9, w_out, p.WoutT, nullptr, DM, DM, 0, DM, 0, 0, 1, 0, 0);
  p.n_ttiles = ts;

  void* args[] = {&p};
  hipError_t e = hipLaunchCooperativeKernel((void*)mega_kernel, dim3(grid_blocks), dim3(NTH), args, 0, stream);
  if (e != hipSuccess) fprintf(stderr, "cooperative launch failed: %s (grid %d)\n", hipGetErrorString(e), grid_blocks);
}
```

```cpp
#include <hip/hip_runtime.h>
#include <hip/hip_cooperative_groups.h>
#include <cstdio>
#include <cstring>
#include <cstdint>
namespace cg = cooperative_groups;

#define DI __device__ __forceinline__
typedef unsigned short bf16_t;
typedef short bf16x8 __attribute__((ext_vector_type(8)));
typedef float f32x16 __attribute__((ext_vector_type(16)));
#define MFMA(a, b, c) __builtin_amdgcn_mfma_f32_32x32x16_bf16((a), (b), (c), 0, 0, 0)

constexpr int NB = 32, SEQ = 2048, DM = 1024, NT = NB * SEQ, CTXL = 256, NC = NB * CTXL;
constexpr int NH = 8, QKD = 96, VD = 64, QL = 384, KVL = 256, NKEY = SEQ + CTXL;
constexpr int N_IN = 3232, NINP = 3328;
constexpr int NE = 16, DE = 512, CAP = 256;
constexpr float EPS = 1e-6f;
constexpr int LDQKV = 672, LDCKV = 288;
constexpr int NTH = 512, NWV = 8;
constexpr int SMEM_BYTES = 147456;

struct TJob {
  const float* src; bf16_t* dst; const float* scale;
  int K, ldS, n_off, n_cnt, dst_row0, mode, batch, tiles_n, tile_start, pad0;
  long src_bstride, dst_bstride;
};
constexpr int NJOBS = 10;

struct Params {
  const float *x, *c, *ctx, *c_ctx, *w_mod, *b_mod, *norm1_g, *q_norm_g, *k_norm_g, *norm2_g, *w_router;
  float* out;
  bf16_t *WinT, *WqT, *WkvT, *WoT, *WfT, *WoutT, *WguT, *WdT, *chanT, *posM;
  float *ropeTab, *mod;
  bf16_t *h, *pqkv, *pckv, *pf, *pg, *Q, *K, *Vt, *attn_o, *ABt, *four_o, *m, *h2, *hmid;
  float *aff, *gate;
  int* idx;
  int* inv;
  bf16_t* Y;
  unsigned* modctr;
  bf16_t* x1b;
  TJob jobs[NJOBS];
  int n_ttiles, pad1;
};

typedef float f32x2v __attribute__((ext_vector_type(2)));
typedef __bf16 bf16x2v __attribute__((ext_vector_type(2)));
DI unsigned pk_bf16(float lo, float hi) { f32x2v v = {lo, hi}; bf16x2v b = __builtin_convertvector(v, bf16x2v); return __builtin_bit_cast(unsigned, b); }
DI int tid_() { int t = threadIdx.x; asm volatile("" : "+v"(t)); return t; }
DI float bf_lo(unsigned u) { return __uint_as_float(u << 16); }
DI float bf_hi(unsigned u) { return __uint_as_float(u & 0xffff0000u); }
DI bf16_t f2bf(float f) { return (bf16_t)(pk_bf16(f, 0.f) & 0xffffu); }
DI float sigmoidf_(float x) { return 1.f / (1.f + __expf(-x)); }
DI int crow(int i, int hh) { return (i & 3) + 8 * (i >> 2) + 4 * hh; }
DI float wave_sum(float v) {
#pragma unroll
  for (int o = 32; o >= 1; o >>= 1) v += __shfl_xor(v, o);
  return v;
}
DI f32x16 zero16() { f32x16 z;
#pragma unroll
  for (int i = 0; i < 16; ++i) z[i] = 0.f; return z; }
DI void wait_vm0() { asm volatile("s_waitcnt vmcnt(0)" ::: "memory"); }
DI void wait_lgkm0() { asm volatile("s_waitcnt lgkmcnt(0)" ::: "memory"); }
DI void bar_() { __builtin_amdgcn_s_barrier(); }
DI void lds_sync() { wait_lgkm0(); bar_(); }
#define GLDS(gp, lp) __builtin_amdgcn_global_load_lds((const unsigned*)(gp), (__attribute__((address_space(3))) unsigned*)(lp), 16, 0, 0)
#define SB_ __builtin_amdgcn_sched_barrier(0)

constexpr int EPI_OFF = 65536;
template <int TM, int TN, int WM, int WN, bool SUMSQ, int NST, class AF, class BF, class AFN, class BFN>
DI void gemm8x(f32x16 (&acc)[TM][TN], AF arow, BF brow, int K, char* smem, float& sumsq, bool pre, bool hasNext, AFN arowN, BFN browN) {
  constexpr int RA = 32 * TM * WM, RB = 32 * TN * WN;
  constexpr int LDR = 128, STAGE = (RA + RB) * LDR;
  static_assert(WM * WN == NWV, "waves");
  static_assert(NST * STAGE <= SMEM_BYTES, "smem");
  static_assert(NST == 2 || (NST == 3 && RA == 256 && RB == 128), "3-stage ring: 6 loads per thread per stage assumed");
  static_assert(RA <= 256 && RB <= 256 && RA % 32 == 0 && RB % 32 == 0, "shape");
  const int t = tid_(), lane = t & 63, w = t >> 6, r = lane & 31, hh = lane >> 5;
  const int wm = w % WM, wn = w / WM;
  const int row0 = t >> 3;
  const int c = (t & 7) ^ ((row0 >> 1) & 7);
  const bool a0v = row0 < RA, a1v = row0 + 64 < RA, a2v = row0 + 128 < RA, a3v = row0 + 192 < RA;
  const bool b0v = row0 < RB, b1v = row0 + 64 < RB, b2v = row0 + 128 < RB, b3v = row0 + 192 < RB;
  const bf16_t* pa0 = arow(a0v ? row0 : 0) + c * 8;
  const bf16_t* pa1 = arow(a1v ? row0 + 64 : 0) + c * 8;
  const bf16_t* pa2 = arow(a2v ? row0 + 128 : 0) + c * 8;
  const bf16_t* pa3 = arow(a3v ? row0 + 192 : 0) + c * 8;
  const bf16_t* pb0 = brow(b0v ? row0 : 0) + c * 8;
  const bf16_t* pb1 = brow(b1v ? row0 + 64 : 0) + c * 8;
  const bf16_t* pb2 = brow(b2v ? row0 + 128 : 0) + c * 8;
  const bf16_t* pb3 = brow(b3v ? row0 + 192 : 0) + c * 8;
  if (!pre) {
    char* l_ = smem + t * 16; char* m_ = l_ + RA * LDR;
    if (a0v) GLDS(pa0, l_); if (a1v) GLDS(pa1, l_ + 8192); if (a2v) GLDS(pa2, l_ + 16384); if (a3v) GLDS(pa3, l_ + 24576);
    if (b0v) GLDS(pb0, m_); if (b1v) GLDS(pb1, m_ + 8192); if (b2v) GLDS(pb2, m_ + 16384); if (b3v) GLDS(pb3, m_ + 24576);
  }
  if (NST == 3) {
    char* l_ = smem + STAGE + t * 16; char* m_ = l_ + RA * LDR;
    GLDS(pa0 + 64, l_); GLDS(pa1 + 64, l_ + 8192); GLDS(pa2 + 64, l_ + 16384); GLDS(pa3 + 64, l_ + 24576);
    GLDS(pb0 + 64, m_); GLDS(pb1 + 64, m_ + 8192);
    asm volatile("s_waitcnt vmcnt(6)" ::: "memory");
  } else wait_vm0();
  bar_();
  const int nk = K >> 6;
  const int sw = (r >> 1) & 7;
  const int aoff = (wm * TM * 32 + r) * LDR, boff = RA * LDR + (wn * TN * 32 + r) * LDR;
  auto compute = [&](const char* cur, char* nxt, bool issue, const bf16_t* q0, const bf16_t* q1, const bf16_t* q2, const bf16_t* q3,
                     const bf16_t* s0, const bf16_t* s1, const bf16_t* s2, const bf16_t* s3) {
    const char* As = cur + aoff;
    const char* Bs = cur + boff;
    char* l_ = nxt + t * 16; char* m_ = l_ + RA * LDR;
    bf16x8 a0[TM], b0[TN], a1[TM], b1[TN];
#define LOADF(A_, B_, ks) do { const int po_ = (((ks) * 2 + hh) ^ sw) * 16; \
      _Pragma("unroll") for (int tm = 0; tm < TM; ++tm) A_[tm] = *(const bf16x8*)(As + tm * 32 * LDR + po_); \
      _Pragma("unroll") for (int tn = 0; tn < TN; ++tn) B_[tn] = *(const bf16x8*)(Bs + tn * 32 * LDR + po_); } while (0)
#define MMF(A_, B_) do { if (SUMSQ) { uint4 u = __builtin_bit_cast(uint4, B_[0]); \
        float e0 = bf_lo(u.x), e1 = bf_hi(u.x), e2 = bf_lo(u.y), e3 = bf_hi(u.y), e4 = bf_lo(u.z), e5 = bf_hi(u.z), e6 = bf_lo(u.w), e7 = bf_hi(u.w); \
        sumsq += e0 * e0 + e1 * e1 + e2 * e2 + e3 * e3 + e4 * e4 + e5 * e5 + e6 * e6 + e7 * e7; } \
      _Pragma("unroll") for (int tm = 0; tm < TM; ++tm) _Pragma("unroll") for (int tn = 0; tn < TN; ++tn) acc[tm][tn] = MFMA(A_[tm], B_[tn], acc[tm][tn]); } while (0)
    LOADF(a0, b0, 0);
    LOADF(a1, b1, 1);
    SB_;
    if (issue) { if (a0v) GLDS(q0, l_); if (a1v) GLDS(q1, l_ + 8192); }
    SB_;
    __builtin_amdgcn_s_setprio(1);
    MMF(a0, b0);
    LOADF(a0, b0, 2);
    SB_;
    if (issue) { if (a2v) GLDS(q2, l_ + 16384); if (a3v) GLDS(q3, l_ + 24576); }
    SB_;
    MMF(a1, b1);
    LOADF(a1, b1, 3);
    SB_;
    if (issue) { if (b0v) GLDS(s0, m_); if (b1v) GLDS(s1, m_ + 8192); }
    SB_;
    MMF(a0, b0);
    SB_;
    if (issue) { if (b2v) GLDS(s2, m_ + 16384); if (b3v) GLDS(s3, m_ + 24576); }
    SB_;
    MMF(a1, b1);
    __builtin_amdgcn_s_setprio(0);
  };
  int sc_ = 0;
  for (int kt = 0; kt < nk - 1; ++kt) {
    SB_;
    if (NST == 2) {
      const int ko = (kt + 1) * 64;
      compute(smem + (kt & 1) * STAGE, smem + ((kt + 1) & 1) * STAGE, true, pa0 + ko, pa1 + ko, pa2 + ko, pa3 + ko, pb0 + ko, pb1 + ko, pb2 + ko, pb3 + ko);
      SB_;
      wait_vm0(); bar_();
    } else {
      const int ko = (kt + 2) * 64; const bool iss = kt + 2 < nk;
      const int sn = (sc_ == 0) ? 2 : sc_ - 1;
      compute(smem + sc_ * STAGE, smem + sn * STAGE, iss, pa0 + ko, pa1 + ko, pa2 + ko, pa3 + ko, pb0 + ko, pb1 + ko, pb2 + ko, pb3 + ko);
      SB_;
      if (iss) asm volatile("s_waitcnt vmcnt(6)" ::: "memory"); else wait_vm0();
      bar_();
      sc_ = (sc_ == 2) ? 0 : sc_ + 1;
    }
  }
  if (NST == 3) {
    SB_;
    compute(smem + sc_ * STAGE, smem, false, pa0, pa0, pa0, pa0, pa0, pa0, pa0, pa0);
    SB_;
    lds_sync();
  } else {
    const bf16_t *q0 = pa0, *q1 = pa0, *q2 = pa0, *q3 = pa0, *s0 = pa0, *s1 = pa0, *s2 = pa0, *s3 = pa0;
    if (hasNext) {
      q0 = arowN(a0v ? row0 : 0) + c * 8; q1 = arowN(a1v ? row0 + 64 : 0) + c * 8; q2 = arowN(a2v ? row0 + 128 : 0) + c * 8; q3 = arowN(a3v ? row0 + 192 : 0) + c * 8;
      s0 = browN(b0v ? row0 : 0) + c * 8; s1 = browN(b1v ? row0 + 64 : 0) + c * 8; s2 = browN(b2v ? row0 + 128 : 0) + c * 8; s3 = browN(b3v ? row0 + 192 : 0) + c * 8;
    }
    SB_;
    compute(smem + ((nk - 1) & 1) * STAGE, smem, hasNext, q0, q1, q2, q3, s0, s1, s2, s3);
    SB_;
    lds_sync();
  }
}
template <int TM, int TN, int WM, int WN, bool SUMSQ, class AF, class BF>
DI void gemm8(f32x16 (&acc)[TM][TN], AF arow, BF brow, int K, char* smem, float& sumsq) {
  gemm8x<TM, TN, WM, WN, SUMSQ, 2>(acc, arow, brow, K, smem, sumsq, false, false, arow, brow);
}
template <class AF, class BF>
DI void gemm8s3(f32x16 (&acc)[2][2], AF arow, BF brow, int K, char* smem) {
  float dummy = 0.f;
  gemm8x<2, 2, 4, 2, false, 3>(acc, arow, brow, K, smem, dummy, false, false, arow, brow);
}
template <int TM, int WM, int WN, int TNSEL, class F>
DI void stage_half(const f32x16 (&acc)[TM][2], char* tile, int pitch, F f) {
  const int t = tid_(), lane = t & 63, w = t >> 6, r = lane & 31, hh = lane >> 5;
  const int wm = w % WM, wn = w / WM;
#pragma unroll
  for (int tm = 0; tm < TM; ++tm) {
    char* d = tile + (wn * 32 + r) * pitch + (wm * TM * 32 + tm * 32 + 4 * hh) * 2;
#pragma unroll
    for (int q = 0; q < 4; ++q) {
      const f32x16& a = acc[tm][TNSEL];
      uint2 o; o.x = pk_bf16(f(a[4 * q]), f(a[4 * q + 1])); o.y = pk_bf16(f(a[4 * q + 2]), f(a[4 * q + 3]));
      *(uint2*)(d + 16 * q) = o;
    }
  }
}

template <int TM, int TN, int WM, int WN, class F>
DI void stage_tile(const f32x16 (&acc)[TM][TN], char* tile, int pitch, F f) {
  const int t = tid_(), lane = t & 63, w = t >> 6, r = lane & 31, hh = lane >> 5;
  const int wm = w % WM, wn = w / WM;
#pragma unroll
  for (int tm = 0; tm < TM; ++tm)
#pragma unroll
    for (int tn = 0; tn < TN; ++tn) {
      char* d = tile + (wn * TN * 32 + tn * 32 + r) * pitch + (wm * TM * 32 + tm * 32 + 4 * hh) * 2;
#pragma unroll
      for (int q = 0; q < 4; ++q) {
        uint2 o; o.x = pk_bf16(f(acc[tm][tn][4 * q]), f(acc[tm][tn][4 * q + 1])); o.y = pk_bf16(f(acc[tm][tn][4 * q + 2]), f(acc[tm][tn][4 * q + 3]));
        *(uint2*)(d + 16 * q) = o;
      }
    }
}
template <class RF>
DI void copy_tile(const char* tile, int pitch, int rows, int lch, RF dst, int ch0, int ch1) {
  const int t = tid_();
  const int total = rows << lch;
  for (int id = t; id < total; id += NTH) {
    const int row = id >> lch, ch = id & ((1 << lch) - 1);
    if (ch >= ch0 && ch < ch1) *(uint4*)(dst(row) + ch * 8) = *(const uint4*)(tile + row * pitch + ch * 16);
  }
}

struct TTile { const float* src; const float* scale; bf16_t* dst; int K, ldS, n0, n_cnt, k0, dst_row0, mode; };
DI TTile ttile_decode(const Params& p, int u) {
  int jb = 0;
#pragma unroll 1
  for (int q = 1; q < NJOBS; ++q) if (u >= p.jobs[q].tile_start) jb = q;
  const TJob& j = p.jobs[jb];
  const int tile = u - j.tile_start;
  const int tpb = (j.K >> 6) * j.tiles_n;
  const int bi = tile / tpb, rem = tile % tpb;
  const int kt = rem / j.tiles_n, ntile = rem % j.tiles_n;
  TTile tt;
  tt.src = j.src + (size_t)bi * j.src_bstride + j.n_off; tt.scale = j.scale; tt.dst = j.dst + (size_t)bi * j.dst_bstride;
  tt.K = j.K; tt.ldS = j.ldS; tt.n0 = ntile * 64; tt.n_cnt = j.n_cnt; tt.k0 = kt * 64; tt.dst_row0 = j.dst_row0; tt.mode = j.mode;
  return tt;
}
DI void ttile_load(const TTile& tt, int t, float (&v)[8]) {
  const int nn = t & 63, kq = t >> 6;
  const bool nvalid = (tt.n0 + nn) < tt.n_cnt;
#pragma unroll
  for (int i = 0; i < 8; ++i) {
    const int kk = kq + 8 * i;
    float x = 0.f;
    if (nvalid) { x = tt.src[(size_t)(tt.k0 + kk) * tt.ldS + tt.n0 + nn]; if (tt.scale) x *= tt.scale[tt.k0 + kk]; }
    v[i] = x;
  }
}
DI void ttile_store(const TTile& tt, int t, const float (&v)[8], char* smem) {
  bf16_t* T = (bf16_t*)smem;
  const int nn = t & 63, kq = t >> 6;
#pragma unroll
  for (int i = 0; i < 8; ++i) T[nn * 66 + kq + 8 * i] = f2bf(v[i]);
  __syncthreads();
  const int n = t >> 3, part = t & 7;
  if (tt.n0 + n < tt.n_cnt) {
    const unsigned* tp = (const unsigned*)(T + n * 66 + part * 8);
    uint4 o0; o0.x = tp[0]; o0.y = tp[1]; o0.z = tp[2]; o0.w = tp[3];
    const int f = tt.n0 + n;
    int drow;
    if (tt.mode == 0) drow = tt.dst_row0 + f;
    else drow = (f >> 7) * 256 + ((f >> 6) & 1) * 128 + (((f >> 5) & 1) * 2 + (tt.mode == 2 ? 1 : 0)) * 32 + (f & 31);
    *(uint4*)(tt.dst + (size_t)drow * tt.K + tt.k0 + part * 8) = o0;
  }
  __syncthreads();
}

DI void mod_item(const Params& p, int it, char* smem) {
  const int t = tid_(), cgi = t & 15, kg = t >> 4;
  const int j0 = it * 16;
  float* Ssm = (float*)smem;
  float* red = (float*)(smem + 33 * 128 * 4);
  float acc[33];
#pragma unroll
  for (int r = 0; r < 33; ++r) acc[r] = 0.f;
  const float* wp = p.w_mod + (size_t)(kg * 4) * 6144 + j0 + cgi;
  float n0 = wp[0], n1 = wp[6144], n2 = wp[2 * 6144], n3 = wp[3 * 6144];
#pragma unroll 1
  for (int kc = 0; kc < 8; ++kc) {
    __syncthreads();
    for (int idx = t; idx < 33 * 128; idx += NTH) {
      const int r = idx >> 7, kk = idx & 127;
      float v = (r < 32) ? p.c[r * DM + kc * 128 + kk] : p.c_ctx[kc * 128 + kk];
      Ssm[idx] = v * sigmoidf_(v);
    }
    const float w0 = n0, w1 = n1, w2 = n2, w3 = n3;
    if (kc < 7) { const float* wq = wp + (size_t)(kc + 1) * 128 * 6144; n0 = wq[0]; n1 = wq[6144]; n2 = wq[2 * 6144]; n3 = wq[3 * 6144]; }
    __syncthreads();
#pragma unroll
    for (int r = 0; r < 33; ++r) {
      const float4 s = *(const float4*)(Ssm + r * 128 + kg * 4);
      acc[r] += s.x * w0 + s.y * w1 + s.z * w2 + s.w * w3;
    }
  }
  __syncthreads();
#pragma unroll
  for (int r = 0; r < 33; ++r) red[(kg * 33 + r) * 16 + cgi] = acc[r];
  __syncthreads();
  for (int idx = t; idx < 33 * 16; idx += NTH) {
    const int r = idx >> 4, cc = idx & 15;
    float s = 0.f;
#pragma unroll
    for (int g = 0; g < 32; ++g) s += red[(g * 33 + r) * 16 + cc];
    p.mod[r * 6144 + j0 + cc] = s + p.b_mod[j0 + cc];
  }
}

DI void phase0a(const Params& p, char* smem) {
  const int t = tid_();
  const int nMod = 384, nPos = 288, nMisc = 3;
  for (int it = blockIdx.x; it < nMod; it += gridDim.x) {
    mod_item(p, it, smem);
    __syncthreads();
    if (t == 0) { __threadfence(); atomicAdd(p.modctr, 1u); }
  }
  float* ctab = (float*)(smem + 98304);
  __syncthreads();
  for (int j = t; j < 2048; j += NTH) ctab[j] = cospif((float)j * (1.f / 1024.f));
  __syncthreads();
  for (int u = blockIdx.x; u < nPos + nMisc; u += gridDim.x) {
    if (u < nPos) {
      for (int e = t; e < 8 * 256; e += NTH) {
        const int R = u * 8 + (e >> 8), c8 = (e & 255) * 8;
        const int part = R >= 1152 ? 1 : 0, k = R - part * 1152;
        float v[8];
#pragma unroll
        for (int q = 0; q < 8; ++q) {
          const int tt = c8 + q;
          v[q] = (k > 1024) ? 0.f : (part ? ctab[(k * tt - 512) & 2047] : ctab[(k * tt) & 2047]);
        }
        uint4 o; o.x = pk_bf16(v[0], v[1]); o.y = pk_bf16(v[2], v[3]); o.z = pk_bf16(v[4], v[5]); o.w = pk_bf16(v[6], v[7]);
        *(uint4*)(p.posM + (size_t)R * 2048 + c8) = o;
      }
      continue;
    }
    const int m_ = u - nPos;
    if (m_ == 0) {
      for (int e = t; e < 256 * 128; e += NTH) {
        const int m2 = e >> 7, cc = e & 127, mm = m2 & 127;
        float v = (m2 < 128) ? ctab[(mm * cc * 16) & 2047] : ctab[(mm * cc * 16 - 512) & 2047];
        p.chanT[e] = f2bf(v);
      }
    } else if (m_ == 1) {
      for (int e = t; e < 64 * 8; e += NTH) {
        const int pos = e >> 3, jf = e & 7;
        const float inv = 1.0f / powf(10000.0f, (float)jf / 8.0f);
        const float ang = (float)pos * inv;
        p.ropeTab[e * 2 + 0] = cosf(ang);
        p.ropeTab[e * 2 + 1] = sinf(ang);
      }
    } else {
      uint4 z; z.x = z.y = z.z = z.w = 0u;
      uint4* dp = (uint4*)(p.WinT + (size_t)672 * DM);
      for (int e = t; e < 96 * DM / 8; e += NTH) dp[e] = z;
    }
  }
}
DI void wait_mod(const Params& p) {
  if (threadIdx.x == 0) {
    while (__hip_atomic_load(p.modctr, __ATOMIC_RELAXED, __HIP_MEMORY_SCOPE_AGENT) < 384u) __builtin_amdgcn_s_sleep(8);
    __threadfence();
  }
  __syncthreads();
}
DI void phase0b(const Params& p, char* smem) {
  const int t = tid_();
  const int nT = p.n_ttiles;
  __syncthreads();
  const int G = gridDim.x;
  int u = blockIdx.x;
  float vn[8];
  TTile tn_ = ttile_decode(p, u < nT ? u : 0);
  if (u < nT) ttile_load(tn_, t, vn);
  for (; u < nT; u += G) {
    const TTile tc = tn_;
    float vc[8];
#pragma unroll
    for (int i = 0; i < 8; ++i) vc[i] = vn[i];
    if (u + G < nT) { tn_ = ttile_decode(p, u + G); ttile_load(tn_, t, vn); }
    ttile_store(tc, t, vc, smem);
  }
}

DI void phase1(const Params& p) {
  const int t_ = tid_(); const int lane = t_ & 63, w = t_ >> 6;
  const int gw = blockIdx.x * NWV + w, nw = gridDim.x * NWV;
  for (int R0 = gw; R0 < NT + NC; R0 += 2 * nw) {
    const int R1 = R0 + nw; const bool has1 = R1 < NT + NC;
    const float* src0 = (R0 < NT) ? p.x + (size_t)R0 * DM : p.ctx + (size_t)(R0 - NT) * DM;
    const float* src1 = has1 ? ((R1 < NT) ? p.x + (size_t)R1 * DM : p.ctx + (size_t)(R1 - NT) * DM) : src0;
    const float* md0 = p.mod + ((R0 < NT) ? (R0 >> 11) : 32) * 6144;
    const float* md1 = p.mod + ((has1 && R1 < NT) ? (R1 >> 11) : 32) * 6144;
    float4 v0[4], v1[4]; float s0 = 0.f, s1 = 0.f;
#pragma unroll
    for (int i = 0; i < 4; ++i) { v0[i] = *(const float4*)(src0 + lane * 4 + 256 * i); v1[i] = *(const float4*)(src1 + lane * 4 + 256 * i); }
#pragma unroll
    for (int i = 0; i < 4; ++i) { s0 += v0[i].x * v0[i].x + v0[i].y * v0[i].y + v0[i].z * v0[i].z + v0[i].w * v0[i].w; s1 += v1[i].x * v1[i].x + v1[i].y * v1[i].y + v1[i].z * v1[i].z + v1[i].w * v1[i].w; }
    s0 = wave_sum(s0); s1 = wave_sum(s1);
    const float r0 = rsqrtf(s0 * (1.f / DM) + EPS), r1 = rsqrtf(s1 * (1.f / DM) + EPS);
#pragma unroll
    for (int i = 0; i < 4; ++i) {
      const int d = lane * 4 + 256 * i;
      const float4 g = *(const float4*)(p.norm1_g + d);
      {
        const float4 sh = *(const float4*)(md0 + d), sc = *(const float4*)(md0 + 1024 + d);
        uint2 o; o.x = pk_bf16(v0[i].x * r0 * g.x * (1.f + sc.x) + sh.x, v0[i].y * r0 * g.y * (1.f + sc.y) + sh.y);
        o.y = pk_bf16(v0[i].z * r0 * g.z * (1.f + sc.z) + sh.z, v0[i].w * r0 * g.w * (1.f + sc.w) + sh.w);
        *(uint2*)(p.h + (size_t)R0 * DM + d) = o;
      }
      if (has1) {
        const float4 sh = *(const float4*)(md1 + d), sc = *(const float4*)(md1 + 1024 + d);
        uint2 o; o.x = pk_bf16(v1[i].x * r1 * g.x * (1.f + sc.x) + sh.x, v1[i].y * r1 * g.y * (1.f + sc.y) + sh.y);
        o.y = pk_bf16(v1[i].z * r1 * g.z * (1.f + sc.z) + sh.z, v1[i].w * r1 * g.w * (1.f + sc.w) + sh.w);
        *(uint2*)(p.h + (size_t)R1 * DM + d) = o;
      }
    }
  }
}

DI void phase2(const Params& p, char* smem) {
  const int xcd = blockIdx.x & 7, jl = blockIdx.x >> 3, nl = gridDim.x >> 3;
  auto decode = [&](int L, int& tokTile, int& ft) {
    if (L < 416) { const int tg = L / 104, rem = L % 104; ft = rem >> 3; tokTile = xcd * 32 + tg * 8 + (rem & 7); }
    else { const int u = L - 416; tokTile = 256 + xcd * 4 + (u >> 1); ft = 1 + (u & 1); }
  };
  bool pre = false;
  for (int L = jl; L < 416 + 8; L += nl) {
    int tokTile, ft, tokTileN = 0, ftN = 0;
    decode(L, tokTile, ft);
    const bool lat = L < 416;
    const int Ln = L + nl; const bool hasNext = Ln < 416 + 8;
    if (hasNext) decode(Ln, tokTileN, ftN);
    f32x16 acc[4][2];
#pragma unroll
    for (int a = 0; a < 4; ++a)
#pragma unroll
      for (int b = 0; b < 2; ++b) acc[a][b] = zero16();
    const bf16_t* Ab = p.WinT + (size_t)ft * 256 * DM;
    const bf16_t* Bb = p.h + (size_t)tokTile * 256 * DM;
    const bf16_t* AbN = p.WinT + (size_t)ftN * 256 * DM;
    const bf16_t* BbN = p.h + (size_t)tokTileN * 256 * DM;
    float dummy = 0.f;
    gemm8x<4, 2, 2, 4, false, 2>(acc, [&](int row) { return Ab + (size_t)row * DM; }, [&](int row) { return Bb + (size_t)row * DM; }, DM, smem, dummy,
                              pre, hasNext, [&](int row) { return AbN + (size_t)row * DM; }, [&](int row) { return BbN + (size_t)row * DM; });
    pre = hasNext;
    char* tile = smem + EPI_OFF;
    bf16_t* base; int ld, c0 = 0, c1 = 32;
    if (lat) {
      const size_t tok0 = (size_t)tokTile * 256;
      if (ft < 3) { base = p.pqkv + tok0 * LDQKV + ft * 256; ld = LDQKV; if (ft == 2) c1 = 20; }
      else if (ft < 5) { base = p.pf + tok0 * 512 + (ft - 3) * 256; ld = 512; }
      else { base = p.pg + tok0 * 2048 + (ft - 5) * 256; ld = 2048; }
    } else {
      const size_t ct0 = (size_t)(tokTile - 256) * 256;
      base = p.pckv + ct0 * LDCKV + ft * 256 - 384; ld = LDCKV;
      if (ft == 1) c0 = 16; else c1 = 20;
    }
    if (ft >= 5) stage_half<4, 2, 4, 0>(acc, tile, 528, [](float v) { return sigmoidf_(v); });
    else stage_half<4, 2, 4, 0>(acc, tile, 528, [](float v) { return v; });
    lds_sync();
    copy_tile(tile, 528, 128, 5, [&](int rl) { return base + (size_t)((rl >> 5) * 64 + (rl & 31)) * ld; }, c0, c1);
    lds_sync();
    if (ft >= 5) stage_half<4, 2, 4, 1>(acc, tile, 528, [](float v) { return sigmoidf_(v); });
    else stage_half<4, 2, 4, 1>(acc, tile, 528, [](float v) { return v; });
    lds_sync();
    copy_tile(tile, 528, 128, 5, [&](int rl) { return base + (size_t)((rl >> 5) * 64 + 32 + (rl & 31)) * ld; }, c0, c1);
  }
}

DI void rope_pair(float& x1, float& x2, const float* tab) { const float c = tab[0], s = tab[1]; const float a = x1 * c - x2 * s, b = x2 * c + x1 * s; x1 = a; x2 = b; }

DI void phase3(const Params& p, char* smem) {
  const int t = tid_(), lane = t & 63, w = t >> 6, r = lane & 31, hh = lane >> 5;
  const int nKV = 288, nQ = 256, nCh = 128;
  const int xcd = blockIdx.x & 7, jl = blockIdx.x >> 3, nl = gridDim.x >> 3;
  for (int it = jl; it < nKV + nQ + nCh; it += nl) {
    if (it < nKV) {
      const int tl_ = it >> 3, hd = it & 7;
      const bool lat = tl_ < 32;
      const bf16_t* Bb; int ldb; const bf16_t* kpeb;
      int b, key0;
      if (lat) { const int tokTile = xcd * 32 + tl_; Bb = p.pqkv + (size_t)tokTile * 256 * LDQKV + QL; ldb = LDQKV; kpeb = p.pqkv + (size_t)tokTile * 256 * LDQKV + 640; b = tokTile >> 3; key0 = (tokTile & 7) * 256; }
      else { const int ct = xcd * 4 + (tl_ - 32); Bb = p.pckv + (size_t)ct * 256 * LDCKV; ldb = LDCKV; kpeb = Bb + 256; b = ct; key0 = SEQ; }
      const bf16_t* Ab = p.WkvT + (size_t)hd * 128 * KVL;
      f32x16 acc[4][1];
#pragma unroll
      for (int a = 0; a < 4; ++a) acc[a][0] = zero16();
      float sumsq = 0.f;
      gemm8<4, 1, 1, 8, true>(acc, [&](int row) { return Ab + (size_t)row * KVL; }, [&](int row) { return Bb + (size_t)row * ldb; }, KVL, smem, sumsq);
      sumsq += __shfl_xor(sumsq, 32);
      const float ra = rsqrtf(sumsq * (1.f / KVL) + EPS);
      const int tl = w * 32 + r;
      const int key = key0 + tl;
      float kp[16];
#pragma unroll
      for (int q = 0; q < 4; ++q) {
        const uint2 u = *(const uint2*)(kpeb + (size_t)tl * ldb + 8 * q + 4 * hh);
        kp[4 * q + 0] = bf_lo(u.x); kp[4 * q + 1] = bf_hi(u.x); kp[4 * q + 2] = bf_lo(u.y); kp[4 * q + 3] = bf_hi(u.y);
      }
      float ss = 0.f;
#pragma unroll
      for (int tm = 0; tm < 4; ++tm)
#pragma unroll
        for (int i = 0; i < 16; ++i) { const float v = acc[tm][0][i] * ra; acc[tm][0][i] = v; if (tm < 2) ss += v * v; }
#pragma unroll
      for (int i = 0; i < 16; ++i) ss += kp[i] * kp[i];
      ss += __shfl_xor(ss, 32);
      const float rk = rsqrtf(ss * (1.f / QKD) + EPS);
#pragma unroll
      for (int i = 0; i < 16; ++i) kp[i] *= rk * p.k_norm_g[64 + crow(i, hh)];
      if (lat) {
        const int pos = key;
        const float* tr = p.ropeTab + ((pos >> 6) * 8 + 4 * hh) * 2;
        const float* tc = p.ropeTab + ((pos & 63) * 8 + 4 * hh) * 2;
#pragma unroll
        for (int i = 0; i < 4; ++i) { rope_pair(kp[i], kp[i + 4], tr + 2 * i); rope_pair(kp[8 + i], kp[12 + i], tc + 2 * i); }
      }
      {
        char* kt_ = smem; char* vt_ = smem + 256 * 208;
        char* kd = kt_ + tl * 208;
#pragma unroll
        for (int tm = 0; tm < 2; ++tm)
#pragma unroll
          for (int q = 0; q < 4; ++q) {
            const int f = tm * 32 + 8 * q + 4 * hh;
            const float4 g = *(const float4*)(p.k_norm_g + f);
            uint2 o; o.x = pk_bf16(acc[tm][0][4 * q] * rk * g.x, acc[tm][0][4 * q + 1] * rk * g.y); o.y = pk_bf16(acc[tm][0][4 * q + 2] * rk * g.z, acc[tm][0][4 * q + 3] * rk * g.w);
            *(uint2*)(kd + f * 2) = o;
          }
#pragma unroll
        for (int q = 0; q < 4; ++q) {
          uint2 o; o.x = pk_bf16(kp[4 * q], kp[4 * q + 1]); o.y = pk_bf16(kp[4 * q + 2], kp[4 * q + 3]);
          *(uint2*)(kd + (64 + 8 * q + 4 * hh) * 2) = o;
        }
#pragma unroll
        for (int tm = 2; tm < 4; ++tm)
#pragma unroll
          for (int i = 0; i < 16; ++i) *(bf16_t*)(vt_ + ((tm - 2) * 32 + crow(i, hh)) * 528 + tl * 2) = f2bf(acc[tm][0][i]);
        lds_sync();
        const int tc_ = tid_();
        bf16_t* Kg = p.K + ((size_t)(b * NH + hd) * NKEY + key0) * QKD;
#pragma unroll
        for (int i = 0; i < 6; ++i) {
          const int id = tc_ + NTH * i, row = id / 12, ch = id % 12;
          *(uint4*)(Kg + row * QKD + ch * 8) = *(const uint4*)(kt_ + row * 208 + ch * 16);
        }
        bf16_t* Vg = p.Vt + (size_t)(b * NH + hd) * VD * NKEY + key0;
#pragma unroll
        for (int i = 0; i < 4; ++i) {
          const int row = (tc_ >> 5) + 16 * i, ch = tc_ & 31;
          *(uint4*)(Vg + (size_t)row * NKEY + ch * 8) = *(const uint4*)(vt_ + row * 528 + ch * 16);
        }
        lds_sync();
      }
    } else if (it < nKV + nQ) {
      const int u = it - nKV;
      const int tokTile = xcd * 32 + (u >> 3), hd = u & 7;
      const bf16_t* Bb = p.pqkv + (size_t)tokTile * 256 * LDQKV;
      const bf16_t* Ab = p.WqT + (size_t)hd * QKD * QL;
      f32x16 acc[3][1];
#pragma unroll
      for (int a = 0; a < 3; ++a) acc[a][0] = zero16();
      float sumsq = 0.f;
      gemm8<3, 1, 1, 8, true>(acc, [&](int row) { return Ab + (size_t)row * QL; }, [&](int row) { return Bb + (size_t)row * LDQKV; }, QL, smem, sumsq);
      sumsq += __shfl_xor(sumsq, 32);
      const float ra = rsqrtf(sumsq * (1.f / QL) + EPS);
      const int tl = w * 32 + r;
      const int b = tokTile >> 3, pos = (tokTile & 7) * 256 + tl;
      float ss = 0.f;
#pragma unroll
      for (int tm = 0; tm < 3; ++tm)
#pragma unroll
        for (int i = 0; i < 16; ++i) { const float v = acc[tm][0][i] * ra; acc[tm][0][i] = v; ss += v * v; }
      ss += __shfl_xor(ss, 32);
      const float rh = rsqrtf(ss * (1.f / QKD) + EPS);
#pragma unroll
      for (int tm = 0; tm < 3; ++tm)
#pragma unroll
        for (int q = 0; q < 4; ++q) {
          const float4 g = *(const float4*)(p.q_norm_g + tm * 32 + 8 * q + 4 * hh);
          acc[tm][0][4 * q] *= rh * g.x; acc[tm][0][4 * q + 1] *= rh * g.y; acc[tm][0][4 * q + 2] *= rh * g.z; acc[tm][0][4 * q + 3] *= rh * g.w;
        }
      {
        const float* tr = p.ropeTab + ((pos >> 6) * 8 + 4 * hh) * 2;
        const float* tc = p.ropeTab + ((pos & 63) * 8 + 4 * hh) * 2;
#pragma unroll
        for (int i = 0; i < 4; ++i) {
          float a0 = acc[2][0][i], a1 = acc[2][0][i + 4], c0 = acc[2][0][8 + i], c1 = acc[2][0][12 + i];
          rope_pair(a0, a1, tr + 2 * i); rope_pair(c0, c1, tc + 2 * i);
          acc[2][0][i] = a0; acc[2][0][i + 4] = a1; acc[2][0][8 + i] = c0; acc[2][0][12 + i] = c1;
        }
      }
      const float qs = 0.10206207261596575f * 1.4426950408889634f;
      {
        char* qd = smem + tl * 208;
#pragma unroll
        for (int tm = 0; tm < 3; ++tm)
#pragma unroll
          for (int q = 0; q < 4; ++q) {
            uint2 o; o.x = pk_bf16(acc[tm][0][4 * q] * qs, acc[tm][0][4 * q + 1] * qs); o.y = pk_bf16(acc[tm][0][4 * q + 2] * qs, acc[tm][0][4 * q + 3] * qs);
            *(uint2*)(qd + (tm * 32 + 8 * q + 4 * hh) * 2) = o;
          }
        lds_sync();
        const int tc_ = tid_();
        bf16_t* Qg = p.Q + ((size_t)(b * NH + hd) * SEQ + (tokTile & 7) * 256) * QKD;
#pragma unroll
        for (int i = 0; i < 6; ++i) {
          const int id = tc_ + NTH * i, row = id / 12, ch = id % 12;
          *(uint4*)(Qg + row * QKD + ch * 8) = *(const uint4*)(smem + row * 208 + ch * 16);
        }
        lds_sync();
      }
    } else {
      const int u = it - nKV - nQ;
      const int tt = u & 7, g = (u >> 3) & 3, b = xcd * 4 + (u >> 5);
      const bf16_t* Tb = p.chanT;
      const bf16_t* Fb = p.pf + (size_t)(b * SEQ + tt * 256) * 512 + g * 128;
      f32x16 acc[4][2];
#pragma unroll
      for (int a = 0; a < 4; ++a)
#pragma unroll
        for (int c = 0; c < 2; ++c) acc[a][c] = zero16();
      float dummy = 0.f;
      gemm8<4, 2, 2, 4, false>(acc, [&](int row) { return Fb + (size_t)row * 512; }, [&](int row) { return Tb + (size_t)row * 128; }, 128, smem, dummy);
      stage_tile<4, 2, 2, 4>(acc, smem, 528, [](float v) { return v; });
      lds_sync();
      bf16_t* dst0 = p.ABt + ((size_t)(b * 512 + g * 128)) * 4096 + tt * 256;
      copy_tile(smem, 528, 256, 5, [&](int row) { return dst0 + (size_t)(row & 127) * 4096 + (row >> 7) * 2048; }, 0, 32);
      lds_sync();
    }
  }
}

DI void attn_item(const Params& p, int it, char* smem) {
  const int t = tid_(), lane = t & 63, w = t >> 6, r = lane & 31, hh = lane >> 5;
  const int qt = it & 7, bh = it >> 3;
  constexpr int KROW = 208, VROW = 136, KBYTES = 64 * KROW, STAGE = KBYTES + 64 * VROW;
  const bf16_t* Kb = p.K + (size_t)bh * NKEY * QKD;
  const bf16_t* Vb = p.Vt + (size_t)bh * VD * NKEY;
  const int qpos = qt * 256 + w * 32 + r;
  const bf16_t* Qp = p.Q + ((size_t)bh * SEQ + qpos) * QKD + hh * 8;
  bf16x8 qf[6];
#pragma unroll
  for (int c = 0; c < 6; ++c) qf[c] = *(const bf16x8*)(Qp + c * 16);
  f32x16 o[2]; o[0] = zero16(); o[1] = zero16();
  float gk = 0.f;
  for (int f = 0; f < QKD; ++f) gk = fmaxf(gk, fabsf(p.k_norm_g[f]));
  float qss = 0.f;
#pragma unroll
  for (int c = 0; c < 6; ++c) {
    const uint4 u = __builtin_bit_cast(uint4, qf[c]);
    const float e0 = bf_lo(u.x), e1 = bf_hi(u.x), e2 = bf_lo(u.y), e3 = bf_hi(u.y), e4 = bf_lo(u.z), e5 = bf_hi(u.z), e6 = bf_lo(u.w), e7 = bf_hi(u.w);
    qss += e0 * e0 + e1 * e1 + e2 * e2 + e3 * e3 + e4 * e4 + e5 * e5 + e6 * e6 + e7 * e7;
  }
  qss += __shfl_xor(qss, 32);
  const float negC = -(sqrtf(qss) * gk * 9.797959f * 1.01f);
  f32x16 sinit;
#pragma unroll
  for (int i = 0; i < 16; ++i) sinit[i] = negC;
  float lrun = 0.f;
  const int kid0 = t, kid1 = (t & 255) + 512;
  const bool k1v = t < 256;
  const int kgo0 = (kid0 / 12) * QKD + (kid0 % 12) * 8, kgo1 = (kid1 / 12) * QKD + (kid1 % 12) * 8;
  const int klo0 = (kid0 / 12) * KROW + (kid0 % 12) * 16, klo1 = (kid1 / 12) * KROW + (kid1 % 12) * 16;
  const int vgo0 = (t >> 3) * NKEY + (t & 7) * 8;
  const int vlo0 = KBYTES + (t >> 3) * VROW + (t & 7) * 16;
  uint4 rk0, rk1, rv0;
  rk0 = *(const uint4*)(Kb + kgo0); rk1 = *(const uint4*)(Kb + kgo1);
  rv0 = *(const uint4*)(Vb + vgo0);
  SB_;
#define ATT_STORE(base) do { \
    *(uint4*)((base) + klo0) = rk0; if (k1v) *(uint4*)((base) + klo1) = rk1; \
    { uint2* d = (uint2*)((base) + vlo0); d[0] = make_uint2(rv0.x, rv0.y); d[1] = make_uint2(rv0.z, rv0.w); } } while (0)
  ATT_STORE(smem);
  __syncthreads();
  constexpr int NKT = NKEY / 64;
  for (int kt = 0; kt < NKT; ++kt) {
    const char* cur = smem + (kt & 1) * STAGE;
    const bool more = kt + 1 < NKT;
    if (more) {
      const bf16_t* kn = Kb + (size_t)(kt + 1) * 64 * QKD; const bf16_t* vn = Vb + (kt + 1) * 64;
      rk0 = *(const uint4*)(kn + kgo0); rk1 = *(const uint4*)(kn + kgo1);
      rv0 = *(const uint4*)(vn + vgo0);
    }
    SB_;
    f32x16 s[2];
#pragma unroll
    for (int t2 = 0; t2 < 2; ++t2) {
      const char* kp = cur + (t2 * 32 + r) * KROW + hh * 16;
      { const bf16x8 kf = *(const bf16x8*)(kp); s[t2] = MFMA(kf, qf[0], sinit); }
#pragma unroll
      for (int c = 1; c < 6; ++c) { const bf16x8 kf = *(const bf16x8*)(kp + c * 32); s[t2] = MFMA(kf, qf[c], s[t2]); }
    }
    SB_;
    float ls = 0.f;
#pragma unroll
    for (int t2 = 0; t2 < 2; ++t2)
#pragma unroll
      for (int i = 0; i < 16; ++i) { const float e = __builtin_amdgcn_exp2f(s[t2][i]); s[t2][i] = e; ls += e; }
    lrun += ls;
    SB_;
#pragma unroll
    for (int t2 = 0; t2 < 2; ++t2)
#pragma unroll
      for (int s2 = 0; s2 < 2; ++s2) {
        uint4 pu;
        pu.x = pk_bf16(s[t2][8 * s2 + 0], s[t2][8 * s2 + 1]); pu.y = pk_bf16(s[t2][8 * s2 + 2], s[t2][8 * s2 + 3]);
        pu.z = pk_bf16(s[t2][8 * s2 + 4], s[t2][8 * s2 + 5]); pu.w = pk_bf16(s[t2][8 * s2 + 6], s[t2][8 * s2 + 7]);
        const bf16x8 pb = __builtin_bit_cast(bf16x8, pu);
#pragma unroll
        for (int vt = 0; vt < 2; ++vt) {
          const char* vp = cur + KBYTES + (vt * 32 + r) * VROW + (t2 * 32 + 16 * s2 + 4 * hh) * 2;
          const uint2 lo = *(const uint2*)(vp), hi = *(const uint2*)(vp + 16);
          uint4 vu; vu.x = lo.x; vu.y = lo.y; vu.z = hi.x; vu.w = hi.y;
          o[vt] = MFMA(__builtin_bit_cast(bf16x8, vu), pb, o[vt]);
        }
      }
    SB_;
    if (more) { char* nxt = smem + ((kt + 1) & 1) * STAGE; ATT_STORE(nxt); }
    __syncthreads();
  }
  lrun += __shfl_xor(lrun, 32);
  const float inv = 1.f / lrun;
  const int b = bh >> 3, hd = bh & 7;
  bf16_t* od = p.attn_o + (size_t)(b * SEQ + qpos) * 512 + hd * 64;
#pragma unroll
  for (int vt = 0; vt < 2; ++vt)
#pragma unroll
    for (int q = 0; q < 4; ++q) {
      uint2 ou; ou.x = pk_bf16(o[vt][4 * q] * inv, o[vt][4 * q + 1] * inv); ou.y = pk_bf16(o[vt][4 * q + 2] * inv, o[vt][4 * q + 3] * inv);
      *(uint2*)(od + vt * 32 + 8 * q + 4 * hh) = ou;
    }
}

DI void attn_item64(const Params& p, int it, char* smem) {
  const int t = tid_(), lane = t & 63, w = t >> 6, r = lane & 31, hh = lane >> 5;
  const int qt = it & 3, bh = it >> 2;
  constexpr int KROW = 192, VROW = 136, KBYTES = 64 * KROW, STAGE = KBYTES + 64 * VROW;
  const bf16_t* Kb = p.K + (size_t)bh * NKEY * QKD;
  const bf16_t* Vb = p.Vt + (size_t)bh * VD * NKEY;
  const int qposa = qt * 512 + w * 64 + r, qposb = qposa + 32;
  const bf16_t* Qa = p.Q + ((size_t)bh * SEQ + qposa) * QKD + hh * 8;
  bf16x8 qfa[6], qfb[6];
#pragma unroll
  for (int c = 0; c < 6; ++c) { qfa[c] = *(const bf16x8*)(Qa + c * 16); qfb[c] = *(const bf16x8*)(Qa + 32 * QKD + c * 16); }
  f32x16 oa[2], ob[2]; oa[0] = zero16(); oa[1] = zero16(); ob[0] = zero16(); ob[1] = zero16();
  float gk = 0.f;
  for (int f = 0; f < QKD; ++f) gk = fmaxf(gk, fabsf(p.k_norm_g[f]));
  float qsa = 0.f, qsb = 0.f;
#pragma unroll
  for (int c = 0; c < 6; ++c) {
    const uint4 u = __builtin_bit_cast(uint4, qfa[c]), v = __builtin_bit_cast(uint4, qfb[c]);
    qsa += bf_lo(u.x) * bf_lo(u.x) + bf_hi(u.x) * bf_hi(u.x) + bf_lo(u.y) * bf_lo(u.y) + bf_hi(u.y) * bf_hi(u.y) + bf_lo(u.z) * bf_lo(u.z) + bf_hi(u.z) * bf_hi(u.z) + bf_lo(u.w) * bf_lo(u.w) + bf_hi(u.w) * bf_hi(u.w);
    qsb += bf_lo(v.x) * bf_lo(v.x) + bf_hi(v.x) * bf_hi(v.x) + bf_lo(v.y) * bf_lo(v.y) + bf_hi(v.y) * bf_hi(v.y) + bf_lo(v.z) * bf_lo(v.z) + bf_hi(v.z) * bf_hi(v.z) + bf_lo(v.w) * bf_lo(v.w) + bf_hi(v.w) * bf_hi(v.w);
  }
  qsa += __shfl_xor(qsa, 32); qsb += __shfl_xor(qsb, 32);
  const float negC = -(sqrtf(fmaxf(qsa, qsb)) * gk * 9.797959f * 1.01f);
  f32x16 sinit;
#pragma unroll
  for (int i = 0; i < 16; ++i) sinit[i] = negC;
  float la = 0.f, lb = 0.f;
  const int kid0 = t, kid1 = (t & 255) + 512;
  const bool k1v = t < 256;
  const int kgo0 = (kid0 / 12) * QKD + (((kid0 % 12) ^ (((kid0 / 12) >> 2) & 3))) * 8, kgo1 = (kid1 / 12) * QKD + (((kid1 % 12) ^ (((kid1 / 12) >> 2) & 3))) * 8;
  const int klo0 = kid0 * 16, klo1 = kid1 * 16;
  const int vgo0 = (t >> 3) * NKEY + (t & 7) * 8;
  const int vlo0 = KBYTES + (t >> 3) * VROW + (t & 7) * 16;
  uint4 rv0;
  GLDS(Kb + kgo0, smem + klo0); if (k1v) GLDS(Kb + kgo1, smem + klo1);
  rv0 = *(const uint4*)(Vb + vgo0);
  SB_;
#define ATT64_STORE(base) do { \
    { uint2* d = (uint2*)((base) + vlo0); d[0] = make_uint2(rv0.x, rv0.y); d[1] = make_uint2(rv0.z, rv0.w); } } while (0)
  ATT64_STORE(smem);
  __syncthreads();
  const int sw = (r >> 2) & 3;
  const int sb32 = ((sw >> 1) & 1) * 32;
  const int swo = ((hh ^ (sw & 1)) << 4) + sb32;
  constexpr int NKT = NKEY / 64;
  for (int kt = 0; kt < NKT; ++kt) {
    const char* cur = smem + (kt & 1) * STAGE;
    const bool more = kt + 1 < NKT;
    if (more) {
      const bf16_t* kn = Kb + (size_t)(kt + 1) * 64 * QKD; const bf16_t* vn = Vb + (kt + 1) * 64;
      char* nx = smem + ((kt + 1) & 1) * STAGE;
      GLDS(kn + kgo0, nx + klo0); if (k1v) GLDS(kn + kgo1, nx + klo1);
      rv0 = *(const uint4*)(vn + vgo0);
    }
    SB_;
#pragma unroll
    for (int t2 = 0; t2 < 2; ++t2) {
      const char* kpe = cur + (t2 * 32 + r) * KROW + swo;
      const char* kpo = kpe - 2 * sb32;
      f32x16 sa, sb;
      { const bf16x8 kf = *(const bf16x8*)(kpe); sa = MFMA(kf, qfa[0], sinit); sb = MFMA(kf, qfb[0], sinit); }
#pragma unroll
      for (int c = 1; c < 6; ++c) { const bf16x8 kf = *(const bf16x8*)(((c & 1) ? kpo : kpe) + c * 32); sa = MFMA(kf, qfa[c], sa); sb = MFMA(kf, qfb[c], sb); }
      SB_;
      float lsa = 0.f, lsb = 0.f;
#pragma unroll
      for (int i = 0; i < 16; ++i) { const float e = __builtin_amdgcn_exp2f(sa[i]); sa[i] = e; lsa += e; const float f = __builtin_amdgcn_exp2f(sb[i]); sb[i] = f; lsb += f; }
      la += lsa; lb += lsb;
      SB_;
#pragma unroll
      for (int s2 = 0; s2 < 2; ++s2) {
        uint4 pu, pv;
        pu.x = pk_bf16(sa[8 * s2 + 0], sa[8 * s2 + 1]); pu.y = pk_bf16(sa[8 * s2 + 2], sa[8 * s2 + 3]); pu.z = pk_bf16(sa[8 * s2 + 4], sa[8 * s2 + 5]); pu.w = pk_bf16(sa[8 * s2 + 6], sa[8 * s2 + 7]);
        pv.x = pk_bf16(sb[8 * s2 + 0], sb[8 * s2 + 1]); pv.y = pk_bf16(sb[8 * s2 + 2], sb[8 * s2 + 3]); pv.z = pk_bf16(sb[8 * s2 + 4], sb[8 * s2 + 5]); pv.w = pk_bf16(sb[8 * s2 + 6], sb[8 * s2 + 7]);
        const bf16x8 pa_ = __builtin_bit_cast(bf16x8, pu), pb_ = __builtin_bit_cast(bf16x8, pv);
#pragma unroll
        for (int vt = 0; vt < 2; ++vt) {
          const char* vp = cur + KBYTES + (vt * 32 + r) * VROW + (t2 * 32 + 16 * s2 + 4 * hh) * 2;
          const uint2 lo = *(const uint2*)(vp), hi = *(const uint2*)(vp + 16);
          uint4 vu; vu.x = lo.x; vu.y = lo.y; vu.z = hi.x; vu.w = hi.y;
          const bf16x8 vf = __builtin_bit_cast(bf16x8, vu);
          oa[vt] = MFMA(vf, pa_, oa[vt]);
          ob[vt] = MFMA(vf, pb_, ob[vt]);
        }
      }
      SB_;
    }
    SB_;
    if (more) { char* nxt = smem + ((kt + 1) & 1) * STAGE; ATT64_STORE(nxt); }
    __syncthreads();
  }
  la += __shfl_xor(la, 32); lb += __shfl_xor(lb, 32);
  const float inva = 1.f / la, invb = 1.f / lb;
  const int b = bh >> 3, hd = bh & 7;
  const int te_ = tid_();
  bf16_t* oda = p.attn_o + (size_t)(b * SEQ + qt * 512 + (te_ >> 6) * 64 + (te_ & 31)) * 512 + hd * 64;
  bf16_t* odb = oda + (size_t)32 * 512;
#pragma unroll
  for (int vt = 0; vt < 2; ++vt)
#pragma unroll
    for (int q = 0; q < 4; ++q) {
      uint2 ou; ou.x = pk_bf16(oa[vt][4 * q] * inva, oa[vt][4 * q + 1] * inva); ou.y = pk_bf16(oa[vt][4 * q + 2] * inva, oa[vt][4 * q + 3] * inva);
      *(uint2*)(oda + vt * 32 + 8 * q + 4 * hh) = ou;
      uint2 ov; ov.x = pk_bf16(ob[vt][4 * q] * invb, ob[vt][4 * q + 1] * invb); ov.y = pk_bf16(ob[vt][4 * q + 2] * invb, ob[vt][4 * q + 3] * invb);
      *(uint2*)(odb + vt * 32 + 8 * q + 4 * hh) = ov;
    }
}

DI void phase4(const Params& p, char* smem) {
  const int t = tid_(), lane = t & 63, w = t >> 6, r = lane & 31, hh = lane >> 5;
  const int nDft = 64, nAlt = 4, nAtt = 128;
  const int xcd = blockIdx.x & 7, jl = blockIdx.x >> 3, nl = gridDim.x >> 3;
  for (int it = jl; it < nDft + nAlt + nAtt; it += nl) {
    if (it < nDft) {
      const int bl = it >> 4, rem = it & 15, ct = rem >> 3, kt = rem & 7, b = xcd * 4 + bl;
      const int wm = w & 3, wn = w >> 2;
      const bf16_t* Ab = p.ABt + (size_t)(b * 512 + ct * 256) * 4096;
      const bf16_t* Cb = p.posM + (size_t)kt * 128 * 2048;
      const bf16_t* Sb = p.posM + (size_t)(1152 + kt * 128) * 2048;
      f32x16 acc1[2][2], acc2[2][2];
#pragma unroll
      for (int a = 0; a < 2; ++a)
#pragma unroll
        for (int c = 0; c < 2; ++c) { acc1[a][c] = zero16(); acc2[a][c] = zero16(); }
      float dummy = 0.f;
      gemm8s3(acc1, [&](int row) { return Ab + (size_t)row * 4096; }, [&](int row) { return Cb + (size_t)row * 2048; }, 2048, smem);
      gemm8s3(acc2, [&](int row) { return Ab + (size_t)row * 4096 + 2048; }, [&](int row) { return Sb + (size_t)row * 2048; }, 2048, smem);
      const float sc = 1.f / 512.f;
#pragma unroll
      for (int tm = 0; tm < 2; ++tm)
#pragma unroll
        for (int tn = 0; tn < 2; ++tn) {
          const int kpos = kt * 128 + wn * 64 + tn * 32 + r;
          const int moff = ct * 256 + wm * 64 + tm * 32 + 4 * hh;
          if (kpos <= 1024) {
            bf16_t* d = p.four_o + (size_t)(b * SEQ + kpos) * 512 + moff;
#pragma unroll
            for (int q = 0; q < 4; ++q) {
              uint2 ou; ou.x = pk_bf16((acc1[tm][tn][4 * q] - acc2[tm][tn][4 * q]) * sc, (acc1[tm][tn][4 * q + 1] - acc2[tm][tn][4 * q + 1]) * sc);
              ou.y = pk_bf16((acc1[tm][tn][4 * q + 2] - acc2[tm][tn][4 * q + 2]) * sc, (acc1[tm][tn][4 * q + 3] - acc2[tm][tn][4 * q + 3]) * sc);
              *(uint2*)(d + 8 * q) = ou;
            }
          }
          if (kpos >= 1 && kpos <= 1023) {
            bf16_t* d = p.four_o + (size_t)(b * SEQ + 2048 - kpos) * 512 + moff;
#pragma unroll
            for (int q = 0; q < 4; ++q) {
              uint2 ou; ou.x = pk_bf16((acc1[tm][tn][4 * q] + acc2[tm][tn][4 * q]) * sc, (acc1[tm][tn][4 * q + 1] + acc2[tm][tn][4 * q + 1]) * sc);
              ou.y = pk_bf16((acc1[tm][tn][4 * q + 2] + acc2[tm][tn][4 * q + 2]) * sc, (acc1[tm][tn][4 * q + 3] + acc2[tm][tn][4 * q + 3]) * sc);
              *(uint2*)(d + 8 * q) = ou;
            }
          }
        }
    } else if (it < nDft + nAlt) {
      const int b = xcd * 4 + (it - nDft);
      const int tl_ = tid_();
      const int lane_ = tl_ & 63;
      for (int m = tl_ >> 6; m < 512; m += NWV) {
        const bf16_t* rowp = p.ABt + (size_t)(b * 512 + m) * 4096 + lane_ * 8;
        float sacc = 0.f;
#pragma unroll
        for (int i = 0; i < 4; ++i) {
          const uint4 u = *(const uint4*)(rowp + 512 * i);
          sacc += (bf_lo(u.x) - bf_hi(u.x)) + (bf_lo(u.y) - bf_hi(u.y)) + (bf_lo(u.z) - bf_hi(u.z)) + (bf_lo(u.w) - bf_hi(u.w));
        }
        sacc = wave_sum(sacc);
        if (lane_ == 0) p.four_o[(size_t)(b * SEQ + 1024) * 512 + m] = f2bf(sacc * (1.f / 512.f));
      }
    } else {
      attn_item64(p, xcd * 128 + (it - nDft - nAlt), smem);
    }
  }
}

DI void phase5(const Params& p, char* smem) {
  const int t = tid_();
  const int xcd = blockIdx.x & 7, jl = blockIdx.x >> 3, nl = gridDim.x >> 3;
  for (int L = jl; L < 256; L += nl) {
    const int tokTile = xcd * 64 + (L >> 5) * 8 + (L & 7), nt = (L >> 3) & 3;
    f32x16 acc1[2][2], acc2[2][2];
#pragma unroll
    for (int a = 0; a < 2; ++a)
#pragma unroll
      for (int c = 0; c < 2; ++c) { acc1[a][c] = zero16(); acc2[a][c] = zero16(); }
    float dummy = 0.f;
    {
      const bf16_t* Ab = p.WoT + (size_t)nt * 256 * 512; const bf16_t* Bb = p.attn_o + (size_t)tokTile * 128 * 512;
      gemm8s3(acc1, [&](int row) { return Ab + (size_t)row * 512; }, [&](int row) { return Bb + (size_t)row * 512; }, 512, smem);
    }
    {
      const bf16_t* Ab = p.WfT + (size_t)nt * 256 * 512; const bf16_t* Bb = p.four_o + (size_t)tokTile * 128 * 512;
      gemm8s3(acc2, [&](int row) { return Ab + (size_t)row * 512; }, [&](int row) { return Bb + (size_t)row * 512; }, 512, smem);
    }
    {
      char* t1 = smem; char* t2 = smem + 128 * 528;
      const int ch = t & 31, r0 = t >> 5;
      stage_tile<2, 2, 4, 2>(acc1, t1, 528, [](float v) { return v; });
      stage_tile<2, 2, 4, 2>(acc2, t2, 528, [](float v) { return v; });
      lds_sync();
#pragma unroll
      for (int hb = 0; hb < 2; ++hb) {
        uint4 gav[4], gbv[4];
#pragma unroll
        for (int i = 0; i < 4; ++i) {
          const size_t tok = (size_t)tokTile * 128 + r0 + 16 * (hb * 4 + i);
          gav[i] = *(const uint4*)(p.pg + tok * 2048 + nt * 256 + ch * 8); gbv[i] = *(const uint4*)(p.pg + tok * 2048 + 1024 + nt * 256 + ch * 8);
        }
#pragma unroll
        for (int i = 0; i < 4; ++i) {
          const int row = r0 + 16 * (hb * 4 + i);
          const size_t tok = (size_t)tokTile * 128 + row;
          const uint4 u1 = *(const uint4*)(t1 + row * 528 + ch * 16), u2 = *(const uint4*)(t2 + row * 528 + ch * 16);
          const uint4 ga = gav[i], gb = gbv[i];
          uint4 o;
          o.x = pk_bf16(bf_lo(ga.x) * bf_lo(u1.x) + bf_lo(gb.x) * bf_lo(u2.x), bf_hi(ga.x) * bf_hi(u1.x) + bf_hi(gb.x) * bf_hi(u2.x));
          o.y = pk_bf16(bf_lo(ga.y) * bf_lo(u1.y) + bf_lo(gb.y) * bf_lo(u2.y), bf_hi(ga.y) * bf_hi(u1.y) + bf_hi(gb.y) * bf_hi(u2.y));
          o.z = pk_bf16(bf_lo(ga.z) * bf_lo(u1.z) + bf_lo(gb.z) * bf_lo(u2.z), bf_hi(ga.z) * bf_hi(u1.z) + bf_hi(gb.z) * bf_hi(u2.z));
          o.w = pk_bf16(bf_lo(ga.w) * bf_lo(u1.w) + bf_lo(gb.w) * bf_lo(u2.w), bf_hi(ga.w) * bf_hi(u1.w) + bf_hi(gb.w) * bf_hi(u2.w));
          *(uint4*)(p.m + tok * DM + nt * 256 + ch * 8) = o;
        }
      }
      lds_sync();
    }
  }
}

DI void phase6(const Params& p, char* smem) {
  const int t = tid_(), lane = t & 63, w = t >> 6, r = lane & 31, hh = lane >> 5;
  const int wm = w & 1, wn = w >> 1;
  const int xcd = blockIdx.x & 7, jl = blockIdx.x >> 3, nl = gridDim.x >> 3;
  for (int L = jl; L < 128; L += nl) {
    const int tokTile = xcd * 32 + (L >> 5) * 8 + (L & 7), nt = (L >> 3) & 3;
    f32x16 acc[4][2];
#pragma unroll
    for (int a = 0; a < 4; ++a)
#pragma unroll
      for (int c = 0; c < 2; ++c) acc[a][c] = zero16();
    float dummy = 0.f;
    const bf16_t* Wb = p.WoutT + (size_t)nt * 256 * DM; const bf16_t* Mb = p.m + (size_t)tokTile * 256 * DM;
    gemm8<4, 2, 2, 4, false>(acc, [&](int row) { return Wb + (size_t)row * DM; }, [&](int row) { return Mb + (size_t)row * DM; }, DM, smem, dummy);
    const int tc_ = tid_();
    const int ch = tc_ & 63, r0 = tc_ >> 6;
    const float4 g = *(const float4*)(p.mod + (tokTile >> 3) * 6144 + 2048 + nt * 256 + ch * 4);
#pragma unroll
    for (int tn = 0; tn < 2; ++tn) {
      const size_t obase = ((size_t)tokTile * 256 + tn * 32) * DM + nt * 256 + ch * 4;
#pragma unroll
      for (int tm = 0; tm < 4; ++tm) {
        char* d = smem + (wn * 32 + r) * 1040 + (wm * 128 + tm * 32 + 4 * hh) * 4;
#pragma unroll
        for (int q = 0; q < 4; ++q) *(float4*)(d + 32 * q) = make_float4(acc[tm][tn][4 * q], acc[tm][tn][4 * q + 1], acc[tm][tn][4 * q + 2], acc[tm][tn][4 * q + 3]);
      }
      lds_sync();
#pragma unroll
      for (int hb = 0; hb < 2; ++hb) {
        float4 xv[8];
#pragma unroll
        for (int i = 0; i < 8; ++i) {
          const int row = r0 + 8 * (hb * 8 + i);
          xv[i] = *(const float4*)(p.x + obase + (size_t)((row >> 5) * 64 + (row & 31)) * DM);
        }
#pragma unroll
        for (int i = 0; i < 8; ++i) {
          const int row = r0 + 8 * (hb * 8 + i);
          const float4 a = *(const float4*)(smem + row * 1040 + ch * 16);
          uint2 ob; ob.x = pk_bf16(xv[i].x + g.x * a.x, xv[i].y + g.y * a.y); ob.y = pk_bf16(xv[i].z + g.z * a.z, xv[i].w + g.w * a.w);
          *(uint2*)(p.x1b + obase + (size_t)((row >> 5) * 64 + (row & 31)) * DM) = ob;
        }
      }
      lds_sync();
    }
  }
}

DI void phase7(const Params& p, char* smem) {
  const int t = tid_(), lane = t & 63, w = t >> 6;
  float* wr = (float*)smem;
  for (int idx = t; idx < DM * NE; idx += NTH) { const int d = idx >> 4, e = idx & 15; wr[e * DM + d] = p.w_router[idx]; }
  __syncthreads();
  const int gw = blockIdx.x * NWV + w, nw = gridDim.x * NWV;
  auto router = [&](const float4 (&v)[4], int R) {
    asm volatile("" ::: "memory");
    float a[16];
#pragma unroll
    for (int e = 0; e < 16; ++e) {
      float s = 0.f;
#pragma unroll
      for (int i = 0; i < 4; ++i) { const float4 wv = *(const float4*)(wr + e * DM + lane * 4 + 256 * i); s += v[i].x * wv.x + v[i].y * wv.y + v[i].z * wv.z + v[i].w * wv.w; }
      a[e] = s;
      if ((e & 3) == 3) __builtin_amdgcn_sched_barrier(0);
    }
    float a8[8], a4[4], a2[2], a1;
    {
      const bool up = lane & 32;
#pragma unroll
      for (int j = 0; j < 8; ++j) { const float send = up ? a[j] : a[j + 8]; const float keep = up ? a[j + 8] : a[j]; a8[j] = keep + __shfl_xor(send, 32); }
    }
    {
      const bool up = lane & 16;
#pragma unroll
      for (int j = 0; j < 4; ++j) { const float send = up ? a8[j] : a8[j + 4]; const float keep = up ? a8[j + 4] : a8[j]; a4[j] = keep + __shfl_xor(send, 16); }
    }
    {
      const bool up = lane & 8;
#pragma unroll
      for (int j = 0; j < 2; ++j) { const float send = up ? a4[j] : a4[j + 2]; const float keep = up ? a4[j + 2] : a4[j]; a2[j] = keep + __shfl_xor(send, 8); }
    }
    {
      const bool up = lane & 4;
      const float send = up ? a2[0] : a2[1]; const float keep = up ? a2[1] : a2[0]; a1 = keep + __shfl_xor(send, 4);
    }
    a1 += __shfl_xor(a1, 2);
    a1 += __shfl_xor(a1, 1);
    float mx = a1;
#pragma unroll
    for (int o = 4; o <= 32; o <<= 1) mx = fmaxf(mx, __shfl_xor(mx, o));
    const float ex = __expf(a1 - mx);
    float sm = ex;
#pragma unroll
    for (int o = 4; o <= 32; o <<= 1) sm += __shfl_xor(sm, o);
    if ((lane & 3) == 0) {
      const int e = (lane >> 2) & 15;
      p.aff[((size_t)((R >> 11) * NE + e)) * SEQ + (R & 2047)] = ex / sm;
    }
  };
  for (int R0 = gw; R0 < NT; R0 += 2 * nw) {
    const int R1 = R0 + nw;
    const bool has1 = R1 < NT;
    const bf16_t* src0 = p.x1b + (size_t)R0 * DM;
    const bf16_t* src1 = p.x1b + (size_t)(has1 ? R1 : R0) * DM;
    const float* md0 = p.mod + (R0 >> 11) * 6144;
    const float* md1 = p.mod + ((has1 ? R1 : R0) >> 11) * 6144;
    float4 v0[4], v1[4]; float s0 = 0.f, s1 = 0.f;
#pragma unroll
    for (int i = 0; i < 4; ++i) {
      const uint2 u0 = *(const uint2*)(src0 + lane * 4 + 256 * i), u1 = *(const uint2*)(src1 + lane * 4 + 256 * i);
      v0[i] = make_float4(bf_lo(u0.x), bf_hi(u0.x), bf_lo(u0.y), bf_hi(u0.y)); v1[i] = make_float4(bf_lo(u1.x), bf_hi(u1.x), bf_lo(u1.y), bf_hi(u1.y));
    }
#pragma unroll
    for (int i = 0; i < 4; ++i) { s0 += v0[i].x * v0[i].x + v0[i].y * v0[i].y + v0[i].z * v0[i].z + v0[i].w * v0[i].w; s1 += v1[i].x * v1[i].x + v1[i].y * v1[i].y + v1[i].z * v1[i].z + v1[i].w * v1[i].w; }
    s0 = wave_sum(s0); s1 = wave_sum(s1);
    const float r0 = rsqrtf(s0 * (1.f / DM) + EPS), r1 = rsqrtf(s1 * (1.f / DM) + EPS);
#pragma unroll
    for (int i = 0; i < 4; ++i) {
      const int d = lane * 4 + 256 * i;
      const float4 g = *(const float4*)(p.norm2_g + d);
      {
        const float4 sh = *(const float4*)(md0 + 3072 + d), sc = *(const float4*)(md0 + 4096 + d);
        v0[i].x = v0[i].x * r0 * g.x * (1.f + sc.x) + sh.x; v0[i].y = v0[i].y * r0 * g.y * (1.f + sc.y) + sh.y;
        v0[i].z = v0[i].z * r0 * g.z * (1.f + sc.z) + sh.z; v0[i].w = v0[i].w * r0 * g.w * (1.f + sc.w) + sh.w;
        uint2 o; o.x = pk_bf16(v0[i].x, v0[i].y); o.y = pk_bf16(v0[i].z, v0[i].w);
        *(uint2*)(p.h2 + (size_t)R0 * DM + d) = o;
      }
      if (has1) {
        const float4 sh = *(const float4*)(md1 + 3072 + d), sc = *(const float4*)(md1 + 4096 + d);
        v1[i].x = v1[i].x * r1 * g.x * (1.f + sc.x) + sh.x; v1[i].y = v1[i].y * r1 * g.y * (1.f + sc.y) + sh.y;
        v1[i].z = v1[i].z * r1 * g.z * (1.f + sc.z) + sh.z; v1[i].w = v1[i].w * r1 * g.w * (1.f + sc.w) + sh.w;
        uint2 o; o.x = pk_bf16(v1[i].x, v1[i].y); o.y = pk_bf16(v1[i].z, v1[i].w);
        *(uint2*)(p.h2 + (size_t)R1 * DM + d) = o;
      }
    }
    SB_;
    router(v0, R0);
    SB_;
    if (has1) router(v1, R1);
    SB_;
  }
}

DI void phase8(const Params& p) {
  const int t_ = tid_(); const int lane = t_ & 63, w = t_ >> 6;
  const int gw = w * gridDim.x + blockIdx.x, nw = gridDim.x * NWV;
  for (int pr = gw; pr < NB * NE; pr += nw) {
    const float* a = p.aff + (size_t)pr * SEQ;
    unsigned u[32];
#pragma unroll
    for (int q = 0; q < 32; ++q) u[q] = __float_as_uint(a[q * 64 + lane]);
    unsigned thr = 0;
    for (int bit = 30; bit >= 0; --bit) {
      const unsigned cand = thr | (1u << bit);
      int cnt = 0;
#pragma unroll
      for (int q = 0; q < 32; ++q) cnt += __popcll(__ballot(u[q] >= cand));
      if (cnt >= CAP) thr = cand;
    }
    int ngt = 0;
#pragma unroll
    for (int q = 0; q < 32; ++q) ngt += __popcll(__ballot(u[q] > thr));
    int cgt = 0, ceq = 0;
    int* io = p.idx + pr * CAP; float* go = p.gate + pr * CAP;
    int* iv = p.inv + (size_t)pr * SEQ;
#pragma unroll
    for (int q = 0; q < 32; ++q) {
      const bool gt = u[q] > thr, eq = u[q] == thr;
      const unsigned long long mg = __ballot(gt), me = __ballot(eq);
      const unsigned long long below = (1ull << lane) - 1ull;
      int myslot = -1;
      if (gt) { const int s = cgt + __popcll(mg & below); io[s] = q * 64 + lane; go[s] = __uint_as_float(u[q]); myslot = s; }
      if (eq) { const int s = ngt + ceq + __popcll(me & below); if (s < CAP) { io[s] = q * 64 + lane; go[s] = __uint_as_float(u[q]); myslot = s; } }
      iv[q * 64 + lane] = myslot;
      cgt += __popcll(mg); ceq += __popcll(me);
    }
  }
}

DI void phase9(const Params& p, char* smem) {
  const int t = tid_(), lane = t & 63, w = t >> 6, r = lane & 31, hh = lane >> 5;
  const int wm = w & 1, wn = w >> 1;
  const int xcd = blockIdx.x & 7, jl = blockIdx.x >> 3, nl = gridDim.x >> 3;
  auto decode = [&](int L, int& e, int& ft, int& b) { e = xcd * 2 + (L >> 7); const int rem = L & 127; ft = (rem >> 3) & 3; b = (rem >> 5) * 8 + (rem & 7); };
  bool pre = false;
  for (int L = jl; L < 256; L += nl) {
    int e, ft, b, eN = 0, ftN = 0, bN = 0;
    decode(L, e, ft, b);
    const int Ln = L + nl; const bool hasNext = Ln < 256;
    if (hasNext) decode(Ln, eN, ftN, bN);
    const int be = b * NE + e;
    const bf16_t* Ab = p.WguT + ((size_t)e * 1024 + ft * 256) * DM;
    const int* ib = p.idx + be * CAP;
    const bf16_t* hb = p.h2 + (size_t)b * SEQ * DM;
    const bf16_t* AbN = p.WguT + ((size_t)eN * 1024 + ftN * 256) * DM;
    const int* ibN = p.idx + (bN * NE + eN) * CAP;
    const bf16_t* hbN = p.h2 + (size_t)bN * SEQ * DM;
    f32x16 acc[4][2];
#pragma unroll
    for (int a = 0; a < 4; ++a)
#pragma unroll
      for (int c = 0; c < 2; ++c) acc[a][c] = zero16();
    float dummy = 0.f;
    gemm8x<4, 2, 2, 4, false, 2>(acc, [&](int row) { return Ab + (size_t)row * DM; }, [&](int row) { return hb + (size_t)ib[row] * DM; }, DM, smem, dummy,
                              pre, hasNext, [&](int row) { return AbN + (size_t)row * DM; }, [&](int row) { return hbN + (size_t)ibN[row] * DM; });
    pre = hasNext;
    char* tile = smem + EPI_OFF;
#pragma unroll
    for (int tn = 0; tn < 2; ++tn)
#pragma unroll
      for (int pr = 0; pr < 2; ++pr) {
        char* d = tile + (wn * 64 + tn * 32 + r) * 272 + (wm * 64 + pr * 32 + 4 * hh) * 2;
#pragma unroll
        for (int q = 0; q < 4; ++q) {
          float v[4];
#pragma unroll
          for (int j = 0; j < 4; ++j) { const float g = acc[2 * pr][tn][4 * q + j], uu = acc[2 * pr + 1][tn][4 * q + j]; v[j] = g * sigmoidf_(g) * uu; }
          uint2 ou; ou.x = pk_bf16(v[0], v[1]); ou.y = pk_bf16(v[2], v[3]);
          *(uint2*)(d + 16 * q) = ou;
        }
      }
    lds_sync();
    bf16_t* hd_ = p.hmid + (size_t)be * CAP * DE + ft * 128;
    copy_tile(tile, 272, 256, 4, [&](int row) { return hd_ + (size_t)row * DE; }, 0, 16);
  }
}

DI void phase10(const Params& p, char* smem) {
  const int xcd = blockIdx.x & 7, jl = blockIdx.x >> 3, nl = gridDim.x >> 3;
  for (int L = jl; L < 512; L += nl) {
    const int e = xcd * 2 + (L >> 8), rem = L & 255, nt = (rem >> 3) & 3, st = (rem >> 5) & 1, b = (rem >> 6) * 8 + (rem & 7);
    const int be = b * NE + e;
    const bf16_t* Hb = p.hmid + ((size_t)be * CAP + st * 128) * DE;
    const bf16_t* Wb = p.WdT + ((size_t)e * DM + nt * 256) * DE;
    f32x16 acc[2][2];
#pragma unroll
    for (int a = 0; a < 2; ++a)
#pragma unroll
      for (int c = 0; c < 2; ++c) acc[a][c] = zero16();
    gemm8s3(acc, [&](int row) { return Wb + (size_t)row * DE; }, [&](int row) { return Hb + (size_t)row * DE; }, DE, smem);
    stage_tile<2, 2, 4, 2>(acc, smem, 528, [](float v) { return v; });
    lds_sync();
    bf16_t* yb = p.Y + ((size_t)be * CAP + st * 128) * DM + nt * 256;
    copy_tile(smem, 528, 128, 5, [&](int row) { return yb + (size_t)row * DM; }, 0, 32);
    lds_sync();
  }
}

DI void phase11(const Params& p) {
  const int t_ = tid_(); const int lane = t_ & 63, w = t_ >> 6;
  const int gw = blockIdx.x * NWV + w, nw = gridDim.x * NWV;
  auto slotOf = [&](int R) { return (lane < NE && R < NT) ? p.inv[((size_t)((R >> 11) * NE + lane)) * SEQ + (R & 2047)] : -1; };
  int nslot = slotOf(gw);
  uint2 nx[4];
  {
    const bf16_t* xs = p.x1b + (size_t)(gw < NT ? gw : 0) * DM + lane * 4;
#pragma unroll
    for (int i = 0; i < 4; ++i) nx[i] = *(const uint2*)(xs + 256 * i);
  }
  for (int R = gw; R < NT; R += nw) {
    const int b = R >> 11;
    const int myslot = nslot;
    uint2 xu[4];
#pragma unroll
    for (int i = 0; i < 4; ++i) xu[i] = nx[i];
    {
      const int Rn = R + nw;
      nslot = slotOf(Rn);
      const bf16_t* xs = p.x1b + (size_t)(Rn < NT ? Rn : 0) * DM + lane * 4;
#pragma unroll
      for (int i = 0; i < 4; ++i) nx[i] = *(const uint2*)(xs + 256 * i);
    }
    unsigned long long mask = __ballot(myslot >= 0);
    float4 a[4];
#pragma unroll
    for (int i = 0; i < 4; ++i) a[i] = make_float4(0.f, 0.f, 0.f, 0.f);
    while (mask) {
      const int e = __ffsll((long long)mask) - 1; mask &= mask - 1ull;
      const int slot = __shfl(myslot, e);
      const float g = p.gate[(b * NE + e) * CAP + slot];
      const bf16_t* y = p.Y + ((size_t)(b * NE + e) * CAP + slot) * DM + lane * 4;
#pragma unroll
      for (int i = 0; i < 4; ++i) {
        const uint2 u = *(const uint2*)(y + 256 * i);
        a[i].x += g * bf_lo(u.x); a[i].y += g * bf_hi(u.x); a[i].z += g * bf_lo(u.y); a[i].w += g * bf_hi(u.y);
      }
    }
    const float* g2 = p.mod + b * 6144 + 5120;
    float* o = p.out + (size_t)R * DM;
#pragma unroll
    for (int i = 0; i < 4; ++i) {
      const int d = lane * 4 + 256 * i;
      const float4 gv = *(const float4*)(g2 + d);
      *(float4*)(o + d) = make_float4(bf_lo(xu[i].x) + gv.x * a[i].x, bf_hi(xu[i].x) + gv.y * a[i].y, bf_lo(xu[i].y) + gv.z * a[i].z, bf_hi(xu[i].y) + gv.w * a[i].w);
    }
  }
}

__global__ void __launch_bounds__(NTH, 2) mega_kernel(Params p) {
  cg::grid_group grid = cg::this_grid();
  __shared__ __attribute__((aligned(16))) char smem[SMEM_BYTES];
#ifndef REPMASK
#define REPMASK 0
#endif
#define RUNPH(k, call) for (int rep_ = 0; rep_ < (((REPMASK) >> (k)) & 1) + 1; ++rep_) { call; grid.sync(); }
  phase0a(p, smem);
  wait_mod(p);
  phase1(p);
  phase0b(p, smem);
  grid.sync();
  RUNPH(2, phase2(p, smem))
  RUNPH(3, phase3(p, smem))
  RUNPH(4, phase4(p, smem))
  RUNPH(5, phase5(p, smem))
  RUNPH(6, phase6(p, smem))
  RUNPH(7, phase7(p, smem))
  RUNPH(8, phase8(p))
  RUNPH(9, phase9(p, smem))
  RUNPH(10, phase10(p, smem))
  phase11(p);
}

static inline size_t align_up(size_t v, size_t a) { return (v + a - 1) / a * a; }

extern "C" void kernel_launch(void* const* d_in, const int* in_sizes, int n_in,
                              void* d_out, int out_size, void* d_ws, size_t ws_size,
                              hipStream_t stream) {
  static int grid_blocks = 0;
  if (!grid_blocks) {
    int dev = 0, cus = 0, per_cu = 0;
    (void)hipGetDevice(&dev);
    (void)hipDeviceGetAttribute(&cus, hipDeviceAttributeMultiprocessorCount, dev);
    (void)hipOccupancyMaxActiveBlocksPerMultiprocessor(&per_cu, mega_kernel, NTH, 0);
    if (per_cu > 1) per_cu = 1;
    if (per_cu < 1) per_cu = 1;
    grid_blocks = (cus * per_cu) & ~7;
    if (grid_blocks < 8) grid_blocks = 8;
  }
  Params p;
  memset(&p, 0, sizeof(p));
  p.x = (const float*)d_in[0]; p.c = (const float*)d_in[1]; p.ctx = (const float*)d_in[2]; p.c_ctx = (const float*)d_in[3];
  p.w_mod = (const float*)d_in[4]; p.b_mod = (const float*)d_in[5]; p.norm1_g = (const float*)d_in[6];
  const float* w_in = (const float*)d_in[7];
  const float* q_a_g = (const float*)d_in[8];
  const float* kv_a_g = (const float*)d_in[9];
  const float* w_q_up = (const float*)d_in[10];
  const float* w_kv_up = (const float*)d_in[11];
  p.q_norm_g = (const float*)d_in[12]; p.k_norm_g = (const float*)d_in[13];
  const float* w_o_attn = (const float*)d_in[14];
  const float* w_fourier = (const float*)d_in[15];
  const float* w_out = (const float*)d_in[16];
  p.norm2_g = (const float*)d_in[17]; p.w_router = (const float*)d_in[18];
  const float* w_e_gate = (const float*)d_in[19];
  const float* w_e_up = (const float*)d_in[20];
  const float* w_e_down = (const float*)d_in[21];
  p.out = (float*)d_out;

  char* base = (char*)d_ws; size_t off = 0;
  auto alloc = [&](size_t bytes) { char* q = base + off; off = align_up(off + bytes, 256); return q; };
  p.WinT = (bf16_t*)alloc((size_t)NINP * DM * 2);
  p.WqT = (bf16_t*)alloc((size_t)768 * QL * 2);
  p.WkvT = (bf16_t*)alloc((size_t)1024 * KVL * 2);
  p.WoT = (bf16_t*)alloc((size_t)DM * 512 * 2);
  p.WfT = (bf16_t*)alloc((size_t)DM * 512 * 2);
  p.WoutT = (bf16_t*)alloc((size_t)DM * DM * 2);
  p.WguT = (bf16_t*)alloc((size_t)NE * 1024 * DM * 2);
  p.WdT = (bf16_t*)alloc((size_t)NE * DM * DE * 2);
  p.chanT = (bf16_t*)alloc((size_t)256 * 128 * 2);
  p.posM = (bf16_t*)alloc((size_t)2 * 1152 * 2048 * 2);
  p.ropeTab = (float*)alloc(64 * 8 * 2 * 4);
  p.mod = (float*)alloc(33 * 6144 * 4);
  p.aff = (float*)alloc((size_t)NB * NE * SEQ * 4);
  p.gate = (float*)alloc((size_t)NB * NE * CAP * 4);
  p.idx = (int*)alloc((size_t)NB * NE * CAP * 4);
  p.inv = (int*)alloc((size_t)NB * NE * SEQ * 4);
  p.modctr = (unsigned*)alloc(256);
  p.pckv = (bf16_t*)alloc((size_t)NC * LDCKV * 2 + 4096);
  char* regA = alloc((size_t)(NT + NC) * DM * 2);
  p.h = (bf16_t*)regA; p.ABt = (bf16_t*)regA; p.h2 = (bf16_t*)regA;
  char* regB1 = alloc((size_t)NT * LDQKV * 2);
  p.pqkv = (bf16_t*)regB1; p.attn_o = (bf16_t*)regB1;
  char* regB2 = alloc((size_t)NT * 512 * 2);
  p.pf = (bf16_t*)regB2; p.four_o = (bf16_t*)regB2;
  p.x1b = (bf16_t*)regB1;
  if ((size_t)(regB2 - regB1) + (size_t)NT * 512 * 2 < (size_t)NT * DM * 2) { fprintf(stderr, "x1b does not fit\n"); return; }
  p.pg = (bf16_t*)alloc((size_t)NT * 2048 * 2);
  p.Y = p.pg;
  const size_t szQ = (size_t)NB * NH * SEQ * QKD * 2, szK = (size_t)NB * NH * NKEY * QKD * 2, szV = (size_t)NB * NH * VD * NKEY * 2;
  char* regC = alloc(szQ + szK + szV + 1024);
  p.Q = (bf16_t*)regC; p.K = (bf16_t*)(regC + align_up(szQ, 256)); p.Vt = (bf16_t*)(regC + align_up(szQ, 256) + align_up(szK, 256));
  p.m = (bf16_t*)regC; p.hmid = (bf16_t*)(regC + (size_t)NT * DM * 2);
  if (off > ws_size) { fprintf(stderr, "workspace too small: need %zu have %zu\n", off, ws_size); return; }

  int ts = 0;
  auto job = [&](int i, const float* src, bf16_t* dst, const float* scale, int K, int ldS, int n_off, int n_cnt, int dst_row0, int mode, int batch, long sbs, long dbs) {
    TJob& j = p.jobs[i];
    j.src = src; j.dst = dst; j.scale = scale; j.K = K; j.ldS = ldS; j.n_off = n_off; j.n_cnt = n_cnt; j.dst_row0 = dst_row0; j.mode = mode; j.batch = batch;
    j.tiles_n = (n_cnt + 63) / 64; j.tile_start = ts; j.src_bstride = sbs; j.dst_bstride = dbs;
    ts += batch * (K / 64) * j.tiles_n;
  };
  job(0, w_e_gate, p.WguT, nullptr, DM, DE, 0, DE, 0, 1, NE, (long)DM * DE, (long)1024 * DM);
  job(1, w_e_up, p.WguT, nullptr, DM, DE, 0, DE, 0, 2, NE, (long)DM * DE, (long)1024 * DM);
  job(2, w_e_down, p.WdT, nullptr, DE, DM, 0, DM, 0, 0, NE, (long)DE * DM, (long)DM * DE);
  job(3, w_in, p.WinT, nullptr, DM, N_IN, 0, 672, 0, 0, 1, 0, 0);
  job(4, w_in, p.WinT, nullptr, DM, N_IN, 672, 2560, 768, 0, 1, 0, 0);
  job(5, w_q_up, p.WqT, q_a_g, QL, 768, 0, 768, 0, 0, 1, 0, 0);
  job(6, w_kv_up, p.WkvT, kv_a_g, KVL, 1024, 0, 1024, 0, 0, 1, 0, 0);
  job(7, w_o_attn, p.WoT, nullptr, 512, DM, 0, DM, 0, 0, 1, 0, 0);
  job(8, w_fourier, p.WfT, nullptr, 512, DM, 0, DM, 0, 0, 1, 0, 0);
  job(9, w_out, p.WoutT, nullptr, DM, DM, 0, DM, 0, 0, 1, 0, 0);
  p.n_ttiles = ts;

  (void)hipMemsetAsync(p.modctr, 0, 256, stream);
  void* args[] = {&p};
  hipError_t e = hipLaunchCooperativeKernel((void*)mega_kernel, dim3(grid_blocks), dim3(NTH), args, 0, stream);
  if (e != hipSuccess) fprintf(stderr, "cooperative launch failed: %s (grid %d)\n", hipGetErrorString(e), grid_blocks);
}
```

```cpp
#include <hip/hip_runtime.h>
#include <hip/hip_cooperative_groups.h>
#include <cstdio>
#include <cstring>
#include <cstdint>
namespace cg = cooperative_groups;

#define DI __device__ __forceinline__
typedef unsigned short bf16_t;
typedef short bf16x8 __attribute__((ext_vector_type(8)));
typedef float f32x16 __attribute__((ext_vector_type(16)));
#define MFMA(a, b, c) __builtin_amdgcn_mfma_f32_32x32x16_bf16((a), (b), (c), 0, 0, 0)

constexpr int NB = 32, SEQ = 2048, DM = 1024, NT = NB * SEQ, CTXL = 256, NC = NB * CTXL;
constexpr int NH = 8, QKD = 96, VD = 64, QL = 384, KVL = 256, NKEY = SEQ + CTXL;
constexpr int N_IN = 3232, NINP = 3328;
constexpr int NE = 16, DE = 512, CAP = 256;
constexpr float EPS = 1e-6f;
constexpr int LDQKV = 672, LDCKV = 288;
constexpr int NTH = 512, NWV = 8;
constexpr int SMEM_BYTES = 147456;

struct TJob {
  const float* src; bf16_t* dst; const float* scale;
  int K, ldS, n_off, n_cnt, dst_row0, mode, batch, tiles_n, tile_start, pad0;
  long src_bstride, dst_bstride;
};
constexpr int NJOBS = 10;

struct Params {
  const float *x, *c, *ctx, *c_ctx, *w_mod, *b_mod, *norm1_g, *q_norm_g, *k_norm_g, *norm2_g, *w_router;
  float* out;
  bf16_t *WinT, *WqT, *WkvT, *WoT, *WfT, *WoutT, *WguT, *WdT, *chanT, *posM;
  float *ropeTab, *mod;
  bf16_t *h, *pqkv, *pckv, *pf, *pg, *Q, *K, *Vt, *attn_o, *ABt, *four_o, *m, *h2, *hmid;
  float *aff, *gate;
  int* idx;
  int* inv;
  bf16_t* Y;
  unsigned* modctr;
  bf16_t* x1b;
  TJob jobs[NJOBS];
  int n_ttiles, pad1;
};

typedef float f32x2v __attribute__((ext_vector_type(2)));
typedef __bf16 bf16x2v __attribute__((ext_vector_type(2)));
DI unsigned pk_bf16(float lo, float hi) { f32x2v v = {lo, hi}; bf16x2v b = __builtin_convertvector(v, bf16x2v); return __builtin_bit_cast(unsigned, b); }
DI int tid_() { int t = threadIdx.x; asm volatile("" : "+v"(t)); return t; }
DI float bf_lo(unsigned u) { return __uint_as_float(u << 16); }
DI float bf_hi(unsigned u) { return __uint_as_float(u & 0xffff0000u); }
DI bf16_t f2bf(float f) { return (bf16_t)(pk_bf16(f, 0.f) & 0xffffu); }
DI float sigmoidf_(float x) { return 1.f / (1.f + __expf(-x)); }
DI int crow(int i, int hh) { return (i & 3) + 8 * (i >> 2) + 4 * hh; }
DI float wave_sum(float v) {
#pragma unroll
  for (int o = 32; o >= 1; o >>= 1) v += __shfl_xor(v, o);
  return v;
}
DI f32x16 zero16() { f32x16 z;
#pragma unroll
  for (int i = 0; i < 16; ++i) z[i] = 0.f; return z; }
DI void wait_vm0() { asm volatile("s_waitcnt vmcnt(0)" ::: "memory"); }
DI void wait_lgkm0() { asm volatile("s_waitcnt lgkmcnt(0)" ::: "memory"); }
DI void bar_() { __builtin_amdgcn_s_barrier(); }
DI void lds_sync() { wait_lgkm0(); bar_(); }
#define GLDS(gp, lp) __builtin_amdgcn_global_load_lds((const unsigned*)(gp), (__attribute__((address_space(3))) unsigned*)(lp), 16, 0, 0)
#define SB_ __builtin_amdgcn_sched_barrier(0)

constexpr int EPI_OFF = 65536;
template <int TM, int TN, int WM, int WN, bool SUMSQ, int NST, class AF, class BF, class AFN, class BFN>
DI void gemm8x(f32x16 (&acc)[TM][TN], AF arow, BF brow, int K, char* smem, float& sumsq, bool pre, bool hasNext, AFN arowN, BFN browN) {
  constexpr int RA = 32 * TM * WM, RB = 32 * TN * WN;
  constexpr int LDR = 128, STAGE = (RA + RB) * LDR;
  static_assert(WM * WN == NWV, "waves");
  static_assert(NST * STAGE <= SMEM_BYTES, "smem");
  static_assert(NST == 2 || (NST == 3 && RA == 256 && RB == 128), "3-stage ring: 6 loads per thread per stage assumed");
  static_assert(RA <= 256 && RB <= 256 && RA % 32 == 0 && RB % 32 == 0, "shape");
  const int t = tid_(), lane = t & 63, w = t >> 6, r = lane & 31, hh = lane >> 5;
  const int wm = w % WM, wn = w / WM;
  const int row0 = t >> 3;
  const int c = (t & 7) ^ ((row0 >> 1) & 7);
  const bool a0v = row0 < RA, a1v = row0 + 64 < RA, a2v = row0 + 128 < RA, a3v = row0 + 192 < RA;
  const bool b0v = row0 < RB, b1v = row0 + 64 < RB, b2v = row0 + 128 < RB, b3v = row0 + 192 < RB;
  const bf16_t* pa0 = arow(a0v ? row0 : 0) + c * 8;
  const bf16_t* pa1 = arow(a1v ? row0 + 64 : 0) + c * 8;
  const bf16_t* pa2 = arow(a2v ? row0 + 128 : 0) + c * 8;
  const bf16_t* pa3 = arow(a3v ? row0 + 192 : 0) + c * 8;
  const bf16_t* pb0 = brow(b0v ? row0 : 0) + c * 8;
  const bf16_t* pb1 = brow(b1v ? row0 + 64 : 0) + c * 8;
  const bf16_t* pb2 = brow(b2v ? row0 + 128 : 0) + c * 8;
  const bf16_t* pb3 = brow(b3v ? row0 + 192 : 0) + c * 8;
  if (!pre) {
    char* l_ = smem + t * 16; char* m_ = l_ + RA * LDR;
    if (a0v) GLDS(pa0, l_); if (a1v) GLDS(pa1, l_ + 8192); if (a2v) GLDS(pa2, l_ + 16384); if (a3v) GLDS(pa3, l_ + 24576);
    if (b0v) GLDS(pb0, m_); if (b1v) GLDS(pb1, m_ + 8192); if (b2v) GLDS(pb2, m_ + 16384); if (b3v) GLDS(pb3, m_ + 24576);
  }
  if (NST == 3) {
    char* l_ = smem + STAGE + t * 16; char* m_ = l_ + RA * LDR;
    GLDS(pa0 + 64, l_); GLDS(pa1 + 64, l_ + 8192); GLDS(pa2 + 64, l_ + 16384); GLDS(pa3 + 64, l_ + 24576);
    GLDS(pb0 + 64, m_); GLDS(pb1 + 64, m_ + 8192);
    asm volatile("s_waitcnt vmcnt(6)" ::: "memory");
  } else wait_vm0();
  bar_();
  const int nk = K >> 6;
  const int sw = (r >> 1) & 7;
  const int aoff = (wm * TM * 32 + r) * LDR, boff = RA * LDR + (wn * TN * 32 + r) * LDR;
  auto compute = [&](const char* cur, char* nxt, bool issue, const bf16_t* q0, const bf16_t* q1, const bf16_t* q2, const bf16_t* q3,
                     const bf16_t* s0, const bf16_t* s1, const bf16_t* s2, const bf16_t* s3) {
    const char* As = cur + aoff;
    const char* Bs = cur + boff;
    char* l_ = nxt + t * 16; char* m_ = l_ + RA * LDR;
    bf16x8 a0[TM], b0[TN], a1[TM], b1[TN];
#define LOADF(A_, B_, ks) do { const int po_ = (((ks) * 2 + hh) ^ sw) * 16; \
      _Pragma("unroll") for (int tm = 0; tm < TM; ++tm) A_[tm] = *(const bf16x8*)(As + tm * 32 * LDR + po_); \
      _Pragma("unroll") for (int tn = 0; tn < TN; ++tn) B_[tn] = *(const bf16x8*)(Bs + tn * 32 * LDR + po_); } while (0)
#define MMF(A_, B_) do { if (SUMSQ) { uint4 u = __builtin_bit_cast(uint4, B_[0]); \
        float e0 = bf_lo(u.x), e1 = bf_hi(u.x), e2 = bf_lo(u.y), e3 = bf_hi(u.y), e4 = bf_lo(u.z), e5 = bf_hi(u.z), e6 = bf_lo(u.w), e7 = bf_hi(u.w); \
        sumsq += e0 * e0 + e1 * e1 + e2 * e2 + e3 * e3 + e4 * e4 + e5 * e5 + e6 * e6 + e7 * e7; } \
      _Pragma("unroll") for (int tm = 0; tm < TM; ++tm) _Pragma("unroll") for (int tn = 0; tn < TN; ++tn) acc[tm][tn] = MFMA(A_[tm], B_[tn], acc[tm][tn]); } while (0)
    LOADF(a0, b0, 0);
    LOADF(a1, b1, 1);
    SB_;
    if (issue) { if (a0v) GLDS(q0, l_); if (a1v) GLDS(q1, l_ + 8192); }
    SB_;
    __builtin_amdgcn_s_setprio(1);
    MMF(a0, b0);
    LOADF(a0, b0, 2);
    SB_;
    if (issue) { if (a2v) GLDS(q2, l_ + 16384); if (a3v) GLDS(q3, l_ + 24576); }
    SB_;
    MMF(a1, b1);
    LOADF(a1, b1, 3);
    SB_;
    if (issue) { if (b0v) GLDS(s0, m_); if (b1v) GLDS(s1, m_ + 8192); }
    SB_;
    MMF(a0, b0);
    SB_;
    if (issue) { if (b2v) GLDS(s2, m_ + 16384); if (b3v) GLDS(s3, m_ + 24576); }
    SB_;
    MMF(a1, b1);
    __builtin_amdgcn_s_setprio(0);
  };
  int sc_ = 0;
  for (int kt = 0; kt < nk - 1; ++kt) {
    SB_;
    if (NST == 2) {
      const int ko = (kt + 1) * 64;
      compute(smem + (kt & 1) * STAGE, smem + ((kt + 1) & 1) * STAGE, true, pa0 + ko, pa1 + ko, pa2 + ko, pa3 + ko, pb0 + ko, pb1 + ko, pb2 + ko, pb3 + ko);
      SB_;
      wait_vm0(); bar_();
    } else {
      const int ko = (kt + 2) * 64; const bool iss = kt + 2 < nk;
      const int sn = (sc_ == 0) ? 2 : sc_ - 1;
      compute(smem + sc_ * STAGE, smem + sn * STAGE, iss, pa0 + ko, pa1 + ko, pa2 + ko, pa3 + ko, pb0 + ko, pb1 + ko, pb2 + ko, pb3 + ko);
      SB_;
      if (iss) asm volatile("s_waitcnt vmcnt(6)" ::: "memory"); else wait_vm0();
      bar_();
      sc_ = (sc_ == 2) ? 0 : sc_ + 1;
    }
  }
  if (NST == 3) {
    SB_;
    compute(smem + sc_ * STAGE, smem, false, pa0, pa0, pa0, pa0, pa0, pa0, pa0, pa0);
    SB_;
    lds_sync();
  } else {
    const bf16_t *q0 = pa0, *q1 = pa0, *q2 = pa0, *q3 = pa0, *s0 = pa0, *s1 = pa0, *s2 = pa0, *s3 = pa0;
    if (hasNext) {
      q0 = arowN(a0v ? row0 : 0) + c * 8; q1 = arowN(a1v ? row0 + 64 : 0) + c * 8; q2 = arowN(a2v ? row0 + 128 : 0) + c * 8; q3 = arowN(a3v ? row0 + 192 : 0) + c * 8;
      s0 = browN(b0v ? row0 : 0) + c * 8; s1 = browN(b1v ? row0 + 64 : 0) + c * 8; s2 = browN(b2v ? row0 + 128 : 0) + c * 8; s3 = browN(b3v ? row0 + 192 : 0) + c * 8;
    }
    SB_;
    compute(smem + ((nk - 1) & 1) * STAGE, smem, hasNext, q0, q1, q2, q3, s0, s1, s2, s3);
    SB_;
    lds_sync();
  }
}
template <int TM, int TN, int WM, int WN, bool SUMSQ, class AF, class BF>
DI void gemm8(f32x16 (&acc)[TM][TN], AF arow, BF brow, int K, char* smem, float& sumsq) {
  gemm8x<TM, TN, WM, WN, SUMSQ, 2>(acc, arow, brow, K, smem, sumsq, false, false, arow, brow);
}
template <class AF, class BF>
DI void gemm8s3(f32x16 (&acc)[2][2], AF arow, BF brow, int K, char* smem) {
  float dummy = 0.f;
  gemm8x<2, 2, 4, 2, false, 3>(acc, arow, brow, K, smem, dummy, false, false, arow, brow);
}
template <int TM, int WM, int WN, int TNSEL, class F>
DI void stage_half(const f32x16 (&acc)[TM][2], char* tile, int pitch, F f) {
  const int t = tid_(), lane = t & 63, w = t >> 6, r = lane & 31, hh = lane >> 5;
  const int wm = w % WM, wn = w / WM;
#pragma unroll
  for (int tm = 0; tm < TM; ++tm) {
    char* d = tile + (wn * 32 + r) * pitch + (wm * TM * 32 + tm * 32 + 4 * hh) * 2;
#pragma unroll
    for (int q = 0; q < 4; ++q) {
      const f32x16& a = acc[tm][TNSEL];
      uint2 o; o.x = pk_bf16(f(a[4 * q]), f(a[4 * q + 1])); o.y = pk_bf16(f(a[4 * q + 2]), f(a[4 * q + 3]));
      *(uint2*)(d + 16 * q) = o;
    }
  }
}

template <int TM, int TN, int WM, int WN, class F>
DI void stage_tile(const f32x16 (&acc)[TM][TN], char* tile, int pitch, F f) {
  const int t = tid_(), lane = t & 63, w = t >> 6, r = lane & 31, hh = lane >> 5;
  const int wm = w % WM, wn = w / WM;
#pragma unroll
  for (int tm = 0; tm < TM; ++tm)
#pragma unroll
    for (int tn = 0; tn < TN; ++tn) {
      char* d = tile + (wn * TN * 32 + tn * 32 + r) * pitch + (wm * TM * 32 + tm * 32 + 4 * hh) * 2;
#pragma unroll
      for (int q = 0; q < 4; ++q) {
        uint2 o; o.x = pk_bf16(f(acc[tm][tn][4 * q]), f(acc[tm][tn][4 * q + 1])); o.y = pk_bf16(f(acc[tm][tn][4 * q + 2]), f(acc[tm][tn][4 * q + 3]));
        *(uint2*)(d + 16 * q) = o;
      }
    }
}
template <class RF>
DI void copy_tile(const char* tile, int pitch, int rows, int lch, RF dst, int ch0, int ch1) {
  const int t = tid_();
  const int total = rows << lch;
  for (int id = t; id < total; id += NTH) {
    const int row = id >> lch, ch = id & ((1 << lch) - 1);
    if (ch >= ch0 && ch < ch1) *(uint4*)(dst(row) + ch * 8) = *(const uint4*)(tile + row * pitch + ch * 16);
  }
}

struct TTile { const float* src; const float* scale; bf16_t* dst; int K, ldS, n0, n_cnt, k0, dst_row0, mode; };
DI TTile ttile_decode(const Params& p, int u) {
  int jb = 0;
#pragma unroll 1
  for (int q = 1; q < NJOBS; ++q) if (u >= p.jobs[q].tile_start) jb = q;
  const TJob& j = p.jobs[jb];
  const int tile = u - j.tile_start;
  const int tpb = (j.K >> 6) * j.tiles_n;
  const int bi = tile / tpb, rem = tile % tpb;
  const int kt = rem / j.tiles_n, ntile = rem % j.tiles_n;
  TTile tt;
  tt.src = j.src + (size_t)bi * j.src_bstride + j.n_off; tt.scale = j.scale; tt.dst = j.dst + (size_t)bi * j.dst_bstride;
  tt.K = j.K; tt.ldS = j.ldS; tt.n0 = ntile * 64; tt.n_cnt = j.n_cnt; tt.k0 = kt * 64; tt.dst_row0 = j.dst_row0; tt.mode = j.mode;
  return tt;
}
DI void ttile_load(const TTile& tt, int t, float (&v)[8]) {
  const int nn = t & 63, kq = t >> 6;
  const bool nvalid = (tt.n0 + nn) < tt.n_cnt;
#pragma unroll
  for (int i = 0; i < 8; ++i) {
    const int kk = kq + 8 * i;
    float x = 0.f;
    if (nvalid) { x = tt.src[(size_t)(tt.k0 + kk) * tt.ldS + tt.n0 + nn]; if (tt.scale) x *= tt.scale[tt.k0 + kk]; }
    v[i] = x;
  }
}
DI void ttile_store(const TTile& tt, int t, const float (&v)[8], char* smem) {
  bf16_t* T = (bf16_t*)smem;
  const int nn = t & 63, kq = t >> 6;
#pragma unroll
  for (int i = 0; i < 8; ++i) T[nn * 66 + kq + 8 * i] = f2bf(v[i]);
  __syncthreads();
  const int n = t >> 3, part = t & 7;
  if (tt.n0 + n < tt.n_cnt) {
    const unsigned* tp = (const unsigned*)(T + n * 66 + part * 8);
    uint4 o0; o0.x = tp[0]; o0.y = tp[1]; o0.z = tp[2]; o0.w = tp[3];
    const int f = tt.n0 + n;
    int drow;
    if (tt.mode == 0) drow = tt.dst_row0 + f;
    else drow = (f >> 7) * 256 + ((f >> 6) & 1) * 128 + (((f >> 5) & 1) * 2 + (tt.mode == 2 ? 1 : 0)) * 32 + (f & 31);
    *(uint4*)(tt.dst + (size_t)drow * tt.K + tt.k0 + part * 8) = o0;
  }
  __syncthreads();
}

DI void mod_item(const Params& p, int it, char* smem) {
  const int t = tid_(), cgi = t & 15, kg = t >> 4;
  const int j0 = it * 16;
  float* Ssm = (float*)smem;
  float* red = (float*)(smem + 33 * 128 * 4);
  float acc[33];
#pragma unroll
  for (int r = 0; r < 33; ++r) acc[r] = 0.f;
  const float* wp = p.w_mod + (size_t)(kg * 4) * 6144 + j0 + cgi;
  float n0 = wp[0], n1 = wp[6144], n2 = wp[2 * 6144], n3 = wp[3 * 6144];
#pragma unroll 1
  for (int kc = 0; kc < 8; ++kc) {
    __syncthreads();
    for (int idx = t; idx < 33 * 128; idx += NTH) {
      const int r = idx >> 7, kk = idx & 127;
      float v = (r < 32) ? p.c[r * DM + kc * 128 + kk] : p.c_ctx[kc * 128 + kk];
      Ssm[idx] = v * sigmoidf_(v);
    }
    const float w0 = n0, w1 = n1, w2 = n2, w3 = n3;
    if (kc < 7) { const float* wq = wp + (size_t)(kc + 1) * 128 * 6144; n0 = wq[0]; n1 = wq[6144]; n2 = wq[2 * 6144]; n3 = wq[3 * 6144]; }
    __syncthreads();
#pragma unroll
    for (int r = 0; r < 33; ++r) {
      const float4 s = *(const float4*)(Ssm + r * 128 + kg * 4);
      acc[r] += s.x * w0 + s.y * w1 + s.z * w2 + s.w * w3;
    }
  }
  __syncthreads();
#pragma unroll
  for (int r = 0; r < 33; ++r) red[(kg * 33 + r) * 16 + cgi] = acc[r];
  __syncthreads();
  for (int idx = t; idx < 33 * 16; idx += NTH) {
    const int r = idx >> 4, cc = idx & 15;
    float s = 0.f;
#pragma unroll
    for (int g = 0; g < 32; ++g) s += red[(g * 33 + r) * 16 + cc];
    p.mod[r * 6144 + j0 + cc] = s + p.b_mod[j0 + cc];
  }
}

DI void phase0a(const Params& p, char* smem) {
  const int t = tid_();
  const int nMod = 384, nPos = 288, nMisc = 3;
  for (int it = blockIdx.x; it < nMod; it += gridDim.x) {
    mod_item(p, it, smem);
    __syncthreads();
    if (t == 0) { __threadfence(); atomicAdd(p.modctr, 1u); }
  }
  float* ctab = (float*)(smem + 98304);
  __syncthreads();
  for (int j = t; j < 2048; j += NTH) ctab[j] = cospif((float)j * (1.f / 1024.f));
  __syncthreads();
  for (int u = blockIdx.x; u < nPos + nMisc; u += gridDim.x) {
    if (u < nPos) {
      for (int e = t; e < 8 * 256; e += NTH) {
        const int R = u * 8 + (e >> 8), c8 = (e & 255) * 8;
        const int part = R >= 1152 ? 1 : 0, k = R - part * 1152;
        float v[8];
#pragma unroll
        for (int q = 0; q < 8; ++q) {
          const int tt = c8 + q;
          v[q] = (k > 1024) ? 0.f : (part ? ctab[(k * tt - 512) & 2047] : ctab[(k * tt) & 2047]);
        }
        uint4 o; o.x = pk_bf16(v[0], v[1]); o.y = pk_bf16(v[2], v[3]); o.z = pk_bf16(v[4], v[5]); o.w = pk_bf16(v[6], v[7]);
        *(uint4*)(p.posM + (size_t)R * 2048 + c8) = o;
      }
      continue;
    }
    const int m_ = u - nPos;
    if (m_ == 0) {
      for (int e = t; e < 256 * 128; e += NTH) {
        const int m2 = e >> 7, cc = e & 127, mm = m2 & 127;
        float v = (m2 < 128) ? ctab[(mm * cc * 16) & 2047] : ctab[(mm * cc * 16 - 512) & 2047];
        p.chanT[e] = f2bf(v);
      }
    } else if (m_ == 1) {
      for (int e = t; e < 64 * 8; e += NTH) {
        const int pos = e >> 3, jf = e & 7;
        const float inv = 1.0f / powf(10000.0f, (float)jf / 8.0f);
        const float ang = (float)pos * inv;
        p.ropeTab[e * 2 + 0] = cosf(ang);
        p.ropeTab[e * 2 + 1] = sinf(ang);
      }
    } else {
      uint4 z; z.x = z.y = z.z = z.w = 0u;
      uint4* dp = (uint4*)(p.WinT + (size_t)672 * DM);
      for (int e = t; e < 96 * DM / 8; e += NTH) dp[e] = z;
    }
  }
}
DI void wait_mod(const Params& p) {
  if (threadIdx.x == 0) {
    while (__hip_atomic_load(p.modctr, __ATOMIC_RELAXED, __HIP_MEMORY_SCOPE_AGENT) < 384u) __builtin_amdgcn_s_sleep(8);
    __threadfence();
  }
  __syncthreads();
}
DI void phase0b(const Params& p, char* smem) {
  const int t = tid_();
  const int nT = p.n_ttiles;
  __syncthreads();
  const int G = gridDim.x;
  int u = blockIdx.x;
  float vn[8];
  TTile tn_ = ttile_decode(p, u < nT ? u : 0);
  if (u < nT) ttile_load(tn_, t, vn);
  for (; u < nT; u += G) {
    const TTile tc = tn_;
    float vc[8];
#pragma unroll
    for (int i = 0; i < 8; ++i) vc[i] = vn[i];
    if (u + G < nT) { tn_ = ttile_decode(p, u + G); ttile_load(tn_, t, vn); }
    ttile_store(tc, t, vc, smem);
  }
}

DI void phase1(const Params& p) {
  const int t_ = tid_(); const int lane = t_ & 63, w = t_ >> 6;
  const int gw = blockIdx.x * NWV + w, nw = gridDim.x * NWV;
  for (int R0 = gw; R0 < NT + NC; R0 += 2 * nw) {
    const int R1 = R0 + nw; const bool has1 = R1 < NT + NC;
    const float* src0 = (R0 < NT) ? p.x + (size_t)R0 * DM : p.ctx + (size_t)(R0 - NT) * DM;
    const float* src1 = has1 ? ((R1 < NT) ? p.x + (size_t)R1 * DM : p.ctx + (size_t)(R1 - NT) * DM) : src0;
    const float* md0 = p.mod + ((R0 < NT) ? (R0 >> 11) : 32) * 6144;
    const float* md1 = p.mod + ((has1 && R1 < NT) ? (R1 >> 11) : 32) * 6144;
    float4 v0[4], v1[4]; float s0 = 0.f, s1 = 0.f;
#pragma unroll
    for (int i = 0; i < 4; ++i) { v0[i] = *(const float4*)(src0 + lane * 4 + 256 * i); v1[i] = *(const float4*)(src1 + lane * 4 + 256 * i); }
#pragma unroll
    for (int i = 0; i < 4; ++i) { s0 += v0[i].x * v0[i].x + v0[i].y * v0[i].y + v0[i].z * v0[i].z + v0[i].w * v0[i].w; s1 += v1[i].x * v1[i].x + v1[i].y * v1[i].y + v1[i].z * v1[i].z + v1[i].w * v1[i].w; }
    s0 = wave_sum(s0); s1 = wave_sum(s1);
    const float r0 = rsqrtf(s0 * (1.f / DM) + EPS), r1 = rsqrtf(s1 * (1.f / DM) + EPS);
#pragma unroll
    for (int i = 0; i < 4; ++i) {
      const int d = lane * 4 + 256 * i;
      const float4 g = *(const float4*)(p.norm1_g + d);
      {
        const float4 sh = *(const float4*)(md0 + d), sc = *(const float4*)(md0 + 1024 + d);
        uint2 o; o.x = pk_bf16(v0[i].x * r0 * g.x * (1.f + sc.x) + sh.x, v0[i].y * r0 * g.y * (1.f + sc.y) + sh.y);
        o.y = pk_bf16(v0[i].z * r0 * g.z * (1.f + sc.z) + sh.z, v0[i].w * r0 * g.w * (1.f + sc.w) + sh.w);
        *(uint2*)(p.h + (size_t)R0 * DM + d) = o;
      }
      if (has1) {
        const float4 sh = *(const float4*)(md1 + d), sc = *(const float4*)(md1 + 1024 + d);
        uint2 o; o.x = pk_bf16(v1[i].x * r1 * g.x * (1.f + sc.x) + sh.x, v1[i].y * r1 * g.y * (1.f + sc.y) + sh.y);
        o.y = pk_bf16(v1[i].z * r1 * g.z * (1.f + sc.z) + sh.z, v1[i].w * r1 * g.w * (1.f + sc.w) + sh.w);
        *(uint2*)(p.h + (size_t)R1 * DM + d) = o;
      }
    }
  }
}

DI void phase2(const Params& p, char* smem) {
  const int xcd = blockIdx.x & 7, jl = blockIdx.x >> 3, nl = gridDim.x >> 3;
  auto decode = [&](int L, int& tokTile, int& ft) {
    if (L < 416) { const int tg = L / 104, rem = L % 104; ft = rem >> 3; tokTile = xcd * 32 + tg * 8 + (rem & 7); }
    else { const int u = L - 416; tokTile = 256 + xcd * 4 + (u >> 1); ft = 1 + (u & 1); }
  };
  bool pre = false;
  for (int L = jl; L < 416 + 8; L += nl) {
    int tokTile, ft, tokTileN = 0, ftN = 0;
    decode(L, tokTile, ft);
    const bool lat = L < 416;
    const int Ln = L + nl; const bool hasNext = Ln < 416 + 8;
    if (hasNext) decode(Ln, tokTileN, ftN);
    f32x16 acc[4][2];
#pragma unroll
    for (int a = 0; a < 4; ++a)
#pragma unroll
      for (int b = 0; b < 2; ++b) acc[a][b] = zero16();
    const bf16_t* Ab = p.WinT + (size_t)ft * 256 * DM;
    const bf16_t* Bb = p.h + (size_t)tokTile * 256 * DM;
    const bf16_t* AbN = p.WinT + (size_t)ftN * 256 * DM;
    const bf16_t* BbN = p.h + (size_t)tokTileN * 256 * DM;
    float dummy = 0.f;
    gemm8x<4, 2, 2, 4, false, 2>(acc, [&](int row) { return Ab + (size_t)row * DM; }, [&](int row) { return Bb + (size_t)row * DM; }, DM, smem, dummy,
                              pre, hasNext, [&](int row) { return AbN + (size_t)row * DM; }, [&](int row) { return BbN + (size_t)row * DM; });
    pre = hasNext;
    char* tile = smem + EPI_OFF;
    bf16_t* base; int ld, c0 = 0, c1 = 32;
    if (lat) {
      const size_t tok0 = (size_t)tokTile * 256;
      if (ft < 3) { base = p.pqkv + tok0 * LDQKV + ft * 256; ld = LDQKV; if (ft == 2) c1 = 20; }
      else if (ft < 5) { base = p.pf + tok0 * 512 + (ft - 3) * 256; ld = 512; }
      else { base = p.pg + tok0 * 2048 + (ft - 5) * 256; ld = 2048; }
    } else {
      const size_t ct0 = (size_t)(tokTile - 256) * 256;
      base = p.pckv + ct0 * LDCKV + ft * 256 - 384; ld = LDCKV;
      if (ft == 1) c0 = 16; else c1 = 20;
    }
    if (ft >= 5) stage_half<4, 2, 4, 0>(acc, tile, 528, [](float v) { return sigmoidf_(v); });
    else stage_half<4, 2, 4, 0>(acc, tile, 528, [](float v) { return v; });
    lds_sync();
    copy_tile(tile, 528, 128, 5, [&](int rl) { return base + (size_t)((rl >> 5) * 64 + (rl & 31)) * ld; }, c0, c1);
    lds_sync();
    if (ft >= 5) stage_half<4, 2, 4, 1>(acc, tile, 528, [](float v) { return sigmoidf_(v); });
    else stage_half<4, 2, 4, 1>(acc, tile, 528, [](float v) { return v; });
    lds_sync();
    copy_tile(tile, 528, 128, 5, [&](int rl) { return base + (size_t)((rl >> 5) * 64 + 32 + (rl & 31)) * ld; }, c0, c1);
  }
}

DI void rope_pair(float& x1, float& x2, const float* tab) { const float c = tab[0], s = tab[1]; const float a = x1 * c - x2 * s, b = x2 * c + x1 * s; x1 = a; x2 = b; }

DI void phase3(const Params& p, char* smem) {
  const int t = tid_(), lane = t & 63, w = t >> 6, r = lane & 31, hh = lane >> 5;
  const int nKV = 288, nQ = 256, nCh = 128;
  const int xcd = blockIdx.x & 7, jl = blockIdx.x >> 3, nl = gridDim.x >> 3;
  for (int it = jl; it < nKV + nQ + nCh; it += nl) {
    if (it < nKV) {
      const int tl_ = it >> 3, hd = it & 7;
      const bool lat = tl_ < 32;
      const bf16_t* Bb; int ldb; const bf16_t* kpeb;
      int b, key0;
      if (lat) { const int tokTile = xcd * 32 + tl_; Bb = p.pqkv + (size_t)tokTile * 256 * LDQKV + QL; ldb = LDQKV; kpeb = p.pqkv + (size_t)tokTile * 256 * LDQKV + 640; b = tokTile >> 3; key0 = (tokTile & 7) * 256; }
      else { const int ct = xcd * 4 + (tl_ - 32); Bb = p.pckv + (size_t)ct * 256 * LDCKV; ldb = LDCKV; kpeb = Bb + 256; b = ct; key0 = SEQ; }
      const bf16_t* Ab = p.WkvT + (size_t)hd * 128 * KVL;
      f32x16 acc[4][1];
#pragma unroll
      for (int a = 0; a < 4; ++a) acc[a][0] = zero16();
      float sumsq = 0.f;
      gemm8<4, 1, 1, 8, true>(acc, [&](int row) { return Ab + (size_t)row * KVL; }, [&](int row) { return Bb + (size_t)row * ldb; }, KVL, smem, sumsq);
      sumsq += __shfl_xor(sumsq, 32);
      const float ra = rsqrtf(sumsq * (1.f / KVL) + EPS);
      const int tl = w * 32 + r;
      const int key = key0 + tl;
      float kp[16];
#pragma unroll
      for (int q = 0; q < 4; ++q) {
        const uint2 u = *(const uint2*)(kpeb + (size_t)tl * ldb + 8 * q + 4 * hh);
        kp[4 * q + 0] = bf_lo(u.x); kp[4 * q + 1] = bf_hi(u.x); kp[4 * q + 2] = bf_lo(u.y); kp[4 * q + 3] = bf_hi(u.y);
      }
      float ss = 0.f;
#pragma unroll
      for (int tm = 0; tm < 4; ++tm)
#pragma unroll
        for (int i = 0; i < 16; ++i) { const float v = acc[tm][0][i] * ra; acc[tm][0][i] = v; if (tm < 2) ss += v * v; }
#pragma unroll
      for (int i = 0; i < 16; ++i) ss += kp[i] * kp[i];
      ss += __shfl_xor(ss, 32);
      const float rk = rsqrtf(ss * (1.f / QKD) + EPS);
#pragma unroll
      for (int i = 0; i < 16; ++i) kp[i] *= rk * p.k_norm_g[64 + crow(i, hh)];
      if (lat) {
        const int pos = key;
        const float* tr = p.ropeTab + ((pos >> 6) * 8 + 4 * hh) * 2;
        const float* tc = p.ropeTab + ((pos & 63) * 8 + 4 * hh) * 2;
#pragma unroll
        for (int i = 0; i < 4; ++i) { rope_pair(kp[i], kp[i + 4], tr + 2 * i); rope_pair(kp[8 + i], kp[12 + i], tc + 2 * i); }
      }
      {
        char* kt_ = smem; char* vt_ = smem + 256 * 208;
        char* kd = kt_ + tl * 208;
#pragma unroll
        for (int tm = 0; tm < 2; ++tm)
#pragma unroll
          for (int q = 0; q < 4; ++q) {
            const int f = tm * 32 + 8 * q + 4 * hh;
            const float4 g = *(const float4*)(p.k_norm_g + f);
            uint2 o; o.x = pk_bf16(acc[tm][0][4 * q] * rk * g.x, acc[tm][0][4 * q + 1] * rk * g.y); o.y = pk_bf16(acc[tm][0][4 * q + 2] * rk * g.z, acc[tm][0][4 * q + 3] * rk * g.w);
            *(uint2*)(kd + f * 2) = o;
          }
#pragma unroll
        for (int q = 0; q < 4; ++q) {
          uint2 o; o.x = pk_bf16(kp[4 * q], kp[4 * q + 1]); o.y = pk_bf16(kp[4 * q + 2], kp[4 * q + 3]);
          *(uint2*)(kd + (64 + 8 * q + 4 * hh) * 2) = o;
        }
#pragma unroll
        for (int tm = 2; tm < 4; ++tm)
#pragma unroll
          for (int i = 0; i < 16; ++i) *(bf16_t*)(vt_ + ((tm - 2) * 32 + crow(i, hh)) * 528 + tl * 2) = f2bf(acc[tm][0][i]);
        lds_sync();
        const int tc_ = tid_();
        bf16_t* Kg = p.K + ((size_t)(b * NH + hd) * NKEY + key0) * QKD;
#pragma unroll
        for (int i = 0; i < 6; ++i) {
          const int id = tc_ + NTH * i, row = id / 12, ch = id % 12;
          *(uint4*)(Kg + row * QKD + ch * 8) = *(const uint4*)(kt_ + row * 208 + ch * 16);
        }
        bf16_t* Vg = p.Vt + (size_t)(b * NH + hd) * VD * NKEY + key0;
#pragma unroll
        for (int i = 0; i < 4; ++i) {
          const int row = (tc_ >> 5) + 16 * i, ch = tc_ & 31;
          *(uint4*)(Vg + (size_t)row * NKEY + ch * 8) = *(const uint4*)(vt_ + row * 528 + ch * 16);
        }
        lds_sync();
      }
    } else if (it < nKV + nQ) {
      const int u = it - nKV;
      const int tokTile = xcd * 32 + (u >> 3), hd = u & 7;
      const bf16_t* Bb = p.pqkv + (size_t)tokTile * 256 * LDQKV;
      const bf16_t* Ab = p.WqT + (size_t)hd * QKD * QL;
      f32x16 acc[3][1];
#pragma unroll
      for (int a = 0; a < 3; ++a) acc[a][0] = zero16();
      float sumsq = 0.f;
      gemm8<3, 1, 1, 8, true>(acc, [&](int row) { return Ab + (size_t)row * QL; }, [&](int row) { return Bb + (size_t)row * LDQKV; }, QL, smem, sumsq);
      sumsq += __shfl_xor(sumsq, 32);
      const float ra = rsqrtf(sumsq * (1.f / QL) + EPS);
      const int tl = w * 32 + r;
      const int b = tokTile >> 3, pos = (tokTile & 7) * 256 + tl;
      float ss = 0.f;
#pragma unroll
      for (int tm = 0; tm < 3; ++tm)
#pragma unroll
        for (int i = 0; i < 16; ++i) { const float v = acc[tm][0][i] * ra; acc[tm][0][i] = v; ss += v * v; }
      ss += __shfl_xor(ss, 32);
      const float rh = rsqrtf(ss * (1.f / QKD) + EPS);
#pragma unroll
      for (int tm = 0; tm < 3; ++tm)
#pragma unroll
        for (int q = 0; q < 4; ++q) {
          const float4 g = *(const float4*)(p.q_norm_g + tm * 32 + 8 * q + 4 * hh);
          acc[tm][0][4 * q] *= rh * g.x; acc[tm][0][4 * q + 1] *= rh * g.y; acc[tm][0][4 * q + 2] *= rh * g.z; acc[tm][0][4 * q + 3] *= rh * g.w;
        }
      {
        const float* tr = p.ropeTab + ((pos >> 6) * 8 + 4 * hh) * 2;
        const float* tc = p.ropeTab + ((pos & 63) * 8 + 4 * hh) * 2;
#pragma unroll
        for (int i = 0; i < 4; ++i) {
          float a0 = acc[2][0][i], a1 = acc[2][0][i + 4], c0 = acc[2][0][8 + i], c1 = acc[2][0][12 + i];
          rope_pair(a0, a1, tr + 2 * i); rope_pair(c0, c1, tc + 2 * i);
          acc[2][0][i] = a0; acc[2][0][i + 4] = a1; acc[2][0][8 + i] = c0; acc[2][0][12 + i] = c1;
        }
      }
      const float qs = 0.10206207261596575f * 1.4426950408889634f;
      {
        char* qd = smem + tl * 208;
#pragma unroll
        for (int tm = 0; tm < 3; ++tm)
#pragma unroll
          for (int q = 0; q < 4; ++q) {
            uint2 o; o.x = pk_bf16(acc[tm][0][4 * q] * qs, acc[tm][0][4 * q + 1] * qs); o.y = pk_bf16(acc[tm][0][4 * q + 2] * qs, acc[tm][0][4 * q + 3] * qs);
            *(uint2*)(qd + (tm * 32 + 8 * q + 4 * hh) * 2) = o;
          }
        lds_sync();
        const int tc_ = tid_();
        bf16_t* Qg = p.Q + ((size_t)(b * NH + hd) * SEQ + (tokTile & 7) * 256) * QKD;
#pragma unroll
        for (int i = 0; i < 6; ++i) {
          const int id = tc_ + NTH * i, row = id / 12, ch = id % 12;
          *(uint4*)(Qg + row * QKD + ch * 8) = *(const uint4*)(smem + row * 208 + ch * 16);
        }
        lds_sync();
      }
    } else {
      const int u = it - nKV - nQ;
      const int tt = u & 7, g = (u >> 3) & 3, b = xcd * 4 + (u >> 5);
      const bf16_t* Tb = p.chanT;
      const bf16_t* Fb = p.pf + (size_t)(b * SEQ + tt * 256) * 512 + g * 128;
      f32x16 acc[4][2];
#pragma unroll
      for (int a = 0; a < 4; ++a)
#pragma unroll
        for (int c = 0; c < 2; ++c) acc[a][c] = zero16();
      float dummy = 0.f;
      gemm8<4, 2, 2, 4, false>(acc, [&](int row) { return Fb + (size_t)row * 512; }, [&](int row) { return Tb + (size_t)row * 128; }, 128, smem, dummy);
      stage_tile<4, 2, 2, 4>(acc, smem, 528, [](float v) { return v; });
      lds_sync();
      bf16_t* dst0 = p.ABt + ((size_t)(b * 512 + g * 128)) * 4096 + tt * 256;
      copy_tile(smem, 528, 256, 5, [&](int row) { return dst0 + (size_t)(row & 127) * 4096 + (row >> 7) * 2048; }, 0, 32);
      lds_sync();
    }
  }
}

DI void attn_item(const Params& p, int it, char* smem) {
  const int t = tid_(), lane = t & 63, w = t >> 6, r = lane & 31, hh = lane >> 5;
  const int qt = it & 7, bh = it >> 3;
  constexpr int KROW = 208, VROW = 136, KBYTES = 64 * KROW, STAGE = KBYTES + 64 * VROW;
  const bf16_t* Kb = p.K + (size_t)bh * NKEY * QKD;
  const bf16_t* Vb = p.Vt + (size_t)bh * VD * NKEY;
  const int qpos = qt * 256 + w * 32 + r;
  const bf16_t* Qp = p.Q + ((size_t)bh * SEQ + qpos) * QKD + hh * 8;
  bf16x8 qf[6];
#pragma unroll
  for (int c = 0; c < 6; ++c) qf[c] = *(const bf16x8*)(Qp + c * 16);
  f32x16 o[2]; o[0] = zero16(); o[1] = zero16();
  float gk = 0.f;
  for (int f = 0; f < QKD; ++f) gk = fmaxf(gk, fabsf(p.k_norm_g[f]));
  float qss = 0.f;
#pragma unroll
  for (int c = 0; c < 6; ++c) {
    const uint4 u = __builtin_bit_cast(uint4, qf[c]);
    const float e0 = bf_lo(u.x), e1 = bf_hi(u.x), e2 = bf_lo(u.y), e3 = bf_hi(u.y), e4 = bf_lo(u.z), e5 = bf_hi(u.z), e6 = bf_lo(u.w), e7 = bf_hi(u.w);
    qss += e0 * e0 + e1 * e1 + e2 * e2 + e3 * e3 + e4 * e4 + e5 * e5 + e6 * e6 + e7 * e7;
  }
  qss += __shfl_xor(qss, 32);
  const float negC = -(sqrtf(qss) * gk * 9.797959f * 1.01f);
  f32x16 sinit;
#pragma unroll
  for (int i = 0; i < 16; ++i) sinit[i] = negC;
  float lrun = 0.f;
  const int kid0 = t, kid1 = (t & 255) + 512;
  const bool k1v = t < 256;
  const int kgo0 = (kid0 / 12) * QKD + (kid0 % 12) * 8, kgo1 = (kid1 / 12) * QKD + (kid1 % 12) * 8;
  const int klo0 = (kid0 / 12) * KROW + (kid0 % 12) * 16, klo1 = (kid1 / 12) * KROW + (kid1 % 12) * 16;
  const int vgo0 = (t >> 3) * NKEY + (t & 7) * 8;
  const int vlo0 = KBYTES + (t >> 3) * VROW + (t & 7) * 16;
  uint4 rk0, rk1, rv0;
  rk0 = *(const uint4*)(Kb + kgo0); rk1 = *(const uint4*)(Kb + kgo1);
  rv0 = *(const uint4*)(Vb + vgo0);
  SB_;
#define ATT_STORE(base) do { \
    *(uint4*)((base) + klo0) = rk0; if (k1v) *(uint4*)((base) + klo1) = rk1; \
    { uint2* d = (uint2*)((base) + vlo0); d[0] = make_uint2(rv0.x, rv0.y); d[1] = make_uint2(rv0.z, rv0.w); } } while (0)
  ATT_STORE(smem);
  __syncthreads();
  constexpr int NKT = NKEY / 64;
  for (int kt = 0; kt < NKT; ++kt) {
    const char* cur = smem + (kt & 1) * STAGE;
    const bool more = kt + 1 < NKT;
    if (more) {
      const bf16_t* kn = Kb + (size_t)(kt + 1) * 64 * QKD; const bf16_t* vn = Vb + (kt + 1) * 64;
      rk0 = *(const uint4*)(kn + kgo0); rk1 = *(const uint4*)(kn + kgo1);
      rv0 = *(const uint4*)(vn + vgo0);
    }
    SB_;
    f32x16 s[2];
#pragma unroll
    for (int t2 = 0; t2 < 2; ++t2) {
      const char* kp = cur + (t2 * 32 + r) * KROW + hh * 16;
      { const bf16x8 kf = *(const bf16x8*)(kp); s[t2] = MFMA(kf, qf[0], sinit); }
#pragma unroll
      for (int c = 1; c < 6; ++c) { const bf16x8 kf = *(const bf16x8*)(kp + c * 32); s[t2] = MFMA(kf, qf[c], s[t2]); }
    }
    SB_;
    float ls = 0.f;
#pragma unroll
    for (int t2 = 0; t2 < 2; ++t2)
#pragma unroll
      for (int i = 0; i < 16; ++i) { const float e = __builtin_amdgcn_exp2f(s[t2][i]); s[t2][i] = e; ls += e; }
    lrun += ls;
    SB_;
#pragma unroll
    for (int t2 = 0; t2 < 2; ++t2)
#pragma unroll
      for (int s2 = 0; s2 < 2; ++s2) {
        uint4 pu;
        pu.x = pk_bf16(s[t2][8 * s2 + 0], s[t2][8 * s2 + 1]); pu.y = pk_bf16(s[t2][8 * s2 + 2], s[t2][8 * s2 + 3]);
        pu.z = pk_bf16(s[t2][8 * s2 + 4], s[t2][8 * s2 + 5]); pu.w = pk_bf16(s[t2][8 * s2 + 6], s[t2][8 * s2 + 7]);
        const bf16x8 pb = __builtin_bit_cast(bf16x8, pu);
#pragma unroll
        for (int vt = 0; vt < 2; ++vt) {
          const char* vp = cur + KBYTES + (vt * 32 + r) * VROW + (t2 * 32 + 16 * s2 + 4 * hh) * 2;
          const uint2 lo = *(const uint2*)(vp), hi = *(const uint2*)(vp + 16);
          uint4 vu; vu.x = lo.x; vu.y = lo.y; vu.z = hi.x; vu.w = hi.y;
          o[vt] = MFMA(__builtin_bit_cast(bf16x8, vu), pb, o[vt]);
        }
      }
    SB_;
    if (more) { char* nxt = smem + ((kt + 1) & 1) * STAGE; ATT_STORE(nxt); }
    __syncthreads();
  }
  lrun += __shfl_xor(lrun, 32);
  const float inv = 1.f / lrun;
  const int b = bh >> 3, hd = bh & 7;
  bf16_t* od = p.attn_o + (size_t)(b * SEQ + qpos) * 512 + hd * 64;
#pragma unroll
  for (int vt = 0; vt < 2; ++vt)
#pragma unroll
    for (int q = 0; q < 4; ++q) {
      uint2 ou; ou.x = pk_bf16(o[vt][4 * q] * inv, o[vt][4 * q + 1] * inv); ou.y = pk_bf16(o[vt][4 * q + 2] * inv, o[vt][4 * q + 3] * inv);
      *(uint2*)(od + vt * 32 + 8 * q + 4 * hh) = ou;
    }
}

DI void attn_item64(const Params& p, int it, char* smem) {
  const int t = tid_(), lane = t & 63, w = t >> 6, r = lane & 31, hh = lane >> 5;
  const int qt = it & 3, bh = it >> 2;
  constexpr int KROW = 192, VROW = 136, KBYTES = 64 * KROW, STAGE = KBYTES + 64 * VROW;
  const bf16_t* Kb = p.K + (size_t)bh * NKEY * QKD;
  const bf16_t* Vb = p.Vt + (size_t)bh * VD * NKEY;
  const int qposa = qt * 512 + w * 64 + r, qposb = qposa + 32;
  const bf16_t* Qa = p.Q + ((size_t)bh * SEQ + qposa) * QKD + hh * 8;
  bf16x8 qfa[6], qfb[6];
#pragma unroll
  for (int c = 0; c < 6; ++c) { qfa[c] = *(const bf16x8*)(Qa + c * 16); qfb[c] = *(const bf16x8*)(Qa + 32 * QKD + c * 16); }
  f32x16 oa[2], ob[2]; oa[0] = zero16(); oa[1] = zero16(); ob[0] = zero16(); ob[1] = zero16();
  float gk = 0.f;
  for (int f = 0; f < QKD; ++f) gk = fmaxf(gk, fabsf(p.k_norm_g[f]));
  float qsa = 0.f, qsb = 0.f;
#pragma unroll
  for (int c = 0; c < 6; ++c) {
    const uint4 u = __builtin_bit_cast(uint4, qfa[c]), v = __builtin_bit_cast(uint4, qfb[c]);
    qsa += bf_lo(u.x) * bf_lo(u.x) + bf_hi(u.x) * bf_hi(u.x) + bf_lo(u.y) * bf_lo(u.y) + bf_hi(u.y) * bf_hi(u.y) + bf_lo(u.z) * bf_lo(u.z) + bf_hi(u.z) * bf_hi(u.z) + bf_lo(u.w) * bf_lo(u.w) + bf_hi(u.w) * bf_hi(u.w);
    qsb += bf_lo(v.x) * bf_lo(v.x) + bf_hi(v.x) * bf_hi(v.x) + bf_lo(v.y) * bf_lo(v.y) + bf_hi(v.y) * bf_hi(v.y) + bf_lo(v.z) * bf_lo(v.z) + bf_hi(v.z) * bf_hi(v.z) + bf_lo(v.w) * bf_lo(v.w) + bf_hi(v.w) * bf_hi(v.w);
  }
  qsa += __shfl_xor(qsa, 32); qsb += __shfl_xor(qsb, 32);
  const float negC = -(sqrtf(fmaxf(qsa, qsb)) * gk * 9.797959f * 1.01f);
  f32x16 sinit;
#pragma unroll
  for (int i = 0; i < 16; ++i) sinit[i] = negC;
  float la = 0.f, lb = 0.f;
  const int kid0 = t, kid1 = (t & 255) + 512;
  const bool k1v = t < 256;
  const int kgo0 = (kid0 / 12) * QKD + (((kid0 % 12) ^ (((kid0 / 12) >> 2) & 3))) * 8, kgo1 = (kid1 / 12) * QKD + (((kid1 % 12) ^ (((kid1 / 12) >> 2) & 3))) * 8;
  const int klo0 = kid0 * 16, klo1 = kid1 * 16;
  const int vgo0 = (t >> 3) * NKEY + (t & 7) * 8;
  const int vlo0 = KBYTES + (t >> 3) * VROW + (t & 7) * 16;
  uint4 rv0;
  GLDS(Kb + kgo0, smem + klo0); if (k1v) GLDS(Kb + kgo1, smem + klo1);
  rv0 = *(const uint4*)(Vb + vgo0);
  SB_;
#define ATT64_STORE(base) do { \
    { uint2* d = (uint2*)((base) + vlo0); d[0] = make_uint2(rv0.x, rv0.y); d[1] = make_uint2(rv0.z, rv0.w); } } while (0)
  ATT64_STORE(smem);
  __syncthreads();
  const int sw = (r >> 2) & 3;
  const int sb32 = ((sw >> 1) & 1) * 32;
  const int swo = ((hh ^ (sw & 1)) << 4) + sb32;
  constexpr int NKT = NKEY / 64;
  for (int kt = 0; kt < NKT; ++kt) {
    const char* cur = smem + (kt & 1) * STAGE;
    const bool more = kt + 1 < NKT;
    if (more) {
      const bf16_t* kn = Kb + (size_t)(kt + 1) * 64 * QKD; const bf16_t* vn = Vb + (kt + 1) * 64;
      char* nx = smem + ((kt + 1) & 1) * STAGE;
      GLDS(kn + kgo0, nx + klo0); if (k1v) GLDS(kn + kgo1, nx + klo1);
      rv0 = *(const uint4*)(vn + vgo0);
    }
    SB_;
#pragma unroll
    for (int t2 = 0; t2 < 2; ++t2) {
      const char* kpe = cur + (t2 * 32 + r) * KROW + swo;
      const char* kpo = kpe - 2 * sb32;
      f32x16 sa, sb;
      { const bf16x8 kf = *(const bf16x8*)(kpe); sa = MFMA(kf, qfa[0], sinit); sb = MFMA(kf, qfb[0], sinit); }
#pragma unroll
      for (int c = 1; c < 6; ++c) { const bf16x8 kf = *(const bf16x8*)(((c & 1) ? kpo : kpe) + c * 32); sa = MFMA(kf, qfa[c], sa); sb = MFMA(kf, qfb[c], sb); }
      SB_;
      float lsa = 0.f, lsb = 0.f;
#pragma unroll
      for (int i = 0; i < 16; ++i) { const float e = __builtin_amdgcn_exp2f(sa[i]); sa[i] = e; lsa += e; const float f = __builtin_amdgcn_exp2f(sb[i]); sb[i] = f; lsb += f; }
      la += lsa; lb += lsb;
      SB_;
#pragma unroll
      for (int s2 = 0; s2 < 2; ++s2) {
        uint4 pu, pv;
        pu.x = pk_bf16(sa[8 * s2 + 0], sa[8 * s2 + 1]); pu.y = pk_bf16(sa[8 * s2 + 2], sa[8 * s2 + 3]); pu.z = pk_bf16(sa[8 * s2 + 4], sa[8 * s2 + 5]); pu.w = pk_bf16(sa[8 * s2 + 6], sa[8 * s2 + 7]);
        pv.x = pk_bf16(sb[8 * s2 + 0], sb[8 * s2 + 1]); pv.y = pk_bf16(sb[8 * s2 + 2], sb[8 * s2 + 3]); pv.z = pk_bf16(sb[8 * s2 + 4], sb[8 * s2 + 5]); pv.w = pk_bf16(sb[8 * s2 + 6], sb[8 * s2 + 7]);
        const bf16x8 pa_ = __builtin_bit_cast(bf16x8, pu), pb_ = __builtin_bit_cast(bf16x8, pv);
#pragma unroll
        for (int vt = 0; vt < 2; ++vt) {
          const char* vp = cur + KBYTES + (vt * 32 + r) * VROW + (t2 * 32 + 16 * s2 + 4 * hh) * 2;
          const uint2 lo = *(const uint2*)(vp), hi = *(const uint2*)(vp + 16);
          uint4 vu; vu.x = lo.x; vu.y = lo.y; vu.z = hi.x; vu.w = hi.y;
          const bf16x8 vf = __builtin_bit_cast(bf16x8, vu);
          oa[vt] = MFMA(vf, pa_, oa[vt]);
          ob[vt] = MFMA(vf, pb_, ob[vt]);
        }
      }
      SB_;
    }
    SB_;
    if (more) { char* nxt = smem + ((kt + 1) & 1) * STAGE; ATT64_STORE(nxt); }
    __syncthreads();
  }
  la += __shfl_xor(la, 32); lb += __shfl_xor(lb, 32);
  const float inva = 1.f / la, invb = 1.f / lb;
  const int b = bh >> 3, hd = bh & 7;
  const int te_ = tid_();
  bf16_t* oda = p.attn_o + (size_t)(b * SEQ + qt * 512 + (te_ >> 6) * 64 + (te_ & 31)) * 512 + hd * 64;
  bf16_t* odb = oda + (size_t)32 * 512;
#pragma unroll
  for (int vt = 0; vt < 2; ++vt)
#pragma unroll
    for (int q = 0; q < 4; ++q) {
      uint2 ou; ou.x = pk_bf16(oa[vt][4 * q] * inva, oa[vt][4 * q + 1] * inva); ou.y = pk_bf16(oa[vt][4 * q + 2] * inva, oa[vt][4 * q + 3] * inva);
      *(uint2*)(oda + vt * 32 + 8 * q + 4 * hh) = ou;
      uint2 ov; ov.x = pk_bf16(ob[vt][4 * q] * invb, ob[vt][4 * q + 1] * invb); ov.y = pk_bf16(ob[vt][4 * q + 2] * invb, ob[vt][4 * q + 3] * invb);
      *(uint2*)(odb + vt * 32 + 8 * q + 4 * hh) = ov;
    }
}

DI void phase4(const Params& p, char* smem) {
  const int t = tid_(), lane = t & 63, w = t >> 6, r = lane & 31, hh = lane >> 5;
  const int nDft = 64, nAlt = 4, nAtt = 128;
  const int xcd = blockIdx.x & 7, jl = blockIdx.x >> 3, nl = gridDim.x >> 3;
  for (int it = jl; it < nDft + nAlt + nAtt; it += nl) {
    if (it < nDft) {
      const int bl = it >> 4, rem = it & 15, ct = rem >> 3, kt = rem & 7, b = xcd * 4 + bl;
      const int wm = w & 3, wn = w >> 2;
      const bf16_t* Ab = p.ABt + (size_t)(b * 512 + ct * 256) * 4096;
      const bf16_t* Cb = p.posM + (size_t)kt * 128 * 2048;
      const bf16_t* Sb = p.posM + (size_t)(1152 + kt * 128) * 2048;
      f32x16 acc1[2][2], acc2[2][2];
#pragma unroll
      for (int a = 0; a < 2; ++a)
#pragma unroll
        for (int c = 0; c < 2; ++c) { acc1[a][c] = zero16(); acc2[a][c] = zero16(); }
      float dummy = 0.f;
      gemm8s3(acc1, [&](int row) { return Ab + (size_t)row * 4096; }, [&](int row) { return Cb + (size_t)row * 2048; }, 2048, smem);
      gemm8s3(acc2, [&](int row) { return Ab + (size_t)row * 4096 + 2048; }, [&](int row) { return Sb + (size_t)row * 2048; }, 2048, smem);
      const float sc = 1.f / 512.f;
#pragma unroll
      for (int tm = 0; tm < 2; ++tm)
#pragma unroll
        for (int tn = 0; tn < 2; ++tn) {
          const int kpos = kt * 128 + wn * 64 + tn * 32 + r;
          const int moff = ct * 256 + wm * 64 + tm * 32 + 4 * hh;
          if (kpos <= 1024) {
            bf16_t* d = p.four_o + (size_t)(b * SEQ + kpos) * 512 + moff;
#pragma unroll
            for (int q = 0; q < 4; ++q) {
              uint2 ou; ou.x = pk_bf16((acc1[tm][tn][4 * q] - acc2[tm][tn][4 * q]) * sc, (acc1[tm][tn][4 * q + 1] - acc2[tm][tn][4 * q + 1]) * sc);
              ou.y = pk_bf16((acc1[tm][tn][4 * q + 2] - acc2[tm][tn][4 * q + 2]) * sc, (acc1[tm][tn][4 * q + 3] - acc2[tm][tn][4 * q + 3]) * sc);
              *(uint2*)(d + 8 * q) = ou;
            }
          }
          if (kpos >= 1 && kpos <= 1023) {
            bf16_t* d = p.four_o + (size_t)(b * SEQ + 2048 - kpos) * 512 + moff;
#pragma unroll
            for (int q = 0; q < 4; ++q) {
              uint2 ou; ou.x = pk_bf16((acc1[tm][tn][4 * q] + acc2[tm][tn][4 * q]) * sc, (acc1[tm][tn][4 * q + 1] + acc2[tm][tn][4 * q + 1]) * sc);
              ou.y = pk_bf16((acc1[tm][tn][4 * q + 2] + acc2[tm][tn][4 * q + 2]) * sc, (acc1[tm][tn][4 * q + 3] + acc2[tm][tn][4 * q + 3]) * sc);
              *(uint2*)(d + 8 * q) = ou;
            }
          }
        }
    } else if (it < nDft + nAlt) {
      const int b = xcd * 4 + (it - nDft);
      const int tl_ = tid_();
      const int lane_ = tl_ & 63;
      for (int m = tl_ >> 6; m < 512; m += NWV) {
        const bf16_t* rowp = p.ABt + (size_t)(b * 512 + m) * 4096 + lane_ * 8;
        float sacc = 0.f;
#pragma unroll
        for (int i = 0; i < 4; ++i) {
          const uint4 u = *(const uint4*)(rowp + 512 * i);
          sacc += (bf_lo(u.x) - bf_hi(u.x)) + (bf_lo(u.y) - bf_hi(u.y)) + (bf_lo(u.z) - bf_hi(u.z)) + (bf_lo(u.w) - bf_hi(u.w));
        }
        sacc = wave_sum(sacc);
        if (lane_ == 0) p.four_o[(size_t)(b * SEQ + 1024) * 512 + m] = f2bf(sacc * (1.f / 512.f));
      }
    } else {
      attn_item64(p, xcd * 128 + (it - nDft - nAlt), smem);
    }
  }
}

DI void phase5(const Params& p, char* smem) {
  const int t = tid_();
  const int xcd = blockIdx.x & 7, jl = blockIdx.x >> 3, nl = gridDim.x >> 3;
  for (int L = jl; L < 256; L += nl) {
    const int tokTile = xcd * 64 + (L >> 5) * 8 + (L & 7), nt = (L >> 3) & 3;
    f32x16 acc1[2][2], acc2[2][2];
#pragma unroll
    for (int a = 0; a < 2; ++a)
#pragma unroll
      for (int c = 0; c < 2; ++c) { acc1[a][c] = zero16(); acc2[a][c] = zero16(); }
    float dummy = 0.f;
    {
      const bf16_t* Ab = p.WoT + (size_t)nt * 256 * 512; const bf16_t* Bb = p.attn_o + (size_t)tokTile * 128 * 512;
      gemm8s3(acc1, [&](int row) { return Ab + (size_t)row * 512; }, [&](int row) { return Bb + (size_t)row * 512; }, 512, smem);
    }
    {
      const bf16_t* Ab = p.WfT + (size_t)nt * 256 * 512; const bf16_t* Bb = p.four_o + (size_t)tokTile * 128 * 512;
      gemm8s3(acc2, [&](int row) { return Ab + (size_t)row * 512; }, [&](int row) { return Bb + (size_t)row * 512; }, 512, smem);
    }
    {
      char* t1 = smem; char* t2 = smem + 128 * 528;
      const int ch = t & 31, r0 = t >> 5;
      stage_tile<2, 2, 4, 2>(acc1, t1, 528, [](float v) { return v; });
      stage_tile<2, 2, 4, 2>(acc2, t2, 528, [](float v) { return v; });
      lds_sync();
#pragma unroll
      for (int hb = 0; hb < 2; ++hb) {
        uint4 gav[4], gbv[4];
#pragma unroll
        for (int i = 0; i < 4; ++i) {
          const size_t tok = (size_t)tokTile * 128 + r0 + 16 * (hb * 4 + i);
          gav[i] = *(const uint4*)(p.pg + tok * 2048 + nt * 256 + ch * 8); gbv[i] = *(const uint4*)(p.pg + tok * 2048 + 1024 + nt * 256 + ch * 8);
        }
#pragma unroll
        for (int i = 0; i < 4; ++i) {
          const int row = r0 + 16 * (hb * 4 + i);
          const size_t tok = (size_t)tokTile * 128 + row;
          const uint4 u1 = *(const uint4*)(t1 + row * 528 + ch * 16), u2 = *(const uint4*)(t2 + row * 528 + ch * 16);
          const uint4 ga = gav[i], gb = gbv[i];
          uint4 o;
          o.x = pk_bf16(bf_lo(ga.x) * bf_lo(u1.x) + bf_lo(gb.x) * bf_lo(u2.x), bf_hi(ga.x) * bf_hi(u1.x) + bf_hi(gb.x) * bf_hi(u2.x));
          o.y = pk_bf16(bf_lo(ga.y) * bf_lo(u1.y) + bf_lo(gb.y) * bf_lo(u2.y), bf_hi(ga.y) * bf_hi(u1.y) + bf_hi(gb.y) * bf_hi(u2.y));
          o.z = pk_bf16(bf_lo(ga.z) * bf_lo(u1.z) + bf_lo(gb.z) * bf_lo(u2.z), bf_hi(ga.z) * bf_hi(u1.z) + bf_hi(gb.z) * bf_hi(u2.z));
          o.w = pk_bf16(bf_lo(ga.w) * bf_lo(u1.w) + bf_lo(gb.w) * bf_lo(u2.w), bf_hi(ga.w) * bf_hi(u1.w) + bf_hi(gb.w) * bf_hi(u2.w));
          *(uint4*)(p.m + tok * DM + nt * 256 + ch * 8) = o;
        }
      }
      lds_sync();
    }
  }
}

DI void phase6(const Params& p, char* smem) {
  const int t = tid_(), lane = t & 63, w = t >> 6, r = lane & 31, hh = lane >> 5;
  const int wm = w & 1, wn = w >> 1;
  const int xcd = blockIdx.x & 7, jl = blockIdx.x >> 3, nl = gridDim.x >> 3;
  for (int L = jl; L < 128; L += nl) {
    const int tokTile = xcd * 32 + (L >> 5) * 8 + (L & 7), nt = (L >> 3) & 3;
    f32x16 acc[4][2];
#pragma unroll
    for (int a = 0; a < 4; ++a)
#pragma unroll
      for (int c = 0; c < 2; ++c) acc[a][c] = zero16();
    float dummy = 0.f;
    const bf16_t* Wb = p.WoutT + (size_t)nt * 256 * DM; const bf16_t* Mb = p.m + (size_t)tokTile * 256 * DM;
    gemm8<4, 2, 2, 4, false>(acc, [&](int row) { return Wb + (size_t)row * DM; }, [&](int row) { return Mb + (size_t)row * DM; }, DM, smem, dummy);
    const int tc_ = tid_();
    const int ch = tc_ & 63, r0 = tc_ >> 6;
    const float4 g = *(const float4*)(p.mod + (tokTile >> 3) * 6144 + 2048 + nt * 256 + ch * 4);
#pragma unroll
    for (int tn = 0; tn < 2; ++tn) {
      const size_t obase = ((size_t)tokTile * 256 + tn * 32) * DM + nt * 256 + ch * 4;
#pragma unroll
      for (int tm = 0; tm < 4; ++tm) {
        char* d = smem + (wn * 32 + r) * 1040 + (wm * 128 + tm * 32 + 4 * hh) * 4;
#pragma unroll
        for (int q = 0; q < 4; ++q) *(float4*)(d + 32 * q) = make_float4(acc[tm][tn][4 * q], acc[tm][tn][4 * q + 1], acc[tm][tn][4 * q + 2], acc[tm][tn][4 * q + 3]);
      }
      lds_sync();
#pragma unroll
      for (int hb = 0; hb < 2; ++hb) {
        float4 xv[8];
#pragma unroll
        for (int i = 0; i < 8; ++i) {
          const int row = r0 + 8 * (hb * 8 + i);
          xv[i] = *(const float4*)(p.x + obase + (size_t)((row >> 5) * 64 + (row & 31)) * DM);
        }
#pragma unroll
        for (int i = 0; i < 8; ++i) {
          const int row = r0 + 8 * (hb * 8 + i);
          const float4 a = *(const float4*)(smem + row * 1040 + ch * 16);
          uint2 ob; ob.x = pk_bf16(xv[i].x + g.x * a.x, xv[i].y + g.y * a.y); ob.y = pk_bf16(xv[i].z + g.z * a.z, xv[i].w + g.w * a.w);
          *(uint2*)(p.x1b + obase + (size_t)((row >> 5) * 64 + (row & 31)) * DM) = ob;
        }
      }
      lds_sync();
    }
  }
}

DI void phase7(const Params& p, char* smem) {
  const int t = tid_(), lane = t & 63, w = t >> 6;
  float* wr = (float*)smem;
  for (int idx = t; idx < DM * NE; idx += NTH) { const int d = idx >> 4, e = idx & 15; wr[e * DM + d] = p.w_router[idx]; }
  __syncthreads();
  const int gw = blockIdx.x * NWV + w, nw = gridDim.x * NWV;
  auto router = [&](const float4 (&v)[4], int R) {
    asm volatile("" ::: "memory");
    float a[16];
#pragma unroll
    for (int e = 0; e < 16; ++e) {
      float s = 0.f;
#pragma unroll
      for (int i = 0; i < 4; ++i) { const float4 wv = *(const float4*)(wr + e * DM + lane * 4 + 256 * i); s += v[i].x * wv.x + v[i].y * wv.y + v[i].z * wv.z + v[i].w * wv.w; }
      a[e] = s;
      if ((e & 3) == 3) __builtin_amdgcn_sched_barrier(0);
    }
    float a8[8], a4[4], a2[2], a1;
    {
      const bool up = lane & 32;
#pragma unroll
      for (int j = 0; j < 8; ++j) { const float send = up ? a[j] : a[j + 8]; const float keep = up ? a[j + 8] : a[j]; a8[j] = keep + __shfl_xor(send, 32); }
    }
    {
      const bool up = lane & 16;
#pragma unroll
      for (int j = 0; j < 4; ++j) { const float send = up ? a8[j] : a8[j + 4]; const float keep = up ? a8[j + 4] : a8[j]; a4[j] = keep + __shfl_xor(send, 16); }
    }
    {
      const bool up = lane & 8;
#pragma unroll
      for (int j = 0; j < 2; ++j) { const float send = up ? a4[j] : a4[j + 2]; const float keep = up ? a4[j + 2] : a4[j]; a2[j] = keep + __shfl_xor(send, 8); }
    }
    {
      const bool up = lane & 4;
      const float send = up ? a2[0] : a2[1]; const float keep = up ? a2[1] : a2[0]; a1 = keep + __shfl_xor(send, 4);
    }
    a1 += __shfl_xor(a1, 2);
    a1 += __shfl_xor(a1, 1);
    float mx = a1;
#pragma unroll
    for (int o = 4; o <= 32; o <<= 1) mx = fmaxf(mx, __shfl_xor(mx, o));
    const float ex = __expf(a1 - mx);
    float sm = ex;
#pragma unroll
    for (int o = 4; o <= 32; o <<= 1) sm += __shfl_xor(sm, o);
    if ((lane & 3) == 0) {
      const int e = (lane >> 2) & 15;
      p.aff[((size_t)((R >> 11) * NE + e)) * SEQ + (R & 2047)] = ex / sm;
    }
  };
  for (int R0 = gw; R0 < NT; R0 += 2 * nw) {
    const int R1 = R0 + nw;
    const bool has1 = R1 < NT;
    const bf16_t* src0 = p.x1b + (size_t)R0 * DM;
    const bf16_t* src1 = p.x1b + (size_t)(has1 ? R1 : R0) * DM;
    const float* md0 = p.mod + (R0 >> 11) * 6144;
    const float* md1 = p.mod + ((has1 ? R1 : R0) >> 11) * 6144;
    float4 v0[4], v1[4]; float s0 = 0.f, s1 = 0.f;
#pragma unroll
    for (int i = 0; i < 4; ++i) {
      const uint2 u0 = *(const uint2*)(src0 + lane * 4 + 256 * i), u1 = *(const uint2*)(src1 + lane * 4 + 256 * i);
      v0[i] = make_float4(bf_lo(u0.x), bf_hi(u0.x), bf_lo(u0.y), bf_hi(u0.y)); v1[i] = make_float4(bf_lo(u1.x), bf_hi(u1.x), bf_lo(u1.y), bf_hi(u1.y));
    }
#pragma unroll
    for (int i = 0; i < 4; ++i) { s0 += v0[i].x * v0[i].x + v0[i].y * v0[i].y + v0[i].z * v0[i].z + v0[i].w * v0[i].w; s1 += v1[i].x * v1[i].x + v1[i].y * v1[i].y + v1[i].z * v1[i].z + v1[i].w * v1[i].w; }
    s0 = wave_sum(s0); s1 = wave_sum(s1);
    const float r0 = rsqrtf(s0 * (1.f / DM) + EPS), r1 = rsqrtf(s1 * (1.f / DM) + EPS);
#pragma unroll
    for (int i = 0; i < 4; ++i) {
      const int d = lane * 4 + 256 * i;
      const float4 g = *(const float4*)(p.norm2_g + d);
      {
        const float4 sh = *(const float4*)(md0 + 3072 + d), sc = *(const float4*)(md0 + 4096 + d);
        v0[i].x = v0[i].x * r0 * g.x * (1.f + sc.x) + sh.x; v0[i].y = v0[i].y * r0 * g.y * (1.f + sc.y) + sh.y;
        v0[i].z = v0[i].z * r0 * g.z * (1.f + sc.z) + sh.z; v0[i].w = v0[i].w * r0 * g.w * (1.f + sc.w) + sh.w;
        uint2 o; o.x = pk_bf16(v0[i].x, v0[i].y); o.y = pk_bf16(v0[i].z, v0[i].w);
        *(uint2*)(p.h2 + (size_t)R0 * DM + d) = o;
      }
      if (has1) {
        const float4 sh = *(const float4*)(md1 + 3072 + d), sc = *(const float4*)(md1 + 4096 + d);
        v1[i].x = v1[i].x * r1 * g.x * (1.f + sc.x) + sh.x; v1[i].y = v1[i].y * r1 * g.y * (1.f + sc.y) + sh.y;
        v1[i].z = v1[i].z * r1 * g.z * (1.f + sc.z) + sh.z; v1[i].w = v1[i].w * r1 * g.w * (1.f + sc.w) + sh.w;
        uint2 o; o.x = pk_bf16(v1[i].x, v1[i].y); o.y = pk_bf16(v1[i].z, v1[i].w);
        *(uint2*)(p.h2 + (size_t)R1 * DM + d) = o;
      }
    }
    SB_;
    router(v0, R0);
    SB_;
    if (has1) router(v1, R1);
    SB_;
  }
}

DI void phase8(const Params& p) {
  const int t_ = tid_(); const int lane = t_ & 63, w = t_ >> 6;
  const int gw = w * gridDim.x + blockIdx.x, nw = gridDim.x * NWV;
  for (int pr = gw; pr < NB * NE; pr += nw) {
    const float* a = p.aff + (size_t)pr * SEQ;
    unsigned u[32];
#pragma unroll
    for (int q = 0; q < 32; ++q) u[q] = __float_as_uint(a[q * 64 + lane]);
    unsigned thr = 0;
    for (int bit = 30; bit >= 0; --bit) {
      const unsigned cand = thr | (1u << bit);
      int cnt = 0;
#pragma unroll
      for (int q = 0; q < 32; ++q) cnt += __popcll(__ballot(u[q] >= cand));
      if (cnt >= CAP) thr = cand;
    }
    int ngt = 0;
#pragma unroll
    for (int q = 0; q < 32; ++q) ngt += __popcll(__ballot(u[q] > thr));
    int cgt = 0, ceq = 0;
    int* io = p.idx + pr * CAP; float* go = p.gate + pr * CAP;
    int* iv = p.inv + (size_t)pr * SEQ;
#pragma unroll
    for (int q = 0; q < 32; ++q) {
      const bool gt = u[q] > thr, eq = u[q] == thr;
      const unsigned long long mg = __ballot(gt), me = __ballot(eq);
      const unsigned long long below = (1ull << lane) - 1ull;
      int myslot = -1;
      if (gt) { const int s = cgt + __popcll(mg & below); io[s] = q * 64 + lane; go[s] = __uint_as_float(u[q]); myslot = s; }
      if (eq) { const int s = ngt + ceq + __popcll(me & below); if (s < CAP) { io[s] = q * 64 + lane; go[s] = __uint_as_float(u[q]); myslot = s; } }
      iv[q * 64 + lane] = myslot;
      cgt += __popcll(mg); ceq += __popcll(me);
    }
  }
}

DI void phase9_10(const Params& p, char* smem) {
  const int t = tid_(), lane = t & 63, w = t >> 6, r = lane & 31, hh = lane >> 5;
  const int wm = w & 1, wn = w >> 1;
  const int xcd = blockIdx.x & 7, jl = blockIdx.x >> 3, nl = gridDim.x >> 3;
  for (int pi = jl; pi < 2 * NB; pi += nl) {
    const int e = xcd * 2 + pi / NB, b = pi % NB;
    const int be = b * NE + e;
    const int* ib = p.idx + be * CAP;
    const bf16_t* hb = p.h2 + (size_t)b * SEQ * DM;
    bool pre = false;
    for (int ft = 0; ft < 4; ++ft) {
      const bool hasNext = ft < 3;
      const bf16_t* Ab = p.WguT + ((size_t)e * 1024 + ft * 256) * DM;
      const bf16_t* AbN = Ab + (size_t)256 * DM;
      f32x16 acc[4][2];
#pragma unroll
      for (int a = 0; a < 4; ++a)
#pragma unroll
        for (int c = 0; c < 2; ++c) acc[a][c] = zero16();
      float dummy = 0.f;
      gemm8x<4, 2, 2, 4, false, 2>(acc, [&](int row) { return Ab + (size_t)row * DM; }, [&](int row) { return hb + (size_t)ib[row] * DM; }, DM, smem, dummy,
                                   pre, hasNext, [&](int row) { return AbN + (size_t)row * DM; }, [&](int row) { return hb + (size_t)ib[row] * DM; });
      pre = hasNext;
      char* tile = smem + EPI_OFF;
#pragma unroll
      for (int tn = 0; tn < 2; ++tn)
#pragma unroll
        for (int pr = 0; pr < 2; ++pr) {
          char* d = tile + (wn * 64 + tn * 32 + r) * 272 + (wm * 64 + pr * 32 + 4 * hh) * 2;
#pragma unroll
          for (int q = 0; q < 4; ++q) {
            float v[4];
#pragma unroll
            for (int j = 0; j < 4; ++j) { const float g = acc[2 * pr][tn][4 * q + j], uu = acc[2 * pr + 1][tn][4 * q + j]; v[j] = g * sigmoidf_(g) * uu; }
            uint2 ou; ou.x = pk_bf16(v[0], v[1]); ou.y = pk_bf16(v[2], v[3]);
            *(uint2*)(d + 16 * q) = ou;
          }
        }
      lds_sync();
      bf16_t* hd_ = p.hmid + (size_t)be * CAP * DE + ft * 128;
      copy_tile(tile, 272, 256, 4, [&](int row) { return hd_ + (size_t)row * DE; }, 0, 16);
    }
    __syncthreads();
    for (int it2 = 0; it2 < 8; ++it2) {
      const int nt = it2 >> 1, st = it2 & 1;
      const bf16_t* Hb = p.hmid + ((size_t)be * CAP + st * 128) * DE;
      const bf16_t* Wb = p.WdT + ((size_t)e * DM + nt * 256) * DE;
      f32x16 acc[2][2];
#pragma unroll
      for (int a = 0; a < 2; ++a)
#pragma unroll
        for (int c = 0; c < 2; ++c) acc[a][c] = zero16();
      gemm8s3(acc, [&](int row) { return Wb + (size_t)row * DE; }, [&](int row) { return Hb + (size_t)row * DE; }, DE, smem);
      stage_tile<2, 2, 4, 2>(acc, smem, 528, [](float v) { return v; });
      lds_sync();
      bf16_t* yb = p.Y + ((size_t)be * CAP + st * 128) * DM + nt * 256;
      copy_tile(smem, 528, 128, 5, [&](int row) { return yb + (size_t)row * DM; }, 0, 32);
      lds_sync();
    }
  }
}

DI void phase11(const Params& p) {
  const int t_ = tid_(); const int lane = t_ & 63, w = t_ >> 6;
  const int gw = blockIdx.x * NWV + w, nw = gridDim.x * NWV;
  auto slotOf = [&](int R) { return (lane < NE && R < NT) ? p.inv[((size_t)((R >> 11) * NE + lane)) * SEQ + (R & 2047)] : -1; };
  int nslot = slotOf(gw);
  uint2 nx[4];
  {
    const bf16_t* xs = p.x1b + (size_t)(gw < NT ? gw : 0) * DM + lane * 4;
#pragma unroll
    for (int i = 0; i < 4; ++i) nx[i] = *(const uint2*)(xs + 256 * i);
  }
  for (int R = gw; R < NT; R += nw) {
    const int b = R >> 11;
    const int myslot = nslot;
    uint2 xu[4];
#pragma unroll
    for (int i = 0; i < 4; ++i) xu[i] = nx[i];
    {
      const int Rn = R + nw;
      nslot = slotOf(Rn);
      const bf16_t* xs = p.x1b + (size_t)(Rn < NT ? Rn : 0) * DM + lane * 4;
#pragma unroll
      for (int i = 0; i < 4; ++i) nx[i] = *(const uint2*)(xs + 256 * i);
    }
    unsigned long long mask = __ballot(myslot >= 0);
    float4 a[4];
#pragma unroll
    for (int i = 0; i < 4; ++i) a[i] = make_float4(0.f, 0.f, 0.f, 0.f);
    while (mask) {
      const int e = __ffsll((long long)mask) - 1; mask &= mask - 1ull;
      const int slot = __shfl(myslot, e);
      const float g = p.gate[(b * NE + e) * CAP + slot];
      const bf16_t* y = p.Y + ((size_t)(b * NE + e) * CAP + slot) * DM + lane * 4;
#pragma unroll
      for (int i = 0; i < 4; ++i) {
        const uint2 u = *(const uint2*)(y + 256 * i);
        a[i].x += g * bf_lo(u.x); a[i].y += g * bf_hi(u.x); a[i].z += g * bf_lo(u.y); a[i].w += g * bf_hi(u.y);
      }
    }
    const float* g2 = p.mod + b * 6144 + 5120;
    float* o = p.out + (size_t)R * DM;
#pragma unroll
    for (int i = 0; i < 4; ++i) {
      const int d = lane * 4 + 256 * i;
      const float4 gv = *(const float4*)(g2 + d);
      *(float4*)(o + d) = make_float4(bf_lo(xu[i].x) + gv.x * a[i].x, bf_hi(xu[i].x) + gv.y * a[i].y, bf_lo(xu[i].y) + gv.z * a[i].z, bf_hi(xu[i].y) + gv.w * a[i].w);
    }
  }
}

__global__ void __launch_bounds__(NTH, 2) mega_kernel(Params p) {
  cg::grid_group grid = cg::this_grid();
  __shared__ __attribute__((aligned(16))) char smem[SMEM_BYTES];
#ifndef REPMASK
#define REPMASK 0
#endif
#define RUNPH(k, call) for (int rep_ = 0; rep_ < (((REPMASK) >> (k)) & 1) + 1; ++rep_) { call; grid.sync(); }
  phase0a(p, smem);
  wait_mod(p);
  phase1(p);
  phase0b(p, smem);
  grid.sync();
  RUNPH(2, phase2(p, smem))
  RUNPH(3, phase3(p, smem))
  RUNPH(4, phase4(p, smem))
  RUNPH(5, phase5(p, smem))
  RUNPH(6, phase6(p, smem))
  RUNPH(7, phase7(p, smem))
  RUNPH(8, phase8(p))
  phase9_10(p, smem);
  grid.sync();
  phase11(p);
}

static inline size_t align_up(size_t v, size_t a) { return (v + a - 1) / a * a; }

extern "C" void kernel_launch(void* const* d_in, const int* in_sizes, int n_in,
                              void* d_out, int out_size, void* d_ws, size_t ws_size,
                              hipStream_t stream) {
  static int grid_blocks = 0;
  if (!grid_blocks) {
    int dev = 0, cus = 0, per_cu = 0;
    (void)hipGetDevice(&dev);
    (void)hipDeviceGetAttribute(&cus, hipDeviceAttributeMultiprocessorCount, dev);
    (void)hipOccupancyMaxActiveBlocksPerMultiprocessor(&per_cu, mega_kernel, NTH, 0);
    if (per_cu > 1) per_cu = 1;
    if (per_cu < 1) per_cu = 1;
    grid_blocks = (cus * per_cu) & ~7;
    if (grid_blocks < 8) grid_blocks = 8;
  }
  Params p;
  memset(&p, 0, sizeof(p));
  p.x = (const float*)d_in[0]; p.c = (const float*)d_in[1]; p.ctx = (const float*)d_in[2]; p.c_ctx = (const float*)d_in[3];
  p.w_mod = (const float*)d_in[4]; p.b_mod = (const float*)d_in[5]; p.norm1_g = (const float*)d_in[6];
  const float* w_in = (const float*)d_in[7];
  const float* q_a_g = (const float*)d_in[8];
  const float* kv_a_g = (const float*)d_in[9];
  const float* w_q_up = (const float*)d_in[10];
  const float* w_kv_up = (const float*)d_in[11];
  p.q_norm_g = (const float*)d_in[12]; p.k_norm_g = (const float*)d_in[13];
  const float* w_o_attn = (const float*)d_in[14];
  const float* w_fourier = (const float*)d_in[15];
  const float* w_out = (const float*)d_in[16];
  p.norm2_g = (const float*)d_in[17]; p.w_router = (const float*)d_in[18];
  const float* w_e_gate = (const float*)d_in[19];
  const float* w_e_up = (const float*)d_in[20];
  const float* w_e_down = (const float*)d_in[21];
  p.out = (float*)d_out;

  char* base = (char*)d_ws; size_t off = 0;
  auto alloc = [&](size_t bytes) { char* q = base + off; off = align_up(off + bytes, 256); return q; };
  p.WinT = (bf16_t*)alloc((size_t)NINP * DM * 2);
  p.WqT = (bf16_t*)alloc((size_t)768 * QL * 2);
  p.WkvT = (bf16_t*)alloc((size_t)1024 * KVL * 2);
  p.WoT = (bf16_t*)alloc((size_t)DM * 512 * 2);
  p.WfT = (bf16_t*)alloc((size_t)DM * 512 * 2);
  p.WoutT = (bf16_t*)alloc((size_t)DM * DM * 2);
  p.WguT = (bf16_t*)alloc((size_t)NE * 1024 * DM * 2);
  p.WdT = (bf16_t*)alloc((size_t)NE * DM * DE * 2);
  p.chanT = (bf16_t*)alloc((size_t)256 * 128 * 2);
  p.posM = (bf16_t*)alloc((size_t)2 * 1152 * 2048 * 2);
  p.ropeTab = (float*)alloc(64 * 8 * 2 * 4);
  p.mod = (float*)alloc(33 * 6144 * 4);
  p.aff = (float*)alloc((size_t)NB * NE * SEQ * 4);
  p.gate = (float*)alloc((size_t)NB * NE * CAP * 4);
  p.idx = (int*)alloc((size_t)NB * NE * CAP * 4);
  p.inv = (int*)alloc((size_t)NB * NE * SEQ * 4);
  p.modctr = (unsigned*)alloc(256);
  p.pckv = (bf16_t*)alloc((size_t)NC * LDCKV * 2 + 4096);
  char* regA = alloc((size_t)(NT + NC) * DM * 2);
  p.h = (bf16_t*)regA; p.ABt = (bf16_t*)regA; p.h2 = (bf16_t*)regA;
  char* regB1 = alloc((size_t)NT * LDQKV * 2);
  p.pqkv = (bf16_t*)regB1; p.attn_o = (bf16_t*)regB1;
  char* regB2 = alloc((size_t)NT * 512 * 2);
  p.pf = (bf16_t*)regB2; p.four_o = (bf16_t*)regB2;
  p.x1b = (bf16_t*)regB1;
  if ((size_t)(regB2 - regB1) + (size_t)NT * 512 * 2 < (size_t)NT * DM * 2) { fprintf(stderr, "x1b does not fit\n"); return; }
  p.pg = (bf16_t*)alloc((size_t)NT * 2048 * 2);
  p.Y = p.pg;
  const size_t szQ = (size_t)NB * NH * SEQ * QKD * 2, szK = (size_t)NB * NH * NKEY * QKD * 2, szV = (size_t)NB * NH * VD * NKEY * 2;
  char* regC = alloc(szQ + szK + szV + 1024);
  p.Q = (bf16_t*)regC; p.K = (bf16_t*)(regC + align_up(szQ, 256)); p.Vt = (bf16_t*)(regC + align_up(szQ, 256) + align_up(szK, 256));
  p.m = (bf16_t*)regC; p.hmid = (bf16_t*)(regC + (size_t)NT * DM * 2);
  if (off > ws_size) { fprintf(stderr, "workspace too small: need %zu have %zu\n", off, ws_size); return; }

  int ts = 0;
  auto job = [&](int i, const float* src, bf16_t* dst, const float* scale, int K, int ldS, int n_off, int n_cnt, int dst_row0, int mode, int batch, long sbs, long dbs) {
    TJob& j = p.jobs[i];
    j.src = src; j.dst = dst; j.scale = scale; j.K = K; j.ldS = ldS; j.n_off = n_off; j.n_cnt = n_cnt; j.dst_row0 = dst_row0; j.mode = mode; j.batch = batch;
    j.tiles_n = (n_cnt + 63) / 64; j.tile_start = ts; j.src_bstride = sbs; j.dst_bstride = dbs;
    ts += batch * (K / 64) * j.tiles_n;
  };
  job(0, w_e_gate, p.WguT, nullptr, DM, DE, 0, DE, 0, 1, NE, (long)DM * DE, (long)1024 * DM);
  job(1, w_e_up, p.WguT, nullptr, DM, DE, 0, DE, 0, 2, NE, (long)DM * DE, (long)1024 * DM);
  job(2, w_e_down, p.WdT, nullptr, DE, DM, 0, DM, 0, 0, NE, (long)DE * DM, (long)DM * DE);
  job(3, w_in, p.WinT, nullptr, DM, N_IN, 0, 672, 0, 0, 1, 0, 0);
  job(4, w_in, p.WinT, nullptr, DM, N_IN, 672, 2560, 768, 0, 1, 0, 0);
  job(5, w_q_up, p.WqT, q_a_g, QL, 768, 0, 768, 0, 0, 1, 0, 0);
  job(6, w_kv_up, p.WkvT, kv_a_g, KVL, 1024, 0, 1024, 0, 0, 1, 0, 0);
  job(7, w_o_attn, p.WoT, nullptr, 512, DM, 0, DM, 0, 0, 1, 0, 0);
  job(8, w_fourier, p.WfT, nullptr, 512, DM, 0, DM, 0, 0, 1, 0, 0);
  job(9, w_out, p.WoutT, nullptr, DM, DM, 0, DM, 0, 0, 1, 0, 0);
  p.n_ttiles = ts;

  (void)hipMemsetAsync(p.modctr, 0, 256, stream);
  void* args[] = {&p};
  hipError_t e = hipLaunchCooperativeKernel((void*)mega_kernel, dim3(grid_blocks), dim3(NTH), args, 0, stream);
  if (e != hipSuccess) fprintf(stderr, "cooperative launch failed: %s (grid %d)\n", hipGetErrorString(e), grid_blocks);
}
```
